# Optimizing an MI355X kernel written in HIP

```python
import math
import jax
import jax.numpy as jnp
from jax import lax

D_MODEL = 1024
BATCH = 8
SEQ = 4096
DEPTH = 4

MEM_LEN = 256
MAX_POS_OFFSET = 4096

DN_HEADS = 4
DN_HEAD_DIM = 128
DN_KEY_DIM = DN_HEADS * DN_HEAD_DIM
DN_QKV_DIM = 3 * DN_KEY_DIM
DN_CONV = 4
DN_CHUNK = 64

SW_HEADS = 8
SW_HEAD_DIM = 64
SW_DIM = SW_HEADS * SW_HEAD_DIM
SW_BRANCHES = ((128, 1), (512, 4), (2048, 16))
SW_BLOCK = 128
ROPE_THETA = 10000.0

IN_SPLITS = (DN_QKV_DIM, DN_KEY_DIM, DN_HEADS, DN_HEADS, SW_DIM, SW_DIM, SW_DIM)
HYB_IN = sum(IN_SPLITS)
HYB_MIX = DN_KEY_DIM + SW_DIM

S5_GROUP = 16
S5_GROUPS = D_MODEL // S5_GROUP
S5_STATE = 64

X_HEADS = 4
X_HEAD_DIM = D_MODEL // X_HEADS

FFN_HIDDEN = -(-8 * D_MODEL // (3 * 256)) * 256

N_EVEN = (DEPTH + 1) // 2
N_ODD = DEPTH // 2
DEEPNORM_ALPHA = (2 * DEPTH) ** 0.25
DEEPNORM_BETA = (8 * DEPTH) ** -0.25
LN_EPS = 1e-5
RMS_EPS = 1e-6

kernel_name = 'hybrid_deltanet_dilated_s5_block'


def _split_points(sizes):
    pts, acc = [], 0
    for s in sizes[:-1]:
        acc += s
        pts.append(acc)
    return pts


def layer_norm(x, g, b):
    xf = x.astype(jnp.float32)
    mu = xf.mean(-1, keepdims=True)
    var = jnp.square(xf - mu).mean(-1, keepdims=True)
    return (xf - mu) * lax.rsqrt(var + LN_EPS) * g.astype(jnp.float32) + b.astype(jnp.float32)


def post_norm(h, sub, g, b):
    return layer_norm(DEEPNORM_ALPHA * h.astype(jnp.float32) + sub.astype(jnp.float32), g, b).astype(h.dtype)


def rms_norm(x, g):
    xf = x.astype(jnp.float32)
    return xf * lax.rsqrt(jnp.mean(xf * xf, -1, keepdims=True) + RMS_EPS) * g.astype(jnp.float32)


def l2_normalize(x):
    xf = x.astype(jnp.float32)
    return xf * lax.rsqrt(jnp.sum(xf * xf, -1, keepdims=True) + RMS_EPS)


def causal_depthwise_conv(x, w):
    k, c = w.shape
    return lax.conv_general_dilated(
        x, w.astype(x.dtype)[:, None, :], window_strides=(1,), padding=[(k - 1, 0)],
        dimension_numbers=('NWC', 'WIO', 'NWC'), feature_group_count=c)


def rope(x, pos):
    d = x.shape[-1]
    inv_freq = ROPE_THETA ** (-jnp.arange(0, d, 2, dtype=jnp.float32) / d)
    ang = pos.astype(jnp.float32)[..., None] * inv_freq
    cos, sin = jnp.cos(ang)[:, :, None, :], jnp.sin(ang)[:, :, None, :]
    xf = x.astype(jnp.float32)
    x1, x2 = xf[..., : d // 2], xf[..., d // 2:]
    return jnp.concatenate([x1 * cos - x2 * sin, x2 * cos + x1 * sin], -1).astype(x.dtype)


def gated_delta_rule(q, k, v, g, beta):
    bsz, s, h, dk = q.shape
    dv = v.shape[-1]
    c = DN_CHUNK
    n = s // c

    def chunk(t):
        return t.reshape(bsz, n, c, h, -1).transpose(0, 3, 1, 2, 4)

    q = chunk(q) * (dk ** -0.5)
    k = chunk(k)
    v = chunk(v)
    g = jnp.cumsum(chunk(g[..., None])[..., 0], axis=-1)
    beta = chunk(beta[..., None])[..., 0]
    causal = jnp.tril(jnp.ones((c, c), dtype=bool))
    strict = jnp.tril(jnp.ones((c, c), dtype=bool), -1)
    decay = jnp.exp(jnp.where(causal, g[..., :, None] - g[..., None, :], -jnp.inf))
    k_beta = k * beta[..., None]
    lower = jnp.where(strict, jnp.einsum('bhnid,bhnjd->bhnij', k_beta, k), 0.0) * decay
    eye = jnp.eye(c, dtype=jnp.float32)
    rhs = jnp.concatenate([v * beta[..., None], k_beta * jnp.exp(g)[..., None]], axis=-1)
    sol = lax.linalg.triangular_solve(lower + eye, rhs, left_side=True, lower=True,
                                      unit_diagonal=True)
    u, w = sol[..., :dv], sol[..., dv:]
    intra = jnp.einsum('bhnid,bhnjd->bhnij', q, k) * decay
    q_dec = q * jnp.exp(g)[..., None]
    g_last = g[..., -1]
    k_dec = k * jnp.exp(g_last[..., None] - g)[..., None]

    def step(state, inp):
        q_c, w_c, u_c, k_c, a_c, gl = inp
        v_new = u_c - jnp.einsum('bhcd,bhde->bhce', w_c, state)
        out = (jnp.einsum('bhcd,bhde->bhce', q_c, state)
               + jnp.einsum('bhij,bhje->bhie', a_c, v_new))
        state = state * jnp.exp(gl)[..., None, None] + jnp.einsum('bhcd,bhce->bhde', k_c, v_new)
        return state, out

    xs = tuple(jnp.moveaxis(t, 2, 0) for t in (q_dec, w, u, k_dec, intra, g_last))
    state0 = jnp.zeros((bsz, h, dk, dv), jnp.float32)
    _, out = lax.scan(step, state0, xs)
    return out.transpose(1, 0, 3, 2, 4).reshape(bsz, s, h, dv)


def gated_deltanet(qkv, z, b_logit, a_logit, conv_w, a_log, dt_bias, norm_g):
    bsz, s, _ = qkv.shape
    qkv = jax.nn.silu(causal_depthwise_conv(qkv, conv_w))
    q, k, v = jnp.split(qkv, [DN_KEY_DIM, 2 * DN_KEY_DIM], axis=-1)
    heads = lambda t: t.reshape(bsz, s, DN_HEADS, DN_HEAD_DIM)
    q = l2_normalize(heads(q))
    k = l2_normalize(heads(k))
    v = heads(v).astype(jnp.float32)
    beta = jax.nn.sigmoid(b_logit.astype(jnp.float32))
    g = -jnp.exp(a_log.astype(jnp.float32)) * jax.nn.softplus(
        a_logit.astype(jnp.float32) + dt_bias.astype(jnp.float32))
    o = gated_delta_rule(q, k, v, g, beta)
    o = rms_norm(o, norm_g) * jax.nn.silu(heads(z).astype(jnp.float32))
    return o.reshape(bsz, s, DN_KEY_DIM)


def dilated_branch(q, k, v, window, dilation):
    bsz, s, h, d = q.shape
    steps = window // dilation
    span = dilation * SW_BLOCK
    s_pad = -(-s // span) * span
    length = s_pad // dilation
    nb = length // SW_BLOCK

    def to_blocks(t):
        t = jnp.pad(t, ((0, 0), (0, s_pad - s), (0, 0), (0, 0)))
        t = t.reshape(bsz, length, dilation, h, -1).transpose(0, 2, 1, 3, 4)
        return t.reshape(bsz, dilation, nb, SW_BLOCK, h, -1)

    def with_prev(t):
        prev = jnp.pad(t, ((0, 0), (0, 0), (1, 0), (0, 0), (0, 0), (0, 0)))[:, :, :-1]
        return jnp.concatenate([prev, t], axis=3)

    def from_blocks(t):
        t = t.reshape(bsz, dilation, length, h, -1).transpose(0, 2, 1, 3, 4)
        return t.reshape(bsz, s_pad, h, -1)[:, :s]

    qb = to_blocks(q)
    kw = with_prev(to_blocks(k))
    vw = with_prev(to_blocks(v))
    scores = jnp.einsum('brnqhd,brnkhd->brnhqk', qb, kw,
                        preferred_element_type=jnp.float32) * (d ** -0.5)
    qi = jnp.arange(SW_BLOCK)[:, None] + SW_BLOCK
    kj = jnp.arange(2 * SW_BLOCK)[None, :]
    dist = qi - kj
    blk = jnp.arange(nb)[:, None, None]
    valid = (dist >= 0) & (dist <= steps) & (blk * SW_BLOCK + kj - SW_BLOCK >= 0)
    scores = jnp.where(valid[None, None, :, None], scores, -jnp.inf)
    m = scores.max(-1, keepdims=True)
    p = jnp.exp(scores - m)
    l = p.sum(-1)
    o = jnp.einsum('brnhqk,brnkhd->brnqhd', p, vw.astype(jnp.float32))
    o = o / jnp.swapaxes(l, -1, -2)[..., None]
    lse = jnp.swapaxes(m[..., 0] + jnp.log(l), -1, -2)
    return from_blocks(o), from_blocks(lse[..., None])[..., 0]


def dilated_attention(q, k, v, pos):
    q = rope(q, pos)
    k = rope(k, pos)
    outs, lses = [], []
    for window, dilation in SW_BRANCHES:
        o, lse = dilated_branch(q, k, v, window, dilation)
        outs.append(o)
        lses.append(lse)
    wts = jax.nn.softmax(jnp.stack(lses), axis=0)[..., None]
    return jnp.sum(jnp.stack(outs) * wts, axis=0)


def delta_dilated_mixer(h, positions, w_in, conv_w, a_log, dt_bias, norm_g, w_out):
    bsz, s, _ = h.shape
    proj = h @ w_in
    dn_qkv, dn_z, dn_b, dn_a, sw_q, sw_k, sw_v = jnp.split(proj, _split_points(IN_SPLITS), axis=-1)
    a_out = gated_deltanet(dn_qkv, dn_z, dn_b, dn_a, conv_w, a_log, dt_bias, norm_g)
    heads = lambda t: t.reshape(bsz, s, SW_HEADS, SW_HEAD_DIM)
    b_out = dilated_attention(heads(sw_q), heads(sw_k), heads(sw_v), positions).reshape(bsz, s, SW_DIM)
    mixed = jnp.concatenate([a_out, b_out], axis=-1).astype(h.dtype)
    return mixed @ w_out


def _lin_rec_combine(e1, e2):
    a1, b1 = e1
    a2, b2 = e2
    return a1 * a2, a2 * b1 + b2


def s5_mixer(u, a_re, a_im, log_dt, b_re, b_im, c_re, c_im, d_skip, w_o, w_g):
    bsz, s, d = u.shape
    uf = u.astype(jnp.float32)
    ug = uf.reshape(bsz, s, S5_GROUPS, S5_GROUP)
    f32 = jnp.float32
    a = lax.complex(a_re.astype(f32), a_im.astype(f32))
    dt = jnp.exp(log_dt.astype(f32))[:, None]
    a_bar = jnp.exp(a * dt)
    b_bar = ((a_bar - 1.0) / a)[..., None] * lax.complex(b_re.astype(f32), b_im.astype(f32))
    bu = jnp.einsum('gph,bsgh->bsgp', b_bar, ug.astype(jnp.complex64))
    a_seq = jnp.broadcast_to(a_bar, (1, s) + a_bar.shape)
    _, states = lax.associative_scan(_lin_rec_combine, (a_seq, bu), axis=1)
    y = (jnp.einsum('ghp,bsgp->bsgh', c_re.astype(f32), states.real)
         - jnp.einsum('ghp,bsgp->bsgh', c_im.astype(f32), states.imag))
    y = y.reshape(bsz, s, d) + d_skip.astype(f32) * uf
    hid = jax.nn.gelu(y).astype(u.dtype)
    return (hid @ w_o) * jax.nn.sigmoid(hid @ w_g)


def memory_cross_attention(h, mem, wq, wk, wv, wo):
    bsz, s, _ = h.shape
    m = mem.shape[1]
    q = (h @ wq).reshape(bsz, s, X_HEADS, X_HEAD_DIM)
    k = (mem @ wk).reshape(bsz, m, X_HEADS, X_HEAD_DIM)
    v = (mem @ wv).reshape(bsz, m, X_HEADS, X_HEAD_DIM)
    scores = jnp.einsum('bqhd,bkhd->bhqk', q, k, preferred_element_type=jnp.float32) * (X_HEAD_DIM ** -0.5)
    p = jax.nn.softmax(scores, axis=-1)
    o = jnp.einsum('bhqk,bkhd->bqhd', p, v.astype(jnp.float32)).reshape(bsz, s, D_MODEL)
    return o.astype(h.dtype) @ wo


def swiglu(h, wg, wu, wd):
    return (jax.nn.silu(h @ wg) * (h @ wu)) @ wd


def setup_inputs(seed: int = 0) -> dict:
    key = jax.random.key(seed)
    keys = iter(jax.random.split(key, 48))
    f32 = jnp.float32

    def nrm(shape, scale):
        return jax.random.normal(next(keys), shape, f32) * scale

    def uni(shape, lo, hi):
        return jax.random.uniform(next(keys), shape, f32, lo, hi)

    def gain(shape):
        return 1.0 + nrm(shape, 0.02)

    x = nrm((BATCH, SEQ, D_MODEL), 1.0)
    mem = nrm((BATCH, MEM_LEN, D_MODEL), 1.0)
    positions = (jax.random.randint(next(keys), (BATCH, 1), 0, MAX_POS_OFFSET, dtype=jnp.int32)
                 + jnp.arange(SEQ, dtype=jnp.int32)[None, :])

    hyb_w_in = nrm((N_EVEN, D_MODEL, HYB_IN), D_MODEL ** -0.5)
    dn_conv_w = nrm((N_EVEN, DN_CONV, DN_QKV_DIM), DN_CONV ** -0.5)
    dn_a_log = jnp.log(uni((N_EVEN, DN_HEADS), 1.0, 16.0))
    dt = jnp.exp(uni((N_EVEN, DN_HEADS), math.log(1e-3), math.log(1e-1)))
    dn_dt_bias = dt + jnp.log(-jnp.expm1(-dt))
    dn_norm_g = gain((N_EVEN, DN_HEAD_DIM))
    hyb_w_out = nrm((N_EVEN, HYB_MIX, D_MODEL), HYB_MIX ** -0.5 * DEEPNORM_BETA)

    s5_a_re = -0.5 + nrm((N_ODD, S5_GROUPS, S5_STATE), 0.01)
    s5_a_im = math.pi * jnp.arange(S5_STATE, dtype=f32) + nrm((N_ODD, S5_GROUPS, S5_STATE), 0.01)
    s5_log_dt = uni((N_ODD, S5_GROUPS), math.log(1e-3), math.log(1e-1))
    s5_b_re = nrm((N_ODD, S5_GROUPS, S5_STATE, S5_GROUP), (2 * S5_GROUP) ** -0.5)
    s5_b_im = nrm((N_ODD, S5_GROUPS, S5_STATE, S5_GROUP), (2 * S5_GROUP) ** -0.5)
    s5_c_re = nrm((N_ODD, S5_GROUPS, S5_GROUP, S5_STATE), 0.5 ** 0.5)
    s5_c_im = nrm((N_ODD, S5_GROUPS, S5_GROUP, S5_STATE), 0.5 ** 0.5)
    s5_d = nrm((N_ODD, D_MODEL), 1.0)
    s5_glu_wo = nrm((N_ODD, D_MODEL, D_MODEL), D_MODEL ** -0.5 * DEEPNORM_BETA)
    s5_glu_wg = nrm((N_ODD, D_MODEL, D_MODEL), D_MODEL ** -0.5)

    ln_mix_g = gain((DEPTH, D_MODEL))
    ln_mix_b = nrm((DEPTH, D_MODEL), 0.02)
    xq_w = nrm((DEPTH, D_MODEL, D_MODEL), D_MODEL ** -0.5)
    xk_w = nrm((DEPTH, D_MODEL, D_MODEL), D_MODEL ** -0.5)
    xv_w = nrm((DEPTH, D_MODEL, D_MODEL), D_MODEL ** -0.5)
    xo_w = nrm((DEPTH, D_MODEL, D_MODEL), D_MODEL ** -0.5 * DEEPNORM_BETA)
    ln_x_g = gain((DEPTH, D_MODEL))
    ln_x_b = nrm((DEPTH, D_MODEL), 0.02)
    ffn_wg = nrm((DEPTH, D_MODEL, FFN_HIDDEN), D_MODEL ** -0.5)
    ffn_wu = nrm((DEPTH, D_MODEL, FFN_HIDDEN), D_MODEL ** -0.5)
    ffn_wd = nrm((DEPTH, FFN_HIDDEN, D_MODEL), FFN_HIDDEN ** -0.5 * DEEPNORM_BETA)
    ln_ffn_g = gain((DEPTH, D_MODEL))
    ln_ffn_b = nrm((DEPTH, D_MODEL), 0.02)

    return {
        'x': x, 'mem': mem, 'positions': positions,
        'hyb_w_in': hyb_w_in, 'dn_conv_w': dn_conv_w, 'dn_a_log': dn_a_log,
        'dn_dt_bias': dn_dt_bias, 'dn_norm_g': dn_norm_g, 'hyb_w_out': hyb_w_out,
        's5_a_re': s5_a_re, 's5_a_im': s5_a_im, 's5_log_dt': s5_log_dt,
        's5_b_re': s5_b_re, 's5_b_im': s5_b_im, 's5_c_re': s5_c_re, 's5_c_im': s5_c_im,
        's5_d': s5_d, 's5_glu_wo': s5_glu_wo, 's5_glu_wg': s5_glu_wg,
        'ln_mix_g': ln_mix_g, 'ln_mix_b': ln_mix_b,
        'xq_w': xq_w, 'xk_w': xk_w, 'xv_w': xv_w, 'xo_w': xo_w,
        'ln_x_g': ln_x_g, 'ln_x_b': ln_x_b,
        'ffn_wg': ffn_wg, 'ffn_wu': ffn_wu, 'ffn_wd': ffn_wd,
        'ln_ffn_g': ln_ffn_g, 'ln_ffn_b': ln_ffn_b,
    }


def reference(x, mem, positions,
              hyb_w_in, dn_conv_w, dn_a_log, dn_dt_bias, dn_norm_g, hyb_w_out,
              s5_a_re, s5_a_im, s5_log_dt, s5_b_re, s5_b_im, s5_c_re, s5_c_im,
              s5_d, s5_glu_wo, s5_glu_wg,
              ln_mix_g, ln_mix_b,
              xq_w, xk_w, xv_w, xo_w, ln_x_g, ln_x_b,
              ffn_wg, ffn_wu, ffn_wd, ln_ffn_g, ln_ffn_b):
    h = x
    for layer in range(DEPTH):
        i = layer // 2
        if layer % 2 == 0:
            mix = delta_dilated_mixer(h, positions, hyb_w_in[i], dn_conv_w[i], dn_a_log[i],
                                      dn_dt_bias[i], dn_norm_g[i], hyb_w_out[i])
        else:
            mix = s5_mixer(h, s5_a_re[i], s5_a_im[i], s5_log_dt[i], s5_b_re[i], s5_b_im[i],
                           s5_c_re[i], s5_c_im[i], s5_d[i], s5_glu_wo[i], s5_glu_wg[i])
        h = post_norm(h, mix, ln_mix_g[layer], ln_mix_b[layer])
        h = post_norm(h, memory_cross_attention(h, mem, xq_w[layer], xk_w[layer], xv_w[layer], xo_w[layer]),
                      ln_x_g[layer], ln_x_b[layer])
        h = post_norm(h, swiglu(h, ffn_wg[layer], ffn_wu[layer], ffn_wd[layer]),
                      ln_ffn_g[layer], ln_ffn_b[layer])
    return h
```

```cpp
#include <hip/hip_runtime.h>
#include <hip/hip_cooperative_groups.h>
#include <cstdio>
namespace cg = cooperative_groups;

typedef unsigned short bf16_t;
using bf16x8 = __attribute__((ext_vector_type(8))) short;
using f32x4 = __attribute__((ext_vector_type(4))) float;
#define DI __device__ __forceinline__

constexpr int T_ = 32768, S_ = 4096;
constexpr size_t MiB = (size_t)1 << 20;
constexpr size_t SZ_SQ = (size_t)1024 * 1024, SZ_WIN = (size_t)3712 * 1024, SZ_GLU = (size_t)2048 * 1024,
                 SZ_GU = (size_t)5632 * 1024, SZ_WD = (size_t)1024 * 2816;
constexpr size_t SZ_COMMON = 4 * SZ_SQ + SZ_GU + SZ_WD;
constexpr size_t W_EVEN0 = 4 * SZ_COMMON;
constexpr size_t W_ODD0 = W_EVEN0 + 2 * (SZ_WIN + SZ_SQ);
constexpr float ALPHA = 1.681792830507429f;

constexpr size_t OFF_W = 0;
constexpr size_t OFF_HB = 126 * MiB;
constexpr size_t OFF_MEMB = 190 * MiB;
constexpr size_t OFF_ROPE = 194 * MiB;
constexpr size_t OFF_KX = 202 * MiB;
constexpr size_t OFF_VX = 206 * MiB;
constexpr size_t OFF_BIG = 210 * MiB;
constexpr size_t OFF_DNQKV = OFF_BIG;
constexpr size_t OFF_Z = OFF_BIG + 96 * MiB;
constexpr size_t OFF_SWQ = OFF_BIG + 128 * MiB;
constexpr size_t OFF_SWK = OFF_BIG + 160 * MiB;
constexpr size_t OFF_SWV = OFF_BIG + 192 * MiB;
constexpr size_t OFF_LOGIT = OFF_BIG + 224 * MiB;
constexpr size_t OFF_VN = OFF_BIG + 226 * MiB;
constexpr size_t OFF_ODN = OFF_BIG + 258 * MiB;
constexpr size_t OFF_QN = OFF_HB;
constexpr size_t OFF_KN = OFF_HB + 32 * MiB;
constexpr size_t OFF_XQ = OFF_BIG;
constexpr size_t OFF_XO = OFF_BIG + 64 * MiB;
constexpr size_t OFF_ACT = OFF_BIG;
constexpr size_t OFF_HID = OFF_BIG;

struct Params {
  const float* x; const float* mem; const int* pos;
  const float* hyb_w_in; const float* dn_conv_w; const float* dn_a_log; const float* dn_dt_bias; const float* dn_norm_g; const float* hyb_w_out;
  const float* s5_a_re; const float* s5_a_im; const float* s5_log_dt; const float* s5_b_re; const float* s5_b_im; const float* s5_c_re; const float* s5_c_im;
  const float* s5_d; const float* s5_glu_wo; const float* s5_glu_wg;
  const float* ln_mix_g; const float* ln_mix_b;
  const float* xq_w; const float* xk_w; const float* xv_w; const float* xo_w; const float* ln_x_g; const float* ln_x_b;
  const float* ffn_wg; const float* ffn_wu; const float* ffn_wd; const float* ln_ffn_g; const float* ln_ffn_b;
  float* out; char* ws;
};

DI bf16_t f2bf(float x) { unsigned u = __float_as_uint(x); u += 0x7fffu + ((u >> 16) & 1u); return (bf16_t)(u >> 16); }
DI float bf2f(bf16_t v) { return __uint_as_float(((unsigned)v) << 16); }
DI unsigned pack2(float a, float b) { return (unsigned)f2bf(a) | ((unsigned)f2bf(b) << 16); }
DI float wave_sum(float v) { for (int o = 32; o > 0; o >>= 1) v += __shfl_xor(v, o); return v; }
DI float wave_max(float v) { for (int o = 32; o > 0; o >>= 1) v = fmaxf(v, __shfl_xor(v, o)); return v; }
DI float sigmoidf_(float x) { return 1.f / (1.f + __expf(-x)); }
DI float siluf_(float x) { return x * sigmoidf_(x); }
DI float softplusf_(float x) { return fmaxf(x, 0.f) + log1pf(__expf(-fabsf(x))); }
DI float gelu_tanh(float x) { float u = 0.7978845608028654f * (x + 0.044715f * x * x * x); return 0.5f * x * (1.f + tanhf(u)); }

template <class CM>
DI void transpose_job(bf16_t* dst, int Ndst, int K, int srcStride, CM colptr, float* tile) {
  const int ntk = K / 64, ntiles = (Ndst / 64) * ntk;
  for (int tl = blockIdx.x; tl < ntiles; tl += gridDim.x) {
    const int r0 = (tl / ntk) * 64, k0 = (tl % ntk) * 64;
    const int rl = threadIdx.x & 63, ks = threadIdx.x >> 6;
    const float* cp = colptr(r0 + rl);
    for (int i = 0; i < 16; ++i) { int kl = ks * 16 + i; tile[kl * 65 + rl] = cp ? cp[(size_t)(k0 + kl) * srcStride] : 0.f; }
    __syncthreads();
    const int kk = threadIdx.x & 63, rs = threadIdx.x >> 6;
    for (int i = 0; i < 16; ++i) { int rr = i * 4 + rs; dst[(size_t)(r0 + rr) * K + k0 + kk] = f2bf(tile[kk * 65 + rr]); }
    __syncthreads();
  }
}

DI void phase_prologue(const Params& p, float* smem) {
  bf16_t* W = (bf16_t*)(p.ws + OFF_W);
  for (int l = 0; l < 4; ++l) {
    bf16_t* wc = W + (size_t)l * SZ_COMMON;
    const float* s;
    s = p.xq_w + (size_t)l * SZ_SQ; transpose_job(wc, 1024, 1024, 1024, [=](int r) { return s + r; }, smem);
    s = p.xk_w + (size_t)l * SZ_SQ; transpose_job(wc + SZ_SQ, 1024, 1024, 1024, [=](int r) { return s + r; }, smem);
    s = p.xv_w + (size_t)l * SZ_SQ; transpose_job(wc + 2 * SZ_SQ, 1024, 1024, 1024, [=](int r) { return s + r; }, smem);
    s = p.xo_w + (size_t)l * SZ_SQ; transpose_job(wc + 3 * SZ_SQ, 1024, 1024, 1024, [=](int r) { return s + r; }, smem);
    {
      const float* g = p.ffn_wg + (size_t)l * 1024 * 2816; const float* u = p.ffn_wu + (size_t)l * 1024 * 2816;
      transpose_job(wc + 4 * SZ_SQ, 5632, 1024, 2816, [=](int r) { int c = (r >> 5) * 16 + (r & 15); return ((r >> 4) & 1) ? (u + c) : (g + c); }, smem);
    }
    s = p.ffn_wd + (size_t)l * 2816 * 1024; transpose_job(wc + 4 * SZ_SQ + SZ_GU, 1024, 2816, 1024, [=](int r) { return s + r; }, smem);
  }
  for (int i = 0; i < 2; ++i) {
    bf16_t* we = W + W_EVEN0 + (size_t)i * (SZ_WIN + SZ_SQ);
    const float* s = p.hyb_w_in + (size_t)i * 1024 * 3592;
    transpose_job(we, 3712, 1024, 3592, [=](int r) -> const float* {
      if (r < 2048) return s + r;
      if (r < 3584) return s + r + 8;
      if (r < 3592) return s + 2048 + (r - 3584);
      return nullptr; }, smem);
    const float* s2 = p.hyb_w_out + (size_t)i * SZ_SQ;
    transpose_job(we + SZ_WIN, 1024, 1024, 1024, [=](int r) { return s2 + r; }, smem);
    bf16_t* wo = W + W_ODD0 + (size_t)i * SZ_GLU;
    const float* a = p.s5_glu_wo + (size_t)i * SZ_SQ; const float* b = p.s5_glu_wg + (size_t)i * SZ_SQ;
    transpose_job(wo, 2048, 1024, 1024, [=](int r) { int c = (r >> 5) * 16 + (r & 15); return ((r >> 4) & 1) ? (b + c) : (a + c); }, smem);
  }
  const size_t gtid = (size_t)blockIdx.x * 256 + threadIdx.x, gsz = (size_t)gridDim.x * 256;
  bf16_t* hb = (bf16_t*)(p.ws + OFF_HB);
  for (size_t i = gtid; i < (size_t)T_ * 256; i += gsz) {
    float4 v = ((const float4*)p.x)[i];
    ((float4*)p.out)[i] = v;
    uint2 o; o.x = pack2(v.x, v.y); o.y = pack2(v.z, v.w);
    ((uint2*)hb)[i] = o;
  }
  bf16_t* memb = (bf16_t*)(p.ws + OFF_MEMB);
  for (size_t i = gtid; i < (size_t)2048 * 256; i += gsz) {
    float4 v = ((const float4*)p.mem)[i];
    uint2 o; o.x = pack2(v.x, v.y); o.y = pack2(v.z, v.w);
    ((uint2*)memb)[i] = o;
  }
  float* rc = (float*)(p.ws + OFF_ROPE); float* rs = rc + (size_t)T_ * 32;
  for (size_t i = gtid; i < (size_t)T_ * 32; i += gsz) {
    int t = (int)(i >> 5), j = (int)(i & 31);
    float invf = (float)exp(-(double)(2 * j) / 64.0 * 9.210340371976184);
    float ang = (float)p.pos[t] * invf;
    double a = (double)ang;
    double k = rint(a * 0.15915494309189535);
    float r = (float)(a - k * 6.283185307179586);
    rc[i] = cosf(r); rs[i] = sinf(r);
  }
}

constexpr int LDT = 72;
template <class AL, class BL, class EP>
DI void gemm_tile(int m0, int n0, int nks, AL aload, BL bload, EP epi, bf16_t* smem) {
  bf16_t* As = smem; bf16_t* Bs = smem + 2 * 128 * LDT;
  const int tid = threadIdx.x, lane = tid & 63, wave = tid >> 6;
  const int wm = wave >> 1, wn = wave & 1, l15 = lane & 15, quad = lane >> 4;
  const int lrow = tid >> 3, lkc = (tid & 7) * 8;
  f32x4 acc[4][4];
#pragma unroll
  for (int i = 0; i < 4; ++i)
#pragma unroll
    for (int j = 0; j < 4; ++j) acc[i][j] = f32x4{0.f, 0.f, 0.f, 0.f};
  uint4 ra[4], rb[4];
#pragma unroll
  for (int i = 0; i < 4; ++i) { ra[i] = aload(m0 + lrow + 32 * i, 0, lkc); rb[i] = bload(n0 + lrow + 32 * i, 0, lkc); }
#pragma unroll
  for (int i = 0; i < 4; ++i) {
    *(uint4*)(As + (lrow + 32 * i) * LDT + lkc) = ra[i];
    *(uint4*)(Bs + (lrow + 32 * i) * LDT + lkc) = rb[i];
  }
  __syncthreads();
  for (int ks = 0; ks < nks; ++ks) {
    const int cur = ks & 1;
    const bool more = (ks + 1 < nks);
    if (more) {
#pragma unroll
      for (int i = 0; i < 4; ++i) { ra[i] = aload(m0 + lrow + 32 * i, ks + 1, lkc); rb[i] = bload(n0 + lrow + 32 * i, ks + 1, lkc); }
    }
    const bf16_t* Ab = As + cur * 128 * LDT; const bf16_t* Bb = Bs + cur * 128 * LDT;
#pragma unroll
    for (int kk = 0; kk < 2; ++kk) {
      bf16x8 a[4], b[4];
#pragma unroll
      for (int mt = 0; mt < 4; ++mt) a[mt] = *(const bf16x8*)(Ab + (wm * 64 + mt * 16 + l15) * LDT + kk * 32 + quad * 8);
#pragma unroll
      for (int nt = 0; nt < 4; ++nt) b[nt] = *(const bf16x8*)(Bb + (wn * 64 + nt * 16 + l15) * LDT + kk * 32 + quad * 8);
#pragma unroll
      for (int mt = 0; mt < 4; ++mt)
#pragma unroll
        for (int nt = 0; nt < 4; ++nt) acc[mt][nt] = __builtin_amdgcn_mfma_f32_16x16x32_bf16(a[mt], b[nt], acc[mt][nt], 0, 0, 0);
    }
    if (more) {
      bf16_t* An = As + (cur ^ 1) * 128 * LDT; bf16_t* Bn = Bs + (cur ^ 1) * 128 * LDT;
#pragma unroll
      for (int i = 0; i < 4; ++i) {
        *(uint4*)(An + (lrow + 32 * i) * LDT + lkc) = ra[i];
        *(uint4*)(Bn + (lrow + 32 * i) * LDT + lkc) = rb[i];
      }
    }
    __syncthreads();
  }
  epi(acc, m0 + wm * 64, n0 + wn * 64);
}

template <class F>
DI void for_tiles(int mtiles, int ntiles, F f) {
  const int xcd = blockIdx.x & 7, slot = blockIdx.x >> 3, nslot = gridDim.x >> 3;
  const int per = (mtiles >> 3) * ntiles;
  for (int w = slot; w < per; w += nslot) {
    int mi = w / ntiles, ni = w - mi * ntiles;
    f((mi * 8 + xcd), ni);
  }
}

#define EPI_LOOP for (int mt = 0; mt < 4; ++mt) for (int nt = 0; nt < 4; ++nt) for (int r = 0; r < 4; ++r)

DI void epi_resid(const Params& p, f32x4 (&acc)[4][4], int rb, int cb) {
  const int lane = threadIdx.x & 63, l15 = lane & 15, quad = lane >> 4;
#pragma unroll
  for (int mt = 0; mt < 4; ++mt)
#pragma unroll
    for (int nt = 0; nt < 4; ++nt)
#pragma unroll
      for (int r = 0; r < 4; ++r) {
        size_t idx = (size_t)(rb + mt * 16 + quad * 4 + r) * 1024 + cb + nt * 16 + l15;
        p.out[idx] = ALPHA * p.out[idx] + acc[mt][nt][r];
      }
}
DI void epi_bf16(bf16_t* dst, int ld, f32x4 (&acc)[4][4], int rb, int cb) {
  const int lane = threadIdx.x & 63, l15 = lane & 15, quad = lane >> 4;
#pragma unroll
  for (int mt = 0; mt < 4; ++mt)
#pragma unroll
    for (int nt = 0; nt < 4; ++nt)
#pragma unroll
      for (int r = 0; r < 4; ++r)
        dst[(size_t)(rb + mt * 16 + quad * 4 + r) * ld + cb + nt * 16 + l15] = f2bf(acc[mt][nt][r]);
}

struct PlainLoad {
  const bf16_t* base; int ld;
  DI uint4 operator()(int row, int ks, int kc) const { return *(const uint4*)(base + (size_t)row * ld + ks * 64 + kc); }
};

DI void phase_proj(const Params& p, int i, bf16_t* smem) {
  const bf16_t* W = (const bf16_t*)(p.ws + OFF_W) + W_EVEN0 + (size_t)i * (SZ_WIN + SZ_SQ);
  PlainLoad al{(const bf16_t*)(p.ws + OFF_HB), 1024}, bl{W, 1024};
  bf16_t* dnqkv = (bf16_t*)(p.ws + OFF_DNQKV); bf16_t* z = (bf16_t*)(p.ws + OFF_Z);
  bf16_t* swq = (bf16_t*)(p.ws + OFF_SWQ); bf16_t* swk = (bf16_t*)(p.ws + OFF_SWK); bf16_t* swv = (bf16_t*)(p.ws + OFF_SWV);
  float* logit = (float*)(p.ws + OFF_LOGIT);
  const float* rc = (const float*)(p.ws + OFF_ROPE); const float* rs = rc + (size_t)T_ * 32;
  for_tiles(256, 29, [&](int mi, int ni) {
    gemm_tile(mi * 128, ni * 128, 16, al, bl, [&](f32x4 (&acc)[4][4], int rb, int cb) {
      const int lane = threadIdx.x & 63, l15 = lane & 15, quad = lane >> 4;
      if (cb < 1536) epi_bf16(dnqkv, 1536, acc, rb, cb);
      else if (cb < 2048) epi_bf16(z, 512, acc, rb, cb - 1536);
      else if (cb < 3072) {
        bf16_t* dst = (cb < 2560) ? swq : swk; const int c0 = (cb < 2560) ? cb - 2048 : cb - 2560;
#pragma unroll
        for (int mt = 0; mt < 4; ++mt)
#pragma unroll
          for (int r = 0; r < 4; ++r) {
            const int row = rb + mt * 16 + quad * 4 + r;
#pragma unroll
            for (int nt = 0; nt < 2; ++nt) {
              const int d = nt * 16 + l15;
              float c = rc[(size_t)row * 32 + d], s = rs[(size_t)row * 32 + d];
              float x1 = acc[mt][nt][r], x2 = acc[mt][nt + 2][r];
              dst[(size_t)row * 512 + c0 + d] = f2bf(x1 * c - x2 * s);
              dst[(size_t)row * 512 + c0 + d + 32] = f2bf(x2 * c + x1 * s);
            }
          }
      } else if (cb < 3584) epi_bf16(swv, 512, acc, rb, cb - 3072);
      else if (cb == 3584) {
#pragma unroll
        for (int mt = 0; mt < 4; ++mt)
#pragma unroll
          for (int r = 0; r < 4; ++r)
            if (l15 < 8) logit[(size_t)(rb + mt * 16 + quad * 4 + r) * 8 + l15] = acc[mt][0][r];
      }
    }, smem);
  });
}

DI void phase_dn_prep(const Params& p, int i) {
  const bf16_t* dnqkv = (const bf16_t*)(p.ws + OFF_DNQKV);
  bf16_t* out_q = (bf16_t*)(p.ws + OFF_QN); bf16_t* out_k = (bf16_t*)(p.ws + OFF_KN); bf16_t* out_v = (bf16_t*)(p.ws + OFF_VN);
  const float* cw = p.dn_conv_w + (size_t)i * 4 * 1536;
  const int wave = threadIdx.x >> 6, lane = threadIdx.x & 63;
  const int N = T_ * 12;
  for (int base = blockIdx.x * 4; base < N; base += gridDim.x * 4) {
    const int item = base + wave;
    const int t = item / 12, rem = item - t * 12, which = rem >> 2, h = rem & 3;
    const int s = t & (S_ - 1);
    const int col = which * 512 + h * 128 + lane * 2;
    float y0 = 0.f, y1 = 0.f;
#pragma unroll
    for (int j = 0; j < 4; ++j) {
      if (s - 3 + j >= 0) {
        unsigned v = *(const unsigned*)(dnqkv + (size_t)(t - 3 + j) * 1536 + col);
        y0 += cw[j * 1536 + col] * bf2f((bf16_t)(v & 0xffff));
        y1 += cw[j * 1536 + col + 1] * bf2f((bf16_t)(v >> 16));
      }
    }
    y0 = siluf_(y0); y1 = siluf_(y1);
    if (which < 2) {
      float ss = wave_sum(y0 * y0 + y1 * y1);
      float sc = rsqrtf(ss + 1e-6f);
      y0 *= sc; y1 *= sc;
    }
    bf16_t* o = (which == 0) ? out_q : (which == 1 ? out_k : out_v);
    *(unsigned*)(o + (size_t)t * 512 + h * 128 + lane * 2) = pack2(y0, y1);
  }
}

DI void dn_chain_item(const Params& p, int i, int item, float* smem) {
  const int b = item >> 2, h = item & 3, tid = threadIdx.x;
  const bf16_t* qn = (const bf16_t*)(p.ws + OFF_QN); const bf16_t* kn = (const bf16_t*)(p.ws + OFF_KN); const bf16_t* vn = (const bf16_t*)(p.ws + OFF_VN);
  const float* logit = (const float*)(p.ws + OFF_LOGIT);
  bf16_t* odn = (bf16_t*)(p.ws + OFF_ODN);
  float* qs = smem; float* ks = smem + 2048; float* vs = smem + 4096; float* as = smem + 6144; float* bs = as + 16;
  const float A = __expf(p.dn_a_log[i * 4 + h]), dtb = p.dn_dt_bias[i * 4 + h];
  float S[128];
#pragma unroll
  for (int d = 0; d < 128; ++d) S[d] = 0.f;
  for (int t0 = 0; t0 < S_; t0 += 16) {
    {
      const int tt = tid >> 4, c8 = (tid & 15) * 8;
      const size_t g = (size_t)(b * S_ + t0 + tt) * 512 + h * 128 + c8;
      uint4 a = *(const uint4*)(qn + g), k = *(const uint4*)(kn + g), v = *(const uint4*)(vn + g);
      const unsigned* pa = (const unsigned*)&a; const unsigned* pk = (const unsigned*)&k; const unsigned* pv = (const unsigned*)&v;
#pragma unroll
      for (int j = 0; j < 4; ++j) {
        qs[tt * 128 + c8 + 2 * j] = bf2f((bf16_t)(pa[j] & 0xffff)); qs[tt * 128 + c8 + 2 * j + 1] = bf2f((bf16_t)(pa[j] >> 16));
        ks[tt * 128 + c8 + 2 * j] = bf2f((bf16_t)(pk[j] & 0xffff)); ks[tt * 128 + c8 + 2 * j + 1] = bf2f((bf16_t)(pk[j] >> 16));
        vs[tt * 128 + c8 + 2 * j] = bf2f((bf16_t)(pv[j] & 0xffff)); vs[tt * 128 + c8 + 2 * j + 1] = bf2f((bf16_t)(pv[j] >> 16));
      }
      if (tid < 16) {
        const size_t row = (size_t)(b * S_ + t0 + tid);
        float bl = logit[row * 8 + h], al = logit[row * 8 + 4 + h];
        bs[tid] = sigmoidf_(bl);
        as[tid] = __expf(-A * softplusf_(al + dtb));
      }
    }
    __syncthreads();
    if (tid < 128) {
      for (int tt = 0; tt < 16; ++tt) {
        const float a = as[tt], bt = bs[tt];
        float r = 0.f;
#pragma unroll
        for (int d = 0; d < 128; d += 4) {
          float4 k4 = *(const float4*)(ks + tt * 128 + d);
          r += k4.x * S[d] + k4.y * S[d + 1] + k4.z * S[d + 2] + k4.w * S[d + 3];
        }
        const float delta = bt * (vs[tt * 128 + tid] - a * r);
        float o = 0.f;
#pragma unroll
        for (int d = 0; d < 128; d += 4) {
          float4 k4 = *(const float4*)(ks + tt * 128 + d);
          float4 q4 = *(const float4*)(qs + tt * 128 + d);
          S[d] = a * S[d] + k4.x * delta; o += q4.x * S[d];
          S[d + 1] = a * S[d + 1] + k4.y * delta; o += q4.y * S[d + 1];
          S[d + 2] = a * S[d + 2] + k4.z * delta; o += q4.z * S[d + 2];
          S[d + 3] = a * S[d + 3] + k4.w * delta; o += q4.w * S[d + 3];
        }
        odn[(size_t)(b * S_ + t0 + tt) * 512 + h * 128 + tid] = f2bf(o * 0.08838834764831845f);
      }
    }
    __syncthreads();
  }
}

DI void dil_attn_wave(const Params& p, int item) {
  const int lane = threadIdx.x & 63;
  const int t = item >> 3, h = item & 7, s = t & (S_ - 1);
  bf16_t* swq = (bf16_t*)(p.ws + OFF_SWQ); const bf16_t* swk = (const bf16_t*)(p.ws + OFF_SWK); const bf16_t* swv = (const bf16_t*)(p.ws + OFF_SWV);
  const float q = bf2f(swq[(size_t)t * 512 + h * 64 + lane]) * 0.125f;
  float m = -1e30f, l = 0.f, acc = 0.f;
#pragma unroll
  for (int br = 0; br < 3; ++br) {
    const int r = (br == 0) ? 1 : (br == 1 ? 4 : 16);
    for (int j = 0; j <= 128; ++j) {
      const int sk = s - j * r;
      if (sk < 0) break;
      const size_t g = (size_t)(t - j * r) * 512 + h * 64 + lane;
      float sc = wave_sum(q * bf2f(swk[g]));
      float mn = fmaxf(m, sc);
      float corr = __expf(m - mn), pj = __expf(sc - mn);
      l = l * corr + pj;
      acc = acc * corr + pj * bf2f(swv[g]);
      m = mn;
    }
  }
  swq[(size_t)t * 512 + h * 64 + lane] = f2bf(acc / l);
}

DI void phase_mix(const Params& p, int i, float* smem) {
  for (int item = blockIdx.x; item < 32; item += gridDim.x) dn_chain_item(p, i, item, smem);
  const int wave = threadIdx.x >> 6;
  const int N = T_ * 8;
  for (int base = blockIdx.x * 4; base < N; base += gridDim.x * 4) dil_attn_wave(p, base + wave);
}

DI void phase_dn_post(const Params& p, int i) {
  const bf16_t* odn = (const bf16_t*)(p.ws + OFF_ODN);
  bf16_t* z = (bf16_t*)(p.ws + OFF_Z);
  const float* ng = p.dn_norm_g + i * 128;
  const int wave = threadIdx.x >> 6, lane = threadIdx.x & 63;
  const int N = T_ * 4;
  for (int base = blockIdx.x * 4; base < N; base += gridDim.x * 4) {
    const int item = base + wave;
    const size_t g = (size_t)item * 128 + lane * 2;
    unsigned ov = *(const unsigned*)(odn + g), zv = *(const unsigned*)(z + g);
    float o0 = bf2f((bf16_t)(ov & 0xffff)), o1 = bf2f((bf16_t)(ov >> 16));
    float z0 = bf2f((bf16_t)(zv & 0xffff)), z1 = bf2f((bf16_t)(zv >> 16));
    float ms = wave_sum(o0 * o0 + o1 * o1) * (1.f / 128.f);
    float rr = rsqrtf(ms + 1e-6f);
    float r0 = o0 * rr * ng[lane * 2] * siluf_(z0), r1 = o1 * rr * ng[lane * 2 + 1] * siluf_(z1);
    *(unsigned*)(z + g) = pack2(r0, r1);
  }
}

struct MixLoad {
  const bf16_t* a; const bf16_t* b;
  DI uint4 operator()(int row, int ks, int kc) const {
    return (ks < 8) ? *(const uint4*)(a + (size_t)row * 512 + ks * 64 + kc) : *(const uint4*)(b + (size_t)row * 512 + (ks - 8) * 64 + kc);
  }
};

DI void phase_wout(const Params& p, int i, bf16_t* smem) {
  const bf16_t* W = (const bf16_t*)(p.ws + OFF_W) + W_EVEN0 + (size_t)i * (SZ_WIN + SZ_SQ) + SZ_WIN;
  MixLoad al{(const bf16_t*)(p.ws + OFF_Z), (const bf16_t*)(p.ws + OFF_SWQ)};
  PlainLoad bl{W, 1024};
  for_tiles(256, 8, [&](int mi, int ni) {
    gemm_tile(mi * 128, ni * 128, 16, al, bl, [&](f32x4 (&acc)[4][4], int rb, int cb) { epi_resid(p, acc, rb, cb); }, smem);
  });
}

DI void phase_ln(const Params& p, const float* g, const float* b) {
  const int wave = threadIdx.x >> 6, lane = threadIdx.x & 63;
  bf16_t* hb = (bf16_t*)(p.ws + OFF_HB);
  for (int row = blockIdx.x * 4 + wave; row < T_; row += gridDim.x * 4) {
    float4* y = (float4*)(p.out + (size_t)row * 1024);
    float4 v[4];
    float s = 0.f;
#pragma unroll
    for (int i = 0; i < 4; ++i) { v[i] = y[lane + 64 * i]; s += v[i].x + v[i].y + v[i].z + v[i].w; }
    const float mu = wave_sum(s) * (1.f / 1024.f);
    float q = 0.f;
#pragma unroll
    for (int i = 0; i < 4; ++i) { float a = v[i].x - mu, b2 = v[i].y - mu, c = v[i].z - mu, d = v[i].w - mu; q += a * a + b2 * b2 + c * c + d * d; }
    const float rstd = rsqrtf(wave_sum(q) * (1.f / 1024.f) + 1e-5f);
#pragma unroll
    for (int i = 0; i < 4; ++i) {
      float4 gg = ((const float4*)g)[lane + 64 * i], bb = ((const float4*)b)[lane + 64 * i];
      float4 o;
      o.x = (v[i].x - mu) * rstd * gg.x + bb.x; o.y = (v[i].y - mu) * rstd * gg.y + bb.y;
      o.z = (v[i].z - mu) * rstd * gg.z + bb.z; o.w = (v[i].w - mu) * rstd * gg.w + bb.w;
      y[lane + 64 * i] = o;
      uint2 ob; ob.x = pack2(o.x, o.y); ob.y = pack2(o.z, o.w);
      ((uint2*)(hb + (size_t)row * 1024))[lane + 64 * i] = ob;
    }
  }
}

DI void phase_s5_naive(const Params& p, int i) {
  const int wave = threadIdx.x >> 6, lane = threadIdx.x & 63;
  bf16_t* hid = (bf16_t*)(p.ws + OFF_HID);
  for (int base = blockIdx.x * 4; base < 512; base += gridDim.x * 4) {
    const int item = base + wave, b = item >> 6, g = item & 63;
    const int gp = (i * 64 + g) * 64 + lane;
    const double dt = exp((double)p.s5_log_dt[i * 64 + g]);
    const double are = p.s5_a_re[gp], aim = p.s5_a_im[gp];
    const double lr = are * dt, li = aim * dt;
    const double kk = rint(li * 0.15915494309189535);
    const double red = li - kk * 6.283185307179586;
    const double e = exp(lr);
    const double abr = e * cos(red), abi = e * sin(red);
    const double den = are * are + aim * aim;
    const double nr = abr - 1.0, ni = abi;
    const double cfr = (nr * are + ni * aim) / den, cfi = (ni * are - nr * aim) / den;
    float bbr[16], bbi[16], cr[16], ci[16];
#pragma unroll
    for (int h = 0; h < 16; ++h) {
      const double br = p.s5_b_re[(size_t)gp * 16 + h], bi = p.s5_b_im[(size_t)gp * 16 + h];
      bbr[h] = (float)(cfr * br - cfi * bi); bbi[h] = (float)(cfr * bi + cfi * br);
      cr[h] = p.s5_c_re[((size_t)(i * 64 + g) * 16 + h) * 64 + lane];
      ci[h] = p.s5_c_im[((size_t)(i * 64 + g) * 16 + h) * 64 + lane];
    }
    const float ar = (float)abr, ai = (float)abi;
    const float dsk = p.s5_d[i * 1024 + g * 16 + (lane & 15)];
    float sr = 0.f, si = 0.f;
#pragma unroll 1
    for (int t = 0; t < S_; ++t) {
      const size_t row = (size_t)(b * S_ + t);
      const float4* up = (const float4*)(p.out + row * 1024 + g * 16);
      float u[16];
#pragma unroll
      for (int j = 0; j < 4; ++j) { float4 v = up[j]; u[4 * j] = v.x; u[4 * j + 1] = v.y; u[4 * j + 2] = v.z; u[4 * j + 3] = v.w; }
      float bur = 0.f, bui = 0.f;
#pragma unroll
      for (int h = 0; h < 16; ++h) { bur += bbr[h] * u[h]; bui += bbi[h] * u[h]; }
      const float nsr = ar * sr - ai * si + bur, nsi = ar * si + ai * sr + bui;
      sr = nsr; si = nsi;
      float yk = 0.f, uk = 0.f;
#pragma unroll
      for (int h = 0; h < 16; ++h) {
        float v = wave_sum(cr[h] * sr - ci[h] * si);
        if (lane == h) { yk = v; uk = u[h]; }
      }
      if (lane < 16) hid[row * 1024 + g * 16 + lane] = f2bf(gelu_tanh(yk + dsk * uk));
    }
  }
}

DI void phase_glu(const Params& p, int i, bf16_t* smem) {
  const bf16_t* W = (const bf16_t*)(p.ws + OFF_W) + W_ODD0 + (size_t)i * SZ_GLU;
  PlainLoad al{(const bf16_t*)(p.ws + OFF_HID), 1024}, bl{W, 1024};
  for_tiles(256, 16, [&](int mi, int ni) {
    gemm_tile(mi * 128, ni * 128, 16, al, bl, [&](f32x4 (&acc)[4][4], int rb, int cb) {
      const int lane = threadIdx.x & 63, l15 = lane & 15, quad = lane >> 4;
#pragma unroll
      for (int mt = 0; mt < 4; ++mt)
#pragma unroll
        for (int np = 0; np < 2; ++np)
#pragma unroll
          for (int r = 0; r < 4; ++r) {
            float val = acc[mt][2 * np][r] * sigmoidf_(acc[mt][2 * np + 1][r]);
            size_t idx = (size_t)(rb + mt * 16 + quad * 4 + r) * 1024 + (cb >> 1) + np * 16 + l15;
            p.out[idx] = ALPHA * p.out[idx] + val;
          }
    }, smem);
  });
}

DI void phase_xproj(const Params& p, int l, bf16_t* smem) {
  const bf16_t* wc = (const bf16_t*)(p.ws + OFF_W) + (size_t)l * SZ_COMMON;
  {
    PlainLoad al{(const bf16_t*)(p.ws + OFF_HB), 1024}, bl{wc, 1024};
    bf16_t* q = (bf16_t*)(p.ws + OFF_XQ);
    for_tiles(256, 8, [&](int mi, int ni) {
      gemm_tile(mi * 128, ni * 128, 16, al, bl, [&](f32x4 (&acc)[4][4], int rb, int cb) { epi_bf16(q, 1024, acc, rb, cb); }, smem);
    });
  }
  {
    PlainLoad al{(const bf16_t*)(p.ws + OFF_MEMB), 1024};
    bf16_t* kx = (bf16_t*)(p.ws + OFF_KX); bf16_t* vx = (bf16_t*)(p.ws + OFF_VX);
    for_tiles(16, 16, [&](int mi, int ni) {
      const bool isv = ni >= 8;
      PlainLoad bl{isv ? (wc + 2 * SZ_SQ) : (wc + SZ_SQ), 1024};
      bf16_t* dst = isv ? vx : kx;
      gemm_tile(mi * 128, (ni & 7) * 128, 16, al, bl, [&](f32x4 (&acc)[4][4], int rb, int cb) { epi_bf16(dst, 1024, acc, rb, cb); }, smem);
    });
  }
}

DI void phase_xattn_naive(const Params& p, float* smem) {
  const int wave = threadIdx.x >> 6, lane = threadIdx.x & 63;
  const bf16_t* q = (const bf16_t*)(p.ws + OFF_XQ); const bf16_t* kx = (const bf16_t*)(p.ws + OFF_KX); const bf16_t* vx = (const bf16_t*)(p.ws + OFF_VX);
  bf16_t* xo = (bf16_t*)(p.ws + OFF_XO);
  float* qs = smem + wave * 256;
  const int N = T_ * 4;
  for (int base = blockIdx.x * 4; base < N; base += gridDim.x * 4) {
    const int item = base + wave, t = item >> 2, h = item & 3, b = t >> 12;
    {
      uint2 v = *(const uint2*)(q + (size_t)t * 1024 + h * 256 + lane * 4);
      qs[lane * 4] = bf2f((bf16_t)(v.x & 0xffff)); qs[lane * 4 + 1] = bf2f((bf16_t)(v.x >> 16));
      qs[lane * 4 + 2] = bf2f((bf16_t)(v.y & 0xffff)); qs[lane * 4 + 3] = bf2f((bf16_t)(v.y >> 16));
    }
    __syncthreads();
    float sc[4];
#pragma unroll
    for (int kk = 0; kk < 4; ++kk) {
      const bf16_t* kp = kx + (size_t)(b * 256 + kk * 64 + lane) * 1024 + h * 256;
      float d = 0.f;
#pragma unroll 4
      for (int c = 0; c < 32; ++c) {
        uint4 kv = *(const uint4*)(kp + c * 8);
        const unsigned* pk = (const unsigned*)&kv;
        float4 q0 = *(const float4*)(qs + c * 8), q1 = *(const float4*)(qs + c * 8 + 4);
        d += q0.x * bf2f((bf16_t)(pk[0] & 0xffff)) + q0.y * bf2f((bf16_t)(pk[0] >> 16)) + q0.z * bf2f((bf16_t)(pk[1] & 0xffff)) + q0.w * bf2f((bf16_t)(pk[1] >> 16));
        d += q1.x * bf2f((bf16_t)(pk[2] & 0xffff)) + q1.y * bf2f((bf16_t)(pk[2] >> 16)) + q1.z * bf2f((bf16_t)(pk[3] & 0xffff)) + q1.w * bf2f((bf16_t)(pk[3] >> 16));
      }
      sc[kk] = d * 0.0625f;
    }
    float m = wave_max(fmaxf(fmaxf(sc[0], sc[1]), fmaxf(sc[2], sc[3])));
    float pr[4], ls = 0.f;
#pragma unroll
    for (int kk = 0; kk < 4; ++kk) { pr[kk] = __expf(sc[kk] - m); ls += pr[kk]; }
    const float l = wave_sum(ls);
    float a0 = 0.f, a1 = 0.f, a2 = 0.f, a3 = 0.f;
#pragma unroll
    for (int kk = 0; kk < 4; ++kk) {
#pragma unroll 4
      for (int src = 0; src < 64; ++src) {
        float pk = __shfl(pr[kk], src);
        uint2 v = *(const uint2*)(vx + (size_t)(b * 256 + kk * 64 + src) * 1024 + h * 256 + lane * 4);
        a0 += pk * bf2f((bf16_t)(v.x & 0xffff)); a1 += pk * bf2f((bf16_t)(v.x >> 16));
        a2 += pk * bf2f((bf16_t)(v.y & 0xffff)); a3 += pk * bf2f((bf16_t)(v.y >> 16));
      }
    }
    const float il = 1.f / l;
    uint2 o; o.x = pack2(a0 * il, a1 * il); o.y = pack2(a2 * il, a3 * il);
    *(uint2*)(xo + (size_t)t * 1024 + h * 256 + lane * 4) = o;
    __syncthreads();
  }
}

DI void phase_xo(const Params& p, int l, bf16_t* smem) {
  const bf16_t* wc = (const bf16_t*)(p.ws + OFF_W) + (size_t)l * SZ_COMMON + 3 * SZ_SQ;
  PlainLoad al{(const bf16_t*)(p.ws + OFF_XO), 1024}, bl{wc, 1024};
  for_tiles(256, 8, [&](int mi, int ni) {
    gemm_tile(mi * 128, ni * 128, 16, al, bl, [&](f32x4 (&acc)[4][4], int rb, int cb) { epi_resid(p, acc, rb, cb); }, smem);
  });
}

DI void phase_ffn_gu(const Params& p, int l, bf16_t* smem) {
  const bf16_t* W = (const bf16_t*)(p.ws + OFF_W) + (size_t)l * SZ_COMMON + 4 * SZ_SQ;
  PlainLoad al{(const bf16_t*)(p.ws + OFF_HB), 1024}, bl{W, 1024};
  bf16_t* act = (bf16_t*)(p.ws + OFF_ACT);
  for_tiles(256, 44, [&](int mi, int ni) {
    gemm_tile(mi * 128, ni * 128, 16, al, bl, [&](f32x4 (&acc)[4][4], int rb, int cb) {
      const int lane = threadIdx.x & 63, l15 = lane & 15, quad = lane >> 4;
#pragma unroll
      for (int mt = 0; mt < 4; ++mt)
#pragma unroll
        for (int np = 0; np < 2; ++np)
#pragma unroll
          for (int r = 0; r < 4; ++r) {
            float val = siluf_(acc[mt][2 * np][r]) * acc[mt][2 * np + 1][r];
            act[(size_t)(rb + mt * 16 + quad * 4 + r) * 2816 + (cb >> 1) + np * 16 + l15] = f2bf(val);
          }
    }, smem);
  });
}
DI void phase_ffn_down(const Params& p, int l, bf16_t* smem) {
  const bf16_t* W = (const bf16_t*)(p.ws + OFF_W) + (size_t)l * SZ_COMMON + 4 * SZ_SQ + SZ_GU;
  PlainLoad al{(const bf16_t*)(p.ws + OFF_ACT), 2816}, bl{W, 2816};
  for_tiles(256, 8, [&](int mi, int ni) {
    gemm_tile(mi * 128, ni * 128, 44, al, bl, [&](f32x4 (&acc)[4][4], int rb, int cb) { epi_resid(p, acc, rb, cb); }, smem);
  });
}

__global__ void __launch_bounds__(256, 1) fwd_megakernel(Params p) {
  cg::grid_group grid = cg::this_grid();
  __shared__ __attribute__((aligned(16))) char smem_raw[2 * 2 * 128 * LDT * 2];
  bf16_t* sm16 = (bf16_t*)smem_raw; float* sm32 = (float*)smem_raw;

  phase_prologue(p, sm32);
  grid.sync();
  for (int l = 0; l < 4; ++l) {
    const int i = l >> 1;
    if ((l & 1) == 0) {
      phase_proj(p, i, sm16); grid.sync();
      phase_dn_prep(p, i); grid.sync();
      phase_mix(p, i, sm32); grid.sync();
      phase_dn_post(p, i); grid.sync();
      phase_wout(p, i, sm16); grid.sync();
    } else {
      phase_s5_naive(p, i); grid.sync();
      phase_glu(p, i, sm16); grid.sync();
    }
    phase_ln(p, p.ln_mix_g + l * 1024, p.ln_mix_b + l * 1024); grid.sync();
    phase_xproj(p, l, sm16); grid.sync();
    phase_xattn_naive(p, sm32); grid.sync();
    phase_xo(p, l, sm16); grid.sync();
    phase_ln(p, p.ln_x_g + l * 1024, p.ln_x_b + l * 1024); grid.sync();
    phase_ffn_gu(p, l, sm16); grid.sync();
    phase_ffn_down(p, l, sm16); grid.sync();
    phase_ln(p, p.ln_ffn_g + l * 1024, p.ln_ffn_b + l * 1024); grid.sync();
  }
}

extern "C" void kernel_launch(void* const* d_in, const int* in_sizes, int n_in, void* d_out, int out_size, void* d_ws, size_t ws_size,
                              hipStream_t stream) {
  static int grid_blocks = 0;
  if (!grid_blocks) {
    int dev = 0, cus = 0, per_cu = 0;
    hipGetDevice(&dev);
    hipDeviceGetAttribute(&cus, hipDeviceAttributeMultiprocessorCount, dev);
    hipOccupancyMaxActiveBlocksPerMultiprocessor(&per_cu, fwd_megakernel, 256, 0);
    if (per_cu > 2) per_cu = 2;
    if (per_cu < 1) per_cu = 1;
    grid_blocks = cus * per_cu;
    grid_blocks -= grid_blocks % 8;
  }
  Params p{};
  const float** pf = (const float**)&p;
  for (int i = 0; i < 32; ++i) pf[i] = (const float*)d_in[i];
  p.pos = (const int*)d_in[2];
  p.out = (float*)d_out; p.ws = (char*)d_ws;
  void* args[] = {&p};
  hipError_t e = hipLaunchCooperativeKernel((void*)fwd_megakernel, dim3(grid_blocks), dim3(256), args, 0, stream);
  if (e != hipSuccess) fprintf(stderr, "cooperative launch failed: %s (grid %d)\n", hipGetErrorString(e), grid_blocks);
}
```

```cpp
#include <hip/hip_runtime.h>
#include <hip/hip_cooperative_groups.h>
#include <cstdio>
namespace cg = cooperative_groups;
#ifndef USE_XATTN_MFMA
#define USE_XATTN_MFMA 1
#endif
#ifndef USE_DIL_MFMA
#define USE_DIL_MFMA 1
#endif

typedef unsigned short bf16_t;
using bf16x8 = __attribute__((ext_vector_type(8))) short;
using f32x4 = __attribute__((ext_vector_type(4))) float;
#define DI __device__ __forceinline__

constexpr int T_ = 32768, S_ = 4096;
constexpr size_t MiB = (size_t)1 << 20;
constexpr size_t SZ_SQ = (size_t)1024 * 1024, SZ_WIN = (size_t)3712 * 1024, SZ_GLU = (size_t)2048 * 1024,
                 SZ_GU = (size_t)5632 * 1024, SZ_WD = (size_t)1024 * 2816;
constexpr size_t SZ_COMMON = 4 * SZ_SQ + SZ_GU + SZ_WD;
constexpr size_t W_EVEN0 = 4 * SZ_COMMON;
constexpr size_t W_ODD0 = W_EVEN0 + 2 * (SZ_WIN + SZ_SQ);
constexpr float ALPHA = 1.681792830507429f;

constexpr size_t OFF_W = 0;
constexpr size_t OFF_HB = 126 * MiB;
constexpr size_t OFF_MEMB = 190 * MiB;
constexpr size_t OFF_ROPE = 194 * MiB;
constexpr size_t OFF_KX = 202 * MiB;
constexpr size_t OFF_VX = 206 * MiB;
constexpr size_t OFF_BIG = 210 * MiB;
constexpr size_t OFF_DNQKV = OFF_BIG;
constexpr size_t OFF_Z = OFF_BIG + 96 * MiB;
constexpr size_t OFF_SWQ = OFF_BIG + 128 * MiB;
constexpr size_t OFF_SWK = OFF_BIG + 160 * MiB;
constexpr size_t OFF_SWV = OFF_BIG + 192 * MiB;
constexpr size_t OFF_LOGIT = OFF_BIG + 224 * MiB;
constexpr size_t OFF_VN = OFF_BIG + 226 * MiB;
constexpr size_t OFF_ODN = OFF_BIG + 258 * MiB;
constexpr size_t OFF_QN = OFF_HB;
constexpr size_t OFF_KN = OFF_HB + 32 * MiB;
constexpr size_t OFF_XQ = OFF_BIG;
constexpr size_t OFF_XO = OFF_BIG + 64 * MiB;
constexpr size_t OFF_ACT = OFF_BIG;
constexpr size_t OFF_HID = OFF_BIG;

struct Params {
  const float* x; const float* mem; const int* pos;
  const float* hyb_w_in; const float* dn_conv_w; const float* dn_a_log; const float* dn_dt_bias; const float* dn_norm_g; const float* hyb_w_out;
  const float* s5_a_re; const float* s5_a_im; const float* s5_log_dt; const float* s5_b_re; const float* s5_b_im; const float* s5_c_re; const float* s5_c_im;
  const float* s5_d; const float* s5_glu_wo; const float* s5_glu_wg;
  const float* ln_mix_g; const float* ln_mix_b;
  const float* xq_w; const float* xk_w; const float* xv_w; const float* xo_w; const float* ln_x_g; const float* ln_x_b;
  const float* ffn_wg; const float* ffn_wu; const float* ffn_wd; const float* ln_ffn_g; const float* ln_ffn_b;
  float* out; char* ws;
};

DI bf16_t f2bf(float x) { unsigned u = __float_as_uint(x); u += 0x7fffu + ((u >> 16) & 1u); return (bf16_t)(u >> 16); }
DI float bf2f(bf16_t v) { return __uint_as_float(((unsigned)v) << 16); }
DI unsigned pack2(float a, float b) { return (unsigned)f2bf(a) | ((unsigned)f2bf(b) << 16); }
using u32x4 = __attribute__((ext_vector_type(4))) unsigned;
using u32x2 = __attribute__((ext_vector_type(2))) unsigned;
DI bf16x8 pack8(f32x4 a, f32x4 b) {
  u32x4 t; t[0] = pack2(a[0], a[1]); t[1] = pack2(a[2], a[3]); t[2] = pack2(b[0], b[1]); t[3] = pack2(b[2], b[3]);
  return __builtin_bit_cast(bf16x8, t);
}
#define MFMA16(a, b, c) __builtin_amdgcn_mfma_f32_16x16x32_bf16((a), (b), (c), 0, 0, 0)
DI float wave_sum(float v) { for (int o = 32; o > 0; o >>= 1) v += __shfl_xor(v, o); return v; }
DI float wave_max(float v) { for (int o = 32; o > 0; o >>= 1) v = fmaxf(v, __shfl_xor(v, o)); return v; }
DI float sigmoidf_(float x) { return 1.f / (1.f + __expf(-x)); }
DI float siluf_(float x) { return x * sigmoidf_(x); }
DI float softplusf_(float x) { return fmaxf(x, 0.f) + log1pf(__expf(-fabsf(x))); }
DI float gelu_tanh(float x) { float u = 0.7978845608028654f * (x + 0.044715f * x * x * x); return 0.5f * x * (1.f + tanhf(u)); }

template <class CM>
DI void transpose_job(bf16_t* dst, int Ndst, int K, int srcStride, CM colptr, float* tile) {
  const int ntk = K / 64, ntiles = (Ndst / 64) * ntk;
  for (int tl = blockIdx.x; tl < ntiles; tl += gridDim.x) {
    const int r0 = (tl / ntk) * 64, k0 = (tl % ntk) * 64;
    const int rl = threadIdx.x & 63, ks = threadIdx.x >> 6;
    const float* cp = colptr(r0 + rl);
    for (int i = 0; i < 16; ++i) { int kl = ks * 16 + i; tile[kl * 65 + rl] = cp ? cp[(size_t)(k0 + kl) * srcStride] : 0.f; }
    __syncthreads();
    const int kk = threadIdx.x & 63, rs = threadIdx.x >> 6;
    for (int i = 0; i < 16; ++i) { int rr = i * 4 + rs; dst[(size_t)(r0 + rr) * K + k0 + kk] = f2bf(tile[kk * 65 + rr]); }
    __syncthreads();
  }
}

DI void phase_prologue(const Params& p, float* smem) {
  bf16_t* W = (bf16_t*)(p.ws + OFF_W);
  for (int l = 0; l < 4; ++l) {
    bf16_t* wc = W + (size_t)l * SZ_COMMON;
    const float* s;
    s = p.xq_w + (size_t)l * SZ_SQ; transpose_job(wc, 1024, 1024, 1024, [=](int r) { return s + r; }, smem);
    s = p.xk_w + (size_t)l * SZ_SQ; transpose_job(wc + SZ_SQ, 1024, 1024, 1024, [=](int r) { return s + r; }, smem);
    s = p.xv_w + (size_t)l * SZ_SQ; transpose_job(wc + 2 * SZ_SQ, 1024, 1024, 1024, [=](int r) { return s + r; }, smem);
    s = p.xo_w + (size_t)l * SZ_SQ; transpose_job(wc + 3 * SZ_SQ, 1024, 1024, 1024, [=](int r) { return s + r; }, smem);
    {
      const float* g = p.ffn_wg + (size_t)l * 1024 * 2816; const float* u = p.ffn_wu + (size_t)l * 1024 * 2816;
      transpose_job(wc + 4 * SZ_SQ, 5632, 1024, 2816, [=](int r) { int c = (r >> 5) * 16 + (r & 15); return ((r >> 4) & 1) ? (u + c) : (g + c); }, smem);
    }
    s = p.ffn_wd + (size_t)l * 2816 * 1024; transpose_job(wc + 4 * SZ_SQ + SZ_GU, 1024, 2816, 1024, [=](int r) { return s + r; }, smem);
  }
  for (int i = 0; i < 2; ++i) {
    bf16_t* we = W + W_EVEN0 + (size_t)i * (SZ_WIN + SZ_SQ);
    const float* s = p.hyb_w_in + (size_t)i * 1024 * 3592;
    transpose_job(we, 3712, 1024, 3592, [=](int r) -> const float* {
      if (r < 2048) return s + r;
      if (r < 3584) return s + r + 8;
      if (r < 3592) return s + 2048 + (r - 3584);
      return nullptr; }, smem);
    const float* s2 = p.hyb_w_out + (size_t)i * SZ_SQ;
    transpose_job(we + SZ_WIN, 1024, 1024, 1024, [=](int r) { return s2 + r; }, smem);
    bf16_t* wo = W + W_ODD0 + (size_t)i * SZ_GLU;
    const float* a = p.s5_glu_wo + (size_t)i * SZ_SQ; const float* b = p.s5_glu_wg + (size_t)i * SZ_SQ;
    transpose_job(wo, 2048, 1024, 1024, [=](int r) { int c = (r >> 5) * 16 + (r & 15); return ((r >> 4) & 1) ? (b + c) : (a + c); }, smem);
  }
  const size_t gtid = (size_t)blockIdx.x * 256 + threadIdx.x, gsz = (size_t)gridDim.x * 256;
  bf16_t* hb = (bf16_t*)(p.ws + OFF_HB);
  for (size_t i = gtid; i < (size_t)T_ * 256; i += gsz) {
    float4 v = ((const float4*)p.x)[i];
    ((float4*)p.out)[i] = v;
    uint2 o; o.x = pack2(v.x, v.y); o.y = pack2(v.z, v.w);
    ((uint2*)hb)[i] = o;
  }
  bf16_t* memb = (bf16_t*)(p.ws + OFF_MEMB);
  for (size_t i = gtid; i < (size_t)2048 * 256; i += gsz) {
    float4 v = ((const float4*)p.mem)[i];
    uint2 o; o.x = pack2(v.x, v.y); o.y = pack2(v.z, v.w);
    ((uint2*)memb)[i] = o;
  }
  float* rc = (float*)(p.ws + OFF_ROPE); float* rs = rc + (size_t)T_ * 32;
  for (size_t i = gtid; i < (size_t)T_ * 32; i += gsz) {
    int t = (int)(i >> 5), j = (int)(i & 31);
    float invf = (float)exp(-(double)(2 * j) / 64.0 * 9.210340371976184);
    float ang = (float)p.pos[t] * invf;
    double a = (double)ang;
    double k = rint(a * 0.15915494309189535);
    float r = (float)(a - k * 6.283185307179586);
    rc[i] = cosf(r); rs[i] = sinf(r);
  }
}

constexpr int LDT = 72;
template <class AL, class BL, class EP>
DI void gemm_tile(int m0, int n0, int nks, AL aload, BL bload, EP epi, bf16_t* smem) {
  bf16_t* As = smem; bf16_t* Bs = smem + 2 * 128 * LDT;
  const int tid = threadIdx.x, lane = tid & 63, wave = tid >> 6;
  const int wm = wave >> 1, wn = wave & 1, l15 = lane & 15, quad = lane >> 4;
  const int lrow = tid >> 3, lkc = (tid & 7) * 8;
  f32x4 acc[4][4];
#pragma unroll
  for (int i = 0; i < 4; ++i)
#pragma unroll
    for (int j = 0; j < 4; ++j) acc[i][j] = f32x4{0.f, 0.f, 0.f, 0.f};
  uint4 ra[4], rb[4];
#pragma unroll
  for (int i = 0; i < 4; ++i) { ra[i] = aload(m0 + lrow + 32 * i, 0, lkc); rb[i] = bload(n0 + lrow + 32 * i, 0, lkc); }
#pragma unroll
  for (int i = 0; i < 4; ++i) {
    *(uint4*)(As + (lrow + 32 * i) * LDT + lkc) = ra[i];
    *(uint4*)(Bs + (lrow + 32 * i) * LDT + lkc) = rb[i];
  }
  __syncthreads();
  for (int ks = 0; ks < nks; ++ks) {
    const int cur = ks & 1;
    const bool more = (ks + 1 < nks);
    if (more) {
#pragma unroll
      for (int i = 0; i < 4; ++i) { ra[i] = aload(m0 + lrow + 32 * i, ks + 1, lkc); rb[i] = bload(n0 + lrow + 32 * i, ks + 1, lkc); }
    }
    const bf16_t* Ab = As + cur * 128 * LDT; const bf16_t* Bb = Bs + cur * 128 * LDT;
#pragma unroll
    for (int kk = 0; kk < 2; ++kk) {
      bf16x8 a[4], b[4];
#pragma unroll
      for (int mt = 0; mt < 4; ++mt) a[mt] = *(const bf16x8*)(Ab + (wm * 64 + mt * 16 + l15) * LDT + kk * 32 + quad * 8);
#pragma unroll
      for (int nt = 0; nt < 4; ++nt) b[nt] = *(const bf16x8*)(Bb + (wn * 64 + nt * 16 + l15) * LDT + kk * 32 + quad * 8);
#pragma unroll
      for (int mt = 0; mt < 4; ++mt)
#pragma unroll
        for (int nt = 0; nt < 4; ++nt) acc[mt][nt] = __builtin_amdgcn_mfma_f32_16x16x32_bf16(a[mt], b[nt], acc[mt][nt], 0, 0, 0);
    }
    if (more) {
      bf16_t* An = As + (cur ^ 1) * 128 * LDT; bf16_t* Bn = Bs + (cur ^ 1) * 128 * LDT;
#pragma unroll
      for (int i = 0; i < 4; ++i) {
        *(uint4*)(An + (lrow + 32 * i) * LDT + lkc) = ra[i];
        *(uint4*)(Bn + (lrow + 32 * i) * LDT + lkc) = rb[i];
      }
    }
    __syncthreads();
  }
  epi(acc, m0 + wm * 64, n0 + wn * 64);
}

template <class F>
DI void for_tiles(int mtiles, int ntiles, F f) {
  const int xcd = blockIdx.x & 7, slot = blockIdx.x >> 3, nslot = gridDim.x >> 3;
  const int per = (mtiles >> 3) * ntiles;
  for (int w = slot; w < per; w += nslot) {
    int mi = w / ntiles, ni = w - mi * ntiles;
    f((mi * 8 + xcd), ni);
  }
}

#define EPI_LOOP for (int mt = 0; mt < 4; ++mt) for (int nt = 0; nt < 4; ++nt) for (int r = 0; r < 4; ++r)

DI void epi_resid(const Params& p, f32x4 (&acc)[4][4], int rb, int cb) {
  const int lane = threadIdx.x & 63, l15 = lane & 15, quad = lane >> 4;
#pragma unroll
  for (int mt = 0; mt < 4; ++mt)
#pragma unroll
    for (int nt = 0; nt < 4; ++nt)
#pragma unroll
      for (int r = 0; r < 4; ++r) {
        size_t idx = (size_t)(rb + mt * 16 + quad * 4 + r) * 1024 + cb + nt * 16 + l15;
        p.out[idx] = ALPHA * p.out[idx] + acc[mt][nt][r];
      }
}
DI void epi_bf16(bf16_t* dst, int ld, f32x4 (&acc)[4][4], int rb, int cb) {
  const int lane = threadIdx.x & 63, l15 = lane & 15, quad = lane >> 4;
#pragma unroll
  for (int mt = 0; mt < 4; ++mt)
#pragma unroll
    for (int nt = 0; nt < 4; ++nt)
#pragma unroll
      for (int r = 0; r < 4; ++r)
        dst[(size_t)(rb + mt * 16 + quad * 4 + r) * ld + cb + nt * 16 + l15] = f2bf(acc[mt][nt][r]);
}

struct PlainLoad {
  const bf16_t* base; int ld;
  DI uint4 operator()(int row, int ks, int kc) const { return *(const uint4*)(base + (size_t)row * ld + ks * 64 + kc); }
};

DI void phase_proj(const Params& p, int i, bf16_t* smem) {
  const bf16_t* W = (const bf16_t*)(p.ws + OFF_W) + W_EVEN0 + (size_t)i * (SZ_WIN + SZ_SQ);
  PlainLoad al{(const bf16_t*)(p.ws + OFF_HB), 1024}, bl{W, 1024};
  bf16_t* dnqkv = (bf16_t*)(p.ws + OFF_DNQKV); bf16_t* z = (bf16_t*)(p.ws + OFF_Z);
  bf16_t* swq = (bf16_t*)(p.ws + OFF_SWQ); bf16_t* swk = (bf16_t*)(p.ws + OFF_SWK); bf16_t* swv = (bf16_t*)(p.ws + OFF_SWV);
  float* logit = (float*)(p.ws + OFF_LOGIT);
  const float* rc = (const float*)(p.ws + OFF_ROPE); const float* rs = rc + (size_t)T_ * 32;
  for_tiles(256, 29, [&](int mi, int ni) {
    gemm_tile(mi * 128, ni * 128, 16, al, bl, [&](f32x4 (&acc)[4][4], int rb, int cb) {
      const int lane = threadIdx.x & 63, l15 = lane & 15, quad = lane >> 4;
      if (cb < 1536) epi_bf16(dnqkv, 1536, acc, rb, cb);
      else if (cb < 2048) epi_bf16(z, 512, acc, rb, cb - 1536);
      else if (cb < 3072) {
        bf16_t* dst = (cb < 2560) ? swq : swk; const int c0 = (cb < 2560) ? cb - 2048 : cb - 2560;
#pragma unroll
        for (int mt = 0; mt < 4; ++mt)
#pragma unroll
          for (int r = 0; r < 4; ++r) {
            const int row = rb + mt * 16 + quad * 4 + r;
#pragma unroll
            for (int nt = 0; nt < 2; ++nt) {
              const int d = nt * 16 + l15;
              float c = rc[(size_t)row * 32 + d], s = rs[(size_t)row * 32 + d];
              float x1 = acc[mt][nt][r], x2 = acc[mt][nt + 2][r];
              dst[(size_t)row * 512 + c0 + d] = f2bf(x1 * c - x2 * s);
              dst[(size_t)row * 512 + c0 + d + 32] = f2bf(x2 * c + x1 * s);
            }
          }
      } else if (cb < 3584) epi_bf16(swv, 512, acc, rb, cb - 3072);
      else if (cb == 3584) {
#pragma unroll
        for (int mt = 0; mt < 4; ++mt)
#pragma unroll
          for (int r = 0; r < 4; ++r)
            if (l15 < 8) logit[(size_t)(rb + mt * 16 + quad * 4 + r) * 8 + l15] = acc[mt][0][r];
      }
    }, smem);
  });
}

DI void phase_dn_prep(const Params& p, int i) {
  const bf16_t* dnqkv = (const bf16_t*)(p.ws + OFF_DNQKV);
  bf16_t* out_q = (bf16_t*)(p.ws + OFF_QN); bf16_t* out_k = (bf16_t*)(p.ws + OFF_KN); bf16_t* out_v = (bf16_t*)(p.ws + OFF_VN);
  const float* cw = p.dn_conv_w + (size_t)i * 4 * 1536;
  const int wave = threadIdx.x >> 6, lane = threadIdx.x & 63;
  const int N = T_ * 12;
  for (int base = blockIdx.x * 4; base < N; base += gridDim.x * 4) {
    const int item = base + wave;
    const int t = item / 12, rem = item - t * 12, which = rem >> 2, h = rem & 3;
    const int s = t & (S_ - 1);
    const int col = which * 512 + h * 128 + lane * 2;
    float y0 = 0.f, y1 = 0.f;
#pragma unroll
    for (int j = 0; j < 4; ++j) {
      if (s - 3 + j >= 0) {
        unsigned v = *(const unsigned*)(dnqkv + (size_t)(t - 3 + j) * 1536 + col);
        y0 += cw[j * 1536 + col] * bf2f((bf16_t)(v & 0xffff));
        y1 += cw[j * 1536 + col + 1] * bf2f((bf16_t)(v >> 16));
      }
    }
    y0 = siluf_(y0); y1 = siluf_(y1);
    if (which < 2) {
      float ss = wave_sum(y0 * y0 + y1 * y1);
      float sc = rsqrtf(ss + 1e-6f);
      y0 *= sc; y1 *= sc;
    }
    bf16_t* o = (which == 0) ? out_q : (which == 1 ? out_k : out_v);
    *(unsigned*)(o + (size_t)t * 512 + h * 128 + lane * 2) = pack2(y0, y1);
  }
}

DI void dn_chain_item(const Params& p, int i, int item, float* smem) {
  const int b = item >> 2, h = item & 3, tid = threadIdx.x;
  const bf16_t* qn = (const bf16_t*)(p.ws + OFF_QN); const bf16_t* kn = (const bf16_t*)(p.ws + OFF_KN); const bf16_t* vn = (const bf16_t*)(p.ws + OFF_VN);
  const float* logit = (const float*)(p.ws + OFF_LOGIT);
  bf16_t* odn = (bf16_t*)(p.ws + OFF_ODN);
  float* qs = smem; float* ks = smem + 2048; float* vs = smem + 4096; float* as = smem + 6144; float* bs = as + 16;
  const float A = __expf(p.dn_a_log[i * 4 + h]), dtb = p.dn_dt_bias[i * 4 + h];
  float S[128];
#pragma unroll
  for (int d = 0; d < 128; ++d) S[d] = 0.f;
  for (int t0 = 0; t0 < S_; t0 += 16) {
    {
      const int tt = tid >> 4, c8 = (tid & 15) * 8;
      const size_t g = (size_t)(b * S_ + t0 + tt) * 512 + h * 128 + c8;
      uint4 a = *(const uint4*)(qn + g), k = *(const uint4*)(kn + g), v = *(const uint4*)(vn + g);
      const unsigned* pa = (const unsigned*)&a; const unsigned* pk = (const unsigned*)&k; const unsigned* pv = (const unsigned*)&v;
#pragma unroll
      for (int j = 0; j < 4; ++j) {
        qs[tt * 128 + c8 + 2 * j] = bf2f((bf16_t)(pa[j] & 0xffff)); qs[tt * 128 + c8 + 2 * j + 1] = bf2f((bf16_t)(pa[j] >> 16));
        ks[tt * 128 + c8 + 2 * j] = bf2f((bf16_t)(pk[j] & 0xffff)); ks[tt * 128 + c8 + 2 * j + 1] = bf2f((bf16_t)(pk[j] >> 16));
        vs[tt * 128 + c8 + 2 * j] = bf2f((bf16_t)(pv[j] & 0xffff)); vs[tt * 128 + c8 + 2 * j + 1] = bf2f((bf16_t)(pv[j] >> 16));
      }
      if (tid < 16) {
        const size_t row = (size_t)(b * S_ + t0 + tid);
        float bl = logit[row * 8 + h], al = logit[row * 8 + 4 + h];
        bs[tid] = sigmoidf_(bl);
        as[tid] = __expf(-A * softplusf_(al + dtb));
      }
    }
    __syncthreads();
    if (tid < 128) {
      for (int tt = 0; tt < 16; ++tt) {
        const float a = as[tt], bt = bs[tt];
        float r = 0.f;
#pragma unroll
        for (int d = 0; d < 128; d += 4) {
          float4 k4 = *(const float4*)(ks + tt * 128 + d);
          r += k4.x * S[d] + k4.y * S[d + 1] + k4.z * S[d + 2] + k4.w * S[d + 3];
        }
        const float delta = bt * (vs[tt * 128 + tid] - a * r);
        float o = 0.f;
#pragma unroll
        for (int d = 0; d < 128; d += 4) {
          float4 k4 = *(const float4*)(ks + tt * 128 + d);
          float4 q4 = *(const float4*)(qs + tt * 128 + d);
          S[d] = a * S[d] + k4.x * delta; o += q4.x * S[d];
          S[d + 1] = a * S[d + 1] + k4.y * delta; o += q4.y * S[d + 1];
          S[d + 2] = a * S[d + 2] + k4.z * delta; o += q4.z * S[d + 2];
          S[d + 3] = a * S[d + 3] + k4.w * delta; o += q4.w * S[d + 3];
        }
        odn[(size_t)(b * S_ + t0 + tt) * 512 + h * 128 + tid] = f2bf(o * 0.08838834764831845f);
      }
    }
    __syncthreads();
  }
}

DI void dil_attn_wave(const Params& p, int item) {
  const int lane = threadIdx.x & 63;
  const int t = item >> 3, h = item & 7, s = t & (S_ - 1);
  bf16_t* swq = (bf16_t*)(p.ws + OFF_SWQ); const bf16_t* swk = (const bf16_t*)(p.ws + OFF_SWK); const bf16_t* swv = (const bf16_t*)(p.ws + OFF_SWV);
  const float q = bf2f(swq[(size_t)t * 512 + h * 64 + lane]) * 0.125f;
  float m = -1e30f, l = 0.f, acc = 0.f;
#pragma unroll
  for (int br = 0; br < 3; ++br) {
    const int r = (br == 0) ? 1 : (br == 1 ? 4 : 16);
    for (int j = 0; j <= 128; ++j) {
      const int sk = s - j * r;
      if (sk < 0) break;
      const size_t g = (size_t)(t - j * r) * 512 + h * 64 + lane;
      float sc = wave_sum(q * bf2f(swk[g]));
      float mn = fmaxf(m, sc);
      float corr = __expf(m - mn), pj = __expf(sc - mn);
      l = l * corr + pj;
      acc = acc * corr + pj * bf2f(swv[g]);
      m = mn;
    }
  }
  swq[(size_t)t * 512 + h * 64 + lane] = f2bf(acc / l);
}

DI void phase_dil_attn(const Params& p);
DI void phase_mix(const Params& p, int i, float* smem) {
  for (int item = blockIdx.x; item < 32; item += gridDim.x) dn_chain_item(p, i, item, smem);
#if USE_DIL_MFMA
  phase_dil_attn(p);
#else
  const int wave = threadIdx.x >> 6;
  const int N = T_ * 8;
  for (int base = blockIdx.x * 4; base < N; base += gridDim.x * 4) dil_attn_wave(p, base + wave);
#endif
}

DI void phase_dn_post(const Params& p, int i) {
  const bf16_t* odn = (const bf16_t*)(p.ws + OFF_ODN);
  bf16_t* z = (bf16_t*)(p.ws + OFF_Z);
  const float* ng = p.dn_norm_g + i * 128;
  const int wave = threadIdx.x >> 6, lane = threadIdx.x & 63;
  const int N = T_ * 4;
  for (int base = blockIdx.x * 4; base < N; base += gridDim.x * 4) {
    const int item = base + wave;
    const size_t g = (size_t)item * 128 + lane * 2;
    unsigned ov = *(const unsigned*)(odn + g), zv = *(const unsigned*)(z + g);
    float o0 = bf2f((bf16_t)(ov & 0xffff)), o1 = bf2f((bf16_t)(ov >> 16));
    float z0 = bf2f((bf16_t)(zv & 0xffff)), z1 = bf2f((bf16_t)(zv >> 16));
    float ms = wave_sum(o0 * o0 + o1 * o1) * (1.f / 128.f);
    float rr = rsqrtf(ms + 1e-6f);
    float r0 = o0 * rr * ng[lane * 2] * siluf_(z0), r1 = o1 * rr * ng[lane * 2 + 1] * siluf_(z1);
    *(unsigned*)(z + g) = pack2(r0, r1);
  }
}

struct MixLoad {
  const bf16_t* a; const bf16_t* b;
  DI uint4 operator()(int row, int ks, int kc) const {
    return (ks < 8) ? *(const uint4*)(a + (size_t)row * 512 + ks * 64 + kc) : *(const uint4*)(b + (size_t)row * 512 + (ks - 8) * 64 + kc);
  }
};

DI void phase_wout(const Params& p, int i, bf16_t* smem) {
  const bf16_t* W = (const bf16_t*)(p.ws + OFF_W) + W_EVEN0 + (size_t)i * (SZ_WIN + SZ_SQ) + SZ_WIN;
  MixLoad al{(const bf16_t*)(p.ws + OFF_Z), (const bf16_t*)(p.ws + OFF_SWQ)};
  PlainLoad bl{W, 1024};
  for_tiles(256, 8, [&](int mi, int ni) {
    gemm_tile(mi * 128, ni * 128, 16, al, bl, [&](f32x4 (&acc)[4][4], int rb, int cb) { epi_resid(p, acc, rb, cb); }, smem);
  });
}

DI void phase_ln(const Params& p, const float* g, const float* b) {
  const int wave = threadIdx.x >> 6, lane = threadIdx.x & 63;
  bf16_t* hb = (bf16_t*)(p.ws + OFF_HB);
  for (int row = blockIdx.x * 4 + wave; row < T_; row += gridDim.x * 4) {
    float4* y = (float4*)(p.out + (size_t)row * 1024);
    float4 v[4];
    float s = 0.f;
#pragma unroll
    for (int i = 0; i < 4; ++i) { v[i] = y[lane + 64 * i]; s += v[i].x + v[i].y + v[i].z + v[i].w; }
    const float mu = wave_sum(s) * (1.f / 1024.f);
    float q = 0.f;
#pragma unroll
    for (int i = 0; i < 4; ++i) { float a = v[i].x - mu, b2 = v[i].y - mu, c = v[i].z - mu, d = v[i].w - mu; q += a * a + b2 * b2 + c * c + d * d; }
    const float rstd = rsqrtf(wave_sum(q) * (1.f / 1024.f) + 1e-5f);
#pragma unroll
    for (int i = 0; i < 4; ++i) {
      float4 gg = ((const float4*)g)[lane + 64 * i], bb = ((const float4*)b)[lane + 64 * i];
      float4 o;
      o.x = (v[i].x - mu) * rstd * gg.x + bb.x; o.y = (v[i].y - mu) * rstd * gg.y + bb.y;
      o.z = (v[i].z - mu) * rstd * gg.z + bb.z; o.w = (v[i].w - mu) * rstd * gg.w + bb.w;
      y[lane + 64 * i] = o;
      uint2 ob; ob.x = pack2(o.x, o.y); ob.y = pack2(o.z, o.w);
      ((uint2*)(hb + (size_t)row * 1024))[lane + 64 * i] = ob;
    }
  }
}

DI void phase_s5_naive(const Params& p, int i) {
  const int wave = threadIdx.x >> 6, lane = threadIdx.x & 63;
  bf16_t* hid = (bf16_t*)(p.ws + OFF_HID);
  for (int base = blockIdx.x * 4; base < 512; base += gridDim.x * 4) {
    const int item = base + wave, b = item >> 6, g = item & 63;
    const int gp = (i * 64 + g) * 64 + lane;
    const double dt = exp((double)p.s5_log_dt[i * 64 + g]);
    const double are = p.s5_a_re[gp], aim = p.s5_a_im[gp];
    const double lr = are * dt, li = aim * dt;
    const double kk = rint(li * 0.15915494309189535);
    const double red = li - kk * 6.283185307179586;
    const double e = exp(lr);
    const double abr = e * cos(red), abi = e * sin(red);
    const double den = are * are + aim * aim;
    const double nr = abr - 1.0, ni = abi;
    const double cfr = (nr * are + ni * aim) / den, cfi = (ni * are - nr * aim) / den;
    float bbr[16], bbi[16], cr[16], ci[16];
#pragma unroll
    for (int h = 0; h < 16; ++h) {
      const double br = p.s5_b_re[(size_t)gp * 16 + h], bi = p.s5_b_im[(size_t)gp * 16 + h];
      bbr[h] = (float)(cfr * br - cfi * bi); bbi[h] = (float)(cfr * bi + cfi * br);
      cr[h] = p.s5_c_re[((size_t)(i * 64 + g) * 16 + h) * 64 + lane];
      ci[h] = p.s5_c_im[((size_t)(i * 64 + g) * 16 + h) * 64 + lane];
    }
    const float ar = (float)abr, ai = (float)abi;
    const float dsk = p.s5_d[i * 1024 + g * 16 + (lane & 15)];
    float sr = 0.f, si = 0.f;
#pragma unroll 1
    for (int t = 0; t < S_; ++t) {
      const size_t row = (size_t)(b * S_ + t);
      const float4* up = (const float4*)(p.out + row * 1024 + g * 16);
      float u[16];
#pragma unroll
      for (int j = 0; j < 4; ++j) { float4 v = up[j]; u[4 * j] = v.x; u[4 * j + 1] = v.y; u[4 * j + 2] = v.z; u[4 * j + 3] = v.w; }
      float bur = 0.f, bui = 0.f;
#pragma unroll
      for (int h = 0; h < 16; ++h) { bur += bbr[h] * u[h]; bui += bbi[h] * u[h]; }
      const float nsr = ar * sr - ai * si + bur, nsi = ar * si + ai * sr + bui;
      sr = nsr; si = nsi;
      float yk = 0.f, uk = 0.f;
#pragma unroll
      for (int h = 0; h < 16; ++h) {
        float v = wave_sum(cr[h] * sr - ci[h] * si);
        if (lane == h) { yk = v; uk = u[h]; }
      }
      if (lane < 16) hid[row * 1024 + g * 16 + lane] = f2bf(gelu_tanh(yk + dsk * uk));
    }
  }
}

DI void phase_glu(const Params& p, int i, bf16_t* smem) {
  const bf16_t* W = (const bf16_t*)(p.ws + OFF_W) + W_ODD0 + (size_t)i * SZ_GLU;
  PlainLoad al{(const bf16_t*)(p.ws + OFF_HID), 1024}, bl{W, 1024};
  for_tiles(256, 16, [&](int mi, int ni) {
    gemm_tile(mi * 128, ni * 128, 16, al, bl, [&](f32x4 (&acc)[4][4], int rb, int cb) {
      const int lane = threadIdx.x & 63, l15 = lane & 15, quad = lane >> 4;
#pragma unroll
      for (int mt = 0; mt < 4; ++mt)
#pragma unroll
        for (int np = 0; np < 2; ++np)
#pragma unroll
          for (int r = 0; r < 4; ++r) {
            float val = acc[mt][2 * np][r] * sigmoidf_(acc[mt][2 * np + 1][r]);
            size_t idx = (size_t)(rb + mt * 16 + quad * 4 + r) * 1024 + (cb >> 1) + np * 16 + l15;
            p.out[idx] = ALPHA * p.out[idx] + val;
          }
    }, smem);
  });
}

DI void phase_xproj(const Params& p, int l, bf16_t* smem) {
  const bf16_t* wc = (const bf16_t*)(p.ws + OFF_W) + (size_t)l * SZ_COMMON;
  {
    PlainLoad al{(const bf16_t*)(p.ws + OFF_HB), 1024}, bl{wc, 1024};
    bf16_t* q = (bf16_t*)(p.ws + OFF_XQ);
    for_tiles(256, 8, [&](int mi, int ni) {
      gemm_tile(mi * 128, ni * 128, 16, al, bl, [&](f32x4 (&acc)[4][4], int rb, int cb) { epi_bf16(q, 1024, acc, rb, cb); }, smem);
    });
  }
  {
    PlainLoad al{(const bf16_t*)(p.ws + OFF_MEMB), 1024};
    bf16_t* kx = (bf16_t*)(p.ws + OFF_KX); bf16_t* vx = (bf16_t*)(p.ws + OFF_VX);
    for_tiles(16, 16, [&](int mi, int ni) {
      const bool isv = ni >= 8;
      PlainLoad bl{isv ? (wc + 2 * SZ_SQ) : (wc + SZ_SQ), 1024};
      gemm_tile(mi * 128, (ni & 7) * 128, 16, al, bl, [&](f32x4 (&acc)[4][4], int rb, int cb) {
        if (!isv) { epi_bf16(kx, 1024, acc, rb, cb); return; }
        if (!USE_XATTN_MFMA) { epi_bf16(vx, 1024, acc, rb, cb); return; }
        const int lane = threadIdx.x & 63, l15 = lane & 15, quad = lane >> 4;
#pragma unroll
        for (int mt = 0; mt < 4; ++mt)
#pragma unroll
          for (int nt = 0; nt < 4; ++nt) {
            const int row = rb + mt * 16 + quad * 4, col = cb + nt * 16 + l15;
            const int b = row >> 8, key = row & 255, h = col >> 8, d = col & 255;
            u32x2 v; v[0] = pack2(acc[mt][nt][0], acc[mt][nt][1]); v[1] = pack2(acc[mt][nt][2], acc[mt][nt][3]);
            *(u32x2*)(vx + ((size_t)((b * 4 + h) * 256 + d)) * 256 + key) = v;
          }
      }, smem);
    });
  }
}

DI void phase_xattn_naive(const Params& p, float* smem) {
  const int wave = threadIdx.x >> 6, lane = threadIdx.x & 63;
  const bf16_t* q = (const bf16_t*)(p.ws + OFF_XQ); const bf16_t* kx = (const bf16_t*)(p.ws + OFF_KX); const bf16_t* vx = (const bf16_t*)(p.ws + OFF_VX);
  bf16_t* xo = (bf16_t*)(p.ws + OFF_XO);
  float* qs = smem + wave * 256;
  const int N = T_ * 4;
  for (int base = blockIdx.x * 4; base < N; base += gridDim.x * 4) {
    const int item = base + wave, t = item >> 2, h = item & 3, b = t >> 12;
    {
      uint2 v = *(const uint2*)(q + (size_t)t * 1024 + h * 256 + lane * 4);
      qs[lane * 4] = bf2f((bf16_t)(v.x & 0xffff)); qs[lane * 4 + 1] = bf2f((bf16_t)(v.x >> 16));
      qs[lane * 4 + 2] = bf2f((bf16_t)(v.y & 0xffff)); qs[lane * 4 + 3] = bf2f((bf16_t)(v.y >> 16));
    }
    __syncthreads();
    float sc[4];
#pragma unroll
    for (int kk = 0; kk < 4; ++kk) {
      const bf16_t* kp = kx + (size_t)(b * 256 + kk * 64 + lane) * 1024 + h * 256;
      float d = 0.f;
#pragma unroll 4
      for (int c = 0; c < 32; ++c) {
        uint4 kv = *(const uint4*)(kp + c * 8);
        const unsigned* pk = (const unsigned*)&kv;
        float4 q0 = *(const float4*)(qs + c * 8), q1 = *(const float4*)(qs + c * 8 + 4);
        d += q0.x * bf2f((bf16_t)(pk[0] & 0xffff)) + q0.y * bf2f((bf16_t)(pk[0] >> 16)) + q0.z * bf2f((bf16_t)(pk[1] & 0xffff)) + q0.w * bf2f((bf16_t)(pk[1] >> 16));
        d += q1.x * bf2f((bf16_t)(pk[2] & 0xffff)) + q1.y * bf2f((bf16_t)(pk[2] >> 16)) + q1.z * bf2f((bf16_t)(pk[3] & 0xffff)) + q1.w * bf2f((bf16_t)(pk[3] >> 16));
      }
      sc[kk] = d * 0.0625f;
    }
    float m = wave_max(fmaxf(fmaxf(sc[0], sc[1]), fmaxf(sc[2], sc[3])));
    float pr[4], ls = 0.f;
#pragma unroll
    for (int kk = 0; kk < 4; ++kk) { pr[kk] = __expf(sc[kk] - m); ls += pr[kk]; }
    const float l = wave_sum(ls);
    float a0 = 0.f, a1 = 0.f, a2 = 0.f, a3 = 0.f;
#pragma unroll
    for (int kk = 0; kk < 4; ++kk) {
#pragma unroll 4
      for (int src = 0; src < 64; ++src) {
        float pk = __shfl(pr[kk], src);
        uint2 v = *(const uint2*)(vx + (size_t)(b * 256 + kk * 64 + src) * 1024 + h * 256 + lane * 4);
        a0 += pk * bf2f((bf16_t)(v.x & 0xffff)); a1 += pk * bf2f((bf16_t)(v.x >> 16));
        a2 += pk * bf2f((bf16_t)(v.y & 0xffff)); a3 += pk * bf2f((bf16_t)(v.y >> 16));
      }
    }
    const float il = 1.f / l;
    uint2 o; o.x = pack2(a0 * il, a1 * il); o.y = pack2(a2 * il, a3 * il);
    *(uint2*)(xo + (size_t)t * 1024 + h * 256 + lane * 4) = o;
    __syncthreads();
  }
}

DI void phase_xattn(const Params& p) {
  const int wave = threadIdx.x >> 6, lane = threadIdx.x & 63, l15 = lane & 15, quad = lane >> 4;
  const bf16_t* q = (const bf16_t*)(p.ws + OFF_XQ); const bf16_t* kx = (const bf16_t*)(p.ws + OFF_KX); const bf16_t* vxT = (const bf16_t*)(p.ws + OFF_VX);
  bf16_t* xo = (bf16_t*)(p.ws + OFF_XO);
  for (int item = blockIdx.x; item < 2048; item += gridDim.x) {
    const int b = item >> 8, h = (item >> 6) & 3, qb = item & 63;
    const size_t tq = (size_t)b * 4096 + qb * 64 + wave * 16 + l15;
    bf16x8 qf[8];
#pragma unroll
    for (int ks = 0; ks < 8; ++ks) qf[ks] = *(const bf16x8*)(q + tq * 1024 + h * 256 + ks * 32 + quad * 8);
    f32x4 s[16];
#pragma unroll
    for (int mt = 0; mt < 16; ++mt) {
      const bf16_t* kp = kx + (size_t)(b * 256 + mt * 16 + l15) * 1024 + h * 256 + quad * 8;
      f32x4 a = {0.f, 0.f, 0.f, 0.f};
#pragma unroll
      for (int ks = 0; ks < 8; ++ks) a = MFMA16(*(const bf16x8*)(kp + ks * 32), qf[ks], a);
      s[mt] = a;
    }
    float m = -1e30f;
#pragma unroll
    for (int mt = 0; mt < 16; ++mt)
#pragma unroll
      for (int r = 0; r < 4; ++r) m = fmaxf(m, s[mt][r]);
    m = fmaxf(m, __shfl_xor(m, 16)); m = fmaxf(m, __shfl_xor(m, 32));
    const float c1 = 0.0625f * 1.4426950408889634f;
    float l = 0.f;
#pragma unroll
    for (int mt = 0; mt < 16; ++mt)
#pragma unroll
      for (int r = 0; r < 4; ++r) { float pv = exp2f((s[mt][r] - m) * c1); s[mt][r] = pv; l += pv; }
    l += __shfl_xor(l, 16); l += __shfl_xor(l, 32);
    f32x4 o[16];
#pragma unroll
    for (int dt = 0; dt < 16; ++dt) o[dt] = f32x4{0.f, 0.f, 0.f, 0.f};
#pragma unroll
    for (int s2 = 0; s2 < 8; ++s2) {
      const bf16x8 pf = pack8(s[2 * s2], s[2 * s2 + 1]);
#pragma unroll
      for (int dt = 0; dt < 16; ++dt) {
        const bf16_t* vp = vxT + ((size_t)((b * 4 + h) * 256 + dt * 16 + l15)) * 256 + s2 * 32 + quad * 4;
        u32x2 lo = *(const u32x2*)vp, hi = *(const u32x2*)(vp + 16);
        u32x4 t; t[0] = lo[0]; t[1] = lo[1]; t[2] = hi[0]; t[3] = hi[1];
        o[dt] = MFMA16(__builtin_bit_cast(bf16x8, t), pf, o[dt]);
      }
    }
    const float il = 1.f / l;
#pragma unroll
    for (int dt = 0; dt < 16; ++dt) {
      u32x2 v; v[0] = pack2(o[dt][0] * il, o[dt][1] * il); v[1] = pack2(o[dt][2] * il, o[dt][3] * il);
      *(u32x2*)(xo + tq * 1024 + h * 256 + dt * 16 + quad * 4) = v;
    }
  }
}

template <int R, int NT>
DI void dil_branch(const bf16_t* swk, const bf16_t* swv, size_t rowbase, int h, int tok0, const bf16x8 (&qf)[2], float& m, float& l, f32x4 (&o)[4],
                   int l15, int quad) {
  constexpr int U = 16 / R, W = 128 * R;
  f32x4 s[NT];
#pragma unroll
  for (int kt = 0; kt < NT; ++kt) {
    int kap = tok0 - W + R * (kt * 16 + l15);
    kap = min(max(kap, 0), 4095);
    const bf16_t* kp = swk + (rowbase + kap) * 512 + h * 64 + quad * 8;
    f32x4 a = {0.f, 0.f, 0.f, 0.f};
    a = MFMA16(*(const bf16x8*)kp, qf[0], a);
    a = MFMA16(*(const bf16x8*)(kp + 32), qf[1], a);
    s[kt] = a;
  }
  float mx = m;
  const float c1 = 0.125f * 1.4426950408889634f;
#pragma unroll
  for (int kt = 0; kt < NT; ++kt)
#pragma unroll
    for (int r2 = 0; r2 < 4; ++r2) {
      const int c = kt * 16 + quad * 4 + r2;
      const int dist = U * l15 + 128 - c;
      const int kap = tok0 - W + R * c;
      const bool ok = (dist >= 0) && (dist <= 128) && (kap >= 0);
      const float v = ok ? s[kt][r2] * c1 : -1e30f;
      s[kt][r2] = v; mx = fmaxf(mx, v);
    }
  mx = fmaxf(mx, __shfl_xor(mx, 16)); mx = fmaxf(mx, __shfl_xor(mx, 32));
  const float corr = exp2f(m - mx);
  m = mx; l *= corr;
#pragma unroll
  for (int dt = 0; dt < 4; ++dt) { o[dt][0] *= corr; o[dt][1] *= corr; o[dt][2] *= corr; o[dt][3] *= corr; }
#pragma unroll
  for (int kt = 0; kt < NT; ++kt)
#pragma unroll
    for (int r2 = 0; r2 < 4; ++r2) { float pv = exp2f(s[kt][r2] - mx); s[kt][r2] = pv; l += pv; }
  constexpr int NS = (NT + 1) / 2;
#pragma unroll
  for (int s2 = 0; s2 < NS; ++s2) {
    const f32x4 z4 = {0.f, 0.f, 0.f, 0.f};
    const bf16x8 pf = pack8(s[2 * s2], (2 * s2 + 1 < NT) ? s[(2 * s2 + 1 < NT) ? 2 * s2 + 1 : 0] : z4);
    const bf16_t* vp[8];
#pragma unroll
    for (int j = 0; j < 8; ++j) {
      const int c = (2 * s2 + (j >> 2)) * 16 + quad * 4 + (j & 3);
      int kap = tok0 - W + R * c;
      kap = min(max(kap, 0), 4095);
      vp[j] = swv + (rowbase + kap) * 512 + h * 64 + l15;
    }
#pragma unroll
    for (int dt = 0; dt < 4; ++dt) {
      bf16x8 vf;
#pragma unroll
      for (int j = 0; j < 8; ++j) vf[j] = (short)vp[j][dt * 16];
      o[dt] = MFMA16(vf, pf, o[dt]);
    }
  }
}

DI void phase_dil_attn(const Params& p) {
  const int wave = threadIdx.x >> 6, lane = threadIdx.x & 63, l15 = lane & 15, quad = lane >> 4;
  bf16_t* swq = (bf16_t*)(p.ws + OFF_SWQ); const bf16_t* swk = (const bf16_t*)(p.ws + OFF_SWK); const bf16_t* swv = (const bf16_t*)(p.ws + OFF_SWV);
  for (int item = blockIdx.x; item < 4096; item += gridDim.x) {
    const int b = item >> 9, h = (item >> 6) & 7, G = (item >> 2) & 15, sub = item & 3;
    const int tok0 = G * 256 + sub * 4 + wave;
    const size_t rowbase = (size_t)b * 4096;
    const size_t tq = rowbase + tok0 + 16 * l15;
    bf16x8 qf[2];
    qf[0] = *(const bf16x8*)(swq + tq * 512 + h * 64 + quad * 8);
    qf[1] = *(const bf16x8*)(swq + tq * 512 + h * 64 + 32 + quad * 8);
    float m = -1e30f, l = 0.f;
    f32x4 o[4];
#pragma unroll
    for (int dt = 0; dt < 4; ++dt) o[dt] = f32x4{0.f, 0.f, 0.f, 0.f};
    dil_branch<16, 9>(swk, swv, rowbase, h, tok0, qf, m, l, o, l15, quad);
    dil_branch<4, 12>(swk, swv, rowbase, h, tok0, qf, m, l, o, l15, quad);
    dil_branch<1, 24>(swk, swv, rowbase, h, tok0, qf, m, l, o, l15, quad);
    l += __shfl_xor(l, 16); l += __shfl_xor(l, 32);
    const float il = 1.f / l;
#pragma unroll
    for (int dt = 0; dt < 4; ++dt) {
      u32x2 v; v[0] = pack2(o[dt][0] * il, o[dt][1] * il); v[1] = pack2(o[dt][2] * il, o[dt][3] * il);
      *(u32x2*)(swq + tq * 512 + h * 64 + dt * 16 + quad * 4) = v;
    }
  }
}

DI void phase_xo(const Params& p, int l, bf16_t* smem) {
  const bf16_t* wc = (const bf16_t*)(p.ws + OFF_W) + (size_t)l * SZ_COMMON + 3 * SZ_SQ;
  PlainLoad al{(const bf16_t*)(p.ws + OFF_XO), 1024}, bl{wc, 1024};
  for_tiles(256, 8, [&](int mi, int ni) {
    gemm_tile(mi * 128, ni * 128, 16, al, bl, [&](f32x4 (&acc)[4][4], int rb, int cb) { epi_resid(p, acc, rb, cb); }, smem);
  });
}

DI void phase_ffn_gu(const Params& p, int l, bf16_t* smem) {
  const bf16_t* W = (const bf16_t*)(p.ws + OFF_W) + (size_t)l * SZ_COMMON + 4 * SZ_SQ;
  PlainLoad al{(const bf16_t*)(p.ws + OFF_HB), 1024}, bl{W, 1024};
  bf16_t* act = (bf16_t*)(p.ws + OFF_ACT);
  for_tiles(256, 44, [&](int mi, int ni) {
    gemm_tile(mi * 128, ni * 128, 16, al, bl, [&](f32x4 (&acc)[4][4], int rb, int cb) {
      const int lane = threadIdx.x & 63, l15 = lane & 15, quad = lane >> 4;
#pragma unroll
      for (int mt = 0; mt < 4; ++mt)
#pragma unroll
        for (int np = 0; np < 2; ++np)
#pragma unroll
          for (int r = 0; r < 4; ++r) {
            float val = siluf_(acc[mt][2 * np][r]) * acc[mt][2 * np + 1][r];
            act[(size_t)(rb + mt * 16 + quad * 4 + r) * 2816 + (cb >> 1) + np * 16 + l15] = f2bf(val);
          }
    }, smem);
  });
}
DI void phase_ffn_down(const Params& p, int l, bf16_t* smem) {
  const bf16_t* W = (const bf16_t*)(p.ws + OFF_W) + (size_t)l * SZ_COMMON + 4 * SZ_SQ + SZ_GU;
  PlainLoad al{(const bf16_t*)(p.ws + OFF_ACT), 2816}, bl{W, 2816};
  for_tiles(256, 8, [&](int mi, int ni) {
    gemm_tile(mi * 128, ni * 128, 44, al, bl, [&](f32x4 (&acc)[4][4], int rb, int cb) { epi_resid(p, acc, rb, cb); }, smem);
  });
}

__global__ void __launch_bounds__(256, 1) fwd_megakernel(Params p) {
  cg::grid_group grid = cg::this_grid();
  __shared__ __attribute__((aligned(16))) char smem_raw[2 * 2 * 128 * LDT * 2];
  bf16_t* sm16 = (bf16_t*)smem_raw; float* sm32 = (float*)smem_raw;

  phase_prologue(p, sm32);
  grid.sync();
  for (int l = 0; l < 4; ++l) {
    const int i = l >> 1;
    if ((l & 1) == 0) {
      phase_proj(p, i, sm16); grid.sync();
      phase_dn_prep(p, i); grid.sync();
      phase_mix(p, i, sm32); grid.sync();
      phase_dn_post(p, i); grid.sync();
      phase_wout(p, i, sm16); grid.sync();
    } else {
      phase_s5_naive(p, i); grid.sync();
      phase_glu(p, i, sm16); grid.sync();
    }
    phase_ln(p, p.ln_mix_g + l * 1024, p.ln_mix_b + l * 1024); grid.sync();
    phase_xproj(p, l, sm16); grid.sync();
#if USE_XATTN_MFMA
    phase_xattn(p); grid.sync();
#else
    phase_xattn_naive(p, sm32); grid.sync();
#endif
    phase_xo(p, l, sm16); grid.sync();
    phase_ln(p, p.ln_x_g + l * 1024, p.ln_x_b + l * 1024); grid.sync();
    phase_ffn_gu(p, l, sm16); grid.sync();
    phase_ffn_down(p, l, sm16); grid.sync();
    phase_ln(p, p.ln_ffn_g + l * 1024, p.ln_ffn_b + l * 1024); grid.sync();
  }
}

extern "C" void kernel_launch(void* const* d_in, const int* in_sizes, int n_in, void* d_out, int out_size, void* d_ws, size_t ws_size,
                              hipStream_t stream) {
  static int grid_blocks = 0;
  if (!grid_blocks) {
    int dev = 0, cus = 0, per_cu = 0;
    hipGetDevice(&dev);
    hipDeviceGetAttribute(&cus, hipDeviceAttributeMultiprocessorCount, dev);
    hipOccupancyMaxActiveBlocksPerMultiprocessor(&per_cu, fwd_megakernel, 256, 0);
    if (per_cu > 2) per_cu = 2;
    if (per_cu < 1) per_cu = 1;
    grid_blocks = cus * per_cu;
    grid_blocks -= grid_blocks % 8;
  }
  Params p{};
  const float** pf = (const float**)&p;
  for (int i = 0; i < 32; ++i) pf[i] = (const float*)d_in[i];
  p.pos = (const int*)d_in[2];
  p.out = (float*)d_out; p.ws = (char*)d_ws;
  void* args[] = {&p};
  hipError_t e = hipLaunchCooperativeKernel((void*)fwd_megakernel, dim3(grid_blocks), dim3(256), args, 0, stream);
  if (e != hipSuccess) fprintf(stderr, "cooperative launch failed: %s (grid %d)\n", hipGetErrorString(e), grid_blocks);
}
```

```cpp
#include <hip/hip_runtime.h>
#include <hip/hip_cooperative_groups.h>
#include <cstdio>
namespace cg = cooperative_groups;
#ifndef USE_XATTN_MFMA
#define USE_XATTN_MFMA 1
#endif
#ifndef USE_S5_GEMM
#define USE_S5_GEMM 1
#endif
#ifndef USE_DIL_MFMA
#define USE_DIL_MFMA 1
#endif

typedef unsigned short bf16_t;
using bf16x8 = __attribute__((ext_vector_type(8))) short;
using f32x4 = __attribute__((ext_vector_type(4))) float;
#define DI __device__ __forceinline__

constexpr int T_ = 32768, S_ = 4096;
constexpr size_t MiB = (size_t)1 << 20;
constexpr size_t SZ_SQ = (size_t)1024 * 1024, SZ_WIN = (size_t)3712 * 1024, SZ_GLU = (size_t)2048 * 1024,
                 SZ_GU = (size_t)5632 * 1024, SZ_WD = (size_t)1024 * 2816;
constexpr size_t SZ_COMMON = 4 * SZ_SQ + SZ_GU + SZ_WD;
constexpr size_t W_EVEN0 = 4 * SZ_COMMON;
constexpr size_t W_ODD0 = W_EVEN0 + 2 * (SZ_WIN + SZ_SQ);
constexpr float ALPHA = 1.681792830507429f;

constexpr size_t OFF_W = 0;
constexpr size_t OFF_ROPE = 125 * MiB;
constexpr size_t OFF_HB = 133 * MiB;
constexpr size_t OFF_KX = 197 * MiB;
constexpr size_t OFF_VX = 201 * MiB;
constexpr size_t OFF_BIG = 205 * MiB;
constexpr size_t OFF_DNQKV = OFF_BIG;
constexpr size_t OFF_Z = OFF_BIG + 96 * MiB;
constexpr size_t OFF_SWQ = OFF_BIG + 128 * MiB;
constexpr size_t OFF_SWK = OFF_BIG + 160 * MiB;
constexpr size_t OFF_SWV = OFF_BIG + 192 * MiB;
constexpr size_t OFF_LOGIT = OFF_BIG + 224 * MiB;
constexpr size_t OFF_QD = OFF_BIG + 225 * MiB;
constexpr size_t OFF_KD = OFF_BIG + 257 * MiB;
constexpr size_t OFF_INTRA = OFF_BIG + 289 * MiB;
constexpr size_t OFF_WB = OFF_HB;
constexpr size_t OFF_UB = OFF_HB + 32 * MiB;
constexpr size_t OFF_EG = OFF_KX;
constexpr size_t OFF_XQ = OFF_BIG;
constexpr size_t OFF_XO = OFF_BIG + 64 * MiB;
constexpr size_t OFF_ACT = OFF_BIG;
constexpr size_t OFF_HID = OFF_BIG;
constexpr size_t OFF_SIN = OFF_BIG + 64 * MiB;
constexpr size_t OFF_KTAB = OFF_BIG + 80 * MiB;
constexpr size_t OFF_ETAB = OFF_BIG + 82 * MiB;
constexpr size_t OFF_GTAB = OFF_BIG + 90 * MiB;
constexpr size_t OFF_AL = OFF_BIG + 98 * MiB;

struct Params {
  const float* x; const float* mem; const int* pos;
  const float* hyb_w_in; const float* dn_conv_w; const float* dn_a_log; const float* dn_dt_bias; const float* dn_norm_g; const float* hyb_w_out;
  const float* s5_a_re; const float* s5_a_im; const float* s5_log_dt; const float* s5_b_re; const float* s5_b_im; const float* s5_c_re; const float* s5_c_im;
  const float* s5_d; const float* s5_glu_wo; const float* s5_glu_wg;
  const float* ln_mix_g; const float* ln_mix_b;
  const float* xq_w; const float* xk_w; const float* xv_w; const float* xo_w; const float* ln_x_g; const float* ln_x_b;
  const float* ffn_wg; const float* ffn_wu; const float* ffn_wd; const float* ln_ffn_g; const float* ln_ffn_b;
  float* out; char* ws;
};

DI int TID() { int t = threadIdx.x; asm volatile("" : "+v"(t)); return t; }
DI int BID() { int t = blockIdx.x; asm volatile("" : "+s"(t)); return t; }
DI int GDIM() { int t = gridDim.x; asm volatile("" : "+s"(t)); return t; }
DI bf16_t f2bf(float x) { unsigned u = __float_as_uint(x); u += 0x7fffu + ((u >> 16) & 1u); return (bf16_t)(u >> 16); }
DI float bf2f(bf16_t v) { return __uint_as_float(((unsigned)v) << 16); }
DI unsigned pack2(float a, float b) { return (unsigned)f2bf(a) | ((unsigned)f2bf(b) << 16); }
using u32x4 = __attribute__((ext_vector_type(4))) unsigned;
using u32x2 = __attribute__((ext_vector_type(2))) unsigned;
DI bf16x8 pack8(f32x4 a, f32x4 b) {
  u32x4 t; t[0] = pack2(a[0], a[1]); t[1] = pack2(a[2], a[3]); t[2] = pack2(b[0], b[1]); t[3] = pack2(b[2], b[3]);
  return __builtin_bit_cast(bf16x8, t);
}
#define MFMA16(a, b, c) __builtin_amdgcn_mfma_f32_16x16x32_bf16((a), (b), (c), 0, 0, 0)
DI float wave_sum(float v) { for (int o = 32; o > 0; o >>= 1) v += __shfl_xor(v, o); return v; }
DI float wave_max(float v) { for (int o = 32; o > 0; o >>= 1) v = fmaxf(v, __shfl_xor(v, o)); return v; }
DI float sigmoidf_(float x) { return 1.f / (1.f + __expf(-x)); }
DI float siluf_(float x) { return x * sigmoidf_(x); }
DI float softplusf_(float x) { return fmaxf(x, 0.f) + log1pf(__expf(-fabsf(x))); }
DI float gelu_tanh(float x) { float u = 0.7978845608028654f * (x + 0.044715f * x * x * x); return 0.5f * x * (1.f + tanhf(u)); }

template <class CM>
DI void transpose_job(bf16_t* dst, int Ndst, int K, int srcStride, CM colptr, float* tile) {
  const int ntk = K / 64, ntiles = (Ndst / 64) * ntk;
  for (int tl = BID(); tl < ntiles; tl += GDIM()) {
    const int r0 = (tl / ntk) * 64, k0 = (tl % ntk) * 64;
    const int rl = TID() & 63, ks = TID() >> 6;
    const float* cp = colptr(r0 + rl);
    for (int i = 0; i < 16; ++i) { int kl = ks * 16 + i; tile[kl * 65 + rl] = cp ? cp[(size_t)(k0 + kl) * srcStride] : 0.f; }
    __syncthreads();
    const int kk = TID() & 63, rs = TID() >> 6;
    for (int i = 0; i < 16; ++i) { int rr = i * 4 + rs; dst[(size_t)(r0 + rr) * K + k0 + kk] = f2bf(tile[kk * 65 + rr]); }
    __syncthreads();
  }
}

DI void phase_prologue(const Params& p, float* smem) {
  bf16_t* W = (bf16_t*)(p.ws + OFF_W);
  for (int l = 0; l < 4; ++l) {
    bf16_t* wc = W + (size_t)l * SZ_COMMON;
    const float* s;
    s = p.xq_w + (size_t)l * SZ_SQ; transpose_job(wc, 1024, 1024, 1024, [=](int r) { return s + r; }, smem);
    s = p.xk_w + (size_t)l * SZ_SQ; transpose_job(wc + SZ_SQ, 1024, 1024, 1024, [=](int r) { return s + r; }, smem);
    s = p.xv_w + (size_t)l * SZ_SQ; transpose_job(wc + 2 * SZ_SQ, 1024, 1024, 1024, [=](int r) { return s + r; }, smem);
    s = p.xo_w + (size_t)l * SZ_SQ; transpose_job(wc + 3 * SZ_SQ, 1024, 1024, 1024, [=](int r) { return s + r; }, smem);
    {
      const float* g = p.ffn_wg + (size_t)l * 1024 * 2816; const float* u = p.ffn_wu + (size_t)l * 1024 * 2816;
      transpose_job(wc + 4 * SZ_SQ, 5632, 1024, 2816, [=](int r) { int c = (r >> 5) * 16 + (r & 15); return ((r >> 4) & 1) ? (u + c) : (g + c); }, smem);
    }
    s = p.ffn_wd + (size_t)l * 2816 * 1024; transpose_job(wc + 4 * SZ_SQ + SZ_GU, 1024, 2816, 1024, [=](int r) { return s + r; }, smem);
  }
  for (int i = 0; i < 2; ++i) {
    bf16_t* we = W + W_EVEN0 + (size_t)i * (SZ_WIN + SZ_SQ);
    const float* s = p.hyb_w_in + (size_t)i * 1024 * 3592;
    transpose_job(we, 3712, 1024, 3592, [=](int r) -> const float* {
      if (r < 2048) return s + r;
      if (r < 3584) return s + r + 8;
      if (r < 3592) return s + 2048 + (r - 3584);
      return nullptr; }, smem);
    const float* s2 = p.hyb_w_out + (size_t)i * SZ_SQ;
    transpose_job(we + SZ_WIN, 1024, 1024, 1024, [=](int r) { return s2 + r; }, smem);
    bf16_t* wo = W + W_ODD0 + (size_t)i * SZ_GLU;
    const float* a = p.s5_glu_wo + (size_t)i * SZ_SQ; const float* b = p.s5_glu_wg + (size_t)i * SZ_SQ;
    transpose_job(wo, 2048, 1024, 1024, [=](int r) { int c = (r >> 5) * 16 + (r & 15); return ((r >> 4) & 1) ? (b + c) : (a + c); }, smem);
  }
  const size_t gtid = (size_t)BID() * 256 + TID(), gsz = (size_t)GDIM() * 256;
  bf16_t* hb = (bf16_t*)(p.ws + OFF_HB);
  for (size_t i = gtid; i < (size_t)T_ * 256; i += gsz) {
    float4 v = ((const float4*)p.x)[i];
    ((float4*)p.out)[i] = v;
    uint2 o; o.x = pack2(v.x, v.y); o.y = pack2(v.z, v.w);
    ((uint2*)hb)[i] = o;
  }
  float* rc = (float*)(p.ws + OFF_ROPE); float* rs = rc + (size_t)T_ * 32;
  for (size_t i = gtid; i < (size_t)T_ * 32; i += gsz) {
    int t = (int)(i >> 5), j = (int)(i & 31);
    float invf = (float)exp(-(double)(2 * j) / 64.0 * 9.210340371976184);
    float ang = (float)p.pos[t] * invf;
    double a = (double)ang;
    double k = rint(a * 0.15915494309189535);
    float r = (float)(a - k * 6.283185307179586);
    rc[i] = cosf(r); rs[i] = sinf(r);
  }
}

constexpr int LDT = 72;
template <class AL, class BL, class EP>
DI void gemm_tile(int m0, int n0, int nks, AL aload, BL bload, EP epi, bf16_t* smem) {
  bf16_t* As = smem; bf16_t* Bs = smem + 2 * 128 * LDT;
  const int tid = TID(), lane = tid & 63, wave = tid >> 6;
  const int wm = wave >> 1, wn = wave & 1, l15 = lane & 15, quad = lane >> 4;
  const int lrow = tid >> 3, lkc = (tid & 7) * 8;
  f32x4 acc[4][4];
#pragma unroll
  for (int i = 0; i < 4; ++i)
#pragma unroll
    for (int j = 0; j < 4; ++j) acc[i][j] = f32x4{0.f, 0.f, 0.f, 0.f};
  uint4 ra[4], rb[4];
#pragma unroll
  for (int i = 0; i < 4; ++i) { ra[i] = aload(m0 + lrow + 32 * i, 0, lkc); rb[i] = bload(n0 + lrow + 32 * i, 0, lkc); }
#pragma unroll
  for (int i = 0; i < 4; ++i) {
    *(uint4*)(As + (lrow + 32 * i) * LDT + lkc) = ra[i];
    *(uint4*)(Bs + (lrow + 32 * i) * LDT + lkc) = rb[i];
  }
  __syncthreads();
  for (int ks = 0; ks < nks; ++ks) {
    const int cur = ks & 1;
    const bool more = (ks + 1 < nks);
    if (more) {
#pragma unroll
      for (int i = 0; i < 4; ++i) { ra[i] = aload(m0 + lrow + 32 * i, ks + 1, lkc); rb[i] = bload(n0 + lrow + 32 * i, ks + 1, lkc); }
    }
    const bf16_t* Ab = As + cur * 128 * LDT; const bf16_t* Bb = Bs + cur * 128 * LDT;
#pragma unroll
    for (int kk = 0; kk < 2; ++kk) {
      bf16x8 a[4], b[4];
#pragma unroll
      for (int mt = 0; mt < 4; ++mt) a[mt] = *(const bf16x8*)(Ab + (wm * 64 + mt * 16 + l15) * LDT + kk * 32 + quad * 8);
#pragma unroll
      for (int nt = 0; nt < 4; ++nt) b[nt] = *(const bf16x8*)(Bb + (wn * 64 + nt * 16 + l15) * LDT + kk * 32 + quad * 8);
#pragma unroll
      for (int mt = 0; mt < 4; ++mt)
#pragma unroll
        for (int nt = 0; nt < 4; ++nt) acc[mt][nt] = __builtin_amdgcn_mfma_f32_16x16x32_bf16(a[mt], b[nt], acc[mt][nt], 0, 0, 0);
    }
    if (more) {
      bf16_t* An = As + (cur ^ 1) * 128 * LDT; bf16_t* Bn = Bs + (cur ^ 1) * 128 * LDT;
#pragma unroll
      for (int i = 0; i < 4; ++i) {
        *(uint4*)(An + (lrow + 32 * i) * LDT + lkc) = ra[i];
        *(uint4*)(Bn + (lrow + 32 * i) * LDT + lkc) = rb[i];
      }
    }
    __syncthreads();
  }
  epi(acc, m0 + wm * 64, n0 + wn * 64);
}

template <class F>
DI void for_tiles(int mtiles, int ntiles, F f) {
  const int xcd = BID() & 7, slot = BID() >> 3, nslot = GDIM() >> 3;
  const int per = (mtiles >> 3) * ntiles;
  for (int w = slot; w < per; w += nslot) {
    int mi = w / ntiles, ni = w - mi * ntiles;
    f((mi * 8 + xcd), ni);
  }
}

#define EPI_LOOP for (int mt = 0; mt < 4; ++mt) for (int nt = 0; nt < 4; ++nt) for (int r = 0; r < 4; ++r)

DI void epi_resid(const Params& p, f32x4 (&acc)[4][4], int rb, int cb) {
  const int lane = TID() & 63, l15 = lane & 15, quad = lane >> 4;
#pragma unroll
  for (int mt = 0; mt < 4; ++mt)
#pragma unroll
    for (int nt = 0; nt < 4; ++nt)
#pragma unroll
      for (int r = 0; r < 4; ++r) {
        size_t idx = (size_t)(rb + mt * 16 + quad * 4 + r) * 1024 + cb + nt * 16 + l15;
        p.out[idx] = ALPHA * p.out[idx] + acc[mt][nt][r];
      }
}
DI void epi_bf16(bf16_t* dst, int ld, f32x4 (&acc)[4][4], int rb, int cb) {
  const int lane = TID() & 63, l15 = lane & 15, quad = lane >> 4;
#pragma unroll
  for (int mt = 0; mt < 4; ++mt)
#pragma unroll
    for (int nt = 0; nt < 4; ++nt)
#pragma unroll
      for (int r = 0; r < 4; ++r)
        dst[(size_t)(rb + mt * 16 + quad * 4 + r) * ld + cb + nt * 16 + l15] = f2bf(acc[mt][nt][r]);
}

struct PlainLoad {
  const bf16_t* base; int ld;
  DI uint4 operator()(int row, int ks, int kc) const { return *(const uint4*)(base + (size_t)row * ld + ks * 64 + kc); }
};

DI void phase_proj(const Params& p, int i, bf16_t* smem) {
  const bf16_t* W = (const bf16_t*)(p.ws + OFF_W) + W_EVEN0 + (size_t)i * (SZ_WIN + SZ_SQ);
  PlainLoad al{(const bf16_t*)(p.ws + OFF_HB), 1024}, bl{W, 1024};
  bf16_t* dnqkv = (bf16_t*)(p.ws + OFF_DNQKV); bf16_t* z = (bf16_t*)(p.ws + OFF_Z);
  bf16_t* swq = (bf16_t*)(p.ws + OFF_SWQ); bf16_t* swk = (bf16_t*)(p.ws + OFF_SWK); bf16_t* swv = (bf16_t*)(p.ws + OFF_SWV);
  float* logit = (float*)(p.ws + OFF_LOGIT);
  const float* rc = (const float*)(p.ws + OFF_ROPE); const float* rs = rc + (size_t)T_ * 32;
  for_tiles(256, 29, [&](int mi, int ni) {
    gemm_tile(mi * 128, ni * 128, 16, al, bl, [&](f32x4 (&acc)[4][4], int rb, int cb) {
      const int lane = TID() & 63, l15 = lane & 15, quad = lane >> 4;
      if (cb < 1536) epi_bf16(dnqkv, 1536, acc, rb, cb);
      else if (cb < 2048) epi_bf16(z, 512, acc, rb, cb - 1536);
      else if (cb < 3072) {
        bf16_t* dst = (cb < 2560) ? swq : swk; const int c0 = (cb < 2560) ? cb - 2048 : cb - 2560;
#pragma unroll
        for (int mt = 0; mt < 4; ++mt)
#pragma unroll
          for (int r = 0; r < 4; ++r) {
            const int row = rb + mt * 16 + quad * 4 + r;
#pragma unroll
            for (int nt = 0; nt < 2; ++nt) {
              const int d = nt * 16 + l15;
              float c = rc[(size_t)row * 32 + d], s = rs[(size_t)row * 32 + d];
              float x1 = acc[mt][nt][r], x2 = acc[mt][nt + 2][r];
              dst[(size_t)row * 512 + c0 + d] = f2bf(x1 * c - x2 * s);
              dst[(size_t)row * 512 + c0 + d + 32] = f2bf(x2 * c + x1 * s);
            }
          }
      } else if (cb < 3584) epi_bf16(swv, 512, acc, rb, cb - 3072);
      else if (cb == 3584) {
#pragma unroll
        for (int mt = 0; mt < 4; ++mt)
#pragma unroll
          for (int r = 0; r < 4; ++r)
            if (l15 < 8) logit[(size_t)(rb + mt * 16 + quad * 4 + r) * 8 + l15] = acc[mt][0][r];
      }
    }, smem);
  });
}

DI void phase_dil_attn(const Params& p, int first, int nblk);

DI void phase_dn_prep(const Params& p, int i, char* smem) {
  bf16_t* qs = (bf16_t*)smem; bf16_t* ks = qs + 64 * 136; bf16_t* vs = ks + 64 * 136;
  float* Lm = (float*)(smem + 3 * 17408); float* beta = Lm + 64 * 68; float* gcum = beta + 64; float* egc = gcum + 64;
  const bf16_t* dnqkv = (const bf16_t*)(p.ws + OFF_DNQKV);
  const float* logit = (const float*)(p.ws + OFF_LOGIT);
  bf16_t* qd_g = (bf16_t*)(p.ws + OFF_QD); bf16_t* kd_g = (bf16_t*)(p.ws + OFF_KD); bf16_t* in_g = (bf16_t*)(p.ws + OFF_INTRA);
  bf16_t* w_g = (bf16_t*)(p.ws + OFF_WB); bf16_t* u_g = (bf16_t*)(p.ws + OFF_UB); float* eg_g = (float*)(p.ws + OFF_EG);
  const float* cw = p.dn_conv_w + (size_t)i * 4 * 1536;
  const int tid = TID(), wave = tid >> 6, lane = tid & 63, l15 = lane & 15, quad = lane >> 4;
  const float QS = 0.08838834764831845f;
  for (int item = BID(); item < 2048; item += GDIM()) {
    const int b = item >> 8, h = (item >> 6) & 3, n = item & 63;
    const int t0 = b * 4096 + n * 64, s0 = n * 64;
    const float A = __expf(p.dn_a_log[i * 4 + h]), dtb = p.dn_dt_bias[i * 4 + h];
    for (int tt = 0; tt < 16; ++tt) {
      const int il = tt * 4 + wave, t = t0 + il, sq = s0 + il;
#pragma unroll
      for (int which = 0; which < 3; ++which) {
        const int col = which * 512 + h * 128 + lane * 2;
        float y0 = 0.f, y1 = 0.f;
#pragma unroll
        for (int j = 0; j < 4; ++j) {
          if (sq - 3 + j >= 0) {
            unsigned v = *(const unsigned*)(dnqkv + (size_t)(t - 3 + j) * 1536 + col);
            y0 += cw[j * 1536 + col] * bf2f((bf16_t)(v & 0xffff));
            y1 += cw[j * 1536 + col + 1] * bf2f((bf16_t)(v >> 16));
          }
        }
        y0 = siluf_(y0); y1 = siluf_(y1);
        if (which < 2) {
          float ss = wave_sum(y0 * y0 + y1 * y1);
          float sc = rsqrtf(ss + 1e-6f);
          y0 *= sc; y1 *= sc;
        }
        bf16_t* dst = (which == 0) ? qs : (which == 1 ? ks : vs);
        *(unsigned*)(dst + il * 136 + lane * 2) = pack2(y0, y1);
      }
    }
    if (wave == 0) {
      const size_t row = (size_t)(t0 + lane);
      const float bl = logit[row * 8 + h], al = logit[row * 8 + 4 + h];
      float g = -A * softplusf_(al + dtb);
#pragma unroll
      for (int o = 1; o < 64; o <<= 1) { float v = __shfl_up(g, o); if (lane >= o) g += v; }
      beta[lane] = sigmoidf_(bl); gcum[lane] = g; egc[lane] = __expf(g);
    }
    __syncthreads();
    {
      f32x4 kk[4], qk[4];
#pragma unroll
      for (int nt = 0; nt < 4; ++nt) { kk[nt] = f32x4{0.f, 0.f, 0.f, 0.f}; qk[nt] = f32x4{0.f, 0.f, 0.f, 0.f}; }
#pragma unroll
      for (int k4 = 0; k4 < 4; ++k4) {
        const bf16x8 ak = *(const bf16x8*)(ks + (wave * 16 + l15) * 136 + k4 * 32 + quad * 8);
        const bf16x8 aq = *(const bf16x8*)(qs + (wave * 16 + l15) * 136 + k4 * 32 + quad * 8);
#pragma unroll
        for (int nt = 0; nt < 4; ++nt) {
          const bf16x8 bk = *(const bf16x8*)(ks + (nt * 16 + l15) * 136 + k4 * 32 + quad * 8);
          kk[nt] = MFMA16(ak, bk, kk[nt]); qk[nt] = MFMA16(aq, bk, qk[nt]);
        }
      }
#pragma unroll
      for (int nt = 0; nt < 4; ++nt)
#pragma unroll
        for (int r = 0; r < 4; ++r) {
          const int ii = wave * 16 + quad * 4 + r, jj = nt * 16 + l15;
          const float dec = (jj <= ii) ? __expf(gcum[ii] - gcum[jj]) : 0.f;
          Lm[ii * 68 + jj] = (jj < ii) ? beta[ii] * kk[nt][r] * dec : 0.f;
          in_g[(size_t)item * 4096 + ii * 64 + jj] = f2bf(qk[nt][r] * QS * dec);
        }
    }
    __syncthreads();
    {
      float x[64];
#pragma unroll
      for (int ii = 0; ii < 64; ++ii) x[ii] = 0.f;
      const int c = tid & 127;
      const bool isw = tid >= 128;
      bf16_t* dstb = (isw ? w_g : u_g) + (size_t)item * 8192 + c;
      const bf16_t* srcb = (isw ? ks : vs) + c;
#pragma unroll
      for (int ii = 0; ii < 64; ++ii) {
        float acc = bf2f(srcb[ii * 136]) * beta[ii] * (isw ? egc[ii] : 1.f);
#pragma unroll
        for (int j4 = 0; j4 < (ii + 3) / 4; ++j4) {
          const float4 l4 = *(const float4*)(Lm + ii * 68 + j4 * 4);
          acc -= l4.x * x[j4 * 4]; acc -= l4.y * x[j4 * 4 + 1]; acc -= l4.z * x[j4 * 4 + 2]; acc -= l4.w * x[j4 * 4 + 3];
        }
        x[ii] = acc;
        dstb[ii * 128] = f2bf(acc);
        if ((ii & 3) == 3) __builtin_amdgcn_sched_barrier(0);
      }
    }
    {
      const float gl = gcum[63];
#pragma unroll 4
      for (int k = 0; k < 32; ++k) {
        const int e = tid + 256 * k;
        const int ii = e >> 7, d = e & 127;
        qd_g[(size_t)item * 8192 + e] = f2bf(bf2f(qs[ii * 136 + d]) * QS * egc[ii]);
        const int d2 = e >> 6, i2 = e & 63;
        kd_g[(size_t)item * 8192 + e] = f2bf(bf2f(ks[i2 * 136 + d2]) * __expf(gl - gcum[i2]));
      }
      if (tid == 0) eg_g[item] = __expf(gl);
    }
    __syncthreads();
  }
}

DI bf16x8 ld2(const bf16_t* ptr) {
  u32x2 lo = *(const u32x2*)ptr, hi = *(const u32x2*)(ptr + 16);
  u32x4 t; t[0] = lo[0]; t[1] = lo[1]; t[2] = hi[0]; t[3] = hi[1];
  return __builtin_bit_cast(bf16x8, t);
}

DI void dn_chain_item(const Params& p, int item) {
  const int tid = TID(), wave = tid >> 6, lane = tid & 63, l15 = lane & 15, quad = lane >> 4;
  const int bh = item >> 1, half = item & 1;
  const int e0 = half * 64 + wave * 16 + l15;
  const bf16_t* qd_g = (const bf16_t*)(p.ws + OFF_QD); const bf16_t* kd_g = (const bf16_t*)(p.ws + OFF_KD); const bf16_t* in_g = (const bf16_t*)(p.ws + OFF_INTRA);
  const bf16_t* w_g = (const bf16_t*)(p.ws + OFF_WB); bf16_t* u_g = (bf16_t*)(p.ws + OFF_UB); const float* eg_g = (const float*)(p.ws + OFF_EG);
  f32x4 S[8];
#pragma unroll
  for (int mt = 0; mt < 8; ++mt) S[mt] = f32x4{0.f, 0.f, 0.f, 0.f};
#pragma unroll 1
  for (int n = 0; n < 64; ++n) {
    const size_t ci = (size_t)bh * 64 + n;
    const bf16_t* wq = w_g + ci * 8192; const bf16_t* qd = qd_g + ci * 8192; const bf16_t* kd = kd_g + ci * 8192; const bf16_t* in = in_g + ci * 4096;
    bf16_t* ub = u_g + ci * 8192;
    const float eg = eg_g[ci];
    bf16x8 sb[4];
#pragma unroll
    for (int s = 0; s < 4; ++s) sb[s] = pack8(S[2 * s], S[2 * s + 1]);
    f32x4 vn[4];
#pragma unroll
    for (int it = 0; it < 4; ++it) {
      f32x4 a = {0.f, 0.f, 0.f, 0.f};
#pragma unroll
      for (int s = 0; s < 4; ++s) a = MFMA16(ld2(wq + (it * 16 + l15) * 128 + s * 32 + quad * 4), sb[s], a);
#pragma unroll
      for (int r = 0; r < 4; ++r) vn[it][r] = bf2f(ub[(it * 16 + quad * 4 + r) * 128 + e0]) - a[r];
    }
    bf16x8 vb[2];
    vb[0] = pack8(vn[0], vn[1]); vb[1] = pack8(vn[2], vn[3]);
#pragma unroll
    for (int it = 0; it < 4; ++it) {
      f32x4 a = {0.f, 0.f, 0.f, 0.f};
#pragma unroll
      for (int s = 0; s < 4; ++s) a = MFMA16(ld2(qd + (it * 16 + l15) * 128 + s * 32 + quad * 4), sb[s], a);
#pragma unroll
      for (int s = 0; s < 2; ++s) a = MFMA16(ld2(in + (it * 16 + l15) * 64 + s * 32 + quad * 4), vb[s], a);
#pragma unroll
      for (int r = 0; r < 4; ++r) ub[(it * 16 + quad * 4 + r) * 128 + e0] = f2bf(a[r]);
    }
#pragma unroll
    for (int mt = 0; mt < 8; ++mt) {
      f32x4 a = S[mt];
      a[0] *= eg; a[1] *= eg; a[2] *= eg; a[3] *= eg;
#pragma unroll
      for (int s = 0; s < 2; ++s) a = MFMA16(ld2(kd + (mt * 16 + l15) * 64 + s * 32 + quad * 4), vb[s], a);
      S[mt] = a;
    }
  }
}

DI void phase_mix(const Params& p, int i) {
  if (BID() < 64) { dn_chain_item(p, BID()); return; }
  phase_dil_attn(p, BID() - 64, GDIM() - 64);
}

DI void phase_dn_post(const Params& p, int i) {
  const bf16_t* ob = (const bf16_t*)(p.ws + OFF_UB);
  bf16_t* z = (bf16_t*)(p.ws + OFF_Z);
  const float* ng = p.dn_norm_g + i * 128;
  const int wave = TID() >> 6, lane = TID() & 63;
  const int N = T_ * 4;
  for (int base = BID() * 4; base < N; base += GDIM() * 4) {
    const int item = base + wave;
    const int t = item >> 2, h = item & 3, b = t >> 12, sidx = t & 4095;
    const size_t g = (size_t)item * 128 + lane * 2;
    const size_t og = ((size_t)((b * 4 + h) * 64 + (sidx >> 6))) * 8192 + (sidx & 63) * 128 + lane * 2;
    unsigned ov = *(const unsigned*)(ob + og), zv = *(const unsigned*)(z + g);
    float o0 = bf2f((bf16_t)(ov & 0xffff)), o1 = bf2f((bf16_t)(ov >> 16));
    float z0 = bf2f((bf16_t)(zv & 0xffff)), z1 = bf2f((bf16_t)(zv >> 16));
    float ms = wave_sum(o0 * o0 + o1 * o1) * (1.f / 128.f);
    float rr = rsqrtf(ms + 1e-6f);
    float r0 = o0 * rr * ng[lane * 2] * siluf_(z0), r1 = o1 * rr * ng[lane * 2 + 1] * siluf_(z1);
    *(unsigned*)(z + g) = pack2(r0, r1);
  }
}

struct MixLoad {
  const bf16_t* a; const bf16_t* b;
  DI uint4 operator()(int row, int ks, int kc) const {
    return (ks < 8) ? *(const uint4*)(a + (size_t)row * 512 + ks * 64 + kc) : *(const uint4*)(b + (size_t)row * 512 + (ks - 8) * 64 + kc);
  }
};

DI void phase_wout(const Params& p, int i, bf16_t* smem) {
  const bf16_t* W = (const bf16_t*)(p.ws + OFF_W) + W_EVEN0 + (size_t)i * (SZ_WIN + SZ_SQ) + SZ_WIN;
  MixLoad al{(const bf16_t*)(p.ws + OFF_Z), (const bf16_t*)(p.ws + OFF_SWQ)};
  PlainLoad bl{W, 1024};
  for_tiles(256, 8, [&](int mi, int ni) {
    gemm_tile(mi * 128, ni * 128, 16, al, bl, [&](f32x4 (&acc)[4][4], int rb, int cb) { epi_resid(p, acc, rb, cb); }, smem);
  });
}

DI void phase_ln(const Params& p, const float* g, const float* b) {
  const int wave = TID() >> 6, lane = TID() & 63;
  bf16_t* hb = (bf16_t*)(p.ws + OFF_HB);
  for (int row = BID() * 4 + wave; row < T_; row += GDIM() * 4) {
    float4* y = (float4*)(p.out + (size_t)row * 1024);
    float4 v[4];
    float s = 0.f;
#pragma unroll
    for (int i = 0; i < 4; ++i) { v[i] = y[lane + 64 * i]; s += v[i].x + v[i].y + v[i].z + v[i].w; }
    const float mu = wave_sum(s) * (1.f / 1024.f);
    float q = 0.f;
#pragma unroll
    for (int i = 0; i < 4; ++i) { float a = v[i].x - mu, b2 = v[i].y - mu, c = v[i].z - mu, d = v[i].w - mu; q += a * a + b2 * b2 + c * c + d * d; }
    const float rstd = rsqrtf(wave_sum(q) * (1.f / 1024.f) + 1e-5f);
#pragma unroll
    for (int i = 0; i < 4; ++i) {
      float4 gg = ((const float4*)g)[lane + 64 * i], bb = ((const float4*)b)[lane + 64 * i];
      float4 o;
      o.x = (v[i].x - mu) * rstd * gg.x + bb.x; o.y = (v[i].y - mu) * rstd * gg.y + bb.y;
      o.z = (v[i].z - mu) * rstd * gg.z + bb.z; o.w = (v[i].w - mu) * rstd * gg.w + bb.w;
      y[lane + 64 * i] = o;
      uint2 ob; ob.x = pack2(o.x, o.y); ob.y = pack2(o.z, o.w);
      ((uint2*)(hb + (size_t)row * 1024))[lane + 64 * i] = ob;
    }
  }
}

DI void phase_s5_naive(const Params& p, int i) {
  const int wave = TID() >> 6, lane = TID() & 63;
  bf16_t* hid = (bf16_t*)(p.ws + OFF_HID);
  for (int base = BID() * 4; base < 512; base += GDIM() * 4) {
    const int item = base + wave, b = item >> 6, g = item & 63;
    const int gp = (i * 64 + g) * 64 + lane;
    const double dt = exp((double)p.s5_log_dt[i * 64 + g]);
    const double are = p.s5_a_re[gp], aim = p.s5_a_im[gp];
    const double lr = are * dt, li = aim * dt;
    const double kk = rint(li * 0.15915494309189535);
    const double red = li - kk * 6.283185307179586;
    const double e = exp(lr);
    const double abr = e * cos(red), abi = e * sin(red);
    const double den = are * are + aim * aim;
    const double nr = abr - 1.0, ni = abi;
    const double cfr = (nr * are + ni * aim) / den, cfi = (ni * are - nr * aim) / den;
    float bbr[16], bbi[16], cr[16], ci[16];
#pragma unroll
    for (int h = 0; h < 16; ++h) {
      const double br = p.s5_b_re[(size_t)gp * 16 + h], bi = p.s5_b_im[(size_t)gp * 16 + h];
      bbr[h] = (float)(cfr * br - cfi * bi); bbi[h] = (float)(cfr * bi + cfi * br);
      cr[h] = p.s5_c_re[((size_t)(i * 64 + g) * 16 + h) * 64 + lane];
      ci[h] = p.s5_c_im[((size_t)(i * 64 + g) * 16 + h) * 64 + lane];
    }
    const float ar = (float)abr, ai = (float)abi;
    const float dsk = p.s5_d[i * 1024 + g * 16 + (lane & 15)];
    float sr = 0.f, si = 0.f;
#pragma unroll 1
    for (int t = 0; t < S_; ++t) {
      const size_t row = (size_t)(b * S_ + t);
      const float4* up = (const float4*)(p.out + row * 1024 + g * 16);
      float u[16];
#pragma unroll
      for (int j = 0; j < 4; ++j) { float4 v = up[j]; u[4 * j] = v.x; u[4 * j + 1] = v.y; u[4 * j + 2] = v.z; u[4 * j + 3] = v.w; }
      float bur = 0.f, bui = 0.f;
#pragma unroll
      for (int h = 0; h < 16; ++h) { bur += bbr[h] * u[h]; bui += bbi[h] * u[h]; }
      const float nsr = ar * sr - ai * si + bur, nsi = ar * si + ai * sr + bui;
      sr = nsr; si = nsi;
      float yk = 0.f, uk = 0.f;
#pragma unroll
      for (int h = 0; h < 16; ++h) {
        float v = wave_sum(cr[h] * sr - ci[h] * si);
        if (lane == h) { yk = v; uk = u[h]; }
      }
      if (lane < 16) hid[row * 1024 + g * 16 + lane] = f2bf(gelu_tanh(yk + dsk * uk));
    }
  }
}

DI void phase_s5_tables(const Params& p, int i, float* smem) {
  float2* pw = (float2*)smem;
  float2* bb = pw + 64 * 33;
  float2* cc = bb + 64 * 16;
  bf16_t* Ktab = (bf16_t*)(p.ws + OFF_KTAB); bf16_t* Etab = (bf16_t*)(p.ws + OFF_ETAB); bf16_t* Gtab = (bf16_t*)(p.ws + OFF_GTAB);
  float2* AL = (float2*)(p.ws + OFF_AL);
  const int tid = TID();
  for (int g = BID(); g < 64; g += GDIM()) {
    const double dt = exp((double)p.s5_log_dt[i * 64 + g]);
    for (int e = tid; e < 64 * 33; e += 256) {
      const int pp = e / 33, n = e - pp * 33;
      const double are = p.s5_a_re[(i * 64 + g) * 64 + pp], aim = p.s5_a_im[(i * 64 + g) * 64 + pp];
      const double lr = are * dt * n, li = aim * dt * n;
      const double k = rint(li * 0.15915494309189535);
      const double red = li - k * 6.283185307179586;
      const double ex = exp(lr);
      pw[e] = make_float2((float)(ex * cos(red)), (float)(ex * sin(red)));
    }
    for (int e = tid; e < 1024; e += 256) {
      const int pp = e >> 4;
      const int gp = (i * 64 + g) * 64 + pp;
      const double are = p.s5_a_re[gp], aim = p.s5_a_im[gp];
      const double lr = are * dt, li = aim * dt;
      const double k = rint(li * 0.15915494309189535);
      const double red = li - k * 6.283185307179586;
      const double ex = exp(lr);
      const double nr = ex * cos(red) - 1.0, ni = ex * sin(red);
      const double den = are * are + aim * aim;
      const double cfr = (nr * are + ni * aim) / den, cfi = (ni * are - nr * aim) / den;
      const double br = p.s5_b_re[(size_t)gp * 16 + (e & 15)], bi = p.s5_b_im[(size_t)gp * 16 + (e & 15)];
      bb[e] = make_float2((float)(cfr * br - cfi * bi), (float)(cfr * bi + cfi * br));
      const size_t ci = ((size_t)(i * 64 + g) * 16 + (e >> 6)) * 64 + (e & 63);
      cc[e] = make_float2(p.s5_c_re[ci], p.s5_c_im[ci]);
    }
    __syncthreads();
    for (int e = tid; e < 8192; e += 256) {
      const int tau = e >> 8, ho = (e >> 4) & 15, hi = e & 15;
      float acc = 0.f;
      for (int pp = 0; pp < 64; ++pp) {
        const float2 c = cc[ho * 64 + pp], w = pw[pp * 33 + tau], b = bb[pp * 16 + hi];
        const float cwr = c.x * w.x - c.y * w.y, cwi = c.x * w.y + c.y * w.x;
        acc += cwr * b.x - cwi * b.y;
      }
      Ktab[(size_t)g * 8192 + e] = f2bf(acc);
    }
    for (int e = tid; e < 65536; e += 256) {
      const int pc = e >> 9, sidx = (e >> 4) & 31, hi = e & 15, pp = pc & 63;
      const float2 w = pw[pp * 33 + 31 - sidx], b = bb[pp * 16 + hi];
      const float v = (pc < 64) ? (w.x * b.x - w.y * b.y) : (w.x * b.y + w.y * b.x);
      Etab[(size_t)g * 65536 + e] = f2bf(v);
    }
    for (int e = tid; e < 65536; e += 256) {
      const int row = e >> 7, pc = e & 127, pp = pc & 63, t = row >> 4, ho = row & 15;
      const float2 c = cc[ho * 64 + pp], w = pw[pp * 33 + t + 1];
      const float v = (pc < 64) ? (c.x * w.x - c.y * w.y) : -(c.x * w.y + c.y * w.x);
      Gtab[(size_t)g * 65536 + e] = f2bf(v);
    }
    if (tid < 64) AL[g * 64 + tid] = pw[tid * 33 + 32];
    __syncthreads();
  }
}

DI void phase_s5_end(const Params& p, bf16_t* smem) {
  const bf16_t* Etab = (const bf16_t*)(p.ws + OFF_ETAB); const bf16_t* hb = (const bf16_t*)(p.ws + OFF_HB);
  const float2* AL = (const float2*)(p.ws + OFF_AL);
  bf16_t* sin_ = (bf16_t*)(p.ws + OFF_SIN);
  float* endbuf = (float*)smem;
  for (int item = BID(); item < 512; item += GDIM()) {
    const int g = item >> 3, b = item & 7;
    auto al = [=](int row, int ks, int kc) { return *(const uint4*)(Etab + ((size_t)g * 128 + row) * 512 + ks * 64 + kc); };
    auto bl = [=](int n, int ks, int kc) {
      const int k = ks * 64 + kc, sidx = k >> 4, hi0 = k & 15;
      return *(const uint4*)(hb + ((size_t)(b * 4096 + n * 32 + sidx)) * 1024 + g * 16 + hi0);
    };
    gemm_tile(0, 0, 8, al, bl, [&](f32x4 (&acc)[4][4], int rb, int cb) {
      const int lane = TID() & 63, l15 = lane & 15, quad = lane >> 4;
#pragma unroll
      for (int mt = 0; mt < 4; ++mt)
#pragma unroll
        for (int nt = 0; nt < 4; ++nt)
#pragma unroll
          for (int r = 0; r < 4; ++r) endbuf[(rb + mt * 16 + quad * 4 + r) * 129 + cb + nt * 16 + l15] = acc[mt][nt][r];
    }, smem);
    __syncthreads();
    if (TID() < 64) {
      const int pp = TID();
      const float2 a = AL[g * 64 + pp];
      float sr = 0.f, si = 0.f;
      for (int n = 0; n < 128; ++n) {
        bf16_t* dst = sin_ + ((size_t)g * 1024 + b * 128 + n) * 128;
        dst[pp] = f2bf(sr); dst[64 + pp] = f2bf(si);
        const float er = endbuf[pp * 129 + n], ei = endbuf[(64 + pp) * 129 + n];
        const float nr = a.x * sr - a.y * si + er, ni = a.x * si + a.y * sr + ei;
        sr = nr; si = ni;
      }
    }
    __syncthreads();
  }
}

DI void phase_s5_y(const Params& p, int i, bf16_t* smem) {
  const bf16_t* Ktab = (const bf16_t*)(p.ws + OFF_KTAB); const bf16_t* Gtab = (const bf16_t*)(p.ws + OFF_GTAB);
  const bf16_t* hb = (const bf16_t*)(p.ws + OFF_HB); const bf16_t* sin_ = (const bf16_t*)(p.ws + OFF_SIN);
  bf16_t* hid = (bf16_t*)(p.ws + OFF_HID);
  for (int w = BID(); w < 2048; w += GDIM()) {
    const int g = w >> 5, mtile = (w >> 3) & 3, b = w & 7;
    const int nT = mtile * 2 + 2;
    auto al = [=](int row, int ks, int kc) -> uint4 {
      if (ks < nT) {
        const int k = ks * 64 + kc, sidx = k >> 4, hi0 = k & 15, t = row >> 4, ho = row & 15;
        if (t >= sidx) return *(const uint4*)(Ktab + (((size_t)g * 32 + (t - sidx)) * 16 + ho) * 16 + hi0);
        return make_uint4(0, 0, 0, 0);
      }
      return *(const uint4*)(Gtab + ((size_t)g * 512 + row) * 128 + (ks - nT) * 64 + kc);
    };
    auto bl = [=](int n, int ks, int kc) -> uint4 {
      if (ks < nT) {
        const int k = ks * 64 + kc, sidx = k >> 4, hi0 = k & 15;
        return *(const uint4*)(hb + ((size_t)(b * 4096 + n * 32 + sidx)) * 1024 + g * 16 + hi0);
      }
      return *(const uint4*)(sin_ + ((size_t)g * 1024 + b * 128 + n) * 128 + (ks - nT) * 64 + kc);
    };
    gemm_tile(mtile * 128, 0, nT + 2, al, bl, [&](f32x4 (&acc)[4][4], int rb, int cb) {
      const int lane = TID() & 63, l15 = lane & 15, quad = lane >> 4;
      const float4 dsk = *(const float4*)(p.s5_d + i * 1024 + g * 16 + quad * 4);
#pragma unroll
      for (int mt = 0; mt < 4; ++mt)
#pragma unroll
        for (int nt = 0; nt < 4; ++nt) {
          const int t = (rb + mt * 16) >> 4, n = cb + nt * 16 + l15;
          const size_t tok = (size_t)b * 4096 + n * 32 + t;
          const float4 u = *(const float4*)(p.out + tok * 1024 + g * 16 + quad * 4);
          u32x2 v;
          v[0] = pack2(gelu_tanh(acc[mt][nt][0] + dsk.x * u.x), gelu_tanh(acc[mt][nt][1] + dsk.y * u.y));
          v[1] = pack2(gelu_tanh(acc[mt][nt][2] + dsk.z * u.z), gelu_tanh(acc[mt][nt][3] + dsk.w * u.w));
          *(u32x2*)(hid + tok * 1024 + g * 16 + quad * 4) = v;
        }
    }, smem);
  }
}

DI void phase_glu(const Params& p, int i, bf16_t* smem) {
  const bf16_t* W = (const bf16_t*)(p.ws + OFF_W) + W_ODD0 + (size_t)i * SZ_GLU;
  PlainLoad al{(const bf16_t*)(p.ws + OFF_HID), 1024}, bl{W, 1024};
  for_tiles(256, 16, [&](int mi, int ni) {
    gemm_tile(mi * 128, ni * 128, 16, al, bl, [&](f32x4 (&acc)[4][4], int rb, int cb) {
      const int lane = TID() & 63, l15 = lane & 15, quad = lane >> 4;
#pragma unroll
      for (int mt = 0; mt < 4; ++mt)
#pragma unroll
        for (int np = 0; np < 2; ++np)
#pragma unroll
          for (int r = 0; r < 4; ++r) {
            float val = acc[mt][2 * np][r] * sigmoidf_(acc[mt][2 * np + 1][r]);
            size_t idx = (size_t)(rb + mt * 16 + quad * 4 + r) * 1024 + (cb >> 1) + np * 16 + l15;
            p.out[idx] = ALPHA * p.out[idx] + val;
          }
    }, smem);
  });
}

DI void phase_xproj(const Params& p, int l, bf16_t* smem) {
  const bf16_t* wc = (const bf16_t*)(p.ws + OFF_W) + (size_t)l * SZ_COMMON;
  {
    PlainLoad al{(const bf16_t*)(p.ws + OFF_HB), 1024}, bl{wc, 1024};
    bf16_t* q = (bf16_t*)(p.ws + OFF_XQ);
    for_tiles(256, 8, [&](int mi, int ni) {
      gemm_tile(mi * 128, ni * 128, 16, al, bl, [&](f32x4 (&acc)[4][4], int rb, int cb) { epi_bf16(q, 1024, acc, rb, cb); }, smem);
    });
  }
  {
    const float* memf = p.mem;
    auto al = [=](int row, int ks, int kc) -> uint4 {
      const float4* src = (const float4*)(memf + (size_t)row * 1024 + ks * 64 + kc);
      float4 a = src[0], b2 = src[1];
      return make_uint4(pack2(a.x, a.y), pack2(a.z, a.w), pack2(b2.x, b2.y), pack2(b2.z, b2.w));
    };
    bf16_t* kx = (bf16_t*)(p.ws + OFF_KX); bf16_t* vx = (bf16_t*)(p.ws + OFF_VX);
    for_tiles(16, 16, [&](int mi, int ni) {
      const bool isv = ni >= 8;
      PlainLoad bl{isv ? (wc + 2 * SZ_SQ) : (wc + SZ_SQ), 1024};
      gemm_tile(mi * 128, (ni & 7) * 128, 16, al, bl, [&](f32x4 (&acc)[4][4], int rb, int cb) {
        if (!isv) { epi_bf16(kx, 1024, acc, rb, cb); return; }
        if (!USE_XATTN_MFMA) { epi_bf16(vx, 1024, acc, rb, cb); return; }
        const int lane = TID() & 63, l15 = lane & 15, quad = lane >> 4;
#pragma unroll
        for (int mt = 0; mt < 4; ++mt)
#pragma unroll
          for (int nt = 0; nt < 4; ++nt) {
            const int row = rb + mt * 16 + quad * 4, col = cb + nt * 16 + l15;
            const int b = row >> 8, key = row & 255, h = col >> 8, d = col & 255;
            u32x2 v; v[0] = pack2(acc[mt][nt][0], acc[mt][nt][1]); v[1] = pack2(acc[mt][nt][2], acc[mt][nt][3]);
            *(u32x2*)(vx + ((size_t)((b * 4 + h) * 256 + d)) * 256 + key) = v;
          }
      }, smem);
    });
  }
}


DI void phase_xattn(const Params& p) {
  const int wave = TID() >> 6, lane = TID() & 63, l15 = lane & 15, quad = lane >> 4;
  const bf16_t* q = (const bf16_t*)(p.ws + OFF_XQ); const bf16_t* kx = (const bf16_t*)(p.ws + OFF_KX); const bf16_t* vxT = (const bf16_t*)(p.ws + OFF_VX);
  bf16_t* xo = (bf16_t*)(p.ws + OFF_XO);
  for (int item = BID(); item < 2048; item += GDIM()) {
    const int b = item >> 8, h = (item >> 6) & 3, qb = item & 63;
    const size_t tq = (size_t)b * 4096 + qb * 64 + wave * 16 + l15;
    bf16x8 qf[8];
#pragma unroll
    for (int ks = 0; ks < 8; ++ks) qf[ks] = *(const bf16x8*)(q + tq * 1024 + h * 256 + ks * 32 + quad * 8);
    f32x4 s[16];
#pragma unroll
    for (int mt = 0; mt < 16; ++mt) {
      const bf16_t* kp = kx + (size_t)(b * 256 + mt * 16 + l15) * 1024 + h * 256 + quad * 8;
      f32x4 a = {0.f, 0.f, 0.f, 0.f};
#pragma unroll
      for (int ks = 0; ks < 8; ++ks) a = MFMA16(*(const bf16x8*)(kp + ks * 32), qf[ks], a);
      s[mt] = a;
      if (mt & 1) __builtin_amdgcn_sched_barrier(0);
    }
    float m = -1e30f;
#pragma unroll
    for (int mt = 0; mt < 16; ++mt)
#pragma unroll
      for (int r = 0; r < 4; ++r) m = fmaxf(m, s[mt][r]);
    m = fmaxf(m, __shfl_xor(m, 16)); m = fmaxf(m, __shfl_xor(m, 32));
    const float c1 = 0.0625f * 1.4426950408889634f;
    float l = 0.f;
#pragma unroll
    for (int mt = 0; mt < 16; ++mt)
#pragma unroll
      for (int r = 0; r < 4; ++r) { float pv = exp2f((s[mt][r] - m) * c1); s[mt][r] = pv; l += pv; }
    l += __shfl_xor(l, 16); l += __shfl_xor(l, 32);
    f32x4 o[16];
#pragma unroll
    for (int dt = 0; dt < 16; ++dt) o[dt] = f32x4{0.f, 0.f, 0.f, 0.f};
#pragma unroll
    for (int s2 = 0; s2 < 8; ++s2) {
      const bf16x8 pf = pack8(s[2 * s2], s[2 * s2 + 1]);
#pragma unroll
      for (int dt = 0; dt < 16; ++dt) {
        const bf16_t* vp = vxT + ((size_t)((b * 4 + h) * 256 + dt * 16 + l15)) * 256 + s2 * 32 + quad * 4;
        u32x2 lo = *(const u32x2*)vp, hi = *(const u32x2*)(vp + 16);
        u32x4 t; t[0] = lo[0]; t[1] = lo[1]; t[2] = hi[0]; t[3] = hi[1];
        o[dt] = MFMA16(__builtin_bit_cast(bf16x8, t), pf, o[dt]);
      }
      __builtin_amdgcn_sched_barrier(0);
    }
    const float il = 1.f / l;
#pragma unroll
    for (int dt = 0; dt < 16; ++dt) {
      u32x2 v; v[0] = pack2(o[dt][0] * il, o[dt][1] * il); v[1] = pack2(o[dt][2] * il, o[dt][3] * il);
      *(u32x2*)(xo + tq * 1024 + h * 256 + dt * 16 + quad * 4) = v;
    }
  }
}

template <int R, int NT>
DI void dil_branch(const bf16_t* swk, const bf16_t* swv, size_t rowbase, int h, int tok0, const bf16x8 (&qf)[2], float& m, float& l, f32x4 (&o)[4],
                   int l15, int quad) {
  constexpr int U = 16 / R, W = 128 * R;
  f32x4 s[NT];
#pragma unroll
  for (int kt = 0; kt < NT; ++kt) {
    int kap = tok0 - W + R * (kt * 16 + l15);
    kap = min(max(kap, 0), 4095);
    const bf16_t* kp = swk + (rowbase + kap) * 512 + h * 64 + quad * 8;
    f32x4 a = {0.f, 0.f, 0.f, 0.f};
    a = MFMA16(*(const bf16x8*)kp, qf[0], a);
    a = MFMA16(*(const bf16x8*)(kp + 32), qf[1], a);
    s[kt] = a;
    if ((kt & 3) == 3) __builtin_amdgcn_sched_barrier(0);
  }
  float mx = m;
  const float c1 = 0.125f * 1.4426950408889634f;
#pragma unroll
  for (int kt = 0; kt < NT; ++kt)
#pragma unroll
    for (int r2 = 0; r2 < 4; ++r2) {
      const int c = kt * 16 + quad * 4 + r2;
      const int dist = U * l15 + 128 - c;
      const int kap = tok0 - W + R * c;
      const bool ok = (dist >= 0) && (dist <= 128) && (kap >= 0);
      const float v = ok ? s[kt][r2] * c1 : -1e30f;
      s[kt][r2] = v; mx = fmaxf(mx, v);
    }
  mx = fmaxf(mx, __shfl_xor(mx, 16)); mx = fmaxf(mx, __shfl_xor(mx, 32));
  const float corr = exp2f(m - mx);
  m = mx; l *= corr;
#pragma unroll
  for (int dt = 0; dt < 4; ++dt) { o[dt][0] *= corr; o[dt][1] *= corr; o[dt][2] *= corr; o[dt][3] *= corr; }
#pragma unroll
  for (int kt = 0; kt < NT; ++kt)
#pragma unroll
    for (int r2 = 0; r2 < 4; ++r2) { float pv = exp2f(s[kt][r2] - mx); s[kt][r2] = pv; l += pv; }
  constexpr int NS = (NT + 1) / 2;
#pragma unroll
  for (int s2 = 0; s2 < NS; ++s2) {
    const f32x4 z4 = {0.f, 0.f, 0.f, 0.f};
    const bf16x8 pf = pack8(s[2 * s2], (2 * s2 + 1 < NT) ? s[(2 * s2 + 1 < NT) ? 2 * s2 + 1 : 0] : z4);
    const bf16_t* vp[8];
#pragma unroll
    for (int j = 0; j < 8; ++j) {
      const int c = (2 * s2 + (j >> 2)) * 16 + quad * 4 + (j & 3);
      int kap = tok0 - W + R * c;
      kap = min(max(kap, 0), 4095);
      vp[j] = swv + (rowbase + kap) * 512 + h * 64 + l15;
    }
#pragma unroll
    for (int dt = 0; dt < 4; ++dt) {
      bf16x8 vf;
#pragma unroll
      for (int j = 0; j < 8; ++j) vf[j] = (short)vp[j][dt * 16];
      o[dt] = MFMA16(vf, pf, o[dt]);
    }
    __builtin_amdgcn_sched_barrier(0);
  }
}

DI void phase_dil_attn(const Params& p, int first, int nblk) {
  const int wave = TID() >> 6, lane = TID() & 63, l15 = lane & 15, quad = lane >> 4;
  bf16_t* swq = (bf16_t*)(p.ws + OFF_SWQ); const bf16_t* swk = (const bf16_t*)(p.ws + OFF_SWK); const bf16_t* swv = (const bf16_t*)(p.ws + OFF_SWV);
  for (int item = first; item < 4096; item += nblk) {
    const int b = item >> 9, h = (item >> 6) & 7, G = (item >> 2) & 15, sub = item & 3;
    const int tok0 = G * 256 + sub * 4 + wave;
    const size_t rowbase = (size_t)b * 4096;
    const size_t tq = rowbase + tok0 + 16 * l15;
    bf16x8 qf[2];
    qf[0] = *(const bf16x8*)(swq + tq * 512 + h * 64 + quad * 8);
    qf[1] = *(const bf16x8*)(swq + tq * 512 + h * 64 + 32 + quad * 8);
    float m = -1e30f, l = 0.f;
    f32x4 o[4];
#pragma unroll
    for (int dt = 0; dt < 4; ++dt) o[dt] = f32x4{0.f, 0.f, 0.f, 0.f};
    dil_branch<16, 9>(swk, swv, rowbase, h, tok0, qf, m, l, o, l15, quad);
    dil_branch<4, 12>(swk, swv, rowbase, h, tok0, qf, m, l, o, l15, quad);
    dil_branch<1, 24>(swk, swv, rowbase, h, tok0, qf, m, l, o, l15, quad);
    l += __shfl_xor(l, 16); l += __shfl_xor(l, 32);
    const float il = 1.f / l;
#pragma unroll
    for (int dt = 0; dt < 4; ++dt) {
      u32x2 v; v[0] = pack2(o[dt][0] * il, o[dt][1] * il); v[1] = pack2(o[dt][2] * il, o[dt][3] * il);
      *(u32x2*)(swq + tq * 512 + h * 64 + dt * 16 + quad * 4) = v;
    }
  }
}

DI void phase_xo(const Params& p, int l, bf16_t* smem) {
  const bf16_t* wc = (const bf16_t*)(p.ws + OFF_W) + (size_t)l * SZ_COMMON + 3 * SZ_SQ;
  PlainLoad al{(const bf16_t*)(p.ws + OFF_XO), 1024}, bl{wc, 1024};
  for_tiles(256, 8, [&](int mi, int ni) {
    gemm_tile(mi * 128, ni * 128, 16, al, bl, [&](f32x4 (&acc)[4][4], int rb, int cb) { epi_resid(p, acc, rb, cb); }, smem);
  });
}

DI void phase_ffn_gu(const Params& p, int l, bf16_t* smem) {
  const bf16_t* W = (const bf16_t*)(p.ws + OFF_W) + (size_t)l * SZ_COMMON + 4 * SZ_SQ;
  PlainLoad al{(const bf16_t*)(p.ws + OFF_HB), 1024}, bl{W, 1024};
  bf16_t* act = (bf16_t*)(p.ws + OFF_ACT);
  for_tiles(256, 44, [&](int mi, int ni) {
    gemm_tile(mi * 128, ni * 128, 16, al, bl, [&](f32x4 (&acc)[4][4], int rb, int cb) {
      const int lane = TID() & 63, l15 = lane & 15, quad = lane >> 4;
#pragma unroll
      for (int mt = 0; mt < 4; ++mt)
#pragma unroll
        for (int np = 0; np < 2; ++np)
#pragma unroll
          for (int r = 0; r < 4; ++r) {
            float val = siluf_(acc[mt][2 * np][r]) * acc[mt][2 * np + 1][r];
            act[(size_t)(rb + mt * 16 + quad * 4 + r) * 2816 + (cb >> 1) + np * 16 + l15] = f2bf(val);
          }
    }, smem);
  });
}
DI void phase_ffn_down(const Params& p, int l, bf16_t* smem) {
  const bf16_t* W = (const bf16_t*)(p.ws + OFF_W) + (size_t)l * SZ_COMMON + 4 * SZ_SQ + SZ_GU;
  PlainLoad al{(const bf16_t*)(p.ws + OFF_ACT), 2816}, bl{W, 2816};
  for_tiles(256, 8, [&](int mi, int ni) {
    gemm_tile(mi * 128, ni * 128, 44, al, bl, [&](f32x4 (&acc)[4][4], int rb, int cb) { epi_resid(p, acc, rb, cb); }, smem);
  });
}

__global__ void __launch_bounds__(256, 2) fwd_megakernel(Params p) {
  cg::grid_group grid = cg::this_grid();
  __shared__ __attribute__((aligned(16))) char smem_raw[2 * 2 * 128 * LDT * 2];
  bf16_t* sm16 = (bf16_t*)smem_raw; float* sm32 = (float*)smem_raw;

  phase_prologue(p, sm32);
  grid.sync();
  for (int l = 0; l < 4; ++l) {
    const int i = l >> 1;
    if ((l & 1) == 0) {
      phase_proj(p, i, sm16); grid.sync();
      phase_dn_prep(p, i, smem_raw); grid.sync();
      phase_mix(p, i); grid.sync();
      phase_dn_post(p, i); grid.sync();
      phase_wout(p, i, sm16); grid.sync();
    } else {
#if USE_S5_GEMM
      phase_s5_tables(p, i, sm32); grid.sync();
      phase_s5_end(p, sm16); grid.sync();
      phase_s5_y(p, i, sm16); grid.sync();
#else
      phase_s5_naive(p, i); grid.sync();
#endif
      phase_glu(p, i, sm16); grid.sync();
    }
    phase_ln(p, p.ln_mix_g + l * 1024, p.ln_mix_b + l * 1024); grid.sync();
    phase_xproj(p, l, sm16); grid.sync();
    phase_xattn(p); grid.sync();
    phase_xo(p, l, sm16); grid.sync();
    phase_ln(p, p.ln_x_g + l * 1024, p.ln_x_b + l * 1024); grid.sync();
    phase_ffn_gu(p, l, sm16); grid.sync();
    phase_ffn_down(p, l, sm16); grid.sync();
    phase_ln(p, p.ln_ffn_g + l * 1024, p.ln_ffn_b + l * 1024); grid.sync();
  }
}

extern "C" void kernel_launch(void* const* d_in, const int* in_sizes, int n_in, void* d_out, int out_size, void* d_ws, size_t ws_size,
                              hipStream_t stream) {
  static int grid_blocks = 0;
  if (!grid_blocks) {
    int dev = 0, cus = 0, per_cu = 0;
    hipGetDevice(&dev);
    hipDeviceGetAttribute(&cus, hipDeviceAttributeMultiprocessorCount, dev);
    hipOccupancyMaxActiveBlocksPerMultiprocessor(&per_cu, fwd_megakernel, 256, 0);
    if (per_cu > 2) per_cu = 2;
    if (per_cu < 1) per_cu = 1;
    grid_blocks = cus * per_cu;
    grid_blocks -= grid_blocks % 8;
  }
  Params p{};
  const float** pf = (const float**)&p;
  for (int i = 0; i < 32; ++i) pf[i] = (const float*)d_in[i];
  p.pos = (const int*)d_in[2];
  p.out = (float*)d_out; p.ws = (char*)d_ws;
  void* args[] = {&p};
  hipError_t e = hipLaunchCooperativeKernel((void*)fwd_megakernel, dim3(grid_blocks), dim3(256), args, 0, stream);
  if (e != hipSuccess) fprintf(stderr, "cooperative launch failed: %s (grid %d)\n", hipGetErrorString(e), grid_blocks);
}
```

```cpp
#include <hip/hip_runtime.h>
#include <hip/hip_cooperative_groups.h>
#include <cstdio>
namespace cg = cooperative_groups;
#ifndef USE_XATTN_MFMA
#define USE_XATTN_MFMA 1
#endif
#ifndef USE_S5_GEMM
#define USE_S5_GEMM 1
#endif
#ifndef USE_DIL_MFMA
#define USE_DIL_MFMA 1
#endif

typedef unsigned short bf16_t;
using bf16x8 = __attribute__((ext_vector_type(8))) short;
using f32x4 = __attribute__((ext_vector_type(4))) float;
#define DI __device__ __forceinline__

constexpr int T_ = 32768, S_ = 4096;
constexpr size_t MiB = (size_t)1 << 20;
constexpr size_t SZ_SQ = (size_t)1024 * 1024, SZ_WIN = (size_t)3712 * 1024, SZ_GLU = (size_t)2048 * 1024,
                 SZ_GU = (size_t)5632 * 1024, SZ_WD = (size_t)1024 * 2816;
constexpr size_t SZ_COMMON = 4 * SZ_SQ + SZ_GU + SZ_WD;
constexpr size_t W_EVEN0 = 4 * SZ_COMMON;
constexpr size_t W_ODD0 = W_EVEN0 + 2 * (SZ_WIN + SZ_SQ);
constexpr float ALPHA = 1.681792830507429f;

constexpr size_t OFF_W = 0;
constexpr size_t OFF_ROPE = 125 * MiB;
constexpr size_t OFF_HB = 133 * MiB;
constexpr size_t OFF_KX = 197 * MiB;
constexpr size_t OFF_VX = 201 * MiB;
constexpr size_t OFF_BIG = 205 * MiB;
constexpr size_t OFF_BAR = 511 * MiB;
constexpr size_t OFF_DNQKV = OFF_BIG;
constexpr size_t OFF_Z = OFF_BIG + 96 * MiB;
constexpr size_t OFF_SWQ = OFF_BIG + 128 * MiB;
constexpr size_t OFF_SWK = OFF_BIG + 160 * MiB;
constexpr size_t OFF_SWV = OFF_BIG + 192 * MiB;
constexpr size_t OFF_LOGIT = OFF_BIG + 224 * MiB;
constexpr size_t OFF_QD = OFF_BIG + 225 * MiB;
constexpr size_t OFF_KD = OFF_BIG + 257 * MiB;
constexpr size_t OFF_INTRA = OFF_BIG + 289 * MiB;
constexpr size_t OFF_WB = OFF_HB;
constexpr size_t OFF_UB = OFF_HB + 32 * MiB;
constexpr size_t OFF_EG = OFF_KX;
constexpr size_t OFF_XQ = OFF_BIG;
constexpr size_t OFF_XO = OFF_BIG + 64 * MiB;
constexpr size_t OFF_ACT = OFF_BIG;
constexpr size_t OFF_HID = OFF_BIG;
constexpr size_t OFF_SIN = OFF_BIG + 64 * MiB;
constexpr size_t OFF_KTAB = OFF_BIG + 80 * MiB;
constexpr size_t OFF_ETAB = OFF_BIG + 82 * MiB;
constexpr size_t OFF_GTAB = OFF_BIG + 90 * MiB;
constexpr size_t OFF_AL = OFF_BIG + 98 * MiB;

struct Params {
  const float* x; const float* mem; const int* pos;
  const float* hyb_w_in; const float* dn_conv_w; const float* dn_a_log; const float* dn_dt_bias; const float* dn_norm_g; const float* hyb_w_out;
  const float* s5_a_re; const float* s5_a_im; const float* s5_log_dt; const float* s5_b_re; const float* s5_b_im; const float* s5_c_re; const float* s5_c_im;
  const float* s5_d; const float* s5_glu_wo; const float* s5_glu_wg;
  const float* ln_mix_g; const float* ln_mix_b;
  const float* xq_w; const float* xk_w; const float* xv_w; const float* xo_w; const float* ln_x_g; const float* ln_x_b;
  const float* ffn_wg; const float* ffn_wu; const float* ffn_wd; const float* ln_ffn_g; const float* ln_ffn_b;
  float* out; char* ws;
};

DI int TID() { int t = threadIdx.x; asm volatile("" : "+v"(t)); return t; }
DI int BID() { int t = blockIdx.x; asm volatile("" : "+s"(t)); return t; }
DI int GDIM() { int t = gridDim.x; asm volatile("" : "+s"(t)); return t; }
DI bf16_t f2bf(float x) { unsigned u = __float_as_uint(x); u += 0x7fffu + ((u >> 16) & 1u); return (bf16_t)(u >> 16); }
DI float bf2f(bf16_t v) { return __uint_as_float(((unsigned)v) << 16); }
DI unsigned pack2(float a, float b) { return (unsigned)f2bf(a) | ((unsigned)f2bf(b) << 16); }
using u32x4 = __attribute__((ext_vector_type(4))) unsigned;
using u32x2 = __attribute__((ext_vector_type(2))) unsigned;
DI bf16x8 pack8(f32x4 a, f32x4 b) {
  u32x4 t; t[0] = pack2(a[0], a[1]); t[1] = pack2(a[2], a[3]); t[2] = pack2(b[0], b[1]); t[3] = pack2(b[2], b[3]);
  return __builtin_bit_cast(bf16x8, t);
}
#define MFMA16(a, b, c) __builtin_amdgcn_mfma_f32_16x16x32_bf16((a), (b), (c), 0, 0, 0)
DI float wave_sum(float v) { for (int o = 32; o > 0; o >>= 1) v += __shfl_xor(v, o); return v; }
DI float wave_max(float v) { for (int o = 32; o > 0; o >>= 1) v = fmaxf(v, __shfl_xor(v, o)); return v; }
DI float sigmoidf_(float x) { return 1.f / (1.f + __expf(-x)); }
DI float siluf_(float x) { return x * sigmoidf_(x); }
DI float softplusf_(float x) { return fmaxf(x, 0.f) + log1pf(__expf(-fabsf(x))); }
DI float gelu_tanh(float x) { float u = 0.7978845608028654f * (x + 0.044715f * x * x * x); return 0.5f * x * (1.f + tanhf(u)); }

template <class CM>
DI void transpose_job(bf16_t* dst, int Ndst, int K, int srcStride, CM colptr, float* tile) {
  const int ntk = K / 64, ntiles = (Ndst / 64) * ntk;
  for (int tl = BID(); tl < ntiles; tl += GDIM()) {
    const int r0 = (tl / ntk) * 64, k0 = (tl % ntk) * 64;
    const int rl = TID() & 63, ks = TID() >> 6;
    const float* cp = colptr(r0 + rl);
    for (int i = 0; i < 16; ++i) { int kl = ks * 16 + i; tile[kl * 65 + rl] = cp ? cp[(size_t)(k0 + kl) * srcStride] : 0.f; }
    __syncthreads();
    const int kk = TID() & 63, rs = TID() >> 6;
    for (int i = 0; i < 16; ++i) { int rr = i * 4 + rs; dst[(size_t)(r0 + rr) * K + k0 + kk] = f2bf(tile[kk * 65 + rr]); }
    __syncthreads();
  }
}

DI void phase_prologue(const Params& p, float* smem) {
  bf16_t* W = (bf16_t*)(p.ws + OFF_W);
  for (int l = 0; l < 4; ++l) {
    bf16_t* wc = W + (size_t)l * SZ_COMMON;
    const float* s;
    s = p.xq_w + (size_t)l * SZ_SQ; transpose_job(wc, 1024, 1024, 1024, [=](int r) { return s + r; }, smem);
    s = p.xk_w + (size_t)l * SZ_SQ; transpose_job(wc + SZ_SQ, 1024, 1024, 1024, [=](int r) { return s + r; }, smem);
    s = p.xv_w + (size_t)l * SZ_SQ; transpose_job(wc + 2 * SZ_SQ, 1024, 1024, 1024, [=](int r) { return s + r; }, smem);
    s = p.xo_w + (size_t)l * SZ_SQ; transpose_job(wc + 3 * SZ_SQ, 1024, 1024, 1024, [=](int r) { return s + r; }, smem);
    {
      const float* g = p.ffn_wg + (size_t)l * 1024 * 2816; const float* u = p.ffn_wu + (size_t)l * 1024 * 2816;
      transpose_job(wc + 4 * SZ_SQ, 5632, 1024, 2816, [=](int r) { int c = (r >> 5) * 16 + (r & 15); return ((r >> 4) & 1) ? (u + c) : (g + c); }, smem);
    }
    s = p.ffn_wd + (size_t)l * 2816 * 1024; transpose_job(wc + 4 * SZ_SQ + SZ_GU, 1024, 2816, 1024, [=](int r) { return s + r; }, smem);
  }
  for (int i = 0; i < 2; ++i) {
    bf16_t* we = W + W_EVEN0 + (size_t)i * (SZ_WIN + SZ_SQ);
    const float* s = p.hyb_w_in + (size_t)i * 1024 * 3592;
    transpose_job(we, 3712, 1024, 3592, [=](int r) -> const float* {
      if (r < 2048) return s + r;
      if (r < 3584) return s + r + 8;
      if (r < 3592) return s + 2048 + (r - 3584);
      return nullptr; }, smem);
    const float* s2 = p.hyb_w_out + (size_t)i * SZ_SQ;
    transpose_job(we + SZ_WIN, 1024, 1024, 1024, [=](int r) { return s2 + r; }, smem);
    bf16_t* wo = W + W_ODD0 + (size_t)i * SZ_GLU;
    const float* a = p.s5_glu_wo + (size_t)i * SZ_SQ; const float* b = p.s5_glu_wg + (size_t)i * SZ_SQ;
    transpose_job(wo, 2048, 1024, 1024, [=](int r) { int c = (r >> 5) * 16 + (r & 15); return ((r >> 4) & 1) ? (b + c) : (a + c); }, smem);
  }
  const size_t gtid = (size_t)BID() * 256 + TID(), gsz = (size_t)GDIM() * 256;
  bf16_t* hb = (bf16_t*)(p.ws + OFF_HB);
  for (size_t i = gtid; i < (size_t)T_ * 256; i += gsz) {
    float4 v = ((const float4*)p.x)[i];
    ((float4*)p.out)[i] = v;
    uint2 o; o.x = pack2(v.x, v.y); o.y = pack2(v.z, v.w);
    ((uint2*)hb)[i] = o;
  }
  float* rc = (float*)(p.ws + OFF_ROPE); float* rs = rc + (size_t)T_ * 32;
  for (size_t i = gtid; i < (size_t)T_ * 32; i += gsz) {
    int t = (int)(i >> 5), j = (int)(i & 31);
    float invf = (float)exp(-(double)(2 * j) / 64.0 * 9.210340371976184);
    float ang = (float)p.pos[t] * invf;
    double a = (double)ang;
    double k = rint(a * 0.15915494309189535);
    float r = (float)(a - k * 6.283185307179586);
    rc[i] = cosf(r); rs[i] = sinf(r);
  }
}

constexpr int LDT = 72;
template <class AL, class BL, class EP>
DI void gemm_tile(int m0, int n0, int nks, AL aload, BL bload, EP epi, bf16_t* smem) {
  bf16_t* As = smem; bf16_t* Bs = smem + 2 * 128 * LDT;
  const int tid = TID(), lane = tid & 63, wave = tid >> 6;
  const int wm = wave >> 1, wn = wave & 1, l15 = lane & 15, quad = lane >> 4;
  const int lrow = tid >> 3, lkc = (tid & 7) * 8;
  f32x4 acc[4][4];
#pragma unroll
  for (int i = 0; i < 4; ++i)
#pragma unroll
    for (int j = 0; j < 4; ++j) acc[i][j] = f32x4{0.f, 0.f, 0.f, 0.f};
  uint4 ra[4], rb[4];
#pragma unroll
  for (int i = 0; i < 4; ++i) { ra[i] = aload(m0 + lrow + 32 * i, 0, lkc); rb[i] = bload(n0 + lrow + 32 * i, 0, lkc); }
#pragma unroll
  for (int i = 0; i < 4; ++i) {
    *(uint4*)(As + (lrow + 32 * i) * LDT + lkc) = ra[i];
    *(uint4*)(Bs + (lrow + 32 * i) * LDT + lkc) = rb[i];
  }
  __syncthreads();
  for (int ks = 0; ks < nks; ++ks) {
    const int cur = ks & 1;
    const bool more = (ks + 1 < nks);
    if (more) {
#pragma unroll
      for (int i = 0; i < 4; ++i) { ra[i] = aload(m0 + lrow + 32 * i, ks + 1, lkc); rb[i] = bload(n0 + lrow + 32 * i, ks + 1, lkc); }
    }
    const bf16_t* Ab = As + cur * 128 * LDT; const bf16_t* Bb = Bs + cur * 128 * LDT;
#pragma unroll
    for (int kk = 0; kk < 2; ++kk) {
      bf16x8 a[4], b[4];
#pragma unroll
      for (int mt = 0; mt < 4; ++mt) a[mt] = *(const bf16x8*)(Ab + (wm * 64 + mt * 16 + l15) * LDT + kk * 32 + quad * 8);
#pragma unroll
      for (int nt = 0; nt < 4; ++nt) b[nt] = *(const bf16x8*)(Bb + (wn * 64 + nt * 16 + l15) * LDT + kk * 32 + quad * 8);
#pragma unroll
      for (int mt = 0; mt < 4; ++mt)
#pragma unroll
        for (int nt = 0; nt < 4; ++nt) acc[mt][nt] = __builtin_amdgcn_mfma_f32_16x16x32_bf16(a[mt], b[nt], acc[mt][nt], 0, 0, 0);
    }
    if (more) {
      bf16_t* An = As + (cur ^ 1) * 128 * LDT; bf16_t* Bn = Bs + (cur ^ 1) * 128 * LDT;
#pragma unroll
      for (int i = 0; i < 4; ++i) {
        *(uint4*)(An + (lrow + 32 * i) * LDT + lkc) = ra[i];
        *(uint4*)(Bn + (lrow + 32 * i) * LDT + lkc) = rb[i];
      }
    }
    __syncthreads();
  }
  epi(acc, m0 + wm * 64, n0 + wn * 64);
}

template <class F>
DI void for_tiles(int mtiles, int ntiles, F f) {
  const int xcd = BID() & 7, slot = BID() >> 3, nslot = GDIM() >> 3;
  const int per = (mtiles >> 3) * ntiles;
  for (int w = slot; w < per; w += nslot) {
    int mi = w / ntiles, ni = w - mi * ntiles;
    f((mi * 8 + xcd), ni);
  }
}

#define EPI_LOOP for (int mt = 0; mt < 4; ++mt) for (int nt = 0; nt < 4; ++nt) for (int r = 0; r < 4; ++r)

DI void epi_resid(const Params& p, f32x4 (&acc)[4][4], int rb, int cb) {
  const int lane = TID() & 63, l15 = lane & 15, quad = lane >> 4;
#pragma unroll
  for (int mt = 0; mt < 4; ++mt)
#pragma unroll
    for (int nt = 0; nt < 4; ++nt)
#pragma unroll
      for (int r = 0; r < 4; ++r) {
        size_t idx = (size_t)(rb + mt * 16 + quad * 4 + r) * 1024 + cb + nt * 16 + l15;
        p.out[idx] = ALPHA * p.out[idx] + acc[mt][nt][r];
      }
}
DI void epi_bf16(bf16_t* dst, int ld, f32x4 (&acc)[4][4], int rb, int cb) {
  const int lane = TID() & 63, l15 = lane & 15, quad = lane >> 4;
#pragma unroll
  for (int mt = 0; mt < 4; ++mt)
#pragma unroll
    for (int nt = 0; nt < 4; ++nt)
#pragma unroll
      for (int r = 0; r < 4; ++r)
        dst[(size_t)(rb + mt * 16 + quad * 4 + r) * ld + cb + nt * 16 + l15] = f2bf(acc[mt][nt][r]);
}

struct PlainLoad {
  const bf16_t* base; int ld;
  DI uint4 operator()(int row, int ks, int kc) const { return *(const uint4*)(base + (size_t)row * ld + ks * 64 + kc); }
};

DI void phase_proj(const Params& p, int i, bf16_t* smem) {
  const bf16_t* W = (const bf16_t*)(p.ws + OFF_W) + W_EVEN0 + (size_t)i * (SZ_WIN + SZ_SQ);
  PlainLoad al{(const bf16_t*)(p.ws + OFF_HB), 1024}, bl{W, 1024};
  bf16_t* dnqkv = (bf16_t*)(p.ws + OFF_DNQKV); bf16_t* z = (bf16_t*)(p.ws + OFF_Z);
  bf16_t* swq = (bf16_t*)(p.ws + OFF_SWQ); bf16_t* swk = (bf16_t*)(p.ws + OFF_SWK); bf16_t* swv = (bf16_t*)(p.ws + OFF_SWV);
  float* logit = (float*)(p.ws + OFF_LOGIT);
  const float* rc = (const float*)(p.ws + OFF_ROPE); const float* rs = rc + (size_t)T_ * 32;
  for_tiles(256, 29, [&](int mi, int ni) {
    gemm_tile(mi * 128, ni * 128, 16, al, bl, [&](f32x4 (&acc)[4][4], int rb, int cb) {
      const int lane = TID() & 63, l15 = lane & 15, quad = lane >> 4;
      if (cb < 1536) epi_bf16(dnqkv, 1536, acc, rb, cb);
      else if (cb < 2048) epi_bf16(z, 512, acc, rb, cb - 1536);
      else if (cb < 3072) {
        bf16_t* dst = (cb < 2560) ? swq : swk; const int c0 = (cb < 2560) ? cb - 2048 : cb - 2560;
#pragma unroll
        for (int mt = 0; mt < 4; ++mt)
#pragma unroll
          for (int r = 0; r < 4; ++r) {
            const int row = rb + mt * 16 + quad * 4 + r;
#pragma unroll
            for (int nt = 0; nt < 2; ++nt) {
              const int d = nt * 16 + l15;
              float c = rc[(size_t)row * 32 + d], s = rs[(size_t)row * 32 + d];
              float x1 = acc[mt][nt][r], x2 = acc[mt][nt + 2][r];
              dst[(size_t)row * 512 + c0 + d] = f2bf(x1 * c - x2 * s);
              dst[(size_t)row * 512 + c0 + d + 32] = f2bf(x2 * c + x1 * s);
            }
          }
      } else if (cb < 3584) epi_bf16(swv, 512, acc, rb, cb - 3072);
      else if (cb == 3584) {
#pragma unroll
        for (int mt = 0; mt < 4; ++mt)
#pragma unroll
          for (int r = 0; r < 4; ++r)
            if (l15 < 8) logit[(size_t)(rb + mt * 16 + quad * 4 + r) * 8 + l15] = acc[mt][0][r];
      }
    }, smem);
  });
}

DI void phase_dil_attn(const Params& p, int first, int nblk);

DI void phase_dn_prep(const Params& p, int i, char* smem) {
  bf16_t* qs = (bf16_t*)smem; bf16_t* ks = qs + 64 * 136; bf16_t* vs = ks + 64 * 136;
  float* Lm = (float*)(smem + 3 * 17408); float* beta = Lm + 64 * 68; float* gcum = beta + 64; float* egc = gcum + 64;
  const bf16_t* dnqkv = (const bf16_t*)(p.ws + OFF_DNQKV);
  const float* logit = (const float*)(p.ws + OFF_LOGIT);
  bf16_t* qd_g = (bf16_t*)(p.ws + OFF_QD); bf16_t* kd_g = (bf16_t*)(p.ws + OFF_KD); bf16_t* in_g = (bf16_t*)(p.ws + OFF_INTRA);
  bf16_t* w_g = (bf16_t*)(p.ws + OFF_WB); bf16_t* u_g = (bf16_t*)(p.ws + OFF_UB); float* eg_g = (float*)(p.ws + OFF_EG);
  const float* cw = p.dn_conv_w + (size_t)i * 4 * 1536;
  const int tid = TID(), wave = tid >> 6, lane = tid & 63, l15 = lane & 15, quad = lane >> 4;
  const float QS = 0.08838834764831845f;
  for (int item = BID(); item < 2048; item += GDIM()) {
    const int b = item >> 8, h = (item >> 6) & 3, n = item & 63;
    const int t0 = b * 4096 + n * 64, s0 = n * 64;
    const float A = __expf(p.dn_a_log[i * 4 + h]), dtb = p.dn_dt_bias[i * 4 + h];
    for (int tt = 0; tt < 16; ++tt) {
      const int il = tt * 4 + wave, t = t0 + il, sq = s0 + il;
#pragma unroll
      for (int which = 0; which < 3; ++which) {
        const int col = which * 512 + h * 128 + lane * 2;
        float y0 = 0.f, y1 = 0.f;
#pragma unroll
        for (int j = 0; j < 4; ++j) {
          if (sq - 3 + j >= 0) {
            unsigned v = *(const unsigned*)(dnqkv + (size_t)(t - 3 + j) * 1536 + col);
            y0 += cw[j * 1536 + col] * bf2f((bf16_t)(v & 0xffff));
            y1 += cw[j * 1536 + col + 1] * bf2f((bf16_t)(v >> 16));
          }
        }
        y0 = siluf_(y0); y1 = siluf_(y1);
        if (which < 2) {
          float ss = wave_sum(y0 * y0 + y1 * y1);
          float sc = rsqrtf(ss + 1e-6f);
          y0 *= sc; y1 *= sc;
        }
        bf16_t* dst = (which == 0) ? qs : (which == 1 ? ks : vs);
        *(unsigned*)(dst + il * 136 + lane * 2) = pack2(y0, y1);
      }
    }
    if (wave == 0) {
      const size_t row = (size_t)(t0 + lane);
      const float bl = logit[row * 8 + h], al = logit[row * 8 + 4 + h];
      float g = -A * softplusf_(al + dtb);
#pragma unroll
      for (int o = 1; o < 64; o <<= 1) { float v = __shfl_up(g, o); if (lane >= o) g += v; }
      beta[lane] = sigmoidf_(bl); gcum[lane] = g; egc[lane] = __expf(g);
    }
    __syncthreads();
    {
      f32x4 kk[4], qk[4];
#pragma unroll
      for (int nt = 0; nt < 4; ++nt) { kk[nt] = f32x4{0.f, 0.f, 0.f, 0.f}; qk[nt] = f32x4{0.f, 0.f, 0.f, 0.f}; }
#pragma unroll
      for (int k4 = 0; k4 < 4; ++k4) {
        const bf16x8 ak = *(const bf16x8*)(ks + (wave * 16 + l15) * 136 + k4 * 32 + quad * 8);
        const bf16x8 aq = *(const bf16x8*)(qs + (wave * 16 + l15) * 136 + k4 * 32 + quad * 8);
#pragma unroll
        for (int nt = 0; nt < 4; ++nt) {
          const bf16x8 bk = *(const bf16x8*)(ks + (nt * 16 + l15) * 136 + k4 * 32 + quad * 8);
          kk[nt] = MFMA16(ak, bk, kk[nt]); qk[nt] = MFMA16(aq, bk, qk[nt]);
        }
      }
#pragma unroll
      for (int nt = 0; nt < 4; ++nt)
#pragma unroll
        for (int r = 0; r < 4; ++r) {
          const int ii = wave * 16 + quad * 4 + r, jj = nt * 16 + l15;
          const float dec = (jj <= ii) ? __expf(gcum[ii] - gcum[jj]) : 0.f;
          Lm[ii * 68 + jj] = (jj < ii) ? beta[ii] * kk[nt][r] * dec : 0.f;
          in_g[(size_t)item * 4096 + ii * 64 + jj] = f2bf(qk[nt][r] * QS * dec);
        }
    }
    __syncthreads();
    {
      float x[64];
#pragma unroll
      for (int ii = 0; ii < 64; ++ii) x[ii] = 0.f;
      const int c = tid & 127;
      const bool isw = tid >= 128;
      bf16_t* dstb = (isw ? w_g : u_g) + (size_t)item * 8192 + c;
      const bf16_t* srcb = (isw ? ks : vs) + c;
#pragma unroll
      for (int ii = 0; ii < 64; ++ii) {
        float acc = bf2f(srcb[ii * 136]) * beta[ii] * (isw ? egc[ii] : 1.f);
#pragma unroll
        for (int j4 = 0; j4 < (ii + 3) / 4; ++j4) {
          const float4 l4 = *(const float4*)(Lm + ii * 68 + j4 * 4);
          acc -= l4.x * x[j4 * 4]; acc -= l4.y * x[j4 * 4 + 1]; acc -= l4.z * x[j4 * 4 + 2]; acc -= l4.w * x[j4 * 4 + 3];
        }
        x[ii] = acc;
        dstb[ii * 128] = f2bf(acc);
        if ((ii & 3) == 3) __builtin_amdgcn_sched_barrier(0);
      }
    }
    {
      const float gl = gcum[63];
#pragma unroll 4
      for (int k = 0; k < 32; ++k) {
        const int e = tid + 256 * k;
        const int ii = e >> 7, d = e & 127;
        qd_g[(size_t)item * 8192 + e] = f2bf(bf2f(qs[ii * 136 + d]) * QS * egc[ii]);
        const int d2 = e >> 6, i2 = e & 63;
        kd_g[(size_t)item * 8192 + e] = f2bf(bf2f(ks[i2 * 136 + d2]) * __expf(gl - gcum[i2]));
      }
      if (tid == 0) eg_g[item] = __expf(gl);
    }
    __syncthreads();
  }
}

DI bf16x8 ld2(const bf16_t* ptr) {
  u32x2 lo = *(const u32x2*)ptr, hi = *(const u32x2*)(ptr + 16);
  u32x4 t; t[0] = lo[0]; t[1] = lo[1]; t[2] = hi[0]; t[3] = hi[1];
  return __builtin_bit_cast(bf16x8, t);
}

DI void dn_chain_item(const Params& p, int item) {
  const int tid = TID(), wave = tid >> 6, lane = tid & 63, l15 = lane & 15, quad = lane >> 4;
  const int bh = item >> 1, half = item & 1;
  const int e0 = half * 64 + wave * 16 + l15;
  const bf16_t* qd_g = (const bf16_t*)(p.ws + OFF_QD); const bf16_t* kd_g = (const bf16_t*)(p.ws + OFF_KD); const bf16_t* in_g = (const bf16_t*)(p.ws + OFF_INTRA);
  const bf16_t* w_g = (const bf16_t*)(p.ws + OFF_WB); bf16_t* u_g = (bf16_t*)(p.ws + OFF_UB); const float* eg_g = (const float*)(p.ws + OFF_EG);
  f32x4 S[8];
#pragma unroll
  for (int mt = 0; mt < 8; ++mt) S[mt] = f32x4{0.f, 0.f, 0.f, 0.f};
#pragma unroll 1
  for (int n = 0; n < 64; ++n) {
    const size_t ci = (size_t)bh * 64 + n;
    const bf16_t* wq = w_g + ci * 8192; const bf16_t* qd = qd_g + ci * 8192; const bf16_t* kd = kd_g + ci * 8192; const bf16_t* in = in_g + ci * 4096;
    bf16_t* ub = u_g + ci * 8192;
    const float eg = eg_g[ci];
    bf16x8 sb[4];
#pragma unroll
    for (int s = 0; s < 4; ++s) sb[s] = pack8(S[2 * s], S[2 * s + 1]);
    f32x4 vn[4];
#pragma unroll
    for (int it = 0; it < 4; ++it) {
      f32x4 a = {0.f, 0.f, 0.f, 0.f};
#pragma unroll
      for (int s = 0; s < 4; ++s) a = MFMA16(ld2(wq + (it * 16 + l15) * 128 + s * 32 + quad * 4), sb[s], a);
#pragma unroll
      for (int r = 0; r < 4; ++r) vn[it][r] = bf2f(ub[(it * 16 + quad * 4 + r) * 128 + e0]) - a[r];
    }
    bf16x8 vb[2];
    vb[0] = pack8(vn[0], vn[1]); vb[1] = pack8(vn[2], vn[3]);
#pragma unroll
    for (int it = 0; it < 4; ++it) {
      f32x4 a = {0.f, 0.f, 0.f, 0.f};
#pragma unroll
      for (int s = 0; s < 4; ++s) a = MFMA16(ld2(qd + (it * 16 + l15) * 128 + s * 32 + quad * 4), sb[s], a);
#pragma unroll
      for (int s = 0; s < 2; ++s) a = MFMA16(ld2(in + (it * 16 + l15) * 64 + s * 32 + quad * 4), vb[s], a);
#pragma unroll
      for (int r = 0; r < 4; ++r) ub[(it * 16 + quad * 4 + r) * 128 + e0] = f2bf(a[r]);
    }
#pragma unroll
    for (int mt = 0; mt < 8; ++mt) {
      f32x4 a = S[mt];
      a[0] *= eg; a[1] *= eg; a[2] *= eg; a[3] *= eg;
#pragma unroll
      for (int s = 0; s < 2; ++s) a = MFMA16(ld2(kd + (mt * 16 + l15) * 64 + s * 32 + quad * 4), vb[s], a);
      S[mt] = a;
    }
  }
}

DI void phase_mix(const Params& p, int i) {
  if (BID() < 64) { dn_chain_item(p, BID()); return; }
  phase_dil_attn(p, BID() - 64, GDIM() - 64);
}

DI void phase_dn_post(const Params& p, int i) {
  const bf16_t* ob = (const bf16_t*)(p.ws + OFF_UB);
  bf16_t* z = (bf16_t*)(p.ws + OFF_Z);
  const float* ng = p.dn_norm_g + i * 128;
  const int wave = TID() >> 6, lane = TID() & 63;
  const int N = T_ * 4;
  for (int base = BID() * 4; base < N; base += GDIM() * 4) {
    const int item = base + wave;
    const int t = item >> 2, h = item & 3, b = t >> 12, sidx = t & 4095;
    const size_t g = (size_t)item * 128 + lane * 2;
    const size_t og = ((size_t)((b * 4 + h) * 64 + (sidx >> 6))) * 8192 + (sidx & 63) * 128 + lane * 2;
    unsigned ov = *(const unsigned*)(ob + og), zv = *(const unsigned*)(z + g);
    float o0 = bf2f((bf16_t)(ov & 0xffff)), o1 = bf2f((bf16_t)(ov >> 16));
    float z0 = bf2f((bf16_t)(zv & 0xffff)), z1 = bf2f((bf16_t)(zv >> 16));
    float ms = wave_sum(o0 * o0 + o1 * o1) * (1.f / 128.f);
    float rr = rsqrtf(ms + 1e-6f);
    float r0 = o0 * rr * ng[lane * 2] * siluf_(z0), r1 = o1 * rr * ng[lane * 2 + 1] * siluf_(z1);
    *(unsigned*)(z + g) = pack2(r0, r1);
  }
}

struct MixLoad {
  const bf16_t* a; const bf16_t* b;
  DI uint4 operator()(int row, int ks, int kc) const {
    return (ks < 8) ? *(const uint4*)(a + (size_t)row * 512 + ks * 64 + kc) : *(const uint4*)(b + (size_t)row * 512 + (ks - 8) * 64 + kc);
  }
};

DI void phase_wout(const Params& p, int i, bf16_t* smem) {
  const bf16_t* W = (const bf16_t*)(p.ws + OFF_W) + W_EVEN0 + (size_t)i * (SZ_WIN + SZ_SQ) + SZ_WIN;
  MixLoad al{(const bf16_t*)(p.ws + OFF_Z), (const bf16_t*)(p.ws + OFF_SWQ)};
  PlainLoad bl{W, 1024};
  for_tiles(256, 8, [&](int mi, int ni) {
    gemm_tile(mi * 128, ni * 128, 16, al, bl, [&](f32x4 (&acc)[4][4], int rb, int cb) { epi_resid(p, acc, rb, cb); }, smem);
  });
}

DI void phase_ln(const Params& p, const float* g, const float* b) {
  const int wave = TID() >> 6, lane = TID() & 63;
  bf16_t* hb = (bf16_t*)(p.ws + OFF_HB);
  for (int row = BID() * 4 + wave; row < T_; row += GDIM() * 4) {
    float4* y = (float4*)(p.out + (size_t)row * 1024);
    float4 v[4];
    float s = 0.f;
#pragma unroll
    for (int i = 0; i < 4; ++i) { v[i] = y[lane + 64 * i]; s += v[i].x + v[i].y + v[i].z + v[i].w; }
    const float mu = wave_sum(s) * (1.f / 1024.f);
    float q = 0.f;
#pragma unroll
    for (int i = 0; i < 4; ++i) { float a = v[i].x - mu, b2 = v[i].y - mu, c = v[i].z - mu, d = v[i].w - mu; q += a * a + b2 * b2 + c * c + d * d; }
    const float rstd = rsqrtf(wave_sum(q) * (1.f / 1024.f) + 1e-5f);
#pragma unroll
    for (int i = 0; i < 4; ++i) {
      float4 gg = ((const float4*)g)[lane + 64 * i], bb = ((const float4*)b)[lane + 64 * i];
      float4 o;
      o.x = (v[i].x - mu) * rstd * gg.x + bb.x; o.y = (v[i].y - mu) * rstd * gg.y + bb.y;
      o.z = (v[i].z - mu) * rstd * gg.z + bb.z; o.w = (v[i].w - mu) * rstd * gg.w + bb.w;
      y[lane + 64 * i] = o;
      uint2 ob; ob.x = pack2(o.x, o.y); ob.y = pack2(o.z, o.w);
      ((uint2*)(hb + (size_t)row * 1024))[lane + 64 * i] = ob;
    }
  }
}

DI void phase_s5_naive(const Params& p, int i) {
  const int wave = TID() >> 6, lane = TID() & 63;
  bf16_t* hid = (bf16_t*)(p.ws + OFF_HID);
  for (int base = BID() * 4; base < 512; base += GDIM() * 4) {
    const int item = base + wave, b = item >> 6, g = item & 63;
    const int gp = (i * 64 + g) * 64 + lane;
    const double dt = exp((double)p.s5_log_dt[i * 64 + g]);
    const double are = p.s5_a_re[gp], aim = p.s5_a_im[gp];
    const double lr = are * dt, li = aim * dt;
    const double kk = rint(li * 0.15915494309189535);
    const double red = li - kk * 6.283185307179586;
    const double e = exp(lr);
    const double abr = e * cos(red), abi = e * sin(red);
    const double den = are * are + aim * aim;
    const double nr = abr - 1.0, ni = abi;
    const double cfr = (nr * are + ni * aim) / den, cfi = (ni * are - nr * aim) / den;
    float bbr[16], bbi[16], cr[16], ci[16];
#pragma unroll
    for (int h = 0; h < 16; ++h) {
      const double br = p.s5_b_re[(size_t)gp * 16 + h], bi = p.s5_b_im[(size_t)gp * 16 + h];
      bbr[h] = (float)(cfr * br - cfi * bi); bbi[h] = (float)(cfr * bi + cfi * br);
      cr[h] = p.s5_c_re[((size_t)(i * 64 + g) * 16 + h) * 64 + lane];
      ci[h] = p.s5_c_im[((size_t)(i * 64 + g) * 16 + h) * 64 + lane];
    }
    const float ar = (float)abr, ai = (float)abi;
    const float dsk = p.s5_d[i * 1024 + g * 16 + (lane & 15)];
    float sr = 0.f, si = 0.f;
#pragma unroll 1
    for (int t = 0; t < S_; ++t) {
      const size_t row = (size_t)(b * S_ + t);
      const float4* up = (const float4*)(p.out + row * 1024 + g * 16);
      float u[16];
#pragma unroll
      for (int j = 0; j < 4; ++j) { float4 v = up[j]; u[4 * j] = v.x; u[4 * j + 1] = v.y; u[4 * j + 2] = v.z; u[4 * j + 3] = v.w; }
      float bur = 0.f, bui = 0.f;
#pragma unroll
      for (int h = 0; h < 16; ++h) { bur += bbr[h] * u[h]; bui += bbi[h] * u[h]; }
      const float nsr = ar * sr - ai * si + bur, nsi = ar * si + ai * sr + bui;
      sr = nsr; si = nsi;
      float yk = 0.f, uk = 0.f;
#pragma unroll
      for (int h = 0; h < 16; ++h) {
        float v = wave_sum(cr[h] * sr - ci[h] * si);
        if (lane == h) { yk = v; uk = u[h]; }
      }
      if (lane < 16) hid[row * 1024 + g * 16 + lane] = f2bf(gelu_tanh(yk + dsk * uk));
    }
  }
}

DI void phase_s5_tables(const Params& p, int i, float* smem) {
  float2* pw = (float2*)smem;
  float2* bb = pw + 64 * 33;
  float2* cc = bb + 64 * 16;
  bf16_t* Ktab = (bf16_t*)(p.ws + OFF_KTAB); bf16_t* Etab = (bf16_t*)(p.ws + OFF_ETAB); bf16_t* Gtab = (bf16_t*)(p.ws + OFF_GTAB);
  float2* AL = (float2*)(p.ws + OFF_AL);
  const int tid = TID();
  for (int g = BID(); g < 64; g += GDIM()) {
    const double dt = exp((double)p.s5_log_dt[i * 64 + g]);
    for (int e = tid; e < 64 * 33; e += 256) {
      const int pp = e / 33, n = e - pp * 33;
      const double are = p.s5_a_re[(i * 64 + g) * 64 + pp], aim = p.s5_a_im[(i * 64 + g) * 64 + pp];
      const double lr = are * dt * n, li = aim * dt * n;
      const double k = rint(li * 0.15915494309189535);
      const double red = li - k * 6.283185307179586;
      const double ex = exp(lr);
      pw[e] = make_float2((float)(ex * cos(red)), (float)(ex * sin(red)));
    }
    for (int e = tid; e < 1024; e += 256) {
      const int pp = e >> 4;
      const int gp = (i * 64 + g) * 64 + pp;
      const double are = p.s5_a_re[gp], aim = p.s5_a_im[gp];
      const double lr = are * dt, li = aim * dt;
      const double k = rint(li * 0.15915494309189535);
      const double red = li - k * 6.283185307179586;
      const double ex = exp(lr);
      const double nr = ex * cos(red) - 1.0, ni = ex * sin(red);
      const double den = are * are + aim * aim;
      const double cfr = (nr * are + ni * aim) / den, cfi = (ni * are - nr * aim) / den;
      const double br = p.s5_b_re[(size_t)gp * 16 + (e & 15)], bi = p.s5_b_im[(size_t)gp * 16 + (e & 15)];
      bb[e] = make_float2((float)(cfr * br - cfi * bi), (float)(cfr * bi + cfi * br));
      const size_t ci = ((size_t)(i * 64 + g) * 16 + (e >> 6)) * 64 + (e & 63);
      cc[e] = make_float2(p.s5_c_re[ci], p.s5_c_im[ci]);
    }
    __syncthreads();
    for (int e = tid; e < 8192; e += 256) {
      const int tau = e >> 8, ho = (e >> 4) & 15, hi = e & 15;
      float acc = 0.f;
      for (int pp = 0; pp < 64; ++pp) {
        const float2 c = cc[ho * 64 + pp], w = pw[pp * 33 + tau], b = bb[pp * 16 + hi];
        const float cwr = c.x * w.x - c.y * w.y, cwi = c.x * w.y + c.y * w.x;
        acc += cwr * b.x - cwi * b.y;
      }
      Ktab[(size_t)g * 8192 + e] = f2bf(acc);
    }
    for (int e = tid; e < 65536; e += 256) {
      const int pc = e >> 9, sidx = (e >> 4) & 31, hi = e & 15, pp = pc & 63;
      const float2 w = pw[pp * 33 + 31 - sidx], b = bb[pp * 16 + hi];
      const float v = (pc < 64) ? (w.x * b.x - w.y * b.y) : (w.x * b.y + w.y * b.x);
      Etab[(size_t)g * 65536 + e] = f2bf(v);
    }
    for (int e = tid; e < 65536; e += 256) {
      const int row = e >> 7, pc = e & 127, pp = pc & 63, t = row >> 4, ho = row & 15;
      const float2 c = cc[ho * 64 + pp], w = pw[pp * 33 + t + 1];
      const float v = (pc < 64) ? (c.x * w.x - c.y * w.y) : -(c.x * w.y + c.y * w.x);
      Gtab[(size_t)g * 65536 + e] = f2bf(v);
    }
    if (tid < 64) AL[g * 64 + tid] = pw[tid * 33 + 32];
    __syncthreads();
  }
}

DI void phase_s5_end(const Params& p, bf16_t* smem) {
  const bf16_t* Etab = (const bf16_t*)(p.ws + OFF_ETAB); const bf16_t* hb = (const bf16_t*)(p.ws + OFF_HB);
  const float2* AL = (const float2*)(p.ws + OFF_AL);
  bf16_t* sin_ = (bf16_t*)(p.ws + OFF_SIN);
  float* endbuf = (float*)smem;
  for (int item = BID(); item < 512; item += GDIM()) {
    const int g = item >> 3, b = item & 7;
    auto al = [=](int row, int ks, int kc) { return *(const uint4*)(Etab + ((size_t)g * 128 + row) * 512 + ks * 64 + kc); };
    auto bl = [=](int n, int ks, int kc) {
      const int k = ks * 64 + kc, sidx = k >> 4, hi0 = k & 15;
      return *(const uint4*)(hb + ((size_t)(b * 4096 + n * 32 + sidx)) * 1024 + g * 16 + hi0);
    };
    gemm_tile(0, 0, 8, al, bl, [&](f32x4 (&acc)[4][4], int rb, int cb) {
      const int lane = TID() & 63, l15 = lane & 15, quad = lane >> 4;
#pragma unroll
      for (int mt = 0; mt < 4; ++mt)
#pragma unroll
        for (int nt = 0; nt < 4; ++nt)
#pragma unroll
          for (int r = 0; r < 4; ++r) endbuf[(rb + mt * 16 + quad * 4 + r) * 129 + cb + nt * 16 + l15] = acc[mt][nt][r];
    }, smem);
    __syncthreads();
    if (TID() < 64) {
      const int pp = TID();
      const float2 a = AL[g * 64 + pp];
      float sr = 0.f, si = 0.f;
      for (int n = 0; n < 128; ++n) {
        bf16_t* dst = sin_ + ((size_t)g * 1024 + b * 128 + n) * 128;
        dst[pp] = f2bf(sr); dst[64 + pp] = f2bf(si);
        const float er = endbuf[pp * 129 + n], ei = endbuf[(64 + pp) * 129 + n];
        const float nr = a.x * sr - a.y * si + er, ni = a.x * si + a.y * sr + ei;
        sr = nr; si = ni;
      }
    }
    __syncthreads();
  }
}

DI void phase_s5_y(const Params& p, int i, bf16_t* smem) {
  const bf16_t* Ktab = (const bf16_t*)(p.ws + OFF_KTAB); const bf16_t* Gtab = (const bf16_t*)(p.ws + OFF_GTAB);
  const bf16_t* hb = (const bf16_t*)(p.ws + OFF_HB); const bf16_t* sin_ = (const bf16_t*)(p.ws + OFF_SIN);
  bf16_t* hid = (bf16_t*)(p.ws + OFF_HID);
  for (int w = BID(); w < 2048; w += GDIM()) {
    const int g = w >> 5, mtile = (w >> 3) & 3, b = w & 7;
    const int nT = mtile * 2 + 2;
    auto al = [=](int row, int ks, int kc) -> uint4 {
      if (ks < nT) {
        const int k = ks * 64 + kc, sidx = k >> 4, hi0 = k & 15, t = row >> 4, ho = row & 15;
        if (t >= sidx) return *(const uint4*)(Ktab + (((size_t)g * 32 + (t - sidx)) * 16 + ho) * 16 + hi0);
        return make_uint4(0, 0, 0, 0);
      }
      return *(const uint4*)(Gtab + ((size_t)g * 512 + row) * 128 + (ks - nT) * 64 + kc);
    };
    auto bl = [=](int n, int ks, int kc) -> uint4 {
      if (ks < nT) {
        const int k = ks * 64 + kc, sidx = k >> 4, hi0 = k & 15;
        return *(const uint4*)(hb + ((size_t)(b * 4096 + n * 32 + sidx)) * 1024 + g * 16 + hi0);
      }
      return *(const uint4*)(sin_ + ((size_t)g * 1024 + b * 128 + n) * 128 + (ks - nT) * 64 + kc);
    };
    gemm_tile(mtile * 128, 0, nT + 2, al, bl, [&](f32x4 (&acc)[4][4], int rb, int cb) {
      const int lane = TID() & 63, l15 = lane & 15, quad = lane >> 4;
      const float4 dsk = *(const float4*)(p.s5_d + i * 1024 + g * 16 + quad * 4);
#pragma unroll
      for (int mt = 0; mt < 4; ++mt)
#pragma unroll
        for (int nt = 0; nt < 4; ++nt) {
          const int t = (rb + mt * 16) >> 4, n = cb + nt * 16 + l15;
          const size_t tok = (size_t)b * 4096 + n * 32 + t;
          const float4 u = *(const float4*)(p.out + tok * 1024 + g * 16 + quad * 4);
          u32x2 v;
          v[0] = pack2(gelu_tanh(acc[mt][nt][0] + dsk.x * u.x), gelu_tanh(acc[mt][nt][1] + dsk.y * u.y));
          v[1] = pack2(gelu_tanh(acc[mt][nt][2] + dsk.z * u.z), gelu_tanh(acc[mt][nt][3] + dsk.w * u.w));
          *(u32x2*)(hid + tok * 1024 + g * 16 + quad * 4) = v;
        }
    }, smem);
  }
}

DI void phase_glu(const Params& p, int i, bf16_t* smem) {
  const bf16_t* W = (const bf16_t*)(p.ws + OFF_W) + W_ODD0 + (size_t)i * SZ_GLU;
  PlainLoad al{(const bf16_t*)(p.ws + OFF_HID), 1024}, bl{W, 1024};
  for_tiles(256, 16, [&](int mi, int ni) {
    gemm_tile(mi * 128, ni * 128, 16, al, bl, [&](f32x4 (&acc)[4][4], int rb, int cb) {
      const int lane = TID() & 63, l15 = lane & 15, quad = lane >> 4;
#pragma unroll
      for (int mt = 0; mt < 4; ++mt)
#pragma unroll
        for (int np = 0; np < 2; ++np)
#pragma unroll
          for (int r = 0; r < 4; ++r) {
            float val = acc[mt][2 * np][r] * sigmoidf_(acc[mt][2 * np + 1][r]);
            size_t idx = (size_t)(rb + mt * 16 + quad * 4 + r) * 1024 + (cb >> 1) + np * 16 + l15;
            p.out[idx] = ALPHA * p.out[idx] + val;
          }
    }, smem);
  });
}

DI void phase_xproj(const Params& p, int l, bf16_t* smem) {
  const bf16_t* wc = (const bf16_t*)(p.ws + OFF_W) + (size_t)l * SZ_COMMON;
  {
    PlainLoad al{(const bf16_t*)(p.ws + OFF_HB), 1024}, bl{wc, 1024};
    bf16_t* q = (bf16_t*)(p.ws + OFF_XQ);
    for_tiles(256, 8, [&](int mi, int ni) {
      gemm_tile(mi * 128, ni * 128, 16, al, bl, [&](f32x4 (&acc)[4][4], int rb, int cb) { epi_bf16(q, 1024, acc, rb, cb); }, smem);
    });
  }
  {
    const float* memf = p.mem;
    auto al = [=](int row, int ks, int kc) -> uint4 {
      const float4* src = (const float4*)(memf + (size_t)row * 1024 + ks * 64 + kc);
      float4 a = src[0], b2 = src[1];
      return make_uint4(pack2(a.x, a.y), pack2(a.z, a.w), pack2(b2.x, b2.y), pack2(b2.z, b2.w));
    };
    bf16_t* kx = (bf16_t*)(p.ws + OFF_KX); bf16_t* vx = (bf16_t*)(p.ws + OFF_VX);
    for_tiles(16, 16, [&](int mi, int ni) {
      const bool isv = ni >= 8;
      PlainLoad bl{isv ? (wc + 2 * SZ_SQ) : (wc + SZ_SQ), 1024};
      gemm_tile(mi * 128, (ni & 7) * 128, 16, al, bl, [&](f32x4 (&acc)[4][4], int rb, int cb) {
        if (!isv) { epi_bf16(kx, 1024, acc, rb, cb); return; }
        if (!USE_XATTN_MFMA) { epi_bf16(vx, 1024, acc, rb, cb); return; }
        const int lane = TID() & 63, l15 = lane & 15, quad = lane >> 4;
#pragma unroll
        for (int mt = 0; mt < 4; ++mt)
#pragma unroll
          for (int nt = 0; nt < 4; ++nt) {
            const int row = rb + mt * 16 + quad * 4, col = cb + nt * 16 + l15;
            const int b = row >> 8, key = row & 255, h = col >> 8, d = col & 255;
            u32x2 v; v[0] = pack2(acc[mt][nt][0], acc[mt][nt][1]); v[1] = pack2(acc[mt][nt][2], acc[mt][nt][3]);
            *(u32x2*)(vx + ((size_t)((b * 4 + h) * 256 + d)) * 256 + key) = v;
          }
      }, smem);
    });
  }
}


DI void phase_xattn(const Params& p) {
  const int wave = TID() >> 6, lane = TID() & 63, l15 = lane & 15, quad = lane >> 4;
  const bf16_t* q = (const bf16_t*)(p.ws + OFF_XQ); const bf16_t* kx = (const bf16_t*)(p.ws + OFF_KX); const bf16_t* vxT = (const bf16_t*)(p.ws + OFF_VX);
  bf16_t* xo = (bf16_t*)(p.ws + OFF_XO);
  for (int item = BID(); item < 2048; item += GDIM()) {
    const int b = item >> 8, h = (item >> 6) & 3, qb = item & 63;
    const size_t tq = (size_t)b * 4096 + qb * 64 + wave * 16 + l15;
    bf16x8 qf[8];
#pragma unroll
    for (int ks = 0; ks < 8; ++ks) qf[ks] = *(const bf16x8*)(q + tq * 1024 + h * 256 + ks * 32 + quad * 8);
    f32x4 s[16];
#pragma unroll
    for (int mt = 0; mt < 16; ++mt) {
      const bf16_t* kp = kx + (size_t)(b * 256 + mt * 16 + l15) * 1024 + h * 256 + quad * 8;
      f32x4 a = {0.f, 0.f, 0.f, 0.f};
#pragma unroll
      for (int ks = 0; ks < 8; ++ks) a = MFMA16(*(const bf16x8*)(kp + ks * 32), qf[ks], a);
      s[mt] = a;
      if (mt & 1) __builtin_amdgcn_sched_barrier(0);
    }
    float m = -1e30f;
#pragma unroll
    for (int mt = 0; mt < 16; ++mt)
#pragma unroll
      for (int r = 0; r < 4; ++r) m = fmaxf(m, s[mt][r]);
    m = fmaxf(m, __shfl_xor(m, 16)); m = fmaxf(m, __shfl_xor(m, 32));
    const float c1 = 0.0625f * 1.4426950408889634f;
    float l = 0.f;
#pragma unroll
    for (int mt = 0; mt < 16; ++mt)
#pragma unroll
      for (int r = 0; r < 4; ++r) { float pv = exp2f((s[mt][r] - m) * c1); s[mt][r] = pv; l += pv; }
    l += __shfl_xor(l, 16); l += __shfl_xor(l, 32);
    f32x4 o[16];
#pragma unroll
    for (int dt = 0; dt < 16; ++dt) o[dt] = f32x4{0.f, 0.f, 0.f, 0.f};
#pragma unroll
    for (int s2 = 0; s2 < 8; ++s2) {
      const bf16x8 pf = pack8(s[2 * s2], s[2 * s2 + 1]);
#pragma unroll
      for (int dt = 0; dt < 16; ++dt) {
        const bf16_t* vp = vxT + ((size_t)((b * 4 + h) * 256 + dt * 16 + l15)) * 256 + s2 * 32 + quad * 4;
        u32x2 lo = *(const u32x2*)vp, hi = *(const u32x2*)(vp + 16);
        u32x4 t; t[0] = lo[0]; t[1] = lo[1]; t[2] = hi[0]; t[3] = hi[1];
        o[dt] = MFMA16(__builtin_bit_cast(bf16x8, t), pf, o[dt]);
      }
      __builtin_amdgcn_sched_barrier(0);
    }
    const float il = 1.f / l;
#pragma unroll
    for (int dt = 0; dt < 16; ++dt) {
      u32x2 v; v[0] = pack2(o[dt][0] * il, o[dt][1] * il); v[1] = pack2(o[dt][2] * il, o[dt][3] * il);
      *(u32x2*)(xo + tq * 1024 + h * 256 + dt * 16 + quad * 4) = v;
    }
  }
}

template <int R, int NT>
DI void dil_branch(const bf16_t* swk, const bf16_t* swv, size_t rowbase, int h, int tok0, const bf16x8 (&qf)[2], float& m, float& l, f32x4 (&o)[4],
                   int l15, int quad) {
  constexpr int U = 16 / R, W = 128 * R;
  f32x4 s[NT];
#pragma unroll
  for (int kt = 0; kt < NT; ++kt) {
    int kap = tok0 - W + R * (kt * 16 + l15);
    kap = min(max(kap, 0), 4095);
    const bf16_t* kp = swk + (rowbase + kap) * 512 + h * 64 + quad * 8;
    f32x4 a = {0.f, 0.f, 0.f, 0.f};
    a = MFMA16(*(const bf16x8*)kp, qf[0], a);
    a = MFMA16(*(const bf16x8*)(kp + 32), qf[1], a);
    s[kt] = a;
    if ((kt & 3) == 3) __builtin_amdgcn_sched_barrier(0);
  }
  float mx = m;
  const float c1 = 0.125f * 1.4426950408889634f;
#pragma unroll
  for (int kt = 0; kt < NT; ++kt)
#pragma unroll
    for (int r2 = 0; r2 < 4; ++r2) {
      const int c = kt * 16 + quad * 4 + r2;
      const int dist = U * l15 + 128 - c;
      const int kap = tok0 - W + R * c;
      const bool ok = (dist >= 0) && (dist <= 128) && (kap >= 0);
      const float v = ok ? s[kt][r2] * c1 : -1e30f;
      s[kt][r2] = v; mx = fmaxf(mx, v);
    }
  mx = fmaxf(mx, __shfl_xor(mx, 16)); mx = fmaxf(mx, __shfl_xor(mx, 32));
  const float corr = exp2f(m - mx);
  m = mx; l *= corr;
#pragma unroll
  for (int dt = 0; dt < 4; ++dt) { o[dt][0] *= corr; o[dt][1] *= corr; o[dt][2] *= corr; o[dt][3] *= corr; }
#pragma unroll
  for (int kt = 0; kt < NT; ++kt)
#pragma unroll
    for (int r2 = 0; r2 < 4; ++r2) { float pv = exp2f(s[kt][r2] - mx); s[kt][r2] = pv; l += pv; }
  constexpr int NS = (NT + 1) / 2;
#pragma unroll
  for (int s2 = 0; s2 < NS; ++s2) {
    const f32x4 z4 = {0.f, 0.f, 0.f, 0.f};
    const bf16x8 pf = pack8(s[2 * s2], (2 * s2 + 1 < NT) ? s[(2 * s2 + 1 < NT) ? 2 * s2 + 1 : 0] : z4);
    const bf16_t* vp[8];
#pragma unroll
    for (int j = 0; j < 8; ++j) {
      const int c = (2 * s2 + (j >> 2)) * 16 + quad * 4 + (j & 3);
      int kap = tok0 - W + R * c;
      kap = min(max(kap, 0), 4095);
      vp[j] = swv + (rowbase + kap) * 512 + h * 64 + l15;
    }
#pragma unroll
    for (int dt = 0; dt < 4; ++dt) {
      bf16x8 vf;
#pragma unroll
      for (int j = 0; j < 8; ++j) vf[j] = (short)vp[j][dt * 16];
      o[dt] = MFMA16(vf, pf, o[dt]);
    }
    __builtin_amdgcn_sched_barrier(0);
  }
}

DI void phase_dil_attn(const Params& p, int first, int nblk) {
  const int wave = TID() >> 6, lane = TID() & 63, l15 = lane & 15, quad = lane >> 4;
  bf16_t* swq = (bf16_t*)(p.ws + OFF_SWQ); const bf16_t* swk = (const bf16_t*)(p.ws + OFF_SWK); const bf16_t* swv = (const bf16_t*)(p.ws + OFF_SWV);
  for (int item = first; item < 4096; item += nblk) {
    const int b = item >> 9, h = (item >> 6) & 7, G = (item >> 2) & 15, sub = item & 3;
    const int tok0 = G * 256 + sub * 4 + wave;
    const size_t rowbase = (size_t)b * 4096;
    const size_t tq = rowbase + tok0 + 16 * l15;
    bf16x8 qf[2];
    qf[0] = *(const bf16x8*)(swq + tq * 512 + h * 64 + quad * 8);
    qf[1] = *(const bf16x8*)(swq + tq * 512 + h * 64 + 32 + quad * 8);
    float m = -1e30f, l = 0.f;
    f32x4 o[4];
#pragma unroll
    for (int dt = 0; dt < 4; ++dt) o[dt] = f32x4{0.f, 0.f, 0.f, 0.f};
    dil_branch<16, 9>(swk, swv, rowbase, h, tok0, qf, m, l, o, l15, quad);
    dil_branch<4, 12>(swk, swv, rowbase, h, tok0, qf, m, l, o, l15, quad);
    dil_branch<1, 24>(swk, swv, rowbase, h, tok0, qf, m, l, o, l15, quad);
    l += __shfl_xor(l, 16); l += __shfl_xor(l, 32);
    const float il = 1.f / l;
#pragma unroll
    for (int dt = 0; dt < 4; ++dt) {
      u32x2 v; v[0] = pack2(o[dt][0] * il, o[dt][1] * il); v[1] = pack2(o[dt][2] * il, o[dt][3] * il);
      *(u32x2*)(swq + tq * 512 + h * 64 + dt * 16 + quad * 4) = v;
    }
  }
}

DI void phase_xo(const Params& p, int l, bf16_t* smem) {
  const bf16_t* wc = (const bf16_t*)(p.ws + OFF_W) + (size_t)l * SZ_COMMON + 3 * SZ_SQ;
  PlainLoad al{(const bf16_t*)(p.ws + OFF_XO), 1024}, bl{wc, 1024};
  for_tiles(256, 8, [&](int mi, int ni) {
    gemm_tile(mi * 128, ni * 128, 16, al, bl, [&](f32x4 (&acc)[4][4], int rb, int cb) { epi_resid(p, acc, rb, cb); }, smem);
  });
}

DI void phase_ffn_gu(const Params& p, int l, bf16_t* smem) {
  const bf16_t* W = (const bf16_t*)(p.ws + OFF_W) + (size_t)l * SZ_COMMON + 4 * SZ_SQ;
  PlainLoad al{(const bf16_t*)(p.ws + OFF_HB), 1024}, bl{W, 1024};
  bf16_t* act = (bf16_t*)(p.ws + OFF_ACT);
  for_tiles(256, 44, [&](int mi, int ni) {
    gemm_tile(mi * 128, ni * 128, 16, al, bl, [&](f32x4 (&acc)[4][4], int rb, int cb) {
      const int lane = TID() & 63, l15 = lane & 15, quad = lane >> 4;
#pragma unroll
      for (int mt = 0; mt < 4; ++mt)
#pragma unroll
        for (int np = 0; np < 2; ++np)
#pragma unroll
          for (int r = 0; r < 4; ++r) {
            float val = siluf_(acc[mt][2 * np][r]) * acc[mt][2 * np + 1][r];
            act[(size_t)(rb + mt * 16 + quad * 4 + r) * 2816 + (cb >> 1) + np * 16 + l15] = f2bf(val);
          }
    }, smem);
  });
}
DI void phase_ffn_down(const Params& p, int l, bf16_t* smem) {
  const bf16_t* W = (const bf16_t*)(p.ws + OFF_W) + (size_t)l * SZ_COMMON + 4 * SZ_SQ + SZ_GU;
  PlainLoad al{(const bf16_t*)(p.ws + OFF_ACT), 2816}, bl{W, 2816};
  for_tiles(256, 8, [&](int mi, int ni) {
    gemm_tile(mi * 128, ni * 128, 44, al, bl, [&](f32x4 (&acc)[4][4], int rb, int cb) { epi_resid(p, acc, rb, cb); }, smem);
  });
}


#define XB_TMO      128
#define XB_XCNT(j)  (256  + 64 * (j))
#define XB_XSUB(j)  (1280 + 64 * (j))
#define XB_XGEN(j)  (2304 + 64 * (j))
#define XB_TOP      3328
#define XB_TOPGEN   3392
#define XCD_BAR_WORDS 3456
#define XB_SPIN_CAP (1u << 22)
#define LAS __attribute__((address_space(3)))
DI unsigned xb_ld(unsigned* p) { return __hip_atomic_load(p, __ATOMIC_RELAXED, __HIP_MEMORY_SCOPE_AGENT); }
DI unsigned xb_add(unsigned* p, unsigned v) { return __hip_atomic_fetch_add(p, v, __ATOMIC_RELAXED, __HIP_MEMORY_SCOPE_AGENT); }
DI unsigned xb_xcc_id() { return (unsigned)__builtin_amdgcn_s_getreg((3 << 11) | 20) & 0xFu; }
#define XB_SPIN(cond, bar) do { unsigned _sp = 0; while (cond) { __builtin_amdgcn_s_sleep(1); \
    if ((++_sp & 255u) == 0u) { if (xb_ld(&(bar)[XB_TMO])) break; if (_sp > XB_SPIN_CAP) { atomicAdd(&(bar)[XB_TMO], 1u); break; } } } } while (0)
struct XcdBarrier { unsigned* bar; unsigned x; volatile LAS unsigned* st; };
DI XcdBarrier xcd_barrier_post(unsigned* bar, volatile LAS unsigned* st) {
  XcdBarrier b; b.bar = bar; b.x = xb_xcc_id(); b.st = st;
  if (threadIdx.x == 0) (void)xb_add(&bar[XB_XCNT(b.x)], 1u);
  return b;
}
DI void xcd_barrier_complete(unsigned* bar, unsigned x, unsigned& nloc, unsigned& nx) {
  const unsigned G = gridDim.x * gridDim.y * gridDim.z;
  unsigned sum, cnt, mine, sp = 0u;
  for (;;) {
    sum = 0u; cnt = 0u; mine = 0u;
#pragma unroll
    for (unsigned j = 0; j < 16; ++j) { const unsigned c = xb_ld(&bar[XB_XCNT(j)]); sum += c; cnt += (c > 0u) ? 1u : 0u; mine = (j == x) ? c : mine; }
    if (sum == G) break;
    __builtin_amdgcn_s_sleep(1);
    if ((++sp & 255u) == 0u) { if (xb_ld(&bar[XB_TMO])) break; if (sp > XB_SPIN_CAP) { atomicAdd(&bar[XB_TMO], 1u); break; } }
  }
  nloc = mine > 0u ? mine : 1u; nx = cnt > 0u ? cnt : 1u;
}
DI void xcd_barrier(const XcdBarrier& b) {
  asm volatile("s_waitcnt vmcnt(0)" ::: "memory");
  __syncthreads();
  if (threadIdx.x == 0) {
    unsigned* bar = b.bar;
    __builtin_amdgcn_s_waitcnt(0);
    unsigned nloc = b.st[0], nx = b.st[1];
    if (nloc == 0u) { xcd_barrier_complete(bar, b.x, nloc, nx); b.st[0] = nloc; b.st[1] = nx; }
    const unsigned old = xb_add(&bar[XB_XSUB(b.x)], 1u);
    const unsigned gen = old / nloc;
    if (old + 1u == (gen + 1u) * nloc) {
      __builtin_amdgcn_fence(__ATOMIC_RELEASE, "agent");
      asm volatile("s_waitcnt vmcnt(0)" ::: "memory");
      const unsigned og = xb_add(&bar[XB_TOP], 1u);
      const unsigned tg = og / nx;
      if (og + 1u == (tg + 1u) * nx) xb_add(&bar[XB_TOPGEN], 1u);
      else XB_SPIN(xb_ld(&bar[XB_TOPGEN]) == tg, bar);
      __builtin_amdgcn_fence(__ATOMIC_ACQUIRE, "agent");
      xb_add(&bar[XB_XGEN(b.x)], 1u);
      asm volatile("s_waitcnt vmcnt(0)" ::: "memory");
    } else {
      XB_SPIN(xb_ld(&bar[XB_XGEN(b.x)]) == gen, bar);
      __builtin_amdgcn_fence(__ATOMIC_ACQUIRE, "agent");
      asm volatile("s_waitcnt vmcnt(0)" ::: "memory");
    }
  }
  __syncthreads();
}

__global__ void __launch_bounds__(256, 2) fwd_megakernel(Params p) {
  cg::grid_group grid = cg::this_grid();
  __shared__ __attribute__((aligned(16))) char smem_raw[2 * 2 * 128 * LDT * 2];
  bf16_t* sm16 = (bf16_t*)smem_raw; float* sm32 = (float*)smem_raw;

  __shared__ uint4 xb_words;
  if (threadIdx.x == 0) xb_words = make_uint4(0u, 0u, 0u, 0u);
  __syncthreads();
  XcdBarrier xb = xcd_barrier_post((unsigned*)(p.ws + OFF_BAR), (volatile LAS unsigned*)&xb_words);
  phase_prologue(p, sm32);
  grid.sync();
  for (int l = 0; l < 4; ++l) {
    const int i = l >> 1;
    if ((l & 1) == 0) {
      phase_proj(p, i, sm16); xcd_barrier(xb);
      phase_dn_prep(p, i, smem_raw); xcd_barrier(xb);
      phase_mix(p, i); xcd_barrier(xb);
      phase_dn_post(p, i); xcd_barrier(xb);
      phase_wout(p, i, sm16); xcd_barrier(xb);
    } else {
#if USE_S5_GEMM
      phase_s5_tables(p, i, sm32); xcd_barrier(xb);
      phase_s5_end(p, sm16); xcd_barrier(xb);
      phase_s5_y(p, i, sm16); xcd_barrier(xb);
#else
      phase_s5_naive(p, i); xcd_barrier(xb);
#endif
      phase_glu(p, i, sm16); xcd_barrier(xb);
    }
    phase_ln(p, p.ln_mix_g + l * 1024, p.ln_mix_b + l * 1024); xcd_barrier(xb);
    phase_xproj(p, l, sm16); xcd_barrier(xb);
    phase_xattn(p); xcd_barrier(xb);
    phase_xo(p, l, sm16); xcd_barrier(xb);
    phase_ln(p, p.ln_x_g + l * 1024, p.ln_x_b + l * 1024); xcd_barrier(xb);
    phase_ffn_gu(p, l, sm16); xcd_barrier(xb);
    phase_ffn_down(p, l, sm16); xcd_barrier(xb);
    phase_ln(p, p.ln_ffn_g + l * 1024, p.ln_ffn_b + l * 1024); xcd_barrier(xb);
  }
}

extern "C" void kernel_launch(void* const* d_in, const int* in_sizes, int n_in, void* d_out, int out_size, void* d_ws, size_t ws_size,
                              hipStream_t stream) {
  static int grid_blocks = 0;
  if (!grid_blocks) {
    int dev = 0, cus = 0, per_cu = 0;
    hipGetDevice(&dev);
    hipDeviceGetAttribute(&cus, hipDeviceAttributeMultiprocessorCount, dev);
    hipOccupancyMaxActiveBlocksPerMultiprocessor(&per_cu, fwd_megakernel, 256, 0);
    if (per_cu > 2) per_cu = 2;
    if (per_cu < 1) per_cu = 1;
    grid_blocks = cus * per_cu;
    grid_blocks -= grid_blocks % 8;
  }
  Params p{};
  const float** pf = (const float**)&p;
  for (int i = 0; i < 32; ++i) pf[i] = (const float*)d_in[i];
  p.pos = (const int*)d_in[2];
  p.out = (float*)d_out; p.ws = (char*)d_ws;
  hipMemsetAsync((char*)d_ws + OFF_BAR, 0, XCD_BAR_WORDS * sizeof(unsigned), stream);
  void* args[] = {&p};
  hipError_t e = hipLaunchCooperativeKernel((void*)fwd_megakernel, dim3(grid_blocks), dim3(256), args, 0, stream);
  if (e != hipSuccess) fprintf(stderr, "cooperative launch failed: %s (grid %d)\n", hipGetErrorString(e), grid_blocks);
}
```

```cpp
#include <hip/hip_runtime.h>
#include <hip/hip_cooperative_groups.h>
#include <cstdio>
namespace cg = cooperative_groups;
#ifndef USE_XATTN_MFMA
#define USE_XATTN_MFMA 1
#endif
#ifndef USE_S5_GEMM
#define USE_S5_GEMM 1
#endif
#ifndef USE_DIL_MFMA
#define USE_DIL_MFMA 1
#endif

typedef unsigned short bf16_t;
using bf16x8 = __attribute__((ext_vector_type(8))) short;
using f32x4 = __attribute__((ext_vector_type(4))) float;
#define DI __device__ __forceinline__

constexpr int T_ = 32768, S_ = 4096;
constexpr size_t MiB = (size_t)1 << 20;
constexpr size_t SZ_SQ = (size_t)1024 * 1024, SZ_WIN = (size_t)3712 * 1024, SZ_GLU = (size_t)2048 * 1024,
                 SZ_GU = (size_t)5632 * 1024, SZ_WD = (size_t)1024 * 2816;
constexpr size_t SZ_COMMON = 4 * SZ_SQ + SZ_GU + SZ_WD;
constexpr size_t W_EVEN0 = 4 * SZ_COMMON;
constexpr size_t W_ODD0 = W_EVEN0 + 2 * (SZ_WIN + SZ_SQ);
constexpr float ALPHA = 1.681792830507429f;

constexpr size_t OFF_W = 0;
constexpr size_t OFF_ROPE = 125 * MiB;
constexpr size_t OFF_HB = 133 * MiB;
constexpr size_t OFF_KX = 197 * MiB;
constexpr size_t OFF_VX = 201 * MiB;
constexpr size_t OFF_BIG = 205 * MiB;
constexpr size_t OFF_BAR = 511 * MiB;
constexpr size_t OFF_DNQKV = OFF_BIG;
constexpr size_t OFF_Z = OFF_BIG + 96 * MiB;
constexpr size_t OFF_SWQ = OFF_BIG + 128 * MiB;
constexpr size_t OFF_SWK = OFF_BIG + 160 * MiB;
constexpr size_t OFF_SWV = OFF_BIG + 192 * MiB;
constexpr size_t OFF_LOGIT = OFF_BIG + 224 * MiB;
constexpr size_t OFF_QD = OFF_BIG + 225 * MiB;
constexpr size_t OFF_KD = OFF_BIG + 257 * MiB;
constexpr size_t OFF_INTRA = OFF_BIG + 289 * MiB;
constexpr size_t OFF_WB = OFF_HB;
constexpr size_t OFF_UB = OFF_HB + 32 * MiB;
constexpr size_t OFF_EG = OFF_KX;
constexpr size_t OFF_XQ = OFF_BIG;
constexpr size_t OFF_XO = OFF_BIG + 64 * MiB;
constexpr size_t OFF_ACT = OFF_BIG;
constexpr size_t OFF_HID = OFF_BIG;
constexpr size_t OFF_SIN = OFF_BIG + 64 * MiB;
constexpr size_t OFF_KTAB = OFF_BIG + 80 * MiB;
constexpr size_t OFF_ETAB = OFF_BIG + 82 * MiB;
constexpr size_t OFF_GTAB = OFF_BIG + 90 * MiB;
constexpr size_t OFF_AL = OFF_BIG + 98 * MiB;

struct Params {
  const float* x; const float* mem; const int* pos;
  const float* hyb_w_in; const float* dn_conv_w; const float* dn_a_log; const float* dn_dt_bias; const float* dn_norm_g; const float* hyb_w_out;
  const float* s5_a_re; const float* s5_a_im; const float* s5_log_dt; const float* s5_b_re; const float* s5_b_im; const float* s5_c_re; const float* s5_c_im;
  const float* s5_d; const float* s5_glu_wo; const float* s5_glu_wg;
  const float* ln_mix_g; const float* ln_mix_b;
  const float* xq_w; const float* xk_w; const float* xv_w; const float* xo_w; const float* ln_x_g; const float* ln_x_b;
  const float* ffn_wg; const float* ffn_wu; const float* ffn_wd; const float* ln_ffn_g; const float* ln_ffn_b;
  float* out; char* ws;
};

DI int TID() { int t = threadIdx.x; asm volatile("" : "+v"(t)); return t; }
DI int BID() { int t = blockIdx.x; asm volatile("" : "+s"(t)); return t; }
DI int GDIM() { int t = gridDim.x; asm volatile("" : "+s"(t)); return t; }
DI bf16_t f2bf(float x) { unsigned u = __float_as_uint(x); u += 0x7fffu + ((u >> 16) & 1u); return (bf16_t)(u >> 16); }
DI float bf2f(bf16_t v) { return __uint_as_float(((unsigned)v) << 16); }
DI unsigned pack2(float a, float b) { return (unsigned)f2bf(a) | ((unsigned)f2bf(b) << 16); }
using u32x4 = __attribute__((ext_vector_type(4))) unsigned;
using u32x2 = __attribute__((ext_vector_type(2))) unsigned;
DI bf16x8 pack8(f32x4 a, f32x4 b) {
  u32x4 t; t[0] = pack2(a[0], a[1]); t[1] = pack2(a[2], a[3]); t[2] = pack2(b[0], b[1]); t[3] = pack2(b[2], b[3]);
  return __builtin_bit_cast(bf16x8, t);
}
#define MFMA16(a, b, c) __builtin_amdgcn_mfma_f32_16x16x32_bf16((a), (b), (c), 0, 0, 0)
DI float wave_sum(float v) { for (int o = 32; o > 0; o >>= 1) v += __shfl_xor(v, o); return v; }
DI float wave_max(float v) { for (int o = 32; o > 0; o >>= 1) v = fmaxf(v, __shfl_xor(v, o)); return v; }
DI float sigmoidf_(float x) { return 1.f / (1.f + __expf(-x)); }
DI float siluf_(float x) { return x * sigmoidf_(x); }
DI float softplusf_(float x) { return fmaxf(x, 0.f) + log1pf(__expf(-fabsf(x))); }
DI float gelu_tanh(float x) { float u = 0.7978845608028654f * (x + 0.044715f * x * x * x); return 0.5f * x * (1.f + tanhf(u)); }

template <class CM>
DI void transpose_job(bf16_t* dst, int Ndst, int K, int srcStride, CM colptr, float* tile) {
  const int ntk = K / 64, ntiles = (Ndst / 64) * ntk;
  for (int tl = BID(); tl < ntiles; tl += GDIM()) {
    const int r0 = (tl / ntk) * 64, k0 = (tl % ntk) * 64;
    const int rl = TID() & 63, ks = TID() >> 6;
    const float* cp = colptr(r0 + rl);
    for (int i = 0; i < 16; ++i) { int kl = ks * 16 + i; tile[kl * 65 + rl] = cp ? cp[(size_t)(k0 + kl) * srcStride] : 0.f; }
    __syncthreads();
    const int kk = TID() & 63, rs = TID() >> 6;
    for (int i = 0; i < 16; ++i) { int rr = i * 4 + rs; dst[(size_t)(r0 + rr) * K + k0 + kk] = f2bf(tile[kk * 65 + rr]); }
    __syncthreads();
  }
}

DI void phase_prologue(const Params& p, float* smem) {
  bf16_t* W = (bf16_t*)(p.ws + OFF_W);
  for (int l = 0; l < 4; ++l) {
    bf16_t* wc = W + (size_t)l * SZ_COMMON;
    const float* s;
    s = p.xq_w + (size_t)l * SZ_SQ; transpose_job(wc, 1024, 1024, 1024, [=](int r) { return s + r; }, smem);
    s = p.xk_w + (size_t)l * SZ_SQ; transpose_job(wc + SZ_SQ, 1024, 1024, 1024, [=](int r) { return s + r; }, smem);
    s = p.xv_w + (size_t)l * SZ_SQ; transpose_job(wc + 2 * SZ_SQ, 1024, 1024, 1024, [=](int r) { return s + r; }, smem);
    s = p.xo_w + (size_t)l * SZ_SQ; transpose_job(wc + 3 * SZ_SQ, 1024, 1024, 1024, [=](int r) { return s + r; }, smem);
    {
      const float* g = p.ffn_wg + (size_t)l * 1024 * 2816; const float* u = p.ffn_wu + (size_t)l * 1024 * 2816;
      transpose_job(wc + 4 * SZ_SQ, 5632, 1024, 2816, [=](int r) { int c = (r >> 5) * 16 + (r & 15); return ((r >> 4) & 1) ? (u + c) : (g + c); }, smem);
    }
    s = p.ffn_wd + (size_t)l * 2816 * 1024; transpose_job(wc + 4 * SZ_SQ + SZ_GU, 1024, 2816, 1024, [=](int r) { return s + r; }, smem);
  }
  for (int i = 0; i < 2; ++i) {
    bf16_t* we = W + W_EVEN0 + (size_t)i * (SZ_WIN + SZ_SQ);
    const float* s = p.hyb_w_in + (size_t)i * 1024 * 3592;
    transpose_job(we, 3712, 1024, 3592, [=](int r) -> const float* {
      if (r < 2048) return s + r;
      if (r < 3584) return s + r + 8;
      if (r < 3592) return s + 2048 + (r - 3584);
      return nullptr; }, smem);
    const float* s2 = p.hyb_w_out + (size_t)i * SZ_SQ;
    transpose_job(we + SZ_WIN, 1024, 1024, 1024, [=](int r) { return s2 + r; }, smem);
    bf16_t* wo = W + W_ODD0 + (size_t)i * SZ_GLU;
    const float* a = p.s5_glu_wo + (size_t)i * SZ_SQ; const float* b = p.s5_glu_wg + (size_t)i * SZ_SQ;
    transpose_job(wo, 2048, 1024, 1024, [=](int r) { int c = (r >> 5) * 16 + (r & 15); return ((r >> 4) & 1) ? (b + c) : (a + c); }, smem);
  }
  const size_t gtid = (size_t)BID() * 256 + TID(), gsz = (size_t)GDIM() * 256;
  bf16_t* hb = (bf16_t*)(p.ws + OFF_HB);
  for (size_t i = gtid; i < (size_t)T_ * 256; i += gsz) {
    float4 v = ((const float4*)p.x)[i];
    ((float4*)p.out)[i] = v;
    uint2 o; o.x = pack2(v.x, v.y); o.y = pack2(v.z, v.w);
    ((uint2*)hb)[i] = o;
  }
  float* rc = (float*)(p.ws + OFF_ROPE); float* rs = rc + (size_t)T_ * 32;
  for (size_t i = gtid; i < (size_t)T_ * 32; i += gsz) {
    int t = (int)(i >> 5), j = (int)(i & 31);
    float invf = (float)exp(-(double)(2 * j) / 64.0 * 9.210340371976184);
    float ang = (float)p.pos[t] * invf;
    double a = (double)ang;
    double k = rint(a * 0.15915494309189535);
    float r = (float)(a - k * 6.283185307179586);
    rc[i] = cosf(r); rs[i] = sinf(r);
  }
}

constexpr int LDT = 72;
template <class AL, class BL, class EP>
DI void gemm_tile(int m0, int n0, int nks, AL aload, BL bload, EP epi, bf16_t* smem) {
  bf16_t* As = smem; bf16_t* Bs = smem + 2 * 128 * LDT;
  const int tid = TID(), lane = tid & 63, wave = tid >> 6;
  const int wm = wave >> 1, wn = wave & 1, l15 = lane & 15, quad = lane >> 4;
  const int lrow = tid >> 3, lkc = (tid & 7) * 8;
  f32x4 acc[4][4];
#pragma unroll
  for (int i = 0; i < 4; ++i)
#pragma unroll
    for (int j = 0; j < 4; ++j) acc[i][j] = f32x4{0.f, 0.f, 0.f, 0.f};
  uint4 ra0[4], rb0[4], ra1[4], rb1[4];
#pragma unroll
  for (int i = 0; i < 4; ++i) { ra0[i] = aload(m0 + lrow + 32 * i, 0, lkc); rb0[i] = bload(n0 + lrow + 32 * i, 0, lkc); }
#pragma unroll
  for (int i = 0; i < 4; ++i) { ra1[i] = aload(m0 + lrow + 32 * i, 1, lkc); rb1[i] = bload(n0 + lrow + 32 * i, 1, lkc); }
#pragma unroll
  for (int i = 0; i < 4; ++i) {
    *(uint4*)(As + (lrow + 32 * i) * LDT + lkc) = ra0[i];
    *(uint4*)(Bs + (lrow + 32 * i) * LDT + lkc) = rb0[i];
  }
  __syncthreads();
  auto compute = [&](int cur) {
    const bf16_t* Ab = As + cur * 128 * LDT; const bf16_t* Bb = Bs + cur * 128 * LDT;
#pragma unroll
    for (int kk = 0; kk < 2; ++kk) {
      bf16x8 a[4], b[4];
#pragma unroll
      for (int mt = 0; mt < 4; ++mt) a[mt] = *(const bf16x8*)(Ab + (wm * 64 + mt * 16 + l15) * LDT + kk * 32 + quad * 8);
#pragma unroll
      for (int nt = 0; nt < 4; ++nt) b[nt] = *(const bf16x8*)(Bb + (wn * 64 + nt * 16 + l15) * LDT + kk * 32 + quad * 8);
#pragma unroll
      for (int mt = 0; mt < 4; ++mt)
#pragma unroll
        for (int nt = 0; nt < 4; ++nt) acc[mt][nt] = __builtin_amdgcn_mfma_f32_16x16x32_bf16(a[mt], b[nt], acc[mt][nt], 0, 0, 0);
    }
  };
  for (int ks = 0; ks < nks; ks += 2) {
    if (ks + 2 < nks) {
#pragma unroll
      for (int i = 0; i < 4; ++i) { ra0[i] = aload(m0 + lrow + 32 * i, ks + 2, lkc); rb0[i] = bload(n0 + lrow + 32 * i, ks + 2, lkc); }
    }
    compute(0);
#pragma unroll
    for (int i = 0; i < 4; ++i) {
      *(uint4*)(As + 128 * LDT + (lrow + 32 * i) * LDT + lkc) = ra1[i];
      *(uint4*)(Bs + 128 * LDT + (lrow + 32 * i) * LDT + lkc) = rb1[i];
    }
    __syncthreads();
    if (ks + 3 < nks) {
#pragma unroll
      for (int i = 0; i < 4; ++i) { ra1[i] = aload(m0 + lrow + 32 * i, ks + 3, lkc); rb1[i] = bload(n0 + lrow + 32 * i, ks + 3, lkc); }
    }
    compute(1);
    if (ks + 2 < nks) {
#pragma unroll
      for (int i = 0; i < 4; ++i) {
        *(uint4*)(As + (lrow + 32 * i) * LDT + lkc) = ra0[i];
        *(uint4*)(Bs + (lrow + 32 * i) * LDT + lkc) = rb0[i];
      }
    }
    __syncthreads();
  }
  epi(acc, m0 + wm * 64, n0 + wn * 64);
}

template <class F>
DI void for_tiles(int mtiles, int ntiles, F f) {
  const int xcd = BID() & 7, slot = BID() >> 3, nslot = GDIM() >> 3;
  const int per = (mtiles >> 3) * ntiles;
  for (int w = slot; w < per; w += nslot) {
    int mi = w / ntiles, ni = w - mi * ntiles;
    f((mi * 8 + xcd), ni);
  }
}

#define EPI_LOOP for (int mt = 0; mt < 4; ++mt) for (int nt = 0; nt < 4; ++nt) for (int r = 0; r < 4; ++r)

DI void epi_resid(const Params& p, f32x4 (&acc)[4][4], int rb, int cb) {
  const int lane = TID() & 63, l15 = lane & 15, quad = lane >> 4;
#pragma unroll
  for (int mt = 0; mt < 4; ++mt)
#pragma unroll
    for (int nt = 0; nt < 4; ++nt)
#pragma unroll
      for (int r = 0; r < 4; ++r) {
        size_t idx = (size_t)(rb + mt * 16 + quad * 4 + r) * 1024 + cb + nt * 16 + l15;
        p.out[idx] = ALPHA * p.out[idx] + acc[mt][nt][r];
      }
}
DI void epi_bf16(bf16_t* dst, int ld, f32x4 (&acc)[4][4], int rb, int cb) {
  const int lane = TID() & 63, l15 = lane & 15, quad = lane >> 4;
#pragma unroll
  for (int mt = 0; mt < 4; ++mt)
#pragma unroll
    for (int nt = 0; nt < 4; ++nt)
#pragma unroll
      for (int r = 0; r < 4; ++r)
        dst[(size_t)(rb + mt * 16 + quad * 4 + r) * ld + cb + nt * 16 + l15] = f2bf(acc[mt][nt][r]);
}

struct PlainLoad {
  const bf16_t* base; int ld;
  DI uint4 operator()(int row, int ks, int kc) const { return *(const uint4*)((const char*)base + (unsigned)((row * ld + ks * 64 + kc) * 2)); }
};

DI void phase_proj(const Params& p, int i, bf16_t* smem) {
  const bf16_t* W = (const bf16_t*)(p.ws + OFF_W) + W_EVEN0 + (size_t)i * (SZ_WIN + SZ_SQ);
  PlainLoad al{(const bf16_t*)(p.ws + OFF_HB), 1024}, bl{W, 1024};
  bf16_t* dnqkv = (bf16_t*)(p.ws + OFF_DNQKV); bf16_t* z = (bf16_t*)(p.ws + OFF_Z);
  bf16_t* swq = (bf16_t*)(p.ws + OFF_SWQ); bf16_t* swk = (bf16_t*)(p.ws + OFF_SWK); bf16_t* swv = (bf16_t*)(p.ws + OFF_SWV);
  float* logit = (float*)(p.ws + OFF_LOGIT);
  const float* rc = (const float*)(p.ws + OFF_ROPE); const float* rs = rc + (size_t)T_ * 32;
  for_tiles(256, 29, [&](int mi, int ni) {
    gemm_tile(mi * 128, ni * 128, 16, al, bl, [&](f32x4 (&acc)[4][4], int rb, int cb) {
      const int lane = TID() & 63, l15 = lane & 15, quad = lane >> 4;
      if (cb < 1536) epi_bf16(dnqkv, 1536, acc, rb, cb);
      else if (cb < 2048) epi_bf16(z, 512, acc, rb, cb - 1536);
      else if (cb < 3072) {
        bf16_t* dst = (cb < 2560) ? swq : swk; const int c0 = (cb < 2560) ? cb - 2048 : cb - 2560;
#pragma unroll
        for (int mt = 0; mt < 4; ++mt)
#pragma unroll
          for (int r = 0; r < 4; ++r) {
            const int row = rb + mt * 16 + quad * 4 + r;
#pragma unroll
            for (int nt = 0; nt < 2; ++nt) {
              const int d = nt * 16 + l15;
              float c = rc[(size_t)row * 32 + d], s = rs[(size_t)row * 32 + d];
              float x1 = acc[mt][nt][r], x2 = acc[mt][nt + 2][r];
              dst[(size_t)row * 512 + c0 + d] = f2bf(x1 * c - x2 * s);
              dst[(size_t)row * 512 + c0 + d + 32] = f2bf(x2 * c + x1 * s);
            }
          }
      } else if (cb < 3584) epi_bf16(swv, 512, acc, rb, cb - 3072);
      else if (cb == 3584) {
#pragma unroll
        for (int mt = 0; mt < 4; ++mt)
#pragma unroll
          for (int r = 0; r < 4; ++r)
            if (l15 < 8) logit[(size_t)(rb + mt * 16 + quad * 4 + r) * 8 + l15] = acc[mt][0][r];
      }
    }, smem);
  });
}

DI void phase_dil_attn(const Params& p, int first, int nblk);

DI void phase_dn_prep(const Params& p, int i, char* smem) {
  bf16_t* qs = (bf16_t*)smem; bf16_t* ks = qs + 64 * 136; bf16_t* vs = ks + 64 * 136;
  float* Lm = (float*)(smem + 3 * 17408); float* beta = Lm + 64 * 68; float* gcum = beta + 64; float* egc = gcum + 64;
  const bf16_t* dnqkv = (const bf16_t*)(p.ws + OFF_DNQKV);
  const float* logit = (const float*)(p.ws + OFF_LOGIT);
  bf16_t* qd_g = (bf16_t*)(p.ws + OFF_QD); bf16_t* kd_g = (bf16_t*)(p.ws + OFF_KD); bf16_t* in_g = (bf16_t*)(p.ws + OFF_INTRA);
  bf16_t* w_g = (bf16_t*)(p.ws + OFF_WB); bf16_t* u_g = (bf16_t*)(p.ws + OFF_UB); float* eg_g = (float*)(p.ws + OFF_EG);
  const float* cw = p.dn_conv_w + (size_t)i * 4 * 1536;
  const int tid = TID(), wave = tid >> 6, lane = tid & 63, l15 = lane & 15, quad = lane >> 4;
  const float QS = 0.08838834764831845f;
  for (int item = BID(); item < 2048; item += GDIM()) {
    const int b = item >> 8, h = (item >> 6) & 3, n = item & 63;
    const int t0 = b * 4096 + n * 64, s0 = n * 64;
    const float A = __expf(p.dn_a_log[i * 4 + h]), dtb = p.dn_dt_bias[i * 4 + h];
    for (int tt = 0; tt < 16; ++tt) {
      const int il = tt * 4 + wave, t = t0 + il, sq = s0 + il;
#pragma unroll
      for (int which = 0; which < 3; ++which) {
        const int col = which * 512 + h * 128 + lane * 2;
        float y0 = 0.f, y1 = 0.f;
#pragma unroll
        for (int j = 0; j < 4; ++j) {
          if (sq - 3 + j >= 0) {
            unsigned v = *(const unsigned*)(dnqkv + (size_t)(t - 3 + j) * 1536 + col);
            y0 += cw[j * 1536 + col] * bf2f((bf16_t)(v & 0xffff));
            y1 += cw[j * 1536 + col + 1] * bf2f((bf16_t)(v >> 16));
          }
        }
        y0 = siluf_(y0); y1 = siluf_(y1);
        if (which < 2) {
          float ss = wave_sum(y0 * y0 + y1 * y1);
          float sc = rsqrtf(ss + 1e-6f);
          y0 *= sc; y1 *= sc;
        }
        bf16_t* dst = (which == 0) ? qs : (which == 1 ? ks : vs);
        *(unsigned*)(dst + il * 136 + lane * 2) = pack2(y0, y1);
      }
    }
    if (wave == 0) {
      const size_t row = (size_t)(t0 + lane);
      const float bl = logit[row * 8 + h], al = logit[row * 8 + 4 + h];
      float g = -A * softplusf_(al + dtb);
#pragma unroll
      for (int o = 1; o < 64; o <<= 1) { float v = __shfl_up(g, o); if (lane >= o) g += v; }
      beta[lane] = sigmoidf_(bl); gcum[lane] = g; egc[lane] = __expf(g);
    }
    __syncthreads();
    {
      f32x4 kk[4], qk[4];
#pragma unroll
      for (int nt = 0; nt < 4; ++nt) { kk[nt] = f32x4{0.f, 0.f, 0.f, 0.f}; qk[nt] = f32x4{0.f, 0.f, 0.f, 0.f}; }
#pragma unroll
      for (int k4 = 0; k4 < 4; ++k4) {
        const bf16x8 ak = *(const bf16x8*)(ks + (wave * 16 + l15) * 136 + k4 * 32 + quad * 8);
        const bf16x8 aq = *(const bf16x8*)(qs + (wave * 16 + l15) * 136 + k4 * 32 + quad * 8);
#pragma unroll
        for (int nt = 0; nt < 4; ++nt) {
          const bf16x8 bk = *(const bf16x8*)(ks + (nt * 16 + l15) * 136 + k4 * 32 + quad * 8);
          kk[nt] = MFMA16(ak, bk, kk[nt]); qk[nt] = MFMA16(aq, bk, qk[nt]);
        }
      }
#pragma unroll
      for (int nt = 0; nt < 4; ++nt)
#pragma unroll
        for (int r = 0; r < 4; ++r) {
          const int ii = wave * 16 + quad * 4 + r, jj = nt * 16 + l15;
          const float dec = (jj <= ii) ? __expf(gcum[ii] - gcum[jj]) : 0.f;
          Lm[ii * 68 + jj] = (jj < ii) ? beta[ii] * kk[nt][r] * dec : 0.f;
          in_g[(size_t)item * 4096 + ii * 64 + jj] = f2bf(qk[nt][r] * QS * dec);
        }
    }
    __syncthreads();
    {
      float x[64];
#pragma unroll
      for (int ii = 0; ii < 64; ++ii) x[ii] = 0.f;
      const int c = tid & 127;
      const bool isw = tid >= 128;
      bf16_t* dstb = (isw ? w_g : u_g) + (size_t)item * 8192 + c;
      const bf16_t* srcb = (isw ? ks : vs) + c;
#pragma unroll
      for (int ii = 0; ii < 64; ++ii) {
        float acc = bf2f(srcb[ii * 136]) * beta[ii] * (isw ? egc[ii] : 1.f);
#pragma unroll
        for (int j4 = 0; j4 < (ii + 3) / 4; ++j4) {
          const float4 l4 = *(const float4*)(Lm + ii * 68 + j4 * 4);
          acc -= l4.x * x[j4 * 4]; acc -= l4.y * x[j4 * 4 + 1]; acc -= l4.z * x[j4 * 4 + 2]; acc -= l4.w * x[j4 * 4 + 3];
        }
        x[ii] = acc;
        dstb[ii * 128] = f2bf(acc);
        if ((ii & 3) == 3) __builtin_amdgcn_sched_barrier(0);
      }
    }
    {
      const float gl = gcum[63];
#pragma unroll 4
      for (int k = 0; k < 32; ++k) {
        const int e = tid + 256 * k;
        const int ii = e >> 7, d = e & 127;
        qd_g[(size_t)item * 8192 + e] = f2bf(bf2f(qs[ii * 136 + d]) * QS * egc[ii]);
        const int d2 = e >> 6, i2 = e & 63;
        kd_g[(size_t)item * 8192 + e] = f2bf(bf2f(ks[i2 * 136 + d2]) * __expf(gl - gcum[i2]));
      }
      if (tid == 0) eg_g[item] = __expf(gl);
    }
    __syncthreads();
  }
}

DI bf16x8 ld2(const bf16_t* ptr) {
  u32x2 lo = *(const u32x2*)ptr, hi = *(const u32x2*)(ptr + 16);
  u32x4 t; t[0] = lo[0]; t[1] = lo[1]; t[2] = hi[0]; t[3] = hi[1];
  return __builtin_bit_cast(bf16x8, t);
}

DI void dn_chain_item(const Params& p, int item) {
  const int tid = TID(), wave = tid >> 6, lane = tid & 63, l15 = lane & 15, quad = lane >> 4;
  const int bh = item >> 1, half = item & 1;
  const int e0 = half * 64 + wave * 16 + l15;
  const bf16_t* qd_g = (const bf16_t*)(p.ws + OFF_QD); const bf16_t* kd_g = (const bf16_t*)(p.ws + OFF_KD); const bf16_t* in_g = (const bf16_t*)(p.ws + OFF_INTRA);
  const bf16_t* w_g = (const bf16_t*)(p.ws + OFF_WB); bf16_t* u_g = (bf16_t*)(p.ws + OFF_UB); const float* eg_g = (const float*)(p.ws + OFF_EG);
  f32x4 S[8];
#pragma unroll
  for (int mt = 0; mt < 8; ++mt) S[mt] = f32x4{0.f, 0.f, 0.f, 0.f};
#pragma unroll 1
  for (int n = 0; n < 64; ++n) {
    const size_t ci = (size_t)bh * 64 + n;
    const bf16_t* wq = w_g + ci * 8192; const bf16_t* qd = qd_g + ci * 8192; const bf16_t* kd = kd_g + ci * 8192; const bf16_t* in = in_g + ci * 4096;
    bf16_t* ub = u_g + ci * 8192;
    const float eg = eg_g[ci];
    bf16x8 sb[4];
#pragma unroll
    for (int s = 0; s < 4; ++s) sb[s] = pack8(S[2 * s], S[2 * s + 1]);
    f32x4 vn[4];
#pragma unroll
    for (int it = 0; it < 4; ++it) {
      f32x4 a = {0.f, 0.f, 0.f, 0.f};
#pragma unroll
      for (int s = 0; s < 4; ++s) a = MFMA16(ld2(wq + (it * 16 + l15) * 128 + s * 32 + quad * 4), sb[s], a);
#pragma unroll
      for (int r = 0; r < 4; ++r) vn[it][r] = bf2f(ub[(it * 16 + quad * 4 + r) * 128 + e0]) - a[r];
    }
    bf16x8 vb[2];
    vb[0] = pack8(vn[0], vn[1]); vb[1] = pack8(vn[2], vn[3]);
#pragma unroll
    for (int it = 0; it < 4; ++it) {
      f32x4 a = {0.f, 0.f, 0.f, 0.f};
#pragma unroll
      for (int s = 0; s < 4; ++s) a = MFMA16(ld2(qd + (it * 16 + l15) * 128 + s * 32 + quad * 4), sb[s], a);
#pragma unroll
      for (int s = 0; s < 2; ++s) a = MFMA16(ld2(in + (it * 16 + l15) * 64 + s * 32 + quad * 4), vb[s], a);
#pragma unroll
      for (int r = 0; r < 4; ++r) ub[(it * 16 + quad * 4 + r) * 128 + e0] = f2bf(a[r]);
    }
#pragma unroll
    for (int mt = 0; mt < 8; ++mt) {
      f32x4 a = S[mt];
      a[0] *= eg; a[1] *= eg; a[2] *= eg; a[3] *= eg;
#pragma unroll
      for (int s = 0; s < 2; ++s) a = MFMA16(ld2(kd + (mt * 16 + l15) * 64 + s * 32 + quad * 4), vb[s], a);
      S[mt] = a;
    }
  }
}

DI void phase_mix(const Params& p, int i) {
  if (BID() < 64) { dn_chain_item(p, BID()); return; }
  phase_dil_attn(p, BID() - 64, GDIM() - 64);
}

DI void phase_dn_post(const Params& p, int i) {
  const bf16_t* ob = (const bf16_t*)(p.ws + OFF_UB);
  bf16_t* z = (bf16_t*)(p.ws + OFF_Z);
  const float* ng = p.dn_norm_g + i * 128;
  const int wave = TID() >> 6, lane = TID() & 63;
  const int N = T_ * 4;
  for (int base = BID() * 4; base < N; base += GDIM() * 4) {
    const int item = base + wave;
    const int t = item >> 2, h = item & 3, b = t >> 12, sidx = t & 4095;
    const size_t g = (size_t)item * 128 + lane * 2;
    const size_t og = ((size_t)((b * 4 + h) * 64 + (sidx >> 6))) * 8192 + (sidx & 63) * 128 + lane * 2;
    unsigned ov = *(const unsigned*)(ob + og), zv = *(const unsigned*)(z + g);
    float o0 = bf2f((bf16_t)(ov & 0xffff)), o1 = bf2f((bf16_t)(ov >> 16));
    float z0 = bf2f((bf16_t)(zv & 0xffff)), z1 = bf2f((bf16_t)(zv >> 16));
    float ms = wave_sum(o0 * o0 + o1 * o1) * (1.f / 128.f);
    float rr = rsqrtf(ms + 1e-6f);
    float r0 = o0 * rr * ng[lane * 2] * siluf_(z0), r1 = o1 * rr * ng[lane * 2 + 1] * siluf_(z1);
    *(unsigned*)(z + g) = pack2(r0, r1);
  }
}

struct MixLoad {
  const bf16_t* a; const bf16_t* b;
  DI uint4 operator()(int row, int ks, int kc) const {
    const unsigned off = (unsigned)((row * 512 + (ks & 7) * 64 + kc) * 2);
    return *(const uint4*)((const char*)((ks < 8) ? a : b) + off);
  }
};

DI void phase_wout(const Params& p, int i, bf16_t* smem) {
  const bf16_t* W = (const bf16_t*)(p.ws + OFF_W) + W_EVEN0 + (size_t)i * (SZ_WIN + SZ_SQ) + SZ_WIN;
  MixLoad al{(const bf16_t*)(p.ws + OFF_Z), (const bf16_t*)(p.ws + OFF_SWQ)};
  PlainLoad bl{W, 1024};
  for_tiles(256, 8, [&](int mi, int ni) {
    gemm_tile(mi * 128, ni * 128, 16, al, bl, [&](f32x4 (&acc)[4][4], int rb, int cb) { epi_resid(p, acc, rb, cb); }, smem);
  });
}

DI void phase_ln(const Params& p, const float* g, const float* b) {
  const int wave = TID() >> 6, lane = TID() & 63;
  bf16_t* hb = (bf16_t*)(p.ws + OFF_HB);
  for (int row = BID() * 4 + wave; row < T_; row += GDIM() * 4) {
    float4* y = (float4*)(p.out + (size_t)row * 1024);
    float4 v[4];
    float s = 0.f;
#pragma unroll
    for (int i = 0; i < 4; ++i) { v[i] = y[lane + 64 * i]; s += v[i].x + v[i].y + v[i].z + v[i].w; }
    const float mu = wave_sum(s) * (1.f / 1024.f);
    float q = 0.f;
#pragma unroll
    for (int i = 0; i < 4; ++i) { float a = v[i].x - mu, b2 = v[i].y - mu, c = v[i].z - mu, d = v[i].w - mu; q += a * a + b2 * b2 + c * c + d * d; }
    const float rstd = rsqrtf(wave_sum(q) * (1.f / 1024.f) + 1e-5f);
#pragma unroll
    for (int i = 0; i < 4; ++i) {
      float4 gg = ((const float4*)g)[lane + 64 * i], bb = ((const float4*)b)[lane + 64 * i];
      float4 o;
      o.x = (v[i].x - mu) * rstd * gg.x + bb.x; o.y = (v[i].y - mu) * rstd * gg.y + bb.y;
      o.z = (v[i].z - mu) * rstd * gg.z + bb.z; o.w = (v[i].w - mu) * rstd * gg.w + bb.w;
      y[lane + 64 * i] = o;
      uint2 ob; ob.x = pack2(o.x, o.y); ob.y = pack2(o.z, o.w);
      ((uint2*)(hb + (size_t)row * 1024))[lane + 64 * i] = ob;
    }
  }
}

DI void phase_s5_naive(const Params& p, int i) {
  const int wave = TID() >> 6, lane = TID() & 63;
  bf16_t* hid = (bf16_t*)(p.ws + OFF_HID);
  for (int base = BID() * 4; base < 512; base += GDIM() * 4) {
    const int item = base + wave, b = item >> 6, g = item & 63;
    const int gp = (i * 64 + g) * 64 + lane;
    const double dt = exp((double)p.s5_log_dt[i * 64 + g]);
    const double are = p.s5_a_re[gp], aim = p.s5_a_im[gp];
    const double lr = are * dt, li = aim * dt;
    const double kk = rint(li * 0.15915494309189535);
    const double red = li - kk * 6.283185307179586;
    const double e = exp(lr);
    const double abr = e * cos(red), abi = e * sin(red);
    const double den = are * are + aim * aim;
    const double nr = abr - 1.0, ni = abi;
    const double cfr = (nr * are + ni * aim) / den, cfi = (ni * are - nr * aim) / den;
    float bbr[16], bbi[16], cr[16], ci[16];
#pragma unroll
    for (int h = 0; h < 16; ++h) {
      const double br = p.s5_b_re[(size_t)gp * 16 + h], bi = p.s5_b_im[(size_t)gp * 16 + h];
      bbr[h] = (float)(cfr * br - cfi * bi); bbi[h] = (float)(cfr * bi + cfi * br);
      cr[h] = p.s5_c_re[((size_t)(i * 64 + g) * 16 + h) * 64 + lane];
      ci[h] = p.s5_c_im[((size_t)(i * 64 + g) * 16 + h) * 64 + lane];
    }
    const float ar = (float)abr, ai = (float)abi;
    const float dsk = p.s5_d[i * 1024 + g * 16 + (lane & 15)];
    float sr = 0.f, si = 0.f;
#pragma unroll 1
    for (int t = 0; t < S_; ++t) {
      const size_t row = (size_t)(b * S_ + t);
      const float4* up = (const float4*)(p.out + row * 1024 + g * 16);
      float u[16];
#pragma unroll
      for (int j = 0; j < 4; ++j) { float4 v = up[j]; u[4 * j] = v.x; u[4 * j + 1] = v.y; u[4 * j + 2] = v.z; u[4 * j + 3] = v.w; }
      float bur = 0.f, bui = 0.f;
#pragma unroll
      for (int h = 0; h < 16; ++h) { bur += bbr[h] * u[h]; bui += bbi[h] * u[h]; }
      const float nsr = ar * sr - ai * si + bur, nsi = ar * si + ai * sr + bui;
      sr = nsr; si = nsi;
      float yk = 0.f, uk = 0.f;
#pragma unroll
      for (int h = 0; h < 16; ++h) {
        float v = wave_sum(cr[h] * sr - ci[h] * si);
        if (lane == h) { yk = v; uk = u[h]; }
      }
      if (lane < 16) hid[row * 1024 + g * 16 + lane] = f2bf(gelu_tanh(yk + dsk * uk));
    }
  }
}

DI void phase_s5_tables(const Params& p, int i, float* smem) {
  float2* pw = (float2*)smem;
  float2* bb = pw + 64 * 33;
  float2* cc = bb + 64 * 16;
  bf16_t* Ktab = (bf16_t*)(p.ws + OFF_KTAB); bf16_t* Etab = (bf16_t*)(p.ws + OFF_ETAB); bf16_t* Gtab = (bf16_t*)(p.ws + OFF_GTAB);
  float2* AL = (float2*)(p.ws + OFF_AL);
  const int tid = TID();
  for (int g = BID(); g < 64; g += GDIM()) {
    const double dt = exp((double)p.s5_log_dt[i * 64 + g]);
    for (int e = tid; e < 64 * 33; e += 256) {
      const int pp = e / 33, n = e - pp * 33;
      const double are = p.s5_a_re[(i * 64 + g) * 64 + pp], aim = p.s5_a_im[(i * 64 + g) * 64 + pp];
      const double lr = are * dt * n, li = aim * dt * n;
      const double k = rint(li * 0.15915494309189535);
      const double red = li - k * 6.283185307179586;
      const double ex = exp(lr);
      pw[e] = make_float2((float)(ex * cos(red)), (float)(ex * sin(red)));
    }
    for (int e = tid; e < 1024; e += 256) {
      const int pp = e >> 4;
      const int gp = (i * 64 + g) * 64 + pp;
      const double are = p.s5_a_re[gp], aim = p.s5_a_im[gp];
      const double lr = are * dt, li = aim * dt;
      const double k = rint(li * 0.15915494309189535);
      const double red = li - k * 6.283185307179586;
      const double ex = exp(lr);
      const double nr = ex * cos(red) - 1.0, ni = ex * sin(red);
      const double den = are * are + aim * aim;
      const double cfr = (nr * are + ni * aim) / den, cfi = (ni * are - nr * aim) / den;
      const double br = p.s5_b_re[(size_t)gp * 16 + (e & 15)], bi = p.s5_b_im[(size_t)gp * 16 + (e & 15)];
      bb[e] = make_float2((float)(cfr * br - cfi * bi), (float)(cfr * bi + cfi * br));
      const size_t ci = ((size_t)(i * 64 + g) * 16 + (e >> 6)) * 64 + (e & 63);
      cc[e] = make_float2(p.s5_c_re[ci], p.s5_c_im[ci]);
    }
    __syncthreads();
    for (int e = tid; e < 8192; e += 256) {
      const int tau = e >> 8, ho = (e >> 4) & 15, hi = e & 15;
      float acc = 0.f;
      for (int pp = 0; pp < 64; ++pp) {
        const float2 c = cc[ho * 64 + pp], w = pw[pp * 33 + tau], b = bb[pp * 16 + hi];
        const float cwr = c.x * w.x - c.y * w.y, cwi = c.x * w.y + c.y * w.x;
        acc += cwr * b.x - cwi * b.y;
      }
      Ktab[(size_t)g * 8192 + e] = f2bf(acc);
    }
    for (int e = tid; e < 65536; e += 256) {
      const int pc = e >> 9, sidx = (e >> 4) & 31, hi = e & 15, pp = pc & 63;
      const float2 w = pw[pp * 33 + 31 - sidx], b = bb[pp * 16 + hi];
      const float v = (pc < 64) ? (w.x * b.x - w.y * b.y) : (w.x * b.y + w.y * b.x);
      Etab[(size_t)g * 65536 + e] = f2bf(v);
    }
    for (int e = tid; e < 65536; e += 256) {
      const int row = e >> 7, pc = e & 127, pp = pc & 63, t = row >> 4, ho = row & 15;
      const float2 c = cc[ho * 64 + pp], w = pw[pp * 33 + t + 1];
      const float v = (pc < 64) ? (c.x * w.x - c.y * w.y) : -(c.x * w.y + c.y * w.x);
      Gtab[(size_t)g * 65536 + e] = f2bf(v);
    }
    if (tid < 64) AL[g * 64 + tid] = pw[tid * 33 + 32];
    __syncthreads();
  }
}

DI void phase_s5_end(const Params& p, bf16_t* smem) {
  const bf16_t* Etab = (const bf16_t*)(p.ws + OFF_ETAB); const bf16_t* hb = (const bf16_t*)(p.ws + OFF_HB);
  const float2* AL = (const float2*)(p.ws + OFF_AL);
  bf16_t* sin_ = (bf16_t*)(p.ws + OFF_SIN);
  float* endbuf = (float*)smem;
  for (int item = BID(); item < 512; item += GDIM()) {
    const int g = item >> 3, b = item & 7;
    auto al = [=](int row, int ks, int kc) { return *(const uint4*)((const char*)Etab + (unsigned)((((g * 128 + row) * 512) + ks * 64 + kc) * 2)); };
    auto bl = [=](int n, int ks, int kc) {
      const int k = ks * 64 + kc, sidx = k >> 4, hi0 = k & 15;
      return *(const uint4*)((const char*)hb + (unsigned)(((b * 4096 + n * 32 + sidx) * 1024 + g * 16 + hi0) * 2));
    };
    gemm_tile(0, 0, 8, al, bl, [&](f32x4 (&acc)[4][4], int rb, int cb) {
      const int lane = TID() & 63, l15 = lane & 15, quad = lane >> 4;
#pragma unroll
      for (int mt = 0; mt < 4; ++mt)
#pragma unroll
        for (int nt = 0; nt < 4; ++nt)
#pragma unroll
          for (int r = 0; r < 4; ++r) endbuf[(rb + mt * 16 + quad * 4 + r) * 129 + cb + nt * 16 + l15] = acc[mt][nt][r];
    }, smem);
    __syncthreads();
    if (TID() < 64) {
      const int pp = TID();
      const float2 a = AL[g * 64 + pp];
      float sr = 0.f, si = 0.f;
      for (int n = 0; n < 128; ++n) {
        bf16_t* dst = sin_ + ((size_t)g * 1024 + b * 128 + n) * 128;
        dst[pp] = f2bf(sr); dst[64 + pp] = f2bf(si);
        const float er = endbuf[pp * 129 + n], ei = endbuf[(64 + pp) * 129 + n];
        const float nr = a.x * sr - a.y * si + er, ni = a.x * si + a.y * sr + ei;
        sr = nr; si = ni;
      }
    }
    __syncthreads();
  }
}

DI void phase_s5_y(const Params& p, int i, bf16_t* smem) {
  const bf16_t* Ktab = (const bf16_t*)(p.ws + OFF_KTAB); const bf16_t* Gtab = (const bf16_t*)(p.ws + OFF_GTAB);
  const bf16_t* hb = (const bf16_t*)(p.ws + OFF_HB); const bf16_t* sin_ = (const bf16_t*)(p.ws + OFF_SIN);
  bf16_t* hid = (bf16_t*)(p.ws + OFF_HID);
  for (int w = BID(); w < 2048; w += GDIM()) {
    const int g = w >> 5, mtile = (w >> 3) & 3, b = w & 7;
    const int nT = mtile * 2 + 2;
    auto al = [=](int row, int ks, int kc) -> uint4 {
      if (ks < nT) {
        const int k = ks * 64 + kc, sidx = k >> 4, hi0 = k & 15, t = row >> 4, ho = row & 15;
        if (t >= sidx) return *(const uint4*)((const char*)Ktab + (unsigned)(((((g * 32 + (t - sidx)) * 16 + ho) * 16) + hi0) * 2));
        return make_uint4(0, 0, 0, 0);
      }
      return *(const uint4*)((const char*)Gtab + (unsigned)((((g * 512 + row) * 128) + (ks - nT) * 64 + kc) * 2));
    };
    auto bl = [=](int n, int ks, int kc) -> uint4 {
      if (ks < nT) {
        const int k = ks * 64 + kc, sidx = k >> 4, hi0 = k & 15;
        return *(const uint4*)((const char*)hb + (unsigned)(((b * 4096 + n * 32 + sidx) * 1024 + g * 16 + hi0) * 2));
      }
      return *(const uint4*)((const char*)sin_ + (unsigned)((((g * 1024 + b * 128 + n) * 128) + (ks - nT) * 64 + kc) * 2));
    };
    gemm_tile(mtile * 128, 0, nT + 2, al, bl, [&](f32x4 (&acc)[4][4], int rb, int cb) {
      const int lane = TID() & 63, l15 = lane & 15, quad = lane >> 4;
      const float4 dsk = *(const float4*)(p.s5_d + i * 1024 + g * 16 + quad * 4);
#pragma unroll
      for (int mt = 0; mt < 4; ++mt)
#pragma unroll
        for (int nt = 0; nt < 4; ++nt) {
          const int t = (rb + mt * 16) >> 4, n = cb + nt * 16 + l15;
          const size_t tok = (size_t)b * 4096 + n * 32 + t;
          const float4 u = *(const float4*)(p.out + tok * 1024 + g * 16 + quad * 4);
          u32x2 v;
          v[0] = pack2(gelu_tanh(acc[mt][nt][0] + dsk.x * u.x), gelu_tanh(acc[mt][nt][1] + dsk.y * u.y));
          v[1] = pack2(gelu_tanh(acc[mt][nt][2] + dsk.z * u.z), gelu_tanh(acc[mt][nt][3] + dsk.w * u.w));
          *(u32x2*)(hid + tok * 1024 + g * 16 + quad * 4) = v;
        }
    }, smem);
  }
}

DI void phase_glu(const Params& p, int i, bf16_t* smem) {
  const bf16_t* W = (const bf16_t*)(p.ws + OFF_W) + W_ODD0 + (size_t)i * SZ_GLU;
  PlainLoad al{(const bf16_t*)(p.ws + OFF_HID), 1024}, bl{W, 1024};
  for_tiles(256, 16, [&](int mi, int ni) {
    gemm_tile(mi * 128, ni * 128, 16, al, bl, [&](f32x4 (&acc)[4][4], int rb, int cb) {
      const int lane = TID() & 63, l15 = lane & 15, quad = lane >> 4;
#pragma unroll
      for (int mt = 0; mt < 4; ++mt)
#pragma unroll
        for (int np = 0; np < 2; ++np)
#pragma unroll
          for (int r = 0; r < 4; ++r) {
            float val = acc[mt][2 * np][r] * sigmoidf_(acc[mt][2 * np + 1][r]);
            size_t idx = (size_t)(rb + mt * 16 + quad * 4 + r) * 1024 + (cb >> 1) + np * 16 + l15;
            p.out[idx] = ALPHA * p.out[idx] + val;
          }
    }, smem);
  });
}

DI void phase_xproj(const Params& p, int l, bf16_t* smem) {
  const bf16_t* wc = (const bf16_t*)(p.ws + OFF_W) + (size_t)l * SZ_COMMON;
  {
    PlainLoad al{(const bf16_t*)(p.ws + OFF_HB), 1024}, bl{wc, 1024};
    bf16_t* q = (bf16_t*)(p.ws + OFF_XQ);
    for_tiles(256, 8, [&](int mi, int ni) {
      gemm_tile(mi * 128, ni * 128, 16, al, bl, [&](f32x4 (&acc)[4][4], int rb, int cb) { epi_bf16(q, 1024, acc, rb, cb); }, smem);
    });
  }
  {
    const float* memf = p.mem;
    auto al = [=](int row, int ks, int kc) -> uint4 {
      const float4* src = (const float4*)((const char*)memf + (unsigned)((row * 1024 + ks * 64 + kc) * 4));
      float4 a = src[0], b2 = src[1];
      return make_uint4(pack2(a.x, a.y), pack2(a.z, a.w), pack2(b2.x, b2.y), pack2(b2.z, b2.w));
    };
    bf16_t* kx = (bf16_t*)(p.ws + OFF_KX); bf16_t* vx = (bf16_t*)(p.ws + OFF_VX);
    for_tiles(16, 16, [&](int mi, int ni) {
      const bool isv = ni >= 8;
      PlainLoad bl{isv ? (wc + 2 * SZ_SQ) : (wc + SZ_SQ), 1024};
      gemm_tile(mi * 128, (ni & 7) * 128, 16, al, bl, [&](f32x4 (&acc)[4][4], int rb, int cb) {
        if (!isv) { epi_bf16(kx, 1024, acc, rb, cb); return; }
        if (!USE_XATTN_MFMA) { epi_bf16(vx, 1024, acc, rb, cb); return; }
        const int lane = TID() & 63, l15 = lane & 15, quad = lane >> 4;
#pragma unroll
        for (int mt = 0; mt < 4; ++mt)
#pragma unroll
          for (int nt = 0; nt < 4; ++nt) {
            const int row = rb + mt * 16 + quad * 4, col = cb + nt * 16 + l15;
            const int b = row >> 8, key = row & 255, h = col >> 8, d = col & 255;
            u32x2 v; v[0] = pack2(acc[mt][nt][0], acc[mt][nt][1]); v[1] = pack2(acc[mt][nt][2], acc[mt][nt][3]);
            *(u32x2*)(vx + ((size_t)((b * 4 + h) * 256 + d)) * 256 + key) = v;
          }
      }, smem);
    });
  }
}


DI void phase_xattn(const Params& p) {
  const int wave = TID() >> 6, lane = TID() & 63, l15 = lane & 15, quad = lane >> 4;
  const bf16_t* q = (const bf16_t*)(p.ws + OFF_XQ); const bf16_t* kx = (const bf16_t*)(p.ws + OFF_KX); const bf16_t* vxT = (const bf16_t*)(p.ws + OFF_VX);
  bf16_t* xo = (bf16_t*)(p.ws + OFF_XO);
  for (int item = BID(); item < 2048; item += GDIM()) {
    const int b = item >> 8, h = (item >> 6) & 3, qb = item & 63;
    const size_t tq = (size_t)b * 4096 + qb * 64 + wave * 16 + l15;
    bf16x8 qf[8];
#pragma unroll
    for (int ks = 0; ks < 8; ++ks) qf[ks] = *(const bf16x8*)(q + tq * 1024 + h * 256 + ks * 32 + quad * 8);
    f32x4 s[16];
#pragma unroll
    for (int mt = 0; mt < 16; ++mt) {
      const bf16_t* kp = kx + (size_t)(b * 256 + mt * 16 + l15) * 1024 + h * 256 + quad * 8;
      f32x4 a = {0.f, 0.f, 0.f, 0.f};
#pragma unroll
      for (int ks = 0; ks < 8; ++ks) a = MFMA16(*(const bf16x8*)(kp + ks * 32), qf[ks], a);
      s[mt] = a;
      if (mt & 1) __builtin_amdgcn_sched_barrier(0);
    }
    float m = -1e30f;
#pragma unroll
    for (int mt = 0; mt < 16; ++mt)
#pragma unroll
      for (int r = 0; r < 4; ++r) m = fmaxf(m, s[mt][r]);
    m = fmaxf(m, __shfl_xor(m, 16)); m = fmaxf(m, __shfl_xor(m, 32));
    const float c1 = 0.0625f * 1.4426950408889634f;
    float l = 0.f;
#pragma unroll
    for (int mt = 0; mt < 16; ++mt)
#pragma unroll
      for (int r = 0; r < 4; ++r) { float pv = exp2f((s[mt][r] - m) * c1); s[mt][r] = pv; l += pv; }
    l += __shfl_xor(l, 16); l += __shfl_xor(l, 32);
    f32x4 o[16];
#pragma unroll
    for (int dt = 0; dt < 16; ++dt) o[dt] = f32x4{0.f, 0.f, 0.f, 0.f};
#pragma unroll
    for (int s2 = 0; s2 < 8; ++s2) {
      const bf16x8 pf = pack8(s[2 * s2], s[2 * s2 + 1]);
#pragma unroll
      for (int dt = 0; dt < 16; ++dt) {
        const bf16_t* vp = vxT + ((size_t)((b * 4 + h) * 256 + dt * 16 + l15)) * 256 + s2 * 32 + quad * 4;
        u32x2 lo = *(const u32x2*)vp, hi = *(const u32x2*)(vp + 16);
        u32x4 t; t[0] = lo[0]; t[1] = lo[1]; t[2] = hi[0]; t[3] = hi[1];
        o[dt] = MFMA16(__builtin_bit_cast(bf16x8, t), pf, o[dt]);
      }
      __builtin_amdgcn_sched_barrier(0);
    }
    const float il = 1.f / l;
#pragma unroll
    for (int dt = 0; dt < 16; ++dt) {
      u32x2 v; v[0] = pack2(o[dt][0] * il, o[dt][1] * il); v[1] = pack2(o[dt][2] * il, o[dt][3] * il);
      *(u32x2*)(xo + tq * 1024 + h * 256 + dt * 16 + quad * 4) = v;
    }
  }
}

template <int R, int NT>
DI void dil_branch(const bf16_t* swk, const bf16_t* swv, size_t rowbase, int h, int tok0, const bf16x8 (&qf)[2], float& m, float& l, f32x4 (&o)[4],
                   int l15, int quad) {
  constexpr int U = 16 / R, W = 128 * R;
  f32x4 s[NT];
#pragma unroll
  for (int kt = 0; kt < NT; ++kt) {
    int kap = tok0 - W + R * (kt * 16 + l15);
    kap = min(max(kap, 0), 4095);
    const bf16_t* kp = swk + (rowbase + kap) * 512 + h * 64 + quad * 8;
    f32x4 a = {0.f, 0.f, 0.f, 0.f};
    a = MFMA16(*(const bf16x8*)kp, qf[0], a);
    a = MFMA16(*(const bf16x8*)(kp + 32), qf[1], a);
    s[kt] = a;
    if ((kt & 3) == 3) __builtin_amdgcn_sched_barrier(0);
  }
  float mx = m;
  const float c1 = 0.125f * 1.4426950408889634f;
#pragma unroll
  for (int kt = 0; kt < NT; ++kt)
#pragma unroll
    for (int r2 = 0; r2 < 4; ++r2) {
      const int c = kt * 16 + quad * 4 + r2;
      const int dist = U * l15 + 128 - c;
      const int kap = tok0 - W + R * c;
      const bool ok = (dist >= 0) && (dist <= 128) && (kap >= 0);
      const float v = ok ? s[kt][r2] * c1 : -1e30f;
      s[kt][r2] = v; mx = fmaxf(mx, v);
    }
  mx = fmaxf(mx, __shfl_xor(mx, 16)); mx = fmaxf(mx, __shfl_xor(mx, 32));
  const float corr = exp2f(m - mx);
  m = mx; l *= corr;
#pragma unroll
  for (int dt = 0; dt < 4; ++dt) { o[dt][0] *= corr; o[dt][1] *= corr; o[dt][2] *= corr; o[dt][3] *= corr; }
#pragma unroll
  for (int kt = 0; kt < NT; ++kt)
#pragma unroll
    for (int r2 = 0; r2 < 4; ++r2) { float pv = exp2f(s[kt][r2] - mx); s[kt][r2] = pv; l += pv; }
  constexpr int NS = (NT + 1) / 2;
#pragma unroll
  for (int s2 = 0; s2 < NS; ++s2) {
    const f32x4 z4 = {0.f, 0.f, 0.f, 0.f};
    const bf16x8 pf = pack8(s[2 * s2], (2 * s2 + 1 < NT) ? s[(2 * s2 + 1 < NT) ? 2 * s2 + 1 : 0] : z4);
    const bf16_t* vp[8];
#pragma unroll
    for (int j = 0; j < 8; ++j) {
      const int c = (2 * s2 + (j >> 2)) * 16 + quad * 4 + (j & 3);
      int kap = tok0 - W + R * c;
      kap = min(max(kap, 0), 4095);
      vp[j] = swv + (rowbase + kap) * 512 + h * 64 + l15;
    }
#pragma unroll
    for (int dt = 0; dt < 4; ++dt) {
      bf16x8 vf;
#pragma unroll
      for (int j = 0; j < 8; ++j) vf[j] = (short)vp[j][dt * 16];
      o[dt] = MFMA16(vf, pf, o[dt]);
    }
    __builtin_amdgcn_sched_barrier(0);
  }
}

DI void phase_dil_attn(const Params& p, int first, int nblk) {
  const int wave = TID() >> 6, lane = TID() & 63, l15 = lane & 15, quad = lane >> 4;
  bf16_t* swq = (bf16_t*)(p.ws + OFF_SWQ); const bf16_t* swk = (const bf16_t*)(p.ws + OFF_SWK); const bf16_t* swv = (const bf16_t*)(p.ws + OFF_SWV);
  for (int item = first; item < 4096; item += nblk) {
    const int b = item >> 9, h = (item >> 6) & 7, G = (item >> 2) & 15, sub = item & 3;
    const int tok0 = G * 256 + sub * 4 + wave;
    const size_t rowbase = (size_t)b * 4096;
    const size_t tq = rowbase + tok0 + 16 * l15;
    bf16x8 qf[2];
    qf[0] = *(const bf16x8*)(swq + tq * 512 + h * 64 + quad * 8);
    qf[1] = *(const bf16x8*)(swq + tq * 512 + h * 64 + 32 + quad * 8);
    float m = -1e30f, l = 0.f;
    f32x4 o[4];
#pragma unroll
    for (int dt = 0; dt < 4; ++dt) o[dt] = f32x4{0.f, 0.f, 0.f, 0.f};
    dil_branch<16, 9>(swk, swv, rowbase, h, tok0, qf, m, l, o, l15, quad);
    dil_branch<4, 12>(swk, swv, rowbase, h, tok0, qf, m, l, o, l15, quad);
    dil_branch<1, 24>(swk, swv, rowbase, h, tok0, qf, m, l, o, l15, quad);
    l += __shfl_xor(l, 16); l += __shfl_xor(l, 32);
    const float il = 1.f / l;
#pragma unroll
    for (int dt = 0; dt < 4; ++dt) {
      u32x2 v; v[0] = pack2(o[dt][0] * il, o[dt][1] * il); v[1] = pack2(o[dt][2] * il, o[dt][3] * il);
      *(u32x2*)(swq + tq * 512 + h * 64 + dt * 16 + quad * 4) = v;
    }
  }
}

DI void phase_xo(const Params& p, int l, bf16_t* smem) {
  const bf16_t* wc = (const bf16_t*)(p.ws + OFF_W) + (size_t)l * SZ_COMMON + 3 * SZ_SQ;
  PlainLoad al{(const bf16_t*)(p.ws + OFF_XO), 1024}, bl{wc, 1024};
  for_tiles(256, 8, [&](int mi, int ni) {
    gemm_tile(mi * 128, ni * 128, 16, al, bl, [&](f32x4 (&acc)[4][4], int rb, int cb) { epi_resid(p, acc, rb, cb); }, smem);
  });
}

DI void phase_ffn_gu(const Params& p, int l, bf16_t* smem) {
  const bf16_t* W = (const bf16_t*)(p.ws + OFF_W) + (size_t)l * SZ_COMMON + 4 * SZ_SQ;
  PlainLoad al{(const bf16_t*)(p.ws + OFF_HB), 1024}, bl{W, 1024};
  bf16_t* act = (bf16_t*)(p.ws + OFF_ACT);
  for_tiles(256, 44, [&](int mi, int ni) {
    gemm_tile(mi * 128, ni * 128, 16, al, bl, [&](f32x4 (&acc)[4][4], int rb, int cb) {
      const int lane = TID() & 63, l15 = lane & 15, quad = lane >> 4;
#pragma unroll
      for (int mt = 0; mt < 4; ++mt)
#pragma unroll
        for (int np = 0; np < 2; ++np)
#pragma unroll
          for (int r = 0; r < 4; ++r) {
            float val = siluf_(acc[mt][2 * np][r]) * acc[mt][2 * np + 1][r];
            act[(size_t)(rb + mt * 16 + quad * 4 + r) * 2816 + (cb >> 1) + np * 16 + l15] = f2bf(val);
          }
    }, smem);
  });
}
DI void phase_ffn_down(const Params& p, int l, bf16_t* smem) {
  const bf16_t* W = (const bf16_t*)(p.ws + OFF_W) + (size_t)l * SZ_COMMON + 4 * SZ_SQ + SZ_GU;
  PlainLoad al{(const bf16_t*)(p.ws + OFF_ACT), 2816}, bl{W, 2816};
  for_tiles(256, 8, [&](int mi, int ni) {
    gemm_tile(mi * 128, ni * 128, 44, al, bl, [&](f32x4 (&acc)[4][4], int rb, int cb) { epi_resid(p, acc, rb, cb); }, smem);
  });
}


#define XB_TMO      128
#define XB_XCNT(j)  (256  + 64 * (j))
#define XB_XSUB(j)  (1280 + 64 * (j))
#define XB_XGEN(j)  (2304 + 64 * (j))
#define XB_TOP      3328
#define XB_TOPGEN   3392
#define XCD_BAR_WORDS 3456
#define XB_SPIN_CAP (1u << 22)
#define LAS __attribute__((address_space(3)))
DI unsigned xb_ld(unsigned* p) { return __hip_atomic_load(p, __ATOMIC_RELAXED, __HIP_MEMORY_SCOPE_AGENT); }
DI unsigned xb_add(unsigned* p, unsigned v) { return __hip_atomic_fetch_add(p, v, __ATOMIC_RELAXED, __HIP_MEMORY_SCOPE_AGENT); }
DI unsigned xb_xcc_id() { return (unsigned)__builtin_amdgcn_s_getreg((3 << 11) | 20) & 0xFu; }
#define XB_SPIN(cond, bar) do { unsigned _sp = 0; while (cond) { __builtin_amdgcn_s_sleep(1); \
    if ((++_sp & 255u) == 0u) { if (xb_ld(&(bar)[XB_TMO])) break; if (_sp > XB_SPIN_CAP) { atomicAdd(&(bar)[XB_TMO], 1u); break; } } } } while (0)
struct XcdBarrier { unsigned* bar; unsigned x; volatile LAS unsigned* st; };
DI XcdBarrier xcd_barrier_post(unsigned* bar, volatile LAS unsigned* st) {
  XcdBarrier b; b.bar = bar; b.x = xb_xcc_id(); b.st = st;
  if (threadIdx.x == 0) (void)xb_add(&bar[XB_XCNT(b.x)], 1u);
  return b;
}
DI void xcd_barrier_complete(unsigned* bar, unsigned x, unsigned& nloc, unsigned& nx) {
  const unsigned G = gridDim.x * gridDim.y * gridDim.z;
  unsigned sum, cnt, mine, sp = 0u;
  for (;;) {
    sum = 0u; cnt = 0u; mine = 0u;
#pragma unroll
    for (unsigned j = 0; j < 16; ++j) { const unsigned c = xb_ld(&bar[XB_XCNT(j)]); sum += c; cnt += (c > 0u) ? 1u : 0u; mine = (j == x) ? c : mine; }
    if (sum == G) break;
    __builtin_amdgcn_s_sleep(1);
    if ((++sp & 255u) == 0u) { if (xb_ld(&bar[XB_TMO])) break; if (sp > XB_SPIN_CAP) { atomicAdd(&bar[XB_TMO], 1u); break; } }
  }
  nloc = mine > 0u ? mine : 1u; nx = cnt > 0u ? cnt : 1u;
}
DI void xcd_barrier(const XcdBarrier& b) {
  asm volatile("s_waitcnt vmcnt(0)" ::: "memory");
  __syncthreads();
  if (threadIdx.x == 0) {
    unsigned* bar = b.bar;
    __builtin_amdgcn_s_waitcnt(0);
    unsigned nloc = b.st[0], nx = b.st[1];
    if (nloc == 0u) { xcd_barrier_complete(bar, b.x, nloc, nx); b.st[0] = nloc; b.st[1] = nx; }
    const unsigned old = xb_add(&bar[XB_XSUB(b.x)], 1u);
    const unsigned gen = old / nloc;
    if (old + 1u == (gen + 1u) * nloc) {
      __builtin_amdgcn_fence(__ATOMIC_RELEASE, "agent");
      asm volatile("s_waitcnt vmcnt(0)" ::: "memory");
      const unsigned og = xb_add(&bar[XB_TOP], 1u);
      const unsigned tg = og / nx;
      if (og + 1u == (tg + 1u) * nx) xb_add(&bar[XB_TOPGEN], 1u);
      else XB_SPIN(xb_ld(&bar[XB_TOPGEN]) == tg, bar);
      __builtin_amdgcn_fence(__ATOMIC_ACQUIRE, "agent");
      xb_add(&bar[XB_XGEN(b.x)], 1u);
      asm volatile("s_waitcnt vmcnt(0)" ::: "memory");
    } else {
      XB_SPIN(xb_ld(&bar[XB_XGEN(b.x)]) == gen, bar);
      __builtin_amdgcn_fence(__ATOMIC_ACQUIRE, "agent");
      asm volatile("s_waitcnt vmcnt(0)" ::: "memory");
    }
  }
  __syncthreads();
}

__global__ void __launch_bounds__(256, 2) fwd_megakernel(Params p) {
  cg::grid_group grid = cg::this_grid();
  __shared__ __attribute__((aligned(16))) char smem_raw[2 * 2 * 128 * LDT * 2];
  bf16_t* sm16 = (bf16_t*)smem_raw; float* sm32 = (float*)smem_raw;

  __shared__ uint4 xb_words;
  if (threadIdx.x == 0) xb_words = make_uint4(0u, 0u, 0u, 0u);
  __syncthreads();
  XcdBarrier xb = xcd_barrier_post((unsigned*)(p.ws + OFF_BAR), (volatile LAS unsigned*)&xb_words);
  phase_prologue(p, sm32);
  grid.sync();
  for (int l = 0; l < 4; ++l) {
    const int i = l >> 1;
    if ((l & 1) == 0) {
      phase_proj(p, i, sm16); xcd_barrier(xb);
      phase_dn_prep(p, i, smem_raw); xcd_barrier(xb);
      phase_mix(p, i); xcd_barrier(xb);
      phase_dn_post(p, i); xcd_barrier(xb);
      phase_wout(p, i, sm16); xcd_barrier(xb);
    } else {
#if USE_S5_GEMM
      phase_s5_tables(p, i, sm32); xcd_barrier(xb);
      phase_s5_end(p, sm16); xcd_barrier(xb);
      phase_s5_y(p, i, sm16); xcd_barrier(xb);
#else
      phase_s5_naive(p, i); xcd_barrier(xb);
#endif
      phase_glu(p, i, sm16); xcd_barrier(xb);
    }
    phase_ln(p, p.ln_mix_g + l * 1024, p.ln_mix_b + l * 1024); xcd_barrier(xb);
    phase_xproj(p, l, sm16); xcd_barrier(xb);
    phase_xattn(p); xcd_barrier(xb);
    phase_xo(p, l, sm16); xcd_barrier(xb);
    phase_ln(p, p.ln_x_g + l * 1024, p.ln_x_b + l * 1024); xcd_barrier(xb);
    phase_ffn_gu(p, l, sm16); xcd_barrier(xb);
    phase_ffn_down(p, l, sm16); xcd_barrier(xb);
    phase_ln(p, p.ln_ffn_g + l * 1024, p.ln_ffn_b + l * 1024); xcd_barrier(xb);
  }
}

extern "C" void kernel_launch(void* const* d_in, const int* in_sizes, int n_in, void* d_out, int out_size, void* d_ws, size_t ws_size,
                              hipStream_t stream) {
  static int grid_blocks = 0;
  if (!grid_blocks) {
    int dev = 0, cus = 0, per_cu = 0;
    hipGetDevice(&dev);
    hipDeviceGetAttribute(&cus, hipDeviceAttributeMultiprocessorCount, dev);
    hipOccupancyMaxActiveBlocksPerMultiprocessor(&per_cu, fwd_megakernel, 256, 0);
    if (per_cu > 2) per_cu = 2;
    if (per_cu < 1) per_cu = 1;
    grid_blocks = cus * per_cu;
    grid_blocks -= grid_blocks % 8;
  }
  Params p{};
  const float** pf = (const float**)&p;
  for (int i = 0; i < 32; ++i) pf[i] = (const float*)d_in[i];
  p.pos = (const int*)d_in[2];
  p.out = (float*)d_out; p.ws = (char*)d_ws;
  hipMemsetAsync((char*)d_ws + OFF_BAR, 0, XCD_BAR_WORDS * sizeof(unsigned), stream);
  void* args[] = {&p};
  hipError_t e = hipLaunchCooperativeKernel((void*)fwd_megakernel, dim3(grid_blocks), dim3(256), args, 0, stream);
  if (e != hipSuccess) fprintf(stderr, "cooperative launch failed: %s (grid %d)\n", hipGetErrorString(e), grid_blocks);
}
```

```cpp
#include <hip/hip_runtime.h>
#include <hip/hip_cooperative_groups.h>
#include <cstdio>
namespace cg = cooperative_groups;
#ifndef USE_XATTN_MFMA
#define USE_XATTN_MFMA 1
#endif
#ifndef USE_S5_GEMM
#define USE_S5_GEMM 1
#endif
#ifndef USE_DIL_MFMA
#define USE_DIL_MFMA 1
#endif

typedef unsigned short bf16_t;
using bf16x8 = __attribute__((ext_vector_type(8))) short;
using f32x4 = __attribute__((ext_vector_type(4))) float;
#define DI __device__ __forceinline__

constexpr int T_ = 32768, S_ = 4096;
constexpr size_t MiB = (size_t)1 << 20;
constexpr size_t SZ_SQ = (size_t)1024 * 1024, SZ_WIN = (size_t)3712 * 1024, SZ_GLU = (size_t)2048 * 1024,
                 SZ_GU = (size_t)5632 * 1024, SZ_WD = (size_t)1024 * 2816;
constexpr size_t SZ_COMMON = 4 * SZ_SQ + SZ_GU + SZ_WD;
constexpr size_t W_EVEN0 = 4 * SZ_COMMON;
constexpr size_t W_ODD0 = W_EVEN0 + 2 * (SZ_WIN + SZ_SQ);
constexpr float ALPHA = 1.681792830507429f;

constexpr size_t OFF_W = 0;
constexpr size_t OFF_ROPE = 125 * MiB;
constexpr size_t OFF_HB = 133 * MiB;
constexpr size_t OFF_KX = 197 * MiB;
constexpr size_t OFF_VX = 201 * MiB;
constexpr size_t OFF_BIG = 205 * MiB;
constexpr size_t OFF_BAR = 511 * MiB;
constexpr size_t OFF_DNQKV = OFF_BIG;
constexpr size_t OFF_Z = OFF_BIG + 96 * MiB;
constexpr size_t OFF_SWQ = OFF_BIG + 128 * MiB;
constexpr size_t OFF_SWK = OFF_BIG + 160 * MiB;
constexpr size_t OFF_SWV = OFF_BIG + 192 * MiB;
constexpr size_t OFF_LOGIT = OFF_BIG + 224 * MiB;
constexpr size_t OFF_QD = OFF_BIG + 225 * MiB;
constexpr size_t OFF_KD = OFF_BIG + 257 * MiB;
constexpr size_t OFF_INTRA = OFF_BIG + 289 * MiB;
constexpr size_t OFF_WB = OFF_HB;
constexpr size_t OFF_UB = OFF_HB + 32 * MiB;
constexpr size_t OFF_EG = OFF_KX;
constexpr size_t OFF_XQ = OFF_BIG;
constexpr size_t OFF_XO = OFF_BIG + 64 * MiB;
constexpr size_t OFF_ACT = OFF_BIG;
constexpr size_t OFF_HID = OFF_BIG;
constexpr size_t OFF_SIN = OFF_BIG + 64 * MiB;
constexpr size_t OFF_KTAB = OFF_BIG + 80 * MiB;
constexpr size_t OFF_ETAB = OFF_BIG + 82 * MiB;
constexpr size_t OFF_GTAB = OFF_BIG + 90 * MiB;
constexpr size_t OFF_AL = OFF_BIG + 98 * MiB;

struct Params {
  const float* x; const float* mem; const int* pos;
  const float* hyb_w_in; const float* dn_conv_w; const float* dn_a_log; const float* dn_dt_bias; const float* dn_norm_g; const float* hyb_w_out;
  const float* s5_a_re; const float* s5_a_im; const float* s5_log_dt; const float* s5_b_re; const float* s5_b_im; const float* s5_c_re; const float* s5_c_im;
  const float* s5_d; const float* s5_glu_wo; const float* s5_glu_wg;
  const float* ln_mix_g; const float* ln_mix_b;
  const float* xq_w; const float* xk_w; const float* xv_w; const float* xo_w; const float* ln_x_g; const float* ln_x_b;
  const float* ffn_wg; const float* ffn_wu; const float* ffn_wd; const float* ln_ffn_g; const float* ln_ffn_b;
  float* out; char* ws;
};

DI int TID() { int t = threadIdx.x; asm volatile("" : "+v"(t)); return t; }
DI int BID() { int t = blockIdx.x; asm volatile("" : "+s"(t)); return t; }
DI int GDIM() { int t = gridDim.x; asm volatile("" : "+s"(t)); return t; }
DI bf16_t f2bf(float x) { unsigned u = __float_as_uint(x); u += 0x7fffu + ((u >> 16) & 1u); return (bf16_t)(u >> 16); }
DI float bf2f(bf16_t v) { return __uint_as_float(((unsigned)v) << 16); }
DI unsigned pack2(float a, float b) { return (unsigned)f2bf(a) | ((unsigned)f2bf(b) << 16); }
using u32x4 = __attribute__((ext_vector_type(4))) unsigned;
using u32x2 = __attribute__((ext_vector_type(2))) unsigned;
DI bf16x8 pack8(f32x4 a, f32x4 b) {
  u32x4 t; t[0] = pack2(a[0], a[1]); t[1] = pack2(a[2], a[3]); t[2] = pack2(b[0], b[1]); t[3] = pack2(b[2], b[3]);
  return __builtin_bit_cast(bf16x8, t);
}
#define MFMA16(a, b, c) __builtin_amdgcn_mfma_f32_16x16x32_bf16((a), (b), (c), 0, 0, 0)
DI int kperm(int x) { return (x & ~31) | (((x >> 2) & 3) * 8 + ((x >> 4) & 1) * 4 + (x & 3)); }
DI float wave_sum(float v) { for (int o = 32; o > 0; o >>= 1) v += __shfl_xor(v, o); return v; }
DI float wave_max(float v) { for (int o = 32; o > 0; o >>= 1) v = fmaxf(v, __shfl_xor(v, o)); return v; }
DI float sigmoidf_(float x) { return 1.f / (1.f + __expf(-x)); }
DI float siluf_(float x) { return x * sigmoidf_(x); }
DI float softplusf_(float x) { return fmaxf(x, 0.f) + log1pf(__expf(-fabsf(x))); }
DI float gelu_tanh(float x) { float u = 0.7978845608028654f * (x + 0.044715f * x * x * x); return 0.5f * x * (1.f + tanhf(u)); }

template <class CM>
DI void transpose_job(bf16_t* dst, int Ndst, int K, int srcStride, CM colptr, float* tile) {
  const int ntk = K / 64, ntiles = (Ndst / 64) * ntk;
  for (int tl = BID(); tl < ntiles; tl += GDIM()) {
    const int r0 = (tl / ntk) * 64, k0 = (tl % ntk) * 64;
    const int rl = TID() & 63, ks = TID() >> 6;
    const float* cp = colptr(r0 + rl);
    for (int i = 0; i < 16; ++i) { int kl = ks * 16 + i; tile[kl * 65 + rl] = cp ? cp[(size_t)(k0 + kl) * srcStride] : 0.f; }
    __syncthreads();
    const int kk = TID() & 63, rs = TID() >> 6;
    for (int i = 0; i < 16; ++i) { int rr = i * 4 + rs; dst[(size_t)(r0 + rr) * K + k0 + kk] = f2bf(tile[kk * 65 + rr]); }
    __syncthreads();
  }
}

DI void phase_prologue(const Params& p, float* smem) {
  bf16_t* W = (bf16_t*)(p.ws + OFF_W);
  for (int l = 0; l < 4; ++l) {
    bf16_t* wc = W + (size_t)l * SZ_COMMON;
    const float* s;
    s = p.xq_w + (size_t)l * SZ_SQ; transpose_job(wc, 1024, 1024, 1024, [=](int r) { return s + r; }, smem);
    s = p.xk_w + (size_t)l * SZ_SQ; transpose_job(wc + SZ_SQ, 1024, 1024, 1024, [=](int r) { return s + r; }, smem);
    s = p.xv_w + (size_t)l * SZ_SQ; transpose_job(wc + 2 * SZ_SQ, 1024, 1024, 1024, [=](int r) { return s + r; }, smem);
    s = p.xo_w + (size_t)l * SZ_SQ; transpose_job(wc + 3 * SZ_SQ, 1024, 1024, 1024, [=](int r) { return s + r; }, smem);
    {
      const float* g = p.ffn_wg + (size_t)l * 1024 * 2816; const float* u = p.ffn_wu + (size_t)l * 1024 * 2816;
      transpose_job(wc + 4 * SZ_SQ, 5632, 1024, 2816, [=](int r) { int c = (r >> 5) * 16 + (r & 15); return ((r >> 4) & 1) ? (u + c) : (g + c); }, smem);
    }
    s = p.ffn_wd + (size_t)l * 2816 * 1024; transpose_job(wc + 4 * SZ_SQ + SZ_GU, 1024, 2816, 1024, [=](int r) { return s + r; }, smem);
  }
  for (int i = 0; i < 2; ++i) {
    bf16_t* we = W + W_EVEN0 + (size_t)i * (SZ_WIN + SZ_SQ);
    const float* s = p.hyb_w_in + (size_t)i * 1024 * 3592;
    transpose_job(we, 3712, 1024, 3592, [=](int r) -> const float* {
      if (r < 2048) return s + r;
      if (r < 3584) return s + r + 8;
      if (r < 3592) return s + 2048 + (r - 3584);
      return nullptr; }, smem);
    const float* s2 = p.hyb_w_out + (size_t)i * SZ_SQ;
    transpose_job(we + SZ_WIN, 1024, 1024, 1024, [=](int r) { return s2 + r; }, smem);
    bf16_t* wo = W + W_ODD0 + (size_t)i * SZ_GLU;
    const float* a = p.s5_glu_wo + (size_t)i * SZ_SQ; const float* b = p.s5_glu_wg + (size_t)i * SZ_SQ;
    transpose_job(wo, 2048, 1024, 1024, [=](int r) { int c = (r >> 5) * 16 + (r & 15); return ((r >> 4) & 1) ? (b + c) : (a + c); }, smem);
  }
  const size_t gtid = (size_t)BID() * 256 + TID(), gsz = (size_t)GDIM() * 256;
  bf16_t* hb = (bf16_t*)(p.ws + OFF_HB);
  for (size_t i = gtid; i < (size_t)T_ * 256; i += gsz) {
    float4 v = ((const float4*)p.x)[i];
    ((float4*)p.out)[i] = v;
    uint2 o; o.x = pack2(v.x, v.y); o.y = pack2(v.z, v.w);
    ((uint2*)hb)[i] = o;
  }
  float* rc = (float*)(p.ws + OFF_ROPE); float* rs = rc + (size_t)T_ * 32;
  for (size_t i = gtid; i < (size_t)T_ * 32; i += gsz) {
    int t = (int)(i >> 5), j = (int)(i & 31);
    float invf = (float)exp(-(double)(2 * j) / 64.0 * 9.210340371976184);
    float ang = (float)p.pos[t] * invf;
    double a = (double)ang;
    double k = rint(a * 0.15915494309189535);
    float r = (float)(a - k * 6.283185307179586);
    rc[i] = cosf(r); rs[i] = sinf(r);
  }
}

constexpr int LDT = 72;
template <class AL, class BL, class EP>
DI void gemm_tile(int m0, int n0, int nks, AL aload, BL bload, EP epi, bf16_t* smem) {
  bf16_t* As = smem; bf16_t* Bs = smem + 2 * 128 * LDT;
  const int tid = TID(), lane = tid & 63, wave = tid >> 6;
  const int wm = wave >> 1, wn = wave & 1, l15 = lane & 15, quad = lane >> 4;
  const int lrow = tid >> 3, lkc = (tid & 7) * 8;
  f32x4 acc[4][4];
#pragma unroll
  for (int i = 0; i < 4; ++i)
#pragma unroll
    for (int j = 0; j < 4; ++j) acc[i][j] = f32x4{0.f, 0.f, 0.f, 0.f};
  uint4 ra0[4], rb0[4], ra1[4], rb1[4];
#pragma unroll
  for (int i = 0; i < 4; ++i) { ra0[i] = aload(m0 + lrow + 32 * i, 0, lkc); rb0[i] = bload(n0 + lrow + 32 * i, 0, lkc); }
#pragma unroll
  for (int i = 0; i < 4; ++i) { ra1[i] = aload(m0 + lrow + 32 * i, 1, lkc); rb1[i] = bload(n0 + lrow + 32 * i, 1, lkc); }
#pragma unroll
  for (int i = 0; i < 4; ++i) {
    *(uint4*)(As + (lrow + 32 * i) * LDT + lkc) = ra0[i];
    *(uint4*)(Bs + (lrow + 32 * i) * LDT + lkc) = rb0[i];
  }
  __syncthreads();
  auto compute = [&](int cur) {
    const bf16_t* Ab = As + cur * 128 * LDT; const bf16_t* Bb = Bs + cur * 128 * LDT;
#pragma unroll
    for (int kk = 0; kk < 2; ++kk) {
      bf16x8 a[4], b[4];
#pragma unroll
      for (int mt = 0; mt < 4; ++mt) a[mt] = *(const bf16x8*)(Ab + (wm * 64 + mt * 16 + l15) * LDT + kk * 32 + quad * 8);
#pragma unroll
      for (int nt = 0; nt < 4; ++nt) b[nt] = *(const bf16x8*)(Bb + (wn * 64 + nt * 16 + l15) * LDT + kk * 32 + quad * 8);
#pragma unroll
      for (int mt = 0; mt < 4; ++mt)
#pragma unroll
        for (int nt = 0; nt < 4; ++nt) acc[mt][nt] = __builtin_amdgcn_mfma_f32_16x16x32_bf16(a[mt], b[nt], acc[mt][nt], 0, 0, 0);
    }
  };
  for (int ks = 0; ks < nks; ks += 2) {
    if (ks + 2 < nks) {
#pragma unroll
      for (int i = 0; i < 4; ++i) { ra0[i] = aload(m0 + lrow + 32 * i, ks + 2, lkc); rb0[i] = bload(n0 + lrow + 32 * i, ks + 2, lkc); }
    }
    compute(0);
#pragma unroll
    for (int i = 0; i < 4; ++i) {
      *(uint4*)(As + 128 * LDT + (lrow + 32 * i) * LDT + lkc) = ra1[i];
      *(uint4*)(Bs + 128 * LDT + (lrow + 32 * i) * LDT + lkc) = rb1[i];
    }
    __syncthreads();
    if (ks + 3 < nks) {
#pragma unroll
      for (int i = 0; i < 4; ++i) { ra1[i] = aload(m0 + lrow + 32 * i, ks + 3, lkc); rb1[i] = bload(n0 + lrow + 32 * i, ks + 3, lkc); }
    }
    compute(1);
    if (ks + 2 < nks) {
#pragma unroll
      for (int i = 0; i < 4; ++i) {
        *(uint4*)(As + (lrow + 32 * i) * LDT + lkc) = ra0[i];
        *(uint4*)(Bs + (lrow + 32 * i) * LDT + lkc) = rb0[i];
      }
    }
    __syncthreads();
  }
  epi(acc, m0 + wm * 64, n0 + wn * 64);
}

template <class F>
DI void for_tiles(int mtiles, int ntiles, F f) {
  const int xcd = BID() & 7, slot = BID() >> 3, nslot = GDIM() >> 3;
  const int per = (mtiles >> 3) * ntiles;
  for (int w = slot; w < per; w += nslot) {
    int mi = w / ntiles, ni = w - mi * ntiles;
    f((mi * 8 + xcd), ni);
  }
}

#define EPI_LOOP for (int mt = 0; mt < 4; ++mt) for (int nt = 0; nt < 4; ++nt) for (int r = 0; r < 4; ++r)

DI void epi_resid(const Params& p, f32x4 (&acc)[4][4], int rb, int cb) {
  const int lane = TID() & 63, l15 = lane & 15, quad = lane >> 4;
#pragma unroll
  for (int mt = 0; mt < 4; ++mt)
#pragma unroll
    for (int nt = 0; nt < 4; ++nt)
#pragma unroll
      for (int r = 0; r < 4; ++r) {
        size_t idx = (size_t)(rb + mt * 16 + quad * 4 + r) * 1024 + cb + nt * 16 + l15;
        p.out[idx] = ALPHA * p.out[idx] + acc[mt][nt][r];
      }
}
DI void epi_bf16(bf16_t* dst, int ld, f32x4 (&acc)[4][4], int rb, int cb) {
  const int lane = TID() & 63, l15 = lane & 15, quad = lane >> 4;
#pragma unroll
  for (int mt = 0; mt < 4; ++mt)
#pragma unroll
    for (int nt = 0; nt < 4; ++nt)
#pragma unroll
      for (int r = 0; r < 4; ++r)
        dst[(size_t)(rb + mt * 16 + quad * 4 + r) * ld + cb + nt * 16 + l15] = f2bf(acc[mt][nt][r]);
}

struct PlainLoad {
  const bf16_t* base; int ld;
  DI uint4 operator()(int row, int ks, int kc) const { return *(const uint4*)((const char*)base + (unsigned)((row * ld + ks * 64 + kc) * 2)); }
};

DI void phase_proj(const Params& p, int i, bf16_t* smem) {
  const bf16_t* W = (const bf16_t*)(p.ws + OFF_W) + W_EVEN0 + (size_t)i * (SZ_WIN + SZ_SQ);
  PlainLoad al{(const bf16_t*)(p.ws + OFF_HB), 1024}, bl{W, 1024};
  bf16_t* dnqkv = (bf16_t*)(p.ws + OFF_DNQKV); bf16_t* z = (bf16_t*)(p.ws + OFF_Z);
  bf16_t* swq = (bf16_t*)(p.ws + OFF_SWQ); bf16_t* swk = (bf16_t*)(p.ws + OFF_SWK); bf16_t* swv = (bf16_t*)(p.ws + OFF_SWV);
  float* logit = (float*)(p.ws + OFF_LOGIT);
  const float* rc = (const float*)(p.ws + OFF_ROPE); const float* rs = rc + (size_t)T_ * 32;
  for_tiles(256, 29, [&](int mi, int ni) {
    gemm_tile(mi * 128, ni * 128, 16, al, bl, [&](f32x4 (&acc)[4][4], int rb, int cb) {
      const int lane = TID() & 63, l15 = lane & 15, quad = lane >> 4;
      if (cb < 1536) epi_bf16(dnqkv, 1536, acc, rb, cb);
      else if (cb < 2048) epi_bf16(z, 512, acc, rb, cb - 1536);
      else if (cb < 3072) {
        bf16_t* dst = (cb < 2560) ? swq : swk; const int c0 = (cb < 2560) ? cb - 2048 : cb - 2560;
#pragma unroll
        for (int mt = 0; mt < 4; ++mt)
#pragma unroll
          for (int r = 0; r < 4; ++r) {
            const int row = rb + mt * 16 + quad * 4 + r;
#pragma unroll
            for (int nt = 0; nt < 2; ++nt) {
              const int d = nt * 16 + l15;
              float c = rc[(size_t)row * 32 + d], s = rs[(size_t)row * 32 + d];
              float x1 = acc[mt][nt][r], x2 = acc[mt][nt + 2][r];
              dst[(size_t)row * 512 + c0 + d] = f2bf(x1 * c - x2 * s);
              dst[(size_t)row * 512 + c0 + d + 32] = f2bf(x2 * c + x1 * s);
            }
          }
      } else if (cb < 3584) epi_bf16(swv, 512, acc, rb, cb - 3072);
      else if (cb == 3584) {
#pragma unroll
        for (int mt = 0; mt < 4; ++mt)
#pragma unroll
          for (int r = 0; r < 4; ++r)
            if (l15 < 8) logit[(size_t)(rb + mt * 16 + quad * 4 + r) * 8 + l15] = acc[mt][0][r];
      }
    }, smem);
  });
}

DI void phase_dil_attn(const Params& p, int first, int nblk);

DI void phase_dn_prep(const Params& p, int i, char* smem) {
  bf16_t* qs = (bf16_t*)smem; bf16_t* ks = qs + 64 * 136; bf16_t* vs = ks + 64 * 136;
  float* Lm = (float*)(smem + 3 * 17408); float* beta = Lm + 64 * 68; float* gcum = beta + 64; float* egc = gcum + 64;
  const bf16_t* dnqkv = (const bf16_t*)(p.ws + OFF_DNQKV);
  const float* logit = (const float*)(p.ws + OFF_LOGIT);
  bf16_t* qd_g = (bf16_t*)(p.ws + OFF_QD); bf16_t* kd_g = (bf16_t*)(p.ws + OFF_KD); bf16_t* in_g = (bf16_t*)(p.ws + OFF_INTRA);
  bf16_t* w_g = (bf16_t*)(p.ws + OFF_WB); bf16_t* u_g = (bf16_t*)(p.ws + OFF_UB); float* eg_g = (float*)(p.ws + OFF_EG);
  const float* cw = p.dn_conv_w + (size_t)i * 4 * 1536;
  const int tid = TID(), wave = tid >> 6, lane = tid & 63, l15 = lane & 15, quad = lane >> 4;
  const float QS = 0.08838834764831845f;
  for (int item = BID(); item < 2048; item += GDIM()) {
    const int b = item >> 8, h = (item >> 6) & 3, n = item & 63;
    const int t0 = b * 4096 + n * 64, s0 = n * 64;
    const float A = __expf(p.dn_a_log[i * 4 + h]), dtb = p.dn_dt_bias[i * 4 + h];
    for (int tt = 0; tt < 16; ++tt) {
      const int il = tt * 4 + wave, t = t0 + il, sq = s0 + il;
#pragma unroll
      for (int which = 0; which < 3; ++which) {
        const int col = which * 512 + h * 128 + lane * 2;
        float y0 = 0.f, y1 = 0.f;
#pragma unroll
        for (int j = 0; j < 4; ++j) {
          if (sq - 3 + j >= 0) {
            unsigned v = *(const unsigned*)(dnqkv + (size_t)(t - 3 + j) * 1536 + col);
            y0 += cw[j * 1536 + col] * bf2f((bf16_t)(v & 0xffff));
            y1 += cw[j * 1536 + col + 1] * bf2f((bf16_t)(v >> 16));
          }
        }
        y0 = siluf_(y0); y1 = siluf_(y1);
        if (which < 2) {
          float ss = wave_sum(y0 * y0 + y1 * y1);
          float sc = rsqrtf(ss + 1e-6f);
          y0 *= sc; y1 *= sc;
        }
        bf16_t* dst = (which == 0) ? qs : (which == 1 ? ks : vs);
        *(unsigned*)(dst + il * 136 + lane * 2) = pack2(y0, y1);
      }
    }
    if (wave == 0) {
      const size_t row = (size_t)(t0 + lane);
      const float bl = logit[row * 8 + h], al = logit[row * 8 + 4 + h];
      float g = -A * softplusf_(al + dtb);
#pragma unroll
      for (int o = 1; o < 64; o <<= 1) { float v = __shfl_up(g, o); if (lane >= o) g += v; }
      beta[lane] = sigmoidf_(bl); gcum[lane] = g; egc[lane] = __expf(g);
    }
    __syncthreads();
    {
      f32x4 kk[4], qk[4];
#pragma unroll
      for (int nt = 0; nt < 4; ++nt) { kk[nt] = f32x4{0.f, 0.f, 0.f, 0.f}; qk[nt] = f32x4{0.f, 0.f, 0.f, 0.f}; }
#pragma unroll
      for (int k4 = 0; k4 < 4; ++k4) {
        const bf16x8 ak = *(const bf16x8*)(ks + (wave * 16 + l15) * 136 + k4 * 32 + quad * 8);
        const bf16x8 aq = *(const bf16x8*)(qs + (wave * 16 + l15) * 136 + k4 * 32 + quad * 8);
#pragma unroll
        for (int nt = 0; nt < 4; ++nt) {
          const bf16x8 bk = *(const bf16x8*)(ks + (nt * 16 + l15) * 136 + k4 * 32 + quad * 8);
          kk[nt] = MFMA16(ak, bk, kk[nt]); qk[nt] = MFMA16(aq, bk, qk[nt]);
        }
      }
#pragma unroll
      for (int nt = 0; nt < 4; ++nt)
#pragma unroll
        for (int r = 0; r < 4; ++r) {
          const int ii = wave * 16 + quad * 4 + r, jj = nt * 16 + l15;
          const float dec = (jj <= ii) ? __expf(gcum[ii] - gcum[jj]) : 0.f;
          Lm[ii * 68 + jj] = (jj < ii) ? beta[ii] * kk[nt][r] * dec : 0.f;
          in_g[(size_t)item * 4096 + ii * 64 + kperm(jj)] = f2bf(qk[nt][r] * QS * dec);
        }
    }
    __syncthreads();
    {
      float x[64];
#pragma unroll
      for (int ii = 0; ii < 64; ++ii) x[ii] = 0.f;
      const int c = tid & 127;
      const bool isw = tid >= 128;
      bf16_t* dstb = (isw ? w_g : u_g) + (size_t)item * 8192 + (isw ? kperm(c) : c);
      const bf16_t* srcb = (isw ? ks : vs) + c;
#pragma unroll
      for (int ii = 0; ii < 64; ++ii) {
        float acc = bf2f(srcb[ii * 136]) * beta[ii] * (isw ? egc[ii] : 1.f);
#pragma unroll
        for (int j4 = 0; j4 < (ii + 3) / 4; ++j4) {
          const float4 l4 = *(const float4*)(Lm + ii * 68 + j4 * 4);
          acc -= l4.x * x[j4 * 4]; acc -= l4.y * x[j4 * 4 + 1]; acc -= l4.z * x[j4 * 4 + 2]; acc -= l4.w * x[j4 * 4 + 3];
        }
        x[ii] = acc;
        dstb[ii * 128] = f2bf(acc);
        if ((ii & 3) == 3) __builtin_amdgcn_sched_barrier(0);
      }
    }
    {
      const float gl = gcum[63];
#pragma unroll 4
      for (int k = 0; k < 32; ++k) {
        const int e = tid + 256 * k;
        const int ii = e >> 7, d = e & 127;
        qd_g[(size_t)item * 8192 + ii * 128 + kperm(d)] = f2bf(bf2f(qs[ii * 136 + d]) * QS * egc[ii]);
        const int d2 = e >> 6, i2 = e & 63;
        kd_g[(size_t)item * 8192 + d2 * 64 + kperm(i2)] = f2bf(bf2f(ks[i2 * 136 + d2]) * __expf(gl - gcum[i2]));
      }
      if (tid == 0) eg_g[item] = __expf(gl);
    }
    __syncthreads();
  }
}

DI bf16x8 ld2(const bf16_t* ptr) {
  u32x2 lo = *(const u32x2*)ptr, hi = *(const u32x2*)(ptr + 16);
  u32x4 t; t[0] = lo[0]; t[1] = lo[1]; t[2] = hi[0]; t[3] = hi[1];
  return __builtin_bit_cast(bf16x8, t);
}

DI void dn_chain_item(const Params& p, int item, bf16_t* smem) {
  const int tid = TID(), wave = tid >> 6, lane = tid & 63, l15 = lane & 15, quad = lane >> 4;
  const int bh = item >> 1, half = item & 1;
  const int e0 = half * 64 + wave * 16 + l15;
  const bf16_t* qd_g = (const bf16_t*)(p.ws + OFF_QD); const bf16_t* kd_g = (const bf16_t*)(p.ws + OFF_KD); const bf16_t* in_g = (const bf16_t*)(p.ws + OFF_INTRA);
  const bf16_t* w_g = (const bf16_t*)(p.ws + OFF_WB); bf16_t* u_g = (bf16_t*)(p.ws + OFF_UB); const float* eg_g = (const float*)(p.ws + OFF_EG);
  bf16_t* wl = smem; bf16_t* ql = wl + 64 * 136; bf16_t* kl = ql + 64 * 136; bf16_t* il = kl + 128 * 72; bf16_t* ul = il + 64 * 72;
  uint4 rw0, rw1, rw2, rw3, rq0, rq1, rq2, rq3, rk0, rk1, rk2, rk3, ri0, ri1, ru0, ru1;
#define CH_GLOAD(n_) do { const size_t ci_ = (size_t)bh * 64 + (n_); \
    const bf16_t* w_ = w_g + ci_ * 8192 + tid * 8; const bf16_t* q_ = qd_g + ci_ * 8192 + tid * 8; const bf16_t* k_ = kd_g + ci_ * 8192 + tid * 8; \
    rw0 = *(const uint4*)(w_); rw1 = *(const uint4*)(w_ + 2048); rw2 = *(const uint4*)(w_ + 4096); rw3 = *(const uint4*)(w_ + 6144); \
    rq0 = *(const uint4*)(q_); rq1 = *(const uint4*)(q_ + 2048); rq2 = *(const uint4*)(q_ + 4096); rq3 = *(const uint4*)(q_ + 6144); \
    rk0 = *(const uint4*)(k_); rk1 = *(const uint4*)(k_ + 2048); rk2 = *(const uint4*)(k_ + 4096); rk3 = *(const uint4*)(k_ + 6144); \
    ri0 = *(const uint4*)(in_g + ci_ * 4096 + tid * 8); ri1 = *(const uint4*)(in_g + ci_ * 4096 + 2048 + tid * 8); \
    ru0 = *(const uint4*)(u_g + ci_ * 8192 + (tid >> 3) * 128 + half * 64 + (tid & 7) * 8); \
    ru1 = *(const uint4*)(u_g + ci_ * 8192 + (32 + (tid >> 3)) * 128 + half * 64 + (tid & 7) * 8); } while (0)
#define CH_LSTORE() do { \
    bf16_t* w_ = wl + (tid >> 4) * 136 + (tid & 15) * 8; bf16_t* q_ = ql + (tid >> 4) * 136 + (tid & 15) * 8; bf16_t* k_ = kl + (tid >> 3) * 72 + (tid & 7) * 8; \
    *(uint4*)(w_) = rw0; *(uint4*)(w_ + 16 * 136) = rw1; *(uint4*)(w_ + 32 * 136) = rw2; *(uint4*)(w_ + 48 * 136) = rw3; \
    *(uint4*)(q_) = rq0; *(uint4*)(q_ + 16 * 136) = rq1; *(uint4*)(q_ + 32 * 136) = rq2; *(uint4*)(q_ + 48 * 136) = rq3; \
    *(uint4*)(k_) = rk0; *(uint4*)(k_ + 32 * 72) = rk1; *(uint4*)(k_ + 64 * 72) = rk2; *(uint4*)(k_ + 96 * 72) = rk3; \
    *(uint4*)(il + (tid >> 3) * 72 + (tid & 7) * 8) = ri0; *(uint4*)(il + (32 + (tid >> 3)) * 72 + (tid & 7) * 8) = ri1; \
    *(uint4*)(ul + (tid >> 3) * 72 + (tid & 7) * 8) = ru0; *(uint4*)(ul + (32 + (tid >> 3)) * 72 + (tid & 7) * 8) = ru1; } while (0)
  f32x4 S[8];
#pragma unroll
  for (int mt = 0; mt < 8; ++mt) S[mt] = f32x4{0.f, 0.f, 0.f, 0.f};
  CH_GLOAD(0);
  CH_LSTORE();
  __syncthreads();
#pragma unroll 1
  for (int n = 0; n < 64; ++n) {
    const size_t ci = (size_t)bh * 64 + n;
    if (n + 1 < 64) CH_GLOAD(n + 1);
    bf16_t* ub = u_g + ci * 8192;
    const float eg = eg_g[ci];
    bf16x8 sb[4];
#pragma unroll
    for (int s = 0; s < 4; ++s) sb[s] = pack8(S[2 * s], S[2 * s + 1]);
    f32x4 vn[4];
#pragma unroll
    for (int it = 0; it < 4; ++it) {
      f32x4 a = {0.f, 0.f, 0.f, 0.f};
#pragma unroll
      for (int s = 0; s < 4; ++s) a = MFMA16(*(const bf16x8*)(wl + (it * 16 + l15) * 136 + s * 32 + quad * 8), sb[s], a);
#pragma unroll
      for (int r = 0; r < 4; ++r) vn[it][r] = bf2f(ul[(it * 16 + quad * 4 + r) * 72 + wave * 16 + l15]) - a[r];
    }
    bf16x8 vb[2];
    vb[0] = pack8(vn[0], vn[1]); vb[1] = pack8(vn[2], vn[3]);
#pragma unroll
    for (int it = 0; it < 4; ++it) {
      f32x4 a = {0.f, 0.f, 0.f, 0.f};
#pragma unroll
      for (int s = 0; s < 4; ++s) a = MFMA16(*(const bf16x8*)(ql + (it * 16 + l15) * 136 + s * 32 + quad * 8), sb[s], a);
#pragma unroll
      for (int s = 0; s < 2; ++s) a = MFMA16(*(const bf16x8*)(il + (it * 16 + l15) * 72 + s * 32 + quad * 8), vb[s], a);
#pragma unroll
      for (int r = 0; r < 4; ++r) ub[(it * 16 + quad * 4 + r) * 128 + e0] = f2bf(a[r]);
    }
#pragma unroll
    for (int mt = 0; mt < 8; ++mt) {
      f32x4 a = S[mt];
      a[0] *= eg; a[1] *= eg; a[2] *= eg; a[3] *= eg;
#pragma unroll
      for (int s = 0; s < 2; ++s) a = MFMA16(*(const bf16x8*)(kl + (mt * 16 + l15) * 72 + s * 32 + quad * 8), vb[s], a);
      S[mt] = a;
    }
    __syncthreads();
    if (n + 1 < 64) CH_LSTORE();
    __syncthreads();
  }
}

DI void phase_mix(const Params& p, int i, bf16_t* smem) {
  if (BID() < 64) { dn_chain_item(p, BID(), smem); return; }
  phase_dil_attn(p, BID() - 64, GDIM() - 64);
}

DI void phase_dn_post(const Params& p, int i) {
  const bf16_t* ob = (const bf16_t*)(p.ws + OFF_UB);
  bf16_t* z = (bf16_t*)(p.ws + OFF_Z);
  const float* ng = p.dn_norm_g + i * 128;
  const int wave = TID() >> 6, lane = TID() & 63;
  const int N = T_ * 4;
  for (int base = BID() * 4; base < N; base += GDIM() * 4) {
    const int item = base + wave;
    const int t = item >> 2, h = item & 3, b = t >> 12, sidx = t & 4095;
    const size_t g = (size_t)item * 128 + lane * 2;
    const size_t og = ((size_t)((b * 4 + h) * 64 + (sidx >> 6))) * 8192 + (sidx & 63) * 128 + lane * 2;
    unsigned ov = *(const unsigned*)(ob + og), zv = *(const unsigned*)(z + g);
    float o0 = bf2f((bf16_t)(ov & 0xffff)), o1 = bf2f((bf16_t)(ov >> 16));
    float z0 = bf2f((bf16_t)(zv & 0xffff)), z1 = bf2f((bf16_t)(zv >> 16));
    float ms = wave_sum(o0 * o0 + o1 * o1) * (1.f / 128.f);
    float rr = rsqrtf(ms + 1e-6f);
    float r0 = o0 * rr * ng[lane * 2] * siluf_(z0), r1 = o1 * rr * ng[lane * 2 + 1] * siluf_(z1);
    *(unsigned*)(z + g) = pack2(r0, r1);
  }
}

struct MixLoad {
  const bf16_t* a; const bf16_t* b;
  DI uint4 operator()(int row, int ks, int kc) const {
    const unsigned off = (unsigned)((row * 512 + (ks & 7) * 64 + kc) * 2);
    return *(const uint4*)((const char*)((ks < 8) ? a : b) + off);
  }
};

DI void phase_wout(const Params& p, int i, bf16_t* smem) {
  const bf16_t* W = (const bf16_t*)(p.ws + OFF_W) + W_EVEN0 + (size_t)i * (SZ_WIN + SZ_SQ) + SZ_WIN;
  MixLoad al{(const bf16_t*)(p.ws + OFF_Z), (const bf16_t*)(p.ws + OFF_SWQ)};
  PlainLoad bl{W, 1024};
  for_tiles(256, 8, [&](int mi, int ni) {
    gemm_tile(mi * 128, ni * 128, 16, al, bl, [&](f32x4 (&acc)[4][4], int rb, int cb) { epi_resid(p, acc, rb, cb); }, smem);
  });
}

DI void phase_ln(const Params& p, const float* g, const float* b) {
  const int wave = TID() >> 6, lane = TID() & 63;
  bf16_t* hb = (bf16_t*)(p.ws + OFF_HB);
  for (int row = BID() * 4 + wave; row < T_; row += GDIM() * 4) {
    float4* y = (float4*)(p.out + (size_t)row * 1024);
    float4 v[4];
    float s = 0.f;
#pragma unroll
    for (int i = 0; i < 4; ++i) { v[i] = y[lane + 64 * i]; s += v[i].x + v[i].y + v[i].z + v[i].w; }
    const float mu = wave_sum(s) * (1.f / 1024.f);
    float q = 0.f;
#pragma unroll
    for (int i = 0; i < 4; ++i) { float a = v[i].x - mu, b2 = v[i].y - mu, c = v[i].z - mu, d = v[i].w - mu; q += a * a + b2 * b2 + c * c + d * d; }
    const float rstd = rsqrtf(wave_sum(q) * (1.f / 1024.f) + 1e-5f);
#pragma unroll
    for (int i = 0; i < 4; ++i) {
      float4 gg = ((const float4*)g)[lane + 64 * i], bb = ((const float4*)b)[lane + 64 * i];
      float4 o;
      o.x = (v[i].x - mu) * rstd * gg.x + bb.x; o.y = (v[i].y - mu) * rstd * gg.y + bb.y;
      o.z = (v[i].z - mu) * rstd * gg.z + bb.z; o.w = (v[i].w - mu) * rstd * gg.w + bb.w;
      y[lane + 64 * i] = o;
      uint2 ob; ob.x = pack2(o.x, o.y); ob.y = pack2(o.z, o.w);
      ((uint2*)(hb + (size_t)row * 1024))[lane + 64 * i] = ob;
    }
  }
}

DI void phase_s5_naive(const Params& p, int i) {
  const int wave = TID() >> 6, lane = TID() & 63;
  bf16_t* hid = (bf16_t*)(p.ws + OFF_HID);
  for (int base = BID() * 4; base < 512; base += GDIM() * 4) {
    const int item = base + wave, b = item >> 6, g = item & 63;
    const int gp = (i * 64 + g) * 64 + lane;
    const double dt = exp((double)p.s5_log_dt[i * 64 + g]);
    const double are = p.s5_a_re[gp], aim = p.s5_a_im[gp];
    const double lr = are * dt, li = aim * dt;
    const double kk = rint(li * 0.15915494309189535);
    const double red = li - kk * 6.283185307179586;
    const double e = exp(lr);
    const double abr = e * cos(red), abi = e * sin(red);
    const double den = are * are + aim * aim;
    const double nr = abr - 1.0, ni = abi;
    const double cfr = (nr * are + ni * aim) / den, cfi = (ni * are - nr * aim) / den;
    float bbr[16], bbi[16], cr[16], ci[16];
#pragma unroll
    for (int h = 0; h < 16; ++h) {
      const double br = p.s5_b_re[(size_t)gp * 16 + h], bi = p.s5_b_im[(size_t)gp * 16 + h];
      bbr[h] = (float)(cfr * br - cfi * bi); bbi[h] = (float)(cfr * bi + cfi * br);
      cr[h] = p.s5_c_re[((size_t)(i * 64 + g) * 16 + h) * 64 + lane];
      ci[h] = p.s5_c_im[((size_t)(i * 64 + g) * 16 + h) * 64 + lane];
    }
    const float ar = (float)abr, ai = (float)abi;
    const float dsk = p.s5_d[i * 1024 + g * 16 + (lane & 15)];
    float sr = 0.f, si = 0.f;
#pragma unroll 1
    for (int t = 0; t < S_; ++t) {
      const size_t row = (size_t)(b * S_ + t);
      const float4* up = (const float4*)(p.out + row * 1024 + g * 16);
      float u[16];
#pragma unroll
      for (int j = 0; j < 4; ++j) { float4 v = up[j]; u[4 * j] = v.x; u[4 * j + 1] = v.y; u[4 * j + 2] = v.z; u[4 * j + 3] = v.w; }
      float bur = 0.f, bui = 0.f;
#pragma unroll
      for (int h = 0; h < 16; ++h) { bur += bbr[h] * u[h]; bui += bbi[h] * u[h]; }
      const float nsr = ar * sr - ai * si + bur, nsi = ar * si + ai * sr + bui;
      sr = nsr; si = nsi;
      float yk = 0.f, uk = 0.f;
#pragma unroll
      for (int h = 0; h < 16; ++h) {
        float v = wave_sum(cr[h] * sr - ci[h] * si);
        if (lane == h) { yk = v; uk = u[h]; }
      }
      if (lane < 16) hid[row * 1024 + g * 16 + lane] = f2bf(gelu_tanh(yk + dsk * uk));
    }
  }
}

DI void phase_s5_tables(const Params& p, int i, float* smem) {
  float2* pw = (float2*)smem;
  float2* bb = pw + 64 * 33;
  float2* cc = bb + 64 * 16;
  bf16_t* Ktab = (bf16_t*)(p.ws + OFF_KTAB); bf16_t* Etab = (bf16_t*)(p.ws + OFF_ETAB); bf16_t* Gtab = (bf16_t*)(p.ws + OFF_GTAB);
  float2* AL = (float2*)(p.ws + OFF_AL);
  const int tid = TID();
  for (int g = BID(); g < 64; g += GDIM()) {
    const double dt = exp((double)p.s5_log_dt[i * 64 + g]);
    for (int e = tid; e < 64 * 33; e += 256) {
      const int pp = e / 33, n = e - pp * 33;
      const double are = p.s5_a_re[(i * 64 + g) * 64 + pp], aim = p.s5_a_im[(i * 64 + g) * 64 + pp];
      const double lr = are * dt * n, li = aim * dt * n;
      const double k = rint(li * 0.15915494309189535);
      const double red = li - k * 6.283185307179586;
      const double ex = exp(lr);
      pw[e] = make_float2((float)(ex * cos(red)), (float)(ex * sin(red)));
    }
    for (int e = tid; e < 1024; e += 256) {
      const int pp = e >> 4;
      const int gp = (i * 64 + g) * 64 + pp;
      const double are = p.s5_a_re[gp], aim = p.s5_a_im[gp];
      const double lr = are * dt, li = aim * dt;
      const double k = rint(li * 0.15915494309189535);
      const double red = li - k * 6.283185307179586;
      const double ex = exp(lr);
      const double nr = ex * cos(red) - 1.0, ni = ex * sin(red);
      const double den = are * are + aim * aim;
      const double cfr = (nr * are + ni * aim) / den, cfi = (ni * are - nr * aim) / den;
      const double br = p.s5_b_re[(size_t)gp * 16 + (e & 15)], bi = p.s5_b_im[(size_t)gp * 16 + (e & 15)];
      bb[e] = make_float2((float)(cfr * br - cfi * bi), (float)(cfr * bi + cfi * br));
      const size_t ci = ((size_t)(i * 64 + g) * 16 + (e >> 6)) * 64 + (e & 63);
      cc[e] = make_float2(p.s5_c_re[ci], p.s5_c_im[ci]);
    }
    __syncthreads();
    for (int e = tid; e < 8192; e += 256) {
      const int tau = e >> 8, ho = (e >> 4) & 15, hi = e & 15;
      float acc = 0.f;
      for (int pp = 0; pp < 64; ++pp) {
        const float2 c = cc[ho * 64 + pp], w = pw[pp * 33 + tau], b = bb[pp * 16 + hi];
        const float cwr = c.x * w.x - c.y * w.y, cwi = c.x * w.y + c.y * w.x;
        acc += cwr * b.x - cwi * b.y;
      }
      Ktab[(size_t)g * 8192 + e] = f2bf(acc);
    }
    for (int e = tid; e < 65536; e += 256) {
      const int pc = e >> 9, sidx = (e >> 4) & 31, hi = e & 15, pp = pc & 63;
      const float2 w = pw[pp * 33 + 31 - sidx], b = bb[pp * 16 + hi];
      const float v = (pc < 64) ? (w.x * b.x - w.y * b.y) : (w.x * b.y + w.y * b.x);
      Etab[(size_t)g * 65536 + e] = f2bf(v);
    }
    for (int e = tid; e < 65536; e += 256) {
      const int row = e >> 7, pc = e & 127, pp = pc & 63, t = row >> 4, ho = row & 15;
      const float2 c = cc[ho * 64 + pp], w = pw[pp * 33 + t + 1];
      const float v = (pc < 64) ? (c.x * w.x - c.y * w.y) : -(c.x * w.y + c.y * w.x);
      Gtab[(size_t)g * 65536 + e] = f2bf(v);
    }
    if (tid < 64) AL[g * 64 + tid] = pw[tid * 33 + 32];
    __syncthreads();
  }
}

DI void phase_s5_end(const Params& p, bf16_t* smem) {
  const bf16_t* Etab = (const bf16_t*)(p.ws + OFF_ETAB); const bf16_t* hb = (const bf16_t*)(p.ws + OFF_HB);
  const float2* AL = (const float2*)(p.ws + OFF_AL);
  bf16_t* sin_ = (bf16_t*)(p.ws + OFF_SIN);
  float* endbuf = (float*)smem;
  for (int item = BID(); item < 512; item += GDIM()) {
    const int g = item >> 3, b = item & 7;
    auto al = [=](int row, int ks, int kc) { return *(const uint4*)((const char*)Etab + (unsigned)((((g * 128 + row) * 512) + ks * 64 + kc) * 2)); };
    auto bl = [=](int n, int ks, int kc) {
      const int k = ks * 64 + kc, sidx = k >> 4, hi0 = k & 15;
      return *(const uint4*)((const char*)hb + (unsigned)(((b * 4096 + n * 32 + sidx) * 1024 + g * 16 + hi0) * 2));
    };
    gemm_tile(0, 0, 8, al, bl, [&](f32x4 (&acc)[4][4], int rb, int cb) {
      const int lane = TID() & 63, l15 = lane & 15, quad = lane >> 4;
#pragma unroll
      for (int mt = 0; mt < 4; ++mt)
#pragma unroll
        for (int nt = 0; nt < 4; ++nt)
#pragma unroll
          for (int r = 0; r < 4; ++r) endbuf[(rb + mt * 16 + quad * 4 + r) * 129 + cb + nt * 16 + l15] = acc[mt][nt][r];
    }, smem);
    __syncthreads();
    if (TID() < 64) {
      const int pp = TID();
      const float2 a = AL[g * 64 + pp];
      float sr = 0.f, si = 0.f;
      for (int n = 0; n < 128; ++n) {
        bf16_t* dst = sin_ + ((size_t)g * 1024 + b * 128 + n) * 128;
        dst[pp] = f2bf(sr); dst[64 + pp] = f2bf(si);
        const float er = endbuf[pp * 129 + n], ei = endbuf[(64 + pp) * 129 + n];
        const float nr = a.x * sr - a.y * si + er, ni = a.x * si + a.y * sr + ei;
        sr = nr; si = ni;
      }
    }
    __syncthreads();
  }
}

DI void phase_s5_y(const Params& p, int i, bf16_t* smem) {
  const bf16_t* Ktab = (const bf16_t*)(p.ws + OFF_KTAB); const bf16_t* Gtab = (const bf16_t*)(p.ws + OFF_GTAB);
  const bf16_t* hb = (const bf16_t*)(p.ws + OFF_HB); const bf16_t* sin_ = (const bf16_t*)(p.ws + OFF_SIN);
  bf16_t* hid = (bf16_t*)(p.ws + OFF_HID);
  for (int w = BID(); w < 2048; w += GDIM()) {
    const int g = w >> 5, mtile = (w >> 3) & 3, b = w & 7;
    const int nT = mtile * 2 + 2;
    auto al = [=](int row, int ks, int kc) -> uint4 {
      if (ks < nT) {
        const int k = ks * 64 + kc, sidx = k >> 4, hi0 = k & 15, t = row >> 4, ho = row & 15;
        if (t >= sidx) return *(const uint4*)((const char*)Ktab + (unsigned)(((((g * 32 + (t - sidx)) * 16 + ho) * 16) + hi0) * 2));
        return make_uint4(0, 0, 0, 0);
      }
      return *(const uint4*)((const char*)Gtab + (unsigned)((((g * 512 + row) * 128) + (ks - nT) * 64 + kc) * 2));
    };
    auto bl = [=](int n, int ks, int kc) -> uint4 {
      if (ks < nT) {
        const int k = ks * 64 + kc, sidx = k >> 4, hi0 = k & 15;
        return *(const uint4*)((const char*)hb + (unsigned)(((b * 4096 + n * 32 + sidx) * 1024 + g * 16 + hi0) * 2));
      }
      return *(const uint4*)((const char*)sin_ + (unsigned)((((g * 1024 + b * 128 + n) * 128) + (ks - nT) * 64 + kc) * 2));
    };
    gemm_tile(mtile * 128, 0, nT + 2, al, bl, [&](f32x4 (&acc)[4][4], int rb, int cb) {
      const int lane = TID() & 63, l15 = lane & 15, quad = lane >> 4;
      const float4 dsk = *(const float4*)(p.s5_d + i * 1024 + g * 16 + quad * 4);
#pragma unroll
      for (int mt = 0; mt < 4; ++mt)
#pragma unroll
        for (int nt = 0; nt < 4; ++nt) {
          const int t = (rb + mt * 16) >> 4, n = cb + nt * 16 + l15;
          const size_t tok = (size_t)b * 4096 + n * 32 + t;
          const float4 u = *(const float4*)(p.out + tok * 1024 + g * 16 + quad * 4);
          u32x2 v;
          v[0] = pack2(gelu_tanh(acc[mt][nt][0] + dsk.x * u.x), gelu_tanh(acc[mt][nt][1] + dsk.y * u.y));
          v[1] = pack2(gelu_tanh(acc[mt][nt][2] + dsk.z * u.z), gelu_tanh(acc[mt][nt][3] + dsk.w * u.w));
          *(u32x2*)(hid + tok * 1024 + g * 16 + quad * 4) = v;
        }
    }, smem);
  }
}

DI void phase_glu(const Params& p, int i, bf16_t* smem) {
  const bf16_t* W = (const bf16_t*)(p.ws + OFF_W) + W_ODD0 + (size_t)i * SZ_GLU;
  PlainLoad al{(const bf16_t*)(p.ws + OFF_HID), 1024}, bl{W, 1024};
  for_tiles(256, 16, [&](int mi, int ni) {
    gemm_tile(mi * 128, ni * 128, 16, al, bl, [&](f32x4 (&acc)[4][4], int rb, int cb) {
      const int lane = TID() & 63, l15 = lane & 15, quad = lane >> 4;
#pragma unroll
      for (int mt = 0; mt < 4; ++mt)
#pragma unroll
        for (int np = 0; np < 2; ++np)
#pragma unroll
          for (int r = 0; r < 4; ++r) {
            float val = acc[mt][2 * np][r] * sigmoidf_(acc[mt][2 * np + 1][r]);
            size_t idx = (size_t)(rb + mt * 16 + quad * 4 + r) * 1024 + (cb >> 1) + np * 16 + l15;
            p.out[idx] = ALPHA * p.out[idx] + val;
          }
    }, smem);
  });
}

DI void phase_xproj(const Params& p, int l, bf16_t* smem) {
  const bf16_t* wc = (const bf16_t*)(p.ws + OFF_W) + (size_t)l * SZ_COMMON;
  {
    PlainLoad al{(const bf16_t*)(p.ws + OFF_HB), 1024}, bl{wc, 1024};
    bf16_t* q = (bf16_t*)(p.ws + OFF_XQ);
    for_tiles(256, 8, [&](int mi, int ni) {
      gemm_tile(mi * 128, ni * 128, 16, al, bl, [&](f32x4 (&acc)[4][4], int rb, int cb) { epi_bf16(q, 1024, acc, rb, cb); }, smem);
    });
  }
  {
    const float* memf = p.mem;
    auto al = [=](int row, int ks, int kc) -> uint4 {
      const float4* src = (const float4*)((const char*)memf + (unsigned)((row * 1024 + ks * 64 + kc) * 4));
      float4 a = src[0], b2 = src[1];
      return make_uint4(pack2(a.x, a.y), pack2(a.z, a.w), pack2(b2.x, b2.y), pack2(b2.z, b2.w));
    };
    bf16_t* kx = (bf16_t*)(p.ws + OFF_KX); bf16_t* vx = (bf16_t*)(p.ws + OFF_VX);
    for_tiles(16, 16, [&](int mi, int ni) {
      const bool isv = ni >= 8;
      PlainLoad bl{isv ? (wc + 2 * SZ_SQ) : (wc + SZ_SQ), 1024};
      gemm_tile(mi * 128, (ni & 7) * 128, 16, al, bl, [&](f32x4 (&acc)[4][4], int rb, int cb) {
        if (!isv) { epi_bf16(kx, 1024, acc, rb, cb); return; }
        if (!USE_XATTN_MFMA) { epi_bf16(vx, 1024, acc, rb, cb); return; }
        const int lane = TID() & 63, l15 = lane & 15, quad = lane >> 4;
#pragma unroll
        for (int mt = 0; mt < 4; ++mt)
#pragma unroll
          for (int nt = 0; nt < 4; ++nt) {
            const int row = rb + mt * 16 + quad * 4, col = cb + nt * 16 + l15;
            const int b = row >> 8, key = row & 255, h = col >> 8, d = col & 255;
            u32x2 v; v[0] = pack2(acc[mt][nt][0], acc[mt][nt][1]); v[1] = pack2(acc[mt][nt][2], acc[mt][nt][3]);
            *(u32x2*)(vx + ((size_t)((b * 4 + h) * 256 + d)) * 256 + key) = v;
          }
      }, smem);
    });
  }
}


DI void phase_xattn(const Params& p) {
  const int wave = TID() >> 6, lane = TID() & 63, l15 = lane & 15, quad = lane >> 4;
  const bf16_t* q = (const bf16_t*)(p.ws + OFF_XQ); const bf16_t* kx = (const bf16_t*)(p.ws + OFF_KX); const bf16_t* vxT = (const bf16_t*)(p.ws + OFF_VX);
  bf16_t* xo = (bf16_t*)(p.ws + OFF_XO);
  for (int item = BID(); item < 2048; item += GDIM()) {
    const int b = item >> 8, h = (item >> 6) & 3, qb = item & 63;
    const size_t tq = (size_t)b * 4096 + qb * 64 + wave * 16 + l15;
    bf16x8 qf[8];
#pragma unroll
    for (int ks = 0; ks < 8; ++ks) qf[ks] = *(const bf16x8*)(q + tq * 1024 + h * 256 + ks * 32 + quad * 8);
    f32x4 s[16];
#pragma unroll
    for (int mt = 0; mt < 16; ++mt) {
      const bf16_t* kp = kx + (size_t)(b * 256 + mt * 16 + l15) * 1024 + h * 256 + quad * 8;
      f32x4 a = {0.f, 0.f, 0.f, 0.f};
#pragma unroll
      for (int ks = 0; ks < 8; ++ks) a = MFMA16(*(const bf16x8*)(kp + ks * 32), qf[ks], a);
      s[mt] = a;
      if (mt & 1) __builtin_amdgcn_sched_barrier(0);
    }
    float m = -1e30f;
#pragma unroll
    for (int mt = 0; mt < 16; ++mt)
#pragma unroll
      for (int r = 0; r < 4; ++r) m = fmaxf(m, s[mt][r]);
    m = fmaxf(m, __shfl_xor(m, 16)); m = fmaxf(m, __shfl_xor(m, 32));
    const float c1 = 0.0625f * 1.4426950408889634f;
    float l = 0.f;
#pragma unroll
    for (int mt = 0; mt < 16; ++mt)
#pragma unroll
      for (int r = 0; r < 4; ++r) { float pv = exp2f((s[mt][r] - m) * c1); s[mt][r] = pv; l += pv; }
    l += __shfl_xor(l, 16); l += __shfl_xor(l, 32);
    f32x4 o[16];
#pragma unroll
    for (int dt = 0; dt < 16; ++dt) o[dt] = f32x4{0.f, 0.f, 0.f, 0.f};
#pragma unroll
    for (int s2 = 0; s2 < 8; ++s2) {
      const bf16x8 pf = pack8(s[2 * s2], s[2 * s2 + 1]);
#pragma unroll
      for (int dt = 0; dt < 16; ++dt) {
        const bf16_t* vp = vxT + ((size_t)((b * 4 + h) * 256 + dt * 16 + l15)) * 256 + s2 * 32 + quad * 4;
        u32x2 lo = *(const u32x2*)vp, hi = *(const u32x2*)(vp + 16);
        u32x4 t; t[0] = lo[0]; t[1] = lo[1]; t[2] = hi[0]; t[3] = hi[1];
        o[dt] = MFMA16(__builtin_bit_cast(bf16x8, t), pf, o[dt]);
      }
      __builtin_amdgcn_sched_barrier(0);
    }
    const float il = 1.f / l;
#pragma unroll
    for (int dt = 0; dt < 16; ++dt) {
      u32x2 v; v[0] = pack2(o[dt][0] * il, o[dt][1] * il); v[1] = pack2(o[dt][2] * il, o[dt][3] * il);
      *(u32x2*)(xo + tq * 1024 + h * 256 + dt * 16 + quad * 4) = v;
    }
  }
}

template <int R, int NT>
DI void dil_branch(const bf16_t* swk, const bf16_t* swv, size_t rowbase, int h, int tok0, const bf16x8 (&qf)[2], float& m, float& l, f32x4 (&o)[4],
                   int l15, int quad) {
  constexpr int U = 16 / R, W = 128 * R;
  f32x4 s[NT];
#pragma unroll
  for (int kt = 0; kt < NT; ++kt) {
    int kap = tok0 - W + R * (kt * 16 + l15);
    kap = min(max(kap, 0), 4095);
    const bf16_t* kp = swk + (rowbase + kap) * 512 + h * 64 + quad * 8;
    f32x4 a = {0.f, 0.f, 0.f, 0.f};
    a = MFMA16(*(const bf16x8*)kp, qf[0], a);
    a = MFMA16(*(const bf16x8*)(kp + 32), qf[1], a);
    s[kt] = a;
    if ((kt & 3) == 3) __builtin_amdgcn_sched_barrier(0);
  }
  float mx = m;
  const float c1 = 0.125f * 1.4426950408889634f;
#pragma unroll
  for (int kt = 0; kt < NT; ++kt)
#pragma unroll
    for (int r2 = 0; r2 < 4; ++r2) {
      const int c = kt * 16 + quad * 4 + r2;
      const int dist = U * l15 + 128 - c;
      const int kap = tok0 - W + R * c;
      const bool ok = (dist >= 0) && (dist <= 128) && (kap >= 0);
      const float v = ok ? s[kt][r2] * c1 : -1e30f;
      s[kt][r2] = v; mx = fmaxf(mx, v);
    }
  mx = fmaxf(mx, __shfl_xor(mx, 16)); mx = fmaxf(mx, __shfl_xor(mx, 32));
  const float corr = exp2f(m - mx);
  m = mx; l *= corr;
#pragma unroll
  for (int dt = 0; dt < 4; ++dt) { o[dt][0] *= corr; o[dt][1] *= corr; o[dt][2] *= corr; o[dt][3] *= corr; }
#pragma unroll
  for (int kt = 0; kt < NT; ++kt)
#pragma unroll
    for (int r2 = 0; r2 < 4; ++r2) { float pv = exp2f(s[kt][r2] - mx); s[kt][r2] = pv; l += pv; }
  constexpr int NS = (NT + 1) / 2;
#pragma unroll
  for (int s2 = 0; s2 < NS; ++s2) {
    const f32x4 z4 = {0.f, 0.f, 0.f, 0.f};
    const bf16x8 pf = pack8(s[2 * s2], (2 * s2 + 1 < NT) ? s[(2 * s2 + 1 < NT) ? 2 * s2 + 1 : 0] : z4);
    const bf16_t* vp[8];
#pragma unroll
    for (int j = 0; j < 8; ++j) {
      const int c = (2 * s2 + (j >> 2)) * 16 + quad * 4 + (j & 3);
      int kap = tok0 - W + R * c;
      kap = min(max(kap, 0), 4095);
      vp[j] = swv + (rowbase + kap) * 512 + h * 64 + l15;
    }
#pragma unroll
    for (int dt = 0; dt < 4; ++dt) {
      bf16x8 vf;
#pragma unroll
      for (int j = 0; j < 8; ++j) vf[j] = (short)vp[j][dt * 16];
      o[dt] = MFMA16(vf, pf, o[dt]);
    }
    __builtin_amdgcn_sched_barrier(0);
  }
}

DI void phase_dil_attn(const Params& p, int first, int nblk) {
  const int wave = TID() >> 6, lane = TID() & 63, l15 = lane & 15, quad = lane >> 4;
  bf16_t* swq = (bf16_t*)(p.ws + OFF_SWQ); const bf16_t* swk = (const bf16_t*)(p.ws + OFF_SWK); const bf16_t* swv = (const bf16_t*)(p.ws + OFF_SWV);
  for (int item = first; item < 4096; item += nblk) {
    const int b = item >> 9, h = (item >> 6) & 7, G = (item >> 2) & 15, sub = item & 3;
    const int tok0 = G * 256 + sub * 4 + wave;
    const size_t rowbase = (size_t)b * 4096;
    const size_t tq = rowbase + tok0 + 16 * l15;
    bf16x8 qf[2];
    qf[0] = *(const bf16x8*)(swq + tq * 512 + h * 64 + quad * 8);
    qf[1] = *(const bf16x8*)(swq + tq * 512 + h * 64 + 32 + quad * 8);
    float m = -1e30f, l = 0.f;
    f32x4 o[4];
#pragma unroll
    for (int dt = 0; dt < 4; ++dt) o[dt] = f32x4{0.f, 0.f, 0.f, 0.f};
    dil_branch<16, 9>(swk, swv, rowbase, h, tok0, qf, m, l, o, l15, quad);
    dil_branch<4, 12>(swk, swv, rowbase, h, tok0, qf, m, l, o, l15, quad);
    dil_branch<1, 24>(swk, swv, rowbase, h, tok0, qf, m, l, o, l15, quad);
    l += __shfl_xor(l, 16); l += __shfl_xor(l, 32);
    const float il = 1.f / l;
#pragma unroll
    for (int dt = 0; dt < 4; ++dt) {
      u32x2 v; v[0] = pack2(o[dt][0] * il, o[dt][1] * il); v[1] = pack2(o[dt][2] * il, o[dt][3] * il);
      *(u32x2*)(swq + tq * 512 + h * 64 + dt * 16 + quad * 4) = v;
    }
  }
}

DI void phase_xo(const Params& p, int l, bf16_t* smem) {
  const bf16_t* wc = (const bf16_t*)(p.ws + OFF_W) + (size_t)l * SZ_COMMON + 3 * SZ_SQ;
  PlainLoad al{(const bf16_t*)(p.ws + OFF_XO), 1024}, bl{wc, 1024};
  for_tiles(256, 8, [&](int mi, int ni) {
    gemm_tile(mi * 128, ni * 128, 16, al, bl, [&](f32x4 (&acc)[4][4], int rb, int cb) { epi_resid(p, acc, rb, cb); }, smem);
  });
}

DI void phase_ffn_gu(const Params& p, int l, bf16_t* smem) {
  const bf16_t* W = (const bf16_t*)(p.ws + OFF_W) + (size_t)l * SZ_COMMON + 4 * SZ_SQ;
  PlainLoad al{(const bf16_t*)(p.ws + OFF_HB), 1024}, bl{W, 1024};
  bf16_t* act = (bf16_t*)(p.ws + OFF_ACT);
  for_tiles(256, 44, [&](int mi, int ni) {
    gemm_tile(mi * 128, ni * 128, 16, al, bl, [&](f32x4 (&acc)[4][4], int rb, int cb) {
      const int lane = TID() & 63, l15 = lane & 15, quad = lane >> 4;
#pragma unroll
      for (int mt = 0; mt < 4; ++mt)
#pragma unroll
        for (int np = 0; np < 2; ++np)
#pragma unroll
          for (int r = 0; r < 4; ++r) {
            float val = siluf_(acc[mt][2 * np][r]) * acc[mt][2 * np + 1][r];
            act[(size_t)(rb + mt * 16 + quad * 4 + r) * 2816 + (cb >> 1) + np * 16 + l15] = f2bf(val);
          }
    }, smem);
  });
}
DI void phase_ffn_down(const Params& p, int l, bf16_t* smem) {
  const bf16_t* W = (const bf16_t*)(p.ws + OFF_W) + (size_t)l * SZ_COMMON + 4 * SZ_SQ + SZ_GU;
  PlainLoad al{(const bf16_t*)(p.ws + OFF_ACT), 2816}, bl{W, 2816};
  for_tiles(256, 8, [&](int mi, int ni) {
    gemm_tile(mi * 128, ni * 128, 44, al, bl, [&](f32x4 (&acc)[4][4], int rb, int cb) { epi_resid(p, acc, rb, cb); }, smem);
  });
}


#define XB_TMO      128
#define XB_XCNT(j)  (256  + 64 * (j))
#define XB_XSUB(j)  (1280 + 64 * (j))
#define XB_XGEN(j)  (2304 + 64 * (j))
#define XB_TOP      3328
#define XB_TOPGEN   3392
#define XCD_BAR_WORDS 3456
#define XB_SPIN_CAP (1u << 22)
#define LAS __attribute__((address_space(3)))
DI unsigned xb_ld(unsigned* p) { return __hip_atomic_load(p, __ATOMIC_RELAXED, __HIP_MEMORY_SCOPE_AGENT); }
DI unsigned xb_add(unsigned* p, unsigned v) { return __hip_atomic_fetch_add(p, v, __ATOMIC_RELAXED, __HIP_MEMORY_SCOPE_AGENT); }
DI unsigned xb_xcc_id() { return (unsigned)__builtin_amdgcn_s_getreg((3 << 11) | 20) & 0xFu; }
#define XB_SPIN(cond, bar) do { unsigned _sp = 0; while (cond) { __builtin_amdgcn_s_sleep(1); \
    if ((++_sp & 255u) == 0u) { if (xb_ld(&(bar)[XB_TMO])) break; if (_sp > XB_SPIN_CAP) { atomicAdd(&(bar)[XB_TMO], 1u); break; } } } } while (0)
struct XcdBarrier { unsigned* bar; unsigned x; volatile LAS unsigned* st; };
DI XcdBarrier xcd_barrier_post(unsigned* bar, volatile LAS unsigned* st) {
  XcdBarrier b; b.bar = bar; b.x = xb_xcc_id(); b.st = st;
  if (threadIdx.x == 0) (void)xb_add(&bar[XB_XCNT(b.x)], 1u);
  return b;
}
DI void xcd_barrier_complete(unsigned* bar, unsigned x, unsigned& nloc, unsigned& nx) {
  const unsigned G = gridDim.x * gridDim.y * gridDim.z;
  unsigned sum, cnt, mine, sp = 0u;
  for (;;) {
    sum = 0u; cnt = 0u; mine = 0u;
#pragma unroll
    for (unsigned j = 0; j < 16; ++j) { const unsigned c = xb_ld(&bar[XB_XCNT(j)]); sum += c; cnt += (c > 0u) ? 1u : 0u; mine = (j == x) ? c : mine; }
    if (sum == G) break;
    __builtin_amdgcn_s_sleep(1);
    if ((++sp & 255u) == 0u) { if (xb_ld(&bar[XB_TMO])) break; if (sp > XB_SPIN_CAP) { atomicAdd(&bar[XB_TMO], 1u); break; } }
  }
  nloc = mine > 0u ? mine : 1u; nx = cnt > 0u ? cnt : 1u;
}
DI void xcd_barrier(const XcdBarrier& b) {
  asm volatile("s_waitcnt vmcnt(0)" ::: "memory");
  __syncthreads();
  if (threadIdx.x == 0) {
    unsigned* bar = b.bar;
    __builtin_amdgcn_s_waitcnt(0);
    unsigned nloc = b.st[0], nx = b.st[1];
    if (nloc == 0u) { xcd_barrier_complete(bar, b.x, nloc, nx); b.st[0] = nloc; b.st[1] = nx; }
    const unsigned old = xb_add(&bar[XB_XSUB(b.x)], 1u);
    const unsigned gen = old / nloc;
    if (old + 1u == (gen + 1u) * nloc) {
      __builtin_amdgcn_fence(__ATOMIC_RELEASE, "agent");
      asm volatile("s_waitcnt vmcnt(0)" ::: "memory");
      const unsigned og = xb_add(&bar[XB_TOP], 1u);
      const unsigned tg = og / nx;
      if (og + 1u == (tg + 1u) * nx) xb_add(&bar[XB_TOPGEN], 1u);
      else XB_SPIN(xb_ld(&bar[XB_TOPGEN]) == tg, bar);
      __builtin_amdgcn_fence(__ATOMIC_ACQUIRE, "agent");
      xb_add(&bar[XB_XGEN(b.x)], 1u);
      asm volatile("s_waitcnt vmcnt(0)" ::: "memory");
    } else {
      XB_SPIN(xb_ld(&bar[XB_XGEN(b.x)]) == gen, bar);
      __builtin_amdgcn_fence(__ATOMIC_ACQUIRE, "agent");
      asm volatile("s_waitcnt vmcnt(0)" ::: "memory");
    }
  }
  __syncthreads();
}

__global__ void __launch_bounds__(256, 2) fwd_megakernel(Params p) {
  cg::grid_group grid = cg::this_grid();
  __shared__ __attribute__((aligned(16))) char smem_raw[2 * 2 * 128 * LDT * 2];
  bf16_t* sm16 = (bf16_t*)smem_raw; float* sm32 = (float*)smem_raw;

  __shared__ uint4 xb_words;
  if (threadIdx.x == 0) xb_words = make_uint4(0u, 0u, 0u, 0u);
  __syncthreads();
  XcdBarrier xb = xcd_barrier_post((unsigned*)(p.ws + OFF_BAR), (volatile LAS unsigned*)&xb_words);
  phase_prologue(p, sm32);
  grid.sync();
  for (int l = 0; l < 4; ++l) {
    const int i = l >> 1;
    if ((l & 1) == 0) {
      phase_proj(p, i, sm16); xcd_barrier(xb);
      phase_dn_prep(p, i, smem_raw); xcd_barrier(xb);
      phase_mix(p, i, sm16); xcd_barrier(xb);
      phase_dn_post(p, i); xcd_barrier(xb);
      phase_wout(p, i, sm16); xcd_barrier(xb);
    } else {
#if USE_S5_GEMM
      phase_s5_tables(p, i, sm32); xcd_barrier(xb);
      phase_s5_end(p, sm16); xcd_barrier(xb);
      phase_s5_y(p, i, sm16); xcd_barrier(xb);
#else
      phase_s5_naive(p, i); xcd_barrier(xb);
#endif
      phase_glu(p, i, sm16); xcd_barrier(xb);
    }
    phase_ln(p, p.ln_mix_g + l * 1024, p.ln_mix_b + l * 1024); xcd_barrier(xb);
    phase_xproj(p, l, sm16); xcd_barrier(xb);
    phase_xattn(p); xcd_barrier(xb);
    phase_xo(p, l, sm16); xcd_barrier(xb);
    phase_ln(p, p.ln_x_g + l * 1024, p.ln_x_b + l * 1024); xcd_barrier(xb);
    phase_ffn_gu(p, l, sm16); xcd_barrier(xb);
    phase_ffn_down(p, l, sm16); xcd_barrier(xb);
    phase_ln(p, p.ln_ffn_g + l * 1024, p.ln_ffn_b + l * 1024); xcd_barrier(xb);
  }
}

extern "C" void kernel_launch(void* const* d_in, const int* in_sizes, int n_in, void* d_out, int out_size, void* d_ws, size_t ws_size,
                              hipStream_t stream) {
  static int grid_blocks = 0;
  if (!grid_blocks) {
    int dev = 0, cus = 0, per_cu = 0;
    hipGetDevice(&dev);
    hipDeviceGetAttribute(&cus, hipDeviceAttributeMultiprocessorCount, dev);
    hipOccupancyMaxActiveBlocksPerMultiprocessor(&per_cu, fwd_megakernel, 256, 0);
    if (per_cu > 2) per_cu = 2;
    if (per_cu < 1) per_cu = 1;
    grid_blocks = cus * per_cu;
    grid_blocks -= grid_blocks % 8;
  }
  Params p{};
  const float** pf = (const float**)&p;
  for (int i = 0; i < 32; ++i) pf[i] = (const float*)d_in[i];
  p.pos = (const int*)d_in[2];
  p.out = (float*)d_out; p.ws = (char*)d_ws;
  hipMemsetAsync((char*)d_ws + OFF_BAR, 0, XCD_BAR_WORDS * sizeof(unsigned), stream);
  void* args[] = {&p};
  hipError_t e = hipLaunchCooperativeKernel((void*)fwd_megakernel, dim3(grid_blocks), dim3(256), args, 0, stream);
  if (e != hipSuccess) fprintf(stderr, "cooperative launch failed: %s (grid %d)\n", hipGetErrorString(e), grid_blocks);
}
```

```cpp
#include <hip/hip_runtime.h>
#include <hip/hip_cooperative_groups.h>
#include <cstdio>
namespace cg = cooperative_groups;
#ifndef USE_XATTN_MFMA
#define USE_XATTN_MFMA 1
#endif
#ifndef USE_S5_GEMM
#define USE_S5_GEMM 1
#endif
#ifndef USE_DIL_MFMA
#define USE_DIL_MFMA 1
#endif

typedef unsigned short bf16_t;
using bf16x8 = __attribute__((ext_vector_type(8))) short;
using f32x4 = __attribute__((ext_vector_type(4))) float;
#define DI __device__ __forceinline__

constexpr int T_ = 32768, S_ = 4096;
constexpr size_t MiB = (size_t)1 << 20;
constexpr size_t SZ_SQ = (size_t)1024 * 1024, SZ_WIN = (size_t)3712 * 1024, SZ_GLU = (size_t)2048 * 1024,
                 SZ_GU = (size_t)5632 * 1024, SZ_WD = (size_t)1024 * 2816;
constexpr size_t SZ_COMMON = 4 * SZ_SQ + SZ_GU + SZ_WD;
constexpr size_t W_EVEN0 = 4 * SZ_COMMON;
constexpr size_t W_ODD0 = W_EVEN0 + 2 * (SZ_WIN + SZ_SQ);
constexpr float ALPHA = 1.681792830507429f;

constexpr size_t OFF_W = 0;
constexpr size_t OFF_ROPE = 125 * MiB;
constexpr size_t OFF_HB = 133 * MiB;
constexpr size_t OFF_KX = 197 * MiB;
constexpr size_t OFF_VX = 201 * MiB;
constexpr size_t OFF_BIG = 205 * MiB;
constexpr size_t OFF_BAR = 511 * MiB;
constexpr size_t OFF_DNQKV = OFF_BIG;
constexpr size_t OFF_Z = OFF_BIG + 96 * MiB;
constexpr size_t OFF_SWQ = OFF_BIG + 128 * MiB;
constexpr size_t OFF_SWK = OFF_BIG + 160 * MiB;
constexpr size_t OFF_SWV = OFF_BIG + 192 * MiB;
constexpr size_t OFF_LOGIT = OFF_BIG + 224 * MiB;
constexpr size_t OFF_QD = OFF_BIG + 225 * MiB;
constexpr size_t OFF_KD = OFF_BIG + 257 * MiB;
constexpr size_t OFF_INTRA = OFF_BIG + 289 * MiB;
constexpr size_t OFF_WB = OFF_HB;
constexpr size_t OFF_UB = OFF_HB + 32 * MiB;
constexpr size_t OFF_EG = OFF_KX;
constexpr size_t OFF_XQ = OFF_BIG;
constexpr size_t OFF_XO = OFF_BIG + 64 * MiB;
constexpr size_t OFF_ACT = OFF_BIG;
constexpr size_t OFF_HID = OFF_BIG;
constexpr size_t OFF_SIN = OFF_BIG + 64 * MiB;
constexpr size_t OFF_KTAB = OFF_BIG + 80 * MiB;
constexpr size_t OFF_ETAB = OFF_BIG + 82 * MiB;
constexpr size_t OFF_GTAB = OFF_BIG + 90 * MiB;
constexpr size_t OFF_AL = OFF_BIG + 98 * MiB;

struct Params {
  const float* x; const float* mem; const int* pos;
  const float* hyb_w_in; const float* dn_conv_w; const float* dn_a_log; const float* dn_dt_bias; const float* dn_norm_g; const float* hyb_w_out;
  const float* s5_a_re; const float* s5_a_im; const float* s5_log_dt; const float* s5_b_re; const float* s5_b_im; const float* s5_c_re; const float* s5_c_im;
  const float* s5_d; const float* s5_glu_wo; const float* s5_glu_wg;
  const float* ln_mix_g; const float* ln_mix_b;
  const float* xq_w; const float* xk_w; const float* xv_w; const float* xo_w; const float* ln_x_g; const float* ln_x_b;
  const float* ffn_wg; const float* ffn_wu; const float* ffn_wd; const float* ln_ffn_g; const float* ln_ffn_b;
  float* out; char* ws;
};

DI int TID() { int t = threadIdx.x; asm volatile("" : "+v"(t)); return t; }
DI int BID() { int t = blockIdx.x; asm volatile("" : "+s"(t)); return t; }
DI int GDIM() { int t = gridDim.x; asm volatile("" : "+s"(t)); return t; }
DI bf16_t f2bf(float x) { unsigned u = __float_as_uint(x); u += 0x7fffu + ((u >> 16) & 1u); return (bf16_t)(u >> 16); }
DI float bf2f(bf16_t v) { return __uint_as_float(((unsigned)v) << 16); }
DI unsigned pack2(float a, float b) { return (unsigned)f2bf(a) | ((unsigned)f2bf(b) << 16); }
using u32x4 = __attribute__((ext_vector_type(4))) unsigned;
using u32x2 = __attribute__((ext_vector_type(2))) unsigned;
DI bf16x8 pack8(f32x4 a, f32x4 b) {
  u32x4 t; t[0] = pack2(a[0], a[1]); t[1] = pack2(a[2], a[3]); t[2] = pack2(b[0], b[1]); t[3] = pack2(b[2], b[3]);
  return __builtin_bit_cast(bf16x8, t);
}
#define MFMA16(a, b, c) __builtin_amdgcn_mfma_f32_16x16x32_bf16((a), (b), (c), 0, 0, 0)
DI int kperm(int x) { return (x & ~31) | (((x >> 2) & 3) * 8 + ((x >> 4) & 1) * 4 + (x & 3)); }
DI float wave_sum(float v) { for (int o = 32; o > 0; o >>= 1) v += __shfl_xor(v, o); return v; }
DI float wave_max(float v) { for (int o = 32; o > 0; o >>= 1) v = fmaxf(v, __shfl_xor(v, o)); return v; }
DI float sigmoidf_(float x) { return 1.f / (1.f + __expf(-x)); }
DI float siluf_(float x) { return x * sigmoidf_(x); }
DI float softplusf_(float x) { return fmaxf(x, 0.f) + log1pf(__expf(-fabsf(x))); }
DI float gelu_tanh(float x) { float u = 0.7978845608028654f * (x + 0.044715f * x * x * x); return 0.5f * x * (1.f + tanhf(u)); }

template <class CM>
DI void transpose_job(bf16_t* dst, int Ndst, int K, int srcStride, CM colptr, float* tile) {
  const int ntk = K / 64, ntiles = (Ndst / 64) * ntk;
  for (int tl = BID(); tl < ntiles; tl += GDIM()) {
    const int r0 = (tl / ntk) * 64, k0 = (tl % ntk) * 64;
    const int rl = TID() & 63, ks = TID() >> 6;
    const float* cp = colptr(r0 + rl);
    for (int i = 0; i < 16; ++i) { int kl = ks * 16 + i; tile[kl * 65 + rl] = cp ? cp[(size_t)(k0 + kl) * srcStride] : 0.f; }
    __syncthreads();
    const int kk = TID() & 63, rs = TID() >> 6;
    for (int i = 0; i < 16; ++i) { int rr = i * 4 + rs; dst[(size_t)(r0 + rr) * K + k0 + kk] = f2bf(tile[kk * 65 + rr]); }
    __syncthreads();
  }
}

DI void phase_prologue(const Params& p, float* smem) {
  bf16_t* W = (bf16_t*)(p.ws + OFF_W);
  for (int l = 0; l < 4; ++l) {
    bf16_t* wc = W + (size_t)l * SZ_COMMON;
    const float* s;
    s = p.xq_w + (size_t)l * SZ_SQ; transpose_job(wc, 1024, 1024, 1024, [=](int r) { return s + r; }, smem);
    s = p.xk_w + (size_t)l * SZ_SQ; transpose_job(wc + SZ_SQ, 1024, 1024, 1024, [=](int r) { return s + r; }, smem);
    s = p.xv_w + (size_t)l * SZ_SQ; transpose_job(wc + 2 * SZ_SQ, 1024, 1024, 1024, [=](int r) { return s + r; }, smem);
    s = p.xo_w + (size_t)l * SZ_SQ; transpose_job(wc + 3 * SZ_SQ, 1024, 1024, 1024, [=](int r) { return s + r; }, smem);
    {
      const float* g = p.ffn_wg + (size_t)l * 1024 * 2816; const float* u = p.ffn_wu + (size_t)l * 1024 * 2816;
      transpose_job(wc + 4 * SZ_SQ, 5632, 1024, 2816, [=](int r) { int c = (r >> 5) * 16 + (r & 15); return ((r >> 4) & 1) ? (u + c) : (g + c); }, smem);
    }
    s = p.ffn_wd + (size_t)l * 2816 * 1024; transpose_job(wc + 4 * SZ_SQ + SZ_GU, 1024, 2816, 1024, [=](int r) { return s + r; }, smem);
  }
  for (int i = 0; i < 2; ++i) {
    bf16_t* we = W + W_EVEN0 + (size_t)i * (SZ_WIN + SZ_SQ);
    const float* s = p.hyb_w_in + (size_t)i * 1024 * 3592;
    transpose_job(we, 3712, 1024, 3592, [=](int r) -> const float* {
      if (r < 2048) return s + r;
      if (r < 3584) return s + r + 8;
      if (r < 3592) return s + 2048 + (r - 3584);
      return nullptr; }, smem);
    const float* s2 = p.hyb_w_out + (size_t)i * SZ_SQ;
    transpose_job(we + SZ_WIN, 1024, 1024, 1024, [=](int r) { return s2 + r; }, smem);
    bf16_t* wo = W + W_ODD0 + (size_t)i * SZ_GLU;
    const float* a = p.s5_glu_wo + (size_t)i * SZ_SQ; const float* b = p.s5_glu_wg + (size_t)i * SZ_SQ;
    transpose_job(wo, 2048, 1024, 1024, [=](int r) { int c = (r >> 5) * 16 + (r & 15); return ((r >> 4) & 1) ? (b + c) : (a + c); }, smem);
  }
  const size_t gtid = (size_t)BID() * 256 + TID(), gsz = (size_t)GDIM() * 256;
  bf16_t* hb = (bf16_t*)(p.ws + OFF_HB);
  for (size_t i = gtid; i < (size_t)T_ * 256; i += gsz) {
    float4 v = ((const float4*)p.x)[i];
    ((float4*)p.out)[i] = v;
    uint2 o; o.x = pack2(v.x, v.y); o.y = pack2(v.z, v.w);
    ((uint2*)hb)[i] = o;
  }
  float* rc = (float*)(p.ws + OFF_ROPE); float* rs = rc + (size_t)T_ * 32;
  for (size_t i = gtid; i < (size_t)T_ * 32; i += gsz) {
    int t = (int)(i >> 5), j = (int)(i & 31);
    float invf = (float)exp(-(double)(2 * j) / 64.0 * 9.210340371976184);
    float ang = (float)p.pos[t] * invf;
    double a = (double)ang;
    double k = rint(a * 0.15915494309189535);
    float r = (float)(a - k * 6.283185307179586);
    rc[i] = cosf(r); rs[i] = sinf(r);
  }
}

constexpr int LDT = 72;
template <class AL, class BL, class EP>
DI void gemm_tile(int m0, int n0, int nks, AL aload, BL bload, EP epi, bf16_t* smem) {
  bf16_t* As = smem; bf16_t* Bs = smem + 2 * 128 * LDT;
  const int tid = TID(), lane = tid & 63, wave = tid >> 6;
  const int wm = wave >> 1, wn = wave & 1, l15 = lane & 15, quad = lane >> 4;
  const int lrow = tid >> 3, lkc = (tid & 7) * 8;
  f32x4 acc[4][4];
#pragma unroll
  for (int i = 0; i < 4; ++i)
#pragma unroll
    for (int j = 0; j < 4; ++j) acc[i][j] = f32x4{0.f, 0.f, 0.f, 0.f};
  uint4 ra0[4], rb0[4], ra1[4], rb1[4];
#pragma unroll
  for (int i = 0; i < 4; ++i) { ra0[i] = aload(m0 + lrow + 32 * i, 0, lkc); rb0[i] = bload(n0 + lrow + 32 * i, 0, lkc); }
#pragma unroll
  for (int i = 0; i < 4; ++i) { ra1[i] = aload(m0 + lrow + 32 * i, 1, lkc); rb1[i] = bload(n0 + lrow + 32 * i, 1, lkc); }
#pragma unroll
  for (int i = 0; i < 4; ++i) {
    *(uint4*)(As + (lrow + 32 * i) * LDT + lkc) = ra0[i];
    *(uint4*)(Bs + (lrow + 32 * i) * LDT + lkc) = rb0[i];
  }
  __syncthreads();
  auto compute = [&](int cur) {
    const bf16_t* Ab = As + cur * 128 * LDT; const bf16_t* Bb = Bs + cur * 128 * LDT;
#pragma unroll
    for (int kk = 0; kk < 2; ++kk) {
      bf16x8 a[4], b[4];
#pragma unroll
      for (int mt = 0; mt < 4; ++mt) a[mt] = *(const bf16x8*)(Ab + (wm * 64 + mt * 16 + l15) * LDT + kk * 32 + quad * 8);
#pragma unroll
      for (int nt = 0; nt < 4; ++nt) b[nt] = *(const bf16x8*)(Bb + (wn * 64 + nt * 16 + l15) * LDT + kk * 32 + quad * 8);
#pragma unroll
      for (int mt = 0; mt < 4; ++mt)
#pragma unroll
        for (int nt = 0; nt < 4; ++nt) acc[mt][nt] = __builtin_amdgcn_mfma_f32_16x16x32_bf16(b[nt], a[mt], acc[mt][nt], 0, 0, 0);
    }
  };
  for (int ks = 0; ks < nks; ks += 2) {
    if (ks + 2 < nks) {
#pragma unroll
      for (int i = 0; i < 4; ++i) { ra0[i] = aload(m0 + lrow + 32 * i, ks + 2, lkc); rb0[i] = bload(n0 + lrow + 32 * i, ks + 2, lkc); }
    }
    compute(0);
#pragma unroll
    for (int i = 0; i < 4; ++i) {
      *(uint4*)(As + 128 * LDT + (lrow + 32 * i) * LDT + lkc) = ra1[i];
      *(uint4*)(Bs + 128 * LDT + (lrow + 32 * i) * LDT + lkc) = rb1[i];
    }
    __syncthreads();
    if (ks + 3 < nks) {
#pragma unroll
      for (int i = 0; i < 4; ++i) { ra1[i] = aload(m0 + lrow + 32 * i, ks + 3, lkc); rb1[i] = bload(n0 + lrow + 32 * i, ks + 3, lkc); }
    }
    compute(1);
    if (ks + 2 < nks) {
#pragma unroll
      for (int i = 0; i < 4; ++i) {
        *(uint4*)(As + (lrow + 32 * i) * LDT + lkc) = ra0[i];
        *(uint4*)(Bs + (lrow + 32 * i) * LDT + lkc) = rb0[i];
      }
    }
    __syncthreads();
  }
  epi(acc, m0 + wm * 64, n0 + wn * 64);
}

template <class F>
DI void for_tiles(int mtiles, int ntiles, F f) {
  const int xcd = BID() & 7, slot = BID() >> 3, nslot = GDIM() >> 3;
  const int per = (mtiles >> 3) * ntiles;
  for (int w = slot; w < per; w += nslot) {
    int mi = w / ntiles, ni = w - mi * ntiles;
    f((mi * 8 + xcd), ni);
  }
}

#define EPI_LOOP for (int mt = 0; mt < 4; ++mt) for (int nt = 0; nt < 4; ++nt) for (int r = 0; r < 4; ++r)

DI void epi_resid(const Params& p, f32x4 (&acc)[4][4], int rb, int cb) {
  const int lane = TID() & 63, l15 = lane & 15, quad = lane >> 4;
#pragma unroll
  for (int mt = 0; mt < 4; ++mt)
#pragma unroll
    for (int nt = 0; nt < 4; ++nt) {
      float4* ptr = (float4*)(p.out + (size_t)(rb + mt * 16 + l15) * 1024 + cb + nt * 16 + quad * 4);
      float4 h = *ptr;
      h.x = ALPHA * h.x + acc[mt][nt][0]; h.y = ALPHA * h.y + acc[mt][nt][1]; h.z = ALPHA * h.z + acc[mt][nt][2]; h.w = ALPHA * h.w + acc[mt][nt][3];
      *ptr = h;
    }
}
DI void epi_bf16(bf16_t* dst, int ld, f32x4 (&acc)[4][4], int rb, int cb) {
  const int lane = TID() & 63, l15 = lane & 15, quad = lane >> 4;
#pragma unroll
  for (int mt = 0; mt < 4; ++mt)
#pragma unroll
    for (int nt = 0; nt < 4; ++nt) {
      u32x2 v; v[0] = pack2(acc[mt][nt][0], acc[mt][nt][1]); v[1] = pack2(acc[mt][nt][2], acc[mt][nt][3]);
      *(u32x2*)(dst + (size_t)(rb + mt * 16 + l15) * ld + cb + nt * 16 + quad * 4) = v;
    }
}

struct PlainLoad {
  const bf16_t* base; int ld;
  DI uint4 operator()(int row, int ks, int kc) const { return *(const uint4*)((const char*)base + (unsigned)((row * ld + ks * 64 + kc) * 2)); }
};

DI void phase_proj(const Params& p, int i, bf16_t* smem) {
  const bf16_t* W = (const bf16_t*)(p.ws + OFF_W) + W_EVEN0 + (size_t)i * (SZ_WIN + SZ_SQ);
  PlainLoad al{(const bf16_t*)(p.ws + OFF_HB), 1024}, bl{W, 1024};
  bf16_t* dnqkv = (bf16_t*)(p.ws + OFF_DNQKV); bf16_t* z = (bf16_t*)(p.ws + OFF_Z);
  bf16_t* swq = (bf16_t*)(p.ws + OFF_SWQ); bf16_t* swk = (bf16_t*)(p.ws + OFF_SWK); bf16_t* swv = (bf16_t*)(p.ws + OFF_SWV);
  float* logit = (float*)(p.ws + OFF_LOGIT);
  const float* rc = (const float*)(p.ws + OFF_ROPE); const float* rs = rc + (size_t)T_ * 32;
  for_tiles(256, 29, [&](int mi, int ni) {
    gemm_tile(mi * 128, ni * 128, 16, al, bl, [&](f32x4 (&acc)[4][4], int rb, int cb) {
      const int lane = TID() & 63, l15 = lane & 15, quad = lane >> 4;
      if (cb < 1536) epi_bf16(dnqkv, 1536, acc, rb, cb);
      else if (cb < 2048) epi_bf16(z, 512, acc, rb, cb - 1536);
      else if (cb < 3072) {
        bf16_t* dst = (cb < 2560) ? swq : swk; const int c0 = (cb < 2560) ? cb - 2048 : cb - 2560;
#pragma unroll
        for (int mt = 0; mt < 4; ++mt) {
          const int row = rb + mt * 16 + l15;
#pragma unroll
          for (int nt = 0; nt < 2; ++nt) {
            const int d = nt * 16 + quad * 4;
            const float4 c = *(const float4*)(rc + (size_t)row * 32 + d), sn = *(const float4*)(rs + (size_t)row * 32 + d);
            const f32x4 x1 = acc[mt][nt], x2 = acc[mt][nt + 2];
            u32x2 o1, o2;
            o1[0] = pack2(x1[0] * c.x - x2[0] * sn.x, x1[1] * c.y - x2[1] * sn.y); o1[1] = pack2(x1[2] * c.z - x2[2] * sn.z, x1[3] * c.w - x2[3] * sn.w);
            o2[0] = pack2(x2[0] * c.x + x1[0] * sn.x, x2[1] * c.y + x1[1] * sn.y); o2[1] = pack2(x2[2] * c.z + x1[2] * sn.z, x2[3] * c.w + x1[3] * sn.w);
            *(u32x2*)(dst + (size_t)row * 512 + c0 + d) = o1;
            *(u32x2*)(dst + (size_t)row * 512 + c0 + d + 32) = o2;
          }
        }
      } else if (cb < 3584) epi_bf16(swv, 512, acc, rb, cb - 3072);
      else if (cb == 3584) {
        if (quad < 2) {
#pragma unroll
          for (int mt = 0; mt < 4; ++mt)
            *(float4*)(logit + (size_t)(rb + mt * 16 + l15) * 8 + quad * 4) = make_float4(acc[mt][0][0], acc[mt][0][1], acc[mt][0][2], acc[mt][0][3]);
        }
      }
    }, smem);
  });
}

DI void phase_dil_attn(const Params& p, int first, int nblk);

DI void phase_dn_prep(const Params& p, int i, char* smem) {
  bf16_t* qs = (bf16_t*)smem; bf16_t* ks = qs + 64 * 136; bf16_t* vs = ks + 64 * 136;
  float* Lm = (float*)(smem + 3 * 17408); float* beta = Lm + 64 * 68; float* gcum = beta + 64; float* egc = gcum + 64;
  const bf16_t* dnqkv = (const bf16_t*)(p.ws + OFF_DNQKV);
  const float* logit = (const float*)(p.ws + OFF_LOGIT);
  bf16_t* qd_g = (bf16_t*)(p.ws + OFF_QD); bf16_t* kd_g = (bf16_t*)(p.ws + OFF_KD); bf16_t* in_g = (bf16_t*)(p.ws + OFF_INTRA);
  bf16_t* w_g = (bf16_t*)(p.ws + OFF_WB); bf16_t* u_g = (bf16_t*)(p.ws + OFF_UB); float* eg_g = (float*)(p.ws + OFF_EG);
  const float* cw = p.dn_conv_w + (size_t)i * 4 * 1536;
  const int tid = TID(), wave = tid >> 6, lane = tid & 63, l15 = lane & 15, quad = lane >> 4;
  const float QS = 0.08838834764831845f;
  for (int item = BID(); item < 2048; item += GDIM()) {
    const int b = item >> 8, h = (item >> 6) & 3, n = item & 63;
    const int t0 = b * 4096 + n * 64, s0 = n * 64;
    const float A = __expf(p.dn_a_log[i * 4 + h]), dtb = p.dn_dt_bias[i * 4 + h];
    for (int tt = 0; tt < 16; ++tt) {
      const int il = tt * 4 + wave, t = t0 + il, sq = s0 + il;
#pragma unroll
      for (int which = 0; which < 3; ++which) {
        const int col = which * 512 + h * 128 + lane * 2;
        float y0 = 0.f, y1 = 0.f;
#pragma unroll
        for (int j = 0; j < 4; ++j) {
          if (sq - 3 + j >= 0) {
            unsigned v = *(const unsigned*)(dnqkv + (size_t)(t - 3 + j) * 1536 + col);
            y0 += cw[j * 1536 + col] * bf2f((bf16_t)(v & 0xffff));
            y1 += cw[j * 1536 + col + 1] * bf2f((bf16_t)(v >> 16));
          }
        }
        y0 = siluf_(y0); y1 = siluf_(y1);
        if (which < 2) {
          float ss = wave_sum(y0 * y0 + y1 * y1);
          float sc = rsqrtf(ss + 1e-6f);
          y0 *= sc; y1 *= sc;
        }
        bf16_t* dst = (which == 0) ? qs : (which == 1 ? ks : vs);
        *(unsigned*)(dst + il * 136 + lane * 2) = pack2(y0, y1);
      }
    }
    if (wave == 0) {
      const size_t row = (size_t)(t0 + lane);
      const float bl = logit[row * 8 + h], al = logit[row * 8 + 4 + h];
      float g = -A * softplusf_(al + dtb);
#pragma unroll
      for (int o = 1; o < 64; o <<= 1) { float v = __shfl_up(g, o); if (lane >= o) g += v; }
      beta[lane] = sigmoidf_(bl); gcum[lane] = g; egc[lane] = __expf(g);
    }
    __syncthreads();
    {
      f32x4 kk[4], qk[4];
#pragma unroll
      for (int nt = 0; nt < 4; ++nt) { kk[nt] = f32x4{0.f, 0.f, 0.f, 0.f}; qk[nt] = f32x4{0.f, 0.f, 0.f, 0.f}; }
#pragma unroll
      for (int k4 = 0; k4 < 4; ++k4) {
        const bf16x8 ak = *(const bf16x8*)(ks + (wave * 16 + l15) * 136 + k4 * 32 + quad * 8);
        const bf16x8 aq = *(const bf16x8*)(qs + (wave * 16 + l15) * 136 + k4 * 32 + quad * 8);
#pragma unroll
        for (int nt = 0; nt < 4; ++nt) {
          const bf16x8 bk = *(const bf16x8*)(ks + (nt * 16 + l15) * 136 + k4 * 32 + quad * 8);
          kk[nt] = MFMA16(ak, bk, kk[nt]); qk[nt] = MFMA16(aq, bk, qk[nt]);
        }
      }
#pragma unroll
      for (int nt = 0; nt < 4; ++nt)
#pragma unroll
        for (int r = 0; r < 4; ++r) {
          const int ii = wave * 16 + quad * 4 + r, jj = nt * 16 + l15;
          const float dec = (jj <= ii) ? __expf(gcum[ii] - gcum[jj]) : 0.f;
          Lm[ii * 68 + jj] = (jj < ii) ? beta[ii] * kk[nt][r] * dec : 0.f;
          in_g[(size_t)item * 4096 + ii * 64 + kperm(jj)] = f2bf(qk[nt][r] * QS * dec);
        }
    }
    __syncthreads();
    {
      float x[64];
#pragma unroll
      for (int ii = 0; ii < 64; ++ii) x[ii] = 0.f;
      const int c = tid & 127;
      const bool isw = tid >= 128;
      bf16_t* dstb = (isw ? w_g : u_g) + (size_t)item * 8192 + (isw ? kperm(c) : c);
      const bf16_t* srcb = (isw ? ks : vs) + c;
#pragma unroll
      for (int ii = 0; ii < 64; ++ii) {
        float acc = bf2f(srcb[ii * 136]) * beta[ii] * (isw ? egc[ii] : 1.f);
#pragma unroll
        for (int j4 = 0; j4 < (ii + 3) / 4; ++j4) {
          const float4 l4 = *(const float4*)(Lm + ii * 68 + j4 * 4);
          acc -= l4.x * x[j4 * 4]; acc -= l4.y * x[j4 * 4 + 1]; acc -= l4.z * x[j4 * 4 + 2]; acc -= l4.w * x[j4 * 4 + 3];
        }
        x[ii] = acc;
        dstb[ii * 128] = f2bf(acc);
        if ((ii & 3) == 3) __builtin_amdgcn_sched_barrier(0);
      }
    }
    {
      const float gl = gcum[63];
#pragma unroll 4
      for (int k = 0; k < 32; ++k) {
        const int e = tid + 256 * k;
        const int ii = e >> 7, d = e & 127;
        qd_g[(size_t)item * 8192 + ii * 128 + kperm(d)] = f2bf(bf2f(qs[ii * 136 + d]) * QS * egc[ii]);
        const int d2 = e >> 6, i2 = e & 63;
        kd_g[(size_t)item * 8192 + d2 * 64 + kperm(i2)] = f2bf(bf2f(ks[i2 * 136 + d2]) * __expf(gl - gcum[i2]));
      }
      if (tid == 0) eg_g[item] = __expf(gl);
    }
    __syncthreads();
  }
}

DI bf16x8 ld2(const bf16_t* ptr) {
  u32x2 lo = *(const u32x2*)ptr, hi = *(const u32x2*)(ptr + 16);
  u32x4 t; t[0] = lo[0]; t[1] = lo[1]; t[2] = hi[0]; t[3] = hi[1];
  return __builtin_bit_cast(bf16x8, t);
}

DI void dn_chain_item(const Params& p, int item, bf16_t* smem) {
  const int tid = TID(), wave = tid >> 6, lane = tid & 63, l15 = lane & 15, quad = lane >> 4;
  const int bh = item >> 1, half = item & 1;
  const int e0 = half * 64 + wave * 16 + l15;
  const bf16_t* qd_g = (const bf16_t*)(p.ws + OFF_QD); const bf16_t* kd_g = (const bf16_t*)(p.ws + OFF_KD); const bf16_t* in_g = (const bf16_t*)(p.ws + OFF_INTRA);
  const bf16_t* w_g = (const bf16_t*)(p.ws + OFF_WB); bf16_t* u_g = (bf16_t*)(p.ws + OFF_UB); const float* eg_g = (const float*)(p.ws + OFF_EG);
  bf16_t* wl = smem; bf16_t* ql = wl + 64 * 136; bf16_t* kl = ql + 64 * 136; bf16_t* il = kl + 128 * 72; bf16_t* ul = il + 64 * 72;
  uint4 rw0, rw1, rw2, rw3, rq0, rq1, rq2, rq3, rk0, rk1, rk2, rk3, ri0, ri1, ru0, ru1;
#define CH_GLOAD(n_) do { const size_t ci_ = (size_t)bh * 64 + (n_); \
    const bf16_t* w_ = w_g + ci_ * 8192 + tid * 8; const bf16_t* q_ = qd_g + ci_ * 8192 + tid * 8; const bf16_t* k_ = kd_g + ci_ * 8192 + tid * 8; \
    rw0 = *(const uint4*)(w_); rw1 = *(const uint4*)(w_ + 2048); rw2 = *(const uint4*)(w_ + 4096); rw3 = *(const uint4*)(w_ + 6144); \
    rq0 = *(const uint4*)(q_); rq1 = *(const uint4*)(q_ + 2048); rq2 = *(const uint4*)(q_ + 4096); rq3 = *(const uint4*)(q_ + 6144); \
    rk0 = *(const uint4*)(k_); rk1 = *(const uint4*)(k_ + 2048); rk2 = *(const uint4*)(k_ + 4096); rk3 = *(const uint4*)(k_ + 6144); \
    ri0 = *(const uint4*)(in_g + ci_ * 4096 + tid * 8); ri1 = *(const uint4*)(in_g + ci_ * 4096 + 2048 + tid * 8); \
    ru0 = *(const uint4*)(u_g + ci_ * 8192 + (tid >> 3) * 128 + half * 64 + (tid & 7) * 8); \
    ru1 = *(const uint4*)(u_g + ci_ * 8192 + (32 + (tid >> 3)) * 128 + half * 64 + (tid & 7) * 8); } while (0)
#define CH_LSTORE() do { \
    bf16_t* w_ = wl + (tid >> 4) * 136 + (tid & 15) * 8; bf16_t* q_ = ql + (tid >> 4) * 136 + (tid & 15) * 8; bf16_t* k_ = kl + (tid >> 3) * 72 + (tid & 7) * 8; \
    *(uint4*)(w_) = rw0; *(uint4*)(w_ + 16 * 136) = rw1; *(uint4*)(w_ + 32 * 136) = rw2; *(uint4*)(w_ + 48 * 136) = rw3; \
    *(uint4*)(q_) = rq0; *(uint4*)(q_ + 16 * 136) = rq1; *(uint4*)(q_ + 32 * 136) = rq2; *(uint4*)(q_ + 48 * 136) = rq3; \
    *(uint4*)(k_) = rk0; *(uint4*)(k_ + 32 * 72) = rk1; *(uint4*)(k_ + 64 * 72) = rk2; *(uint4*)(k_ + 96 * 72) = rk3; \
    *(uint4*)(il + (tid >> 3) * 72 + (tid & 7) * 8) = ri0; *(uint4*)(il + (32 + (tid >> 3)) * 72 + (tid & 7) * 8) = ri1; \
    *(uint4*)(ul + (tid >> 3) * 72 + (tid & 7) * 8) = ru0; *(uint4*)(ul + (32 + (tid >> 3)) * 72 + (tid & 7) * 8) = ru1; } while (0)
  f32x4 S[8];
#pragma unroll
  for (int mt = 0; mt < 8; ++mt) S[mt] = f32x4{0.f, 0.f, 0.f, 0.f};
  CH_GLOAD(0);
  CH_LSTORE();
  __syncthreads();
#pragma unroll 1
  for (int n = 0; n < 64; ++n) {
    const size_t ci = (size_t)bh * 64 + n;
    if (n + 1 < 64) CH_GLOAD(n + 1);
    bf16_t* ub = u_g + ci * 8192;
    const float eg = eg_g[ci];
    bf16x8 sb[4];
#pragma unroll
    for (int s = 0; s < 4; ++s) sb[s] = pack8(S[2 * s], S[2 * s + 1]);
    f32x4 vn[4];
#pragma unroll
    for (int it = 0; it < 4; ++it) {
      f32x4 a = {0.f, 0.f, 0.f, 0.f};
#pragma unroll
      for (int s = 0; s < 4; ++s) a = MFMA16(*(const bf16x8*)(wl + (it * 16 + l15) * 136 + s * 32 + quad * 8), sb[s], a);
#pragma unroll
      for (int r = 0; r < 4; ++r) vn[it][r] = bf2f(ul[(it * 16 + quad * 4 + r) * 72 + wave * 16 + l15]) - a[r];
    }
    bf16x8 vb[2];
    vb[0] = pack8(vn[0], vn[1]); vb[1] = pack8(vn[2], vn[3]);
#pragma unroll
    for (int it = 0; it < 4; ++it) {
      f32x4 a = {0.f, 0.f, 0.f, 0.f};
#pragma unroll
      for (int s = 0; s < 4; ++s) a = MFMA16(*(const bf16x8*)(ql + (it * 16 + l15) * 136 + s * 32 + quad * 8), sb[s], a);
#pragma unroll
      for (int s = 0; s < 2; ++s) a = MFMA16(*(const bf16x8*)(il + (it * 16 + l15) * 72 + s * 32 + quad * 8), vb[s], a);
#pragma unroll
      for (int r = 0; r < 4; ++r) ub[(it * 16 + quad * 4 + r) * 128 + e0] = f2bf(a[r]);
    }
#pragma unroll
    for (int mt = 0; mt < 8; ++mt) {
      f32x4 a = S[mt];
      a[0] *= eg; a[1] *= eg; a[2] *= eg; a[3] *= eg;
#pragma unroll
      for (int s = 0; s < 2; ++s) a = MFMA16(*(const bf16x8*)(kl + (mt * 16 + l15) * 72 + s * 32 + quad * 8), vb[s], a);
      S[mt] = a;
    }
    __syncthreads();
    if (n + 1 < 64) CH_LSTORE();
    __syncthreads();
  }
}

DI void phase_mix(const Params& p, int i, bf16_t* smem) {
  if (BID() < 64) { dn_chain_item(p, BID(), smem); return; }
  phase_dil_attn(p, BID() - 64, GDIM() - 64);
}

DI void phase_dn_post(const Params& p, int i) {
  const bf16_t* ob = (const bf16_t*)(p.ws + OFF_UB);
  bf16_t* z = (bf16_t*)(p.ws + OFF_Z);
  const float* ng = p.dn_norm_g + i * 128;
  const int wave = TID() >> 6, lane = TID() & 63;
  const int N = T_ * 4;
  for (int base = BID() * 4; base < N; base += GDIM() * 4) {
    const int item = base + wave;
    const int t = item >> 2, h = item & 3, b = t >> 12, sidx = t & 4095;
    const size_t g = (size_t)item * 128 + lane * 2;
    const size_t og = ((size_t)((b * 4 + h) * 64 + (sidx >> 6))) * 8192 + (sidx & 63) * 128 + lane * 2;
    unsigned ov = *(const unsigned*)(ob + og), zv = *(const unsigned*)(z + g);
    float o0 = bf2f((bf16_t)(ov & 0xffff)), o1 = bf2f((bf16_t)(ov >> 16));
    float z0 = bf2f((bf16_t)(zv & 0xffff)), z1 = bf2f((bf16_t)(zv >> 16));
    float ms = wave_sum(o0 * o0 + o1 * o1) * (1.f / 128.f);
    float rr = rsqrtf(ms + 1e-6f);
    float r0 = o0 * rr * ng[lane * 2] * siluf_(z0), r1 = o1 * rr * ng[lane * 2 + 1] * siluf_(z1);
    *(unsigned*)(z + g) = pack2(r0, r1);
  }
}

struct MixLoad {
  const bf16_t* a; const bf16_t* b;
  DI uint4 operator()(int row, int ks, int kc) const {
    const unsigned off = (unsigned)((row * 512 + (ks & 7) * 64 + kc) * 2);
    return *(const uint4*)((const char*)((ks < 8) ? a : b) + off);
  }
};

DI void phase_wout(const Params& p, int i, bf16_t* smem) {
  const bf16_t* W = (const bf16_t*)(p.ws + OFF_W) + W_EVEN0 + (size_t)i * (SZ_WIN + SZ_SQ) + SZ_WIN;
  MixLoad al{(const bf16_t*)(p.ws + OFF_Z), (const bf16_t*)(p.ws + OFF_SWQ)};
  PlainLoad bl{W, 1024};
  for_tiles(256, 8, [&](int mi, int ni) {
    gemm_tile(mi * 128, ni * 128, 16, al, bl, [&](f32x4 (&acc)[4][4], int rb, int cb) { epi_resid(p, acc, rb, cb); }, smem);
  });
}

DI void phase_ln(const Params& p, const float* g, const float* b) {
  const int wave = TID() >> 6, lane = TID() & 63;
  bf16_t* hb = (bf16_t*)(p.ws + OFF_HB);
  for (int row = BID() * 4 + wave; row < T_; row += GDIM() * 4) {
    float4* y = (float4*)(p.out + (size_t)row * 1024);
    float4 v[4];
    float s = 0.f;
#pragma unroll
    for (int i = 0; i < 4; ++i) { v[i] = y[lane + 64 * i]; s += v[i].x + v[i].y + v[i].z + v[i].w; }
    const float mu = wave_sum(s) * (1.f / 1024.f);
    float q = 0.f;
#pragma unroll
    for (int i = 0; i < 4; ++i) { float a = v[i].x - mu, b2 = v[i].y - mu, c = v[i].z - mu, d = v[i].w - mu; q += a * a + b2 * b2 + c * c + d * d; }
    const float rstd = rsqrtf(wave_sum(q) * (1.f / 1024.f) + 1e-5f);
#pragma unroll
    for (int i = 0; i < 4; ++i) {
      float4 gg = ((const float4*)g)[lane + 64 * i], bb = ((const float4*)b)[lane + 64 * i];
      float4 o;
      o.x = (v[i].x - mu) * rstd * gg.x + bb.x; o.y = (v[i].y - mu) * rstd * gg.y + bb.y;
      o.z = (v[i].z - mu) * rstd * gg.z + bb.z; o.w = (v[i].w - mu) * rstd * gg.w + bb.w;
      y[lane + 64 * i] = o;
      uint2 ob; ob.x = pack2(o.x, o.y); ob.y = pack2(o.z, o.w);
      ((uint2*)(hb + (size_t)row * 1024))[lane + 64 * i] = ob;
    }
  }
}

DI void phase_s5_naive(const Params& p, int i) {
  const int wave = TID() >> 6, lane = TID() & 63;
  bf16_t* hid = (bf16_t*)(p.ws + OFF_HID);
  for (int base = BID() * 4; base < 512; base += GDIM() * 4) {
    const int item = base + wave, b = item >> 6, g = item & 63;
    const int gp = (i * 64 + g) * 64 + lane;
    const double dt = exp((double)p.s5_log_dt[i * 64 + g]);
    const double are = p.s5_a_re[gp], aim = p.s5_a_im[gp];
    const double lr = are * dt, li = aim * dt;
    const double kk = rint(li * 0.15915494309189535);
    const double red = li - kk * 6.283185307179586;
    const double e = exp(lr);
    const double abr = e * cos(red), abi = e * sin(red);
    const double den = are * are + aim * aim;
    const double nr = abr - 1.0, ni = abi;
    const double cfr = (nr * are + ni * aim) / den, cfi = (ni * are - nr * aim) / den;
    float bbr[16], bbi[16], cr[16], ci[16];
#pragma unroll
    for (int h = 0; h < 16; ++h) {
      const double br = p.s5_b_re[(size_t)gp * 16 + h], bi = p.s5_b_im[(size_t)gp * 16 + h];
      bbr[h] = (float)(cfr * br - cfi * bi); bbi[h] = (float)(cfr * bi + cfi * br);
      cr[h] = p.s5_c_re[((size_t)(i * 64 + g) * 16 + h) * 64 + lane];
      ci[h] = p.s5_c_im[((size_t)(i * 64 + g) * 16 + h) * 64 + lane];
    }
    const float ar = (float)abr, ai = (float)abi;
    const float dsk = p.s5_d[i * 1024 + g * 16 + (lane & 15)];
    float sr = 0.f, si = 0.f;
#pragma unroll 1
    for (int t = 0; t < S_; ++t) {
      const size_t row = (size_t)(b * S_ + t);
      const float4* up = (const float4*)(p.out + row * 1024 + g * 16);
      float u[16];
#pragma unroll
      for (int j = 0; j < 4; ++j) { float4 v = up[j]; u[4 * j] = v.x; u[4 * j + 1] = v.y; u[4 * j + 2] = v.z; u[4 * j + 3] = v.w; }
      float bur = 0.f, bui = 0.f;
#pragma unroll
      for (int h = 0; h < 16; ++h) { bur += bbr[h] * u[h]; bui += bbi[h] * u[h]; }
      const float nsr = ar * sr - ai * si + bur, nsi = ar * si + ai * sr + bui;
      sr = nsr; si = nsi;
      float yk = 0.f, uk = 0.f;
#pragma unroll
      for (int h = 0; h < 16; ++h) {
        float v = wave_sum(cr[h] * sr - ci[h] * si);
        if (lane == h) { yk = v; uk = u[h]; }
      }
      if (lane < 16) hid[row * 1024 + g * 16 + lane] = f2bf(gelu_tanh(yk + dsk * uk));
    }
  }
}

DI void phase_s5_tables(const Params& p, int i, float* smem) {
  float2* pw = (float2*)smem;
  float2* bb = pw + 64 * 33;
  float2* cc = bb + 64 * 16;
  bf16_t* Ktab = (bf16_t*)(p.ws + OFF_KTAB); bf16_t* Etab = (bf16_t*)(p.ws + OFF_ETAB); bf16_t* Gtab = (bf16_t*)(p.ws + OFF_GTAB);
  float2* AL = (float2*)(p.ws + OFF_AL);
  const int tid = TID();
  for (int g = BID(); g < 64; g += GDIM()) {
    const double dt = exp((double)p.s5_log_dt[i * 64 + g]);
    for (int e = tid; e < 64 * 33; e += 256) {
      const int pp = e / 33, n = e - pp * 33;
      const double are = p.s5_a_re[(i * 64 + g) * 64 + pp], aim = p.s5_a_im[(i * 64 + g) * 64 + pp];
      const double lr = are * dt * n, li = aim * dt * n;
      const double k = rint(li * 0.15915494309189535);
      const double red = li - k * 6.283185307179586;
      const double ex = exp(lr);
      pw[e] = make_float2((float)(ex * cos(red)), (float)(ex * sin(red)));
    }
    for (int e = tid; e < 1024; e += 256) {
      const int pp = e >> 4;
      const int gp = (i * 64 + g) * 64 + pp;
      const double are = p.s5_a_re[gp], aim = p.s5_a_im[gp];
      const double lr = are * dt, li = aim * dt;
      const double k = rint(li * 0.15915494309189535);
      const double red = li - k * 6.283185307179586;
      const double ex = exp(lr);
      const double nr = ex * cos(red) - 1.0, ni = ex * sin(red);
      const double den = are * are + aim * aim;
      const double cfr = (nr * are + ni * aim) / den, cfi = (ni * are - nr * aim) / den;
      const double br = p.s5_b_re[(size_t)gp * 16 + (e & 15)], bi = p.s5_b_im[(size_t)gp * 16 + (e & 15)];
      bb[e] = make_float2((float)(cfr * br - cfi * bi), (float)(cfr * bi + cfi * br));
      const size_t ci = ((size_t)(i * 64 + g) * 16 + (e >> 6)) * 64 + (e & 63);
      cc[e] = make_float2(p.s5_c_re[ci], p.s5_c_im[ci]);
    }
    __syncthreads();
    for (int e = tid; e < 8192; e += 256) {
      const int tau = e >> 8, ho = (e >> 4) & 15, hi = e & 15;
      float acc = 0.f;
      for (int pp = 0; pp < 64; ++pp) {
        const float2 c = cc[ho * 64 + pp], w = pw[pp * 33 + tau], b = bb[pp * 16 + hi];
        const float cwr = c.x * w.x - c.y * w.y, cwi = c.x * w.y + c.y * w.x;
        acc += cwr * b.x - cwi * b.y;
      }
      Ktab[(size_t)g * 8192 + e] = f2bf(acc);
    }
    for (int e = tid; e < 65536; e += 256) {
      const int pc = e >> 9, sidx = (e >> 4) & 31, hi = e & 15, pp = pc & 63;
      const float2 w = pw[pp * 33 + 31 - sidx], b = bb[pp * 16 + hi];
      const float v = (pc < 64) ? (w.x * b.x - w.y * b.y) : (w.x * b.y + w.y * b.x);
      Etab[(size_t)g * 65536 + e] = f2bf(v);
    }
    for (int e = tid; e < 65536; e += 256) {
      const int row = e >> 7, pc = e & 127, pp = pc & 63, t = row >> 4, ho = row & 15;
      const float2 c = cc[ho * 64 + pp], w = pw[pp * 33 + t + 1];
      const float v = (pc < 64) ? (c.x * w.x - c.y * w.y) : -(c.x * w.y + c.y * w.x);
      Gtab[(size_t)g * 65536 + e] = f2bf(v);
    }
    if (tid < 64) AL[g * 64 + tid] = pw[tid * 33 + 32];
    __syncthreads();
  }
}

DI void phase_s5_end(const Params& p, bf16_t* smem) {
  const bf16_t* Etab = (const bf16_t*)(p.ws + OFF_ETAB); const bf16_t* hb = (const bf16_t*)(p.ws + OFF_HB);
  const float2* AL = (const float2*)(p.ws + OFF_AL);
  bf16_t* sin_ = (bf16_t*)(p.ws + OFF_SIN);
  float* endbuf = (float*)smem;
  for (int item = BID(); item < 512; item += GDIM()) {
    const int g = item >> 3, b = item & 7;
    auto al = [=](int row, int ks, int kc) { return *(const uint4*)((const char*)Etab + (unsigned)((((g * 128 + row) * 512) + ks * 64 + kc) * 2)); };
    auto bl = [=](int n, int ks, int kc) {
      const int k = ks * 64 + kc, sidx = k >> 4, hi0 = k & 15;
      return *(const uint4*)((const char*)hb + (unsigned)(((b * 4096 + n * 32 + sidx) * 1024 + g * 16 + hi0) * 2));
    };
    gemm_tile(0, 0, 8, al, bl, [&](f32x4 (&acc)[4][4], int rb, int cb) {
      const int lane = TID() & 63, l15 = lane & 15, quad = lane >> 4;
#pragma unroll
      for (int mt = 0; mt < 4; ++mt)
#pragma unroll
        for (int nt = 0; nt < 4; ++nt)
#pragma unroll
          for (int r = 0; r < 4; ++r) endbuf[(rb + mt * 16 + l15) * 129 + cb + nt * 16 + quad * 4 + r] = acc[mt][nt][r];
    }, smem);
    __syncthreads();
    if (TID() < 64) {
      const int pp = TID();
      const float2 a = AL[g * 64 + pp];
      float sr = 0.f, si = 0.f;
      for (int n = 0; n < 128; ++n) {
        bf16_t* dst = sin_ + ((size_t)g * 1024 + b * 128 + n) * 128;
        dst[pp] = f2bf(sr); dst[64 + pp] = f2bf(si);
        const float er = endbuf[pp * 129 + n], ei = endbuf[(64 + pp) * 129 + n];
        const float nr = a.x * sr - a.y * si + er, ni = a.x * si + a.y * sr + ei;
        sr = nr; si = ni;
      }
    }
    __syncthreads();
  }
}

DI void phase_s5_y(const Params& p, int i, bf16_t* smem) {
  const bf16_t* Ktab = (const bf16_t*)(p.ws + OFF_KTAB); const bf16_t* Gtab = (const bf16_t*)(p.ws + OFF_GTAB);
  const bf16_t* hb = (const bf16_t*)(p.ws + OFF_HB); const bf16_t* sin_ = (const bf16_t*)(p.ws + OFF_SIN);
  bf16_t* hid = (bf16_t*)(p.ws + OFF_HID);
  for (int w = BID(); w < 2048; w += GDIM()) {
    const int g = w >> 5, mtile = (w >> 3) & 3, b = w & 7;
    const int nT = mtile * 2 + 2;
    auto al = [=](int row, int ks, int kc) -> uint4 {
      if (ks < nT) {
        const int k = ks * 64 + kc, sidx = k >> 4, hi0 = k & 15, t = row >> 4, ho = row & 15;
        if (t >= sidx) return *(const uint4*)((const char*)Ktab + (unsigned)(((((g * 32 + (t - sidx)) * 16 + ho) * 16) + hi0) * 2));
        return make_uint4(0, 0, 0, 0);
      }
      return *(const uint4*)((const char*)Gtab + (unsigned)((((g * 512 + row) * 128) + (ks - nT) * 64 + kc) * 2));
    };
    auto bl = [=](int n, int ks, int kc) -> uint4 {
      if (ks < nT) {
        const int k = ks * 64 + kc, sidx = k >> 4, hi0 = k & 15;
        return *(const uint4*)((const char*)hb + (unsigned)(((b * 4096 + n * 32 + sidx) * 1024 + g * 16 + hi0) * 2));
      }
      return *(const uint4*)((const char*)sin_ + (unsigned)((((g * 1024 + b * 128 + n) * 128) + (ks - nT) * 64 + kc) * 2));
    };
    gemm_tile(0, mtile * 128, nT + 2, bl, al, [&](f32x4 (&acc)[4][4], int rb, int cb) {
      const int lane = TID() & 63, l15 = lane & 15, quad = lane >> 4;
      const float4 dsk = *(const float4*)(p.s5_d + i * 1024 + g * 16 + quad * 4);
#pragma unroll
      for (int mt = 0; mt < 4; ++mt)
#pragma unroll
        for (int nt = 0; nt < 4; ++nt) {
          const int t = (cb + nt * 16) >> 4, n = rb + mt * 16 + l15;
          const size_t tok = (size_t)b * 4096 + n * 32 + t;
          const float4 u = *(const float4*)(p.out + tok * 1024 + g * 16 + quad * 4);
          u32x2 v;
          v[0] = pack2(gelu_tanh(acc[mt][nt][0] + dsk.x * u.x), gelu_tanh(acc[mt][nt][1] + dsk.y * u.y));
          v[1] = pack2(gelu_tanh(acc[mt][nt][2] + dsk.z * u.z), gelu_tanh(acc[mt][nt][3] + dsk.w * u.w));
          *(u32x2*)(hid + tok * 1024 + g * 16 + quad * 4) = v;
        }
    }, smem);
  }
}

DI void phase_glu(const Params& p, int i, bf16_t* smem) {
  const bf16_t* W = (const bf16_t*)(p.ws + OFF_W) + W_ODD0 + (size_t)i * SZ_GLU;
  PlainLoad al{(const bf16_t*)(p.ws + OFF_HID), 1024}, bl{W, 1024};
  for_tiles(256, 16, [&](int mi, int ni) {
    gemm_tile(mi * 128, ni * 128, 16, al, bl, [&](f32x4 (&acc)[4][4], int rb, int cb) {
      const int lane = TID() & 63, l15 = lane & 15, quad = lane >> 4;
#pragma unroll
      for (int mt = 0; mt < 4; ++mt)
#pragma unroll
        for (int np = 0; np < 2; ++np) {
          float4* ptr = (float4*)(p.out + (size_t)(rb + mt * 16 + l15) * 1024 + (cb >> 1) + np * 16 + quad * 4);
          float4 h = *ptr;
          h.x = ALPHA * h.x + acc[mt][2 * np][0] * sigmoidf_(acc[mt][2 * np + 1][0]);
          h.y = ALPHA * h.y + acc[mt][2 * np][1] * sigmoidf_(acc[mt][2 * np + 1][1]);
          h.z = ALPHA * h.z + acc[mt][2 * np][2] * sigmoidf_(acc[mt][2 * np + 1][2]);
          h.w = ALPHA * h.w + acc[mt][2 * np][3] * sigmoidf_(acc[mt][2 * np + 1][3]);
          *ptr = h;
        }
    }, smem);
  });
}

DI void phase_xproj(const Params& p, int l, bf16_t* smem) {
  const bf16_t* wc = (const bf16_t*)(p.ws + OFF_W) + (size_t)l * SZ_COMMON;
  {
    PlainLoad al{(const bf16_t*)(p.ws + OFF_HB), 1024}, bl{wc, 1024};
    bf16_t* q = (bf16_t*)(p.ws + OFF_XQ);
    for_tiles(256, 8, [&](int mi, int ni) {
      gemm_tile(mi * 128, ni * 128, 16, al, bl, [&](f32x4 (&acc)[4][4], int rb, int cb) { epi_bf16(q, 1024, acc, rb, cb); }, smem);
    });
  }
  {
    const float* memf = p.mem;
    auto al = [=](int row, int ks, int kc) -> uint4 {
      const float4* src = (const float4*)((const char*)memf + (unsigned)((row * 1024 + ks * 64 + kc) * 4));
      float4 a = src[0], b2 = src[1];
      return make_uint4(pack2(a.x, a.y), pack2(a.z, a.w), pack2(b2.x, b2.y), pack2(b2.z, b2.w));
    };
    bf16_t* kx = (bf16_t*)(p.ws + OFF_KX); bf16_t* vx = (bf16_t*)(p.ws + OFF_VX);
    for_tiles(16, 16, [&](int mi, int ni) {
      const bool isv = ni >= 8;
      PlainLoad bl{isv ? (wc + 2 * SZ_SQ) : (wc + SZ_SQ), 1024};
      gemm_tile(mi * 128, (ni & 7) * 128, 16, al, bl, [&](f32x4 (&acc)[4][4], int rb, int cb) {
        if (!isv) { epi_bf16(kx, 1024, acc, rb, cb); return; }
        const int lane = TID() & 63, l15 = lane & 15, quad = lane >> 4;
#pragma unroll
        for (int mt = 0; mt < 4; ++mt)
#pragma unroll
          for (int nt = 0; nt < 4; ++nt) {
            const int row = rb + mt * 16 + l15, col = cb + nt * 16 + quad * 4;
            const int b = row >> 8, key = row & 255, h = col >> 8, d = col & 255;
            bf16_t* dst = vx + ((size_t)((b * 4 + h) * 256 + d)) * 256 + key;
#pragma unroll
            for (int r = 0; r < 4; ++r) dst[r * 256] = f2bf(acc[mt][nt][r]);
          }
      }, smem);
    });
  }
}


DI void phase_xattn(const Params& p) {
  const int wave = TID() >> 6, lane = TID() & 63, l15 = lane & 15, quad = lane >> 4;
  const bf16_t* q = (const bf16_t*)(p.ws + OFF_XQ); const bf16_t* kx = (const bf16_t*)(p.ws + OFF_KX); const bf16_t* vxT = (const bf16_t*)(p.ws + OFF_VX);
  bf16_t* xo = (bf16_t*)(p.ws + OFF_XO);
  for (int item = BID(); item < 2048; item += GDIM()) {
    const int b = item >> 8, h = (item >> 6) & 3, qb = item & 63;
    const size_t tq = (size_t)b * 4096 + qb * 64 + wave * 16 + l15;
    bf16x8 qf[8];
#pragma unroll
    for (int ks = 0; ks < 8; ++ks) qf[ks] = *(const bf16x8*)(q + tq * 1024 + h * 256 + ks * 32 + quad * 8);
    f32x4 s[16];
#pragma unroll
    for (int mt = 0; mt < 16; ++mt) {
      const bf16_t* kp = kx + (size_t)(b * 256 + mt * 16 + l15) * 1024 + h * 256 + quad * 8;
      f32x4 a = {0.f, 0.f, 0.f, 0.f};
#pragma unroll
      for (int ks = 0; ks < 8; ++ks) a = MFMA16(*(const bf16x8*)(kp + ks * 32), qf[ks], a);
      s[mt] = a;
      if (mt & 1) __builtin_amdgcn_sched_barrier(0);
    }
    float m = -1e30f;
#pragma unroll
    for (int mt = 0; mt < 16; ++mt)
#pragma unroll
      for (int r = 0; r < 4; ++r) m = fmaxf(m, s[mt][r]);
    m = fmaxf(m, __shfl_xor(m, 16)); m = fmaxf(m, __shfl_xor(m, 32));
    const float c1 = 0.0625f * 1.4426950408889634f;
    float l = 0.f;
#pragma unroll
    for (int mt = 0; mt < 16; ++mt)
#pragma unroll
      for (int r = 0; r < 4; ++r) { float pv = exp2f((s[mt][r] - m) * c1); s[mt][r] = pv; l += pv; }
    l += __shfl_xor(l, 16); l += __shfl_xor(l, 32);
    f32x4 o[16];
#pragma unroll
    for (int dt = 0; dt < 16; ++dt) o[dt] = f32x4{0.f, 0.f, 0.f, 0.f};
#pragma unroll
    for (int s2 = 0; s2 < 8; ++s2) {
      const bf16x8 pf = pack8(s[2 * s2], s[2 * s2 + 1]);
#pragma unroll
      for (int dt = 0; dt < 16; ++dt) {
        const bf16_t* vp = vxT + ((size_t)((b * 4 + h) * 256 + dt * 16 + l15)) * 256 + s2 * 32 + quad * 4;
        u32x2 lo = *(const u32x2*)vp, hi = *(const u32x2*)(vp + 16);
        u32x4 t; t[0] = lo[0]; t[1] = lo[1]; t[2] = hi[0]; t[3] = hi[1];
        o[dt] = MFMA16(__builtin_bit_cast(bf16x8, t), pf, o[dt]);
      }
      __builtin_amdgcn_sched_barrier(0);
    }
    const float il = 1.f / l;
#pragma unroll
    for (int dt = 0; dt < 16; ++dt) {
      u32x2 v; v[0] = pack2(o[dt][0] * il, o[dt][1] * il); v[1] = pack2(o[dt][2] * il, o[dt][3] * il);
      *(u32x2*)(xo + tq * 1024 + h * 256 + dt * 16 + quad * 4) = v;
    }
  }
}

template <int R, int NT>
DI void dil_branch(const bf16_t* swk, const bf16_t* swv, size_t rowbase, int h, int tok0, const bf16x8 (&qf)[2], float& m, float& l, f32x4 (&o)[4],
                   int l15, int quad) {
  constexpr int U = 16 / R, W = 128 * R;
  f32x4 s[NT];
#pragma unroll
  for (int kt = 0; kt < NT; ++kt) {
    int kap = tok0 - W + R * (kt * 16 + l15);
    kap = min(max(kap, 0), 4095);
    const bf16_t* kp = swk + (rowbase + kap) * 512 + h * 64 + quad * 8;
    f32x4 a = {0.f, 0.f, 0.f, 0.f};
    a = MFMA16(*(const bf16x8*)kp, qf[0], a);
    a = MFMA16(*(const bf16x8*)(kp + 32), qf[1], a);
    s[kt] = a;
    if ((kt & 3) == 3) __builtin_amdgcn_sched_barrier(0);
  }
  float mx = m;
  const float c1 = 0.125f * 1.4426950408889634f;
#pragma unroll
  for (int kt = 0; kt < NT; ++kt)
#pragma unroll
    for (int r2 = 0; r2 < 4; ++r2) {
      const int c = kt * 16 + quad * 4 + r2;
      const int dist = U * l15 + 128 - c;
      const int kap = tok0 - W + R * c;
      const bool ok = (dist >= 0) && (dist <= 128) && (kap >= 0);
      const float v = ok ? s[kt][r2] * c1 : -1e30f;
      s[kt][r2] = v; mx = fmaxf(mx, v);
    }
  mx = fmaxf(mx, __shfl_xor(mx, 16)); mx = fmaxf(mx, __shfl_xor(mx, 32));
  const float corr = exp2f(m - mx);
  m = mx; l *= corr;
#pragma unroll
  for (int dt = 0; dt < 4; ++dt) { o[dt][0] *= corr; o[dt][1] *= corr; o[dt][2] *= corr; o[dt][3] *= corr; }
#pragma unroll
  for (int kt = 0; kt < NT; ++kt)
#pragma unroll
    for (int r2 = 0; r2 < 4; ++r2) { float pv = exp2f(s[kt][r2] - mx); s[kt][r2] = pv; l += pv; }
  constexpr int NS = (NT + 1) / 2;
#pragma unroll
  for (int s2 = 0; s2 < NS; ++s2) {
    const f32x4 z4 = {0.f, 0.f, 0.f, 0.f};
    const bf16x8 pf = pack8(s[2 * s2], (2 * s2 + 1 < NT) ? s[(2 * s2 + 1 < NT) ? 2 * s2 + 1 : 0] : z4);
    const bf16_t* vp[8];
#pragma unroll
    for (int j = 0; j < 8; ++j) {
      const int c = (2 * s2 + (j >> 2)) * 16 + quad * 4 + (j & 3);
      int kap = tok0 - W + R * c;
      kap = min(max(kap, 0), 4095);
      vp[j] = swv + (rowbase + kap) * 512 + h * 64 + l15;
    }
#pragma unroll
    for (int dt = 0; dt < 4; ++dt) {
      bf16x8 vf;
#pragma unroll
      for (int j = 0; j < 8; ++j) vf[j] = (short)vp[j][dt * 16];
      o[dt] = MFMA16(vf, pf, o[dt]);
    }
    __builtin_amdgcn_sched_barrier(0);
  }
}

DI void phase_dil_attn(const Params& p, int first, int nblk) {
  const int wave = TID() >> 6, lane = TID() & 63, l15 = lane & 15, quad = lane >> 4;
  bf16_t* swq = (bf16_t*)(p.ws + OFF_SWQ); const bf16_t* swk = (const bf16_t*)(p.ws + OFF_SWK); const bf16_t* swv = (const bf16_t*)(p.ws + OFF_SWV);
  for (int item = first; item < 4096; item += nblk) {
    const int b = item >> 9, h = (item >> 6) & 7, G = (item >> 2) & 15, sub = item & 3;
    const int tok0 = G * 256 + sub * 4 + wave;
    const size_t rowbase = (size_t)b * 4096;
    const size_t tq = rowbase + tok0 + 16 * l15;
    bf16x8 qf[2];
    qf[0] = *(const bf16x8*)(swq + tq * 512 + h * 64 + quad * 8);
    qf[1] = *(const bf16x8*)(swq + tq * 512 + h * 64 + 32 + quad * 8);
    float m = -1e30f, l = 0.f;
    f32x4 o[4];
#pragma unroll
    for (int dt = 0; dt < 4; ++dt) o[dt] = f32x4{0.f, 0.f, 0.f, 0.f};
    dil_branch<16, 9>(swk, swv, rowbase, h, tok0, qf, m, l, o, l15, quad);
    dil_branch<4, 12>(swk, swv, rowbase, h, tok0, qf, m, l, o, l15, quad);
    dil_branch<1, 24>(swk, swv, rowbase, h, tok0, qf, m, l, o, l15, quad);
    l += __shfl_xor(l, 16); l += __shfl_xor(l, 32);
    const float il = 1.f / l;
#pragma unroll
    for (int dt = 0; dt < 4; ++dt) {
      u32x2 v; v[0] = pack2(o[dt][0] * il, o[dt][1] * il); v[1] = pack2(o[dt][2] * il, o[dt][3] * il);
      *(u32x2*)(swq + tq * 512 + h * 64 + dt * 16 + quad * 4) = v;
    }
  }
}

DI void phase_xo(const Params& p, int l, bf16_t* smem) {
  const bf16_t* wc = (const bf16_t*)(p.ws + OFF_W) + (size_t)l * SZ_COMMON + 3 * SZ_SQ;
  PlainLoad al{(const bf16_t*)(p.ws + OFF_XO), 1024}, bl{wc, 1024};
  for_tiles(256, 8, [&](int mi, int ni) {
    gemm_tile(mi * 128, ni * 128, 16, al, bl, [&](f32x4 (&acc)[4][4], int rb, int cb) { epi_resid(p, acc, rb, cb); }, smem);
  });
}

DI void phase_ffn_gu(const Params& p, int l, bf16_t* smem) {
  const bf16_t* W = (const bf16_t*)(p.ws + OFF_W) + (size_t)l * SZ_COMMON + 4 * SZ_SQ;
  PlainLoad al{(const bf16_t*)(p.ws + OFF_HB), 1024}, bl{W, 1024};
  bf16_t* act = (bf16_t*)(p.ws + OFF_ACT);
  for_tiles(256, 44, [&](int mi, int ni) {
    gemm_tile(mi * 128, ni * 128, 16, al, bl, [&](f32x4 (&acc)[4][4], int rb, int cb) {
      const int lane = TID() & 63, l15 = lane & 15, quad = lane >> 4;
#pragma unroll
      for (int mt = 0; mt < 4; ++mt)
#pragma unroll
        for (int np = 0; np < 2; ++np) {
          u32x2 v;
          v[0] = pack2(siluf_(acc[mt][2 * np][0]) * acc[mt][2 * np + 1][0], siluf_(acc[mt][2 * np][1]) * acc[mt][2 * np + 1][1]);
          v[1] = pack2(siluf_(acc[mt][2 * np][2]) * acc[mt][2 * np + 1][2], siluf_(acc[mt][2 * np][3]) * acc[mt][2 * np + 1][3]);
          *(u32x2*)(act + (size_t)(rb + mt * 16 + l15) * 2816 + (cb >> 1) + np * 16 + quad * 4) = v;
        }
    }, smem);
  });
}
DI void phase_ffn_down(const Params& p, int l, bf16_t* smem) {
  const bf16_t* W = (const bf16_t*)(p.ws + OFF_W) + (size_t)l * SZ_COMMON + 4 * SZ_SQ + SZ_GU;
  PlainLoad al{(const bf16_t*)(p.ws + OFF_ACT), 2816}, bl{W, 2816};
  for_tiles(256, 8, [&](int mi, int ni) {
    gemm_tile(mi * 128, ni * 128, 44, al, bl, [&](f32x4 (&acc)[4][4], int rb, int cb) { epi_resid(p, acc, rb, cb); }, smem);
  });
}


#define XB_TMO      128
#define XB_XCNT(j)  (256  + 64 * (j))
#define XB_XSUB(j)  (1280 + 64 * (j))
#define XB_XGEN(j)  (2304 + 64 * (j))
#define XB_TOP      3328
#define XB_TOPGEN   3392
#define XCD_BAR_WORDS 3456
#define XB_SPIN_CAP (1u << 22)
#define LAS __attribute__((address_space(3)))
DI unsigned xb_ld(unsigned* p) { return __hip_atomic_load(p, __ATOMIC_RELAXED, __HIP_MEMORY_SCOPE_AGENT); }
DI unsigned xb_add(unsigned* p, unsigned v) { return __hip_atomic_fetch_add(p, v, __ATOMIC_RELAXED, __HIP_MEMORY_SCOPE_AGENT); }
DI unsigned xb_xcc_id() { return (unsigned)__builtin_amdgcn_s_getreg((3 << 11) | 20) & 0xFu; }
#define XB_SPIN(cond, bar) do { unsigned _sp = 0; while (cond) { __builtin_amdgcn_s_sleep(1); \
    if ((++_sp & 255u) == 0u) { if (xb_ld(&(bar)[XB_TMO])) break; if (_sp > XB_SPIN_CAP) { atomicAdd(&(bar)[XB_TMO], 1u); break; } } } } while (0)
struct XcdBarrier { unsigned* bar; unsigned x; volatile LAS unsigned* st; };
DI XcdBarrier xcd_barrier_post(unsigned* bar, volatile LAS unsigned* st) {
  XcdBarrier b; b.bar = bar; b.x = xb_xcc_id(); b.st = st;
  if (threadIdx.x == 0) (void)xb_add(&bar[XB_XCNT(b.x)], 1u);
  return b;
}
DI void xcd_barrier_complete(unsigned* bar, unsigned x, unsigned& nloc, unsigned& nx) {
  const unsigned G = gridDim.x * gridDim.y * gridDim.z;
  unsigned sum, cnt, mine, sp = 0u;
  for (;;) {
    sum = 0u; cnt = 0u; mine = 0u;
#pragma unroll
    for (unsigned j = 0; j < 16; ++j) { const unsigned c = xb_ld(&bar[XB_XCNT(j)]); sum += c; cnt += (c > 0u) ? 1u : 0u; mine = (j == x) ? c : mine; }
    if (sum == G) break;
    __builtin_amdgcn_s_sleep(1);
    if ((++sp & 255u) == 0u) { if (xb_ld(&bar[XB_TMO])) break; if (sp > XB_SPIN_CAP) { atomicAdd(&bar[XB_TMO], 1u); break; } }
  }
  nloc = mine > 0u ? mine : 1u; nx = cnt > 0u ? cnt : 1u;
}
DI void xcd_barrier(const XcdBarrier& b) {
  asm volatile("s_waitcnt vmcnt(0)" ::: "memory");
  __syncthreads();
  if (threadIdx.x == 0) {
    unsigned* bar = b.bar;
    __builtin_amdgcn_s_waitcnt(0);
    unsigned nloc = b.st[0], nx = b.st[1];
    if (nloc == 0u) { xcd_barrier_complete(bar, b.x, nloc, nx); b.st[0] = nloc; b.st[1] = nx; }
    const unsigned old = xb_add(&bar[XB_XSUB(b.x)], 1u);
    const unsigned gen = old / nloc;
    if (old + 1u == (gen + 1u) * nloc) {
      __builtin_amdgcn_fence(__ATOMIC_RELEASE, "agent");
      asm volatile("s_waitcnt vmcnt(0)" ::: "memory");
      const unsigned og = xb_add(&bar[XB_TOP], 1u);
      const unsigned tg = og / nx;
      if (og + 1u == (tg + 1u) * nx) xb_add(&bar[XB_TOPGEN], 1u);
      else XB_SPIN(xb_ld(&bar[XB_TOPGEN]) == tg, bar);
      __builtin_amdgcn_fence(__ATOMIC_ACQUIRE, "agent");
      xb_add(&bar[XB_XGEN(b.x)], 1u);
      asm volatile("s_waitcnt vmcnt(0)" ::: "memory");
    } else {
      XB_SPIN(xb_ld(&bar[XB_XGEN(b.x)]) == gen, bar);
      __builtin_amdgcn_fence(__ATOMIC_ACQUIRE, "agent");
      asm volatile("s_waitcnt vmcnt(0)" ::: "memory");
    }
  }
  __syncthreads();
}

__global__ void __launch_bounds__(256, 2) fwd_megakernel(Params p) {
  cg::grid_group grid = cg::this_grid();
  __shared__ __attribute__((aligned(16))) char smem_raw[2 * 2 * 128 * LDT * 2];
  bf16_t* sm16 = (bf16_t*)smem_raw; float* sm32 = (float*)smem_raw;

  __shared__ uint4 xb_words;
  if (threadIdx.x == 0) xb_words = make_uint4(0u, 0u, 0u, 0u);
  __syncthreads();
  XcdBarrier xb = xcd_barrier_post((unsigned*)(p.ws + OFF_BAR), (volatile LAS unsigned*)&xb_words);
  phase_prologue(p, sm32);
  grid.sync();
  for (int l = 0; l < 4; ++l) {
    const int i = l >> 1;
    if ((l & 1) == 0) {
      phase_proj(p, i, sm16); xcd_barrier(xb);
      phase_dn_prep(p, i, smem_raw); xcd_barrier(xb);
      phase_mix(p, i, sm16); xcd_barrier(xb);
      phase_dn_post(p, i); xcd_barrier(xb);
      phase_wout(p, i, sm16); xcd_barrier(xb);
    } else {
#if USE_S5_GEMM
      phase_s5_tables(p, i, sm32); xcd_barrier(xb);
      phase_s5_end(p, sm16); xcd_barrier(xb);
      phase_s5_y(p, i, sm16); xcd_barrier(xb);
#else
      phase_s5_naive(p, i); xcd_barrier(xb);
#endif
      phase_glu(p, i, sm16); xcd_barrier(xb);
    }
    phase_ln(p, p.ln_mix_g + l * 1024, p.ln_mix_b + l * 1024); xcd_barrier(xb);
    phase_xproj(p, l, sm16); xcd_barrier(xb);
    phase_xattn(p); xcd_barrier(xb);
    phase_xo(p, l, sm16); xcd_barrier(xb);
    phase_ln(p, p.ln_x_g + l * 1024, p.ln_x_b + l * 1024); xcd_barrier(xb);
    phase_ffn_gu(p, l, sm16); xcd_barrier(xb);
    phase_ffn_down(p, l, sm16); xcd_barrier(xb);
    phase_ln(p, p.ln_ffn_g + l * 1024, p.ln_ffn_b + l * 1024); xcd_barrier(xb);
  }
}

extern "C" void kernel_launch(void* const* d_in, const int* in_sizes, int n_in, void* d_out, int out_size, void* d_ws, size_t ws_size,
                              hipStream_t stream) {
  static int grid_blocks = 0;
  if (!grid_blocks) {
    int dev = 0, cus = 0, per_cu = 0;
    hipGetDevice(&dev);
    hipDeviceGetAttribute(&cus, hipDeviceAttributeMultiprocessorCount, dev);
    hipOccupancyMaxActiveBlocksPerMultiprocessor(&per_cu, fwd_megakernel, 256, 0);
    if (per_cu > 2) per_cu = 2;
    if (per_cu < 1) per_cu = 1;
    grid_blocks = cus * per_cu;
    grid_blocks -= grid_blocks % 8;
  }
  Params p{};
  const float** pf = (const float**)&p;
  for (int i = 0; i < 32; ++i) pf[i] = (const float*)d_in[i];
  p.pos = (const int*)d_in[2];
  p.out = (float*)d_out; p.ws = (char*)d_ws;
  hipMemsetAsync((char*)d_ws + OFF_BAR, 0, XCD_BAR_WORDS * sizeof(unsigned), stream);
  void* args[] = {&p};
  hipError_t e = hipLaunchCooperativeKernel((void*)fwd_megakernel, dim3(grid_blocks), dim3(256), args, 0, stream);
  if (e != hipSuccess) fprintf(stderr, "cooperative launch failed: %s (grid %d)\n", hipGetErrorString(e), grid_blocks);
}
```

```cpp
#include <hip/hip_runtime.h>
#include <hip/hip_cooperative_groups.h>
#include <cstdio>
namespace cg = cooperative_groups;
#ifndef USE_XATTN_MFMA
#define USE_XATTN_MFMA 1
#endif
#ifndef USE_S5_GEMM
#define USE_S5_GEMM 1
#endif
#ifndef USE_DIL_MFMA
#define USE_DIL_MFMA 1
#endif

typedef unsigned short bf16_t;
using bf16x8 = __attribute__((ext_vector_type(8))) short;
using f32x4 = __attribute__((ext_vector_type(4))) float;
#define DI __device__ __forceinline__

constexpr int T_ = 32768, S_ = 4096;
constexpr size_t MiB = (size_t)1 << 20;
constexpr size_t SZ_SQ = (size_t)1024 * 1024, SZ_WIN = (size_t)3712 * 1024, SZ_GLU = (size_t)2048 * 1024,
                 SZ_GU = (size_t)5632 * 1024, SZ_WD = (size_t)1024 * 2816;
constexpr size_t SZ_COMMON = 4 * SZ_SQ + SZ_GU + SZ_WD;
constexpr size_t W_EVEN0 = 4 * SZ_COMMON;
constexpr size_t W_ODD0 = W_EVEN0 + 2 * (SZ_WIN + SZ_SQ);
constexpr float ALPHA = 1.681792830507429f;

constexpr size_t OFF_W = 0;
constexpr size_t OFF_ROPE = 125 * MiB;
constexpr size_t OFF_HB = 133 * MiB;
constexpr size_t OFF_KX = 197 * MiB;
constexpr size_t OFF_VX = 201 * MiB;
constexpr size_t OFF_BIG = 205 * MiB;
constexpr size_t OFF_BAR = 511 * MiB;
constexpr size_t OFF_DNQKV = OFF_BIG;
constexpr size_t OFF_Z = OFF_BIG + 96 * MiB;
constexpr size_t OFF_SWQ = OFF_BIG + 128 * MiB;
constexpr size_t OFF_SWK = OFF_BIG + 160 * MiB;
constexpr size_t OFF_SWV = OFF_BIG + 192 * MiB;
constexpr size_t OFF_LOGIT = OFF_BIG + 224 * MiB;
constexpr size_t OFF_QD = OFF_BIG + 225 * MiB;
constexpr size_t OFF_KD = OFF_BIG + 257 * MiB;
constexpr size_t OFF_INTRA = OFF_BIG + 289 * MiB;
constexpr size_t OFF_WB = OFF_HB;
constexpr size_t OFF_UB = OFF_HB + 32 * MiB;
constexpr size_t OFF_EG = OFF_KX;
constexpr size_t OFF_XQ = OFF_BIG;
constexpr size_t OFF_XO = OFF_BIG + 64 * MiB;
constexpr size_t OFF_ACT = OFF_BIG;
constexpr size_t OFF_HID = OFF_BIG;
constexpr size_t OFF_SIN = OFF_BIG + 64 * MiB;
constexpr size_t OFF_KTAB = OFF_BIG + 80 * MiB;
constexpr size_t OFF_ETAB = OFF_BIG + 82 * MiB;
constexpr size_t OFF_GTAB = OFF_BIG + 90 * MiB;
constexpr size_t OFF_AL = OFF_BIG + 98 * MiB;

struct Params {
  const float* x; const float* mem; const int* pos;
  const float* hyb_w_in; const float* dn_conv_w; const float* dn_a_log; const float* dn_dt_bias; const float* dn_norm_g; const float* hyb_w_out;
  const float* s5_a_re; const float* s5_a_im; const float* s5_log_dt; const float* s5_b_re; const float* s5_b_im; const float* s5_c_re; const float* s5_c_im;
  const float* s5_d; const float* s5_glu_wo; const float* s5_glu_wg;
  const float* ln_mix_g; const float* ln_mix_b;
  const float* xq_w; const float* xk_w; const float* xv_w; const float* xo_w; const float* ln_x_g; const float* ln_x_b;
  const float* ffn_wg; const float* ffn_wu; const float* ffn_wd; const float* ln_ffn_g; const float* ln_ffn_b;
  float* out; char* ws;
};

DI int TID() { int t = threadIdx.x; asm volatile("" : "+v"(t)); return t; }
DI int BID() { int t = blockIdx.x; asm volatile("" : "+s"(t)); return t; }
DI int GDIM() { int t = gridDim.x; asm volatile("" : "+s"(t)); return t; }
DI bf16_t f2bf(float x) { unsigned u = __float_as_uint(x); u += 0x7fffu + ((u >> 16) & 1u); return (bf16_t)(u >> 16); }
DI float bf2f(bf16_t v) { return __uint_as_float(((unsigned)v) << 16); }
DI unsigned pack2(float a, float b) { return (unsigned)f2bf(a) | ((unsigned)f2bf(b) << 16); }
using u32x4 = __attribute__((ext_vector_type(4))) unsigned;
using u32x2 = __attribute__((ext_vector_type(2))) unsigned;
DI bf16x8 pack8(f32x4 a, f32x4 b) {
  u32x4 t; t[0] = pack2(a[0], a[1]); t[1] = pack2(a[2], a[3]); t[2] = pack2(b[0], b[1]); t[3] = pack2(b[2], b[3]);
  return __builtin_bit_cast(bf16x8, t);
}
#define MFMA16(a, b, c) __builtin_amdgcn_mfma_f32_16x16x32_bf16((a), (b), (c), 0, 0, 0)
DI int kperm(int x) { return (x & ~31) | (((x >> 2) & 3) * 8 + ((x >> 4) & 1) * 4 + (x & 3)); }
DI float wave_sum(float v) { for (int o = 32; o > 0; o >>= 1) v += __shfl_xor(v, o); return v; }
DI float wave_max(float v) { for (int o = 32; o > 0; o >>= 1) v = fmaxf(v, __shfl_xor(v, o)); return v; }
DI float sigmoidf_(float x) { return 1.f / (1.f + __expf(-x)); }
DI float siluf_(float x) { return x * sigmoidf_(x); }
DI float softplusf_(float x) { return fmaxf(x, 0.f) + log1pf(__expf(-fabsf(x))); }
DI float gelu_tanh(float x) { float u = 0.7978845608028654f * (x + 0.044715f * x * x * x); return 0.5f * x * (1.f + tanhf(u)); }

template <class CM>
DI void transpose_job(bf16_t* dst, int Ndst, int K, int srcStride, CM colptr, float* tile) {
  const int ntk = K / 64, ntiles = (Ndst / 64) * ntk;
  const int tid = TID();
  for (int tl = BID(); tl < ntiles; tl += GDIM()) {
    const int r0 = (tl / ntk) * 64, k0 = (tl % ntk) * 64;
    const int q4 = tid & 15, kl0 = tid >> 4;
    const float* cp = colptr(r0 + 4 * q4);
    float4 v[4];
#pragma unroll
    for (int i = 0; i < 4; ++i) v[i] = cp ? *(const float4*)(cp + (size_t)(k0 + kl0 + 16 * i) * srcStride) : make_float4(0.f, 0.f, 0.f, 0.f);
#pragma unroll
    for (int i = 0; i < 4; ++i) {
      float* t = tile + (kl0 + 16 * i) * 65 + 4 * q4;
      t[0] = v[i].x; t[1] = v[i].y; t[2] = v[i].z; t[3] = v[i].w;
    }
    __syncthreads();
#pragma unroll
    for (int i = 0; i < 2; ++i) {
      const int c = tid + 256 * i, rr = c >> 3, kc = (c & 7) * 8;
      const float* t = tile + kc * 65 + rr;
      uint4 o;
      o.x = pack2(t[0], t[65]); o.y = pack2(t[2 * 65], t[3 * 65]); o.z = pack2(t[4 * 65], t[5 * 65]); o.w = pack2(t[6 * 65], t[7 * 65]);
      *(uint4*)(dst + (size_t)(r0 + rr) * K + k0 + kc) = o;
    }
    __syncthreads();
  }
}

DI void phase_prologue(const Params& p, float* smem) {
  bf16_t* W = (bf16_t*)(p.ws + OFF_W);
  for (int l = 0; l < 4; ++l) {
    bf16_t* wc = W + (size_t)l * SZ_COMMON;
    const float* s;
    s = p.xq_w + (size_t)l * SZ_SQ; transpose_job(wc, 1024, 1024, 1024, [=](int r) { return s + r; }, smem);
    s = p.xk_w + (size_t)l * SZ_SQ; transpose_job(wc + SZ_SQ, 1024, 1024, 1024, [=](int r) { return s + r; }, smem);
    s = p.xv_w + (size_t)l * SZ_SQ; transpose_job(wc + 2 * SZ_SQ, 1024, 1024, 1024, [=](int r) { return s + r; }, smem);
    s = p.xo_w + (size_t)l * SZ_SQ; transpose_job(wc + 3 * SZ_SQ, 1024, 1024, 1024, [=](int r) { return s + r; }, smem);
    {
      const float* g = p.ffn_wg + (size_t)l * 1024 * 2816; const float* u = p.ffn_wu + (size_t)l * 1024 * 2816;
      transpose_job(wc + 4 * SZ_SQ, 5632, 1024, 2816, [=](int r) { int c = (r >> 5) * 16 + (r & 15); return ((r >> 4) & 1) ? (u + c) : (g + c); }, smem);
    }
    s = p.ffn_wd + (size_t)l * 2816 * 1024; transpose_job(wc + 4 * SZ_SQ + SZ_GU, 1024, 2816, 1024, [=](int r) { return s + r; }, smem);
  }
  for (int i = 0; i < 2; ++i) {
    bf16_t* we = W + W_EVEN0 + (size_t)i * (SZ_WIN + SZ_SQ);
    const float* s = p.hyb_w_in + (size_t)i * 1024 * 3592;
    transpose_job(we, 3712, 1024, 3592, [=](int r) -> const float* {
      if (r < 2048) return s + r;
      if (r < 3584) return s + r + 8;
      if (r < 3592) return s + 2048 + (r - 3584);
      return nullptr; }, smem);
    const float* s2 = p.hyb_w_out + (size_t)i * SZ_SQ;
    transpose_job(we + SZ_WIN, 1024, 1024, 1024, [=](int r) { return s2 + r; }, smem);
    bf16_t* wo = W + W_ODD0 + (size_t)i * SZ_GLU;
    const float* a = p.s5_glu_wo + (size_t)i * SZ_SQ; const float* b = p.s5_glu_wg + (size_t)i * SZ_SQ;
    transpose_job(wo, 2048, 1024, 1024, [=](int r) { int c = (r >> 5) * 16 + (r & 15); return ((r >> 4) & 1) ? (b + c) : (a + c); }, smem);
  }
  const size_t gtid = (size_t)BID() * 256 + TID(), gsz = (size_t)GDIM() * 256;
  bf16_t* hb = (bf16_t*)(p.ws + OFF_HB);
  for (size_t i = gtid; i < (size_t)T_ * 256; i += gsz) {
    float4 v = ((const float4*)p.x)[i];
    ((float4*)p.out)[i] = v;
    uint2 o; o.x = pack2(v.x, v.y); o.y = pack2(v.z, v.w);
    ((uint2*)hb)[i] = o;
  }
  float* rc = (float*)(p.ws + OFF_ROPE); float* rs = rc + (size_t)T_ * 32;
  for (size_t i = gtid; i < (size_t)T_ * 32; i += gsz) {
    int t = (int)(i >> 5), j = (int)(i & 31);
    float invf = (float)exp(-(double)(2 * j) / 64.0 * 9.210340371976184);
    float ang = (float)p.pos[t] * invf;
    double a = (double)ang;
    double k = rint(a * 0.15915494309189535);
    float r = (float)(a - k * 6.283185307179586);
    rc[i] = cosf(r); rs[i] = sinf(r);
  }
}

constexpr int LDT = 72;
template <class AL, class BL, class EP>
DI void gemm_tile(int m0, int n0, int nks, AL aload, BL bload, EP epi, bf16_t* smem) {
  bf16_t* As = smem; bf16_t* Bs = smem + 2 * 128 * LDT;
  const int tid = TID(), lane = tid & 63, wave = tid >> 6;
  const int wm = wave >> 1, wn = wave & 1, l15 = lane & 15, quad = lane >> 4;
  const int lrow = tid >> 3, lkc = (tid & 7) * 8;
  f32x4 acc[4][4];
#pragma unroll
  for (int i = 0; i < 4; ++i)
#pragma unroll
    for (int j = 0; j < 4; ++j) acc[i][j] = f32x4{0.f, 0.f, 0.f, 0.f};
  uint4 ra0[4], rb0[4], ra1[4], rb1[4];
#pragma unroll
  for (int i = 0; i < 4; ++i) { ra0[i] = aload(m0 + lrow + 32 * i, 0, lkc); rb0[i] = bload(n0 + lrow + 32 * i, 0, lkc); }
#pragma unroll
  for (int i = 0; i < 4; ++i) { ra1[i] = aload(m0 + lrow + 32 * i, 1, lkc); rb1[i] = bload(n0 + lrow + 32 * i, 1, lkc); }
#pragma unroll
  for (int i = 0; i < 4; ++i) {
    *(uint4*)(As + (lrow + 32 * i) * LDT + lkc) = ra0[i];
    *(uint4*)(Bs + (lrow + 32 * i) * LDT + lkc) = rb0[i];
  }
  __syncthreads();
  auto compute = [&](int cur) {
    const bf16_t* Ab = As + cur * 128 * LDT; const bf16_t* Bb = Bs + cur * 128 * LDT;
#pragma unroll
    for (int kk = 0; kk < 2; ++kk) {
      bf16x8 a[4], b[4];
#pragma unroll
      for (int mt = 0; mt < 4; ++mt) a[mt] = *(const bf16x8*)(Ab + (wm * 64 + mt * 16 + l15) * LDT + kk * 32 + quad * 8);
#pragma unroll
      for (int nt = 0; nt < 4; ++nt) b[nt] = *(const bf16x8*)(Bb + (wn * 64 + nt * 16 + l15) * LDT + kk * 32 + quad * 8);
#pragma unroll
      for (int mt = 0; mt < 4; ++mt)
#pragma unroll
        for (int nt = 0; nt < 4; ++nt) acc[mt][nt] = __builtin_amdgcn_mfma_f32_16x16x32_bf16(b[nt], a[mt], acc[mt][nt], 0, 0, 0);
    }
  };
  for (int ks = 0; ks < nks; ks += 2) {
    if (ks + 2 < nks) {
#pragma unroll
      for (int i = 0; i < 4; ++i) { ra0[i] = aload(m0 + lrow + 32 * i, ks + 2, lkc); rb0[i] = bload(n0 + lrow + 32 * i, ks + 2, lkc); }
    }
    compute(0);
#pragma unroll
    for (int i = 0; i < 4; ++i) {
      *(uint4*)(As + 128 * LDT + (lrow + 32 * i) * LDT + lkc) = ra1[i];
      *(uint4*)(Bs + 128 * LDT + (lrow + 32 * i) * LDT + lkc) = rb1[i];
    }
    __syncthreads();
    if (ks + 3 < nks) {
#pragma unroll
      for (int i = 0; i < 4; ++i) { ra1[i] = aload(m0 + lrow + 32 * i, ks + 3, lkc); rb1[i] = bload(n0 + lrow + 32 * i, ks + 3, lkc); }
    }
    compute(1);
    if (ks + 2 < nks) {
#pragma unroll
      for (int i = 0; i < 4; ++i) {
        *(uint4*)(As + (lrow + 32 * i) * LDT + lkc) = ra0[i];
        *(uint4*)(Bs + (lrow + 32 * i) * LDT + lkc) = rb0[i];
      }
    }
    __syncthreads();
  }
  epi(acc, m0 + wm * 64, n0 + wn * 64);
}

template <class F>
DI void for_tiles(int mtiles, int ntiles, F f) {
  const int xcd = BID() & 7, slot = BID() >> 3, nslot = GDIM() >> 3;
  const int per = (mtiles >> 3) * ntiles;
  for (int w = slot; w < per; w += nslot) {
    int mi = w / ntiles, ni = w - mi * ntiles;
    f((mi * 8 + xcd), ni);
  }
}

#define EPI_LOOP for (int mt = 0; mt < 4; ++mt) for (int nt = 0; nt < 4; ++nt) for (int r = 0; r < 4; ++r)

DI void epi_resid(const Params& p, f32x4 (&acc)[4][4], int rb, int cb) {
  const int lane = TID() & 63, l15 = lane & 15, quad = lane >> 4;
#pragma unroll
  for (int mt = 0; mt < 4; ++mt)
#pragma unroll
    for (int nt = 0; nt < 4; ++nt) {
      float4* ptr = (float4*)(p.out + (size_t)(rb + mt * 16 + l15) * 1024 + cb + nt * 16 + quad * 4);
      float4 h = *ptr;
      h.x = ALPHA * h.x + acc[mt][nt][0]; h.y = ALPHA * h.y + acc[mt][nt][1]; h.z = ALPHA * h.z + acc[mt][nt][2]; h.w = ALPHA * h.w + acc[mt][nt][3];
      *ptr = h;
    }
}
DI void epi_bf16(bf16_t* dst, int ld, f32x4 (&acc)[4][4], int rb, int cb) {
  const int lane = TID() & 63, l15 = lane & 15, quad = lane >> 4;
#pragma unroll
  for (int mt = 0; mt < 4; ++mt)
#pragma unroll
    for (int nt = 0; nt < 4; ++nt) {
      u32x2 v; v[0] = pack2(acc[mt][nt][0], acc[mt][nt][1]); v[1] = pack2(acc[mt][nt][2], acc[mt][nt][3]);
      *(u32x2*)(dst + (size_t)(rb + mt * 16 + l15) * ld + cb + nt * 16 + quad * 4) = v;
    }
}

struct PlainLoad {
  const bf16_t* base; int ld;
  DI uint4 operator()(int row, int ks, int kc) const { return *(const uint4*)((const char*)base + (unsigned)((row * ld + ks * 64 + kc) * 2)); }
};

DI void phase_proj(const Params& p, int i, bf16_t* smem) {
  const bf16_t* W = (const bf16_t*)(p.ws + OFF_W) + W_EVEN0 + (size_t)i * (SZ_WIN + SZ_SQ);
  PlainLoad al{(const bf16_t*)(p.ws + OFF_HB), 1024}, bl{W, 1024};
  bf16_t* dnqkv = (bf16_t*)(p.ws + OFF_DNQKV); bf16_t* z = (bf16_t*)(p.ws + OFF_Z);
  bf16_t* swq = (bf16_t*)(p.ws + OFF_SWQ); bf16_t* swk = (bf16_t*)(p.ws + OFF_SWK); bf16_t* swv = (bf16_t*)(p.ws + OFF_SWV);
  float* logit = (float*)(p.ws + OFF_LOGIT);
  const float* rc = (const float*)(p.ws + OFF_ROPE); const float* rs = rc + (size_t)T_ * 32;
  for_tiles(256, 29, [&](int mi, int ni) {
    gemm_tile(mi * 128, ni * 128, 16, al, bl, [&](f32x4 (&acc)[4][4], int rb, int cb) {
      const int lane = TID() & 63, l15 = lane & 15, quad = lane >> 4;
      if (cb < 1536) epi_bf16(dnqkv, 1536, acc, rb, cb);
      else if (cb < 2048) epi_bf16(z, 512, acc, rb, cb - 1536);
      else if (cb < 3072) {
        bf16_t* dst = (cb < 2560) ? swq : swk; const int c0 = (cb < 2560) ? cb - 2048 : cb - 2560;
#pragma unroll
        for (int mt = 0; mt < 4; ++mt) {
          const int row = rb + mt * 16 + l15;
#pragma unroll
          for (int nt = 0; nt < 2; ++nt) {
            const int d = nt * 16 + quad * 4;
            const float4 c = *(const float4*)(rc + (size_t)row * 32 + d), sn = *(const float4*)(rs + (size_t)row * 32 + d);
            const f32x4 x1 = acc[mt][nt], x2 = acc[mt][nt + 2];
            u32x2 o1, o2;
            o1[0] = pack2(x1[0] * c.x - x2[0] * sn.x, x1[1] * c.y - x2[1] * sn.y); o1[1] = pack2(x1[2] * c.z - x2[2] * sn.z, x1[3] * c.w - x2[3] * sn.w);
            o2[0] = pack2(x2[0] * c.x + x1[0] * sn.x, x2[1] * c.y + x1[1] * sn.y); o2[1] = pack2(x2[2] * c.z + x1[2] * sn.z, x2[3] * c.w + x1[3] * sn.w);
            *(u32x2*)(dst + (size_t)row * 512 + c0 + d) = o1;
            *(u32x2*)(dst + (size_t)row * 512 + c0 + d + 32) = o2;
          }
        }
      } else if (cb < 3584) epi_bf16(swv, 512, acc, rb, cb - 3072);
      else if (cb == 3584) {
        if (quad < 2) {
#pragma unroll
          for (int mt = 0; mt < 4; ++mt)
            *(float4*)(logit + (size_t)(rb + mt * 16 + l15) * 8 + quad * 4) = make_float4(acc[mt][0][0], acc[mt][0][1], acc[mt][0][2], acc[mt][0][3]);
        }
      }
    }, smem);
  });
}

DI void phase_dil_attn(const Params& p, int first, int nblk);

DI void phase_dn_prep(const Params& p, int i, char* smem) {
  bf16_t* qs = (bf16_t*)smem; bf16_t* ks = qs + 64 * 136; bf16_t* vs = ks + 64 * 136;
  float* Lm = (float*)(smem + 3 * 17408); float* beta = Lm + 64 * 68; float* gcum = beta + 64; float* egc = gcum + 64;
  const bf16_t* dnqkv = (const bf16_t*)(p.ws + OFF_DNQKV);
  const float* logit = (const float*)(p.ws + OFF_LOGIT);
  bf16_t* qd_g = (bf16_t*)(p.ws + OFF_QD); bf16_t* kd_g = (bf16_t*)(p.ws + OFF_KD); bf16_t* in_g = (bf16_t*)(p.ws + OFF_INTRA);
  bf16_t* w_g = (bf16_t*)(p.ws + OFF_WB); bf16_t* u_g = (bf16_t*)(p.ws + OFF_UB); float* eg_g = (float*)(p.ws + OFF_EG);
  const float* cw = p.dn_conv_w + (size_t)i * 4 * 1536;
  const int tid = TID(), wave = tid >> 6, lane = tid & 63, l15 = lane & 15, quad = lane >> 4;
  const float QS = 0.08838834764831845f;
  for (int item = BID(); item < 2048; item += GDIM()) {
    const int b = item >> 8, h = (item >> 6) & 3, n = item & 63;
    const int t0 = b * 4096 + n * 64, s0 = n * 64;
    const float A = __expf(p.dn_a_log[i * 4 + h]), dtb = p.dn_dt_bias[i * 4 + h];
    {
      float cw0[3][4], cw1[3][4], x0[3][4], x1[3][4];
#pragma unroll
      for (int which = 0; which < 3; ++which)
#pragma unroll
        for (int j = 0; j < 4; ++j) {
          const int col = which * 512 + h * 128 + lane * 2;
          cw0[which][j] = cw[j * 1536 + col]; cw1[which][j] = cw[j * 1536 + col + 1];
        }
      const int ilb = wave * 16;
#pragma unroll
      for (int which = 0; which < 3; ++which)
#pragma unroll
        for (int j = 0; j < 3; ++j) {
          const int sq = s0 + ilb - 3 + j;
          unsigned v = 0u;
          if (sq >= 0) v = *(const unsigned*)(dnqkv + (size_t)(t0 + ilb - 3 + j) * 1536 + which * 512 + h * 128 + lane * 2);
          x0[which][j + 1] = bf2f((bf16_t)(v & 0xffff)); x1[which][j + 1] = bf2f((bf16_t)(v >> 16));
        }
#pragma unroll 4
      for (int tt = 0; tt < 16; ++tt) {
        const int il = ilb + tt;
#pragma unroll
        for (int which = 0; which < 3; ++which) {
          x0[which][0] = x0[which][1]; x0[which][1] = x0[which][2]; x0[which][2] = x0[which][3];
          x1[which][0] = x1[which][1]; x1[which][1] = x1[which][2]; x1[which][2] = x1[which][3];
          const unsigned v = *(const unsigned*)(dnqkv + (size_t)(t0 + il) * 1536 + which * 512 + h * 128 + lane * 2);
          x0[which][3] = bf2f((bf16_t)(v & 0xffff)); x1[which][3] = bf2f((bf16_t)(v >> 16));
          float y0 = cw0[which][0] * x0[which][0] + cw0[which][1] * x0[which][1] + cw0[which][2] * x0[which][2] + cw0[which][3] * x0[which][3];
          float y1 = cw1[which][0] * x1[which][0] + cw1[which][1] * x1[which][1] + cw1[which][2] * x1[which][2] + cw1[which][3] * x1[which][3];
          y0 = siluf_(y0); y1 = siluf_(y1);
          if (which < 2) {
            float ss = wave_sum(y0 * y0 + y1 * y1);
            float sc = rsqrtf(ss + 1e-6f);
            y0 *= sc; y1 *= sc;
          }
          bf16_t* dst = (which == 0) ? qs : (which == 1 ? ks : vs);
          *(unsigned*)(dst + il * 136 + lane * 2) = pack2(y0, y1);
        }
      }
    }
    if (wave == 0) {
      const size_t row = (size_t)(t0 + lane);
      const float bl = logit[row * 8 + h], al = logit[row * 8 + 4 + h];
      float g = -A * softplusf_(al + dtb);
#pragma unroll
      for (int o = 1; o < 64; o <<= 1) { float v = __shfl_up(g, o); if (lane >= o) g += v; }
      beta[lane] = sigmoidf_(bl); gcum[lane] = g; egc[lane] = __expf(g);
    }
    __syncthreads();
    {
      f32x4 kk[4], qk[4];
#pragma unroll
      for (int nt = 0; nt < 4; ++nt) { kk[nt] = f32x4{0.f, 0.f, 0.f, 0.f}; qk[nt] = f32x4{0.f, 0.f, 0.f, 0.f}; }
#pragma unroll
      for (int k4 = 0; k4 < 4; ++k4) {
        const bf16x8 ak = *(const bf16x8*)(ks + (wave * 16 + l15) * 136 + k4 * 32 + quad * 8);
        const bf16x8 aq = *(const bf16x8*)(qs + (wave * 16 + l15) * 136 + k4 * 32 + quad * 8);
#pragma unroll
        for (int nt = 0; nt < 4; ++nt) {
          const bf16x8 bk = *(const bf16x8*)(ks + (nt * 16 + l15) * 136 + k4 * 32 + quad * 8);
          kk[nt] = MFMA16(ak, bk, kk[nt]); qk[nt] = MFMA16(aq, bk, qk[nt]);
        }
      }
#pragma unroll
      for (int nt = 0; nt < 4; ++nt)
#pragma unroll
        for (int r = 0; r < 4; ++r) {
          const int ii = wave * 16 + quad * 4 + r, jj = nt * 16 + l15;
          const float dec = (jj <= ii) ? __expf(gcum[ii] - gcum[jj]) : 0.f;
          Lm[ii * 68 + jj] = (jj < ii) ? beta[ii] * kk[nt][r] * dec : 0.f;
          in_g[(size_t)item * 4096 + ii * 64 + kperm(jj)] = f2bf(qk[nt][r] * QS * dec);
        }
    }
    __syncthreads();
    {
      float x[64];
#pragma unroll
      for (int ii = 0; ii < 64; ++ii) x[ii] = 0.f;
      const int c = tid & 127;
      const bool isw = tid >= 128;
      bf16_t* dstb = (isw ? w_g : u_g) + (size_t)item * 8192 + (isw ? kperm(c) : c);
      const bf16_t* srcb = (isw ? ks : vs) + c;
#pragma unroll
      for (int ii = 0; ii < 64; ++ii) {
        float acc = bf2f(srcb[ii * 136]) * beta[ii] * (isw ? egc[ii] : 1.f);
#pragma unroll
        for (int j4 = 0; j4 < (ii + 3) / 4; ++j4) {
          const float4 l4 = *(const float4*)(Lm + ii * 68 + j4 * 4);
          acc -= l4.x * x[j4 * 4]; acc -= l4.y * x[j4 * 4 + 1]; acc -= l4.z * x[j4 * 4 + 2]; acc -= l4.w * x[j4 * 4 + 3];
        }
        x[ii] = acc;
        dstb[ii * 128] = f2bf(acc);
        if ((ii & 3) == 3) __builtin_amdgcn_sched_barrier(0);
      }
    }
    {
      const float gl = gcum[63];
#pragma unroll 4
      for (int k = 0; k < 32; ++k) {
        const int e = tid + 256 * k;
        const int ii = e >> 7, d = e & 127;
        qd_g[(size_t)item * 8192 + ii * 128 + kperm(d)] = f2bf(bf2f(qs[ii * 136 + d]) * QS * egc[ii]);
        const int d2 = e >> 6, i2 = e & 63;
        kd_g[(size_t)item * 8192 + d2 * 64 + kperm(i2)] = f2bf(bf2f(ks[i2 * 136 + d2]) * __expf(gl - gcum[i2]));
      }
      if (tid == 0) eg_g[item] = __expf(gl);
    }
    __syncthreads();
  }
}

DI bf16x8 ld2(const bf16_t* ptr) {
  u32x2 lo = *(const u32x2*)ptr, hi = *(const u32x2*)(ptr + 16);
  u32x4 t; t[0] = lo[0]; t[1] = lo[1]; t[2] = hi[0]; t[3] = hi[1];
  return __builtin_bit_cast(bf16x8, t);
}

DI void dn_chain_item(const Params& p, int item, bf16_t* smem) {
  const int tid = TID(), wave = tid >> 6, lane = tid & 63, l15 = lane & 15, quad = lane >> 4;
  const int bh = item >> 1, half = item & 1;
  const int e0 = half * 64 + wave * 16 + l15;
  const bf16_t* qd_g = (const bf16_t*)(p.ws + OFF_QD); const bf16_t* kd_g = (const bf16_t*)(p.ws + OFF_KD); const bf16_t* in_g = (const bf16_t*)(p.ws + OFF_INTRA);
  const bf16_t* w_g = (const bf16_t*)(p.ws + OFF_WB); bf16_t* u_g = (bf16_t*)(p.ws + OFF_UB); const float* eg_g = (const float*)(p.ws + OFF_EG);
  bf16_t* wl = smem; bf16_t* ql = wl + 64 * 136; bf16_t* kl = ql + 64 * 136; bf16_t* il = kl + 128 * 72; bf16_t* ul = il + 64 * 72;
  uint4 rw0, rw1, rw2, rw3, rq0, rq1, rq2, rq3, rk0, rk1, rk2, rk3, ri0, ri1, ru0, ru1;
#define CH_GLOAD(n_) do { const size_t ci_ = (size_t)bh * 64 + (n_); \
    const bf16_t* w_ = w_g + ci_ * 8192 + tid * 8; const bf16_t* q_ = qd_g + ci_ * 8192 + tid * 8; const bf16_t* k_ = kd_g + ci_ * 8192 + tid * 8; \
    rw0 = *(const uint4*)(w_); rw1 = *(const uint4*)(w_ + 2048); rw2 = *(const uint4*)(w_ + 4096); rw3 = *(const uint4*)(w_ + 6144); \
    rq0 = *(const uint4*)(q_); rq1 = *(const uint4*)(q_ + 2048); rq2 = *(const uint4*)(q_ + 4096); rq3 = *(const uint4*)(q_ + 6144); \
    rk0 = *(const uint4*)(k_); rk1 = *(const uint4*)(k_ + 2048); rk2 = *(const uint4*)(k_ + 4096); rk3 = *(const uint4*)(k_ + 6144); \
    ri0 = *(const uint4*)(in_g + ci_ * 4096 + tid * 8); ri1 = *(const uint4*)(in_g + ci_ * 4096 + 2048 + tid * 8); \
    ru0 = *(const uint4*)(u_g + ci_ * 8192 + (tid >> 3) * 128 + half * 64 + (tid & 7) * 8); \
    ru1 = *(const uint4*)(u_g + ci_ * 8192 + (32 + (tid >> 3)) * 128 + half * 64 + (tid & 7) * 8); } while (0)
#define CH_LSTORE() do { \
    bf16_t* w_ = wl + (tid >> 4) * 136 + (tid & 15) * 8; bf16_t* q_ = ql + (tid >> 4) * 136 + (tid & 15) * 8; bf16_t* k_ = kl + (tid >> 3) * 72 + (tid & 7) * 8; \
    *(uint4*)(w_) = rw0; *(uint4*)(w_ + 16 * 136) = rw1; *(uint4*)(w_ + 32 * 136) = rw2; *(uint4*)(w_ + 48 * 136) = rw3; \
    *(uint4*)(q_) = rq0; *(uint4*)(q_ + 16 * 136) = rq1; *(uint4*)(q_ + 32 * 136) = rq2; *(uint4*)(q_ + 48 * 136) = rq3; \
    *(uint4*)(k_) = rk0; *(uint4*)(k_ + 32 * 72) = rk1; *(uint4*)(k_ + 64 * 72) = rk2; *(uint4*)(k_ + 96 * 72) = rk3; \
    *(uint4*)(il + (tid >> 3) * 72 + (tid & 7) * 8) = ri0; *(uint4*)(il + (32 + (tid >> 3)) * 72 + (tid & 7) * 8) = ri1; \
    *(uint4*)(ul + (tid >> 3) * 72 + (tid & 7) * 8) = ru0; *(uint4*)(ul + (32 + (tid >> 3)) * 72 + (tid & 7) * 8) = ru1; } while (0)
  f32x4 S[8];
#pragma unroll
  for (int mt = 0; mt < 8; ++mt) S[mt] = f32x4{0.f, 0.f, 0.f, 0.f};
  CH_GLOAD(0);
  CH_LSTORE();
  __syncthreads();
#pragma unroll 1
  for (int n = 0; n < 64; ++n) {
    const size_t ci = (size_t)bh * 64 + n;
    if (n + 1 < 64) CH_GLOAD(n + 1);
    bf16_t* ub = u_g + ci * 8192;
    const float eg = eg_g[ci];
    bf16x8 sb[4];
#pragma unroll
    for (int s = 0; s < 4; ++s) sb[s] = pack8(S[2 * s], S[2 * s + 1]);
    f32x4 vn[4];
#pragma unroll
    for (int it = 0; it < 4; ++it) {
      f32x4 a = {0.f, 0.f, 0.f, 0.f};
#pragma unroll
      for (int s = 0; s < 4; ++s) a = MFMA16(*(const bf16x8*)(wl + (it * 16 + l15) * 136 + s * 32 + quad * 8), sb[s], a);
#pragma unroll
      for (int r = 0; r < 4; ++r) vn[it][r] = bf2f(ul[(it * 16 + quad * 4 + r) * 72 + wave * 16 + l15]) - a[r];
    }
    bf16x8 vb[2];
    vb[0] = pack8(vn[0], vn[1]); vb[1] = pack8(vn[2], vn[3]);
#pragma unroll
    for (int it = 0; it < 4; ++it) {
      f32x4 a = {0.f, 0.f, 0.f, 0.f};
#pragma unroll
      for (int s = 0; s < 4; ++s) a = MFMA16(*(const bf16x8*)(ql + (it * 16 + l15) * 136 + s * 32 + quad * 8), sb[s], a);
#pragma unroll
      for (int s = 0; s < 2; ++s) a = MFMA16(*(const bf16x8*)(il + (it * 16 + l15) * 72 + s * 32 + quad * 8), vb[s], a);
#pragma unroll
      for (int r = 0; r < 4; ++r) ub[(it * 16 + quad * 4 + r) * 128 + e0] = f2bf(a[r]);
    }
#pragma unroll
    for (int mt = 0; mt < 8; ++mt) {
      f32x4 a = S[mt];
      a[0] *= eg; a[1] *= eg; a[2] *= eg; a[3] *= eg;
#pragma unroll
      for (int s = 0; s < 2; ++s) a = MFMA16(*(const bf16x8*)(kl + (mt * 16 + l15) * 72 + s * 32 + quad * 8), vb[s], a);
      S[mt] = a;
    }
    __syncthreads();
    if (n + 1 < 64) CH_LSTORE();
    __syncthreads();
  }
}

DI void phase_mix(const Params& p, int i, bf16_t* smem) {
  if (BID() < 64) { dn_chain_item(p, BID(), smem); return; }
  phase_dil_attn(p, BID() - 64, GDIM() - 64);
}

DI void phase_dn_post(const Params& p, int i) {
  const bf16_t* ob = (const bf16_t*)(p.ws + OFF_UB);
  bf16_t* z = (bf16_t*)(p.ws + OFF_Z);
  const float* ng = p.dn_norm_g + i * 128;
  const int wave = TID() >> 6, lane = TID() & 63;
  const int N = T_ * 4;
  for (int base = BID() * 4; base < N; base += GDIM() * 4) {
    const int item = base + wave;
    const int t = item >> 2, h = item & 3, b = t >> 12, sidx = t & 4095;
    const size_t g = (size_t)item * 128 + lane * 2;
    const size_t og = ((size_t)((b * 4 + h) * 64 + (sidx >> 6))) * 8192 + (sidx & 63) * 128 + lane * 2;
    unsigned ov = *(const unsigned*)(ob + og), zv = *(const unsigned*)(z + g);
    float o0 = bf2f((bf16_t)(ov & 0xffff)), o1 = bf2f((bf16_t)(ov >> 16));
    float z0 = bf2f((bf16_t)(zv & 0xffff)), z1 = bf2f((bf16_t)(zv >> 16));
    float ms = wave_sum(o0 * o0 + o1 * o1) * (1.f / 128.f);
    float rr = rsqrtf(ms + 1e-6f);
    float r0 = o0 * rr * ng[lane * 2] * siluf_(z0), r1 = o1 * rr * ng[lane * 2 + 1] * siluf_(z1);
    *(unsigned*)(z + g) = pack2(r0, r1);
  }
}

struct MixLoad {
  const bf16_t* a; const bf16_t* b;
  DI uint4 operator()(int row, int ks, int kc) const {
    const unsigned off = (unsigned)((row * 512 + (ks & 7) * 64 + kc) * 2);
    return *(const uint4*)((const char*)((ks < 8) ? a : b) + off);
  }
};

DI void phase_wout(const Params& p, int i, bf16_t* smem) {
  const bf16_t* W = (const bf16_t*)(p.ws + OFF_W) + W_EVEN0 + (size_t)i * (SZ_WIN + SZ_SQ) + SZ_WIN;
  MixLoad al{(const bf16_t*)(p.ws + OFF_Z), (const bf16_t*)(p.ws + OFF_SWQ)};
  PlainLoad bl{W, 1024};
  for_tiles(256, 8, [&](int mi, int ni) {
    gemm_tile(mi * 128, ni * 128, 16, al, bl, [&](f32x4 (&acc)[4][4], int rb, int cb) { epi_resid(p, acc, rb, cb); }, smem);
  });
}

DI void phase_ln(const Params& p, const float* g, const float* b) {
  const int wave = TID() >> 6, lane = TID() & 63;
  bf16_t* hb = (bf16_t*)(p.ws + OFF_HB);
  for (int row = BID() * 4 + wave; row < T_; row += GDIM() * 4) {
    float4* y = (float4*)(p.out + (size_t)row * 1024);
    float4 v[4];
    float s = 0.f;
#pragma unroll
    for (int i = 0; i < 4; ++i) { v[i] = y[lane + 64 * i]; s += v[i].x + v[i].y + v[i].z + v[i].w; }
    const float mu = wave_sum(s) * (1.f / 1024.f);
    float q = 0.f;
#pragma unroll
    for (int i = 0; i < 4; ++i) { float a = v[i].x - mu, b2 = v[i].y - mu, c = v[i].z - mu, d = v[i].w - mu; q += a * a + b2 * b2 + c * c + d * d; }
    const float rstd = rsqrtf(wave_sum(q) * (1.f / 1024.f) + 1e-5f);
#pragma unroll
    for (int i = 0; i < 4; ++i) {
      float4 gg = ((const float4*)g)[lane + 64 * i], bb = ((const float4*)b)[lane + 64 * i];
      float4 o;
      o.x = (v[i].x - mu) * rstd * gg.x + bb.x; o.y = (v[i].y - mu) * rstd * gg.y + bb.y;
      o.z = (v[i].z - mu) * rstd * gg.z + bb.z; o.w = (v[i].w - mu) * rstd * gg.w + bb.w;
      y[lane + 64 * i] = o;
      uint2 ob; ob.x = pack2(o.x, o.y); ob.y = pack2(o.z, o.w);
      ((uint2*)(hb + (size_t)row * 1024))[lane + 64 * i] = ob;
    }
  }
}

DI void phase_s5_naive(const Params& p, int i) {
  const int wave = TID() >> 6, lane = TID() & 63;
  bf16_t* hid = (bf16_t*)(p.ws + OFF_HID);
  for (int base = BID() * 4; base < 512; base += GDIM() * 4) {
    const int item = base + wave, b = item >> 6, g = item & 63;
    const int gp = (i * 64 + g) * 64 + lane;
    const double dt = exp((double)p.s5_log_dt[i * 64 + g]);
    const double are = p.s5_a_re[gp], aim = p.s5_a_im[gp];
    const double lr = are * dt, li = aim * dt;
    const double kk = rint(li * 0.15915494309189535);
    const double red = li - kk * 6.283185307179586;
    const double e = exp(lr);
    const double abr = e * cos(red), abi = e * sin(red);
    const double den = are * are + aim * aim;
    const double nr = abr - 1.0, ni = abi;
    const double cfr = (nr * are + ni * aim) / den, cfi = (ni * are - nr * aim) / den;
    float bbr[16], bbi[16], cr[16], ci[16];
#pragma unroll
    for (int h = 0; h < 16; ++h) {
      const double br = p.s5_b_re[(size_t)gp * 16 + h], bi = p.s5_b_im[(size_t)gp * 16 + h];
      bbr[h] = (float)(cfr * br - cfi * bi); bbi[h] = (float)(cfr * bi + cfi * br);
      cr[h] = p.s5_c_re[((size_t)(i * 64 + g) * 16 + h) * 64 + lane];
      ci[h] = p.s5_c_im[((size_t)(i * 64 + g) * 16 + h) * 64 + lane];
    }
    const float ar = (float)abr, ai = (float)abi;
    const float dsk = p.s5_d[i * 1024 + g * 16 + (lane & 15)];
    float sr = 0.f, si = 0.f;
#pragma unroll 1
    for (int t = 0; t < S_; ++t) {
      const size_t row = (size_t)(b * S_ + t);
      const float4* up = (const float4*)(p.out + row * 1024 + g * 16);
      float u[16];
#pragma unroll
      for (int j = 0; j < 4; ++j) { float4 v = up[j]; u[4 * j] = v.x; u[4 * j + 1] = v.y; u[4 * j + 2] = v.z; u[4 * j + 3] = v.w; }
      float bur = 0.f, bui = 0.f;
#pragma unroll
      for (int h = 0; h < 16; ++h) { bur += bbr[h] * u[h]; bui += bbi[h] * u[h]; }
      const float nsr = ar * sr - ai * si + bur, nsi = ar * si + ai * sr + bui;
      sr = nsr; si = nsi;
      float yk = 0.f, uk = 0.f;
#pragma unroll
      for (int h = 0; h < 16; ++h) {
        float v = wave_sum(cr[h] * sr - ci[h] * si);
        if (lane == h) { yk = v; uk = u[h]; }
      }
      if (lane < 16) hid[row * 1024 + g * 16 + lane] = f2bf(gelu_tanh(yk + dsk * uk));
    }
  }
}

DI void phase_s5_tables(const Params& p, int i, float* smem) {
  float2* pw = (float2*)smem;
  float2* bb = pw + 64 * 33;
  float2* cc = bb + 64 * 16;
  bf16_t* Ktab = (bf16_t*)(p.ws + OFF_KTAB); bf16_t* Etab = (bf16_t*)(p.ws + OFF_ETAB); bf16_t* Gtab = (bf16_t*)(p.ws + OFF_GTAB);
  float2* AL = (float2*)(p.ws + OFF_AL);
  const int tid = TID();
  for (int item = BID(); item < 512; item += GDIM()) {
    const int g = item >> 3, part = item & 7;
    const double dt = exp((double)p.s5_log_dt[i * 64 + g]);
    for (int e = tid; e < 64 * 33; e += 256) {
      const int pp = e / 33, n = e - pp * 33;
      const double are = p.s5_a_re[(i * 64 + g) * 64 + pp], aim = p.s5_a_im[(i * 64 + g) * 64 + pp];
      const double lr = are * dt * n, li = aim * dt * n;
      const double k = rint(li * 0.15915494309189535);
      const double red = li - k * 6.283185307179586;
      const double ex = exp(lr);
      pw[e] = make_float2((float)(ex * cos(red)), (float)(ex * sin(red)));
    }
    for (int e = tid; e < 1024; e += 256) {
      const int pp = e >> 4;
      const int gp = (i * 64 + g) * 64 + pp;
      const double are = p.s5_a_re[gp], aim = p.s5_a_im[gp];
      const double lr = are * dt, li = aim * dt;
      const double k = rint(li * 0.15915494309189535);
      const double red = li - k * 6.283185307179586;
      const double ex = exp(lr);
      const double nr = ex * cos(red) - 1.0, ni = ex * sin(red);
      const double den = are * are + aim * aim;
      const double cfr = (nr * are + ni * aim) / den, cfi = (ni * are - nr * aim) / den;
      const double br = p.s5_b_re[(size_t)gp * 16 + (e & 15)], bi = p.s5_b_im[(size_t)gp * 16 + (e & 15)];
      bb[e] = make_float2((float)(cfr * br - cfi * bi), (float)(cfr * bi + cfi * br));
      const size_t ci = ((size_t)(i * 64 + g) * 16 + (e >> 6)) * 64 + (e & 63);
      cc[e] = make_float2(p.s5_c_re[ci], p.s5_c_im[ci]);
    }
    __syncthreads();
    for (int e = part * 1024 + tid; e < (part + 1) * 1024; e += 256) {
      const int tau = e >> 8, ho = (e >> 4) & 15, hi = e & 15;
      float acc = 0.f;
      for (int pp = 0; pp < 64; ++pp) {
        const float2 c = cc[ho * 64 + pp], w = pw[pp * 33 + tau], b = bb[pp * 16 + hi];
        const float cwr = c.x * w.x - c.y * w.y, cwi = c.x * w.y + c.y * w.x;
        acc += cwr * b.x - cwi * b.y;
      }
      Ktab[(size_t)g * 8192 + e] = f2bf(acc);
    }
    for (int e = part * 8192 + tid; e < (part + 1) * 8192; e += 256) {
      const int pc = e >> 9, sidx = (e >> 4) & 31, hi = e & 15, pp = pc & 63;
      const float2 w = pw[pp * 33 + 31 - sidx], b = bb[pp * 16 + hi];
      const float v = (pc < 64) ? (w.x * b.x - w.y * b.y) : (w.x * b.y + w.y * b.x);
      Etab[(size_t)g * 65536 + e] = f2bf(v);
    }
    for (int e = part * 8192 + tid; e < (part + 1) * 8192; e += 256) {
      const int row = e >> 7, pc = e & 127, pp = pc & 63, t = row >> 4, ho = row & 15;
      const float2 c = cc[ho * 64 + pp], w = pw[pp * 33 + t + 1];
      const float v = (pc < 64) ? (c.x * w.x - c.y * w.y) : -(c.x * w.y + c.y * w.x);
      Gtab[(size_t)g * 65536 + e] = f2bf(v);
    }
    if (tid < 64 && part == 0) AL[g * 64 + tid] = pw[tid * 33 + 32];
    __syncthreads();
  }
}

DI void phase_s5_end(const Params& p, bf16_t* smem) {
  const bf16_t* Etab = (const bf16_t*)(p.ws + OFF_ETAB); const bf16_t* hb = (const bf16_t*)(p.ws + OFF_HB);
  const float2* AL = (const float2*)(p.ws + OFF_AL);
  bf16_t* sin_ = (bf16_t*)(p.ws + OFF_SIN);
  float* endbuf = (float*)smem;
  for (int item = BID(); item < 512; item += GDIM()) {
    const int g = item >> 3, b = item & 7;
    auto al = [=](int row, int ks, int kc) { return *(const uint4*)((const char*)Etab + (unsigned)((((g * 128 + row) * 512) + ks * 64 + kc) * 2)); };
    auto bl = [=](int n, int ks, int kc) {
      const int k = ks * 64 + kc, sidx = k >> 4, hi0 = k & 15;
      return *(const uint4*)((const char*)hb + (unsigned)(((b * 4096 + n * 32 + sidx) * 1024 + g * 16 + hi0) * 2));
    };
    gemm_tile(0, 0, 8, al, bl, [&](f32x4 (&acc)[4][4], int rb, int cb) {
      const int lane = TID() & 63, l15 = lane & 15, quad = lane >> 4;
#pragma unroll
      for (int mt = 0; mt < 4; ++mt)
#pragma unroll
        for (int nt = 0; nt < 4; ++nt)
#pragma unroll
          for (int r = 0; r < 4; ++r) endbuf[(rb + mt * 16 + l15) * 129 + cb + nt * 16 + quad * 4 + r] = acc[mt][nt][r];
    }, smem);
    __syncthreads();
    if (TID() < 64) {
      const int pp = TID();
      const float2 a = AL[g * 64 + pp];
      float sr = 0.f, si = 0.f;
      for (int n = 0; n < 128; ++n) {
        bf16_t* dst = sin_ + ((size_t)g * 1024 + b * 128 + n) * 128;
        dst[pp] = f2bf(sr); dst[64 + pp] = f2bf(si);
        const float er = endbuf[pp * 129 + n], ei = endbuf[(64 + pp) * 129 + n];
        const float nr = a.x * sr - a.y * si + er, ni = a.x * si + a.y * sr + ei;
        sr = nr; si = ni;
      }
    }
    __syncthreads();
  }
}

DI void phase_s5_y(const Params& p, int i, bf16_t* smem) {
  const bf16_t* Ktab = (const bf16_t*)(p.ws + OFF_KTAB); const bf16_t* Gtab = (const bf16_t*)(p.ws + OFF_GTAB);
  const bf16_t* hb = (const bf16_t*)(p.ws + OFF_HB); const bf16_t* sin_ = (const bf16_t*)(p.ws + OFF_SIN);
  bf16_t* hid = (bf16_t*)(p.ws + OFF_HID);
  for (int w = BID(); w < 2048; w += GDIM()) {
    const int g = w >> 5, mtile = (w >> 3) & 3, b = w & 7;
    const int nT = mtile * 2 + 2;
    auto al = [=](int row, int ks, int kc) -> uint4 {
      if (ks < nT) {
        const int k = ks * 64 + kc, sidx = k >> 4, hi0 = k & 15, t = row >> 4, ho = row & 15;
        if (t >= sidx) return *(const uint4*)((const char*)Ktab + (unsigned)(((((g * 32 + (t - sidx)) * 16 + ho) * 16) + hi0) * 2));
        return make_uint4(0, 0, 0, 0);
      }
      return *(const uint4*)((const char*)Gtab + (unsigned)((((g * 512 + row) * 128) + (ks - nT) * 64 + kc) * 2));
    };
    auto bl = [=](int n, int ks, int kc) -> uint4 {
      if (ks < nT) {
        const int k = ks * 64 + kc, sidx = k >> 4, hi0 = k & 15;
        return *(const uint4*)((const char*)hb + (unsigned)(((b * 4096 + n * 32 + sidx) * 1024 + g * 16 + hi0) * 2));
      }
      return *(const uint4*)((const char*)sin_ + (unsigned)((((g * 1024 + b * 128 + n) * 128) + (ks - nT) * 64 + kc) * 2));
    };
    gemm_tile(0, mtile * 128, nT + 2, bl, al, [&](f32x4 (&acc)[4][4], int rb, int cb) {
      const int lane = TID() & 63, l15 = lane & 15, quad = lane >> 4;
      const float4 dsk = *(const float4*)(p.s5_d + i * 1024 + g * 16 + quad * 4);
#pragma unroll
      for (int mt = 0; mt < 4; ++mt)
#pragma unroll
        for (int nt = 0; nt < 4; ++nt) {
          const int t = (cb + nt * 16) >> 4, n = rb + mt * 16 + l15;
          const size_t tok = (size_t)b * 4096 + n * 32 + t;
          const float4 u = *(const float4*)(p.out + tok * 1024 + g * 16 + quad * 4);
          u32x2 v;
          v[0] = pack2(gelu_tanh(acc[mt][nt][0] + dsk.x * u.x), gelu_tanh(acc[mt][nt][1] + dsk.y * u.y));
          v[1] = pack2(gelu_tanh(acc[mt][nt][2] + dsk.z * u.z), gelu_tanh(acc[mt][nt][3] + dsk.w * u.w));
          *(u32x2*)(hid + tok * 1024 + g * 16 + quad * 4) = v;
        }
    }, smem);
  }
}

DI void phase_glu(const Params& p, int i, bf16_t* smem) {
  const bf16_t* W = (const bf16_t*)(p.ws + OFF_W) + W_ODD0 + (size_t)i * SZ_GLU;
  PlainLoad al{(const bf16_t*)(p.ws + OFF_HID), 1024}, bl{W, 1024};
  for_tiles(256, 16, [&](int mi, int ni) {
    gemm_tile(mi * 128, ni * 128, 16, al, bl, [&](f32x4 (&acc)[4][4], int rb, int cb) {
      const int lane = TID() & 63, l15 = lane & 15, quad = lane >> 4;
#pragma unroll
      for (int mt = 0; mt < 4; ++mt)
#pragma unroll
        for (int np = 0; np < 2; ++np) {
          float4* ptr = (float4*)(p.out + (size_t)(rb + mt * 16 + l15) * 1024 + (cb >> 1) + np * 16 + quad * 4);
          float4 h = *ptr;
          h.x = ALPHA * h.x + acc[mt][2 * np][0] * sigmoidf_(acc[mt][2 * np + 1][0]);
          h.y = ALPHA * h.y + acc[mt][2 * np][1] * sigmoidf_(acc[mt][2 * np + 1][1]);
          h.z = ALPHA * h.z + acc[mt][2 * np][2] * sigmoidf_(acc[mt][2 * np + 1][2]);
          h.w = ALPHA * h.w + acc[mt][2 * np][3] * sigmoidf_(acc[mt][2 * np + 1][3]);
          *ptr = h;
        }
    }, smem);
  });
}

DI void phase_xproj(const Params& p, int l, bf16_t* smem) {
  const bf16_t* wc = (const bf16_t*)(p.ws + OFF_W) + (size_t)l * SZ_COMMON;
  {
    PlainLoad al{(const bf16_t*)(p.ws + OFF_HB), 1024}, bl{wc, 1024};
    bf16_t* q = (bf16_t*)(p.ws + OFF_XQ);
    for_tiles(256, 8, [&](int mi, int ni) {
      gemm_tile(mi * 128, ni * 128, 16, al, bl, [&](f32x4 (&acc)[4][4], int rb, int cb) { epi_bf16(q, 1024, acc, rb, cb); }, smem);
    });
  }
  {
    const float* memf = p.mem;
    auto al = [=](int row, int ks, int kc) -> uint4 {
      const float4* src = (const float4*)((const char*)memf + (unsigned)((row * 1024 + ks * 64 + kc) * 4));
      float4 a = src[0], b2 = src[1];
      return make_uint4(pack2(a.x, a.y), pack2(a.z, a.w), pack2(b2.x, b2.y), pack2(b2.z, b2.w));
    };
    bf16_t* kx = (bf16_t*)(p.ws + OFF_KX); bf16_t* vx = (bf16_t*)(p.ws + OFF_VX);
    for_tiles(16, 16, [&](int mi, int ni) {
      const bool isv = ni >= 8;
      PlainLoad bl{isv ? (wc + 2 * SZ_SQ) : (wc + SZ_SQ), 1024};
      gemm_tile(mi * 128, (ni & 7) * 128, 16, al, bl, [&](f32x4 (&acc)[4][4], int rb, int cb) {
        if (!isv) { epi_bf16(kx, 1024, acc, rb, cb); return; }
        const int lane = TID() & 63, l15 = lane & 15, quad = lane >> 4;
#pragma unroll
        for (int mt = 0; mt < 4; ++mt)
#pragma unroll
          for (int nt = 0; nt < 4; ++nt) {
            const int row = rb + mt * 16 + l15, col = cb + nt * 16 + quad * 4;
            const int b = row >> 8, key = row & 255, h = col >> 8, d = col & 255;
            bf16_t* dst = vx + ((size_t)((b * 4 + h) * 256 + d)) * 256 + key;
#pragma unroll
            for (int r = 0; r < 4; ++r) dst[r * 256] = f2bf(acc[mt][nt][r]);
          }
      }, smem);
    });
  }
}


DI void phase_xattn(const Params& p) {
  const int wave = TID() >> 6, lane = TID() & 63, l15 = lane & 15, quad = lane >> 4;
  const bf16_t* q = (const bf16_t*)(p.ws + OFF_XQ); const bf16_t* kx = (const bf16_t*)(p.ws + OFF_KX); const bf16_t* vxT = (const bf16_t*)(p.ws + OFF_VX);
  bf16_t* xo = (bf16_t*)(p.ws + OFF_XO);
  for (int item = BID(); item < 2048; item += GDIM()) {
    const int b = item >> 8, h = (item >> 6) & 3, qb = item & 63;
    const size_t tq = (size_t)b * 4096 + qb * 64 + wave * 16 + l15;
    bf16x8 qf[8];
#pragma unroll
    for (int ks = 0; ks < 8; ++ks) qf[ks] = *(const bf16x8*)(q + tq * 1024 + h * 256 + ks * 32 + quad * 8);
    f32x4 s[16];
#pragma unroll
    for (int mt = 0; mt < 16; ++mt) {
      const bf16_t* kp = kx + (size_t)(b * 256 + mt * 16 + l15) * 1024 + h * 256 + quad * 8;
      f32x4 a = {0.f, 0.f, 0.f, 0.f};
#pragma unroll
      for (int ks = 0; ks < 8; ++ks) a = MFMA16(*(const bf16x8*)(kp + ks * 32), qf[ks], a);
      s[mt] = a;
      if (mt & 1) __builtin_amdgcn_sched_barrier(0);
    }
    float m = -1e30f;
#pragma unroll
    for (int mt = 0; mt < 16; ++mt)
#pragma unroll
      for (int r = 0; r < 4; ++r) m = fmaxf(m, s[mt][r]);
    m = fmaxf(m, __shfl_xor(m, 16)); m = fmaxf(m, __shfl_xor(m, 32));
    const float c1 = 0.0625f * 1.4426950408889634f;
    float l = 0.f;
#pragma unroll
    for (int mt = 0; mt < 16; ++mt)
#pragma unroll
      for (int r = 0; r < 4; ++r) { float pv = exp2f((s[mt][r] - m) * c1); s[mt][r] = pv; l += pv; }
    l += __shfl_xor(l, 16); l += __shfl_xor(l, 32);
    f32x4 o[16];
#pragma unroll
    for (int dt = 0; dt < 16; ++dt) o[dt] = f32x4{0.f, 0.f, 0.f, 0.f};
#pragma unroll
    for (int s2 = 0; s2 < 8; ++s2) {
      const bf16x8 pf = pack8(s[2 * s2], s[2 * s2 + 1]);
#pragma unroll
      for (int dt = 0; dt < 16; ++dt) {
        const bf16_t* vp = vxT + ((size_t)((b * 4 + h) * 256 + dt * 16 + l15)) * 256 + s2 * 32 + quad * 4;
        u32x2 lo = *(const u32x2*)vp, hi = *(const u32x2*)(vp + 16);
        u32x4 t; t[0] = lo[0]; t[1] = lo[1]; t[2] = hi[0]; t[3] = hi[1];
        o[dt] = MFMA16(__builtin_bit_cast(bf16x8, t), pf, o[dt]);
      }
      __builtin_amdgcn_sched_barrier(0);
    }
    const float il = 1.f / l;
#pragma unroll
    for (int dt = 0; dt < 16; ++dt) {
      u32x2 v; v[0] = pack2(o[dt][0] * il, o[dt][1] * il); v[1] = pack2(o[dt][2] * il, o[dt][3] * il);
      *(u32x2*)(xo + tq * 1024 + h * 256 + dt * 16 + quad * 4) = v;
    }
  }
}

template <int R, int NT>
DI void dil_branch(const bf16_t* swk, const bf16_t* swv, size_t rowbase, int h, int tok0, const bf16x8 (&qf)[2], float& m, float& l, f32x4 (&o)[4],
                   int l15, int quad) {
  constexpr int U = 16 / R, W = 128 * R;
  f32x4 s[NT];
#pragma unroll
  for (int kt = 0; kt < NT; ++kt) {
    int kap = tok0 - W + R * (kt * 16 + l15);
    kap = min(max(kap, 0), 4095);
    const bf16_t* kp = swk + (rowbase + kap) * 512 + h * 64 + quad * 8;
    f32x4 a = {0.f, 0.f, 0.f, 0.f};
    a = MFMA16(*(const bf16x8*)kp, qf[0], a);
    a = MFMA16(*(const bf16x8*)(kp + 32), qf[1], a);
    s[kt] = a;
    if ((kt & 3) == 3) __builtin_amdgcn_sched_barrier(0);
  }
  float mx = m;
  const float c1 = 0.125f * 1.4426950408889634f;
#pragma unroll
  for (int kt = 0; kt < NT; ++kt)
#pragma unroll
    for (int r2 = 0; r2 < 4; ++r2) {
      const int c = kt * 16 + quad * 4 + r2;
      const int dist = U * l15 + 128 - c;
      const int kap = tok0 - W + R * c;
      const bool ok = (dist >= 0) && (dist <= 128) && (kap >= 0);
      const float v = ok ? s[kt][r2] * c1 : -1e30f;
      s[kt][r2] = v; mx = fmaxf(mx, v);
    }
  mx = fmaxf(mx, __shfl_xor(mx, 16)); mx = fmaxf(mx, __shfl_xor(mx, 32));
  const float corr = exp2f(m - mx);
  m = mx; l *= corr;
#pragma unroll
  for (int dt = 0; dt < 4; ++dt) { o[dt][0] *= corr; o[dt][1] *= corr; o[dt][2] *= corr; o[dt][3] *= corr; }
#pragma unroll
  for (int kt = 0; kt < NT; ++kt)
#pragma unroll
    for (int r2 = 0; r2 < 4; ++r2) { float pv = exp2f(s[kt][r2] - mx); s[kt][r2] = pv; l += pv; }
  constexpr int NS = (NT + 1) / 2;
#pragma unroll
  for (int s2 = 0; s2 < NS; ++s2) {
    const f32x4 z4 = {0.f, 0.f, 0.f, 0.f};
    const bf16x8 pf = pack8(s[2 * s2], (2 * s2 + 1 < NT) ? s[(2 * s2 + 1 < NT) ? 2 * s2 + 1 : 0] : z4);
    u32x2 vv[8];
#pragma unroll
    for (int j = 0; j < 8; ++j) {
      const int c = (2 * s2 + (j >> 2)) * 16 + quad * 4 + (j & 3);
      int kap = tok0 - W + R * c;
      kap = min(max(kap, 0), 4095);
      vv[j] = *(const u32x2*)(swv + (rowbase + kap) * 512 + h * 64 + 4 * l15);
    }
#pragma unroll
    for (int t4 = 0; t4 < 4; ++t4) {
      u32x4 t;
#pragma unroll
      for (int m = 0; m < 4; ++m) {
        const unsigned a = vv[2 * m][t4 >> 1], b2 = vv[2 * m + 1][t4 >> 1];
        t[m] = (t4 & 1) ? ((a >> 16) | (b2 & 0xffff0000u)) : ((a & 0xffffu) | (b2 << 16));
      }
      o[t4] = MFMA16(__builtin_bit_cast(bf16x8, t), pf, o[t4]);
    }
    __builtin_amdgcn_sched_barrier(0);
  }
}

DI void phase_dil_attn(const Params& p, int first, int nblk) {
  const int wave = TID() >> 6, lane = TID() & 63, l15 = lane & 15, quad = lane >> 4;
  bf16_t* swq = (bf16_t*)(p.ws + OFF_SWQ); const bf16_t* swk = (const bf16_t*)(p.ws + OFF_SWK); const bf16_t* swv = (const bf16_t*)(p.ws + OFF_SWV);
  for (int item = first; item < 4096; item += nblk) {
    const int b = item >> 9, h = (item >> 6) & 7, G = (item >> 2) & 15, sub = item & 3;
    const int tok0 = G * 256 + sub * 4 + wave;
    const size_t rowbase = (size_t)b * 4096;
    const size_t tq = rowbase + tok0 + 16 * l15;
    bf16x8 qf[2];
    qf[0] = *(const bf16x8*)(swq + tq * 512 + h * 64 + quad * 8);
    qf[1] = *(const bf16x8*)(swq + tq * 512 + h * 64 + 32 + quad * 8);
    float m = -1e30f, l = 0.f;
    f32x4 o[4];
#pragma unroll
    for (int dt = 0; dt < 4; ++dt) o[dt] = f32x4{0.f, 0.f, 0.f, 0.f};
    dil_branch<16, 9>(swk, swv, rowbase, h, tok0, qf, m, l, o, l15, quad);
    dil_branch<4, 12>(swk, swv, rowbase, h, tok0, qf, m, l, o, l15, quad);
    dil_branch<1, 24>(swk, swv, rowbase, h, tok0, qf, m, l, o, l15, quad);
    l += __shfl_xor(l, 16); l += __shfl_xor(l, 32);
    const float il = 1.f / l;
    u32x4 w0, w1;
    w0[0] = pack2(o[0][0] * il, o[1][0] * il); w0[1] = pack2(o[2][0] * il, o[3][0] * il);
    w0[2] = pack2(o[0][1] * il, o[1][1] * il); w0[3] = pack2(o[2][1] * il, o[3][1] * il);
    w1[0] = pack2(o[0][2] * il, o[1][2] * il); w1[1] = pack2(o[2][2] * il, o[3][2] * il);
    w1[2] = pack2(o[0][3] * il, o[1][3] * il); w1[3] = pack2(o[2][3] * il, o[3][3] * il);
    *(u32x4*)(swq + tq * 512 + h * 64 + quad * 16) = w0;
    *(u32x4*)(swq + tq * 512 + h * 64 + quad * 16 + 8) = w1;
  }
}

DI void phase_xo(const Params& p, int l, bf16_t* smem) {
  const bf16_t* wc = (const bf16_t*)(p.ws + OFF_W) + (size_t)l * SZ_COMMON + 3 * SZ_SQ;
  PlainLoad al{(const bf16_t*)(p.ws + OFF_XO), 1024}, bl{wc, 1024};
  for_tiles(256, 8, [&](int mi, int ni) {
    gemm_tile(mi * 128, ni * 128, 16, al, bl, [&](f32x4 (&acc)[4][4], int rb, int cb) { epi_resid(p, acc, rb, cb); }, smem);
  });
}

DI void phase_ffn_gu(const Params& p, int l, bf16_t* smem) {
  const bf16_t* W = (const bf16_t*)(p.ws + OFF_W) + (size_t)l * SZ_COMMON + 4 * SZ_SQ;
  PlainLoad al{(const bf16_t*)(p.ws + OFF_HB), 1024}, bl{W, 1024};
  bf16_t* act = (bf16_t*)(p.ws + OFF_ACT);
  for_tiles(256, 44, [&](int mi, int ni) {
    gemm_tile(mi * 128, ni * 128, 16, al, bl, [&](f32x4 (&acc)[4][4], int rb, int cb) {
      const int lane = TID() & 63, l15 = lane & 15, quad = lane >> 4;
#pragma unroll
      for (int mt = 0; mt < 4; ++mt)
#pragma unroll
        for (int np = 0; np < 2; ++np) {
          u32x2 v;
          v[0] = pack2(siluf_(acc[mt][2 * np][0]) * acc[mt][2 * np + 1][0], siluf_(acc[mt][2 * np][1]) * acc[mt][2 * np + 1][1]);
          v[1] = pack2(siluf_(acc[mt][2 * np][2]) * acc[mt][2 * np + 1][2], siluf_(acc[mt][2 * np][3]) * acc[mt][2 * np + 1][3]);
          *(u32x2*)(act + (size_t)(rb + mt * 16 + l15) * 2816 + (cb >> 1) + np * 16 + quad * 4) = v;
        }
    }, smem);
  });
}
DI void phase_ffn_down(const Params& p, int l, bf16_t* smem) {
  const bf16_t* W = (const bf16_t*)(p.ws + OFF_W) + (size_t)l * SZ_COMMON + 4 * SZ_SQ + SZ_GU;
  PlainLoad al{(const bf16_t*)(p.ws + OFF_ACT), 2816}, bl{W, 2816};
  for_tiles(256, 8, [&](int mi, int ni) {
    gemm_tile(mi * 128, ni * 128, 44, al, bl, [&](f32x4 (&acc)[4][4], int rb, int cb) { epi_resid(p, acc, rb, cb); }, smem);
  });
}


#define XB_TMO      128
#define XB_XCNT(j)  (256  + 64 * (j))
#define XB_XSUB(j)  (1280 + 64 * (j))
#define XB_XGEN(j)  (2304 + 64 * (j))
#define XB_TOP      3328
#define XB_TOPGEN   3392
#define XCD_BAR_WORDS 3456
#define XB_SPIN_CAP (1u << 22)
#define LAS __attribute__((address_space(3)))
DI unsigned xb_ld(unsigned* p) { return __hip_atomic_load(p, __ATOMIC_RELAXED, __HIP_MEMORY_SCOPE_AGENT); }
DI unsigned xb_add(unsigned* p, unsigned v) { return __hip_atomic_fetch_add(p, v, __ATOMIC_RELAXED, __HIP_MEMORY_SCOPE_AGENT); }
DI unsigned xb_xcc_id() { return (unsigned)__builtin_amdgcn_s_getreg((3 << 11) | 20) & 0xFu; }
#define XB_SPIN(cond, bar) do { unsigned _sp = 0; while (cond) { __builtin_amdgcn_s_sleep(1); \
    if ((++_sp & 255u) == 0u) { if (xb_ld(&(bar)[XB_TMO])) break; if (_sp > XB_SPIN_CAP) { atomicAdd(&(bar)[XB_TMO], 1u); break; } } } } while (0)
struct XcdBarrier { unsigned* bar; unsigned x; volatile LAS unsigned* st; };
DI XcdBarrier xcd_barrier_post(unsigned* bar, volatile LAS unsigned* st) {
  XcdBarrier b; b.bar = bar; b.x = xb_xcc_id(); b.st = st;
  if (threadIdx.x == 0) (void)xb_add(&bar[XB_XCNT(b.x)], 1u);
  return b;
}
DI void xcd_barrier_complete(unsigned* bar, unsigned x, unsigned& nloc, unsigned& nx) {
  const unsigned G = gridDim.x * gridDim.y * gridDim.z;
  unsigned sum, cnt, mine, sp = 0u;
  for (;;) {
    sum = 0u; cnt = 0u; mine = 0u;
#pragma unroll
    for (unsigned j = 0; j < 16; ++j) { const unsigned c = xb_ld(&bar[XB_XCNT(j)]); sum += c; cnt += (c > 0u) ? 1u : 0u; mine = (j == x) ? c : mine; }
    if (sum == G) break;
    __builtin_amdgcn_s_sleep(1);
    if ((++sp & 255u) == 0u) { if (xb_ld(&bar[XB_TMO])) break; if (sp > XB_SPIN_CAP) { atomicAdd(&bar[XB_TMO], 1u); break; } }
  }
  nloc = mine > 0u ? mine : 1u; nx = cnt > 0u ? cnt : 1u;
}
DI void xcd_barrier(const XcdBarrier& b) {
  asm volatile("s_waitcnt vmcnt(0)" ::: "memory");
  __syncthreads();
  if (threadIdx.x == 0) {
    unsigned* bar = b.bar;
    __builtin_amdgcn_s_waitcnt(0);
    unsigned nloc = b.st[0], nx = b.st[1];
    if (nloc == 0u) { xcd_barrier_complete(bar, b.x, nloc, nx); b.st[0] = nloc; b.st[1] = nx; }
    const unsigned old = xb_add(&bar[XB_XSUB(b.x)], 1u);
    const unsigned gen = old / nloc;
    if (old + 1u == (gen + 1u) * nloc) {
      __builtin_amdgcn_fence(__ATOMIC_RELEASE, "agent");
      asm volatile("s_waitcnt vmcnt(0)" ::: "memory");
      const unsigned og = xb_add(&bar[XB_TOP], 1u);
      const unsigned tg = og / nx;
      if (og + 1u == (tg + 1u) * nx) xb_add(&bar[XB_TOPGEN], 1u);
      else XB_SPIN(xb_ld(&bar[XB_TOPGEN]) == tg, bar);
      __builtin_amdgcn_fence(__ATOMIC_ACQUIRE, "agent");
      xb_add(&bar[XB_XGEN(b.x)], 1u);
      asm volatile("s_waitcnt vmcnt(0)" ::: "memory");
    } else {
      XB_SPIN(xb_ld(&bar[XB_XGEN(b.x)]) == gen, bar);
      __builtin_amdgcn_fence(__ATOMIC_ACQUIRE, "agent");
      asm volatile("s_waitcnt vmcnt(0)" ::: "memory");
    }
  }
  __syncthreads();
}

__global__ void __launch_bounds__(256, 2) fwd_megakernel(Params p) {
  cg::grid_group grid = cg::this_grid();
  __shared__ __attribute__((aligned(16))) char smem_raw[2 * 2 * 128 * LDT * 2];
  bf16_t* sm16 = (bf16_t*)smem_raw; float* sm32 = (float*)smem_raw;

  __shared__ uint4 xb_words;
  if (threadIdx.x == 0) xb_words = make_uint4(0u, 0u, 0u, 0u);
  __syncthreads();
  XcdBarrier xb = xcd_barrier_post((unsigned*)(p.ws + OFF_BAR), (volatile LAS unsigned*)&xb_words);
  phase_prologue(p, sm32);
  grid.sync();
  for (int l = 0; l < 4; ++l) {
    const int i = l >> 1;
    if ((l & 1) == 0) {
      phase_proj(p, i, sm16); xcd_barrier(xb);
      phase_dn_prep(p, i, smem_raw); xcd_barrier(xb);
      phase_mix(p, i, sm16); xcd_barrier(xb);
      phase_dn_post(p, i); xcd_barrier(xb);
      phase_wout(p, i, sm16); xcd_barrier(xb);
    } else {
#if USE_S5_GEMM
      phase_s5_tables(p, i, sm32); xcd_barrier(xb);
      phase_s5_end(p, sm16); xcd_barrier(xb);
      phase_s5_y(p, i, sm16); xcd_barrier(xb);
#else
      phase_s5_naive(p, i); xcd_barrier(xb);
#endif
      phase_glu(p, i, sm16); xcd_barrier(xb);
    }
    phase_ln(p, p.ln_mix_g + l * 1024, p.ln_mix_b + l * 1024); xcd_barrier(xb);
    phase_xproj(p, l, sm16); xcd_barrier(xb);
    phase_xattn(p); xcd_barrier(xb);
    phase_xo(p, l, sm16); xcd_barrier(xb);
    phase_ln(p, p.ln_x_g + l * 1024, p.ln_x_b + l * 1024); xcd_barrier(xb);
    phase_ffn_gu(p, l, sm16); xcd_barrier(xb);
    phase_ffn_down(p, l, sm16); xcd_barrier(xb);
    phase_ln(p, p.ln_ffn_g + l * 1024, p.ln_ffn_b + l * 1024); xcd_barrier(xb);
  }
}

extern "C" void kernel_launch(void* const* d_in, const int* in_sizes, int n_in, void* d_out, int out_size, void* d_ws, size_t ws_size,
                              hipStream_t stream) {
  static int grid_blocks = 0;
  if (!grid_blocks) {
    int dev = 0, cus = 0, per_cu = 0;
    hipGetDevice(&dev);
    hipDeviceGetAttribute(&cus, hipDeviceAttributeMultiprocessorCount, dev);
    hipOccupancyMaxActiveBlocksPerMultiprocessor(&per_cu, fwd_megakernel, 256, 0);
    if (per_cu > 2) per_cu = 2;
    if (per_cu < 1) per_cu = 1;
    grid_blocks = cus * per_cu;
    grid_blocks -= grid_blocks % 8;
  }
  Params p{};
  const float** pf = (const float**)&p;
  for (int i = 0; i < 32; ++i) pf[i] = (const float*)d_in[i];
  p.pos = (const int*)d_in[2];
  p.out = (float*)d_out; p.ws = (char*)d_ws;
  hipMemsetAsync((char*)d_ws + OFF_BAR, 0, XCD_BAR_WORDS * sizeof(unsigned), stream);
  void* args[] = {&p};
  hipError_t e = hipLaunchCooperativeKernel((void*)fwd_megakernel, dim3(grid_blocks), dim3(256), args, 0, stream);
  if (e != hipSuccess) fprintf(stderr, "cooperative launch failed: %s (grid %d)\n", hipGetErrorString(e), grid_blocks);
}
```

```cpp
#include <hip/hip_runtime.h>
#include <hip/hip_cooperative_groups.h>
#include <cstdio>
namespace cg = cooperative_groups;
#ifndef USE_XATTN_MFMA
#define USE_XATTN_MFMA 1
#endif
#ifndef USE_S5_GEMM
#define USE_S5_GEMM 1
#endif
#ifndef USE_DIL_MFMA
#define USE_DIL_MFMA 1
#endif

typedef unsigned short bf16_t;
using bf16x8 = __attribute__((ext_vector_type(8))) short;
using f32x4 = __attribute__((ext_vector_type(4))) float;
#define DI __device__ __forceinline__

constexpr int T_ = 32768, S_ = 4096;
constexpr size_t MiB = (size_t)1 << 20;
constexpr size_t SZ_SQ = (size_t)1024 * 1024, SZ_WIN = (size_t)3712 * 1024, SZ_GLU = (size_t)2048 * 1024,
                 SZ_GU = (size_t)5632 * 1024, SZ_WD = (size_t)1024 * 2816;
constexpr size_t SZ_COMMON = 4 * SZ_SQ + SZ_GU + SZ_WD;
constexpr size_t W_EVEN0 = 4 * SZ_COMMON;
constexpr size_t W_ODD0 = W_EVEN0 + 2 * (SZ_WIN + SZ_SQ);
constexpr float ALPHA = 1.681792830507429f;

constexpr size_t OFF_W = 0;
constexpr size_t OFF_ROPE = 125 * MiB;
constexpr size_t OFF_HB = 133 * MiB;
constexpr size_t OFF_KX = 197 * MiB;
constexpr size_t OFF_VX = 201 * MiB;
constexpr size_t OFF_BIG = 205 * MiB;
constexpr size_t OFF_BAR = 511 * MiB;
constexpr size_t OFF_DNQKV = OFF_BIG;
constexpr size_t OFF_Z = OFF_BIG + 96 * MiB;
constexpr size_t OFF_SWQ = OFF_BIG + 128 * MiB;
constexpr size_t OFF_SWK = OFF_BIG + 160 * MiB;
constexpr size_t OFF_SWV = OFF_BIG + 192 * MiB;
constexpr size_t OFF_LOGIT = OFF_BIG + 224 * MiB;
constexpr size_t OFF_QD = OFF_BIG + 225 * MiB;
constexpr size_t OFF_KD = OFF_BIG + 257 * MiB;
constexpr size_t OFF_INTRA = OFF_BIG + 289 * MiB;
constexpr size_t OFF_WB = OFF_HB;
constexpr size_t OFF_UB = OFF_HB + 32 * MiB;
constexpr size_t OFF_EG = OFF_KX;
constexpr size_t OFF_XQ = OFF_BIG;
constexpr size_t OFF_XO = OFF_BIG + 64 * MiB;
constexpr size_t OFF_ACT = OFF_BIG;
constexpr size_t OFF_HID = OFF_BIG;
constexpr size_t OFF_SIN = OFF_BIG + 64 * MiB;
constexpr size_t OFF_KTAB = OFF_BIG + 80 * MiB;
constexpr size_t OFF_ETAB = OFF_BIG + 82 * MiB;
constexpr size_t OFF_GTAB = OFF_BIG + 90 * MiB;
constexpr size_t OFF_AL = OFF_BIG + 98 * MiB;

struct Params {
  const float* x; const float* mem; const int* pos;
  const float* hyb_w_in; const float* dn_conv_w; const float* dn_a_log; const float* dn_dt_bias; const float* dn_norm_g; const float* hyb_w_out;
  const float* s5_a_re; const float* s5_a_im; const float* s5_log_dt; const float* s5_b_re; const float* s5_b_im; const float* s5_c_re; const float* s5_c_im;
  const float* s5_d; const float* s5_glu_wo; const float* s5_glu_wg;
  const float* ln_mix_g; const float* ln_mix_b;
  const float* xq_w; const float* xk_w; const float* xv_w; const float* xo_w; const float* ln_x_g; const float* ln_x_b;
  const float* ffn_wg; const float* ffn_wu; const float* ffn_wd; const float* ln_ffn_g; const float* ln_ffn_b;
  float* out; char* ws;
};

DI int TID() { int t = threadIdx.x; asm volatile("" : "+v"(t)); return t; }
DI int BID() { int t = blockIdx.x; asm volatile("" : "+s"(t)); return t; }
DI int GDIM() { int t = gridDim.x; asm volatile("" : "+s"(t)); return t; }
DI bf16_t f2bf(float x) { unsigned u = __float_as_uint(x); u += 0x7fffu + ((u >> 16) & 1u); return (bf16_t)(u >> 16); }
DI float bf2f(bf16_t v) { return __uint_as_float(((unsigned)v) << 16); }
DI unsigned pack2(float a, float b) { return (unsigned)f2bf(a) | ((unsigned)f2bf(b) << 16); }
using u32x4 = __attribute__((ext_vector_type(4))) unsigned;
using u32x2 = __attribute__((ext_vector_type(2))) unsigned;
DI bf16x8 pack8(f32x4 a, f32x4 b) {
  u32x4 t; t[0] = pack2(a[0], a[1]); t[1] = pack2(a[2], a[3]); t[2] = pack2(b[0], b[1]); t[3] = pack2(b[2], b[3]);
  return __builtin_bit_cast(bf16x8, t);
}
#define MFMA16(a, b, c) __builtin_amdgcn_mfma_f32_16x16x32_bf16((a), (b), (c), 0, 0, 0)
DI int kperm(int x) { return (x & ~31) | (((x >> 2) & 3) * 8 + ((x >> 4) & 1) * 4 + (x & 3)); }
DI float wave_sum(float v) { for (int o = 32; o > 0; o >>= 1) v += __shfl_xor(v, o); return v; }
DI float wave_max(float v) { for (int o = 32; o > 0; o >>= 1) v = fmaxf(v, __shfl_xor(v, o)); return v; }
DI float sigmoidf_(float x) { return 1.f / (1.f + __expf(-x)); }
DI float siluf_(float x) { return x * sigmoidf_(x); }
DI float softplusf_(float x) { return fmaxf(x, 0.f) + log1pf(__expf(-fabsf(x))); }
DI float gelu_tanh(float x) { float u = 0.7978845608028654f * (x + 0.044715f * x * x * x); return 0.5f * x * (1.f + tanhf(u)); }

template <class CM>
DI void transpose_job(bf16_t* dst, int Ndst, int K, int srcStride, CM colptr, float* tile) {
  const int ntk = K / 64, ntiles = (Ndst / 64) * ntk;
  const int tid = TID();
  for (int tl = BID(); tl < ntiles; tl += GDIM()) {
    const int r0 = (tl / ntk) * 64, k0 = (tl % ntk) * 64;
    const int q4 = tid & 15, kl0 = tid >> 4;
    const float* cp = colptr(r0 + 4 * q4);
    float4 v[4];
#pragma unroll
    for (int i = 0; i < 4; ++i) v[i] = cp ? *(const float4*)(cp + (size_t)(k0 + kl0 + 16 * i) * srcStride) : make_float4(0.f, 0.f, 0.f, 0.f);
#pragma unroll
    for (int i = 0; i < 4; ++i) {
      float* t = tile + (kl0 + 16 * i) * 65 + 4 * q4;
      t[0] = v[i].x; t[1] = v[i].y; t[2] = v[i].z; t[3] = v[i].w;
    }
    __syncthreads();
#pragma unroll
    for (int i = 0; i < 2; ++i) {
      const int c = tid + 256 * i, rr = c >> 3, kc = (c & 7) * 8;
      const float* t = tile + kc * 65 + rr;
      uint4 o;
      o.x = pack2(t[0], t[65]); o.y = pack2(t[2 * 65], t[3 * 65]); o.z = pack2(t[4 * 65], t[5 * 65]); o.w = pack2(t[6 * 65], t[7 * 65]);
      *(uint4*)(dst + (size_t)(r0 + rr) * K + k0 + kc) = o;
    }
    __syncthreads();
  }
}

DI void phase_prologue(const Params& p, float* smem) {
  bf16_t* W = (bf16_t*)(p.ws + OFF_W);
  for (int l = 0; l < 4; ++l) {
    bf16_t* wc = W + (size_t)l * SZ_COMMON;
    const float* s;
    s = p.xq_w + (size_t)l * SZ_SQ; transpose_job(wc, 1024, 1024, 1024, [=](int r) { return s + r; }, smem);
    s = p.xk_w + (size_t)l * SZ_SQ; transpose_job(wc + SZ_SQ, 1024, 1024, 1024, [=](int r) { return s + r; }, smem);
    s = p.xv_w + (size_t)l * SZ_SQ; transpose_job(wc + 2 * SZ_SQ, 1024, 1024, 1024, [=](int r) { return s + r; }, smem);
    s = p.xo_w + (size_t)l * SZ_SQ; transpose_job(wc + 3 * SZ_SQ, 1024, 1024, 1024, [=](int r) { return s + r; }, smem);
    {
      const float* g = p.ffn_wg + (size_t)l * 1024 * 2816; const float* u = p.ffn_wu + (size_t)l * 1024 * 2816;
      transpose_job(wc + 4 * SZ_SQ, 5632, 1024, 2816, [=](int r) { int c = (r >> 5) * 16 + (r & 15); return ((r >> 4) & 1) ? (u + c) : (g + c); }, smem);
    }
    s = p.ffn_wd + (size_t)l * 2816 * 1024; transpose_job(wc + 4 * SZ_SQ + SZ_GU, 1024, 2816, 1024, [=](int r) { return s + r; }, smem);
  }
  for (int i = 0; i < 2; ++i) {
    bf16_t* we = W + W_EVEN0 + (size_t)i * (SZ_WIN + SZ_SQ);
    const float* s = p.hyb_w_in + (size_t)i * 1024 * 3592;
    transpose_job(we, 3712, 1024, 3592, [=](int r) -> const float* {
      if (r < 2048) return s + r;
      if (r < 3584) return s + r + 8;
      if (r < 3592) return s + 2048 + (r - 3584);
      return nullptr; }, smem);
    const float* s2 = p.hyb_w_out + (size_t)i * SZ_SQ;
    transpose_job(we + SZ_WIN, 1024, 1024, 1024, [=](int r) { return s2 + r; }, smem);
    bf16_t* wo = W + W_ODD0 + (size_t)i * SZ_GLU;
    const float* a = p.s5_glu_wo + (size_t)i * SZ_SQ; const float* b = p.s5_glu_wg + (size_t)i * SZ_SQ;
    transpose_job(wo, 2048, 1024, 1024, [=](int r) { int c = (r >> 5) * 16 + (r & 15); return ((r >> 4) & 1) ? (b + c) : (a + c); }, smem);
  }
  const size_t gtid = (size_t)BID() * 256 + TID(), gsz = (size_t)GDIM() * 256;
  bf16_t* hb = (bf16_t*)(p.ws + OFF_HB);
  for (size_t i = gtid; i < (size_t)T_ * 256; i += gsz) {
    float4 v = ((const float4*)p.x)[i];
    ((float4*)p.out)[i] = v;
    uint2 o; o.x = pack2(v.x, v.y); o.y = pack2(v.z, v.w);
    ((uint2*)hb)[i] = o;
  }
  float* rc = (float*)(p.ws + OFF_ROPE); float* rs = rc + (size_t)T_ * 32;
  for (size_t i = gtid; i < (size_t)T_ * 32; i += gsz) {
    int t = (int)(i >> 5), j = (int)(i & 31);
    float invf = (float)exp(-(double)(2 * j) / 64.0 * 9.210340371976184);
    float ang = (float)p.pos[t] * invf;
    double a = (double)ang;
    double k = rint(a * 0.15915494309189535);
    float r = (float)(a - k * 6.283185307179586);
    rc[i] = cosf(r); rs[i] = sinf(r);
  }
}

constexpr int LDT = 72;
template <class AL, class BL, class EP>
DI void gemm_tile(int m0, int n0, int nks, AL aload, BL bload, EP epi, bf16_t* smem) {
  bf16_t* As = smem; bf16_t* Bs = smem + 2 * 128 * LDT;
  const int tid = TID(), lane = tid & 63, wave = tid >> 6;
  const int wm = wave >> 1, wn = wave & 1, l15 = lane & 15, quad = lane >> 4;
  const int lrow = tid >> 3, lkc = (tid & 7) * 8;
  f32x4 acc[4][4];
#pragma unroll
  for (int i = 0; i < 4; ++i)
#pragma unroll
    for (int j = 0; j < 4; ++j) acc[i][j] = f32x4{0.f, 0.f, 0.f, 0.f};
  uint4 ra0[4], rb0[4], ra1[4], rb1[4];
#pragma unroll
  for (int i = 0; i < 4; ++i) { ra0[i] = aload(m0 + lrow + 32 * i, 0, lkc); rb0[i] = bload(n0 + lrow + 32 * i, 0, lkc); }
#pragma unroll
  for (int i = 0; i < 4; ++i) { ra1[i] = aload(m0 + lrow + 32 * i, 1, lkc); rb1[i] = bload(n0 + lrow + 32 * i, 1, lkc); }
#pragma unroll
  for (int i = 0; i < 4; ++i) {
    *(uint4*)(As + (lrow + 32 * i) * LDT + lkc) = ra0[i];
    *(uint4*)(Bs + (lrow + 32 * i) * LDT + lkc) = rb0[i];
  }
  __syncthreads();
  auto compute = [&](int cur) {
    const bf16_t* Ab = As + cur * 128 * LDT; const bf16_t* Bb = Bs + cur * 128 * LDT;
#pragma unroll
    for (int kk = 0; kk < 2; ++kk) {
      bf16x8 a[4], b[4];
#pragma unroll
      for (int mt = 0; mt < 4; ++mt) a[mt] = *(const bf16x8*)(Ab + (wm * 64 + mt * 16 + l15) * LDT + kk * 32 + quad * 8);
#pragma unroll
      for (int nt = 0; nt < 4; ++nt) b[nt] = *(const bf16x8*)(Bb + (wn * 64 + nt * 16 + l15) * LDT + kk * 32 + quad * 8);
#pragma unroll
      for (int mt = 0; mt < 4; ++mt)
#pragma unroll
        for (int nt = 0; nt < 4; ++nt) acc[mt][nt] = __builtin_amdgcn_mfma_f32_16x16x32_bf16(b[nt], a[mt], acc[mt][nt], 0, 0, 0);
    }
  };
  for (int ks = 0; ks < nks; ks += 2) {
    if (ks + 2 < nks) {
#pragma unroll
      for (int i = 0; i < 4; ++i) { ra0[i] = aload(m0 + lrow + 32 * i, ks + 2, lkc); rb0[i] = bload(n0 + lrow + 32 * i, ks + 2, lkc); }
    }
    compute(0);
#pragma unroll
    for (int i = 0; i < 4; ++i) {
      *(uint4*)(As + 128 * LDT + (lrow + 32 * i) * LDT + lkc) = ra1[i];
      *(uint4*)(Bs + 128 * LDT + (lrow + 32 * i) * LDT + lkc) = rb1[i];
    }
    __syncthreads();
    if (ks + 3 < nks) {
#pragma unroll
      for (int i = 0; i < 4; ++i) { ra1[i] = aload(m0 + lrow + 32 * i, ks + 3, lkc); rb1[i] = bload(n0 + lrow + 32 * i, ks + 3, lkc); }
    }
    compute(1);
    if (ks + 2 < nks) {
#pragma unroll
      for (int i = 0; i < 4; ++i) {
        *(uint4*)(As + (lrow + 32 * i) * LDT + lkc) = ra0[i];
        *(uint4*)(Bs + (lrow + 32 * i) * LDT + lkc) = rb0[i];
      }
    }
    __syncthreads();
  }
  epi(acc, m0 + wm * 64, n0 + wn * 64);
}

DI void tile_of(int w, int mtiles, int ntiles, int xcd, int& m0, int& n0) {
  const int mper = mtiles >> 3, full = mper * 8;
  int gidx = w / full;
  const int ngroups = (ntiles + 7) >> 3;
  if (gidx > ngroups - 1) gidx = ngroups - 1;
  const int rest = w - gidx * full;
  const int wg = min(8, ntiles - 8 * gidx);
  const int ml = rest / wg, ni = 8 * gidx + (rest - ml * wg);
  m0 = (ml * 8 + xcd) * 128; n0 = ni * 128;
}
template <class AL, class BL, class EP>
DI void gemm_stream(int mtiles, int ntiles, int nks, AL aload, BL bload, EP epi, bf16_t* smem) {
  const int xcd = BID() & 7, slot = BID() >> 3, nslot = GDIM() >> 3;
  const int per = (mtiles >> 3) * ntiles;
  if (slot >= per) return;
  bf16_t* As = smem; bf16_t* Bs = smem + 2 * 128 * LDT;
  const int tid = TID(), lane = tid & 63, wave = tid >> 6;
  const int wm = wave >> 1, wc = wave & 1, l15 = lane & 15, quad = lane >> 4;
  const int lrow = tid >> 3, lkc = (tid & 7) * 8;
  f32x4 acc[4][4];
  uint4 ra0[4], rb0[4], ra1[4], rb1[4];
  int w = slot;
  int m0, n0;
  tile_of(w, mtiles, ntiles, xcd, m0, n0);
#pragma unroll
  for (int i = 0; i < 4; ++i) { ra0[i] = aload(m0 + lrow + 32 * i, 0, lkc); rb0[i] = bload(n0 + lrow + 32 * i, 0, lkc); }
#pragma unroll
  for (int i = 0; i < 4; ++i) { ra1[i] = aload(m0 + lrow + 32 * i, 1, lkc); rb1[i] = bload(n0 + lrow + 32 * i, 1, lkc); }
#pragma unroll
  for (int i = 0; i < 4; ++i) {
    *(uint4*)(As + (lrow + 32 * i) * LDT + lkc) = ra0[i];
    *(uint4*)(Bs + (lrow + 32 * i) * LDT + lkc) = rb0[i];
  }
  __syncthreads();
  auto compute = [&](int cur) {
    const bf16_t* Ab = As + cur * 128 * LDT; const bf16_t* Bb = Bs + cur * 128 * LDT;
#pragma unroll
    for (int kk = 0; kk < 2; ++kk) {
      bf16x8 a[4], b[4];
#pragma unroll
      for (int mt = 0; mt < 4; ++mt) a[mt] = *(const bf16x8*)(Ab + (wm * 64 + mt * 16 + l15) * LDT + kk * 32 + quad * 8);
#pragma unroll
      for (int nt = 0; nt < 4; ++nt) b[nt] = *(const bf16x8*)(Bb + (wc * 64 + nt * 16 + l15) * LDT + kk * 32 + quad * 8);
#pragma unroll
      for (int mt = 0; mt < 4; ++mt)
#pragma unroll
        for (int nt = 0; nt < 4; ++nt) acc[mt][nt] = __builtin_amdgcn_mfma_f32_16x16x32_bf16(b[nt], a[mt], acc[mt][nt], 0, 0, 0);
    }
  };
  for (;;) {
    const int wnext = w + nslot;
    const bool has_next = wnext < per;
    int m1 = 0, n1 = 0;
    if (has_next) tile_of(wnext, mtiles, ntiles, xcd, m1, n1);
#pragma unroll
    for (int i = 0; i < 4; ++i)
#pragma unroll
      for (int j = 0; j < 4; ++j) acc[i][j] = f32x4{0.f, 0.f, 0.f, 0.f};
    for (int ks = 0; ks < nks; ks += 2) {
      const bool in2 = ks + 2 < nks;
      if (in2 || has_next) {
        const int mm = in2 ? m0 : m1, nn = in2 ? n0 : n1, kq = in2 ? ks + 2 : 0;
#pragma unroll
        for (int i = 0; i < 4; ++i) { ra0[i] = aload(mm + lrow + 32 * i, kq, lkc); rb0[i] = bload(nn + lrow + 32 * i, kq, lkc); }
      }
      compute(0);
#pragma unroll
      for (int i = 0; i < 4; ++i) {
        *(uint4*)(As + 128 * LDT + (lrow + 32 * i) * LDT + lkc) = ra1[i];
        *(uint4*)(Bs + 128 * LDT + (lrow + 32 * i) * LDT + lkc) = rb1[i];
      }
      __syncthreads();
      if (in2 || has_next) {
        const int mm = in2 ? m0 : m1, nn = in2 ? n0 : n1, kq = in2 ? ks + 3 : 1;
#pragma unroll
        for (int i = 0; i < 4; ++i) { ra1[i] = aload(mm + lrow + 32 * i, kq, lkc); rb1[i] = bload(nn + lrow + 32 * i, kq, lkc); }
      }
      compute(1);
      if (in2 || has_next) {
#pragma unroll
        for (int i = 0; i < 4; ++i) {
          *(uint4*)(As + (lrow + 32 * i) * LDT + lkc) = ra0[i];
          *(uint4*)(Bs + (lrow + 32 * i) * LDT + lkc) = rb0[i];
        }
      }
      __syncthreads();
    }
    epi(acc, m0 + wm * 64, n0 + wc * 64);
    if (!has_next) break;
    w = wnext; m0 = m1; n0 = n1;
  }
}

template <class F>
DI void for_tiles(int mtiles, int ntiles, F f) {
  const int xcd = BID() & 7, slot = BID() >> 3, nslot = GDIM() >> 3;
  const int per = (mtiles >> 3) * ntiles;
  for (int w = slot; w < per; w += nslot) {
    int mi = w / ntiles, ni = w - mi * ntiles;
    f((mi * 8 + xcd), ni);
  }
}

#define EPI_LOOP for (int mt = 0; mt < 4; ++mt) for (int nt = 0; nt < 4; ++nt) for (int r = 0; r < 4; ++r)

DI void epi_resid(const Params& p, f32x4 (&acc)[4][4], int rb, int cb) {
  const int lane = TID() & 63, l15 = lane & 15, quad = lane >> 4;
#pragma unroll
  for (int mt = 0; mt < 4; ++mt)
#pragma unroll
    for (int nt = 0; nt < 4; ++nt) {
      float4* ptr = (float4*)(p.out + (size_t)(rb + mt * 16 + l15) * 1024 + cb + nt * 16 + quad * 4);
      float4 h = *ptr;
      h.x = ALPHA * h.x + acc[mt][nt][0]; h.y = ALPHA * h.y + acc[mt][nt][1]; h.z = ALPHA * h.z + acc[mt][nt][2]; h.w = ALPHA * h.w + acc[mt][nt][3];
      *ptr = h;
    }
}
DI void epi_bf16(bf16_t* dst, int ld, f32x4 (&acc)[4][4], int rb, int cb) {
  const int lane = TID() & 63, l15 = lane & 15, quad = lane >> 4;
#pragma unroll
  for (int mt = 0; mt < 4; ++mt)
#pragma unroll
    for (int nt = 0; nt < 4; ++nt) {
      u32x2 v; v[0] = pack2(acc[mt][nt][0], acc[mt][nt][1]); v[1] = pack2(acc[mt][nt][2], acc[mt][nt][3]);
      *(u32x2*)(dst + (size_t)(rb + mt * 16 + l15) * ld + cb + nt * 16 + quad * 4) = v;
    }
}

struct PlainLoad {
  const bf16_t* base; int ld;
  DI uint4 operator()(int row, int ks, int kc) const { return *(const uint4*)((const char*)base + (unsigned)((row * ld + ks * 64 + kc) * 2)); }
};

DI void phase_proj(const Params& p, int i, bf16_t* smem) {
  const bf16_t* W = (const bf16_t*)(p.ws + OFF_W) + W_EVEN0 + (size_t)i * (SZ_WIN + SZ_SQ);
  PlainLoad al{(const bf16_t*)(p.ws + OFF_HB), 1024}, bl{W, 1024};
  bf16_t* dnqkv = (bf16_t*)(p.ws + OFF_DNQKV); bf16_t* z = (bf16_t*)(p.ws + OFF_Z);
  bf16_t* swq = (bf16_t*)(p.ws + OFF_SWQ); bf16_t* swk = (bf16_t*)(p.ws + OFF_SWK); bf16_t* swv = (bf16_t*)(p.ws + OFF_SWV);
  float* logit = (float*)(p.ws + OFF_LOGIT);
  const float* rc = (const float*)(p.ws + OFF_ROPE); const float* rs = rc + (size_t)T_ * 32;
  {
    gemm_stream(256, 29, 16, al, bl, [&](f32x4 (&acc)[4][4], int rb, int cb) {
      const int lane = TID() & 63, l15 = lane & 15, quad = lane >> 4;
      if (cb < 1536) epi_bf16(dnqkv, 1536, acc, rb, cb);
      else if (cb < 2048) epi_bf16(z, 512, acc, rb, cb - 1536);
      else if (cb < 3072) {
        bf16_t* dst = (cb < 2560) ? swq : swk; const int c0 = (cb < 2560) ? cb - 2048 : cb - 2560;
#pragma unroll
        for (int mt = 0; mt < 4; ++mt) {
          const int row = rb + mt * 16 + l15;
#pragma unroll
          for (int nt = 0; nt < 2; ++nt) {
            const int d = nt * 16 + quad * 4;
            const float4 c = *(const float4*)(rc + (size_t)row * 32 + d), sn = *(const float4*)(rs + (size_t)row * 32 + d);
            const f32x4 x1 = acc[mt][nt], x2 = acc[mt][nt + 2];
            u32x2 o1, o2;
            o1[0] = pack2(x1[0] * c.x - x2[0] * sn.x, x1[1] * c.y - x2[1] * sn.y); o1[1] = pack2(x1[2] * c.z - x2[2] * sn.z, x1[3] * c.w - x2[3] * sn.w);
            o2[0] = pack2(x2[0] * c.x + x1[0] * sn.x, x2[1] * c.y + x1[1] * sn.y); o2[1] = pack2(x2[2] * c.z + x1[2] * sn.z, x2[3] * c.w + x1[3] * sn.w);
            *(u32x2*)(dst + (size_t)row * 512 + c0 + d) = o1;
            *(u32x2*)(dst + (size_t)row * 512 + c0 + d + 32) = o2;
          }
        }
      } else if (cb < 3584) epi_bf16(swv, 512, acc, rb, cb - 3072);
      else if (cb == 3584) {
        if (quad < 2) {
#pragma unroll
          for (int mt = 0; mt < 4; ++mt)
            *(float4*)(logit + (size_t)(rb + mt * 16 + l15) * 8 + quad * 4) = make_float4(acc[mt][0][0], acc[mt][0][1], acc[mt][0][2], acc[mt][0][3]);
        }
      }
    }, smem);
  }
}

DI void phase_dil_attn(const Params& p, int first, int nblk);

DI void phase_dn_prep(const Params& p, int i, char* smem) {
  bf16_t* qs = (bf16_t*)smem; bf16_t* ks = qs + 64 * 136; bf16_t* vs = ks + 64 * 136;
  float* Lm = (float*)(smem + 3 * 17408); float* beta = Lm + 64 * 68; float* gcum = beta + 64; float* egc = gcum + 64;
  const bf16_t* dnqkv = (const bf16_t*)(p.ws + OFF_DNQKV);
  const float* logit = (const float*)(p.ws + OFF_LOGIT);
  bf16_t* qd_g = (bf16_t*)(p.ws + OFF_QD); bf16_t* kd_g = (bf16_t*)(p.ws + OFF_KD); bf16_t* in_g = (bf16_t*)(p.ws + OFF_INTRA);
  bf16_t* w_g = (bf16_t*)(p.ws + OFF_WB); bf16_t* u_g = (bf16_t*)(p.ws + OFF_UB); float* eg_g = (float*)(p.ws + OFF_EG);
  const float* cw = p.dn_conv_w + (size_t)i * 4 * 1536;
  const int tid = TID(), wave = tid >> 6, lane = tid & 63, l15 = lane & 15, quad = lane >> 4;
  const float QS = 0.08838834764831845f;
  for (int item = BID(); item < 2048; item += GDIM()) {
    const int b = item >> 8, h = (item >> 6) & 3, n = item & 63;
    const int t0 = b * 4096 + n * 64, s0 = n * 64;
    const float A = __expf(p.dn_a_log[i * 4 + h]), dtb = p.dn_dt_bias[i * 4 + h];
    {
      float cw0[3][4], cw1[3][4], x0[3][4], x1[3][4];
#pragma unroll
      for (int which = 0; which < 3; ++which)
#pragma unroll
        for (int j = 0; j < 4; ++j) {
          const int col = which * 512 + h * 128 + lane * 2;
          cw0[which][j] = cw[j * 1536 + col]; cw1[which][j] = cw[j * 1536 + col + 1];
        }
      const int ilb = wave * 16;
#pragma unroll
      for (int which = 0; which < 3; ++which)
#pragma unroll
        for (int j = 0; j < 3; ++j) {
          const int sq = s0 + ilb - 3 + j;
          unsigned v = 0u;
          if (sq >= 0) v = *(const unsigned*)(dnqkv + (size_t)(t0 + ilb - 3 + j) * 1536 + which * 512 + h * 128 + lane * 2);
          x0[which][j + 1] = bf2f((bf16_t)(v & 0xffff)); x1[which][j + 1] = bf2f((bf16_t)(v >> 16));
        }
#pragma unroll 4
      for (int tt = 0; tt < 16; ++tt) {
        const int il = ilb + tt;
#pragma unroll
        for (int which = 0; which < 3; ++which) {
          x0[which][0] = x0[which][1]; x0[which][1] = x0[which][2]; x0[which][2] = x0[which][3];
          x1[which][0] = x1[which][1]; x1[which][1] = x1[which][2]; x1[which][2] = x1[which][3];
          const unsigned v = *(const unsigned*)(dnqkv + (size_t)(t0 + il) * 1536 + which * 512 + h * 128 + lane * 2);
          x0[which][3] = bf2f((bf16_t)(v & 0xffff)); x1[which][3] = bf2f((bf16_t)(v >> 16));
          float y0 = cw0[which][0] * x0[which][0] + cw0[which][1] * x0[which][1] + cw0[which][2] * x0[which][2] + cw0[which][3] * x0[which][3];
          float y1 = cw1[which][0] * x1[which][0] + cw1[which][1] * x1[which][1] + cw1[which][2] * x1[which][2] + cw1[which][3] * x1[which][3];
          y0 = siluf_(y0); y1 = siluf_(y1);
          if (which < 2) {
            float ss = wave_sum(y0 * y0 + y1 * y1);
            float sc = rsqrtf(ss + 1e-6f);
            y0 *= sc; y1 *= sc;
          }
          bf16_t* dst = (which == 0) ? qs : (which == 1 ? ks : vs);
          *(unsigned*)(dst + il * 136 + lane * 2) = pack2(y0, y1);
        }
      }
    }
    if (wave == 0) {
      const size_t row = (size_t)(t0 + lane);
      const float bl = logit[row * 8 + h], al = logit[row * 8 + 4 + h];
      float g = -A * softplusf_(al + dtb);
#pragma unroll
      for (int o = 1; o < 64; o <<= 1) { float v = __shfl_up(g, o); if (lane >= o) g += v; }
      beta[lane] = sigmoidf_(bl); gcum[lane] = g; egc[lane] = __expf(g);
    }
    __syncthreads();
    {
      f32x4 kk[4], qk[4];
#pragma unroll
      for (int nt = 0; nt < 4; ++nt) { kk[nt] = f32x4{0.f, 0.f, 0.f, 0.f}; qk[nt] = f32x4{0.f, 0.f, 0.f, 0.f}; }
#pragma unroll
      for (int k4 = 0; k4 < 4; ++k4) {
        const bf16x8 ak = *(const bf16x8*)(ks + (wave * 16 + l15) * 136 + k4 * 32 + quad * 8);
        const bf16x8 aq = *(const bf16x8*)(qs + (wave * 16 + l15) * 136 + k4 * 32 + quad * 8);
#pragma unroll
        for (int nt = 0; nt < 4; ++nt) {
          const bf16x8 bk = *(const bf16x8*)(ks + (nt * 16 + l15) * 136 + k4 * 32 + quad * 8);
          kk[nt] = MFMA16(ak, bk, kk[nt]); qk[nt] = MFMA16(aq, bk, qk[nt]);
        }
      }
#pragma unroll
      for (int nt = 0; nt < 4; ++nt)
#pragma unroll
        for (int r = 0; r < 4; ++r) {
          const int ii = wave * 16 + quad * 4 + r, jj = nt * 16 + l15;
          const float dec = (jj <= ii) ? __expf(gcum[ii] - gcum[jj]) : 0.f;
          Lm[ii * 68 + jj] = (jj < ii) ? beta[ii] * kk[nt][r] * dec : 0.f;
          in_g[(size_t)item * 4096 + ii * 64 + kperm(jj)] = f2bf(qk[nt][r] * QS * dec);
        }
    }
    __syncthreads();
    {
      float x[64];
#pragma unroll
      for (int ii = 0; ii < 64; ++ii) x[ii] = 0.f;
      const int c = tid & 127;
      const bool isw = tid >= 128;
      bf16_t* dstb = (isw ? w_g : u_g) + (size_t)item * 8192 + (isw ? kperm(c) : c);
      const bf16_t* srcb = (isw ? ks : vs) + c;
#pragma unroll
      for (int ii = 0; ii < 64; ++ii) {
        float acc = bf2f(srcb[ii * 136]) * beta[ii] * (isw ? egc[ii] : 1.f);
#pragma unroll
        for (int j4 = 0; j4 < (ii + 3) / 4; ++j4) {
          const float4 l4 = *(const float4*)(Lm + ii * 68 + j4 * 4);
          acc -= l4.x * x[j4 * 4]; acc -= l4.y * x[j4 * 4 + 1]; acc -= l4.z * x[j4 * 4 + 2]; acc -= l4.w * x[j4 * 4 + 3];
        }
        x[ii] = acc;
        dstb[ii * 128] = f2bf(acc);
        if ((ii & 3) == 3) __builtin_amdgcn_sched_barrier(0);
      }
    }
    {
      const float gl = gcum[63];
#pragma unroll 4
      for (int k = 0; k < 32; ++k) {
        const int e = tid + 256 * k;
        const int ii = e >> 7, d = e & 127;
        qd_g[(size_t)item * 8192 + ii * 128 + kperm(d)] = f2bf(bf2f(qs[ii * 136 + d]) * QS * egc[ii]);
        const int d2 = e >> 6, i2 = e & 63;
        kd_g[(size_t)item * 8192 + d2 * 64 + kperm(i2)] = f2bf(bf2f(ks[i2 * 136 + d2]) * __expf(gl - gcum[i2]));
      }
      if (tid == 0) eg_g[item] = __expf(gl);
    }
    __syncthreads();
  }
}

DI bf16x8 ld2(const bf16_t* ptr) {
  u32x2 lo = *(const u32x2*)ptr, hi = *(const u32x2*)(ptr + 16);
  u32x4 t; t[0] = lo[0]; t[1] = lo[1]; t[2] = hi[0]; t[3] = hi[1];
  return __builtin_bit_cast(bf16x8, t);
}

DI void dn_chain_item(const Params& p, int item, bf16_t* smem) {
  const int tid = TID(), wave = tid >> 6, lane = tid & 63, l15 = lane & 15, quad = lane >> 4;
  const int bh = item >> 1, half = item & 1;
  const int e0 = half * 64 + wave * 16 + l15;
  const bf16_t* qd_g = (const bf16_t*)(p.ws + OFF_QD); const bf16_t* kd_g = (const bf16_t*)(p.ws + OFF_KD); const bf16_t* in_g = (const bf16_t*)(p.ws + OFF_INTRA);
  const bf16_t* w_g = (const bf16_t*)(p.ws + OFF_WB); bf16_t* u_g = (bf16_t*)(p.ws + OFF_UB); const float* eg_g = (const float*)(p.ws + OFF_EG);
  bf16_t* wl = smem; bf16_t* ql = wl + 64 * 136; bf16_t* kl = ql + 64 * 136; bf16_t* il = kl + 128 * 72; bf16_t* ul = il + 64 * 72;
  uint4 rw0, rw1, rw2, rw3, rq0, rq1, rq2, rq3, rk0, rk1, rk2, rk3, ri0, ri1, ru0, ru1;
#define CH_GLOAD(n_) do { const size_t ci_ = (size_t)bh * 64 + (n_); \
    const bf16_t* w_ = w_g + ci_ * 8192 + tid * 8; const bf16_t* q_ = qd_g + ci_ * 8192 + tid * 8; const bf16_t* k_ = kd_g + ci_ * 8192 + tid * 8; \
    rw0 = *(const uint4*)(w_); rw1 = *(const uint4*)(w_ + 2048); rw2 = *(const uint4*)(w_ + 4096); rw3 = *(const uint4*)(w_ + 6144); \
    rq0 = *(const uint4*)(q_); rq1 = *(const uint4*)(q_ + 2048); rq2 = *(const uint4*)(q_ + 4096); rq3 = *(const uint4*)(q_ + 6144); \
    rk0 = *(const uint4*)(k_); rk1 = *(const uint4*)(k_ + 2048); rk2 = *(const uint4*)(k_ + 4096); rk3 = *(const uint4*)(k_ + 6144); \
    ri0 = *(const uint4*)(in_g + ci_ * 4096 + tid * 8); ri1 = *(const uint4*)(in_g + ci_ * 4096 + 2048 + tid * 8); \
    ru0 = *(const uint4*)(u_g + ci_ * 8192 + (tid >> 3) * 128 + half * 64 + (tid & 7) * 8); \
    ru1 = *(const uint4*)(u_g + ci_ * 8192 + (32 + (tid >> 3)) * 128 + half * 64 + (tid & 7) * 8); } while (0)
#define CH_LSTORE() do { \
    bf16_t* w_ = wl + (tid >> 4) * 136 + (tid & 15) * 8; bf16_t* q_ = ql + (tid >> 4) * 136 + (tid & 15) * 8; bf16_t* k_ = kl + (tid >> 3) * 72 + (tid & 7) * 8; \
    *(uint4*)(w_) = rw0; *(uint4*)(w_ + 16 * 136) = rw1; *(uint4*)(w_ + 32 * 136) = rw2; *(uint4*)(w_ + 48 * 136) = rw3; \
    *(uint4*)(q_) = rq0; *(uint4*)(q_ + 16 * 136) = rq1; *(uint4*)(q_ + 32 * 136) = rq2; *(uint4*)(q_ + 48 * 136) = rq3; \
    *(uint4*)(k_) = rk0; *(uint4*)(k_ + 32 * 72) = rk1; *(uint4*)(k_ + 64 * 72) = rk2; *(uint4*)(k_ + 96 * 72) = rk3; \
    *(uint4*)(il + (tid >> 3) * 72 + (tid & 7) * 8) = ri0; *(uint4*)(il + (32 + (tid >> 3)) * 72 + (tid & 7) * 8) = ri1; \
    *(uint4*)(ul + (tid >> 3) * 72 + (tid & 7) * 8) = ru0; *(uint4*)(ul + (32 + (tid >> 3)) * 72 + (tid & 7) * 8) = ru1; } while (0)
  f32x4 S[8];
#pragma unroll
  for (int mt = 0; mt < 8; ++mt) S[mt] = f32x4{0.f, 0.f, 0.f, 0.f};
  CH_GLOAD(0);
  CH_LSTORE();
  __syncthreads();
#pragma unroll 1
  for (int n = 0; n < 64; ++n) {
    const size_t ci = (size_t)bh * 64 + n;
    if (n + 1 < 64) CH_GLOAD(n + 1);
    bf16_t* ub = u_g + ci * 8192;
    const float eg = eg_g[ci];
    bf16x8 sb[4];
#pragma unroll
    for (int s = 0; s < 4; ++s) sb[s] = pack8(S[2 * s], S[2 * s + 1]);
    f32x4 vn[4];
#pragma unroll
    for (int it = 0; it < 4; ++it) {
      f32x4 a = {0.f, 0.f, 0.f, 0.f};
#pragma unroll
      for (int s = 0; s < 4; ++s) a = MFMA16(*(const bf16x8*)(wl + (it * 16 + l15) * 136 + s * 32 + quad * 8), sb[s], a);
#pragma unroll
      for (int r = 0; r < 4; ++r) vn[it][r] = bf2f(ul[(it * 16 + quad * 4 + r) * 72 + wave * 16 + l15]) - a[r];
    }
    bf16x8 vb[2];
    vb[0] = pack8(vn[0], vn[1]); vb[1] = pack8(vn[2], vn[3]);
#pragma unroll
    for (int it = 0; it < 4; ++it) {
      f32x4 a = {0.f, 0.f, 0.f, 0.f};
#pragma unroll
      for (int s = 0; s < 4; ++s) a = MFMA16(*(const bf16x8*)(ql + (it * 16 + l15) * 136 + s * 32 + quad * 8), sb[s], a);
#pragma unroll
      for (int s = 0; s < 2; ++s) a = MFMA16(*(const bf16x8*)(il + (it * 16 + l15) * 72 + s * 32 + quad * 8), vb[s], a);
#pragma unroll
      for (int r = 0; r < 4; ++r) ub[(it * 16 + quad * 4 + r) * 128 + e0] = f2bf(a[r]);
    }
#pragma unroll
    for (int mt = 0; mt < 8; ++mt) {
      f32x4 a = S[mt];
      a[0] *= eg; a[1] *= eg; a[2] *= eg; a[3] *= eg;
#pragma unroll
      for (int s = 0; s < 2; ++s) a = MFMA16(*(const bf16x8*)(kl + (mt * 16 + l15) * 72 + s * 32 + quad * 8), vb[s], a);
      S[mt] = a;
    }
    __syncthreads();
    if (n + 1 < 64) CH_LSTORE();
    __syncthreads();
  }
}

DI void phase_mix(const Params& p, int i, bf16_t* smem) {
  if (BID() < 64) { dn_chain_item(p, BID(), smem); return; }
  phase_dil_attn(p, BID() - 64, GDIM() - 64);
}

DI void phase_dn_post(const Params& p, int i) {
  const bf16_t* ob = (const bf16_t*)(p.ws + OFF_UB);
  bf16_t* z = (bf16_t*)(p.ws + OFF_Z);
  const float* ng = p.dn_norm_g + i * 128;
  const int wave = TID() >> 6, lane = TID() & 63;
  const int N = T_ * 4;
  for (int base = BID() * 4; base < N; base += GDIM() * 4) {
    const int item = base + wave;
    const int t = item >> 2, h = item & 3, b = t >> 12, sidx = t & 4095;
    const size_t g = (size_t)item * 128 + lane * 2;
    const size_t og = ((size_t)((b * 4 + h) * 64 + (sidx >> 6))) * 8192 + (sidx & 63) * 128 + lane * 2;
    unsigned ov = *(const unsigned*)(ob + og), zv = *(const unsigned*)(z + g);
    float o0 = bf2f((bf16_t)(ov & 0xffff)), o1 = bf2f((bf16_t)(ov >> 16));
    float z0 = bf2f((bf16_t)(zv & 0xffff)), z1 = bf2f((bf16_t)(zv >> 16));
    float ms = wave_sum(o0 * o0 + o1 * o1) * (1.f / 128.f);
    float rr = rsqrtf(ms + 1e-6f);
    float r0 = o0 * rr * ng[lane * 2] * siluf_(z0), r1 = o1 * rr * ng[lane * 2 + 1] * siluf_(z1);
    *(unsigned*)(z + g) = pack2(r0, r1);
  }
}

struct MixLoad {
  const bf16_t* a; const bf16_t* b;
  DI uint4 operator()(int row, int ks, int kc) const {
    const unsigned off = (unsigned)((row * 512 + (ks & 7) * 64 + kc) * 2);
    return *(const uint4*)((const char*)((ks < 8) ? a : b) + off);
  }
};

DI void phase_wout(const Params& p, int i, bf16_t* smem) {
  const bf16_t* W = (const bf16_t*)(p.ws + OFF_W) + W_EVEN0 + (size_t)i * (SZ_WIN + SZ_SQ) + SZ_WIN;
  MixLoad al{(const bf16_t*)(p.ws + OFF_Z), (const bf16_t*)(p.ws + OFF_SWQ)};
  PlainLoad bl{W, 1024};
  {
    gemm_stream(256, 8, 16, al, bl, [&](f32x4 (&acc)[4][4], int rb, int cb) { epi_resid(p, acc, rb, cb); }, smem);
  }
}

DI void phase_ln(const Params& p, const float* g, const float* b) {
  const int wave = TID() >> 6, lane = TID() & 63;
  bf16_t* hb = (bf16_t*)(p.ws + OFF_HB);
  for (int row = BID() * 4 + wave; row < T_; row += GDIM() * 4) {
    float4* y = (float4*)(p.out + (size_t)row * 1024);
    float4 v[4];
    float s = 0.f;
#pragma unroll
    for (int i = 0; i < 4; ++i) { v[i] = y[lane + 64 * i]; s += v[i].x + v[i].y + v[i].z + v[i].w; }
    const float mu = wave_sum(s) * (1.f / 1024.f);
    float q = 0.f;
#pragma unroll
    for (int i = 0; i < 4; ++i) { float a = v[i].x - mu, b2 = v[i].y - mu, c = v[i].z - mu, d = v[i].w - mu; q += a * a + b2 * b2 + c * c + d * d; }
    const float rstd = rsqrtf(wave_sum(q) * (1.f / 1024.f) + 1e-5f);
#pragma unroll
    for (int i = 0; i < 4; ++i) {
      float4 gg = ((const float4*)g)[lane + 64 * i], bb = ((const float4*)b)[lane + 64 * i];
      float4 o;
      o.x = (v[i].x - mu) * rstd * gg.x + bb.x; o.y = (v[i].y - mu) * rstd * gg.y + bb.y;
      o.z = (v[i].z - mu) * rstd * gg.z + bb.z; o.w = (v[i].w - mu) * rstd * gg.w + bb.w;
      y[lane + 64 * i] = o;
      uint2 ob; ob.x = pack2(o.x, o.y); ob.y = pack2(o.z, o.w);
      ((uint2*)(hb + (size_t)row * 1024))[lane + 64 * i] = ob;
    }
  }
}

DI void phase_s5_naive(const Params& p, int i) {
  const int wave = TID() >> 6, lane = TID() & 63;
  bf16_t* hid = (bf16_t*)(p.ws + OFF_HID);
  for (int base = BID() * 4; base < 512; base += GDIM() * 4) {
    const int item = base + wave, b = item >> 6, g = item & 63;
    const int gp = (i * 64 + g) * 64 + lane;
    const double dt = exp((double)p.s5_log_dt[i * 64 + g]);
    const double are = p.s5_a_re[gp], aim = p.s5_a_im[gp];
    const double lr = are * dt, li = aim * dt;
    const double kk = rint(li * 0.15915494309189535);
    const double red = li - kk * 6.283185307179586;
    const double e = exp(lr);
    const double abr = e * cos(red), abi = e * sin(red);
    const double den = are * are + aim * aim;
    const double nr = abr - 1.0, ni = abi;
    const double cfr = (nr * are + ni * aim) / den, cfi = (ni * are - nr * aim) / den;
    float bbr[16], bbi[16], cr[16], ci[16];
#pragma unroll
    for (int h = 0; h < 16; ++h) {
      const double br = p.s5_b_re[(size_t)gp * 16 + h], bi = p.s5_b_im[(size_t)gp * 16 + h];
      bbr[h] = (float)(cfr * br - cfi * bi); bbi[h] = (float)(cfr * bi + cfi * br);
      cr[h] = p.s5_c_re[((size_t)(i * 64 + g) * 16 + h) * 64 + lane];
      ci[h] = p.s5_c_im[((size_t)(i * 64 + g) * 16 + h) * 64 + lane];
    }
    const float ar = (float)abr, ai = (float)abi;
    const float dsk = p.s5_d[i * 1024 + g * 16 + (lane & 15)];
    float sr = 0.f, si = 0.f;
#pragma unroll 1
    for (int t = 0; t < S_; ++t) {
      const size_t row = (size_t)(b * S_ + t);
      const float4* up = (const float4*)(p.out + row * 1024 + g * 16);
      float u[16];
#pragma unroll
      for (int j = 0; j < 4; ++j) { float4 v = up[j]; u[4 * j] = v.x; u[4 * j + 1] = v.y; u[4 * j + 2] = v.z; u[4 * j + 3] = v.w; }
      float bur = 0.f, bui = 0.f;
#pragma unroll
      for (int h = 0; h < 16; ++h) { bur += bbr[h] * u[h]; bui += bbi[h] * u[h]; }
      const float nsr = ar * sr - ai * si + bur, nsi = ar * si + ai * sr + bui;
      sr = nsr; si = nsi;
      float yk = 0.f, uk = 0.f;
#pragma unroll
      for (int h = 0; h < 16; ++h) {
        float v = wave_sum(cr[h] * sr - ci[h] * si);
        if (lane == h) { yk = v; uk = u[h]; }
      }
      if (lane < 16) hid[row * 1024 + g * 16 + lane] = f2bf(gelu_tanh(yk + dsk * uk));
    }
  }
}

DI void phase_s5_tables(const Params& p, int i, float* smem) {
  float2* pw = (float2*)smem;
  float2* bb = pw + 64 * 33;
  float2* cc = bb + 64 * 16;
  bf16_t* Ktab = (bf16_t*)(p.ws + OFF_KTAB); bf16_t* Etab = (bf16_t*)(p.ws + OFF_ETAB); bf16_t* Gtab = (bf16_t*)(p.ws + OFF_GTAB);
  float2* AL = (float2*)(p.ws + OFF_AL);
  const int tid = TID();
  for (int item = BID(); item < 512; item += GDIM()) {
    const int g = item >> 3, part = item & 7;
    const double dt = exp((double)p.s5_log_dt[i * 64 + g]);
    for (int e = tid; e < 64 * 33; e += 256) {
      const int pp = e / 33, n = e - pp * 33;
      const double are = p.s5_a_re[(i * 64 + g) * 64 + pp], aim = p.s5_a_im[(i * 64 + g) * 64 + pp];
      const double lr = are * dt * n, li = aim * dt * n;
      const double k = rint(li * 0.15915494309189535);
      const double red = li - k * 6.283185307179586;
      const double ex = exp(lr);
      pw[e] = make_float2((float)(ex * cos(red)), (float)(ex * sin(red)));
    }
    for (int e = tid; e < 1024; e += 256) {
      const int pp = e >> 4;
      const int gp = (i * 64 + g) * 64 + pp;
      const double are = p.s5_a_re[gp], aim = p.s5_a_im[gp];
      const double lr = are * dt, li = aim * dt;
      const double k = rint(li * 0.15915494309189535);
      const double red = li - k * 6.283185307179586;
      const double ex = exp(lr);
      const double nr = ex * cos(red) - 1.0, ni = ex * sin(red);
      const double den = are * are + aim * aim;
      const double cfr = (nr * are + ni * aim) / den, cfi = (ni * are - nr * aim) / den;
      const double br = p.s5_b_re[(size_t)gp * 16 + (e & 15)], bi = p.s5_b_im[(size_t)gp * 16 + (e & 15)];
      bb[e] = make_float2((float)(cfr * br - cfi * bi), (float)(cfr * bi + cfi * br));
      const size_t ci = ((size_t)(i * 64 + g) * 16 + (e >> 6)) * 64 + (e & 63);
      cc[e] = make_float2(p.s5_c_re[ci], p.s5_c_im[ci]);
    }
    __syncthreads();
    for (int e = part * 1024 + tid; e < (part + 1) * 1024; e += 256) {
      const int tau = e >> 8, ho = (e >> 4) & 15, hi = e & 15;
      float acc = 0.f;
      for (int pp = 0; pp < 64; ++pp) {
        const float2 c = cc[ho * 64 + pp], w = pw[pp * 33 + tau], b = bb[pp * 16 + hi];
        const float cwr = c.x * w.x - c.y * w.y, cwi = c.x * w.y + c.y * w.x;
        acc += cwr * b.x - cwi * b.y;
      }
      Ktab[(size_t)g * 8192 + e] = f2bf(acc);
    }
    for (int e = part * 8192 + tid; e < (part + 1) * 8192; e += 256) {
      const int pc = e >> 9, sidx = (e >> 4) & 31, hi = e & 15, pp = pc & 63;
      const float2 w = pw[pp * 33 + 31 - sidx], b = bb[pp * 16 + hi];
      const float v = (pc < 64) ? (w.x * b.x - w.y * b.y) : (w.x * b.y + w.y * b.x);
      Etab[(size_t)g * 65536 + e] = f2bf(v);
    }
    for (int e = part * 8192 + tid; e < (part + 1) * 8192; e += 256) {
      const int row = e >> 7, pc = e & 127, pp = pc & 63, t = row >> 4, ho = row & 15;
      const float2 c = cc[ho * 64 + pp], w = pw[pp * 33 + t + 1];
      const float v = (pc < 64) ? (c.x * w.x - c.y * w.y) : -(c.x * w.y + c.y * w.x);
      Gtab[(size_t)g * 65536 + e] = f2bf(v);
    }
    if (tid < 64 && part == 0) AL[g * 64 + tid] = pw[tid * 33 + 32];
    __syncthreads();
  }
}

DI void phase_s5_end(const Params& p, bf16_t* smem) {
  const bf16_t* Etab = (const bf16_t*)(p.ws + OFF_ETAB); const bf16_t* hb = (const bf16_t*)(p.ws + OFF_HB);
  const float2* AL = (const float2*)(p.ws + OFF_AL);
  bf16_t* sin_ = (bf16_t*)(p.ws + OFF_SIN);
  float* endbuf = (float*)smem;
  for (int item = BID(); item < 512; item += GDIM()) {
    const int g = item >> 3, b = item & 7;
    auto al = [=](int row, int ks, int kc) { return *(const uint4*)((const char*)Etab + (unsigned)((((g * 128 + row) * 512) + ks * 64 + kc) * 2)); };
    auto bl = [=](int n, int ks, int kc) {
      const int k = ks * 64 + kc, sidx = k >> 4, hi0 = k & 15;
      return *(const uint4*)((const char*)hb + (unsigned)(((b * 4096 + n * 32 + sidx) * 1024 + g * 16 + hi0) * 2));
    };
    gemm_tile(0, 0, 8, al, bl, [&](f32x4 (&acc)[4][4], int rb, int cb) {
      const int lane = TID() & 63, l15 = lane & 15, quad = lane >> 4;
#pragma unroll
      for (int mt = 0; mt < 4; ++mt)
#pragma unroll
        for (int nt = 0; nt < 4; ++nt)
#pragma unroll
          for (int r = 0; r < 4; ++r) endbuf[(rb + mt * 16 + l15) * 129 + cb + nt * 16 + quad * 4 + r] = acc[mt][nt][r];
    }, smem);
    __syncthreads();
    if (TID() < 64) {
      const int pp = TID();
      const float2 a = AL[g * 64 + pp];
      float sr = 0.f, si = 0.f;
      for (int n = 0; n < 128; ++n) {
        bf16_t* dst = sin_ + ((size_t)g * 1024 + b * 128 + n) * 128;
        dst[pp] = f2bf(sr); dst[64 + pp] = f2bf(si);
        const float er = endbuf[pp * 129 + n], ei = endbuf[(64 + pp) * 129 + n];
        const float nr = a.x * sr - a.y * si + er, ni = a.x * si + a.y * sr + ei;
        sr = nr; si = ni;
      }
    }
    __syncthreads();
  }
}

DI void phase_s5_y(const Params& p, int i, bf16_t* smem) {
  const bf16_t* Ktab = (const bf16_t*)(p.ws + OFF_KTAB); const bf16_t* Gtab = (const bf16_t*)(p.ws + OFF_GTAB);
  const bf16_t* hb = (const bf16_t*)(p.ws + OFF_HB); const bf16_t* sin_ = (const bf16_t*)(p.ws + OFF_SIN);
  bf16_t* hid = (bf16_t*)(p.ws + OFF_HID);
  for (int w = BID(); w < 2048; w += GDIM()) {
    const int g = w >> 5, mtile = (w >> 3) & 3, b = w & 7;
    const int nT = mtile * 2 + 2;
    auto al = [=](int row, int ks, int kc) -> uint4 {
      if (ks < nT) {
        const int k = ks * 64 + kc, sidx = k >> 4, hi0 = k & 15, t = row >> 4, ho = row & 15;
        if (t >= sidx) return *(const uint4*)((const char*)Ktab + (unsigned)(((((g * 32 + (t - sidx)) * 16 + ho) * 16) + hi0) * 2));
        return make_uint4(0, 0, 0, 0);
      }
      return *(const uint4*)((const char*)Gtab + (unsigned)((((g * 512 + row) * 128) + (ks - nT) * 64 + kc) * 2));
    };
    auto bl = [=](int n, int ks, int kc) -> uint4 {
      if (ks < nT) {
        const int k = ks * 64 + kc, sidx = k >> 4, hi0 = k & 15;
        return *(const uint4*)((const char*)hb + (unsigned)(((b * 4096 + n * 32 + sidx) * 1024 + g * 16 + hi0) * 2));
      }
      return *(const uint4*)((const char*)sin_ + (unsigned)((((g * 1024 + b * 128 + n) * 128) + (ks - nT) * 64 + kc) * 2));
    };
    gemm_tile(0, mtile * 128, nT + 2, bl, al, [&](f32x4 (&acc)[4][4], int rb, int cb) {
      const int lane = TID() & 63, l15 = lane & 15, quad = lane >> 4;
      const float4 dsk = *(const float4*)(p.s5_d + i * 1024 + g * 16 + quad * 4);
#pragma unroll
      for (int mt = 0; mt < 4; ++mt)
#pragma unroll
        for (int nt = 0; nt < 4; ++nt) {
          const int t = (cb + nt * 16) >> 4, n = rb + mt * 16 + l15;
          const size_t tok = (size_t)b * 4096 + n * 32 + t;
          const float4 u = *(const float4*)(p.out + tok * 1024 + g * 16 + quad * 4);
          u32x2 v;
          v[0] = pack2(gelu_tanh(acc[mt][nt][0] + dsk.x * u.x), gelu_tanh(acc[mt][nt][1] + dsk.y * u.y));
          v[1] = pack2(gelu_tanh(acc[mt][nt][2] + dsk.z * u.z), gelu_tanh(acc[mt][nt][3] + dsk.w * u.w));
          *(u32x2*)(hid + tok * 1024 + g * 16 + quad * 4) = v;
        }
    }, smem);
  }
}

DI void phase_glu(const Params& p, int i, bf16_t* smem) {
  const bf16_t* W = (const bf16_t*)(p.ws + OFF_W) + W_ODD0 + (size_t)i * SZ_GLU;
  PlainLoad al{(const bf16_t*)(p.ws + OFF_HID), 1024}, bl{W, 1024};
  {
    gemm_stream(256, 16, 16, al, bl, [&](f32x4 (&acc)[4][4], int rb, int cb) {
      const int lane = TID() & 63, l15 = lane & 15, quad = lane >> 4;
#pragma unroll
      for (int mt = 0; mt < 4; ++mt)
#pragma unroll
        for (int np = 0; np < 2; ++np) {
          float4* ptr = (float4*)(p.out + (size_t)(rb + mt * 16 + l15) * 1024 + (cb >> 1) + np * 16 + quad * 4);
          float4 h = *ptr;
          h.x = ALPHA * h.x + acc[mt][2 * np][0] * sigmoidf_(acc[mt][2 * np + 1][0]);
          h.y = ALPHA * h.y + acc[mt][2 * np][1] * sigmoidf_(acc[mt][2 * np + 1][1]);
          h.z = ALPHA * h.z + acc[mt][2 * np][2] * sigmoidf_(acc[mt][2 * np + 1][2]);
          h.w = ALPHA * h.w + acc[mt][2 * np][3] * sigmoidf_(acc[mt][2 * np + 1][3]);
          *ptr = h;
        }
    }, smem);
  }
}

DI void phase_xproj(const Params& p, int l, bf16_t* smem) {
  const bf16_t* wc = (const bf16_t*)(p.ws + OFF_W) + (size_t)l * SZ_COMMON;
  {
    PlainLoad al{(const bf16_t*)(p.ws + OFF_HB), 1024}, bl{wc, 1024};
    bf16_t* q = (bf16_t*)(p.ws + OFF_XQ);
    gemm_stream(256, 8, 16, al, bl, [&](f32x4 (&acc)[4][4], int rb, int cb) { epi_bf16(q, 1024, acc, rb, cb); }, smem);
  }
  {
    const float* memf = p.mem;
    auto al = [=](int row, int ks, int kc) -> uint4 {
      const float4* src = (const float4*)((const char*)memf + (unsigned)((row * 1024 + ks * 64 + kc) * 4));
      float4 a = src[0], b2 = src[1];
      return make_uint4(pack2(a.x, a.y), pack2(a.z, a.w), pack2(b2.x, b2.y), pack2(b2.z, b2.w));
    };
    bf16_t* kx = (bf16_t*)(p.ws + OFF_KX); bf16_t* vx = (bf16_t*)(p.ws + OFF_VX);
    for_tiles(16, 16, [&](int mi, int ni) {
      const bool isv = ni >= 8;
      PlainLoad bl{isv ? (wc + 2 * SZ_SQ) : (wc + SZ_SQ), 1024};
      gemm_tile(mi * 128, (ni & 7) * 128, 16, al, bl, [&](f32x4 (&acc)[4][4], int rb, int cb) {
        if (!isv) { epi_bf16(kx, 1024, acc, rb, cb); return; }
        const int lane = TID() & 63, l15 = lane & 15, quad = lane >> 4;
#pragma unroll
        for (int mt = 0; mt < 4; ++mt)
#pragma unroll
          for (int nt = 0; nt < 4; ++nt) {
            const int row = rb + mt * 16 + l15, col = cb + nt * 16 + quad * 4;
            const int b = row >> 8, key = row & 255, h = col >> 8, d = col & 255;
            bf16_t* dst = vx + ((size_t)((b * 4 + h) * 256 + d)) * 256 + key;
#pragma unroll
            for (int r = 0; r < 4; ++r) dst[r * 256] = f2bf(acc[mt][nt][r]);
          }
      }, smem);
    });
  }
}


DI void phase_xattn(const Params& p) {
  const int wave = TID() >> 6, lane = TID() & 63, l15 = lane & 15, quad = lane >> 4;
  const bf16_t* q = (const bf16_t*)(p.ws + OFF_XQ); const bf16_t* kx = (const bf16_t*)(p.ws + OFF_KX); const bf16_t* vxT = (const bf16_t*)(p.ws + OFF_VX);
  bf16_t* xo = (bf16_t*)(p.ws + OFF_XO);
  for (int item = BID(); item < 2048; item += GDIM()) {
    const int b = item >> 8, h = (item >> 6) & 3, qb = item & 63;
    const size_t tq = (size_t)b * 4096 + qb * 64 + wave * 16 + l15;
    bf16x8 qf[8];
#pragma unroll
    for (int ks = 0; ks < 8; ++ks) qf[ks] = *(const bf16x8*)(q + tq * 1024 + h * 256 + ks * 32 + quad * 8);
    f32x4 s[16];
#pragma unroll
    for (int mt = 0; mt < 16; ++mt) {
      const bf16_t* kp = kx + (size_t)(b * 256 + mt * 16 + l15) * 1024 + h * 256 + quad * 8;
      f32x4 a = {0.f, 0.f, 0.f, 0.f};
#pragma unroll
      for (int ks = 0; ks < 8; ++ks) a = MFMA16(*(const bf16x8*)(kp + ks * 32), qf[ks], a);
      s[mt] = a;
      if (mt & 1) __builtin_amdgcn_sched_barrier(0);
    }
    float m = -1e30f;
#pragma unroll
    for (int mt = 0; mt < 16; ++mt)
#pragma unroll
      for (int r = 0; r < 4; ++r) m = fmaxf(m, s[mt][r]);
    m = fmaxf(m, __shfl_xor(m, 16)); m = fmaxf(m, __shfl_xor(m, 32));
    const float c1 = 0.0625f * 1.4426950408889634f;
    float l = 0.f;
#pragma unroll
    for (int mt = 0; mt < 16; ++mt)
#pragma unroll
      for (int r = 0; r < 4; ++r) { float pv = exp2f((s[mt][r] - m) * c1); s[mt][r] = pv; l += pv; }
    l += __shfl_xor(l, 16); l += __shfl_xor(l, 32);
    f32x4 o[16];
#pragma unroll
    for (int dt = 0; dt < 16; ++dt) o[dt] = f32x4{0.f, 0.f, 0.f, 0.f};
#pragma unroll
    for (int s2 = 0; s2 < 8; ++s2) {
      const bf16x8 pf = pack8(s[2 * s2], s[2 * s2 + 1]);
#pragma unroll
      for (int dt = 0; dt < 16; ++dt) {
        const bf16_t* vp = vxT + ((size_t)((b * 4 + h) * 256 + dt * 16 + l15)) * 256 + s2 * 32 + quad * 4;
        u32x2 lo = *(const u32x2*)vp, hi = *(const u32x2*)(vp + 16);
        u32x4 t; t[0] = lo[0]; t[1] = lo[1]; t[2] = hi[0]; t[3] = hi[1];
        o[dt] = MFMA16(__builtin_bit_cast(bf16x8, t), pf, o[dt]);
      }
      __builtin_amdgcn_sched_barrier(0);
    }
    const float il = 1.f / l;
#pragma unroll
    for (int dt = 0; dt < 16; ++dt) {
      u32x2 v; v[0] = pack2(o[dt][0] * il, o[dt][1] * il); v[1] = pack2(o[dt][2] * il, o[dt][3] * il);
      *(u32x2*)(xo + tq * 1024 + h * 256 + dt * 16 + quad * 4) = v;
    }
  }
}

template <int R, int NT>
DI void dil_branch(const bf16_t* swk, const bf16_t* swv, size_t rowbase, int h, int tok0, const bf16x8 (&qf)[2], float& m, float& l, f32x4 (&o)[4],
                   int l15, int quad) {
  constexpr int U = 16 / R, W = 128 * R;
  f32x4 s[NT];
#pragma unroll
  for (int kt = 0; kt < NT; ++kt) {
    int kap = tok0 - W + R * (kt * 16 + l15);
    kap = min(max(kap, 0), 4095);
    const bf16_t* kp = swk + (rowbase + kap) * 512 + h * 64 + quad * 8;
    f32x4 a = {0.f, 0.f, 0.f, 0.f};
    a = MFMA16(*(const bf16x8*)kp, qf[0], a);
    a = MFMA16(*(const bf16x8*)(kp + 32), qf[1], a);
    s[kt] = a;
    if ((kt & 3) == 3) __builtin_amdgcn_sched_barrier(0);
  }
  float mx = m;
  const float c1 = 0.125f * 1.4426950408889634f;
#pragma unroll
  for (int kt = 0; kt < NT; ++kt)
#pragma unroll
    for (int r2 = 0; r2 < 4; ++r2) {
      const int c = kt * 16 + quad * 4 + r2;
      const int dist = U * l15 + 128 - c;
      const int kap = tok0 - W + R * c;
      const bool ok = (dist >= 0) && (dist <= 128) && (kap >= 0);
      const float v = ok ? s[kt][r2] * c1 : -1e30f;
      s[kt][r2] = v; mx = fmaxf(mx, v);
    }
  mx = fmaxf(mx, __shfl_xor(mx, 16)); mx = fmaxf(mx, __shfl_xor(mx, 32));
  const float corr = exp2f(m - mx);
  m = mx; l *= corr;
#pragma unroll
  for (int dt = 0; dt < 4; ++dt) { o[dt][0] *= corr; o[dt][1] *= corr; o[dt][2] *= corr; o[dt][3] *= corr; }
#pragma unroll
  for (int kt = 0; kt < NT; ++kt)
#pragma unroll
    for (int r2 = 0; r2 < 4; ++r2) { float pv = exp2f(s[kt][r2] - mx); s[kt][r2] = pv; l += pv; }
  constexpr int NS = (NT + 1) / 2;
#pragma unroll
  for (int s2 = 0; s2 < NS; ++s2) {
    const f32x4 z4 = {0.f, 0.f, 0.f, 0.f};
    const bf16x8 pf = pack8(s[2 * s2], (2 * s2 + 1 < NT) ? s[(2 * s2 + 1 < NT) ? 2 * s2 + 1 : 0] : z4);
    u32x2 vv[8];
#pragma unroll
    for (int j = 0; j < 8; ++j) {
      const int c = (2 * s2 + (j >> 2)) * 16 + quad * 4 + (j & 3);
      int kap = tok0 - W + R * c;
      kap = min(max(kap, 0), 4095);
      vv[j] = *(const u32x2*)(swv + (rowbase + kap) * 512 + h * 64 + 4 * l15);
    }
#pragma unroll
    for (int t4 = 0; t4 < 4; ++t4) {
      u32x4 t;
#pragma unroll
      for (int m = 0; m < 4; ++m) {
        const unsigned a = vv[2 * m][t4 >> 1], b2 = vv[2 * m + 1][t4 >> 1];
        t[m] = (t4 & 1) ? ((a >> 16) | (b2 & 0xffff0000u)) : ((a & 0xffffu) | (b2 << 16));
      }
      o[t4] = MFMA16(__builtin_bit_cast(bf16x8, t), pf, o[t4]);
    }
    __builtin_amdgcn_sched_barrier(0);
  }
}

DI void phase_dil_attn(const Params& p, int first, int nblk) {
  const int wave = TID() >> 6, lane = TID() & 63, l15 = lane & 15, quad = lane >> 4;
  bf16_t* swq = (bf16_t*)(p.ws + OFF_SWQ); const bf16_t* swk = (const bf16_t*)(p.ws + OFF_SWK); const bf16_t* swv = (const bf16_t*)(p.ws + OFF_SWV);
  for (int item = first; item < 4096; item += nblk) {
    const int b = item >> 9, h = (item >> 6) & 7, G = (item >> 2) & 15, sub = item & 3;
    const int tok0 = G * 256 + sub * 4 + wave;
    const size_t rowbase = (size_t)b * 4096;
    const size_t tq = rowbase + tok0 + 16 * l15;
    bf16x8 qf[2];
    qf[0] = *(const bf16x8*)(swq + tq * 512 + h * 64 + quad * 8);
    qf[1] = *(const bf16x8*)(swq + tq * 512 + h * 64 + 32 + quad * 8);
    float m = -1e30f, l = 0.f;
    f32x4 o[4];
#pragma unroll
    for (int dt = 0; dt < 4; ++dt) o[dt] = f32x4{0.f, 0.f, 0.f, 0.f};
    dil_branch<16, 9>(swk, swv, rowbase, h, tok0, qf, m, l, o, l15, quad);
    dil_branch<4, 12>(swk, swv, rowbase, h, tok0, qf, m, l, o, l15, quad);
    dil_branch<1, 24>(swk, swv, rowbase, h, tok0, qf, m, l, o, l15, quad);
    l += __shfl_xor(l, 16); l += __shfl_xor(l, 32);
    const float il = 1.f / l;
    u32x4 w0, w1;
    w0[0] = pack2(o[0][0] * il, o[1][0] * il); w0[1] = pack2(o[2][0] * il, o[3][0] * il);
    w0[2] = pack2(o[0][1] * il, o[1][1] * il); w0[3] = pack2(o[2][1] * il, o[3][1] * il);
    w1[0] = pack2(o[0][2] * il, o[1][2] * il); w1[1] = pack2(o[2][2] * il, o[3][2] * il);
    w1[2] = pack2(o[0][3] * il, o[1][3] * il); w1[3] = pack2(o[2][3] * il, o[3][3] * il);
    *(u32x4*)(swq + tq * 512 + h * 64 + quad * 16) = w0;
    *(u32x4*)(swq + tq * 512 + h * 64 + quad * 16 + 8) = w1;
  }
}

DI void phase_xo(const Params& p, int l, bf16_t* smem) {
  const bf16_t* wc = (const bf16_t*)(p.ws + OFF_W) + (size_t)l * SZ_COMMON + 3 * SZ_SQ;
  PlainLoad al{(const bf16_t*)(p.ws + OFF_XO), 1024}, bl{wc, 1024};
  {
    gemm_stream(256, 8, 16, al, bl, [&](f32x4 (&acc)[4][4], int rb, int cb) { epi_resid(p, acc, rb, cb); }, smem);
  }
}

DI void phase_ffn_gu(const Params& p, int l, bf16_t* smem) {
  const bf16_t* W = (const bf16_t*)(p.ws + OFF_W) + (size_t)l * SZ_COMMON + 4 * SZ_SQ;
  PlainLoad al{(const bf16_t*)(p.ws + OFF_HB), 1024}, bl{W, 1024};
  bf16_t* act = (bf16_t*)(p.ws + OFF_ACT);
  {
    gemm_stream(256, 44, 16, al, bl, [&](f32x4 (&acc)[4][4], int rb, int cb) {
      const int lane = TID() & 63, l15 = lane & 15, quad = lane >> 4;
#pragma unroll
      for (int mt = 0; mt < 4; ++mt)
#pragma unroll
        for (int np = 0; np < 2; ++np) {
          u32x2 v;
          v[0] = pack2(siluf_(acc[mt][2 * np][0]) * acc[mt][2 * np + 1][0], siluf_(acc[mt][2 * np][1]) * acc[mt][2 * np + 1][1]);
          v[1] = pack2(siluf_(acc[mt][2 * np][2]) * acc[mt][2 * np + 1][2], siluf_(acc[mt][2 * np][3]) * acc[mt][2 * np + 1][3]);
          *(u32x2*)(act + (size_t)(rb + mt * 16 + l15) * 2816 + (cb >> 1) + np * 16 + quad * 4) = v;
        }
    }, smem);
  }
}
DI void phase_ffn_down(const Params& p, int l, bf16_t* smem) {
  const bf16_t* W = (const bf16_t*)(p.ws + OFF_W) + (size_t)l * SZ_COMMON + 4 * SZ_SQ + SZ_GU;
  PlainLoad al{(const bf16_t*)(p.ws + OFF_ACT), 2816}, bl{W, 2816};
  {
    gemm_stream(256, 8, 44, al, bl, [&](f32x4 (&acc)[4][4], int rb, int cb) { epi_resid(p, acc, rb, cb); }, smem);
  }
}


#define XB_TMO      128
#define XB_XCNT(j)  (256  + 64 * (j))
#define XB_XSUB(j)  (1280 + 64 * (j))
#define XB_XGEN(j)  (2304 + 64 * (j))
#define XB_TOP      3328
#define XB_TOPGEN   3392
#define XCD_BAR_WORDS 3456
#define XB_SPIN_CAP (1u << 22)
#define LAS __attribute__((address_space(3)))
DI unsigned xb_ld(unsigned* p) { return __hip_atomic_load(p, __ATOMIC_RELAXED, __HIP_MEMORY_SCOPE_AGENT); }
DI unsigned xb_add(unsigned* p, unsigned v) { return __hip_atomic_fetch_add(p, v, __ATOMIC_RELAXED, __HIP_MEMORY_SCOPE_AGENT); }
DI unsigned xb_xcc_id() { return (unsigned)__builtin_amdgcn_s_getreg((3 << 11) | 20) & 0xFu; }
#define XB_SPIN(cond, bar) do { unsigned _sp = 0; while (cond) { __builtin_amdgcn_s_sleep(1); \
    if ((++_sp & 255u) == 0u) { if (xb_ld(&(bar)[XB_TMO])) break; if (_sp > XB_SPIN_CAP) { atomicAdd(&(bar)[XB_TMO], 1u); break; } } } } while (0)
struct XcdBarrier { unsigned* bar; unsigned x; volatile LAS unsigned* st; };
DI XcdBarrier xcd_barrier_post(unsigned* bar, volatile LAS unsigned* st) {
  XcdBarrier b; b.bar = bar; b.x = xb_xcc_id(); b.st = st;
  if (threadIdx.x == 0) (void)xb_add(&bar[XB_XCNT(b.x)], 1u);
  return b;
}
DI void xcd_barrier_complete(unsigned* bar, unsigned x, unsigned& nloc, unsigned& nx) {
  const unsigned G = gridDim.x * gridDim.y * gridDim.z;
  unsigned sum, cnt, mine, sp = 0u;
  for (;;) {
    sum = 0u; cnt = 0u; mine = 0u;
#pragma unroll
    for (unsigned j = 0; j < 16; ++j) { const unsigned c = xb_ld(&bar[XB_XCNT(j)]); sum += c; cnt += (c > 0u) ? 1u : 0u; mine = (j == x) ? c : mine; }
    if (sum == G) break;
    __builtin_amdgcn_s_sleep(1);
    if ((++sp & 255u) == 0u) { if (xb_ld(&bar[XB_TMO])) break; if (sp > XB_SPIN_CAP) { atomicAdd(&bar[XB_TMO], 1u); break; } }
  }
  nloc = mine > 0u ? mine : 1u; nx = cnt > 0u ? cnt : 1u;
}
DI void xcd_barrier(const XcdBarrier& b) {
  asm volatile("s_waitcnt vmcnt(0)" ::: "memory");
  __syncthreads();
  if (threadIdx.x == 0) {
    unsigned* bar = b.bar;
    __builtin_amdgcn_s_waitcnt(0);
    unsigned nloc = b.st[0], nx = b.st[1];
    if (nloc == 0u) { xcd_barrier_complete(bar, b.x, nloc, nx); b.st[0] = nloc; b.st[1] = nx; }
    const unsigned old = xb_add(&bar[XB_XSUB(b.x)], 1u);
    const unsigned gen = old / nloc;
    if (old + 1u == (gen + 1u) * nloc) {
      __builtin_amdgcn_fence(__ATOMIC_RELEASE, "agent");
      asm volatile("s_waitcnt vmcnt(0)" ::: "memory");
      const unsigned og = xb_add(&bar[XB_TOP], 1u);
      const unsigned tg = og / nx;
      if (og + 1u == (tg + 1u) * nx) xb_add(&bar[XB_TOPGEN], 1u);
      else XB_SPIN(xb_ld(&bar[XB_TOPGEN]) == tg, bar);
      __builtin_amdgcn_fence(__ATOMIC_ACQUIRE, "agent");
      xb_add(&bar[XB_XGEN(b.x)], 1u);
      asm volatile("s_waitcnt vmcnt(0)" ::: "memory");
    } else {
      XB_SPIN(xb_ld(&bar[XB_XGEN(b.x)]) == gen, bar);
      __builtin_amdgcn_fence(__ATOMIC_ACQUIRE, "agent");
      asm volatile("s_waitcnt vmcnt(0)" ::: "memory");
    }
  }
  __syncthreads();
}

__global__ void __launch_bounds__(256, 2) fwd_megakernel(Params p) {
  cg::grid_group grid = cg::this_grid();
  __shared__ __attribute__((aligned(16))) char smem_raw[2 * 2 * 128 * LDT * 2];
  bf16_t* sm16 = (bf16_t*)smem_raw; float* sm32 = (float*)smem_raw;

  __shared__ uint4 xb_words;
  if (threadIdx.x == 0) xb_words = make_uint4(0u, 0u, 0u, 0u);
  __syncthreads();
  XcdBarrier xb = xcd_barrier_post((unsigned*)(p.ws + OFF_BAR), (volatile LAS unsigned*)&xb_words);
  phase_prologue(p, sm32);
  grid.sync();
  for (int l = 0; l < 4; ++l) {
    const int i = l >> 1;
    if ((l & 1) == 0) {
      phase_proj(p, i, sm16); xcd_barrier(xb);
      phase_dn_prep(p, i, smem_raw); xcd_barrier(xb);
      phase_mix(p, i, sm16); xcd_barrier(xb);
      phase_dn_post(p, i); xcd_barrier(xb);
      phase_wout(p, i, sm16); xcd_barrier(xb);
    } else {
#if USE_S5_GEMM
      phase_s5_tables(p, i, sm32); xcd_barrier(xb);
      phase_s5_end(p, sm16); xcd_barrier(xb);
      phase_s5_y(p, i, sm16); xcd_barrier(xb);
#else
      phase_s5_naive(p, i); xcd_barrier(xb);
#endif
      phase_glu(p, i, sm16); xcd_barrier(xb);
    }
    phase_ln(p, p.ln_mix_g + l * 1024, p.ln_mix_b + l * 1024); xcd_barrier(xb);
    phase_xproj(p, l, sm16); xcd_barrier(xb);
    phase_xattn(p); xcd_barrier(xb);
    phase_xo(p, l, sm16); xcd_barrier(xb);
    phase_ln(p, p.ln_x_g + l * 1024, p.ln_x_b + l * 1024); xcd_barrier(xb);
    phase_ffn_gu(p, l, sm16); xcd_barrier(xb);
    phase_ffn_down(p, l, sm16); xcd_barrier(xb);
    phase_ln(p, p.ln_ffn_g + l * 1024, p.ln_ffn_b + l * 1024); xcd_barrier(xb);
  }
}

extern "C" void kernel_launch(void* const* d_in, const int* in_sizes, int n_in, void* d_out, int out_size, void* d_ws, size_t ws_size,
                              hipStream_t stream) {
  static int grid_blocks = 0;
  if (!grid_blocks) {
    int dev = 0, cus = 0, per_cu = 0;
    hipGetDevice(&dev);
    hipDeviceGetAttribute(&cus, hipDeviceAttributeMultiprocessorCount, dev);
    hipOccupancyMaxActiveBlocksPerMultiprocessor(&per_cu, fwd_megakernel, 256, 0);
    if (per_cu > 2) per_cu = 2;
    if (per_cu < 1) per_cu = 1;
    grid_blocks = cus * per_cu;
    grid_blocks -= grid_blocks % 8;
  }
  Params p{};
  const float** pf = (const float**)&p;
  for (int i = 0; i < 32; ++i) pf[i] = (const float*)d_in[i];
  p.pos = (const int*)d_in[2];
  p.out = (float*)d_out; p.ws = (char*)d_ws;
  hipMemsetAsync((char*)d_ws + OFF_BAR, 0, XCD_BAR_WORDS * sizeof(unsigned), stream);
  void* args[] = {&p};
  hipError_t e = hipLaunchCooperativeKernel((void*)fwd_megakernel, dim3(grid_blocks), dim3(256), args, 0, stream);
  if (e != hipSuccess) fprintf(stderr, "cooperative launch failed: %s (grid %d)\n", hipGetErrorString(e), grid_blocks);
}
```

```cpp
#include <hip/hip_runtime.h>
#include <hip/hip_cooperative_groups.h>
#include <cstdio>
namespace cg = cooperative_groups;
#ifndef USE_XATTN_MFMA
#define USE_XATTN_MFMA 1
#endif
#ifndef USE_S5_GEMM
#define USE_S5_GEMM 1
#endif
#ifndef USE_DIL_MFMA
#define USE_DIL_MFMA 1
#endif

typedef unsigned short bf16_t;
using bf16x8 = __attribute__((ext_vector_type(8))) short;
using f32x4 = __attribute__((ext_vector_type(4))) float;
#define DI __device__ __forceinline__

constexpr int T_ = 32768, S_ = 4096;
constexpr size_t MiB = (size_t)1 << 20;
constexpr size_t SZ_SQ = (size_t)1024 * 1024, SZ_WIN = (size_t)3712 * 1024, SZ_GLU = (size_t)2048 * 1024,
                 SZ_GU = (size_t)5632 * 1024, SZ_WD = (size_t)1024 * 2816;
constexpr size_t SZ_COMMON = 4 * SZ_SQ + SZ_GU + SZ_WD;
constexpr size_t W_EVEN0 = 4 * SZ_COMMON;
constexpr size_t W_ODD0 = W_EVEN0 + 2 * (SZ_WIN + SZ_SQ);
constexpr float ALPHA = 1.681792830507429f;

constexpr size_t OFF_W = 0;
constexpr size_t OFF_ROPE = 125 * MiB;
constexpr size_t OFF_HB = 133 * MiB;
constexpr size_t OFF_KX = 197 * MiB;
constexpr size_t OFF_VX = 201 * MiB;
constexpr size_t OFF_BIG = 205 * MiB;
constexpr size_t OFF_BAR = 511 * MiB;
constexpr size_t OFF_DNQKV = OFF_BIG;
constexpr size_t OFF_Z = OFF_BIG + 96 * MiB;
constexpr size_t OFF_SWQ = OFF_BIG + 128 * MiB;
constexpr size_t OFF_SWK = OFF_BIG + 160 * MiB;
constexpr size_t OFF_SWV = OFF_BIG + 192 * MiB;
constexpr size_t OFF_LOGIT = OFF_BIG + 224 * MiB;
constexpr size_t OFF_QD = OFF_BIG + 225 * MiB;
constexpr size_t OFF_KD = OFF_BIG + 257 * MiB;
constexpr size_t OFF_INTRA = OFF_BIG + 289 * MiB;
constexpr size_t OFF_WB = OFF_HB;
constexpr size_t OFF_UB = OFF_HB + 32 * MiB;
constexpr size_t OFF_EG = OFF_KX;
constexpr size_t OFF_XQ = OFF_BIG;
constexpr size_t OFF_XO = OFF_BIG + 64 * MiB;
constexpr size_t OFF_ACT = OFF_BIG;
constexpr size_t OFF_HID = OFF_BIG;
constexpr size_t OFF_SIN = OFF_BIG + 64 * MiB;
constexpr size_t OFF_KTAB = OFF_BIG + 80 * MiB;
constexpr size_t OFF_ETAB = OFF_BIG + 82 * MiB;
constexpr size_t OFF_GTAB = OFF_BIG + 90 * MiB;
constexpr size_t OFF_AL = OFF_BIG + 98 * MiB;

struct Params {
  const float* x; const float* mem; const int* pos;
  const float* hyb_w_in; const float* dn_conv_w; const float* dn_a_log; const float* dn_dt_bias; const float* dn_norm_g; const float* hyb_w_out;
  const float* s5_a_re; const float* s5_a_im; const float* s5_log_dt; const float* s5_b_re; const float* s5_b_im; const float* s5_c_re; const float* s5_c_im;
  const float* s5_d; const float* s5_glu_wo; const float* s5_glu_wg;
  const float* ln_mix_g; const float* ln_mix_b;
  const float* xq_w; const float* xk_w; const float* xv_w; const float* xo_w; const float* ln_x_g; const float* ln_x_b;
  const float* ffn_wg; const float* ffn_wu; const float* ffn_wd; const float* ln_ffn_g; const float* ln_ffn_b;
  float* out; char* ws;
};

DI int TID() { int t = threadIdx.x; asm volatile("" : "+v"(t)); return t; }
DI int BID() { int t = blockIdx.x; asm volatile("" : "+s"(t)); return t; }
DI int GDIM() { int t = gridDim.x; asm volatile("" : "+s"(t)); return t; }
DI bf16_t f2bf(float x) { unsigned u = __float_as_uint(x); u += 0x7fffu + ((u >> 16) & 1u); return (bf16_t)(u >> 16); }
DI float bf2f(bf16_t v) { return __uint_as_float(((unsigned)v) << 16); }
DI unsigned pack2(float a, float b) { return (unsigned)f2bf(a) | ((unsigned)f2bf(b) << 16); }
using u32x4 = __attribute__((ext_vector_type(4))) unsigned;
using u32x2 = __attribute__((ext_vector_type(2))) unsigned;
DI bf16x8 pack8(f32x4 a, f32x4 b) {
  u32x4 t; t[0] = pack2(a[0], a[1]); t[1] = pack2(a[2], a[3]); t[2] = pack2(b[0], b[1]); t[3] = pack2(b[2], b[3]);
  return __builtin_bit_cast(bf16x8, t);
}
#define MFMA16(a, b, c) __builtin_amdgcn_mfma_f32_16x16x32_bf16((a), (b), (c), 0, 0, 0)
DI int kperm(int x) { return (x & ~31) | (((x >> 2) & 3) * 8 + ((x >> 4) & 1) * 4 + (x & 3)); }
DI float wave_sum(float v) { for (int o = 32; o > 0; o >>= 1) v += __shfl_xor(v, o); return v; }
DI float wave_max(float v) { for (int o = 32; o > 0; o >>= 1) v = fmaxf(v, __shfl_xor(v, o)); return v; }
DI float sigmoidf_(float x) { return 1.f / (1.f + __expf(-x)); }
DI float siluf_(float x) { return x * sigmoidf_(x); }
DI float softplusf_(float x) { return fmaxf(x, 0.f) + log1pf(__expf(-fabsf(x))); }
DI float gelu_tanh(float x) { float u = 0.7978845608028654f * (x + 0.044715f * x * x * x); return 0.5f * x * (1.f + tanhf(u)); }

template <class CM>
DI void transpose_job(bf16_t* dst, int Ndst, int K, int srcStride, CM colptr, float* tile) {
  const int ntk = K / 64, ntiles = (Ndst / 64) * ntk;
  const int tid = TID();
  for (int tl = BID(); tl < ntiles; tl += GDIM()) {
    const int r0 = (tl / ntk) * 64, k0 = (tl % ntk) * 64;
    const int q4 = tid & 15, kl0 = tid >> 4;
    const float* cp = colptr(r0 + 4 * q4);
    float4 v[4];
#pragma unroll
    for (int i = 0; i < 4; ++i) v[i] = cp ? *(const float4*)(cp + (size_t)(k0 + kl0 + 16 * i) * srcStride) : make_float4(0.f, 0.f, 0.f, 0.f);
#pragma unroll
    for (int i = 0; i < 4; ++i) {
      float* t = tile + (kl0 + 16 * i) * 65 + 4 * q4;
      t[0] = v[i].x; t[1] = v[i].y; t[2] = v[i].z; t[3] = v[i].w;
    }
    __syncthreads();
#pragma unroll
    for (int i = 0; i < 2; ++i) {
      const int c = tid + 256 * i, rr = c >> 3, kc = (c & 7) * 8;
      const float* t = tile + kc * 65 + rr;
      uint4 o;
      o.x = pack2(t[0], t[65]); o.y = pack2(t[2 * 65], t[3 * 65]); o.z = pack2(t[4 * 65], t[5 * 65]); o.w = pack2(t[6 * 65], t[7 * 65]);
      *(uint4*)(dst + (size_t)(r0 + rr) * K + k0 + kc) = o;
    }
    __syncthreads();
  }
}

DI void phase_prologue(const Params& p, float* smem) {
  bf16_t* W = (bf16_t*)(p.ws + OFF_W);
  for (int l = 0; l < 4; ++l) {
    bf16_t* wc = W + (size_t)l * SZ_COMMON;
    const float* s;
    s = p.xq_w + (size_t)l * SZ_SQ; transpose_job(wc, 1024, 1024, 1024, [=](int r) { return s + r; }, smem);
    s = p.xk_w + (size_t)l * SZ_SQ; transpose_job(wc + SZ_SQ, 1024, 1024, 1024, [=](int r) { return s + r; }, smem);
    s = p.xv_w + (size_t)l * SZ_SQ; transpose_job(wc + 2 * SZ_SQ, 1024, 1024, 1024, [=](int r) { return s + r; }, smem);
    s = p.xo_w + (size_t)l * SZ_SQ; transpose_job(wc + 3 * SZ_SQ, 1024, 1024, 1024, [=](int r) { return s + r; }, smem);
    {
      const float* g = p.ffn_wg + (size_t)l * 1024 * 2816; const float* u = p.ffn_wu + (size_t)l * 1024 * 2816;
      transpose_job(wc + 4 * SZ_SQ, 5632, 1024, 2816, [=](int r) { int c = (r >> 5) * 16 + (r & 15); return ((r >> 4) & 1) ? (u + c) : (g + c); }, smem);
    }
    s = p.ffn_wd + (size_t)l * 2816 * 1024; transpose_job(wc + 4 * SZ_SQ + SZ_GU, 1024, 2816, 1024, [=](int r) { return s + r; }, smem);
  }
  for (int i = 0; i < 2; ++i) {
    bf16_t* we = W + W_EVEN0 + (size_t)i * (SZ_WIN + SZ_SQ);
    const float* s = p.hyb_w_in + (size_t)i * 1024 * 3592;
    transpose_job(we, 3712, 1024, 3592, [=](int r) -> const float* {
      if (r < 2048) return s + r;
      if (r < 3584) return s + r + 8;
      if (r < 3592) return s + 2048 + (r - 3584);
      return nullptr; }, smem);
    const float* s2 = p.hyb_w_out + (size_t)i * SZ_SQ;
    transpose_job(we + SZ_WIN, 1024, 1024, 1024, [=](int r) { return s2 + r; }, smem);
    bf16_t* wo = W + W_ODD0 + (size_t)i * SZ_GLU;
    const float* a = p.s5_glu_wo + (size_t)i * SZ_SQ; const float* b = p.s5_glu_wg + (size_t)i * SZ_SQ;
    transpose_job(wo, 2048, 1024, 1024, [=](int r) { int c = (r >> 5) * 16 + (r & 15); return ((r >> 4) & 1) ? (b + c) : (a + c); }, smem);
  }
  const size_t gtid = (size_t)BID() * 256 + TID(), gsz = (size_t)GDIM() * 256;
  bf16_t* hb = (bf16_t*)(p.ws + OFF_HB);
  for (size_t i = gtid; i < (size_t)T_ * 256; i += gsz) {
    float4 v = ((const float4*)p.x)[i];
    ((float4*)p.out)[i] = v;
    uint2 o; o.x = pack2(v.x, v.y); o.y = pack2(v.z, v.w);
    ((uint2*)hb)[i] = o;
  }
  float* rc = (float*)(p.ws + OFF_ROPE); float* rs = rc + (size_t)T_ * 32;
  for (size_t i = gtid; i < (size_t)T_ * 32; i += gsz) {
    int t = (int)(i >> 5), j = (int)(i & 31);
    float invf = (float)exp(-(double)(2 * j) / 64.0 * 9.210340371976184);
    float ang = (float)p.pos[t] * invf;
    double a = (double)ang;
    double k = rint(a * 0.15915494309189535);
    float r = (float)(a - k * 6.283185307179586);
    rc[i] = cosf(r); rs[i] = sinf(r);
  }
}

constexpr int LDT = 72;
template <class AL, class BL, class EP>
DI void gemm_tile(int m0, int n0, int nks, AL aload, BL bload, EP epi, bf16_t* smem) {
  bf16_t* As = smem; bf16_t* Bs = smem + 2 * 128 * LDT;
  const int tid = TID(), lane = tid & 63, wave = tid >> 6;
  const int wm = wave >> 1, wn = wave & 1, l15 = lane & 15, quad = lane >> 4;
  const int lrow = tid >> 3, lkc = (tid & 7) * 8;
  f32x4 acc[4][4];
#pragma unroll
  for (int i = 0; i < 4; ++i)
#pragma unroll
    for (int j = 0; j < 4; ++j) acc[i][j] = f32x4{0.f, 0.f, 0.f, 0.f};
  uint4 ra0[4], rb0[4], ra1[4], rb1[4];
#pragma unroll
  for (int i = 0; i < 4; ++i) { ra0[i] = aload(m0 + lrow + 32 * i, 0, lkc); rb0[i] = bload(n0 + lrow + 32 * i, 0, lkc); }
#pragma unroll
  for (int i = 0; i < 4; ++i) { ra1[i] = aload(m0 + lrow + 32 * i, 1, lkc); rb1[i] = bload(n0 + lrow + 32 * i, 1, lkc); }
#pragma unroll
  for (int i = 0; i < 4; ++i) {
    *(uint4*)(As + (lrow + 32 * i) * LDT + lkc) = ra0[i];
    *(uint4*)(Bs + (lrow + 32 * i) * LDT + lkc) = rb0[i];
  }
  __syncthreads();
  auto compute = [&](int cur) {
    const bf16_t* Ab = As + cur * 128 * LDT; const bf16_t* Bb = Bs + cur * 128 * LDT;
#pragma unroll
    for (int kk = 0; kk < 2; ++kk) {
      bf16x8 a[4], b[4];
#pragma unroll
      for (int mt = 0; mt < 4; ++mt) a[mt] = *(const bf16x8*)(Ab + (wm * 64 + mt * 16 + l15) * LDT + kk * 32 + quad * 8);
#pragma unroll
      for (int nt = 0; nt < 4; ++nt) b[nt] = *(const bf16x8*)(Bb + (wn * 64 + nt * 16 + l15) * LDT + kk * 32 + quad * 8);
#pragma unroll
      for (int mt = 0; mt < 4; ++mt)
#pragma unroll
        for (int nt = 0; nt < 4; ++nt) acc[mt][nt] = __builtin_amdgcn_mfma_f32_16x16x32_bf16(b[nt], a[mt], acc[mt][nt], 0, 0, 0);
    }
  };
  for (int ks = 0; ks < nks; ks += 2) {
    if (ks + 2 < nks) {
#pragma unroll
      for (int i = 0; i < 4; ++i) { ra0[i] = aload(m0 + lrow + 32 * i, ks + 2, lkc); rb0[i] = bload(n0 + lrow + 32 * i, ks + 2, lkc); }
    }
    compute(0);
#pragma unroll
    for (int i = 0; i < 4; ++i) {
      *(uint4*)(As + 128 * LDT + (lrow + 32 * i) * LDT + lkc) = ra1[i];
      *(uint4*)(Bs + 128 * LDT + (lrow + 32 * i) * LDT + lkc) = rb1[i];
    }
    __syncthreads();
    if (ks + 3 < nks) {
#pragma unroll
      for (int i = 0; i < 4; ++i) { ra1[i] = aload(m0 + lrow + 32 * i, ks + 3, lkc); rb1[i] = bload(n0 + lrow + 32 * i, ks + 3, lkc); }
    }
    compute(1);
    if (ks + 2 < nks) {
#pragma unroll
      for (int i = 0; i < 4; ++i) {
        *(uint4*)(As + (lrow + 32 * i) * LDT + lkc) = ra0[i];
        *(uint4*)(Bs + (lrow + 32 * i) * LDT + lkc) = rb0[i];
      }
    }
    __syncthreads();
  }
  epi(acc, m0 + wm * 64, n0 + wn * 64);
}

DI void tile_of(int w, int mtiles, int ntiles, int xcd, int& m0, int& n0) {
  const int mper = mtiles >> 3, full = mper * 8;
  int gidx = w / full;
  const int ngroups = (ntiles + 7) >> 3;
  if (gidx > ngroups - 1) gidx = ngroups - 1;
  const int rest = w - gidx * full;
  const int wg = min(8, ntiles - 8 * gidx);
  const int ml = rest / wg, ni = 8 * gidx + (rest - ml * wg);
  m0 = (ml * 8 + xcd) * 128; n0 = ni * 128;
}
template <class AL, class BL, class EP>
DI void gemm_stream(int mtiles, int ntiles, int nks, AL aload, BL bload, EP epi, bf16_t* smem) {
  const int xcd = BID() & 7, slot = BID() >> 3, nslot = GDIM() >> 3;
  const int per = (mtiles >> 3) * ntiles;
  if (slot >= per) return;
  bf16_t* As = smem; bf16_t* Bs = smem + 2 * 128 * LDT;
  const int tid = TID(), lane = tid & 63, wave = tid >> 6;
  const int wm = wave >> 1, wc = wave & 1, l15 = lane & 15, quad = lane >> 4;
  const int lrow = tid >> 3, lkc = (tid & 7) * 8;
  f32x4 acc[4][4];
  uint4 ra0[4], rb0[4], ra1[4], rb1[4];
  int w = slot;
  int m0, n0;
  tile_of(w, mtiles, ntiles, xcd, m0, n0);
#pragma unroll
  for (int i = 0; i < 4; ++i) { ra0[i] = aload(m0 + lrow + 32 * i, 0, lkc); rb0[i] = bload(n0 + lrow + 32 * i, 0, lkc); }
#pragma unroll
  for (int i = 0; i < 4; ++i) { ra1[i] = aload(m0 + lrow + 32 * i, 1, lkc); rb1[i] = bload(n0 + lrow + 32 * i, 1, lkc); }
#pragma unroll
  for (int i = 0; i < 4; ++i) {
    *(uint4*)(As + (lrow + 32 * i) * LDT + lkc) = ra0[i];
    *(uint4*)(Bs + (lrow + 32 * i) * LDT + lkc) = rb0[i];
  }
  __syncthreads();
  auto compute = [&](int cur) {
    const bf16_t* Ab = As + cur * 128 * LDT; const bf16_t* Bb = Bs + cur * 128 * LDT;
#pragma unroll
    for (int kk = 0; kk < 2; ++kk) {
      bf16x8 a[4], b[4];
#pragma unroll
      for (int mt = 0; mt < 4; ++mt) a[mt] = *(const bf16x8*)(Ab + (wm * 64 + mt * 16 + l15) * LDT + kk * 32 + quad * 8);
#pragma unroll
      for (int nt = 0; nt < 4; ++nt) b[nt] = *(const bf16x8*)(Bb + (wc * 64 + nt * 16 + l15) * LDT + kk * 32 + quad * 8);
#pragma unroll
      for (int mt = 0; mt < 4; ++mt)
#pragma unroll
        for (int nt = 0; nt < 4; ++nt) acc[mt][nt] = __builtin_amdgcn_mfma_f32_16x16x32_bf16(b[nt], a[mt], acc[mt][nt], 0, 0, 0);
    }
  };
  for (;;) {
    const int wnext = w + nslot;
    const bool has_next = wnext < per;
    int m1 = 0, n1 = 0;
    if (has_next) tile_of(wnext, mtiles, ntiles, xcd, m1, n1);
#pragma unroll
    for (int i = 0; i < 4; ++i)
#pragma unroll
      for (int j = 0; j < 4; ++j) acc[i][j] = f32x4{0.f, 0.f, 0.f, 0.f};
    for (int ks = 0; ks < nks; ks += 2) {
      const bool in2 = ks + 2 < nks;
      if (in2 || has_next) {
        const int mm = in2 ? m0 : m1, nn = in2 ? n0 : n1, kq = in2 ? ks + 2 : 0;
#pragma unroll
        for (int i = 0; i < 4; ++i) { ra0[i] = aload(mm + lrow + 32 * i, kq, lkc); rb0[i] = bload(nn + lrow + 32 * i, kq, lkc); }
      }
      compute(0);
#pragma unroll
      for (int i = 0; i < 4; ++i) {
        *(uint4*)(As + 128 * LDT + (lrow + 32 * i) * LDT + lkc) = ra1[i];
        *(uint4*)(Bs + 128 * LDT + (lrow + 32 * i) * LDT + lkc) = rb1[i];
      }
      __syncthreads();
      if (in2 || has_next) {
        const int mm = in2 ? m0 : m1, nn = in2 ? n0 : n1, kq = in2 ? ks + 3 : 1;
#pragma unroll
        for (int i = 0; i < 4; ++i) { ra1[i] = aload(mm + lrow + 32 * i, kq, lkc); rb1[i] = bload(nn + lrow + 32 * i, kq, lkc); }
      }
      compute(1);
      if (in2 || has_next) {
#pragma unroll
        for (int i = 0; i < 4; ++i) {
          *(uint4*)(As + (lrow + 32 * i) * LDT + lkc) = ra0[i];
          *(uint4*)(Bs + (lrow + 32 * i) * LDT + lkc) = rb0[i];
        }
      }
      __syncthreads();
    }
    epi(acc, m0 + wm * 64, n0 + wc * 64);
    if (!has_next) break;
    w = wnext; m0 = m1; n0 = n1;
  }
}

template <class F>
DI void for_tiles(int mtiles, int ntiles, F f) {
  const int xcd = BID() & 7, slot = BID() >> 3, nslot = GDIM() >> 3;
  const int per = (mtiles >> 3) * ntiles;
  for (int w = slot; w < per; w += nslot) {
    int mi = w / ntiles, ni = w - mi * ntiles;
    f((mi * 8 + xcd), ni);
  }
}

#define EPI_LOOP for (int mt = 0; mt < 4; ++mt) for (int nt = 0; nt < 4; ++nt) for (int r = 0; r < 4; ++r)

DI void epi_resid(const Params& p, f32x4 (&acc)[4][4], int rb, int cb) {
  const int lane = TID() & 63, l15 = lane & 15, quad = lane >> 4;
#pragma unroll
  for (int mt = 0; mt < 4; ++mt)
#pragma unroll
    for (int nt = 0; nt < 4; ++nt) {
      float4* ptr = (float4*)(p.out + (size_t)(rb + mt * 16 + l15) * 1024 + cb + nt * 16 + quad * 4);
      float4 h = *ptr;
      h.x = ALPHA * h.x + acc[mt][nt][0]; h.y = ALPHA * h.y + acc[mt][nt][1]; h.z = ALPHA * h.z + acc[mt][nt][2]; h.w = ALPHA * h.w + acc[mt][nt][3];
      *ptr = h;
    }
}
DI void epi_bf16(bf16_t* dst, int ld, f32x4 (&acc)[4][4], int rb, int cb) {
  const int lane = TID() & 63, l15 = lane & 15, quad = lane >> 4;
#pragma unroll
  for (int mt = 0; mt < 4; ++mt)
#pragma unroll
    for (int nt = 0; nt < 4; ++nt) {
      u32x2 v; v[0] = pack2(acc[mt][nt][0], acc[mt][nt][1]); v[1] = pack2(acc[mt][nt][2], acc[mt][nt][3]);
      *(u32x2*)(dst + (size_t)(rb + mt * 16 + l15) * ld + cb + nt * 16 + quad * 4) = v;
    }
}

struct PlainLoad {
  const bf16_t* base; int ld;
  DI uint4 operator()(int row, int ks, int kc) const { return *(const uint4*)((const char*)base + (unsigned)((row * ld + ks * 64 + kc) * 2)); }
};

DI void phase_proj(const Params& p, int i, bf16_t* smem) {
  const bf16_t* W = (const bf16_t*)(p.ws + OFF_W) + W_EVEN0 + (size_t)i * (SZ_WIN + SZ_SQ);
  PlainLoad al{(const bf16_t*)(p.ws + OFF_HB), 1024}, bl{W, 1024};
  bf16_t* dnqkv = (bf16_t*)(p.ws + OFF_DNQKV); bf16_t* z = (bf16_t*)(p.ws + OFF_Z);
  bf16_t* swq = (bf16_t*)(p.ws + OFF_SWQ); bf16_t* swk = (bf16_t*)(p.ws + OFF_SWK); bf16_t* swv = (bf16_t*)(p.ws + OFF_SWV);
  float* logit = (float*)(p.ws + OFF_LOGIT);
  const float* rc = (const float*)(p.ws + OFF_ROPE); const float* rs = rc + (size_t)T_ * 32;
  {
    gemm_stream(256, 29, 16, al, bl, [&](f32x4 (&acc)[4][4], int rb, int cb) {
      const int lane = TID() & 63, l15 = lane & 15, quad = lane >> 4;
      if (cb < 1536) epi_bf16(dnqkv, 1536, acc, rb, cb);
      else if (cb < 2048) epi_bf16(z, 512, acc, rb, cb - 1536);
      else if (cb < 3072) {
        bf16_t* dst = (cb < 2560) ? swq : swk; const int c0 = (cb < 2560) ? cb - 2048 : cb - 2560;
#pragma unroll
        for (int mt = 0; mt < 4; ++mt) {
          const int row = rb + mt * 16 + l15;
#pragma unroll
          for (int nt = 0; nt < 2; ++nt) {
            const int d = nt * 16 + quad * 4;
            const float4 c = *(const float4*)(rc + (size_t)row * 32 + d), sn = *(const float4*)(rs + (size_t)row * 32 + d);
            const f32x4 x1 = acc[mt][nt], x2 = acc[mt][nt + 2];
            u32x2 o1, o2;
            o1[0] = pack2(x1[0] * c.x - x2[0] * sn.x, x1[1] * c.y - x2[1] * sn.y); o1[1] = pack2(x1[2] * c.z - x2[2] * sn.z, x1[3] * c.w - x2[3] * sn.w);
            o2[0] = pack2(x2[0] * c.x + x1[0] * sn.x, x2[1] * c.y + x1[1] * sn.y); o2[1] = pack2(x2[2] * c.z + x1[2] * sn.z, x2[3] * c.w + x1[3] * sn.w);
            *(u32x2*)(dst + (size_t)row * 512 + c0 + d) = o1;
            *(u32x2*)(dst + (size_t)row * 512 + c0 + d + 32) = o2;
          }
        }
      } else if (cb < 3584) epi_bf16(swv, 512, acc, rb, cb - 3072);
      else if (cb == 3584) {
        if (quad < 2) {
#pragma unroll
          for (int mt = 0; mt < 4; ++mt)
            *(float4*)(logit + (size_t)(rb + mt * 16 + l15) * 8 + quad * 4) = make_float4(acc[mt][0][0], acc[mt][0][1], acc[mt][0][2], acc[mt][0][3]);
        }
      }
    }, smem);
  }
}

DI void phase_dil_attn(const Params& p, int first, int nblk);

DI void phase_dn_prep(const Params& p, int i, char* smem) {
  bf16_t* qs = (bf16_t*)smem; bf16_t* ks = qs + 64 * 136; bf16_t* vs = ks + 64 * 136;
  float* Lm = (float*)(smem + 3 * 17408); float* beta = Lm + 64 * 68; float* gcum = beta + 64; float* egc = gcum + 64;
  const bf16_t* dnqkv = (const bf16_t*)(p.ws + OFF_DNQKV);
  const float* logit = (const float*)(p.ws + OFF_LOGIT);
  bf16_t* qd_g = (bf16_t*)(p.ws + OFF_QD); bf16_t* kd_g = (bf16_t*)(p.ws + OFF_KD); bf16_t* in_g = (bf16_t*)(p.ws + OFF_INTRA);
  bf16_t* w_g = (bf16_t*)(p.ws + OFF_WB); bf16_t* u_g = (bf16_t*)(p.ws + OFF_UB); float* eg_g = (float*)(p.ws + OFF_EG);
  const float* cw = p.dn_conv_w + (size_t)i * 4 * 1536;
  const int tid = TID(), wave = tid >> 6, lane = tid & 63, l15 = lane & 15, quad = lane >> 4;
  const float QS = 0.08838834764831845f;
  for (int item = BID(); item < 2048; item += GDIM()) {
    const int b = item >> 8, h = (item >> 6) & 3, n = item & 63;
    const int t0 = b * 4096 + n * 64, s0 = n * 64;
    const float A = __expf(p.dn_a_log[i * 4 + h]), dtb = p.dn_dt_bias[i * 4 + h];
    {
      float cw0[3][4], cw1[3][4], x0[3][4], x1[3][4];
#pragma unroll
      for (int which = 0; which < 3; ++which)
#pragma unroll
        for (int j = 0; j < 4; ++j) {
          const int col = which * 512 + h * 128 + lane * 2;
          cw0[which][j] = cw[j * 1536 + col]; cw1[which][j] = cw[j * 1536 + col + 1];
        }
      const int ilb = wave * 16;
#pragma unroll
      for (int which = 0; which < 3; ++which)
#pragma unroll
        for (int j = 0; j < 3; ++j) {
          const int sq = s0 + ilb - 3 + j;
          unsigned v = 0u;
          if (sq >= 0) v = *(const unsigned*)(dnqkv + (size_t)(t0 + ilb - 3 + j) * 1536 + which * 512 + h * 128 + lane * 2);
          x0[which][j + 1] = bf2f((bf16_t)(v & 0xffff)); x1[which][j + 1] = bf2f((bf16_t)(v >> 16));
        }
#pragma unroll 4
      for (int tt = 0; tt < 16; ++tt) {
        const int il = ilb + tt;
#pragma unroll
        for (int which = 0; which < 3; ++which) {
          x0[which][0] = x0[which][1]; x0[which][1] = x0[which][2]; x0[which][2] = x0[which][3];
          x1[which][0] = x1[which][1]; x1[which][1] = x1[which][2]; x1[which][2] = x1[which][3];
          const unsigned v = *(const unsigned*)(dnqkv + (size_t)(t0 + il) * 1536 + which * 512 + h * 128 + lane * 2);
          x0[which][3] = bf2f((bf16_t)(v & 0xffff)); x1[which][3] = bf2f((bf16_t)(v >> 16));
          float y0 = cw0[which][0] * x0[which][0] + cw0[which][1] * x0[which][1] + cw0[which][2] * x0[which][2] + cw0[which][3] * x0[which][3];
          float y1 = cw1[which][0] * x1[which][0] + cw1[which][1] * x1[which][1] + cw1[which][2] * x1[which][2] + cw1[which][3] * x1[which][3];
          y0 = siluf_(y0); y1 = siluf_(y1);
          if (which < 2) {
            float ss = wave_sum(y0 * y0 + y1 * y1);
            float sc = rsqrtf(ss + 1e-6f);
            y0 *= sc; y1 *= sc;
          }
          bf16_t* dst = (which == 0) ? qs : (which == 1 ? ks : vs);
          *(unsigned*)(dst + il * 136 + lane * 2) = pack2(y0, y1);
        }
      }
    }
    if (wave == 0) {
      const size_t row = (size_t)(t0 + lane);
      const float bl = logit[row * 8 + h], al = logit[row * 8 + 4 + h];
      float g = -A * softplusf_(al + dtb);
#pragma unroll
      for (int o = 1; o < 64; o <<= 1) { float v = __shfl_up(g, o); if (lane >= o) g += v; }
      beta[lane] = sigmoidf_(bl); gcum[lane] = g; egc[lane] = __expf(g);
    }
    __syncthreads();
    {
      f32x4 kk[4], qk[4];
#pragma unroll
      for (int nt = 0; nt < 4; ++nt) { kk[nt] = f32x4{0.f, 0.f, 0.f, 0.f}; qk[nt] = f32x4{0.f, 0.f, 0.f, 0.f}; }
#pragma unroll
      for (int k4 = 0; k4 < 4; ++k4) {
        const bf16x8 ak = *(const bf16x8*)(ks + (wave * 16 + l15) * 136 + k4 * 32 + quad * 8);
        const bf16x8 aq = *(const bf16x8*)(qs + (wave * 16 + l15) * 136 + k4 * 32 + quad * 8);
#pragma unroll
        for (int nt = 0; nt < 4; ++nt) {
          const bf16x8 bk = *(const bf16x8*)(ks + (nt * 16 + l15) * 136 + k4 * 32 + quad * 8);
          kk[nt] = MFMA16(ak, bk, kk[nt]); qk[nt] = MFMA16(aq, bk, qk[nt]);
        }
      }
#pragma unroll
      for (int nt = 0; nt < 4; ++nt)
#pragma unroll
        for (int r = 0; r < 4; ++r) {
          const int ii = wave * 16 + quad * 4 + r, jj = nt * 16 + l15;
          const float dec = (jj <= ii) ? __expf(gcum[ii] - gcum[jj]) : 0.f;
          Lm[ii * 68 + jj] = (jj < ii) ? beta[ii] * kk[nt][r] * dec : 0.f;
          in_g[(size_t)item * 4096 + ii * 64 + kperm(jj)] = f2bf(qk[nt][r] * QS * dec);
        }
    }
    __syncthreads();
    {
      float x[64];
#pragma unroll
      for (int ii = 0; ii < 64; ++ii) x[ii] = 0.f;
      const int c = tid & 127;
      const bool isw = tid >= 128;
      bf16_t* dstb = (isw ? w_g : u_g) + (size_t)item * 8192 + (isw ? kperm(c) : c);
      const bf16_t* srcb = (isw ? ks : vs) + c;
#pragma unroll
      for (int ii = 0; ii < 64; ++ii) {
        float acc = bf2f(srcb[ii * 136]) * beta[ii] * (isw ? egc[ii] : 1.f);
#pragma unroll
        for (int j4 = 0; j4 < (ii + 3) / 4; ++j4) {
          const float4 l4 = *(const float4*)(Lm + ii * 68 + j4 * 4);
          acc -= l4.x * x[j4 * 4]; acc -= l4.y * x[j4 * 4 + 1]; acc -= l4.z * x[j4 * 4 + 2]; acc -= l4.w * x[j4 * 4 + 3];
        }
        x[ii] = acc;
        dstb[ii * 128] = f2bf(acc);
        if ((ii & 3) == 3) __builtin_amdgcn_sched_barrier(0);
      }
    }
    {
      const float gl = gcum[63];
#pragma unroll 4
      for (int k = 0; k < 32; ++k) {
        const int e = tid + 256 * k;
        const int ii = e >> 7, d = e & 127;
        qd_g[(size_t)item * 8192 + ii * 128 + kperm(d)] = f2bf(bf2f(qs[ii * 136 + d]) * QS * egc[ii]);
        const int d2 = e >> 6, i2 = e & 63;
        kd_g[(size_t)item * 8192 + d2 * 64 + kperm(i2)] = f2bf(bf2f(ks[i2 * 136 + d2]) * __expf(gl - gcum[i2]));
      }
      if (tid == 0) eg_g[item] = __expf(gl);
    }
    __syncthreads();
  }
}

DI bf16x8 ld2(const bf16_t* ptr) {
  u32x2 lo = *(const u32x2*)ptr, hi = *(const u32x2*)(ptr + 16);
  u32x4 t; t[0] = lo[0]; t[1] = lo[1]; t[2] = hi[0]; t[3] = hi[1];
  return __builtin_bit_cast(bf16x8, t);
}

DI void dn_chain_item(const Params& p, int item, bf16_t* smem) {
  const int tid = TID(), wave = tid >> 6, lane = tid & 63, l15 = lane & 15, quad = lane >> 4;
  const int bh = item >> 1, half = item & 1;
  const int e0 = half * 64 + wave * 16 + l15;
  const bf16_t* qd_g = (const bf16_t*)(p.ws + OFF_QD); const bf16_t* kd_g = (const bf16_t*)(p.ws + OFF_KD); const bf16_t* in_g = (const bf16_t*)(p.ws + OFF_INTRA);
  const bf16_t* w_g = (const bf16_t*)(p.ws + OFF_WB); bf16_t* u_g = (bf16_t*)(p.ws + OFF_UB); const float* eg_g = (const float*)(p.ws + OFF_EG);
  bf16_t* wl = smem; bf16_t* ql = wl + 64 * 136; bf16_t* kl = ql + 64 * 136; bf16_t* il = kl + 128 * 72; bf16_t* ul = il + 64 * 72;
  uint4 rw0, rw1, rw2, rw3, rq0, rq1, rq2, rq3, rk0, rk1, rk2, rk3, ri0, ri1, ru0, ru1;
#define CH_GLOAD(n_) do { const size_t ci_ = (size_t)bh * 64 + (n_); \
    const bf16_t* w_ = w_g + ci_ * 8192 + tid * 8; const bf16_t* q_ = qd_g + ci_ * 8192 + tid * 8; const bf16_t* k_ = kd_g + ci_ * 8192 + tid * 8; \
    rw0 = *(const uint4*)(w_); rw1 = *(const uint4*)(w_ + 2048); rw2 = *(const uint4*)(w_ + 4096); rw3 = *(const uint4*)(w_ + 6144); \
    rq0 = *(const uint4*)(q_); rq1 = *(const uint4*)(q_ + 2048); rq2 = *(const uint4*)(q_ + 4096); rq3 = *(const uint4*)(q_ + 6144); \
    rk0 = *(const uint4*)(k_); rk1 = *(const uint4*)(k_ + 2048); rk2 = *(const uint4*)(k_ + 4096); rk3 = *(const uint4*)(k_ + 6144); \
    ri0 = *(const uint4*)(in_g + ci_ * 4096 + tid * 8); ri1 = *(const uint4*)(in_g + ci_ * 4096 + 2048 + tid * 8); \
    ru0 = *(const uint4*)(u_g + ci_ * 8192 + (tid >> 3) * 128 + half * 64 + (tid & 7) * 8); \
    ru1 = *(const uint4*)(u_g + ci_ * 8192 + (32 + (tid >> 3)) * 128 + half * 64 + (tid & 7) * 8); } while (0)
#define CH_LSTORE() do { \
    bf16_t* w_ = wl + (tid >> 4) * 136 + (tid & 15) * 8; bf16_t* q_ = ql + (tid >> 4) * 136 + (tid & 15) * 8; bf16_t* k_ = kl + (tid >> 3) * 72 + (tid & 7) * 8; \
    *(uint4*)(w_) = rw0; *(uint4*)(w_ + 16 * 136) = rw1; *(uint4*)(w_ + 32 * 136) = rw2; *(uint4*)(w_ + 48 * 136) = rw3; \
    *(uint4*)(q_) = rq0; *(uint4*)(q_ + 16 * 136) = rq1; *(uint4*)(q_ + 32 * 136) = rq2; *(uint4*)(q_ + 48 * 136) = rq3; \
    *(uint4*)(k_) = rk0; *(uint4*)(k_ + 32 * 72) = rk1; *(uint4*)(k_ + 64 * 72) = rk2; *(uint4*)(k_ + 96 * 72) = rk3; \
    *(uint4*)(il + (tid >> 3) * 72 + (tid & 7) * 8) = ri0; *(uint4*)(il + (32 + (tid >> 3)) * 72 + (tid & 7) * 8) = ri1; \
    *(uint4*)(ul + (tid >> 3) * 72 + (tid & 7) * 8) = ru0; *(uint4*)(ul + (32 + (tid >> 3)) * 72 + (tid & 7) * 8) = ru1; } while (0)
  f32x4 S[8];
#pragma unroll
  for (int mt = 0; mt < 8; ++mt) S[mt] = f32x4{0.f, 0.f, 0.f, 0.f};
  CH_GLOAD(0);
  CH_LSTORE();
  __syncthreads();
#pragma unroll 1
  for (int n = 0; n < 64; ++n) {
    const size_t ci = (size_t)bh * 64 + n;
    if (n + 1 < 64) CH_GLOAD(n + 1);
    bf16_t* ub = u_g + ci * 8192;
    const float eg = eg_g[ci];
    bf16x8 sb[4];
#pragma unroll
    for (int s = 0; s < 4; ++s) sb[s] = pack8(S[2 * s], S[2 * s + 1]);
    f32x4 vn[4];
#pragma unroll
    for (int it = 0; it < 4; ++it) {
      f32x4 a = {0.f, 0.f, 0.f, 0.f};
#pragma unroll
      for (int s = 0; s < 4; ++s) a = MFMA16(*(const bf16x8*)(wl + (it * 16 + l15) * 136 + s * 32 + quad * 8), sb[s], a);
#pragma unroll
      for (int r = 0; r < 4; ++r) vn[it][r] = bf2f(ul[(it * 16 + quad * 4 + r) * 72 + wave * 16 + l15]) - a[r];
    }
    bf16x8 vb[2];
    vb[0] = pack8(vn[0], vn[1]); vb[1] = pack8(vn[2], vn[3]);
#pragma unroll
    for (int it = 0; it < 4; ++it) {
      f32x4 a = {0.f, 0.f, 0.f, 0.f};
#pragma unroll
      for (int s = 0; s < 4; ++s) a = MFMA16(*(const bf16x8*)(ql + (it * 16 + l15) * 136 + s * 32 + quad * 8), sb[s], a);
#pragma unroll
      for (int s = 0; s < 2; ++s) a = MFMA16(*(const bf16x8*)(il + (it * 16 + l15) * 72 + s * 32 + quad * 8), vb[s], a);
#pragma unroll
      for (int r = 0; r < 4; ++r) ub[(it * 16 + quad * 4 + r) * 128 + e0] = f2bf(a[r]);
    }
#pragma unroll
    for (int mt = 0; mt < 8; ++mt) {
      f32x4 a = S[mt];
      a[0] *= eg; a[1] *= eg; a[2] *= eg; a[3] *= eg;
#pragma unroll
      for (int s = 0; s < 2; ++s) a = MFMA16(*(const bf16x8*)(kl + (mt * 16 + l15) * 72 + s * 32 + quad * 8), vb[s], a);
      S[mt] = a;
    }
    __syncthreads();
    if (n + 1 < 64) CH_LSTORE();
    __syncthreads();
  }
}

DI void phase_mix(const Params& p, int i, bf16_t* smem) {
  if (BID() < 64) { dn_chain_item(p, BID(), smem); return; }
  phase_dil_attn(p, BID() - 64, GDIM() - 64);
}

DI void phase_dn_post(const Params& p, int i) {
  const bf16_t* ob = (const bf16_t*)(p.ws + OFF_UB);
  bf16_t* z = (bf16_t*)(p.ws + OFF_Z);
  const float* ng = p.dn_norm_g + i * 128;
  const int wave = TID() >> 6, lane = TID() & 63;
  const int N = T_ * 4;
  for (int base = BID() * 4; base < N; base += GDIM() * 4) {
    const int item = base + wave;
    const int t = item >> 2, h = item & 3, b = t >> 12, sidx = t & 4095;
    const size_t g = (size_t)item * 128 + lane * 2;
    const size_t og = ((size_t)((b * 4 + h) * 64 + (sidx >> 6))) * 8192 + (sidx & 63) * 128 + lane * 2;
    unsigned ov = *(const unsigned*)(ob + og), zv = *(const unsigned*)(z + g);
    float o0 = bf2f((bf16_t)(ov & 0xffff)), o1 = bf2f((bf16_t)(ov >> 16));
    float z0 = bf2f((bf16_t)(zv & 0xffff)), z1 = bf2f((bf16_t)(zv >> 16));
    float ms = wave_sum(o0 * o0 + o1 * o1) * (1.f / 128.f);
    float rr = rsqrtf(ms + 1e-6f);
    float r0 = o0 * rr * ng[lane * 2] * siluf_(z0), r1 = o1 * rr * ng[lane * 2 + 1] * siluf_(z1);
    *(unsigned*)(z + g) = pack2(r0, r1);
  }
}

struct MixLoad {
  const bf16_t* a; const bf16_t* b;
  DI uint4 operator()(int row, int ks, int kc) const {
    const unsigned off = (unsigned)((row * 512 + (ks & 7) * 64 + kc) * 2);
    return *(const uint4*)((const char*)((ks < 8) ? a : b) + off);
  }
};

DI void phase_wout(const Params& p, int i, bf16_t* smem) {
  const bf16_t* W = (const bf16_t*)(p.ws + OFF_W) + W_EVEN0 + (size_t)i * (SZ_WIN + SZ_SQ) + SZ_WIN;
  MixLoad al{(const bf16_t*)(p.ws + OFF_Z), (const bf16_t*)(p.ws + OFF_SWQ)};
  PlainLoad bl{W, 1024};
  {
    gemm_stream(256, 8, 16, al, bl, [&](f32x4 (&acc)[4][4], int rb, int cb) { epi_resid(p, acc, rb, cb); }, smem);
  }
}

template <int R>
DI void ln_rows(const Params& p, int row0, const float* g, const float* b, int lane) {
  bf16_t* hb = (bf16_t*)(p.ws + OFF_HB);
  float4 v[R][4];
#pragma unroll
  for (int j = 0; j < R; ++j)
#pragma unroll
    for (int i = 0; i < 4; ++i) v[j][i] = ((const float4*)(p.out + (size_t)(row0 + j) * 1024))[lane + 64 * i];
  float4 gg[4], bb[4];
#pragma unroll
  for (int i = 0; i < 4; ++i) { gg[i] = ((const float4*)g)[lane + 64 * i]; bb[i] = ((const float4*)b)[lane + 64 * i]; }
#pragma unroll
  for (int j = 0; j < R; ++j) {
    float s = 0.f;
#pragma unroll
    for (int i = 0; i < 4; ++i) s += v[j][i].x + v[j][i].y + v[j][i].z + v[j][i].w;
    const float mu = wave_sum(s) * (1.f / 1024.f);
    float q = 0.f;
#pragma unroll
    for (int i = 0; i < 4; ++i) { float a = v[j][i].x - mu, b2 = v[j][i].y - mu, c = v[j][i].z - mu, d = v[j][i].w - mu; q += a * a + b2 * b2 + c * c + d * d; }
    const float rstd = rsqrtf(wave_sum(q) * (1.f / 1024.f) + 1e-5f);
    float4* y = (float4*)(p.out + (size_t)(row0 + j) * 1024);
#pragma unroll
    for (int i = 0; i < 4; ++i) {
      float4 o;
      o.x = (v[j][i].x - mu) * rstd * gg[i].x + bb[i].x; o.y = (v[j][i].y - mu) * rstd * gg[i].y + bb[i].y;
      o.z = (v[j][i].z - mu) * rstd * gg[i].z + bb[i].z; o.w = (v[j][i].w - mu) * rstd * gg[i].w + bb[i].w;
      y[lane + 64 * i] = o;
      uint2 ob; ob.x = pack2(o.x, o.y); ob.y = pack2(o.z, o.w);
      ((uint2*)(hb + (size_t)(row0 + j) * 1024))[lane + 64 * i] = ob;
    }
  }
}
DI void phase_ln(const Params& p, const float* g, const float* b) {
  const int wave = TID() >> 6, lane = TID() & 63;
  for (int row = (BID() * 4 + wave) * 4; row < T_; row += GDIM() * 16) ln_rows<4>(p, row, g, b, lane);
}

DI void phase_s5_naive(const Params& p, int i) {
  const int wave = TID() >> 6, lane = TID() & 63;
  bf16_t* hid = (bf16_t*)(p.ws + OFF_HID);
  for (int base = BID() * 4; base < 512; base += GDIM() * 4) {
    const int item = base + wave, b = item >> 6, g = item & 63;
    const int gp = (i * 64 + g) * 64 + lane;
    const double dt = exp((double)p.s5_log_dt[i * 64 + g]);
    const double are = p.s5_a_re[gp], aim = p.s5_a_im[gp];
    const double lr = are * dt, li = aim * dt;
    const double kk = rint(li * 0.15915494309189535);
    const double red = li - kk * 6.283185307179586;
    const double e = exp(lr);
    const double abr = e * cos(red), abi = e * sin(red);
    const double den = are * are + aim * aim;
    const double nr = abr - 1.0, ni = abi;
    const double cfr = (nr * are + ni * aim) / den, cfi = (ni * are - nr * aim) / den;
    float bbr[16], bbi[16], cr[16], ci[16];
#pragma unroll
    for (int h = 0; h < 16; ++h) {
      const double br = p.s5_b_re[(size_t)gp * 16 + h], bi = p.s5_b_im[(size_t)gp * 16 + h];
      bbr[h] = (float)(cfr * br - cfi * bi); bbi[h] = (float)(cfr * bi + cfi * br);
      cr[h] = p.s5_c_re[((size_t)(i * 64 + g) * 16 + h) * 64 + lane];
      ci[h] = p.s5_c_im[((size_t)(i * 64 + g) * 16 + h) * 64 + lane];
    }
    const float ar = (float)abr, ai = (float)abi;
    const float dsk = p.s5_d[i * 1024 + g * 16 + (lane & 15)];
    float sr = 0.f, si = 0.f;
#pragma unroll 1
    for (int t = 0; t < S_; ++t) {
      const size_t row = (size_t)(b * S_ + t);
      const float4* up = (const float4*)(p.out + row * 1024 + g * 16);
      float u[16];
#pragma unroll
      for (int j = 0; j < 4; ++j) { float4 v = up[j]; u[4 * j] = v.x; u[4 * j + 1] = v.y; u[4 * j + 2] = v.z; u[4 * j + 3] = v.w; }
      float bur = 0.f, bui = 0.f;
#pragma unroll
      for (int h = 0; h < 16; ++h) { bur += bbr[h] * u[h]; bui += bbi[h] * u[h]; }
      const float nsr = ar * sr - ai * si + bur, nsi = ar * si + ai * sr + bui;
      sr = nsr; si = nsi;
      float yk = 0.f, uk = 0.f;
#pragma unroll
      for (int h = 0; h < 16; ++h) {
        float v = wave_sum(cr[h] * sr - ci[h] * si);
        if (lane == h) { yk = v; uk = u[h]; }
      }
      if (lane < 16) hid[row * 1024 + g * 16 + lane] = f2bf(gelu_tanh(yk + dsk * uk));
    }
  }
}

DI void phase_s5_tables(const Params& p, int i, float* smem) {
  float2* pw = (float2*)smem;
  float2* bb = pw + 64 * 33;
  float2* cc = bb + 64 * 16;
  bf16_t* Ktab = (bf16_t*)(p.ws + OFF_KTAB); bf16_t* Etab = (bf16_t*)(p.ws + OFF_ETAB); bf16_t* Gtab = (bf16_t*)(p.ws + OFF_GTAB);
  float2* AL = (float2*)(p.ws + OFF_AL);
  const int tid = TID();
  for (int item = BID(); item < 512; item += GDIM()) {
    const int g = item >> 3, part = item & 7;
    const double dt = exp((double)p.s5_log_dt[i * 64 + g]);
    for (int e = tid; e < 64 * 33; e += 256) {
      const int pp = e / 33, n = e - pp * 33;
      const double are = p.s5_a_re[(i * 64 + g) * 64 + pp], aim = p.s5_a_im[(i * 64 + g) * 64 + pp];
      const double lr = are * dt * n, li = aim * dt * n;
      const double k = rint(li * 0.15915494309189535);
      const double red = li - k * 6.283185307179586;
      const double ex = exp(lr);
      pw[e] = make_float2((float)(ex * cos(red)), (float)(ex * sin(red)));
    }
    for (int e = tid; e < 1024; e += 256) {
      const int pp = e >> 4;
      const int gp = (i * 64 + g) * 64 + pp;
      const double are = p.s5_a_re[gp], aim = p.s5_a_im[gp];
      const double lr = are * dt, li = aim * dt;
      const double k = rint(li * 0.15915494309189535);
      const double red = li - k * 6.283185307179586;
      const double ex = exp(lr);
      const double nr = ex * cos(red) - 1.0, ni = ex * sin(red);
      const double den = are * are + aim * aim;
      const double cfr = (nr * are + ni * aim) / den, cfi = (ni * are - nr * aim) / den;
      const double br = p.s5_b_re[(size_t)gp * 16 + (e & 15)], bi = p.s5_b_im[(size_t)gp * 16 + (e & 15)];
      bb[e] = make_float2((float)(cfr * br - cfi * bi), (float)(cfr * bi + cfi * br));
      const size_t ci = ((size_t)(i * 64 + g) * 16 + (e >> 6)) * 64 + (e & 63);
      cc[e] = make_float2(p.s5_c_re[ci], p.s5_c_im[ci]);
    }
    __syncthreads();
    for (int e = part * 1024 + tid; e < (part + 1) * 1024; e += 256) {
      const int tau = e >> 8, ho = (e >> 4) & 15, hi = e & 15;
      float acc = 0.f;
      for (int pp = 0; pp < 64; ++pp) {
        const float2 c = cc[ho * 64 + pp], w = pw[pp * 33 + tau], b = bb[pp * 16 + hi];
        const float cwr = c.x * w.x - c.y * w.y, cwi = c.x * w.y + c.y * w.x;
        acc += cwr * b.x - cwi * b.y;
      }
      Ktab[(size_t)g * 8192 + e] = f2bf(acc);
    }
    for (int e = part * 8192 + tid; e < (part + 1) * 8192; e += 256) {
      const int pc = e >> 9, sidx = (e >> 4) & 31, hi = e & 15, pp = pc & 63;
      const float2 w = pw[pp * 33 + 31 - sidx], b = bb[pp * 16 + hi];
      const float v = (pc < 64) ? (w.x * b.x - w.y * b.y) : (w.x * b.y + w.y * b.x);
      Etab[(size_t)g * 65536 + e] = f2bf(v);
    }
    for (int e = part * 8192 + tid; e < (part + 1) * 8192; e += 256) {
      const int row = e >> 7, pc = e & 127, pp = pc & 63, t = row >> 4, ho = row & 15;
      const float2 c = cc[ho * 64 + pp], w = pw[pp * 33 + t + 1];
      const float v = (pc < 64) ? (c.x * w.x - c.y * w.y) : -(c.x * w.y + c.y * w.x);
      Gtab[(size_t)g * 65536 + e] = f2bf(v);
    }
    if (tid < 64 && part == 0) AL[g * 64 + tid] = pw[tid * 33 + 32];
    __syncthreads();
  }
}

DI void phase_s5_end(const Params& p, bf16_t* smem) {
  const bf16_t* Etab = (const bf16_t*)(p.ws + OFF_ETAB); const bf16_t* hb = (const bf16_t*)(p.ws + OFF_HB);
  const float2* AL = (const float2*)(p.ws + OFF_AL);
  bf16_t* sin_ = (bf16_t*)(p.ws + OFF_SIN);
  float* endbuf = (float*)smem;
  for (int item = BID(); item < 512; item += GDIM()) {
    const int g = item >> 3, b = item & 7;
    auto al = [=](int row, int ks, int kc) { return *(const uint4*)((const char*)Etab + (unsigned)((((g * 128 + row) * 512) + ks * 64 + kc) * 2)); };
    auto bl = [=](int n, int ks, int kc) {
      const int k = ks * 64 + kc, sidx = k >> 4, hi0 = k & 15;
      return *(const uint4*)((const char*)hb + (unsigned)(((b * 4096 + n * 32 + sidx) * 1024 + g * 16 + hi0) * 2));
    };
    gemm_tile(0, 0, 8, al, bl, [&](f32x4 (&acc)[4][4], int rb, int cb) {
      const int lane = TID() & 63, l15 = lane & 15, quad = lane >> 4;
#pragma unroll
      for (int mt = 0; mt < 4; ++mt)
#pragma unroll
        for (int nt = 0; nt < 4; ++nt)
#pragma unroll
          for (int r = 0; r < 4; ++r) endbuf[(rb + mt * 16 + l15) * 129 + cb + nt * 16 + quad * 4 + r] = acc[mt][nt][r];
    }, smem);
    __syncthreads();
    if (TID() < 64) {
      const int pp = TID();
      const float2 a = AL[g * 64 + pp];
      float sr = 0.f, si = 0.f;
      for (int n = 0; n < 128; ++n) {
        bf16_t* dst = sin_ + ((size_t)g * 1024 + b * 128 + n) * 128;
        dst[pp] = f2bf(sr); dst[64 + pp] = f2bf(si);
        const float er = endbuf[pp * 129 + n], ei = endbuf[(64 + pp) * 129 + n];
        const float nr = a.x * sr - a.y * si + er, ni = a.x * si + a.y * sr + ei;
        sr = nr; si = ni;
      }
    }
    __syncthreads();
  }
}

DI void phase_s5_y(const Params& p, int i, bf16_t* smem) {
  const bf16_t* Ktab = (const bf16_t*)(p.ws + OFF_KTAB); const bf16_t* Gtab = (const bf16_t*)(p.ws + OFF_GTAB);
  const bf16_t* hb = (const bf16_t*)(p.ws + OFF_HB); const bf16_t* sin_ = (const bf16_t*)(p.ws + OFF_SIN);
  bf16_t* hid = (bf16_t*)(p.ws + OFF_HID);
  for (int w = BID(); w < 2048; w += GDIM()) {
    const int g = w >> 5, mtile = (w >> 3) & 3, b = w & 7;
    const int nT = mtile * 2 + 2;
    auto al = [=](int row, int ks, int kc) -> uint4 {
      if (ks < nT) {
        const int k = ks * 64 + kc, sidx = k >> 4, hi0 = k & 15, t = row >> 4, ho = row & 15;
        if (t >= sidx) return *(const uint4*)((const char*)Ktab + (unsigned)(((((g * 32 + (t - sidx)) * 16 + ho) * 16) + hi0) * 2));
        return make_uint4(0, 0, 0, 0);
      }
      return *(const uint4*)((const char*)Gtab + (unsigned)((((g * 512 + row) * 128) + (ks - nT) * 64 + kc) * 2));
    };
    auto bl = [=](int n, int ks, int kc) -> uint4 {
      if (ks < nT) {
        const int k = ks * 64 + kc, sidx = k >> 4, hi0 = k & 15;
        return *(const uint4*)((const char*)hb + (unsigned)(((b * 4096 + n * 32 + sidx) * 1024 + g * 16 + hi0) * 2));
      }
      return *(const uint4*)((const char*)sin_ + (unsigned)((((g * 1024 + b * 128 + n) * 128) + (ks - nT) * 64 + kc) * 2));
    };
    gemm_tile(0, mtile * 128, nT + 2, bl, al, [&](f32x4 (&acc)[4][4], int rb, int cb) {
      const int lane = TID() & 63, l15 = lane & 15, quad = lane >> 4;
      const float4 dsk = *(const float4*)(p.s5_d + i * 1024 + g * 16 + quad * 4);
#pragma unroll
      for (int mt = 0; mt < 4; ++mt)
#pragma unroll
        for (int nt = 0; nt < 4; ++nt) {
          const int t = (cb + nt * 16) >> 4, n = rb + mt * 16 + l15;
          const size_t tok = (size_t)b * 4096 + n * 32 + t;
          const float4 u = *(const float4*)(p.out + tok * 1024 + g * 16 + quad * 4);
          u32x2 v;
          v[0] = pack2(gelu_tanh(acc[mt][nt][0] + dsk.x * u.x), gelu_tanh(acc[mt][nt][1] + dsk.y * u.y));
          v[1] = pack2(gelu_tanh(acc[mt][nt][2] + dsk.z * u.z), gelu_tanh(acc[mt][nt][3] + dsk.w * u.w));
          *(u32x2*)(hid + tok * 1024 + g * 16 + quad * 4) = v;
        }
    }, smem);
  }
}

DI void phase_glu(const Params& p, int i, bf16_t* smem) {
  const bf16_t* W = (const bf16_t*)(p.ws + OFF_W) + W_ODD0 + (size_t)i * SZ_GLU;
  PlainLoad al{(const bf16_t*)(p.ws + OFF_HID), 1024}, bl{W, 1024};
  {
    gemm_stream(256, 16, 16, al, bl, [&](f32x4 (&acc)[4][4], int rb, int cb) {
      const int lane = TID() & 63, l15 = lane & 15, quad = lane >> 4;
#pragma unroll
      for (int mt = 0; mt < 4; ++mt)
#pragma unroll
        for (int np = 0; np < 2; ++np) {
          float4* ptr = (float4*)(p.out + (size_t)(rb + mt * 16 + l15) * 1024 + (cb >> 1) + np * 16 + quad * 4);
          float4 h = *ptr;
          h.x = ALPHA * h.x + acc[mt][2 * np][0] * sigmoidf_(acc[mt][2 * np + 1][0]);
          h.y = ALPHA * h.y + acc[mt][2 * np][1] * sigmoidf_(acc[mt][2 * np + 1][1]);
          h.z = ALPHA * h.z + acc[mt][2 * np][2] * sigmoidf_(acc[mt][2 * np + 1][2]);
          h.w = ALPHA * h.w + acc[mt][2 * np][3] * sigmoidf_(acc[mt][2 * np + 1][3]);
          *ptr = h;
        }
    }, smem);
  }
}

DI void phase_xproj(const Params& p, int l, bf16_t* smem) {
  const bf16_t* wc = (const bf16_t*)(p.ws + OFF_W) + (size_t)l * SZ_COMMON;
  {
    PlainLoad al{(const bf16_t*)(p.ws + OFF_HB), 1024}, bl{wc, 1024};
    bf16_t* q = (bf16_t*)(p.ws + OFF_XQ);
    gemm_stream(256, 8, 16, al, bl, [&](f32x4 (&acc)[4][4], int rb, int cb) { epi_bf16(q, 1024, acc, rb, cb); }, smem);
  }
  {
    const float* memf = p.mem;
    auto al = [=](int row, int ks, int kc) -> uint4 {
      const float4* src = (const float4*)((const char*)memf + (unsigned)((row * 1024 + ks * 64 + kc) * 4));
      float4 a = src[0], b2 = src[1];
      return make_uint4(pack2(a.x, a.y), pack2(a.z, a.w), pack2(b2.x, b2.y), pack2(b2.z, b2.w));
    };
    bf16_t* kx = (bf16_t*)(p.ws + OFF_KX); bf16_t* vx = (bf16_t*)(p.ws + OFF_VX);
    for_tiles(16, 16, [&](int mi, int ni) {
      const bool isv = ni >= 8;
      PlainLoad bl{isv ? (wc + 2 * SZ_SQ) : (wc + SZ_SQ), 1024};
      gemm_tile(mi * 128, (ni & 7) * 128, 16, al, bl, [&](f32x4 (&acc)[4][4], int rb, int cb) {
        if (!isv) { epi_bf16(kx, 1024, acc, rb, cb); return; }
        const int lane = TID() & 63, l15 = lane & 15, quad = lane >> 4;
#pragma unroll
        for (int mt = 0; mt < 4; ++mt)
#pragma unroll
          for (int nt = 0; nt < 4; ++nt) {
            const int row = rb + mt * 16 + l15, col = cb + nt * 16 + quad * 4;
            const int b = row >> 8, key = row & 255, h = col >> 8, d = col & 255;
            bf16_t* dst = vx + ((size_t)((b * 4 + h) * 256 + d)) * 256 + kperm(key);
#pragma unroll
            for (int r = 0; r < 4; ++r) dst[r * 256] = f2bf(acc[mt][nt][r]);
          }
      }, smem);
    });
  }
}


DI void phase_xattn(const Params& p, bf16_t* smem) {
  const int tid = TID(), wave = tid >> 6, lane = tid & 63, l15 = lane & 15, quad = lane >> 4;
  const bf16_t* q = (const bf16_t*)(p.ws + OFF_XQ); const bf16_t* kx = (const bf16_t*)(p.ws + OFF_KX); const bf16_t* vxT = (const bf16_t*)(p.ws + OFF_VX);
  bf16_t* xo = (bf16_t*)(p.ws + OFF_XO);
  uint4 rg0, rg1, rg2, rg3, rg4, rg5, rg6, rg7;
#define XA_KLOAD(c_) do { const bf16_t* s_ = kx + (size_t)(b * 256 + (c_) * 64 + (tid >> 5)) * 1024 + h * 256 + (tid & 31) * 8; \
    rg0 = *(const uint4*)(s_); rg1 = *(const uint4*)(s_ + 8 * 1024); rg2 = *(const uint4*)(s_ + 16 * 1024); rg3 = *(const uint4*)(s_ + 24 * 1024); \
    rg4 = *(const uint4*)(s_ + 32 * 1024); rg5 = *(const uint4*)(s_ + 40 * 1024); rg6 = *(const uint4*)(s_ + 48 * 1024); rg7 = *(const uint4*)(s_ + 56 * 1024); } while (0)
#define XA_KSTORE(buf_) do { bf16_t* d_ = (buf_) + (tid >> 5) * 264 + (tid & 31) * 8; \
    *(uint4*)(d_) = rg0; *(uint4*)(d_ + 8 * 264) = rg1; *(uint4*)(d_ + 16 * 264) = rg2; *(uint4*)(d_ + 24 * 264) = rg3; \
    *(uint4*)(d_ + 32 * 264) = rg4; *(uint4*)(d_ + 40 * 264) = rg5; *(uint4*)(d_ + 48 * 264) = rg6; *(uint4*)(d_ + 56 * 264) = rg7; } while (0)
#define XA_VLOAD(c_) do { const bf16_t* s_ = vxT + ((size_t)((b * 4 + h) * 256 + (tid >> 3))) * 256 + (c_) * 64 + (tid & 7) * 8; \
    rg0 = *(const uint4*)(s_); rg1 = *(const uint4*)(s_ + 32 * 256); rg2 = *(const uint4*)(s_ + 64 * 256); rg3 = *(const uint4*)(s_ + 96 * 256); \
    rg4 = *(const uint4*)(s_ + 128 * 256); rg5 = *(const uint4*)(s_ + 160 * 256); rg6 = *(const uint4*)(s_ + 192 * 256); rg7 = *(const uint4*)(s_ + 224 * 256); } while (0)
#define XA_VSTORE(buf_) do { bf16_t* d_ = (buf_) + (tid >> 3) * 72 + (tid & 7) * 8; \
    *(uint4*)(d_) = rg0; *(uint4*)(d_ + 32 * 72) = rg1; *(uint4*)(d_ + 64 * 72) = rg2; *(uint4*)(d_ + 96 * 72) = rg3; \
    *(uint4*)(d_ + 128 * 72) = rg4; *(uint4*)(d_ + 160 * 72) = rg5; *(uint4*)(d_ + 192 * 72) = rg6; *(uint4*)(d_ + 224 * 72) = rg7; } while (0)
  for (int item = BID(); item < 2048; item += GDIM()) {
    const int b = item >> 8, h = (item >> 6) & 3, qb = item & 63;
    const size_t tq = (size_t)b * 4096 + qb * 64 + wave * 16 + l15;
    XA_KLOAD(0);
    bf16x8 qf[8];
#pragma unroll
    for (int ks = 0; ks < 8; ++ks) qf[ks] = *(const bf16x8*)(q + tq * 1024 + h * 256 + ks * 32 + quad * 8);
    XA_KSTORE(smem);
    __syncthreads();
    f32x4 s[16];
#pragma unroll
    for (int c = 0; c < 4; ++c) {
      const bf16_t* cur = smem + (c & 1) * 18432; bf16_t* nxt = smem + ((c + 1) & 1) * 18432;
      if (c < 3) XA_KLOAD(c + 1); else XA_VLOAD(0);
#pragma unroll
      for (int m4 = 0; m4 < 4; ++m4) {
        f32x4 a = {0.f, 0.f, 0.f, 0.f};
#pragma unroll
        for (int ks = 0; ks < 8; ++ks) a = MFMA16(*(const bf16x8*)(cur + (m4 * 16 + l15) * 264 + ks * 32 + quad * 8), qf[ks], a);
        s[c * 4 + m4] = a;
      }
      if (c < 3) XA_KSTORE(nxt); else XA_VSTORE(nxt);
      __syncthreads();
    }
    float m = -1e30f;
#pragma unroll
    for (int mt = 0; mt < 16; ++mt)
#pragma unroll
      for (int r = 0; r < 4; ++r) m = fmaxf(m, s[mt][r]);
    m = fmaxf(m, __shfl_xor(m, 16)); m = fmaxf(m, __shfl_xor(m, 32));
    const float c1 = 0.0625f * 1.4426950408889634f;
    float l = 0.f;
#pragma unroll
    for (int mt = 0; mt < 16; ++mt)
#pragma unroll
      for (int r = 0; r < 4; ++r) { float pv = exp2f((s[mt][r] - m) * c1); s[mt][r] = pv; l += pv; }
    l += __shfl_xor(l, 16); l += __shfl_xor(l, 32);
    f32x4 o[16];
#pragma unroll
    for (int dt = 0; dt < 16; ++dt) o[dt] = f32x4{0.f, 0.f, 0.f, 0.f};
#pragma unroll
    for (int c = 0; c < 4; ++c) {
      const bf16_t* cur = smem + (c & 1) * 18432; bf16_t* nxt = smem + ((c + 1) & 1) * 18432;
      if (c < 3) XA_VLOAD(c + 1);
#pragma unroll
      for (int s2 = 0; s2 < 2; ++s2) {
        const bf16x8 pf = pack8(s[4 * c + 2 * s2], s[4 * c + 2 * s2 + 1]);
#pragma unroll
        for (int dt = 0; dt < 16; ++dt) o[dt] = MFMA16(*(const bf16x8*)(cur + (dt * 16 + l15) * 72 + s2 * 32 + quad * 8), pf, o[dt]);
      }
      if (c < 3) XA_VSTORE(nxt);
      __syncthreads();
    }
    const float il = 1.f / l;
#pragma unroll
    for (int dt = 0; dt < 16; ++dt) {
      u32x2 v; v[0] = pack2(o[dt][0] * il, o[dt][1] * il); v[1] = pack2(o[dt][2] * il, o[dt][3] * il);
      *(u32x2*)(xo + tq * 1024 + h * 256 + dt * 16 + quad * 4) = v;
    }
  }
}

template <int R, int NT>
DI void dil_branch(const bf16_t* swk, const bf16_t* swv, size_t rowbase, int h, int tok0, const bf16x8 (&qf)[2], float& m, float& l, f32x4 (&o)[4],
                   int l15, int quad) {
  constexpr int U = 16 / R, W = 128 * R;
  f32x4 s[NT];
#pragma unroll
  for (int kt = 0; kt < NT; ++kt) {
    int kap = tok0 - W + R * (kt * 16 + l15);
    kap = min(max(kap, 0), 4095);
    const bf16_t* kp = swk + (rowbase + kap) * 512 + h * 64 + quad * 8;
    f32x4 a = {0.f, 0.f, 0.f, 0.f};
    a = MFMA16(*(const bf16x8*)kp, qf[0], a);
    a = MFMA16(*(const bf16x8*)(kp + 32), qf[1], a);
    s[kt] = a;
    if ((kt & 3) == 3) __builtin_amdgcn_sched_barrier(0);
  }
  float mx = m;
  const float c1 = 0.125f * 1.4426950408889634f;
#pragma unroll
  for (int kt = 0; kt < NT; ++kt)
#pragma unroll
    for (int r2 = 0; r2 < 4; ++r2) {
      const int c = kt * 16 + quad * 4 + r2;
      const int dist = U * l15 + 128 - c;
      const int kap = tok0 - W + R * c;
      const bool ok = (dist >= 0) && (dist <= 128) && (kap >= 0);
      const float v = ok ? s[kt][r2] * c1 : -1e30f;
      s[kt][r2] = v; mx = fmaxf(mx, v);
    }
  mx = fmaxf(mx, __shfl_xor(mx, 16)); mx = fmaxf(mx, __shfl_xor(mx, 32));
  const float corr = exp2f(m - mx);
  m = mx; l *= corr;
#pragma unroll
  for (int dt = 0; dt < 4; ++dt) { o[dt][0] *= corr; o[dt][1] *= corr; o[dt][2] *= corr; o[dt][3] *= corr; }
#pragma unroll
  for (int kt = 0; kt < NT; ++kt)
#pragma unroll
    for (int r2 = 0; r2 < 4; ++r2) { float pv = exp2f(s[kt][r2] - mx); s[kt][r2] = pv; l += pv; }
  constexpr int NS = (NT + 1) / 2;
#pragma unroll
  for (int s2 = 0; s2 < NS; ++s2) {
    const f32x4 z4 = {0.f, 0.f, 0.f, 0.f};
    const bf16x8 pf = pack8(s[2 * s2], (2 * s2 + 1 < NT) ? s[(2 * s2 + 1 < NT) ? 2 * s2 + 1 : 0] : z4);
    u32x2 vv[8];
#pragma unroll
    for (int j = 0; j < 8; ++j) {
      const int c = (2 * s2 + (j >> 2)) * 16 + quad * 4 + (j & 3);
      int kap = tok0 - W + R * c;
      kap = min(max(kap, 0), 4095);
      vv[j] = *(const u32x2*)(swv + (rowbase + kap) * 512 + h * 64 + 4 * l15);
    }
#pragma unroll
    for (int t4 = 0; t4 < 4; ++t4) {
      u32x4 t;
#pragma unroll
      for (int m = 0; m < 4; ++m) {
        const unsigned a = vv[2 * m][t4 >> 1], b2 = vv[2 * m + 1][t4 >> 1];
        t[m] = (t4 & 1) ? ((a >> 16) | (b2 & 0xffff0000u)) : ((a & 0xffffu) | (b2 << 16));
      }
      o[t4] = MFMA16(__builtin_bit_cast(bf16x8, t), pf, o[t4]);
    }
    __builtin_amdgcn_sched_barrier(0);
  }
}

DI void phase_dil_attn(const Params& p, int first, int nblk) {
  const int wave = TID() >> 6, lane = TID() & 63, l15 = lane & 15, quad = lane >> 4;
  bf16_t* swq = (bf16_t*)(p.ws + OFF_SWQ); const bf16_t* swk = (const bf16_t*)(p.ws + OFF_SWK); const bf16_t* swv = (const bf16_t*)(p.ws + OFF_SWV);
  for (int item = first; item < 4096; item += nblk) {
    const int b = item >> 9, h = (item >> 6) & 7, G = (item >> 2) & 15, sub = item & 3;
    const int tok0 = G * 256 + sub * 4 + wave;
    const size_t rowbase = (size_t)b * 4096;
    const size_t tq = rowbase + tok0 + 16 * l15;
    bf16x8 qf[2];
    qf[0] = *(const bf16x8*)(swq + tq * 512 + h * 64 + quad * 8);
    qf[1] = *(const bf16x8*)(swq + tq * 512 + h * 64 + 32 + quad * 8);
    float m = -1e30f, l = 0.f;
    f32x4 o[4];
#pragma unroll
    for (int dt = 0; dt < 4; ++dt) o[dt] = f32x4{0.f, 0.f, 0.f, 0.f};
    dil_branch<16, 9>(swk, swv, rowbase, h, tok0, qf, m, l, o, l15, quad);
    dil_branch<4, 12>(swk, swv, rowbase, h, tok0, qf, m, l, o, l15, quad);
    dil_branch<1, 24>(swk, swv, rowbase, h, tok0, qf, m, l, o, l15, quad);
    l += __shfl_xor(l, 16); l += __shfl_xor(l, 32);
    const float il = 1.f / l;
    u32x4 w0, w1;
    w0[0] = pack2(o[0][0] * il, o[1][0] * il); w0[1] = pack2(o[2][0] * il, o[3][0] * il);
    w0[2] = pack2(o[0][1] * il, o[1][1] * il); w0[3] = pack2(o[2][1] * il, o[3][1] * il);
    w1[0] = pack2(o[0][2] * il, o[1][2] * il); w1[1] = pack2(o[2][2] * il, o[3][2] * il);
    w1[2] = pack2(o[0][3] * il, o[1][3] * il); w1[3] = pack2(o[2][3] * il, o[3][3] * il);
    *(u32x4*)(swq + tq * 512 + h * 64 + quad * 16) = w0;
    *(u32x4*)(swq + tq * 512 + h * 64 + quad * 16 + 8) = w1;
  }
}

DI void phase_xo(const Params& p, int l, bf16_t* smem) {
  const bf16_t* wc = (const bf16_t*)(p.ws + OFF_W) + (size_t)l * SZ_COMMON + 3 * SZ_SQ;
  PlainLoad al{(const bf16_t*)(p.ws + OFF_XO), 1024}, bl{wc, 1024};
  {
    gemm_stream(256, 8, 16, al, bl, [&](f32x4 (&acc)[4][4], int rb, int cb) { epi_resid(p, acc, rb, cb); }, smem);
  }
}

DI void phase_ffn_gu(const Params& p, int l, bf16_t* smem) {
  const bf16_t* W = (const bf16_t*)(p.ws + OFF_W) + (size_t)l * SZ_COMMON + 4 * SZ_SQ;
  PlainLoad al{(const bf16_t*)(p.ws + OFF_HB), 1024}, bl{W, 1024};
  bf16_t* act = (bf16_t*)(p.ws + OFF_ACT);
  {
    gemm_stream(256, 44, 16, al, bl, [&](f32x4 (&acc)[4][4], int rb, int cb) {
      const int lane = TID() & 63, l15 = lane & 15, quad = lane >> 4;
#pragma unroll
      for (int mt = 0; mt < 4; ++mt)
#pragma unroll
        for (int np = 0; np < 2; ++np) {
          u32x2 v;
          v[0] = pack2(siluf_(acc[mt][2 * np][0]) * acc[mt][2 * np + 1][0], siluf_(acc[mt][2 * np][1]) * acc[mt][2 * np + 1][1]);
          v[1] = pack2(siluf_(acc[mt][2 * np][2]) * acc[mt][2 * np + 1][2], siluf_(acc[mt][2 * np][3]) * acc[mt][2 * np + 1][3]);
          *(u32x2*)(act + (size_t)(rb + mt * 16 + l15) * 2816 + (cb >> 1) + np * 16 + quad * 4) = v;
        }
    }, smem);
  }
}
DI void phase_ffn_down(const Params& p, int l, bf16_t* smem) {
  const bf16_t* W = (const bf16_t*)(p.ws + OFF_W) + (size_t)l * SZ_COMMON + 4 * SZ_SQ + SZ_GU;
  PlainLoad al{(const bf16_t*)(p.ws + OFF_ACT), 2816}, bl{W, 2816};
  {
    gemm_stream(256, 8, 44, al, bl, [&](f32x4 (&acc)[4][4], int rb, int cb) { epi_resid(p, acc, rb, cb); }, smem);
  }
}


#define XB_TMO      128
#define XB_XCNT(j)  (256  + 64 * (j))
#define XB_XSUB(j)  (1280 + 64 * (j))
#define XB_XGEN(j)  (2304 + 64 * (j))
#define XB_TOP      3328
#define XB_TOPGEN   3392
#define XCD_BAR_WORDS 3456
#define XB_SPIN_CAP (1u << 22)
#define LAS __attribute__((address_space(3)))
DI unsigned xb_ld(unsigned* p) { return __hip_atomic_load(p, __ATOMIC_RELAXED, __HIP_MEMORY_SCOPE_AGENT); }
DI unsigned xb_add(unsigned* p, unsigned v) { return __hip_atomic_fetch_add(p, v, __ATOMIC_RELAXED, __HIP_MEMORY_SCOPE_AGENT); }
DI unsigned xb_xcc_id() { return (unsigned)__builtin_amdgcn_s_getreg((3 << 11) | 20) & 0xFu; }
#define XB_SPIN(cond, bar) do { unsigned _sp = 0; while (cond) { __builtin_amdgcn_s_sleep(1); \
    if ((++_sp & 255u) == 0u) { if (xb_ld(&(bar)[XB_TMO])) break; if (_sp > XB_SPIN_CAP) { atomicAdd(&(bar)[XB_TMO], 1u); break; } } } } while (0)
struct XcdBarrier { unsigned* bar; unsigned x; volatile LAS unsigned* st; };
DI XcdBarrier xcd_barrier_post(unsigned* bar, volatile LAS unsigned* st) {
  XcdBarrier b; b.bar = bar; b.x = xb_xcc_id(); b.st = st;
  if (threadIdx.x == 0) (void)xb_add(&bar[XB_XCNT(b.x)], 1u);
  return b;
}
DI void xcd_barrier_complete(unsigned* bar, unsigned x, unsigned& nloc, unsigned& nx) {
  const unsigned G = gridDim.x * gridDim.y * gridDim.z;
  unsigned sum, cnt, mine, sp = 0u;
  for (;;) {
    sum = 0u; cnt = 0u; mine = 0u;
#pragma unroll
    for (unsigned j = 0; j < 16; ++j) { const unsigned c = xb_ld(&bar[XB_XCNT(j)]); sum += c; cnt += (c > 0u) ? 1u : 0u; mine = (j == x) ? c : mine; }
    if (sum == G) break;
    __builtin_amdgcn_s_sleep(1);
    if ((++sp & 255u) == 0u) { if (xb_ld(&bar[XB_TMO])) break; if (sp > XB_SPIN_CAP) { atomicAdd(&bar[XB_TMO], 1u); break; } }
  }
  nloc = mine > 0u ? mine : 1u; nx = cnt > 0u ? cnt : 1u;
}
DI void xcd_barrier(const XcdBarrier& b) {
  asm volatile("s_waitcnt vmcnt(0)" ::: "memory");
  __syncthreads();
  if (threadIdx.x == 0) {
    unsigned* bar = b.bar;
    __builtin_amdgcn_s_waitcnt(0);
    unsigned nloc = b.st[0], nx = b.st[1];
    if (nloc == 0u) { xcd_barrier_complete(bar, b.x, nloc, nx); b.st[0] = nloc; b.st[1] = nx; }
    const unsigned old = xb_add(&bar[XB_XSUB(b.x)], 1u);
    const unsigned gen = old / nloc;
    if (old + 1u == (gen + 1u) * nloc) {
      __builtin_amdgcn_fence(__ATOMIC_RELEASE, "agent");
      asm volatile("s_waitcnt vmcnt(0)" ::: "memory");
      const unsigned og = xb_add(&bar[XB_TOP], 1u);
      const unsigned tg = og / nx;
      if (og + 1u == (tg + 1u) * nx) xb_add(&bar[XB_TOPGEN], 1u);
      else XB_SPIN(xb_ld(&bar[XB_TOPGEN]) == tg, bar);
      __builtin_amdgcn_fence(__ATOMIC_ACQUIRE, "agent");
      xb_add(&bar[XB_XGEN(b.x)], 1u);
      asm volatile("s_waitcnt vmcnt(0)" ::: "memory");
    } else {
      XB_SPIN(xb_ld(&bar[XB_XGEN(b.x)]) == gen, bar);
      __builtin_amdgcn_fence(__ATOMIC_ACQUIRE, "agent");
      asm volatile("s_waitcnt vmcnt(0)" ::: "memory");
    }
  }
  __syncthreads();
}

__global__ void __launch_bounds__(256, 2) fwd_megakernel(Params p) {
  cg::grid_group grid = cg::this_grid();
  __shared__ __attribute__((aligned(16))) char smem_raw[2 * 2 * 128 * LDT * 2];
  bf16_t* sm16 = (bf16_t*)smem_raw; float* sm32 = (float*)smem_raw;

  __shared__ uint4 xb_words;
  if (threadIdx.x == 0) xb_words = make_uint4(0u, 0u, 0u, 0u);
  __syncthreads();
  XcdBarrier xb = xcd_barrier_post((unsigned*)(p.ws + OFF_BAR), (volatile LAS unsigned*)&xb_words);
  phase_prologue(p, sm32);
  grid.sync();
  for (int l = 0; l < 4; ++l) {
    const int i = l >> 1;
    if ((l & 1) == 0) {
      phase_proj(p, i, sm16); xcd_barrier(xb);
      phase_dn_prep(p, i, smem_raw); xcd_barrier(xb);
      phase_mix(p, i, sm16); xcd_barrier(xb);
      phase_dn_post(p, i); xcd_barrier(xb);
      phase_wout(p, i, sm16); xcd_barrier(xb);
    } else {
#if USE_S5_GEMM
      phase_s5_tables(p, i, sm32); xcd_barrier(xb);
      phase_s5_end(p, sm16); xcd_barrier(xb);
      phase_s5_y(p, i, sm16); xcd_barrier(xb);
#else
      phase_s5_naive(p, i); xcd_barrier(xb);
#endif
      phase_glu(p, i, sm16); xcd_barrier(xb);
    }
    phase_ln(p, p.ln_mix_g + l * 1024, p.ln_mix_b + l * 1024); xcd_barrier(xb);
    phase_xproj(p, l, sm16); xcd_barrier(xb);
    phase_xattn(p, sm16); xcd_barrier(xb);
    phase_xo(p, l, sm16); xcd_barrier(xb);
    phase_ln(p, p.ln_x_g + l * 1024, p.ln_x_b + l * 1024); xcd_barrier(xb);
    phase_ffn_gu(p, l, sm16); xcd_barrier(xb);
    phase_ffn_down(p, l, sm16); xcd_barrier(xb);
    phase_ln(p, p.ln_ffn_g + l * 1024, p.ln_ffn_b + l * 1024); xcd_barrier(xb);
  }
}

extern "C" void kernel_launch(void* const* d_in, const int* in_sizes, int n_in, void* d_out, int out_size, void* d_ws, size_t ws_size,
                              hipStream_t stream) {
  static int grid_blocks = 0;
  if (!grid_blocks) {
    int dev = 0, cus = 0, per_cu = 0;
    hipGetDevice(&dev);
    hipDeviceGetAttribute(&cus, hipDeviceAttributeMultiprocessorCount, dev);
    hipOccupancyMaxActiveBlocksPerMultiprocessor(&per_cu, fwd_megakernel, 256, 0);
    if (per_cu > 2) per_cu = 2;
    if (per_cu < 1) per_cu = 1;
    grid_blocks = cus * per_cu;
    grid_blocks -= grid_blocks % 8;
  }
  Params p{};
  const float** pf = (const float**)&p;
  for (int i = 0; i < 32; ++i) pf[i] = (const float*)d_in[i];
  p.pos = (const int*)d_in[2];
  p.out = (float*)d_out; p.ws = (char*)d_ws;
  hipMemsetAsync((char*)d_ws + OFF_BAR, 0, XCD_BAR_WORDS * sizeof(unsigned), stream);
  void* args[] = {&p};
  hipError_t e = hipLaunchCooperativeKernel((void*)fwd_megakernel, dim3(grid_blocks), dim3(256), args, 0, stream);
  if (e != hipSuccess) fprintf(stderr, "cooperative launch failed: %s (grid %d)\n", hipGetErrorString(e), grid_blocks);
}
```

```cpp
#include <hip/hip_runtime.h>
#include <hip/hip_cooperative_groups.h>
#include <cstdio>
namespace cg = cooperative_groups;
#ifndef USE_XATTN_MFMA
#define USE_XATTN_MFMA 1
#endif
#ifndef USE_S5_GEMM
#define USE_S5_GEMM 1
#endif
#ifndef USE_DIL_MFMA
#define USE_DIL_MFMA 1
#endif

typedef unsigned short bf16_t;
using bf16x8 = __attribute__((ext_vector_type(8))) short;
using f32x4 = __attribute__((ext_vector_type(4))) float;
#define DI __device__ __forceinline__

constexpr int T_ = 32768, S_ = 4096;
constexpr size_t MiB = (size_t)1 << 20;
constexpr size_t SZ_SQ = (size_t)1024 * 1024, SZ_WIN = (size_t)3712 * 1024, SZ_GLU = (size_t)2048 * 1024,
                 SZ_GU = (size_t)5632 * 1024, SZ_WD = (size_t)1024 * 2816;
constexpr size_t SZ_COMMON = 4 * SZ_SQ + SZ_GU + SZ_WD;
constexpr size_t W_EVEN0 = 4 * SZ_COMMON;
constexpr size_t W_ODD0 = W_EVEN0 + 2 * (SZ_WIN + SZ_SQ);
constexpr float ALPHA = 1.681792830507429f;

constexpr size_t OFF_W = 0;
constexpr size_t OFF_ROPE = 125 * MiB;
constexpr size_t OFF_HB = 133 * MiB;
constexpr size_t OFF_KX = 197 * MiB;
constexpr size_t OFF_VX = 201 * MiB;
constexpr size_t OFF_BIG = 205 * MiB;
constexpr size_t OFF_BAR = 511 * MiB;
constexpr size_t OFF_DNQKV = OFF_BIG;
constexpr size_t OFF_Z = OFF_BIG + 96 * MiB;
constexpr size_t OFF_SWQ = OFF_BIG + 128 * MiB;
constexpr size_t OFF_SWK = OFF_BIG + 160 * MiB;
constexpr size_t OFF_SWV = OFF_BIG + 192 * MiB;
constexpr size_t OFF_LOGIT = OFF_BIG + 224 * MiB;
constexpr size_t OFF_QD = OFF_BIG + 225 * MiB;
constexpr size_t OFF_KD = OFF_BIG + 257 * MiB;
constexpr size_t OFF_INTRA = OFF_BIG + 289 * MiB;
constexpr size_t OFF_WB = OFF_HB;
constexpr size_t OFF_UB = OFF_HB + 32 * MiB;
constexpr size_t OFF_EG = OFF_KX;
constexpr size_t OFF_XQ = OFF_BIG;
constexpr size_t OFF_XO = OFF_BIG + 64 * MiB;
constexpr size_t OFF_ACT = OFF_BIG;
constexpr size_t OFF_HID = OFF_BIG;
constexpr size_t OFF_SIN = OFF_BIG + 64 * MiB;
constexpr size_t OFF_KTAB = OFF_BIG + 80 * MiB;
constexpr size_t OFF_ETAB = OFF_BIG + 82 * MiB;
constexpr size_t OFF_GTAB = OFF_BIG + 90 * MiB;
constexpr size_t OFF_AL = OFF_BIG + 98 * MiB;

struct Params {
  const float* x; const float* mem; const int* pos;
  const float* hyb_w_in; const float* dn_conv_w; const float* dn_a_log; const float* dn_dt_bias; const float* dn_norm_g; const float* hyb_w_out;
  const float* s5_a_re; const float* s5_a_im; const float* s5_log_dt; const float* s5_b_re; const float* s5_b_im; const float* s5_c_re; const float* s5_c_im;
  const float* s5_d; const float* s5_glu_wo; const float* s5_glu_wg;
  const float* ln_mix_g; const float* ln_mix_b;
  const float* xq_w; const float* xk_w; const float* xv_w; const float* xo_w; const float* ln_x_g; const float* ln_x_b;
  const float* ffn_wg; const float* ffn_wu; const float* ffn_wd; const float* ln_ffn_g; const float* ln_ffn_b;
  float* out; char* ws;
};

DI int TID() { int t = threadIdx.x; asm volatile("" : "+v"(t)); return t; }
DI int BID() { int t = blockIdx.x; asm volatile("" : "+s"(t)); return t; }
DI int GDIM() { int t = gridDim.x; asm volatile("" : "+s"(t)); return t; }
typedef float f32x2_t __attribute__((ext_vector_type(2)));
typedef __bf16 bf16x2_t __attribute__((ext_vector_type(2)));
DI bf16_t f2bf(float x) { return __builtin_bit_cast(bf16_t, (__bf16)x); }
DI float bf2f(bf16_t v) { return __uint_as_float(((unsigned)v) << 16); }
DI unsigned pack2(float a, float b) { f32x2_t v = {a, b}; return __builtin_bit_cast(unsigned, __builtin_convertvector(v, bf16x2_t)); }
using u32x4 = __attribute__((ext_vector_type(4))) unsigned;
using u32x2 = __attribute__((ext_vector_type(2))) unsigned;
DI bf16x8 pack8(f32x4 a, f32x4 b) {
  u32x4 t; t[0] = pack2(a[0], a[1]); t[1] = pack2(a[2], a[3]); t[2] = pack2(b[0], b[1]); t[3] = pack2(b[2], b[3]);
  return __builtin_bit_cast(bf16x8, t);
}
#define MFMA16(a, b, c) __builtin_amdgcn_mfma_f32_16x16x32_bf16((a), (b), (c), 0, 0, 0)
DI int kperm(int x) { return (x & ~31) | (((x >> 2) & 3) * 8 + ((x >> 4) & 1) * 4 + (x & 3)); }
DI float wave_sum(float v) { for (int o = 32; o > 0; o >>= 1) v += __shfl_xor(v, o); return v; }
DI float wave_max(float v) { for (int o = 32; o > 0; o >>= 1) v = fmaxf(v, __shfl_xor(v, o)); return v; }
DI float sigmoidf_(float x) { return __builtin_amdgcn_rcpf(1.f + __expf(-x)); }
DI float siluf_(float x) { return x * sigmoidf_(x); }
DI float softplusf_(float x) { return fmaxf(x, 0.f) + log1pf(__expf(-fabsf(x))); }
DI float gelu_tanh(float x) { float u = 0.7978845608028654f * (x + 0.044715f * x * x * x); return 0.5f * x * (1.f + tanhf(u)); }

template <class CM>
DI void transpose_job(bf16_t* dst, int Ndst, int K, int srcStride, CM colptr, float* tile) {
  const int ntk = K / 64, ntiles = (Ndst / 64) * ntk;
  const int tid = TID();
  for (int tl = BID(); tl < ntiles; tl += GDIM()) {
    const int r0 = (tl / ntk) * 64, k0 = (tl % ntk) * 64;
    const int q4 = tid & 15, kl0 = tid >> 4;
    const float* cp = colptr(r0 + 4 * q4);
    float4 v[4];
#pragma unroll
    for (int i = 0; i < 4; ++i) v[i] = cp ? *(const float4*)(cp + (size_t)(k0 + kl0 + 16 * i) * srcStride) : make_float4(0.f, 0.f, 0.f, 0.f);
#pragma unroll
    for (int i = 0; i < 4; ++i) {
      float* t = tile + (kl0 + 16 * i) * 65 + 4 * q4;
      t[0] = v[i].x; t[1] = v[i].y; t[2] = v[i].z; t[3] = v[i].w;
    }
    __syncthreads();
#pragma unroll
    for (int i = 0; i < 2; ++i) {
      const int c = tid + 256 * i, rr = c >> 3, kc = (c & 7) * 8;
      const float* t = tile + kc * 65 + rr;
      uint4 o;
      o.x = pack2(t[0], t[65]); o.y = pack2(t[2 * 65], t[3 * 65]); o.z = pack2(t[4 * 65], t[5 * 65]); o.w = pack2(t[6 * 65], t[7 * 65]);
      *(uint4*)(dst + (size_t)(r0 + rr) * K + k0 + kc) = o;
    }
    __syncthreads();
  }
}

DI void phase_prologue(const Params& p, float* smem) {
  bf16_t* W = (bf16_t*)(p.ws + OFF_W);
  for (int l = 0; l < 4; ++l) {
    bf16_t* wc = W + (size_t)l * SZ_COMMON;
    const float* s;
    s = p.xq_w + (size_t)l * SZ_SQ; transpose_job(wc, 1024, 1024, 1024, [=](int r) { return s + r; }, smem);
    s = p.xk_w + (size_t)l * SZ_SQ; transpose_job(wc + SZ_SQ, 1024, 1024, 1024, [=](int r) { return s + r; }, smem);
    s = p.xv_w + (size_t)l * SZ_SQ; transpose_job(wc + 2 * SZ_SQ, 1024, 1024, 1024, [=](int r) { return s + r; }, smem);
    s = p.xo_w + (size_t)l * SZ_SQ; transpose_job(wc + 3 * SZ_SQ, 1024, 1024, 1024, [=](int r) { return s + r; }, smem);
    {
      const float* g = p.ffn_wg + (size_t)l * 1024 * 2816; const float* u = p.ffn_wu + (size_t)l * 1024 * 2816;
      transpose_job(wc + 4 * SZ_SQ, 5632, 1024, 2816, [=](int r) { int c = (r >> 5) * 16 + (r & 15); return ((r >> 4) & 1) ? (u + c) : (g + c); }, smem);
    }
    s = p.ffn_wd + (size_t)l * 2816 * 1024; transpose_job(wc + 4 * SZ_SQ + SZ_GU, 1024, 2816, 1024, [=](int r) { return s + r; }, smem);
  }
  for (int i = 0; i < 2; ++i) {
    bf16_t* we = W + W_EVEN0 + (size_t)i * (SZ_WIN + SZ_SQ);
    const float* s = p.hyb_w_in + (size_t)i * 1024 * 3592;
    transpose_job(we, 3712, 1024, 3592, [=](int r) -> const float* {
      if (r < 2048) return s + r;
      if (r < 3584) return s + r + 8;
      if (r < 3592) return s + 2048 + (r - 3584);
      return nullptr; }, smem);
    const float* s2 = p.hyb_w_out + (size_t)i * SZ_SQ;
    transpose_job(we + SZ_WIN, 1024, 1024, 1024, [=](int r) { return s2 + r; }, smem);
    bf16_t* wo = W + W_ODD0 + (size_t)i * SZ_GLU;
    const float* a = p.s5_glu_wo + (size_t)i * SZ_SQ; const float* b = p.s5_glu_wg + (size_t)i * SZ_SQ;
    transpose_job(wo, 2048, 1024, 1024, [=](int r) { int c = (r >> 5) * 16 + (r & 15); return ((r >> 4) & 1) ? (b + c) : (a + c); }, smem);
  }
  const size_t gtid = (size_t)BID() * 256 + TID(), gsz = (size_t)GDIM() * 256;
  bf16_t* hb = (bf16_t*)(p.ws + OFF_HB);
  for (size_t i = gtid; i < (size_t)T_ * 256; i += gsz) {
    float4 v = ((const float4*)p.x)[i];
    ((float4*)p.out)[i] = v;
    uint2 o; o.x = pack2(v.x, v.y); o.y = pack2(v.z, v.w);
    ((uint2*)hb)[i] = o;
  }
  float* rc = (float*)(p.ws + OFF_ROPE); float* rs = rc + (size_t)T_ * 32;
  for (size_t i = gtid; i < (size_t)T_ * 32; i += gsz) {
    int t = (int)(i >> 5), j = (int)(i & 31);
    float invf = (float)exp(-(double)(2 * j) / 64.0 * 9.210340371976184);
    float ang = (float)p.pos[t] * invf;
    double a = (double)ang;
    double k = rint(a * 0.15915494309189535);
    float r = (float)(a - k * 6.283185307179586);
    rc[i] = cosf(r); rs[i] = sinf(r);
  }
}

constexpr int LDT = 72;
template <class AL, class BL, class EP>
DI void gemm_tile(int m0, int n0, int nks, AL aload, BL bload, EP epi, bf16_t* smem) {
  bf16_t* As = smem; bf16_t* Bs = smem + 2 * 128 * LDT;
  const int tid = TID(), lane = tid & 63, wave = tid >> 6;
  const int wm = wave >> 1, wn = wave & 1, l15 = lane & 15, quad = lane >> 4;
  const int lrow = tid >> 3, lkc = (tid & 7) * 8;
  f32x4 acc[4][4];
#pragma unroll
  for (int i = 0; i < 4; ++i)
#pragma unroll
    for (int j = 0; j < 4; ++j) acc[i][j] = f32x4{0.f, 0.f, 0.f, 0.f};
  uint4 ra0[4], rb0[4], ra1[4], rb1[4];
#pragma unroll
  for (int i = 0; i < 4; ++i) { ra0[i] = aload(m0 + lrow + 32 * i, 0, lkc); rb0[i] = bload(n0 + lrow + 32 * i, 0, lkc); }
#pragma unroll
  for (int i = 0; i < 4; ++i) { ra1[i] = aload(m0 + lrow + 32 * i, 1, lkc); rb1[i] = bload(n0 + lrow + 32 * i, 1, lkc); }
#pragma unroll
  for (int i = 0; i < 4; ++i) {
    *(uint4*)(As + (lrow + 32 * i) * LDT + lkc) = ra0[i];
    *(uint4*)(Bs + (lrow + 32 * i) * LDT + lkc) = rb0[i];
  }
  __syncthreads();
  auto compute = [&](int cur) {
    const bf16_t* Ab = As + cur * 128 * LDT; const bf16_t* Bb = Bs + cur * 128 * LDT;
#pragma unroll
    for (int kk = 0; kk < 2; ++kk) {
      bf16x8 a[4], b[4];
#pragma unroll
      for (int mt = 0; mt < 4; ++mt) a[mt] = *(const bf16x8*)(Ab + (wm * 64 + mt * 16 + l15) * LDT + kk * 32 + quad * 8);
#pragma unroll
      for (int nt = 0; nt < 4; ++nt) b[nt] = *(const bf16x8*)(Bb + (wn * 64 + nt * 16 + l15) * LDT + kk * 32 + quad * 8);
#pragma unroll
      for (int mt = 0; mt < 4; ++mt)
#pragma unroll
        for (int nt = 0; nt < 4; ++nt) acc[mt][nt] = __builtin_amdgcn_mfma_f32_16x16x32_bf16(b[nt], a[mt], acc[mt][nt], 0, 0, 0);
    }
  };
  for (int ks = 0; ks < nks; ks += 2) {
    {
      const int kq = (ks + 2 < nks) ? ks + 2 : 0;
#pragma unroll
      for (int i = 0; i < 4; ++i) { ra0[i] = aload(m0 + lrow + 32 * i, kq, lkc); rb0[i] = bload(n0 + lrow + 32 * i, kq, lkc); }
    }
    compute(0);
#pragma unroll
    for (int i = 0; i < 4; ++i) {
      *(uint4*)(As + 128 * LDT + (lrow + 32 * i) * LDT + lkc) = ra1[i];
      *(uint4*)(Bs + 128 * LDT + (lrow + 32 * i) * LDT + lkc) = rb1[i];
    }
    __syncthreads();
    {
      const int kq = (ks + 3 < nks) ? ks + 3 : 1;
#pragma unroll
      for (int i = 0; i < 4; ++i) { ra1[i] = aload(m0 + lrow + 32 * i, kq, lkc); rb1[i] = bload(n0 + lrow + 32 * i, kq, lkc); }
    }
    compute(1);
#pragma unroll
    for (int i = 0; i < 4; ++i) {
      *(uint4*)(As + (lrow + 32 * i) * LDT + lkc) = ra0[i];
      *(uint4*)(Bs + (lrow + 32 * i) * LDT + lkc) = rb0[i];
    }
    __syncthreads();
  }
  epi(acc, m0 + wm * 64, n0 + wn * 64);
}

DI void tile_of(int w, int mtiles, int ntiles, int xcd, int& m0, int& n0) {
  const int mper = mtiles >> 3, full = mper * 8;
  int gidx = w / full;
  const int ngroups = (ntiles + 7) >> 3;
  if (gidx > ngroups - 1) gidx = ngroups - 1;
  const int rest = w - gidx * full;
  const int wg = min(8, ntiles - 8 * gidx);
  const int ml = rest / wg, ni = 8 * gidx + (rest - ml * wg);
  m0 = (ml * 8 + xcd) * 128; n0 = ni * 128;
}
template <class AL, class BL, class EP>
DI void gemm_stream(int mtiles, int ntiles, int nks, AL aload, BL bload, EP epi, bf16_t* smem) {
  const int xcd = BID() & 7, slot = BID() >> 3, nslot = GDIM() >> 3;
  const int per = (mtiles >> 3) * ntiles;
  if (slot >= per) return;
  bf16_t* As = smem; bf16_t* Bs = smem + 2 * 128 * LDT;
  const int tid = TID(), lane = tid & 63, wave = tid >> 6;
  const int wm = wave >> 1, wc = wave & 1, l15 = lane & 15, quad = lane >> 4;
  const int lrow = tid >> 3, lkc = (tid & 7) * 8;
  f32x4 acc[4][4];
  uint4 ra0[4], rb0[4], ra1[4], rb1[4];
  int w = slot;
  int m0, n0;
  tile_of(w, mtiles, ntiles, xcd, m0, n0);
#pragma unroll
  for (int i = 0; i < 4; ++i) { ra0[i] = aload(m0 + lrow + 32 * i, 0, lkc); rb0[i] = bload(n0 + lrow + 32 * i, 0, lkc); }
#pragma unroll
  for (int i = 0; i < 4; ++i) { ra1[i] = aload(m0 + lrow + 32 * i, 1, lkc); rb1[i] = bload(n0 + lrow + 32 * i, 1, lkc); }
#pragma unroll
  for (int i = 0; i < 4; ++i) {
    *(uint4*)(As + (lrow + 32 * i) * LDT + lkc) = ra0[i];
    *(uint4*)(Bs + (lrow + 32 * i) * LDT + lkc) = rb0[i];
  }
  __syncthreads();
  auto compute = [&](int cur) {
    const bf16_t* Ab = As + cur * 128 * LDT; const bf16_t* Bb = Bs + cur * 128 * LDT;
#pragma unroll
    for (int kk = 0; kk < 2; ++kk) {
      bf16x8 a[4], b[4];
#pragma unroll
      for (int mt = 0; mt < 4; ++mt) a[mt] = *(const bf16x8*)(Ab + (wm * 64 + mt * 16 + l15) * LDT + kk * 32 + quad * 8);
#pragma unroll
      for (int nt = 0; nt < 4; ++nt) b[nt] = *(const bf16x8*)(Bb + (wc * 64 + nt * 16 + l15) * LDT + kk * 32 + quad * 8);
#pragma unroll
      for (int mt = 0; mt < 4; ++mt)
#pragma unroll
        for (int nt = 0; nt < 4; ++nt) acc[mt][nt] = __builtin_amdgcn_mfma_f32_16x16x32_bf16(b[nt], a[mt], acc[mt][nt], 0, 0, 0);
    }
  };
  for (;;) {
    const int wnext = w + nslot;
    const bool has_next = wnext < per;
    int m1 = m0, n1 = n0;
    if (has_next) tile_of(wnext, mtiles, ntiles, xcd, m1, n1);
#pragma unroll
    for (int i = 0; i < 4; ++i)
#pragma unroll
      for (int j = 0; j < 4; ++j) acc[i][j] = f32x4{0.f, 0.f, 0.f, 0.f};
    for (int ks = 0; ks < nks; ks += 2) {
      const bool in2 = ks + 2 < nks;
      {
        const int mm = in2 ? m0 : m1, nn = in2 ? n0 : n1, kq = in2 ? ks + 2 : 0;
#pragma unroll
        for (int i = 0; i < 4; ++i) { ra0[i] = aload(mm + lrow + 32 * i, kq, lkc); rb0[i] = bload(nn + lrow + 32 * i, kq, lkc); }
      }
      compute(0);
#pragma unroll
      for (int i = 0; i < 4; ++i) {
        *(uint4*)(As + 128 * LDT + (lrow + 32 * i) * LDT + lkc) = ra1[i];
        *(uint4*)(Bs + 128 * LDT + (lrow + 32 * i) * LDT + lkc) = rb1[i];
      }
      __syncthreads();
      {
        const int mm = in2 ? m0 : m1, nn = in2 ? n0 : n1, kq = in2 ? ks + 3 : 1;
#pragma unroll
        for (int i = 0; i < 4; ++i) { ra1[i] = aload(mm + lrow + 32 * i, kq, lkc); rb1[i] = bload(nn + lrow + 32 * i, kq, lkc); }
      }
      compute(1);
#pragma unroll
      for (int i = 0; i < 4; ++i) {
        *(uint4*)(As + (lrow + 32 * i) * LDT + lkc) = ra0[i];
        *(uint4*)(Bs + (lrow + 32 * i) * LDT + lkc) = rb0[i];
      }
      __syncthreads();
    }
    epi(acc, m0 + wm * 64, n0 + wc * 64);
    if (!has_next) break;
    w = wnext; m0 = m1; n0 = n1;
  }
}

template <class F>
DI void for_tiles(int mtiles, int ntiles, F f) {
  const int xcd = BID() & 7, slot = BID() >> 3, nslot = GDIM() >> 3;
  const int per = (mtiles >> 3) * ntiles;
  for (int w = slot; w < per; w += nslot) {
    int mi = w / ntiles, ni = w - mi * ntiles;
    f((mi * 8 + xcd), ni);
  }
}

#define EPI_LOOP for (int mt = 0; mt < 4; ++mt) for (int nt = 0; nt < 4; ++nt) for (int r = 0; r < 4; ++r)

DI void epi_resid(const Params& p, f32x4 (&acc)[4][4], int rb, int cb) {
  const int lane = TID() & 63, l15 = lane & 15, quad = lane >> 4;
#pragma unroll
  for (int mt = 0; mt < 4; ++mt)
#pragma unroll
    for (int nt = 0; nt < 4; ++nt) {
      float4* ptr = (float4*)(p.out + (size_t)(rb + mt * 16 + l15) * 1024 + cb + nt * 16 + quad * 4);
      float4 h = *ptr;
      h.x = ALPHA * h.x + acc[mt][nt][0]; h.y = ALPHA * h.y + acc[mt][nt][1]; h.z = ALPHA * h.z + acc[mt][nt][2]; h.w = ALPHA * h.w + acc[mt][nt][3];
      *ptr = h;
    }
}
DI void epi_bf16(bf16_t* dst, int ld, f32x4 (&acc)[4][4], int rb, int cb) {
  const int lane = TID() & 63, l15 = lane & 15, quad = lane >> 4;
#pragma unroll
  for (int mt = 0; mt < 4; ++mt)
#pragma unroll
    for (int nt = 0; nt < 4; ++nt) {
      u32x2 v; v[0] = pack2(acc[mt][nt][0], acc[mt][nt][1]); v[1] = pack2(acc[mt][nt][2], acc[mt][nt][3]);
      *(u32x2*)(dst + (size_t)(rb + mt * 16 + l15) * ld + cb + nt * 16 + quad * 4) = v;
    }
}

struct PlainLoad {
  const bf16_t* base; int ld;
  DI uint4 operator()(int row, int ks, int kc) const { return *(const uint4*)((const char*)base + (unsigned)((row * ld + ks * 64 + kc) * 2)); }
};

DI void phase_proj(const Params& p, int i, bf16_t* smem) {
  const bf16_t* W = (const bf16_t*)(p.ws + OFF_W) + W_EVEN0 + (size_t)i * (SZ_WIN + SZ_SQ);
  PlainLoad al{(const bf16_t*)(p.ws + OFF_HB), 1024}, bl{W, 1024};
  bf16_t* dnqkv = (bf16_t*)(p.ws + OFF_DNQKV); bf16_t* z = (bf16_t*)(p.ws + OFF_Z);
  bf16_t* swq = (bf16_t*)(p.ws + OFF_SWQ); bf16_t* swk = (bf16_t*)(p.ws + OFF_SWK); bf16_t* swv = (bf16_t*)(p.ws + OFF_SWV);
  float* logit = (float*)(p.ws + OFF_LOGIT);
  const float* rc = (const float*)(p.ws + OFF_ROPE); const float* rs = rc + (size_t)T_ * 32;
  {
    gemm_stream(256, 29, 16, al, bl, [&](f32x4 (&acc)[4][4], int rb, int cb) {
      const int lane = TID() & 63, l15 = lane & 15, quad = lane >> 4;
      if (cb < 1536) epi_bf16(dnqkv, 1536, acc, rb, cb);
      else if (cb < 2048) epi_bf16(z, 512, acc, rb, cb - 1536);
      else if (cb < 3072) {
        bf16_t* dst = (cb < 2560) ? swq : swk; const int c0 = (cb < 2560) ? cb - 2048 : cb - 2560;
#pragma unroll
        for (int mt = 0; mt < 4; ++mt) {
          const int row = rb + mt * 16 + l15;
#pragma unroll
          for (int nt = 0; nt < 2; ++nt) {
            const int d = nt * 16 + quad * 4;
            const float4 c = *(const float4*)(rc + (size_t)row * 32 + d), sn = *(const float4*)(rs + (size_t)row * 32 + d);
            const f32x4 x1 = acc[mt][nt], x2 = acc[mt][nt + 2];
            u32x2 o1, o2;
            o1[0] = pack2(x1[0] * c.x - x2[0] * sn.x, x1[1] * c.y - x2[1] * sn.y); o1[1] = pack2(x1[2] * c.z - x2[2] * sn.z, x1[3] * c.w - x2[3] * sn.w);
            o2[0] = pack2(x2[0] * c.x + x1[0] * sn.x, x2[1] * c.y + x1[1] * sn.y); o2[1] = pack2(x2[2] * c.z + x1[2] * sn.z, x2[3] * c.w + x1[3] * sn.w);
            *(u32x2*)(dst + (size_t)row * 512 + c0 + d) = o1;
            *(u32x2*)(dst + (size_t)row * 512 + c0 + d + 32) = o2;
          }
        }
      } else if (cb < 3584) epi_bf16(swv, 512, acc, rb, cb - 3072);
      else if (cb == 3584) {
        if (quad < 2) {
#pragma unroll
          for (int mt = 0; mt < 4; ++mt)
            *(float4*)(logit + (size_t)(rb + mt * 16 + l15) * 8 + quad * 4) = make_float4(acc[mt][0][0], acc[mt][0][1], acc[mt][0][2], acc[mt][0][3]);
        }
      }
    }, smem);
  }
}

DI void phase_dil_attn(const Params& p, int first, int nblk);

DI void phase_dn_prep(const Params& p, int i, char* smem) {
  bf16_t* qs = (bf16_t*)smem; bf16_t* ks = qs + 64 * 136; bf16_t* vs = ks + 64 * 136;
  float* Lm = (float*)(smem + 3 * 17408); float* beta = Lm + 64 * 68; float* gcum = beta + 64; float* egc = gcum + 64;
  const bf16_t* dnqkv = (const bf16_t*)(p.ws + OFF_DNQKV);
  const float* logit = (const float*)(p.ws + OFF_LOGIT);
  bf16_t* qd_g = (bf16_t*)(p.ws + OFF_QD); bf16_t* kd_g = (bf16_t*)(p.ws + OFF_KD); bf16_t* in_g = (bf16_t*)(p.ws + OFF_INTRA);
  bf16_t* w_g = (bf16_t*)(p.ws + OFF_WB); bf16_t* u_g = (bf16_t*)(p.ws + OFF_UB); float* eg_g = (float*)(p.ws + OFF_EG);
  const float* cw = p.dn_conv_w + (size_t)i * 4 * 1536;
  const int tid = TID(), wave = tid >> 6, lane = tid & 63, l15 = lane & 15, quad = lane >> 4;
  const float QS = 0.08838834764831845f;
  for (int item = BID(); item < 2048; item += GDIM()) {
    const int b = item >> 8, h = (item >> 6) & 3, n = item & 63;
    const int t0 = b * 4096 + n * 64, s0 = n * 64;
    const float A = __expf(p.dn_a_log[i * 4 + h]), dtb = p.dn_dt_bias[i * 4 + h];
    {
      float cw0[3][4], cw1[3][4], x0[3][4], x1[3][4];
#pragma unroll
      for (int which = 0; which < 3; ++which)
#pragma unroll
        for (int j = 0; j < 4; ++j) {
          const int col = which * 512 + h * 128 + lane * 2;
          cw0[which][j] = cw[j * 1536 + col]; cw1[which][j] = cw[j * 1536 + col + 1];
        }
      const int ilb = wave * 16;
#pragma unroll
      for (int which = 0; which < 3; ++which)
#pragma unroll
        for (int j = 0; j < 3; ++j) {
          const int sq = s0 + ilb - 3 + j;
          unsigned v = 0u;
          if (sq >= 0) v = *(const unsigned*)(dnqkv + (size_t)(t0 + ilb - 3 + j) * 1536 + which * 512 + h * 128 + lane * 2);
          x0[which][j + 1] = bf2f((bf16_t)(v & 0xffff)); x1[which][j + 1] = bf2f((bf16_t)(v >> 16));
        }
#pragma unroll 4
      for (int tt = 0; tt < 16; ++tt) {
        const int il = ilb + tt;
#pragma unroll
        for (int which = 0; which < 3; ++which) {
          x0[which][0] = x0[which][1]; x0[which][1] = x0[which][2]; x0[which][2] = x0[which][3];
          x1[which][0] = x1[which][1]; x1[which][1] = x1[which][2]; x1[which][2] = x1[which][3];
          const unsigned v = *(const unsigned*)(dnqkv + (size_t)(t0 + il) * 1536 + which * 512 + h * 128 + lane * 2);
          x0[which][3] = bf2f((bf16_t)(v & 0xffff)); x1[which][3] = bf2f((bf16_t)(v >> 16));
          float y0 = cw0[which][0] * x0[which][0] + cw0[which][1] * x0[which][1] + cw0[which][2] * x0[which][2] + cw0[which][3] * x0[which][3];
          float y1 = cw1[which][0] * x1[which][0] + cw1[which][1] * x1[which][1] + cw1[which][2] * x1[which][2] + cw1[which][3] * x1[which][3];
          y0 = siluf_(y0); y1 = siluf_(y1);
          if (which < 2) {
            float ss = wave_sum(y0 * y0 + y1 * y1);
            float sc = rsqrtf(ss + 1e-6f);
            y0 *= sc; y1 *= sc;
          }
          bf16_t* dst = (which == 0) ? qs : (which == 1 ? ks : vs);
          *(unsigned*)(dst + il * 136 + lane * 2) = pack2(y0, y1);
        }
      }
    }
    if (wave == 0) {
      const size_t row = (size_t)(t0 + lane);
      const float bl = logit[row * 8 + h], al = logit[row * 8 + 4 + h];
      float g = -A * softplusf_(al + dtb);
#pragma unroll
      for (int o = 1; o < 64; o <<= 1) { float v = __shfl_up(g, o); if (lane >= o) g += v; }
      beta[lane] = sigmoidf_(bl); gcum[lane] = g; egc[lane] = __expf(g);
    }
    __syncthreads();
    {
      f32x4 kk[4], qk[4];
#pragma unroll
      for (int nt = 0; nt < 4; ++nt) { kk[nt] = f32x4{0.f, 0.f, 0.f, 0.f}; qk[nt] = f32x4{0.f, 0.f, 0.f, 0.f}; }
#pragma unroll
      for (int k4 = 0; k4 < 4; ++k4) {
        const bf16x8 ak = *(const bf16x8*)(ks + (wave * 16 + l15) * 136 + k4 * 32 + quad * 8);
        const bf16x8 aq = *(const bf16x8*)(qs + (wave * 16 + l15) * 136 + k4 * 32 + quad * 8);
#pragma unroll
        for (int nt = 0; nt < 4; ++nt) {
          const bf16x8 bk = *(const bf16x8*)(ks + (nt * 16 + l15) * 136 + k4 * 32 + quad * 8);
          kk[nt] = MFMA16(ak, bk, kk[nt]); qk[nt] = MFMA16(aq, bk, qk[nt]);
        }
      }
#pragma unroll
      for (int nt = 0; nt < 4; ++nt)
#pragma unroll
        for (int r = 0; r < 4; ++r) {
          const int ii = wave * 16 + quad * 4 + r, jj = nt * 16 + l15;
          const float dec = (jj <= ii) ? __expf(gcum[ii] - gcum[jj]) : 0.f;
          Lm[ii * 68 + jj] = (jj < ii) ? beta[ii] * kk[nt][r] * dec : 0.f;
          in_g[(size_t)item * 4096 + ii * 64 + kperm(jj)] = f2bf(qk[nt][r] * QS * dec);
        }
    }
    __syncthreads();
    {
      float x[64];
#pragma unroll
      for (int ii = 0; ii < 64; ++ii) x[ii] = 0.f;
      const int c = tid & 127;
      const bool isw = tid >= 128;
      bf16_t* dstb = (isw ? w_g : u_g) + (size_t)item * 8192 + (isw ? kperm(c) : c);
      const bf16_t* srcb = (isw ? ks : vs) + c;
#pragma unroll
      for (int ii = 0; ii < 64; ++ii) {
        float acc = bf2f(srcb[ii * 136]) * beta[ii] * (isw ? egc[ii] : 1.f);
#pragma unroll
        for (int j4 = 0; j4 < (ii + 3) / 4; ++j4) {
          const float4 l4 = *(const float4*)(Lm + ii * 68 + j4 * 4);
          acc -= l4.x * x[j4 * 4]; acc -= l4.y * x[j4 * 4 + 1]; acc -= l4.z * x[j4 * 4 + 2]; acc -= l4.w * x[j4 * 4 + 3];
        }
        x[ii] = acc;
        dstb[ii * 128] = f2bf(acc);
        if ((ii & 3) == 3) __builtin_amdgcn_sched_barrier(0);
      }
    }
    {
      const float gl = gcum[63];
#pragma unroll 4
      for (int k = 0; k < 32; ++k) {
        const int e = tid + 256 * k;
        const int ii = e >> 7, d = e & 127;
        qd_g[(size_t)item * 8192 + ii * 128 + kperm(d)] = f2bf(bf2f(qs[ii * 136 + d]) * QS * egc[ii]);
        const int d2 = e >> 6, i2 = e & 63;
        kd_g[(size_t)item * 8192 + d2 * 64 + kperm(i2)] = f2bf(bf2f(ks[i2 * 136 + d2]) * __expf(gl - gcum[i2]));
      }
      if (tid == 0) eg_g[item] = __expf(gl);
    }
    __syncthreads();
  }
}

DI bf16x8 ld2(const bf16_t* ptr) {
  u32x2 lo = *(const u32x2*)ptr, hi = *(const u32x2*)(ptr + 16);
  u32x4 t; t[0] = lo[0]; t[1] = lo[1]; t[2] = hi[0]; t[3] = hi[1];
  return __builtin_bit_cast(bf16x8, t);
}

DI void dn_chain_item(const Params& p, int item, bf16_t* smem) {
  const int tid = TID(), wave = tid >> 6, lane = tid & 63, l15 = lane & 15, quad = lane >> 4;
  const int bh = item >> 1, half = item & 1;
  const int e0 = half * 64 + wave * 16 + l15;
  const bf16_t* qd_g = (const bf16_t*)(p.ws + OFF_QD); const bf16_t* kd_g = (const bf16_t*)(p.ws + OFF_KD); const bf16_t* in_g = (const bf16_t*)(p.ws + OFF_INTRA);
  const bf16_t* w_g = (const bf16_t*)(p.ws + OFF_WB); bf16_t* u_g = (bf16_t*)(p.ws + OFF_UB); const float* eg_g = (const float*)(p.ws + OFF_EG);
  bf16_t* wl = smem; bf16_t* ql = wl + 64 * 136; bf16_t* kl = ql + 64 * 136; bf16_t* il = kl + 128 * 72; bf16_t* ul = il + 64 * 72;
  uint4 rw0, rw1, rw2, rw3, rq0, rq1, rq2, rq3, rk0, rk1, rk2, rk3, ri0, ri1, ru0, ru1;
#define CH_GLOAD(n_) do { const size_t ci_ = (size_t)bh * 64 + (n_); \
    const bf16_t* w_ = w_g + ci_ * 8192 + tid * 8; const bf16_t* q_ = qd_g + ci_ * 8192 + tid * 8; const bf16_t* k_ = kd_g + ci_ * 8192 + tid * 8; \
    rw0 = *(const uint4*)(w_); rw1 = *(const uint4*)(w_ + 2048); rw2 = *(const uint4*)(w_ + 4096); rw3 = *(const uint4*)(w_ + 6144); \
    rq0 = *(const uint4*)(q_); rq1 = *(const uint4*)(q_ + 2048); rq2 = *(const uint4*)(q_ + 4096); rq3 = *(const uint4*)(q_ + 6144); \
    rk0 = *(const uint4*)(k_); rk1 = *(const uint4*)(k_ + 2048); rk2 = *(const uint4*)(k_ + 4096); rk3 = *(const uint4*)(k_ + 6144); \
    ri0 = *(const uint4*)(in_g + ci_ * 4096 + tid * 8); ri1 = *(const uint4*)(in_g + ci_ * 4096 + 2048 + tid * 8); \
    ru0 = *(const uint4*)(u_g + ci_ * 8192 + (tid >> 3) * 128 + half * 64 + (tid & 7) * 8); \
    ru1 = *(const uint4*)(u_g + ci_ * 8192 + (32 + (tid >> 3)) * 128 + half * 64 + (tid & 7) * 8); } while (0)
#define CH_LSTORE() do { \
    bf16_t* w_ = wl + (tid >> 4) * 136 + (tid & 15) * 8; bf16_t* q_ = ql + (tid >> 4) * 136 + (tid & 15) * 8; bf16_t* k_ = kl + (tid >> 3) * 72 + (tid & 7) * 8; \
    *(uint4*)(w_) = rw0; *(uint4*)(w_ + 16 * 136) = rw1; *(uint4*)(w_ + 32 * 136) = rw2; *(uint4*)(w_ + 48 * 136) = rw3; \
    *(uint4*)(q_) = rq0; *(uint4*)(q_ + 16 * 136) = rq1; *(uint4*)(q_ + 32 * 136) = rq2; *(uint4*)(q_ + 48 * 136) = rq3; \
    *(uint4*)(k_) = rk0; *(uint4*)(k_ + 32 * 72) = rk1; *(uint4*)(k_ + 64 * 72) = rk2; *(uint4*)(k_ + 96 * 72) = rk3; \
    *(uint4*)(il + (tid >> 3) * 72 + (tid & 7) * 8) = ri0; *(uint4*)(il + (32 + (tid >> 3)) * 72 + (tid & 7) * 8) = ri1; \
    *(uint4*)(ul + (tid >> 3) * 72 + (tid & 7) * 8) = ru0; *(uint4*)(ul + (32 + (tid >> 3)) * 72 + (tid & 7) * 8) = ru1; } while (0)
  f32x4 S[8];
#pragma unroll
  for (int mt = 0; mt < 8; ++mt) S[mt] = f32x4{0.f, 0.f, 0.f, 0.f};
  CH_GLOAD(0);
  CH_LSTORE();
  __syncthreads();
#pragma unroll 1
  for (int n = 0; n < 64; ++n) {
    const size_t ci = (size_t)bh * 64 + n;
    if (n + 1 < 64) CH_GLOAD(n + 1);
    bf16_t* ub = u_g + ci * 8192;
    const float eg = eg_g[ci];
    bf16x8 sb[4];
#pragma unroll
    for (int s = 0; s < 4; ++s) sb[s] = pack8(S[2 * s], S[2 * s + 1]);
    f32x4 vn[4];
#pragma unroll
    for (int it = 0; it < 4; ++it) {
      f32x4 a = {0.f, 0.f, 0.f, 0.f};
#pragma unroll
      for (int s = 0; s < 4; ++s) a = MFMA16(*(const bf16x8*)(wl + (it * 16 + l15) * 136 + s * 32 + quad * 8), sb[s], a);
#pragma unroll
      for (int r = 0; r < 4; ++r) vn[it][r] = bf2f(ul[(it * 16 + quad * 4 + r) * 72 + wave * 16 + l15]) - a[r];
    }
    bf16x8 vb[2];
    vb[0] = pack8(vn[0], vn[1]); vb[1] = pack8(vn[2], vn[3]);
#pragma unroll
    for (int it = 0; it < 4; ++it) {
      f32x4 a = {0.f, 0.f, 0.f, 0.f};
#pragma unroll
      for (int s = 0; s < 4; ++s) a = MFMA16(*(const bf16x8*)(ql + (it * 16 + l15) * 136 + s * 32 + quad * 8), sb[s], a);
#pragma unroll
      for (int s = 0; s < 2; ++s) a = MFMA16(*(const bf16x8*)(il + (it * 16 + l15) * 72 + s * 32 + quad * 8), vb[s], a);
#pragma unroll
      for (int r = 0; r < 4; ++r) ub[(it * 16 + quad * 4 + r) * 128 + e0] = f2bf(a[r]);
    }
#pragma unroll
    for (int mt = 0; mt < 8; ++mt) {
      f32x4 a = S[mt];
      a[0] *= eg; a[1] *= eg; a[2] *= eg; a[3] *= eg;
#pragma unroll
      for (int s = 0; s < 2; ++s) a = MFMA16(*(const bf16x8*)(kl + (mt * 16 + l15) * 72 + s * 32 + quad * 8), vb[s], a);
      S[mt] = a;
    }
    __syncthreads();
    if (n + 1 < 64) CH_LSTORE();
    __syncthreads();
  }
}

DI void phase_mix(const Params& p, int i, bf16_t* smem) {
  if (BID() < 64) { dn_chain_item(p, BID(), smem); return; }
  phase_dil_attn(p, BID() - 64, GDIM() - 64);
}

DI void phase_dn_post(const Params& p, int i) {
  const bf16_t* ob = (const bf16_t*)(p.ws + OFF_UB);
  bf16_t* z = (bf16_t*)(p.ws + OFF_Z);
  const float* ng = p.dn_norm_g + i * 128;
  const int wave = TID() >> 6, lane = TID() & 63;
  const int N = T_ * 4;
  for (int base = BID() * 4; base < N; base += GDIM() * 4) {
    const int item = base + wave;
    const int t = item >> 2, h = item & 3, b = t >> 12, sidx = t & 4095;
    const size_t g = (size_t)item * 128 + lane * 2;
    const size_t og = ((size_t)((b * 4 + h) * 64 + (sidx >> 6))) * 8192 + (sidx & 63) * 128 + lane * 2;
    unsigned ov = *(const unsigned*)(ob + og), zv = *(const unsigned*)(z + g);
    float o0 = bf2f((bf16_t)(ov & 0xffff)), o1 = bf2f((bf16_t)(ov >> 16));
    float z0 = bf2f((bf16_t)(zv & 0xffff)), z1 = bf2f((bf16_t)(zv >> 16));
    float ms = wave_sum(o0 * o0 + o1 * o1) * (1.f / 128.f);
    float rr = rsqrtf(ms + 1e-6f);
    float r0 = o0 * rr * ng[lane * 2] * siluf_(z0), r1 = o1 * rr * ng[lane * 2 + 1] * siluf_(z1);
    *(unsigned*)(z + g) = pack2(r0, r1);
  }
}

struct MixLoad {
  const bf16_t* a; const bf16_t* b;
  DI uint4 operator()(int row, int ks, int kc) const {
    const unsigned off = (unsigned)((row * 512 + (ks & 7) * 64 + kc) * 2);
    return *(const uint4*)((const char*)((ks < 8) ? a : b) + off);
  }
};

DI void phase_wout(const Params& p, int i, bf16_t* smem) {
  const bf16_t* W = (const bf16_t*)(p.ws + OFF_W) + W_EVEN0 + (size_t)i * (SZ_WIN + SZ_SQ) + SZ_WIN;
  MixLoad al{(const bf16_t*)(p.ws + OFF_Z), (const bf16_t*)(p.ws + OFF_SWQ)};
  PlainLoad bl{W, 1024};
  {
    gemm_stream(256, 8, 16, al, bl, [&](f32x4 (&acc)[4][4], int rb, int cb) { epi_resid(p, acc, rb, cb); }, smem);
  }
}

template <int R>
DI void ln_rows(const Params& p, int row0, const float* g, const float* b, int lane) {
  bf16_t* hb = (bf16_t*)(p.ws + OFF_HB);
  float4 v[R][4];
#pragma unroll
  for (int j = 0; j < R; ++j)
#pragma unroll
    for (int i = 0; i < 4; ++i) v[j][i] = ((const float4*)(p.out + (size_t)(row0 + j) * 1024))[lane + 64 * i];
  float4 gg[4], bb[4];
#pragma unroll
  for (int i = 0; i < 4; ++i) { gg[i] = ((const float4*)g)[lane + 64 * i]; bb[i] = ((const float4*)b)[lane + 64 * i]; }
#pragma unroll
  for (int j = 0; j < R; ++j) {
    float s = 0.f;
#pragma unroll
    for (int i = 0; i < 4; ++i) s += v[j][i].x + v[j][i].y + v[j][i].z + v[j][i].w;
    const float mu = wave_sum(s) * (1.f / 1024.f);
    float q = 0.f;
#pragma unroll
    for (int i = 0; i < 4; ++i) { float a = v[j][i].x - mu, b2 = v[j][i].y - mu, c = v[j][i].z - mu, d = v[j][i].w - mu; q += a * a + b2 * b2 + c * c + d * d; }
    const float rstd = rsqrtf(wave_sum(q) * (1.f / 1024.f) + 1e-5f);
    float4* y = (float4*)(p.out + (size_t)(row0 + j) * 1024);
#pragma unroll
    for (int i = 0; i < 4; ++i) {
      float4 o;
      o.x = (v[j][i].x - mu) * rstd * gg[i].x + bb[i].x; o.y = (v[j][i].y - mu) * rstd * gg[i].y + bb[i].y;
      o.z = (v[j][i].z - mu) * rstd * gg[i].z + bb[i].z; o.w = (v[j][i].w - mu) * rstd * gg[i].w + bb[i].w;
      y[lane + 64 * i] = o;
      uint2 ob; ob.x = pack2(o.x, o.y); ob.y = pack2(o.z, o.w);
      ((uint2*)(hb + (size_t)(row0 + j) * 1024))[lane + 64 * i] = ob;
    }
  }
}
DI void phase_ln(const Params& p, const float* g, const float* b) {
  const int wave = TID() >> 6, lane = TID() & 63;
  for (int row = (BID() * 4 + wave) * 4; row < T_; row += GDIM() * 16) ln_rows<4>(p, row, g, b, lane);
}

DI void phase_s5_naive(const Params& p, int i) {
  const int wave = TID() >> 6, lane = TID() & 63;
  bf16_t* hid = (bf16_t*)(p.ws + OFF_HID);
  for (int base = BID() * 4; base < 512; base += GDIM() * 4) {
    const int item = base + wave, b = item >> 6, g = item & 63;
    const int gp = (i * 64 + g) * 64 + lane;
    const double dt = exp((double)p.s5_log_dt[i * 64 + g]);
    const double are = p.s5_a_re[gp], aim = p.s5_a_im[gp];
    const double lr = are * dt, li = aim * dt;
    const double kk = rint(li * 0.15915494309189535);
    const double red = li - kk * 6.283185307179586;
    const double e = exp(lr);
    const double abr = e * cos(red), abi = e * sin(red);
    const double den = are * are + aim * aim;
    const double nr = abr - 1.0, ni = abi;
    const double cfr = (nr * are + ni * aim) / den, cfi = (ni * are - nr * aim) / den;
    float bbr[16], bbi[16], cr[16], ci[16];
#pragma unroll
    for (int h = 0; h < 16; ++h) {
      const double br = p.s5_b_re[(size_t)gp * 16 + h], bi = p.s5_b_im[(size_t)gp * 16 + h];
      bbr[h] = (float)(cfr * br - cfi * bi); bbi[h] = (float)(cfr * bi + cfi * br);
      cr[h] = p.s5_c_re[((size_t)(i * 64 + g) * 16 + h) * 64 + lane];
      ci[h] = p.s5_c_im[((size_t)(i * 64 + g) * 16 + h) * 64 + lane];
    }
    const float ar = (float)abr, ai = (float)abi;
    const float dsk = p.s5_d[i * 1024 + g * 16 + (lane & 15)];
    float sr = 0.f, si = 0.f;
#pragma unroll 1
    for (int t = 0; t < S_; ++t) {
      const size_t row = (size_t)(b * S_ + t);
      const float4* up = (const float4*)(p.out + row * 1024 + g * 16);
      float u[16];
#pragma unroll
      for (int j = 0; j < 4; ++j) { float4 v = up[j]; u[4 * j] = v.x; u[4 * j + 1] = v.y; u[4 * j + 2] = v.z; u[4 * j + 3] = v.w; }
      float bur = 0.f, bui = 0.f;
#pragma unroll
      for (int h = 0; h < 16; ++h) { bur += bbr[h] * u[h]; bui += bbi[h] * u[h]; }
      const float nsr = ar * sr - ai * si + bur, nsi = ar * si + ai * sr + bui;
      sr = nsr; si = nsi;
      float yk = 0.f, uk = 0.f;
#pragma unroll
      for (int h = 0; h < 16; ++h) {
        float v = wave_sum(cr[h] * sr - ci[h] * si);
        if (lane == h) { yk = v; uk = u[h]; }
      }
      if (lane < 16) hid[row * 1024 + g * 16 + lane] = f2bf(gelu_tanh(yk + dsk * uk));
    }
  }
}

DI void phase_s5_tables(const Params& p, int i, float* smem) {
  float2* pw = (float2*)smem;
  float2* bb = pw + 64 * 33;
  float2* cc = bb + 64 * 16;
  bf16_t* Ktab = (bf16_t*)(p.ws + OFF_KTAB); bf16_t* Etab = (bf16_t*)(p.ws + OFF_ETAB); bf16_t* Gtab = (bf16_t*)(p.ws + OFF_GTAB);
  float2* AL = (float2*)(p.ws + OFF_AL);
  const int tid = TID();
  for (int item = BID(); item < 512; item += GDIM()) {
    const int g = item >> 3, part = item & 7;
    const double dt = exp((double)p.s5_log_dt[i * 64 + g]);
    for (int e = tid; e < 64 * 33; e += 256) {
      const int pp = e / 33, n = e - pp * 33;
      const double are = p.s5_a_re[(i * 64 + g) * 64 + pp], aim = p.s5_a_im[(i * 64 + g) * 64 + pp];
      const double lr = are * dt * n, li = aim * dt * n;
      const double k = rint(li * 0.15915494309189535);
      const double red = li - k * 6.283185307179586;
      const double ex = exp(lr);
      pw[e] = make_float2((float)(ex * cos(red)), (float)(ex * sin(red)));
    }
    for (int e = tid; e < 1024; e += 256) {
      const int pp = e >> 4;
      const int gp = (i * 64 + g) * 64 + pp;
      const double are = p.s5_a_re[gp], aim = p.s5_a_im[gp];
      const double lr = are * dt, li = aim * dt;
      const double k = rint(li * 0.15915494309189535);
      const double red = li - k * 6.283185307179586;
      const double ex = exp(lr);
      const double nr = ex * cos(red) - 1.0, ni = ex * sin(red);
      const double den = are * are + aim * aim;
      const double cfr = (nr * are + ni * aim) / den, cfi = (ni * are - nr * aim) / den;
      const double br = p.s5_b_re[(size_t)gp * 16 + (e & 15)], bi = p.s5_b_im[(size_t)gp * 16 + (e & 15)];
      bb[e] = make_float2((float)(cfr * br - cfi * bi), (float)(cfr * bi + cfi * br));
      const size_t ci = ((size_t)(i * 64 + g) * 16 + (e >> 6)) * 64 + (e & 63);
      cc[e] = make_float2(p.s5_c_re[ci], p.s5_c_im[ci]);
    }
    __syncthreads();
    for (int e = part * 1024 + tid; e < (part + 1) * 1024; e += 256) {
      const int tau = e >> 8, ho = (e >> 4) & 15, hi = e & 15;
      float acc = 0.f;
      for (int pp = 0; pp < 64; ++pp) {
        const float2 c = cc[ho * 64 + pp], w = pw[pp * 33 + tau], b = bb[pp * 16 + hi];
        const float cwr = c.x * w.x - c.y * w.y, cwi = c.x * w.y + c.y * w.x;
        acc += cwr * b.x - cwi * b.y;
      }
      Ktab[(size_t)g * 8192 + e] = f2bf(acc);
    }
    for (int e = part * 8192 + tid; e < (part + 1) * 8192; e += 256) {
      const int pc = e >> 9, sidx = (e >> 4) & 31, hi = e & 15, pp = pc & 63;
      const float2 w = pw[pp * 33 + 31 - sidx], b = bb[pp * 16 + hi];
      const float v = (pc < 64) ? (w.x * b.x - w.y * b.y) : (w.x * b.y + w.y * b.x);
      Etab[(size_t)g * 65536 + e] = f2bf(v);
    }
    for (int e = part * 8192 + tid; e < (part + 1) * 8192; e += 256) {
      const int row = e >> 7, pc = e & 127, pp = pc & 63, t = row >> 4, ho = row & 15;
      const float2 c = cc[ho * 64 + pp], w = pw[pp * 33 + t + 1];
      const float v = (pc < 64) ? (c.x * w.x - c.y * w.y) : -(c.x * w.y + c.y * w.x);
      Gtab[(size_t)g * 65536 + e] = f2bf(v);
    }
    if (tid < 64 && part == 0) AL[g * 64 + tid] = pw[tid * 33 + 32];
    __syncthreads();
  }
}

DI void phase_s5_end(const Params& p, bf16_t* smem) {
  const bf16_t* Etab = (const bf16_t*)(p.ws + OFF_ETAB); const bf16_t* hb = (const bf16_t*)(p.ws + OFF_HB);
  const float2* AL = (const float2*)(p.ws + OFF_AL);
  bf16_t* sin_ = (bf16_t*)(p.ws + OFF_SIN);
  float* endbuf = (float*)smem;
  for (int item = BID(); item < 512; item += GDIM()) {
    const int g = item >> 3, b = item & 7;
    auto al = [=](int row, int ks, int kc) { return *(const uint4*)((const char*)Etab + (unsigned)((((g * 128 + row) * 512) + ks * 64 + kc) * 2)); };
    auto bl = [=](int n, int ks, int kc) {
      const int k = ks * 64 + kc, sidx = k >> 4, hi0 = k & 15;
      return *(const uint4*)((const char*)hb + (unsigned)(((b * 4096 + n * 32 + sidx) * 1024 + g * 16 + hi0) * 2));
    };
    gemm_tile(0, 0, 8, al, bl, [&](f32x4 (&acc)[4][4], int rb, int cb) {
      const int lane = TID() & 63, l15 = lane & 15, quad = lane >> 4;
#pragma unroll
      for (int mt = 0; mt < 4; ++mt)
#pragma unroll
        for (int nt = 0; nt < 4; ++nt)
#pragma unroll
          for (int r = 0; r < 4; ++r) endbuf[(rb + mt * 16 + l15) * 129 + cb + nt * 16 + quad * 4 + r] = acc[mt][nt][r];
    }, smem);
    __syncthreads();
    if (TID() < 64) {
      const int pp = TID();
      const float2 a = AL[g * 64 + pp];
      float sr = 0.f, si = 0.f;
      for (int n = 0; n < 128; ++n) {
        bf16_t* dst = sin_ + ((size_t)g * 1024 + b * 128 + n) * 128;
        dst[pp] = f2bf(sr); dst[64 + pp] = f2bf(si);
        const float er = endbuf[pp * 129 + n], ei = endbuf[(64 + pp) * 129 + n];
        const float nr = a.x * sr - a.y * si + er, ni = a.x * si + a.y * sr + ei;
        sr = nr; si = ni;
      }
    }
    __syncthreads();
  }
}

DI void phase_s5_y(const Params& p, int i, bf16_t* smem) {
  const bf16_t* Ktab = (const bf16_t*)(p.ws + OFF_KTAB); const bf16_t* Gtab = (const bf16_t*)(p.ws + OFF_GTAB);
  const bf16_t* hb = (const bf16_t*)(p.ws + OFF_HB); const bf16_t* sin_ = (const bf16_t*)(p.ws + OFF_SIN);
  bf16_t* hid = (bf16_t*)(p.ws + OFF_HID);
  for (int w = BID(); w < 2048; w += GDIM()) {
    const int g = w >> 5, mtile = (w >> 3) & 3, b = w & 7;
    const int nT = mtile * 2 + 2;
    auto al = [=](int row, int ks, int kc) -> uint4 {
      if (ks < nT) {
        const int k = ks * 64 + kc, sidx = k >> 4, hi0 = k & 15, t = row >> 4, ho = row & 15;
        if (t >= sidx) return *(const uint4*)((const char*)Ktab + (unsigned)(((((g * 32 + (t - sidx)) * 16 + ho) * 16) + hi0) * 2));
        return make_uint4(0, 0, 0, 0);
      }
      return *(const uint4*)((const char*)Gtab + (unsigned)((((g * 512 + row) * 128) + (ks - nT) * 64 + kc) * 2));
    };
    auto bl = [=](int n, int ks, int kc) -> uint4 {
      if (ks < nT) {
        const int k = ks * 64 + kc, sidx = k >> 4, hi0 = k & 15;
        return *(const uint4*)((const char*)hb + (unsigned)(((b * 4096 + n * 32 + sidx) * 1024 + g * 16 + hi0) * 2));
      }
      return *(const uint4*)((const char*)sin_ + (unsigned)((((g * 1024 + b * 128 + n) * 128) + (ks - nT) * 64 + kc) * 2));
    };
    gemm_tile(0, mtile * 128, nT + 2, bl, al, [&](f32x4 (&acc)[4][4], int rb, int cb) {
      const int lane = TID() & 63, l15 = lane & 15, quad = lane >> 4;
      const float4 dsk = *(const float4*)(p.s5_d + i * 1024 + g * 16 + quad * 4);
#pragma unroll
      for (int mt = 0; mt < 4; ++mt)
#pragma unroll
        for (int nt = 0; nt < 4; ++nt) {
          const int t = (cb + nt * 16) >> 4, n = rb + mt * 16 + l15;
          const size_t tok = (size_t)b * 4096 + n * 32 + t;
          const float4 u = *(const float4*)(p.out + tok * 1024 + g * 16 + quad * 4);
          u32x2 v;
          v[0] = pack2(gelu_tanh(acc[mt][nt][0] + dsk.x * u.x), gelu_tanh(acc[mt][nt][1] + dsk.y * u.y));
          v[1] = pack2(gelu_tanh(acc[mt][nt][2] + dsk.z * u.z), gelu_tanh(acc[mt][nt][3] + dsk.w * u.w));
          *(u32x2*)(hid + tok * 1024 + g * 16 + quad * 4) = v;
        }
    }, smem);
  }
}

DI void phase_glu(const Params& p, int i, bf16_t* smem) {
  const bf16_t* W = (const bf16_t*)(p.ws + OFF_W) + W_ODD0 + (size_t)i * SZ_GLU;
  PlainLoad al{(const bf16_t*)(p.ws + OFF_HID), 1024}, bl{W, 1024};
  {
    gemm_stream(256, 16, 16, al, bl, [&](f32x4 (&acc)[4][4], int rb, int cb) {
      const int lane = TID() & 63, l15 = lane & 15, quad = lane >> 4;
#pragma unroll
      for (int mt = 0; mt < 4; ++mt)
#pragma unroll
        for (int np = 0; np < 2; ++np) {
          float4* ptr = (float4*)(p.out + (size_t)(rb + mt * 16 + l15) * 1024 + (cb >> 1) + np * 16 + quad * 4);
          float4 h = *ptr;
          h.x = ALPHA * h.x + acc[mt][2 * np][0] * sigmoidf_(acc[mt][2 * np + 1][0]);
          h.y = ALPHA * h.y + acc[mt][2 * np][1] * sigmoidf_(acc[mt][2 * np + 1][1]);
          h.z = ALPHA * h.z + acc[mt][2 * np][2] * sigmoidf_(acc[mt][2 * np + 1][2]);
          h.w = ALPHA * h.w + acc[mt][2 * np][3] * sigmoidf_(acc[mt][2 * np + 1][3]);
          *ptr = h;
        }
    }, smem);
  }
}

DI void phase_xproj(const Params& p, int l, bf16_t* smem) {
  const bf16_t* wc = (const bf16_t*)(p.ws + OFF_W) + (size_t)l * SZ_COMMON;
  {
    PlainLoad al{(const bf16_t*)(p.ws + OFF_HB), 1024}, bl{wc, 1024};
    bf16_t* q = (bf16_t*)(p.ws + OFF_XQ);
    gemm_stream(256, 8, 16, al, bl, [&](f32x4 (&acc)[4][4], int rb, int cb) { epi_bf16(q, 1024, acc, rb, cb); }, smem);
  }
  {
    const float* memf = p.mem;
    auto al = [=](int row, int ks, int kc) -> uint4 {
      const float4* src = (const float4*)((const char*)memf + (unsigned)((row * 1024 + ks * 64 + kc) * 4));
      float4 a = src[0], b2 = src[1];
      return make_uint4(pack2(a.x, a.y), pack2(a.z, a.w), pack2(b2.x, b2.y), pack2(b2.z, b2.w));
    };
    bf16_t* kx = (bf16_t*)(p.ws + OFF_KX); bf16_t* vx = (bf16_t*)(p.ws + OFF_VX);
    for_tiles(16, 16, [&](int mi, int ni) {
      const bool isv = ni >= 8;
      PlainLoad bl{isv ? (wc + 2 * SZ_SQ) : (wc + SZ_SQ), 1024};
      gemm_tile(mi * 128, (ni & 7) * 128, 16, al, bl, [&](f32x4 (&acc)[4][4], int rb, int cb) {
        if (!isv) { epi_bf16(kx, 1024, acc, rb, cb); return; }
        const int lane = TID() & 63, l15 = lane & 15, quad = lane >> 4;
#pragma unroll
        for (int mt = 0; mt < 4; ++mt)
#pragma unroll
          for (int nt = 0; nt < 4; ++nt) {
            const int row = rb + mt * 16 + l15, col = cb + nt * 16 + quad * 4;
            const int b = row >> 8, key = row & 255, h = col >> 8, d = col & 255;
            bf16_t* dst = vx + ((size_t)((b * 4 + h) * 256 + d)) * 256 + kperm(key);
#pragma unroll
            for (int r = 0; r < 4; ++r) dst[r * 256] = f2bf(acc[mt][nt][r]);
          }
      }, smem);
    });
  }
}


DI void phase_xattn(const Params& p, bf16_t* smem) {
  const int tid = TID(), wave = tid >> 6, lane = tid & 63, l15 = lane & 15, quad = lane >> 4;
  const bf16_t* q = (const bf16_t*)(p.ws + OFF_XQ); const bf16_t* kx = (const bf16_t*)(p.ws + OFF_KX); const bf16_t* vxT = (const bf16_t*)(p.ws + OFF_VX);
  bf16_t* xo = (bf16_t*)(p.ws + OFF_XO);
  uint4 rg0, rg1, rg2, rg3, rg4, rg5, rg6, rg7;
#define XA_KLOAD(c_) do { const bf16_t* s_ = kx + (size_t)(b * 256 + (c_) * 64 + (tid >> 5)) * 1024 + h * 256 + (tid & 31) * 8; \
    rg0 = *(const uint4*)(s_); rg1 = *(const uint4*)(s_ + 8 * 1024); rg2 = *(const uint4*)(s_ + 16 * 1024); rg3 = *(const uint4*)(s_ + 24 * 1024); \
    rg4 = *(const uint4*)(s_ + 32 * 1024); rg5 = *(const uint4*)(s_ + 40 * 1024); rg6 = *(const uint4*)(s_ + 48 * 1024); rg7 = *(const uint4*)(s_ + 56 * 1024); } while (0)
#define XA_KSTORE(buf_) do { bf16_t* d_ = (buf_) + (tid >> 5) * 264 + (tid & 31) * 8; \
    *(uint4*)(d_) = rg0; *(uint4*)(d_ + 8 * 264) = rg1; *(uint4*)(d_ + 16 * 264) = rg2; *(uint4*)(d_ + 24 * 264) = rg3; \
    *(uint4*)(d_ + 32 * 264) = rg4; *(uint4*)(d_ + 40 * 264) = rg5; *(uint4*)(d_ + 48 * 264) = rg6; *(uint4*)(d_ + 56 * 264) = rg7; } while (0)
#define XA_VLOAD(c_) do { const bf16_t* s_ = vxT + ((size_t)((b * 4 + h) * 256 + (tid >> 3))) * 256 + (c_) * 64 + (tid & 7) * 8; \
    rg0 = *(const uint4*)(s_); rg1 = *(const uint4*)(s_ + 32 * 256); rg2 = *(const uint4*)(s_ + 64 * 256); rg3 = *(const uint4*)(s_ + 96 * 256); \
    rg4 = *(const uint4*)(s_ + 128 * 256); rg5 = *(const uint4*)(s_ + 160 * 256); rg6 = *(const uint4*)(s_ + 192 * 256); rg7 = *(const uint4*)(s_ + 224 * 256); } while (0)
#define XA_VSTORE(buf_) do { bf16_t* d_ = (buf_) + (tid >> 3) * 72 + (tid & 7) * 8; \
    *(uint4*)(d_) = rg0; *(uint4*)(d_ + 32 * 72) = rg1; *(uint4*)(d_ + 64 * 72) = rg2; *(uint4*)(d_ + 96 * 72) = rg3; \
    *(uint4*)(d_ + 128 * 72) = rg4; *(uint4*)(d_ + 160 * 72) = rg5; *(uint4*)(d_ + 192 * 72) = rg6; *(uint4*)(d_ + 224 * 72) = rg7; } while (0)
  for (int item = BID(); item < 2048; item += GDIM()) {
    const int b = item >> 8, h = (item >> 6) & 3, qb = item & 63;
    const size_t tq = (size_t)b * 4096 + qb * 64 + wave * 16 + l15;
    XA_KLOAD(0);
    bf16x8 qf[8];
#pragma unroll
    for (int ks = 0; ks < 8; ++ks) qf[ks] = *(const bf16x8*)(q + tq * 1024 + h * 256 + ks * 32 + quad * 8);
    XA_KSTORE(smem);
    __syncthreads();
    f32x4 s[16];
#pragma unroll
    for (int c = 0; c < 4; ++c) {
      const bf16_t* cur = smem + (c & 1) * 18432; bf16_t* nxt = smem + ((c + 1) & 1) * 18432;
      if (c < 3) XA_KLOAD(c + 1); else XA_VLOAD(0);
#pragma unroll
      for (int m4 = 0; m4 < 4; ++m4) {
        f32x4 a = {0.f, 0.f, 0.f, 0.f};
#pragma unroll
        for (int ks = 0; ks < 8; ++ks) a = MFMA16(*(const bf16x8*)(cur + (m4 * 16 + l15) * 264 + ks * 32 + quad * 8), qf[ks], a);
        s[c * 4 + m4] = a;
      }
      if (c < 3) XA_KSTORE(nxt); else XA_VSTORE(nxt);
      __syncthreads();
    }
    float m = -1e30f;
#pragma unroll
    for (int mt = 0; mt < 16; ++mt)
#pragma unroll
      for (int r = 0; r < 4; ++r) m = fmaxf(m, s[mt][r]);
    m = fmaxf(m, __shfl_xor(m, 16)); m = fmaxf(m, __shfl_xor(m, 32));
    const float c1 = 0.0625f * 1.4426950408889634f;
    float l = 0.f;
#pragma unroll
    for (int mt = 0; mt < 16; ++mt)
#pragma unroll
      for (int r = 0; r < 4; ++r) { float pv = exp2f((s[mt][r] - m) * c1); s[mt][r] = pv; l += pv; }
    l += __shfl_xor(l, 16); l += __shfl_xor(l, 32);
    f32x4 o[16];
#pragma unroll
    for (int dt = 0; dt < 16; ++dt) o[dt] = f32x4{0.f, 0.f, 0.f, 0.f};
#pragma unroll
    for (int c = 0; c < 4; ++c) {
      const bf16_t* cur = smem + (c & 1) * 18432; bf16_t* nxt = smem + ((c + 1) & 1) * 18432;
      if (c < 3) XA_VLOAD(c + 1);
#pragma unroll
      for (int s2 = 0; s2 < 2; ++s2) {
        const bf16x8 pf = pack8(s[4 * c + 2 * s2], s[4 * c + 2 * s2 + 1]);
#pragma unroll
        for (int dt = 0; dt < 16; ++dt) o[dt] = MFMA16(*(const bf16x8*)(cur + (dt * 16 + l15) * 72 + s2 * 32 + quad * 8), pf, o[dt]);
      }
      if (c < 3) XA_VSTORE(nxt);
      __syncthreads();
    }
    const float il = 1.f / l;
#pragma unroll
    for (int dt = 0; dt < 16; ++dt) {
      u32x2 v; v[0] = pack2(o[dt][0] * il, o[dt][1] * il); v[1] = pack2(o[dt][2] * il, o[dt][3] * il);
      *(u32x2*)(xo + tq * 1024 + h * 256 + dt * 16 + quad * 4) = v;
    }
  }
}

template <int R, int NT>
DI void dil_branch(const bf16_t* swk, const bf16_t* swv, size_t rowbase, int h, int tok0, const bf16x8 (&qf)[2], float& m, float& l, f32x4 (&o)[4],
                   int l15, int quad) {
  constexpr int U = 16 / R, W = 128 * R;
  f32x4 s[NT];
#pragma unroll
  for (int kt = 0; kt < NT; ++kt) {
    int kap = tok0 - W + R * (kt * 16 + l15);
    kap = min(max(kap, 0), 4095);
    const bf16_t* kp = swk + (rowbase + kap) * 512 + h * 64 + quad * 8;
    f32x4 a = {0.f, 0.f, 0.f, 0.f};
    a = MFMA16(*(const bf16x8*)kp, qf[0], a);
    a = MFMA16(*(const bf16x8*)(kp + 32), qf[1], a);
    s[kt] = a;
    if ((kt & 3) == 3) __builtin_amdgcn_sched_barrier(0);
  }
  float mx = m;
  const float c1 = 0.125f * 1.4426950408889634f;
#pragma unroll
  for (int kt = 0; kt < NT; ++kt)
#pragma unroll
    for (int r2 = 0; r2 < 4; ++r2) {
      const int c = kt * 16 + quad * 4 + r2;
      const int dist = U * l15 + 128 - c;
      const int kap = tok0 - W + R * c;
      const bool ok = (dist >= 0) && (dist <= 128) && (kap >= 0);
      const float v = ok ? s[kt][r2] * c1 : -1e30f;
      s[kt][r2] = v; mx = fmaxf(mx, v);
    }
  mx = fmaxf(mx, __shfl_xor(mx, 16)); mx = fmaxf(mx, __shfl_xor(mx, 32));
  const float corr = exp2f(m - mx);
  m = mx; l *= corr;
#pragma unroll
  for (int dt = 0; dt < 4; ++dt) { o[dt][0] *= corr; o[dt][1] *= corr; o[dt][2] *= corr; o[dt][3] *= corr; }
#pragma unroll
  for (int kt = 0; kt < NT; ++kt)
#pragma unroll
    for (int r2 = 0; r2 < 4; ++r2) { float pv = exp2f(s[kt][r2] - mx); s[kt][r2] = pv; l += pv; }
  constexpr int NS = (NT + 1) / 2;
#pragma unroll
  for (int s2 = 0; s2 < NS; ++s2) {
    const f32x4 z4 = {0.f, 0.f, 0.f, 0.f};
    const bf16x8 pf = pack8(s[2 * s2], (2 * s2 + 1 < NT) ? s[(2 * s2 + 1 < NT) ? 2 * s2 + 1 : 0] : z4);
    u32x2 vv[8];
#pragma unroll
    for (int j = 0; j < 8; ++j) {
      const int c = (2 * s2 + (j >> 2)) * 16 + quad * 4 + (j & 3);
      int kap = tok0 - W + R * c;
      kap = min(max(kap, 0), 4095);
      vv[j] = *(const u32x2*)(swv + (rowbase + kap) * 512 + h * 64 + 4 * l15);
    }
#pragma unroll
    for (int t4 = 0; t4 < 4; ++t4) {
      u32x4 t;
#pragma unroll
      for (int m = 0; m < 4; ++m) {
        const unsigned a = vv[2 * m][t4 >> 1], b2 = vv[2 * m + 1][t4 >> 1];
        t[m] = (t4 & 1) ? ((a >> 16) | (b2 & 0xffff0000u)) : ((a & 0xffffu) | (b2 << 16));
      }
      o[t4] = MFMA16(__builtin_bit_cast(bf16x8, t), pf, o[t4]);
    }
    __builtin_amdgcn_sched_barrier(0);
  }
}

DI void phase_dil_attn(const Params& p, int first, int nblk) {
  const int wave = TID() >> 6, lane = TID() & 63, l15 = lane & 15, quad = lane >> 4;
  bf16_t* swq = (bf16_t*)(p.ws + OFF_SWQ); const bf16_t* swk = (const bf16_t*)(p.ws + OFF_SWK); const bf16_t* swv = (const bf16_t*)(p.ws + OFF_SWV);
  for (int item = first; item < 4096; item += nblk) {
    const int b = item >> 9, h = (item >> 6) & 7, rho = (item >> 2) & 15, gq = item & 3;
    const int tok0 = (gq * 4 + wave) * 256 + rho;
    const size_t rowbase = (size_t)b * 4096;
    const size_t tq = rowbase + tok0 + 16 * l15;
    bf16x8 qf[2];
    qf[0] = *(const bf16x8*)(swq + tq * 512 + h * 64 + quad * 8);
    qf[1] = *(const bf16x8*)(swq + tq * 512 + h * 64 + 32 + quad * 8);
    float m = -1e30f, l = 0.f;
    f32x4 o[4];
#pragma unroll
    for (int dt = 0; dt < 4; ++dt) o[dt] = f32x4{0.f, 0.f, 0.f, 0.f};
    dil_branch<16, 9>(swk, swv, rowbase, h, tok0, qf, m, l, o, l15, quad);
    dil_branch<4, 12>(swk, swv, rowbase, h, tok0, qf, m, l, o, l15, quad);
    dil_branch<1, 24>(swk, swv, rowbase, h, tok0, qf, m, l, o, l15, quad);
    l += __shfl_xor(l, 16); l += __shfl_xor(l, 32);
    const float il = 1.f / l;
    u32x4 w0, w1;
    w0[0] = pack2(o[0][0] * il, o[1][0] * il); w0[1] = pack2(o[2][0] * il, o[3][0] * il);
    w0[2] = pack2(o[0][1] * il, o[1][1] * il); w0[3] = pack2(o[2][1] * il, o[3][1] * il);
    w1[0] = pack2(o[0][2] * il, o[1][2] * il); w1[1] = pack2(o[2][2] * il, o[3][2] * il);
    w1[2] = pack2(o[0][3] * il, o[1][3] * il); w1[3] = pack2(o[2][3] * il, o[3][3] * il);
    *(u32x4*)(swq + tq * 512 + h * 64 + quad * 16) = w0;
    *(u32x4*)(swq + tq * 512 + h * 64 + quad * 16 + 8) = w1;
  }
}

DI void phase_xo(const Params& p, int l, bf16_t* smem) {
  const bf16_t* wc = (const bf16_t*)(p.ws + OFF_W) + (size_t)l * SZ_COMMON + 3 * SZ_SQ;
  PlainLoad al{(const bf16_t*)(p.ws + OFF_XO), 1024}, bl{wc, 1024};
  {
    gemm_stream(256, 8, 16, al, bl, [&](f32x4 (&acc)[4][4], int rb, int cb) { epi_resid(p, acc, rb, cb); }, smem);
  }
}

DI void phase_ffn_gu(const Params& p, int l, bf16_t* smem) {
  const bf16_t* W = (const bf16_t*)(p.ws + OFF_W) + (size_t)l * SZ_COMMON + 4 * SZ_SQ;
  PlainLoad al{(const bf16_t*)(p.ws + OFF_HB), 1024}, bl{W, 1024};
  bf16_t* act = (bf16_t*)(p.ws + OFF_ACT);
  {
    gemm_stream(256, 44, 16, al, bl, [&](f32x4 (&acc)[4][4], int rb, int cb) {
      const int lane = TID() & 63, l15 = lane & 15, quad = lane >> 4;
#pragma unroll
      for (int mt = 0; mt < 4; ++mt)
#pragma unroll
        for (int np = 0; np < 2; ++np) {
          u32x2 v;
          v[0] = pack2(siluf_(acc[mt][2 * np][0]) * acc[mt][2 * np + 1][0], siluf_(acc[mt][2 * np][1]) * acc[mt][2 * np + 1][1]);
          v[1] = pack2(siluf_(acc[mt][2 * np][2]) * acc[mt][2 * np + 1][2], siluf_(acc[mt][2 * np][3]) * acc[mt][2 * np + 1][3]);
          *(u32x2*)(act + (size_t)(rb + mt * 16 + l15) * 2816 + (cb >> 1) + np * 16 + quad * 4) = v;
        }
    }, smem);
  }
}
DI void phase_ffn_down(const Params& p, int l, bf16_t* smem) {
  const bf16_t* W = (const bf16_t*)(p.ws + OFF_W) + (size_t)l * SZ_COMMON + 4 * SZ_SQ + SZ_GU;
  PlainLoad al{(const bf16_t*)(p.ws + OFF_ACT), 2816}, bl{W, 2816};
  {
    gemm_stream(256, 8, 44, al, bl, [&](f32x4 (&acc)[4][4], int rb, int cb) { epi_resid(p, acc, rb, cb); }, smem);
  }
}


#define XB_TMO      128
#define XB_XCNT(j)  (256  + 64 * (j))
#define XB_XSUB(j)  (1280 + 64 * (j))
#define XB_XGEN(j)  (2304 + 64 * (j))
#define XB_TOP      3328
#define XB_TOPGEN   3392
#define XCD_BAR_WORDS 3456
#define XB_SPIN_CAP (1u << 22)
#define LAS __attribute__((address_space(3)))
DI unsigned xb_ld(unsigned* p) { return __hip_atomic_load(p, __ATOMIC_RELAXED, __HIP_MEMORY_SCOPE_AGENT); }
DI unsigned xb_add(unsigned* p, unsigned v) { return __hip_atomic_fetch_add(p, v, __ATOMIC_RELAXED, __HIP_MEMORY_SCOPE_AGENT); }
DI unsigned xb_xcc_id() { return (unsigned)__builtin_amdgcn_s_getreg((3 << 11) | 20) & 0xFu; }
#define XB_SPIN(cond, bar) do { unsigned _sp = 0; while (cond) { __builtin_amdgcn_s_sleep(1); \
    if ((++_sp & 255u) == 0u) { if (xb_ld(&(bar)[XB_TMO])) break; if (_sp > XB_SPIN_CAP) { atomicAdd(&(bar)[XB_TMO], 1u); break; } } } } while (0)
struct XcdBarrier { unsigned* bar; unsigned x; volatile LAS unsigned* st; };
DI XcdBarrier xcd_barrier_post(unsigned* bar, volatile LAS unsigned* st) {
  XcdBarrier b; b.bar = bar; b.x = xb_xcc_id(); b.st = st;
  if (threadIdx.x == 0) (void)xb_add(&bar[XB_XCNT(b.x)], 1u);
  return b;
}
DI void xcd_barrier_complete(unsigned* bar, unsigned x, unsigned& nloc, unsigned& nx) {
  const unsigned G = gridDim.x * gridDim.y * gridDim.z;
  unsigned sum, cnt, mine, sp = 0u;
  for (;;) {
    sum = 0u; cnt = 0u; mine = 0u;
#pragma unroll
    for (unsigned j = 0; j < 16; ++j) { const unsigned c = xb_ld(&bar[XB_XCNT(j)]); sum += c; cnt += (c > 0u) ? 1u : 0u; mine = (j == x) ? c : mine; }
    if (sum == G) break;
    __builtin_amdgcn_s_sleep(1);
    if ((++sp & 255u) == 0u) { if (xb_ld(&bar[XB_TMO])) break; if (sp > XB_SPIN_CAP) { atomicAdd(&bar[XB_TMO], 1u); break; } }
  }
  nloc = mine > 0u ? mine : 1u; nx = cnt > 0u ? cnt : 1u;
}
DI void xcd_barrier(const XcdBarrier& b) {
  asm volatile("s_waitcnt vmcnt(0)" ::: "memory");
  __syncthreads();
  if (threadIdx.x == 0) {
    unsigned* bar = b.bar;
    __builtin_amdgcn_s_waitcnt(0);
    unsigned nloc = b.st[0], nx = b.st[1];
    if (nloc == 0u) { xcd_barrier_complete(bar, b.x, nloc, nx); b.st[0] = nloc; b.st[1] = nx; }
    const unsigned old = xb_add(&bar[XB_XSUB(b.x)], 1u);
    const unsigned gen = old / nloc;
    if (old + 1u == (gen + 1u) * nloc) {
      __builtin_amdgcn_fence(__ATOMIC_RELEASE, "agent");
      asm volatile("s_waitcnt vmcnt(0)" ::: "memory");
      const unsigned og = xb_add(&bar[XB_TOP], 1u);
      const unsigned tg = og / nx;
      if (og + 1u == (tg + 1u) * nx) xb_add(&bar[XB_TOPGEN], 1u);
      else XB_SPIN(xb_ld(&bar[XB_TOPGEN]) == tg, bar);
      __builtin_amdgcn_fence(__ATOMIC_ACQUIRE, "agent");
      xb_add(&bar[XB_XGEN(b.x)], 1u);
      asm volatile("s_waitcnt vmcnt(0)" ::: "memory");
    } else {
      XB_SPIN(xb_ld(&bar[XB_XGEN(b.x)]) == gen, bar);
      __builtin_amdgcn_fence(__ATOMIC_ACQUIRE, "agent");
      asm volatile("s_waitcnt vmcnt(0)" ::: "memory");
    }
  }
  __syncthreads();
}

__global__ void __launch_bounds__(256, 2) fwd_megakernel(Params p) {
  cg::grid_group grid = cg::this_grid();
  __shared__ __attribute__((aligned(16))) char smem_raw[2 * 2 * 128 * LDT * 2];
  bf16_t* sm16 = (bf16_t*)smem_raw; float* sm32 = (float*)smem_raw;

  __shared__ uint4 xb_words;
  if (threadIdx.x == 0) xb_words = make_uint4(0u, 0u, 0u, 0u);
  __syncthreads();
  XcdBarrier xb = xcd_barrier_post((unsigned*)(p.ws + OFF_BAR), (volatile LAS unsigned*)&xb_words);
  phase_prologue(p, sm32);
  grid.sync();
  for (int l = 0; l < 4; ++l) {
    const int i = l >> 1;
    if ((l & 1) == 0) {
      phase_proj(p, i, sm16); xcd_barrier(xb);
      phase_dn_prep(p, i, smem_raw); xcd_barrier(xb);
      phase_mix(p, i, sm16); xcd_barrier(xb);
      phase_dn_post(p, i); xcd_barrier(xb);
      phase_wout(p, i, sm16); xcd_barrier(xb);
    } else {
#if USE_S5_GEMM
      phase_s5_tables(p, i, sm32); xcd_barrier(xb);
      phase_s5_end(p, sm16); xcd_barrier(xb);
      phase_s5_y(p, i, sm16); xcd_barrier(xb);
#else
      phase_s5_naive(p, i); xcd_barrier(xb);
#endif
      phase_glu(p, i, sm16); xcd_barrier(xb);
    }
    phase_ln(p, p.ln_mix_g + l * 1024, p.ln_mix_b + l * 1024); xcd_barrier(xb);
    phase_xproj(p, l, sm16); xcd_barrier(xb);
    phase_xattn(p, sm16); xcd_barrier(xb);
    phase_xo(p, l, sm16); xcd_barrier(xb);
    phase_ln(p, p.ln_x_g + l * 1024, p.ln_x_b + l * 1024); xcd_barrier(xb);
    phase_ffn_gu(p, l, sm16); xcd_barrier(xb);
    phase_ffn_down(p, l, sm16); xcd_barrier(xb);
    phase_ln(p, p.ln_ffn_g + l * 1024, p.ln_ffn_b + l * 1024); xcd_barrier(xb);
  }
}

extern "C" void kernel_launch(void* const* d_in, const int* in_sizes, int n_in, void* d_out, int out_size, void* d_ws, size_t ws_size,
                              hipStream_t stream) {
  static int grid_blocks = 0;
  if (!grid_blocks) {
    int dev = 0, cus = 0, per_cu = 0;
    hipGetDevice(&dev);
    hipDeviceGetAttribute(&cus, hipDeviceAttributeMultiprocessorCount, dev);
    hipOccupancyMaxActiveBlocksPerMultiprocessor(&per_cu, fwd_megakernel, 256, 0);
    if (per_cu > 2) per_cu = 2;
    if (per_cu < 1) per_cu = 1;
    grid_blocks = cus * per_cu;
    grid_blocks -= grid_blocks % 8;
  }
  Params p{};
  const float** pf = (const float**)&p;
  for (int i = 0; i < 32; ++i) pf[i] = (const float*)d_in[i];
  p.pos = (const int*)d_in[2];
  p.out = (float*)d_out; p.ws = (char*)d_ws;
  hipMemsetAsync((char*)d_ws + OFF_BAR, 0, XCD_BAR_WORDS * sizeof(unsigned), stream);
  void* args[] = {&p};
  hipError_t e = hipLaunchCooperativeKernel((void*)fwd_megakernel, dim3(grid_blocks), dim3(256), args, 0, stream);
  if (e != hipSuccess) fprintf(stderr, "cooperative launch failed: %s (grid %d)\n", hipGetErrorString(e), grid_blocks);
}
```

```cpp
#include <hip/hip_runtime.h>
#include <hip/hip_cooperative_groups.h>
#include <cstdio>
namespace cg = cooperative_groups;
#ifndef USE_XATTN_MFMA
#define USE_XATTN_MFMA 1
#endif
#ifndef USE_S5_GEMM
#define USE_S5_GEMM 1
#endif
#ifndef USE_DIL_MFMA
#define USE_DIL_MFMA 1
#endif

typedef unsigned short bf16_t;
using bf16x8 = __attribute__((ext_vector_type(8))) short;
using f32x4 = __attribute__((ext_vector_type(4))) float;
#define DI __device__ __forceinline__

constexpr int T_ = 32768, S_ = 4096;
constexpr size_t MiB = (size_t)1 << 20;
constexpr size_t SZ_SQ = (size_t)1024 * 1024, SZ_WIN = (size_t)3712 * 1024, SZ_GLU = (size_t)2048 * 1024,
                 SZ_GU = (size_t)5632 * 1024, SZ_WD = (size_t)1024 * 2816;
constexpr size_t SZ_COMMON = 4 * SZ_SQ + SZ_GU + SZ_WD;
constexpr size_t W_EVEN0 = 4 * SZ_COMMON;
constexpr size_t W_ODD0 = W_EVEN0 + 2 * (SZ_WIN + SZ_SQ);
constexpr float ALPHA = 1.681792830507429f;

constexpr size_t OFF_W = 0;
constexpr size_t OFF_ROPE = 125 * MiB;
constexpr size_t OFF_HB = 133 * MiB;
constexpr size_t OFF_KX = 197 * MiB;
constexpr size_t OFF_VX = 201 * MiB;
constexpr size_t OFF_BIG = 205 * MiB;
constexpr size_t OFF_BAR = 511 * MiB;
constexpr size_t OFF_DNQKV = OFF_BIG;
constexpr size_t OFF_Z = OFF_BIG + 96 * MiB;
constexpr size_t OFF_SWQ = OFF_BIG + 128 * MiB;
constexpr size_t OFF_SWK = OFF_BIG + 160 * MiB;
constexpr size_t OFF_SWV = OFF_BIG + 192 * MiB;
constexpr size_t OFF_LOGIT = OFF_BIG + 224 * MiB;
constexpr size_t OFF_QD = OFF_BIG + 225 * MiB;
constexpr size_t OFF_KD = OFF_BIG + 257 * MiB;
constexpr size_t OFF_INTRA = OFF_BIG + 289 * MiB;
constexpr size_t OFF_WB = OFF_HB;
constexpr size_t OFF_UB = OFF_HB + 32 * MiB;
constexpr size_t OFF_EG = OFF_KX;
constexpr size_t OFF_XQ = OFF_BIG;
constexpr size_t OFF_XO = OFF_BIG + 64 * MiB;
constexpr size_t OFF_ACT = OFF_BIG;
constexpr size_t OFF_HID = OFF_BIG;
constexpr size_t OFF_SIN = OFF_BIG + 64 * MiB;
constexpr size_t OFF_KTAB = OFF_BIG + 80 * MiB;
constexpr size_t OFF_ETAB = OFF_BIG + 82 * MiB;
constexpr size_t OFF_GTAB = OFF_BIG + 90 * MiB;
constexpr size_t OFF_AL = OFF_BIG + 98 * MiB;

struct Params {
  const float* x; const float* mem; const int* pos;
  const float* hyb_w_in; const float* dn_conv_w; const float* dn_a_log; const float* dn_dt_bias; const float* dn_norm_g; const float* hyb_w_out;
  const float* s5_a_re; const float* s5_a_im; const float* s5_log_dt; const float* s5_b_re; const float* s5_b_im; const float* s5_c_re; const float* s5_c_im;
  const float* s5_d; const float* s5_glu_wo; const float* s5_glu_wg;
  const float* ln_mix_g; const float* ln_mix_b;
  const float* xq_w; const float* xk_w; const float* xv_w; const float* xo_w; const float* ln_x_g; const float* ln_x_b;
  const float* ffn_wg; const float* ffn_wu; const float* ffn_wd; const float* ln_ffn_g; const float* ln_ffn_b;
  float* out; char* ws;
};

DI int TID() { int t = threadIdx.x; asm volatile("" : "+v"(t)); return t; }
DI int BID() { int t = blockIdx.x; asm volatile("" : "+s"(t)); return t; }
DI int GDIM() { int t = gridDim.x; asm volatile("" : "+s"(t)); return t; }
typedef float f32x2_t __attribute__((ext_vector_type(2)));
typedef __bf16 bf16x2_t __attribute__((ext_vector_type(2)));
DI bf16_t f2bf(float x) { return __builtin_bit_cast(bf16_t, (__bf16)x); }
DI float bf2f(bf16_t v) { return __uint_as_float(((unsigned)v) << 16); }
DI unsigned pack2(float a, float b) { f32x2_t v = {a, b}; return __builtin_bit_cast(unsigned, __builtin_convertvector(v, bf16x2_t)); }
using u32x4 = __attribute__((ext_vector_type(4))) unsigned;
using u32x2 = __attribute__((ext_vector_type(2))) unsigned;
DI bf16x8 pack8(f32x4 a, f32x4 b) {
  u32x4 t; t[0] = pack2(a[0], a[1]); t[1] = pack2(a[2], a[3]); t[2] = pack2(b[0], b[1]); t[3] = pack2(b[2], b[3]);
  return __builtin_bit_cast(bf16x8, t);
}
#define MFMA16(a, b, c) __builtin_amdgcn_mfma_f32_16x16x32_bf16((a), (b), (c), 0, 0, 0)
DI int kperm(int x) { return (x & ~31) | (((x >> 2) & 3) * 8 + ((x >> 4) & 1) * 4 + (x & 3)); }
DI float wave_sum(float v) { for (int o = 32; o > 0; o >>= 1) v += __shfl_xor(v, o); return v; }
DI float wave_max(float v) { for (int o = 32; o > 0; o >>= 1) v = fmaxf(v, __shfl_xor(v, o)); return v; }
DI float sigmoidf_(float x) { return __builtin_amdgcn_rcpf(1.f + __expf(-x)); }
DI float siluf_(float x) { return x * sigmoidf_(x); }
DI float softplusf_(float x) { return fmaxf(x, 0.f) + log1pf(__expf(-fabsf(x))); }
DI float gelu_tanh(float x) { float u = 0.7978845608028654f * (x + 0.044715f * x * x * x); return 0.5f * x * (1.f + tanhf(u)); }

template <class CM>
DI void transpose_job(bf16_t* dst, int Ndst, int K, int srcStride, CM colptr, float* tile) {
  const int ntk = K / 64, ntiles = (Ndst / 64) * ntk;
  const int tid = TID();
  for (int tl = BID(); tl < ntiles; tl += GDIM()) {
    const int r0 = (tl / ntk) * 64, k0 = (tl % ntk) * 64;
    const int q4 = tid & 15, kl0 = tid >> 4;
    const float* cp = colptr(r0 + 4 * q4);
    float4 v[4];
#pragma unroll
    for (int i = 0; i < 4; ++i) v[i] = cp ? *(const float4*)(cp + (size_t)(k0 + kl0 + 16 * i) * srcStride) : make_float4(0.f, 0.f, 0.f, 0.f);
#pragma unroll
    for (int i = 0; i < 4; ++i) {
      float* t = tile + (kl0 + 16 * i) * 65 + 4 * q4;
      t[0] = v[i].x; t[1] = v[i].y; t[2] = v[i].z; t[3] = v[i].w;
    }
    __syncthreads();
#pragma unroll
    for (int i = 0; i < 2; ++i) {
      const int c = tid + 256 * i, rr = c >> 3, kc = (c & 7) * 8;
      const float* t = tile + kc * 65 + rr;
      uint4 o;
      o.x = pack2(t[0], t[65]); o.y = pack2(t[2 * 65], t[3 * 65]); o.z = pack2(t[4 * 65], t[5 * 65]); o.w = pack2(t[6 * 65], t[7 * 65]);
      *(uint4*)(dst + (size_t)(r0 + rr) * K + k0 + kc) = o;
    }
    __syncthreads();
  }
}

DI void phase_prologue(const Params& p, float* smem) {
  bf16_t* W = (bf16_t*)(p.ws + OFF_W);
  for (int l = 0; l < 4; ++l) {
    bf16_t* wc = W + (size_t)l * SZ_COMMON;
    const float* s;
    s = p.xq_w + (size_t)l * SZ_SQ; transpose_job(wc, 1024, 1024, 1024, [=](int r) { return s + r; }, smem);
    s = p.xk_w + (size_t)l * SZ_SQ; transpose_job(wc + SZ_SQ, 1024, 1024, 1024, [=](int r) { return s + r; }, smem);
    s = p.xv_w + (size_t)l * SZ_SQ; transpose_job(wc + 2 * SZ_SQ, 1024, 1024, 1024, [=](int r) { return s + r; }, smem);
    s = p.xo_w + (size_t)l * SZ_SQ; transpose_job(wc + 3 * SZ_SQ, 1024, 1024, 1024, [=](int r) { return s + r; }, smem);
    {
      const float* g = p.ffn_wg + (size_t)l * 1024 * 2816; const float* u = p.ffn_wu + (size_t)l * 1024 * 2816;
      transpose_job(wc + 4 * SZ_SQ, 5632, 1024, 2816, [=](int r) { int c = (r >> 5) * 16 + (r & 15); return ((r >> 4) & 1) ? (u + c) : (g + c); }, smem);
    }
    s = p.ffn_wd + (size_t)l * 2816 * 1024; transpose_job(wc + 4 * SZ_SQ + SZ_GU, 1024, 2816, 1024, [=](int r) { return s + r; }, smem);
  }
  for (int i = 0; i < 2; ++i) {
    bf16_t* we = W + W_EVEN0 + (size_t)i * (SZ_WIN + SZ_SQ);
    const float* s = p.hyb_w_in + (size_t)i * 1024 * 3592;
    transpose_job(we, 3712, 1024, 3592, [=](int r) -> const float* {
      if (r < 2048) return s + r;
      if (r < 3584) return s + r + 8;
      if (r < 3592) return s + 2048 + (r - 3584);
      return nullptr; }, smem);
    const float* s2 = p.hyb_w_out + (size_t)i * SZ_SQ;
    transpose_job(we + SZ_WIN, 1024, 1024, 1024, [=](int r) { return s2 + r; }, smem);
    bf16_t* wo = W + W_ODD0 + (size_t)i * SZ_GLU;
    const float* a = p.s5_glu_wo + (size_t)i * SZ_SQ; const float* b = p.s5_glu_wg + (size_t)i * SZ_SQ;
    transpose_job(wo, 2048, 1024, 1024, [=](int r) { int c = (r >> 5) * 16 + (r & 15); return ((r >> 4) & 1) ? (b + c) : (a + c); }, smem);
  }
  const size_t gtid = (size_t)BID() * 256 + TID(), gsz = (size_t)GDIM() * 256;
  bf16_t* hb = (bf16_t*)(p.ws + OFF_HB);
  for (size_t i = gtid; i < (size_t)T_ * 256; i += gsz) {
    float4 v = ((const float4*)p.x)[i];
    ((float4*)p.out)[i] = v;
    uint2 o; o.x = pack2(v.x, v.y); o.y = pack2(v.z, v.w);
    ((uint2*)hb)[i] = o;
  }
  float* rc = (float*)(p.ws + OFF_ROPE); float* rs = rc + (size_t)T_ * 32;
  for (size_t i = gtid; i < (size_t)T_ * 32; i += gsz) {
    int t = (int)(i >> 5), j = (int)(i & 31);
    float invf = (float)exp(-(double)(2 * j) / 64.0 * 9.210340371976184);
    float ang = (float)p.pos[t] * invf;
    double a = (double)ang;
    double k = rint(a * 0.15915494309189535);
    float r = (float)(a - k * 6.283185307179586);
    rc[i] = cosf(r); rs[i] = sinf(r);
  }
}

constexpr int LDT = 72;
template <class AL, class BL, class EP>
DI void gemm_tile(int m0, int n0, int nks, AL aload, BL bload, EP epi, bf16_t* smem) {
  bf16_t* As = smem; bf16_t* Bs = smem + 2 * 128 * LDT;
  const int tid = TID(), lane = tid & 63, wave = tid >> 6;
  const int wm = wave >> 1, wn = wave & 1, l15 = lane & 15, quad = lane >> 4;
  const int lrow = tid >> 3, lkc = (tid & 7) * 8;
  f32x4 acc[4][4];
#pragma unroll
  for (int i = 0; i < 4; ++i)
#pragma unroll
    for (int j = 0; j < 4; ++j) acc[i][j] = f32x4{0.f, 0.f, 0.f, 0.f};
  uint4 ra0[4], rb0[4], ra1[4], rb1[4];
#pragma unroll
  for (int i = 0; i < 4; ++i) { ra0[i] = aload(m0 + lrow + 32 * i, 0, lkc); rb0[i] = bload(n0 + lrow + 32 * i, 0, lkc); }
#pragma unroll
  for (int i = 0; i < 4; ++i) { ra1[i] = aload(m0 + lrow + 32 * i, 1, lkc); rb1[i] = bload(n0 + lrow + 32 * i, 1, lkc); }
#pragma unroll
  for (int i = 0; i < 4; ++i) {
    *(uint4*)(As + (lrow + 32 * i) * LDT + lkc) = ra0[i];
    *(uint4*)(Bs + (lrow + 32 * i) * LDT + lkc) = rb0[i];
  }
  __syncthreads();
  auto compute = [&](int cur) {
    const bf16_t* Ab = As + cur * 128 * LDT; const bf16_t* Bb = Bs + cur * 128 * LDT;
#pragma unroll
    for (int kk = 0; kk < 2; ++kk) {
      bf16x8 a[4], b[4];
#pragma unroll
      for (int mt = 0; mt < 4; ++mt) a[mt] = *(const bf16x8*)(Ab + (wm * 64 + mt * 16 + l15) * LDT + kk * 32 + quad * 8);
#pragma unroll
      for (int nt = 0; nt < 4; ++nt) b[nt] = *(const bf16x8*)(Bb + (wn * 64 + nt * 16 + l15) * LDT + kk * 32 + quad * 8);
#pragma unroll
      for (int mt = 0; mt < 4; ++mt)
#pragma unroll
        for (int nt = 0; nt < 4; ++nt) acc[mt][nt] = __builtin_amdgcn_mfma_f32_16x16x32_bf16(b[nt], a[mt], acc[mt][nt], 0, 0, 0);
    }
  };
  for (int ks = 0; ks < nks; ks += 2) {
    {
      const int kq = (ks + 2 < nks) ? ks + 2 : 0;
#pragma unroll
      for (int i = 0; i < 4; ++i) { ra0[i] = aload(m0 + lrow + 32 * i, kq, lkc); rb0[i] = bload(n0 + lrow + 32 * i, kq, lkc); }
    }
    compute(0);
#pragma unroll
    for (int i = 0; i < 4; ++i) {
      *(uint4*)(As + 128 * LDT + (lrow + 32 * i) * LDT + lkc) = ra1[i];
      *(uint4*)(Bs + 128 * LDT + (lrow + 32 * i) * LDT + lkc) = rb1[i];
    }
    __syncthreads();
    {
      const int kq = (ks + 3 < nks) ? ks + 3 : 1;
#pragma unroll
      for (int i = 0; i < 4; ++i) { ra1[i] = aload(m0 + lrow + 32 * i, kq, lkc); rb1[i] = bload(n0 + lrow + 32 * i, kq, lkc); }
    }
    compute(1);
#pragma unroll
    for (int i = 0; i < 4; ++i) {
      *(uint4*)(As + (lrow + 32 * i) * LDT + lkc) = ra0[i];
      *(uint4*)(Bs + (lrow + 32 * i) * LDT + lkc) = rb0[i];
    }
    __syncthreads();
  }
  epi(acc, m0 + wm * 64, n0 + wn * 64);
}

DI void tile_of(int w, int mtiles, int ntiles, int xcd, int& m0, int& n0) {
  const int mper = mtiles >> 3, full = mper * 8;
  int gidx = w / full;
  const int ngroups = (ntiles + 7) >> 3;
  if (gidx > ngroups - 1) gidx = ngroups - 1;
  const int rest = w - gidx * full;
  const int wg = min(8, ntiles - 8 * gidx);
  const int ml = rest / wg, ni = 8 * gidx + (rest - ml * wg);
  m0 = (ml * 8 + xcd) * 128; n0 = ni * 128;
}
template <class AL, class BL, class EP>
DI void gemm_stream(int mtiles, int ntiles, int nks, AL aload, BL bload, EP epi, bf16_t* smem) {
  const int xcd = BID() & 7, slot = BID() >> 3, nslot = GDIM() >> 3;
  const int per = (mtiles >> 3) * ntiles;
  if (slot >= per) return;
  bf16_t* As = smem; bf16_t* Bs = smem + 2 * 128 * LDT;
  const int tid = TID(), lane = tid & 63, wave = tid >> 6;
  const int wm = wave >> 1, wc = wave & 1, l15 = lane & 15, quad = lane >> 4;
  const int lrow = tid >> 3, lkc = (tid & 7) * 8;
  f32x4 acc[4][4];
  uint4 ra0[4], rb0[4], ra1[4], rb1[4];
  int w = slot;
  int m0, n0;
  tile_of(w, mtiles, ntiles, xcd, m0, n0);
#pragma unroll
  for (int i = 0; i < 4; ++i) { ra0[i] = aload(m0 + lrow + 32 * i, 0, lkc); rb0[i] = bload(n0 + lrow + 32 * i, 0, lkc); }
#pragma unroll
  for (int i = 0; i < 4; ++i) { ra1[i] = aload(m0 + lrow + 32 * i, 1, lkc); rb1[i] = bload(n0 + lrow + 32 * i, 1, lkc); }
#pragma unroll
  for (int i = 0; i < 4; ++i) {
    *(uint4*)(As + (lrow + 32 * i) * LDT + lkc) = ra0[i];
    *(uint4*)(Bs + (lrow + 32 * i) * LDT + lkc) = rb0[i];
  }
  __syncthreads();
  auto compute = [&](int cur) {
    const bf16_t* Ab = As + cur * 128 * LDT; const bf16_t* Bb = Bs + cur * 128 * LDT;
#pragma unroll
    for (int kk = 0; kk < 2; ++kk) {
      bf16x8 a[4], b[4];
#pragma unroll
      for (int mt = 0; mt < 4; ++mt) a[mt] = *(const bf16x8*)(Ab + (wm * 64 + mt * 16 + l15) * LDT + kk * 32 + quad * 8);
#pragma unroll
      for (int nt = 0; nt < 4; ++nt) b[nt] = *(const bf16x8*)(Bb + (wc * 64 + nt * 16 + l15) * LDT + kk * 32 + quad * 8);
      __builtin_amdgcn_s_setprio(2);
#pragma unroll
      for (int mt = 0; mt < 4; ++mt)
#pragma unroll
        for (int nt = 0; nt < 4; ++nt) acc[mt][nt] = __builtin_amdgcn_mfma_f32_16x16x32_bf16(b[nt], a[mt], acc[mt][nt], 0, 0, 0);
      __builtin_amdgcn_s_setprio(0);
    }
  };
  for (;;) {
    const int wnext = w + nslot;
    const bool has_next = wnext < per;
    int m1 = m0, n1 = n0;
    if (has_next) tile_of(wnext, mtiles, ntiles, xcd, m1, n1);
#pragma unroll
    for (int i = 0; i < 4; ++i)
#pragma unroll
      for (int j = 0; j < 4; ++j) acc[i][j] = f32x4{0.f, 0.f, 0.f, 0.f};
    for (int ks = 0; ks < nks; ks += 2) {
      const bool in2 = ks + 2 < nks;
      {
        const int mm = in2 ? m0 : m1, nn = in2 ? n0 : n1, kq = in2 ? ks + 2 : 0;
#pragma unroll
        for (int i = 0; i < 4; ++i) { ra0[i] = aload(mm + lrow + 32 * i, kq, lkc); rb0[i] = bload(nn + lrow + 32 * i, kq, lkc); }
      }
      compute(0);
#pragma unroll
      for (int i = 0; i < 4; ++i) {
        *(uint4*)(As + 128 * LDT + (lrow + 32 * i) * LDT + lkc) = ra1[i];
        *(uint4*)(Bs + 128 * LDT + (lrow + 32 * i) * LDT + lkc) = rb1[i];
      }
      __syncthreads();
      {
        const int mm = in2 ? m0 : m1, nn = in2 ? n0 : n1, kq = in2 ? ks + 3 : 1;
#pragma unroll
        for (int i = 0; i < 4; ++i) { ra1[i] = aload(mm + lrow + 32 * i, kq, lkc); rb1[i] = bload(nn + lrow + 32 * i, kq, lkc); }
      }
      compute(1);
#pragma unroll
      for (int i = 0; i < 4; ++i) {
        *(uint4*)(As + (lrow + 32 * i) * LDT + lkc) = ra0[i];
        *(uint4*)(Bs + (lrow + 32 * i) * LDT + lkc) = rb0[i];
      }
      __syncthreads();
    }
    epi(acc, m0 + wm * 64, n0 + wc * 64);
    if (!has_next) break;
    w = wnext; m0 = m1; n0 = n1;
  }
}

template <class F>
DI void for_tiles(int mtiles, int ntiles, F f) {
  const int xcd = BID() & 7, slot = BID() >> 3, nslot = GDIM() >> 3;
  const int per = (mtiles >> 3) * ntiles;
  for (int w = slot; w < per; w += nslot) {
    int mi = w / ntiles, ni = w - mi * ntiles;
    f((mi * 8 + xcd), ni);
  }
}

#define EPI_LOOP for (int mt = 0; mt < 4; ++mt) for (int nt = 0; nt < 4; ++nt) for (int r = 0; r < 4; ++r)

DI void epi_resid(const Params& p, f32x4 (&acc)[4][4], int rb, int cb) {
  const int lane = TID() & 63, l15 = lane & 15, quad = lane >> 4;
#pragma unroll
  for (int mt = 0; mt < 4; ++mt)
#pragma unroll
    for (int nt = 0; nt < 4; ++nt) {
      float4* ptr = (float4*)(p.out + (size_t)(rb + mt * 16 + l15) * 1024 + cb + nt * 16 + quad * 4);
      float4 h = *ptr;
      h.x = ALPHA * h.x + acc[mt][nt][0]; h.y = ALPHA * h.y + acc[mt][nt][1]; h.z = ALPHA * h.z + acc[mt][nt][2]; h.w = ALPHA * h.w + acc[mt][nt][3];
      *ptr = h;
    }
}
DI void epi_bf16(bf16_t* dst, int ld, f32x4 (&acc)[4][4], int rb, int cb) {
  const int lane = TID() & 63, l15 = lane & 15, quad = lane >> 4;
#pragma unroll
  for (int mt = 0; mt < 4; ++mt)
#pragma unroll
    for (int nt = 0; nt < 4; ++nt) {
      u32x2 v; v[0] = pack2(acc[mt][nt][0], acc[mt][nt][1]); v[1] = pack2(acc[mt][nt][2], acc[mt][nt][3]);
      *(u32x2*)(dst + (size_t)(rb + mt * 16 + l15) * ld + cb + nt * 16 + quad * 4) = v;
    }
}

struct PlainLoad {
  const bf16_t* base; int ld;
  DI uint4 operator()(int row, int ks, int kc) const { return *(const uint4*)((const char*)base + (unsigned)((row * ld + ks * 64 + kc) * 2)); }
};

DI void phase_proj(const Params& p, int i, bf16_t* smem) {
  const bf16_t* W = (const bf16_t*)(p.ws + OFF_W) + W_EVEN0 + (size_t)i * (SZ_WIN + SZ_SQ);
  PlainLoad al{(const bf16_t*)(p.ws + OFF_HB), 1024}, bl{W, 1024};
  bf16_t* dnqkv = (bf16_t*)(p.ws + OFF_DNQKV); bf16_t* z = (bf16_t*)(p.ws + OFF_Z);
  bf16_t* swq = (bf16_t*)(p.ws + OFF_SWQ); bf16_t* swk = (bf16_t*)(p.ws + OFF_SWK); bf16_t* swv = (bf16_t*)(p.ws + OFF_SWV);
  float* logit = (float*)(p.ws + OFF_LOGIT);
  const float* rc = (const float*)(p.ws + OFF_ROPE); const float* rs = rc + (size_t)T_ * 32;
  {
    gemm_stream(256, 29, 16, al, bl, [&](f32x4 (&acc)[4][4], int rb, int cb) {
      const int lane = TID() & 63, l15 = lane & 15, quad = lane >> 4;
      if (cb < 1536) epi_bf16(dnqkv, 1536, acc, rb, cb);
      else if (cb < 2048) epi_bf16(z, 512, acc, rb, cb - 1536);
      else if (cb < 3072) {
        bf16_t* dst = (cb < 2560) ? swq : swk; const int c0 = (cb < 2560) ? cb - 2048 : cb - 2560;
#pragma unroll
        for (int mt = 0; mt < 4; ++mt) {
          const int row = rb + mt * 16 + l15;
#pragma unroll
          for (int nt = 0; nt < 2; ++nt) {
            const int d = nt * 16 + quad * 4;
            const float4 c = *(const float4*)(rc + (size_t)row * 32 + d), sn = *(const float4*)(rs + (size_t)row * 32 + d);
            const f32x4 x1 = acc[mt][nt], x2 = acc[mt][nt + 2];
            u32x2 o1, o2;
            o1[0] = pack2(x1[0] * c.x - x2[0] * sn.x, x1[1] * c.y - x2[1] * sn.y); o1[1] = pack2(x1[2] * c.z - x2[2] * sn.z, x1[3] * c.w - x2[3] * sn.w);
            o2[0] = pack2(x2[0] * c.x + x1[0] * sn.x, x2[1] * c.y + x1[1] * sn.y); o2[1] = pack2(x2[2] * c.z + x1[2] * sn.z, x2[3] * c.w + x1[3] * sn.w);
            *(u32x2*)(dst + (size_t)row * 512 + c0 + d) = o1;
            *(u32x2*)(dst + (size_t)row * 512 + c0 + d + 32) = o2;
          }
        }
      } else if (cb < 3584) epi_bf16(swv, 512, acc, rb, cb - 3072);
      else if (cb == 3584) {
        if (quad < 2) {
#pragma unroll
          for (int mt = 0; mt < 4; ++mt)
            *(float4*)(logit + (size_t)(rb + mt * 16 + l15) * 8 + quad * 4) = make_float4(acc[mt][0][0], acc[mt][0][1], acc[mt][0][2], acc[mt][0][3]);
        }
      }
    }, smem);
  }
}

DI void phase_dil_attn(const Params& p, int first, int nblk);

DI void phase_dn_prep(const Params& p, int i, char* smem) {
  bf16_t* qs = (bf16_t*)smem; bf16_t* ks = qs + 64 * 136; bf16_t* vs = ks + 64 * 136;
  float* Lm = (float*)(smem + 3 * 17408); float* beta = Lm + 64 * 68; float* gcum = beta + 64; float* egc = gcum + 64;
  const bf16_t* dnqkv = (const bf16_t*)(p.ws + OFF_DNQKV);
  const float* logit = (const float*)(p.ws + OFF_LOGIT);
  bf16_t* qd_g = (bf16_t*)(p.ws + OFF_QD); bf16_t* kd_g = (bf16_t*)(p.ws + OFF_KD); bf16_t* in_g = (bf16_t*)(p.ws + OFF_INTRA);
  bf16_t* w_g = (bf16_t*)(p.ws + OFF_WB); bf16_t* u_g = (bf16_t*)(p.ws + OFF_UB); float* eg_g = (float*)(p.ws + OFF_EG);
  const float* cw = p.dn_conv_w + (size_t)i * 4 * 1536;
  const int tid = TID(), wave = tid >> 6, lane = tid & 63, l15 = lane & 15, quad = lane >> 4;
  const float QS = 0.08838834764831845f;
  for (int item = BID(); item < 2048; item += GDIM()) {
    const int b = item >> 8, h = (item >> 6) & 3, n = item & 63;
    const int t0 = b * 4096 + n * 64, s0 = n * 64;
    const float A = __expf(p.dn_a_log[i * 4 + h]), dtb = p.dn_dt_bias[i * 4 + h];
    {
      float cw0[3][4], cw1[3][4], x0[3][4], x1[3][4];
#pragma unroll
      for (int which = 0; which < 3; ++which)
#pragma unroll
        for (int j = 0; j < 4; ++j) {
          const int col = which * 512 + h * 128 + lane * 2;
          cw0[which][j] = cw[j * 1536 + col]; cw1[which][j] = cw[j * 1536 + col + 1];
        }
      const int ilb = wave * 16;
#pragma unroll
      for (int which = 0; which < 3; ++which)
#pragma unroll
        for (int j = 0; j < 3; ++j) {
          const int sq = s0 + ilb - 3 + j;
          unsigned v = 0u;
          if (sq >= 0) v = *(const unsigned*)(dnqkv + (size_t)(t0 + ilb - 3 + j) * 1536 + which * 512 + h * 128 + lane * 2);
          x0[which][j + 1] = bf2f((bf16_t)(v & 0xffff)); x1[which][j + 1] = bf2f((bf16_t)(v >> 16));
        }
#pragma unroll 4
      for (int tt = 0; tt < 16; ++tt) {
        const int il = ilb + tt;
#pragma unroll
        for (int which = 0; which < 3; ++which) {
          x0[which][0] = x0[which][1]; x0[which][1] = x0[which][2]; x0[which][2] = x0[which][3];
          x1[which][0] = x1[which][1]; x1[which][1] = x1[which][2]; x1[which][2] = x1[which][3];
          const unsigned v = *(const unsigned*)(dnqkv + (size_t)(t0 + il) * 1536 + which * 512 + h * 128 + lane * 2);
          x0[which][3] = bf2f((bf16_t)(v & 0xffff)); x1[which][3] = bf2f((bf16_t)(v >> 16));
          float y0 = cw0[which][0] * x0[which][0] + cw0[which][1] * x0[which][1] + cw0[which][2] * x0[which][2] + cw0[which][3] * x0[which][3];
          float y1 = cw1[which][0] * x1[which][0] + cw1[which][1] * x1[which][1] + cw1[which][2] * x1[which][2] + cw1[which][3] * x1[which][3];
          y0 = siluf_(y0); y1 = siluf_(y1);
          if (which < 2) {
            float ss = wave_sum(y0 * y0 + y1 * y1);
            float sc = rsqrtf(ss + 1e-6f);
            y0 *= sc; y1 *= sc;
          }
          bf16_t* dst = (which == 0) ? qs : (which == 1 ? ks : vs);
          *(unsigned*)(dst + il * 136 + lane * 2) = pack2(y0, y1);
        }
      }
    }
    if (wave == 0) {
      const size_t row = (size_t)(t0 + lane);
      const float bl = logit[row * 8 + h], al = logit[row * 8 + 4 + h];
      float g = -A * softplusf_(al + dtb);
#pragma unroll
      for (int o = 1; o < 64; o <<= 1) { float v = __shfl_up(g, o); if (lane >= o) g += v; }
      beta[lane] = sigmoidf_(bl); gcum[lane] = g; egc[lane] = __expf(g);
    }
    __syncthreads();
    {
      f32x4 kk[4], qk[4];
#pragma unroll
      for (int nt = 0; nt < 4; ++nt) { kk[nt] = f32x4{0.f, 0.f, 0.f, 0.f}; qk[nt] = f32x4{0.f, 0.f, 0.f, 0.f}; }
#pragma unroll
      for (int k4 = 0; k4 < 4; ++k4) {
        const bf16x8 ak = *(const bf16x8*)(ks + (wave * 16 + l15) * 136 + k4 * 32 + quad * 8);
        const bf16x8 aq = *(const bf16x8*)(qs + (wave * 16 + l15) * 136 + k4 * 32 + quad * 8);
#pragma unroll
        for (int nt = 0; nt < 4; ++nt) {
          const bf16x8 bk = *(const bf16x8*)(ks + (nt * 16 + l15) * 136 + k4 * 32 + quad * 8);
          kk[nt] = MFMA16(ak, bk, kk[nt]); qk[nt] = MFMA16(aq, bk, qk[nt]);
        }
      }
#pragma unroll
      for (int nt = 0; nt < 4; ++nt)
#pragma unroll
        for (int r = 0; r < 4; ++r) {
          const int ii = wave * 16 + quad * 4 + r, jj = nt * 16 + l15;
          const float dec = (jj <= ii) ? __expf(gcum[ii] - gcum[jj]) : 0.f;
          Lm[ii * 68 + jj] = (jj < ii) ? beta[ii] * kk[nt][r] * dec : 0.f;
          in_g[(size_t)item * 4096 + ii * 64 + kperm(jj)] = f2bf(qk[nt][r] * QS * dec);
        }
    }
    __syncthreads();
    {
      float x[64];
#pragma unroll
      for (int ii = 0; ii < 64; ++ii) x[ii] = 0.f;
      const int c = tid & 127;
      const bool isw = tid >= 128;
      bf16_t* dstb = (isw ? w_g : u_g) + (size_t)item * 8192 + (isw ? kperm(c) : c);
      const bf16_t* srcb = (isw ? ks : vs) + c;
#pragma unroll
      for (int ii = 0; ii < 64; ++ii) {
        float acc = bf2f(srcb[ii * 136]) * beta[ii] * (isw ? egc[ii] : 1.f);
#pragma unroll
        for (int j4 = 0; j4 < (ii + 3) / 4; ++j4) {
          const float4 l4 = *(const float4*)(Lm + ii * 68 + j4 * 4);
          acc -= l4.x * x[j4 * 4]; acc -= l4.y * x[j4 * 4 + 1]; acc -= l4.z * x[j4 * 4 + 2]; acc -= l4.w * x[j4 * 4 + 3];
        }
        x[ii] = acc;
        dstb[ii * 128] = f2bf(acc);
        if ((ii & 3) == 3) __builtin_amdgcn_sched_barrier(0);
      }
    }
    {
      const float gl = gcum[63];
#pragma unroll 4
      for (int k = 0; k < 32; ++k) {
        const int e = tid + 256 * k;
        const int ii = e >> 7, d = e & 127;
        qd_g[(size_t)item * 8192 + ii * 128 + kperm(d)] = f2bf(bf2f(qs[ii * 136 + d]) * QS * egc[ii]);
        const int d2 = e >> 6, i2 = e & 63;
        kd_g[(size_t)item * 8192 + d2 * 64 + kperm(i2)] = f2bf(bf2f(ks[i2 * 136 + d2]) * __expf(gl - gcum[i2]));
      }
      if (tid == 0) eg_g[item] = __expf(gl);
    }
    __syncthreads();
  }
}

DI bf16x8 ld2(const bf16_t* ptr) {
  u32x2 lo = *(const u32x2*)ptr, hi = *(const u32x2*)(ptr + 16);
  u32x4 t; t[0] = lo[0]; t[1] = lo[1]; t[2] = hi[0]; t[3] = hi[1];
  return __builtin_bit_cast(bf16x8, t);
}

DI void dn_chain_item(const Params& p, int item, bf16_t* smem) {
  const int tid = TID(), wave = tid >> 6, lane = tid & 63, l15 = lane & 15, quad = lane >> 4;
  const int bh = item >> 1, half = item & 1;
  const int e0 = half * 64 + wave * 16 + l15;
  const bf16_t* qd_g = (const bf16_t*)(p.ws + OFF_QD); const bf16_t* kd_g = (const bf16_t*)(p.ws + OFF_KD); const bf16_t* in_g = (const bf16_t*)(p.ws + OFF_INTRA);
  const bf16_t* w_g = (const bf16_t*)(p.ws + OFF_WB); bf16_t* u_g = (bf16_t*)(p.ws + OFF_UB); const float* eg_g = (const float*)(p.ws + OFF_EG);
  bf16_t* wl = smem; bf16_t* ql = wl + 64 * 136; bf16_t* kl = ql + 64 * 136; bf16_t* il = kl + 128 * 72; bf16_t* ul = il + 64 * 72;
  uint4 rw0, rw1, rw2, rw3, rq0, rq1, rq2, rq3, rk0, rk1, rk2, rk3, ri0, ri1, ru0, ru1;
#define CH_GLOAD(n_) do { const size_t ci_ = (size_t)bh * 64 + (n_); \
    const bf16_t* w_ = w_g + ci_ * 8192 + tid * 8; const bf16_t* q_ = qd_g + ci_ * 8192 + tid * 8; const bf16_t* k_ = kd_g + ci_ * 8192 + tid * 8; \
    rw0 = *(const uint4*)(w_); rw1 = *(const uint4*)(w_ + 2048); rw2 = *(const uint4*)(w_ + 4096); rw3 = *(const uint4*)(w_ + 6144); \
    rq0 = *(const uint4*)(q_); rq1 = *(const uint4*)(q_ + 2048); rq2 = *(const uint4*)(q_ + 4096); rq3 = *(const uint4*)(q_ + 6144); \
    rk0 = *(const uint4*)(k_); rk1 = *(const uint4*)(k_ + 2048); rk2 = *(const uint4*)(k_ + 4096); rk3 = *(const uint4*)(k_ + 6144); \
    ri0 = *(const uint4*)(in_g + ci_ * 4096 + tid * 8); ri1 = *(const uint4*)(in_g + ci_ * 4096 + 2048 + tid * 8); \
    ru0 = *(const uint4*)(u_g + ci_ * 8192 + (tid >> 3) * 128 + half * 64 + (tid & 7) * 8); \
    ru1 = *(const uint4*)(u_g + ci_ * 8192 + (32 + (tid >> 3)) * 128 + half * 64 + (tid & 7) * 8); } while (0)
#define CH_LSTORE() do { \
    bf16_t* w_ = wl + (tid >> 4) * 136 + (tid & 15) * 8; bf16_t* q_ = ql + (tid >> 4) * 136 + (tid & 15) * 8; bf16_t* k_ = kl + (tid >> 3) * 72 + (tid & 7) * 8; \
    *(uint4*)(w_) = rw0; *(uint4*)(w_ + 16 * 136) = rw1; *(uint4*)(w_ + 32 * 136) = rw2; *(uint4*)(w_ + 48 * 136) = rw3; \
    *(uint4*)(q_) = rq0; *(uint4*)(q_ + 16 * 136) = rq1; *(uint4*)(q_ + 32 * 136) = rq2; *(uint4*)(q_ + 48 * 136) = rq3; \
    *(uint4*)(k_) = rk0; *(uint4*)(k_ + 32 * 72) = rk1; *(uint4*)(k_ + 64 * 72) = rk2; *(uint4*)(k_ + 96 * 72) = rk3; \
    *(uint4*)(il + (tid >> 3) * 72 + (tid & 7) * 8) = ri0; *(uint4*)(il + (32 + (tid >> 3)) * 72 + (tid & 7) * 8) = ri1; \
    *(uint4*)(ul + (tid >> 3) * 72 + (tid & 7) * 8) = ru0; *(uint4*)(ul + (32 + (tid >> 3)) * 72 + (tid & 7) * 8) = ru1; } while (0)
  f32x4 S[8];
#pragma unroll
  for (int mt = 0; mt < 8; ++mt) S[mt] = f32x4{0.f, 0.f, 0.f, 0.f};
  CH_GLOAD(0);
  CH_LSTORE();
  __syncthreads();
#pragma unroll 1
  for (int n = 0; n < 64; ++n) {
    const size_t ci = (size_t)bh * 64 + n;
    if (n + 1 < 64) CH_GLOAD(n + 1);
    bf16_t* ub = u_g + ci * 8192;
    const float eg = eg_g[ci];
    bf16x8 sb[4];
#pragma unroll
    for (int s = 0; s < 4; ++s) sb[s] = pack8(S[2 * s], S[2 * s + 1]);
    f32x4 vn[4];
#pragma unroll
    for (int it = 0; it < 4; ++it) {
      f32x4 a = {0.f, 0.f, 0.f, 0.f};
#pragma unroll
      for (int s = 0; s < 4; ++s) a = MFMA16(*(const bf16x8*)(wl + (it * 16 + l15) * 136 + s * 32 + quad * 8), sb[s], a);
#pragma unroll
      for (int r = 0; r < 4; ++r) vn[it][r] = bf2f(ul[(it * 16 + quad * 4 + r) * 72 + wave * 16 + l15]) - a[r];
    }
    bf16x8 vb[2];
    vb[0] = pack8(vn[0], vn[1]); vb[1] = pack8(vn[2], vn[3]);
#pragma unroll
    for (int it = 0; it < 4; ++it) {
      f32x4 a = {0.f, 0.f, 0.f, 0.f};
#pragma unroll
      for (int s = 0; s < 4; ++s) a = MFMA16(*(const bf16x8*)(ql + (it * 16 + l15) * 136 + s * 32 + quad * 8), sb[s], a);
#pragma unroll
      for (int s = 0; s < 2; ++s) a = MFMA16(*(const bf16x8*)(il + (it * 16 + l15) * 72 + s * 32 + quad * 8), vb[s], a);
#pragma unroll
      for (int r = 0; r < 4; ++r) ub[(it * 16 + quad * 4 + r) * 128 + e0] = f2bf(a[r]);
    }
#pragma unroll
    for (int mt = 0; mt < 8; ++mt) {
      f32x4 a = S[mt];
      a[0] *= eg; a[1] *= eg; a[2] *= eg; a[3] *= eg;
#pragma unroll
      for (int s = 0; s < 2; ++s) a = MFMA16(*(const bf16x8*)(kl + (mt * 16 + l15) * 72 + s * 32 + quad * 8), vb[s], a);
      S[mt] = a;
    }
    __syncthreads();
    if (n + 1 < 64) CH_LSTORE();
    __syncthreads();
  }
}

DI void phase_mix(const Params& p, int i, bf16_t* smem) {
  if (BID() < 64) { dn_chain_item(p, BID(), smem); return; }
  phase_dil_attn(p, BID() - 64, GDIM() - 64);
}

DI void phase_dn_post(const Params& p, int i) {
  const bf16_t* ob = (const bf16_t*)(p.ws + OFF_UB);
  bf16_t* z = (bf16_t*)(p.ws + OFF_Z);
  const float* ng = p.dn_norm_g + i * 128;
  const int wave = TID() >> 6, lane = TID() & 63;
  const int N = T_ * 4;
  for (int base = BID() * 4; base < N; base += GDIM() * 4) {
    const int item = base + wave;
    const int t = item >> 2, h = item & 3, b = t >> 12, sidx = t & 4095;
    const size_t g = (size_t)item * 128 + lane * 2;
    const size_t og = ((size_t)((b * 4 + h) * 64 + (sidx >> 6))) * 8192 + (sidx & 63) * 128 + lane * 2;
    unsigned ov = *(const unsigned*)(ob + og), zv = *(const unsigned*)(z + g);
    float o0 = bf2f((bf16_t)(ov & 0xffff)), o1 = bf2f((bf16_t)(ov >> 16));
    float z0 = bf2f((bf16_t)(zv & 0xffff)), z1 = bf2f((bf16_t)(zv >> 16));
    float ms = wave_sum(o0 * o0 + o1 * o1) * (1.f / 128.f);
    float rr = rsqrtf(ms + 1e-6f);
    float r0 = o0 * rr * ng[lane * 2] * siluf_(z0), r1 = o1 * rr * ng[lane * 2 + 1] * siluf_(z1);
    *(unsigned*)(z + g) = pack2(r0, r1);
  }
}

struct MixLoad {
  const bf16_t* a; const bf16_t* b;
  DI uint4 operator()(int row, int ks, int kc) const {
    const unsigned off = (unsigned)((row * 512 + (ks & 7) * 64 + kc) * 2);
    return *(const uint4*)((const char*)((ks < 8) ? a : b) + off);
  }
};

DI void phase_wout(const Params& p, int i, bf16_t* smem) {
  const bf16_t* W = (const bf16_t*)(p.ws + OFF_W) + W_EVEN0 + (size_t)i * (SZ_WIN + SZ_SQ) + SZ_WIN;
  MixLoad al{(const bf16_t*)(p.ws + OFF_Z), (const bf16_t*)(p.ws + OFF_SWQ)};
  PlainLoad bl{W, 1024};
  {
    gemm_stream(256, 8, 16, al, bl, [&](f32x4 (&acc)[4][4], int rb, int cb) { epi_resid(p, acc, rb, cb); }, smem);
  }
}

template <int R>
DI void ln_rows(const Params& p, int row0, const float* g, const float* b, int lane) {
  bf16_t* hb = (bf16_t*)(p.ws + OFF_HB);
  float4 v[R][4];
#pragma unroll
  for (int j = 0; j < R; ++j)
#pragma unroll
    for (int i = 0; i < 4; ++i) v[j][i] = ((const float4*)(p.out + (size_t)(row0 + j) * 1024))[lane + 64 * i];
  float4 gg[4], bb[4];
#pragma unroll
  for (int i = 0; i < 4; ++i) { gg[i] = ((const float4*)g)[lane + 64 * i]; bb[i] = ((const float4*)b)[lane + 64 * i]; }
#pragma unroll
  for (int j = 0; j < R; ++j) {
    float s = 0.f;
#pragma unroll
    for (int i = 0; i < 4; ++i) s += v[j][i].x + v[j][i].y + v[j][i].z + v[j][i].w;
    const float mu = wave_sum(s) * (1.f / 1024.f);
    float q = 0.f;
#pragma unroll
    for (int i = 0; i < 4; ++i) { float a = v[j][i].x - mu, b2 = v[j][i].y - mu, c = v[j][i].z - mu, d = v[j][i].w - mu; q += a * a + b2 * b2 + c * c + d * d; }
    const float rstd = rsqrtf(wave_sum(q) * (1.f / 1024.f) + 1e-5f);
    float4* y = (float4*)(p.out + (size_t)(row0 + j) * 1024);
#pragma unroll
    for (int i = 0; i < 4; ++i) {
      float4 o;
      o.x = (v[j][i].x - mu) * rstd * gg[i].x + bb[i].x; o.y = (v[j][i].y - mu) * rstd * gg[i].y + bb[i].y;
      o.z = (v[j][i].z - mu) * rstd * gg[i].z + bb[i].z; o.w = (v[j][i].w - mu) * rstd * gg[i].w + bb[i].w;
      y[lane + 64 * i] = o;
      uint2 ob; ob.x = pack2(o.x, o.y); ob.y = pack2(o.z, o.w);
      ((uint2*)(hb + (size_t)(row0 + j) * 1024))[lane + 64 * i] = ob;
    }
  }
}
DI void phase_ln(const Params& p, const float* g, const float* b) {
  const int wave = TID() >> 6, lane = TID() & 63;
  for (int row = (BID() * 4 + wave) * 4; row < T_; row += GDIM() * 16) ln_rows<4>(p, row, g, b, lane);
}

DI void phase_s5_naive(const Params& p, int i) {
  const int wave = TID() >> 6, lane = TID() & 63;
  bf16_t* hid = (bf16_t*)(p.ws + OFF_HID);
  for (int base = BID() * 4; base < 512; base += GDIM() * 4) {
    const int item = base + wave, b = item >> 6, g = item & 63;
    const int gp = (i * 64 + g) * 64 + lane;
    const double dt = exp((double)p.s5_log_dt[i * 64 + g]);
    const double are = p.s5_a_re[gp], aim = p.s5_a_im[gp];
    const double lr = are * dt, li = aim * dt;
    const double kk = rint(li * 0.15915494309189535);
    const double red = li - kk * 6.283185307179586;
    const double e = exp(lr);
    const double abr = e * cos(red), abi = e * sin(red);
    const double den = are * are + aim * aim;
    const double nr = abr - 1.0, ni = abi;
    const double cfr = (nr * are + ni * aim) / den, cfi = (ni * are - nr * aim) / den;
    float bbr[16], bbi[16], cr[16], ci[16];
#pragma unroll
    for (int h = 0; h < 16; ++h) {
      const double br = p.s5_b_re[(size_t)gp * 16 + h], bi = p.s5_b_im[(size_t)gp * 16 + h];
      bbr[h] = (float)(cfr * br - cfi * bi); bbi[h] = (float)(cfr * bi + cfi * br);
      cr[h] = p.s5_c_re[((size_t)(i * 64 + g) * 16 + h) * 64 + lane];
      ci[h] = p.s5_c_im[((size_t)(i * 64 + g) * 16 + h) * 64 + lane];
    }
    const float ar = (float)abr, ai = (float)abi;
    const float dsk = p.s5_d[i * 1024 + g * 16 + (lane & 15)];
    float sr = 0.f, si = 0.f;
#pragma unroll 1
    for (int t = 0; t < S_; ++t) {
      const size_t row = (size_t)(b * S_ + t);
      const float4* up = (const float4*)(p.out + row * 1024 + g * 16);
      float u[16];
#pragma unroll
      for (int j = 0; j < 4; ++j) { float4 v = up[j]; u[4 * j] = v.x; u[4 * j + 1] = v.y; u[4 * j + 2] = v.z; u[4 * j + 3] = v.w; }
      float bur = 0.f, bui = 0.f;
#pragma unroll
      for (int h = 0; h < 16; ++h) { bur += bbr[h] * u[h]; bui += bbi[h] * u[h]; }
      const float nsr = ar * sr - ai * si + bur, nsi = ar * si + ai * sr + bui;
      sr = nsr; si = nsi;
      float yk = 0.f, uk = 0.f;
#pragma unroll
      for (int h = 0; h < 16; ++h) {
        float v = wave_sum(cr[h] * sr - ci[h] * si);
        if (lane == h) { yk = v; uk = u[h]; }
      }
      if (lane < 16) hid[row * 1024 + g * 16 + lane] = f2bf(gelu_tanh(yk + dsk * uk));
    }
  }
}

DI void phase_s5_tables(const Params& p, int i, float* smem) {
  float2* pw = (float2*)smem;
  float2* bb = pw + 64 * 33;
  float2* cc = bb + 64 * 16;
  bf16_t* Ktab = (bf16_t*)(p.ws + OFF_KTAB); bf16_t* Etab = (bf16_t*)(p.ws + OFF_ETAB); bf16_t* Gtab = (bf16_t*)(p.ws + OFF_GTAB);
  float2* AL = (float2*)(p.ws + OFF_AL);
  const int tid = TID();
  for (int item = BID(); item < 512; item += GDIM()) {
    const int g = item >> 3, part = item & 7;
    const double dt = exp((double)p.s5_log_dt[i * 64 + g]);
    for (int e = tid; e < 64 * 33; e += 256) {
      const int pp = e / 33, n = e - pp * 33;
      const double are = p.s5_a_re[(i * 64 + g) * 64 + pp], aim = p.s5_a_im[(i * 64 + g) * 64 + pp];
      const double lr = are * dt * n, li = aim * dt * n;
      const double k = rint(li * 0.15915494309189535);
      const double red = li - k * 6.283185307179586;
      const double ex = exp(lr);
      pw[e] = make_float2((float)(ex * cos(red)), (float)(ex * sin(red)));
    }
    for (int e = tid; e < 1024; e += 256) {
      const int pp = e >> 4;
      const int gp = (i * 64 + g) * 64 + pp;
      const double are = p.s5_a_re[gp], aim = p.s5_a_im[gp];
      const double lr = are * dt, li = aim * dt;
      const double k = rint(li * 0.15915494309189535);
      const double red = li - k * 6.283185307179586;
      const double ex = exp(lr);
      const double nr = ex * cos(red) - 1.0, ni = ex * sin(red);
      const double den = are * are + aim * aim;
      const double cfr = (nr * are + ni * aim) / den, cfi = (ni * are - nr * aim) / den;
      const double br = p.s5_b_re[(size_t)gp * 16 + (e & 15)], bi = p.s5_b_im[(size_t)gp * 16 + (e & 15)];
      bb[e] = make_float2((float)(cfr * br - cfi * bi), (float)(cfr * bi + cfi * br));
      const size_t ci = ((size_t)(i * 64 + g) * 16 + (e >> 6)) * 64 + (e & 63);
      cc[e] = make_float2(p.s5_c_re[ci], p.s5_c_im[ci]);
    }
    __syncthreads();
    for (int e = part * 1024 + tid; e < (part + 1) * 1024; e += 256) {
      const int tau = e >> 8, ho = (e >> 4) & 15, hi = e & 15;
      float acc = 0.f;
      for (int pp = 0; pp < 64; ++pp) {
        const float2 c = cc[ho * 64 + pp], w = pw[pp * 33 + tau], b = bb[pp * 16 + hi];
        const float cwr = c.x * w.x - c.y * w.y, cwi = c.x * w.y + c.y * w.x;
        acc += cwr * b.x - cwi * b.y;
      }
      Ktab[(size_t)g * 8192 + e] = f2bf(acc);
    }
    for (int e = part * 8192 + tid; e < (part + 1) * 8192; e += 256) {
      const int pc = e >> 9, sidx = (e >> 4) & 31, hi = e & 15, pp = pc & 63;
      const float2 w = pw[pp * 33 + 31 - sidx], b = bb[pp * 16 + hi];
      const float v = (pc < 64) ? (w.x * b.x - w.y * b.y) : (w.x * b.y + w.y * b.x);
      Etab[(size_t)g * 65536 + e] = f2bf(v);
    }
    for (int e = part * 8192 + tid; e < (part + 1) * 8192; e += 256) {
      const int row = e >> 7, pc = e & 127, pp = pc & 63, t = row >> 4, ho = row & 15;
      const float2 c = cc[ho * 64 + pp], w = pw[pp * 33 + t + 1];
      const float v = (pc < 64) ? (c.x * w.x - c.y * w.y) : -(c.x * w.y + c.y * w.x);
      Gtab[(size_t)g * 65536 + e] = f2bf(v);
    }
    if (tid < 64 && part == 0) AL[g * 64 + tid] = pw[tid * 33 + 32];
    __syncthreads();
  }
}

DI void phase_s5_end(const Params& p, bf16_t* smem) {
  const bf16_t* Etab = (const bf16_t*)(p.ws + OFF_ETAB); const bf16_t* hb = (const bf16_t*)(p.ws + OFF_HB);
  const float2* AL = (const float2*)(p.ws + OFF_AL);
  bf16_t* sin_ = (bf16_t*)(p.ws + OFF_SIN);
  float* endbuf = (float*)smem;
  for (int item = BID(); item < 512; item += GDIM()) {
    const int g = item >> 3, b = item & 7;
    auto al = [=](int row, int ks, int kc) { return *(const uint4*)((const char*)Etab + (unsigned)((((g * 128 + row) * 512) + ks * 64 + kc) * 2)); };
    auto bl = [=](int n, int ks, int kc) {
      const int k = ks * 64 + kc, sidx = k >> 4, hi0 = k & 15;
      return *(const uint4*)((const char*)hb + (unsigned)(((b * 4096 + n * 32 + sidx) * 1024 + g * 16 + hi0) * 2));
    };
    gemm_tile(0, 0, 8, al, bl, [&](f32x4 (&acc)[4][4], int rb, int cb) {
      const int lane = TID() & 63, l15 = lane & 15, quad = lane >> 4;
#pragma unroll
      for (int mt = 0; mt < 4; ++mt)
#pragma unroll
        for (int nt = 0; nt < 4; ++nt)
#pragma unroll
          for (int r = 0; r < 4; ++r) endbuf[(rb + mt * 16 + l15) * 129 + cb + nt * 16 + quad * 4 + r] = acc[mt][nt][r];
    }, smem);
    __syncthreads();
    if (TID() < 64) {
      const int pp = TID();
      const float2 a = AL[g * 64 + pp];
      float sr = 0.f, si = 0.f;
      for (int n = 0; n < 128; ++n) {
        bf16_t* dst = sin_ + ((size_t)g * 1024 + b * 128 + n) * 128;
        dst[pp] = f2bf(sr); dst[64 + pp] = f2bf(si);
        const float er = endbuf[pp * 129 + n], ei = endbuf[(64 + pp) * 129 + n];
        const float nr = a.x * sr - a.y * si + er, ni = a.x * si + a.y * sr + ei;
        sr = nr; si = ni;
      }
    }
    __syncthreads();
  }
}

DI void phase_s5_y(const Params& p, int i, bf16_t* smem) {
  const bf16_t* Ktab = (const bf16_t*)(p.ws + OFF_KTAB); const bf16_t* Gtab = (const bf16_t*)(p.ws + OFF_GTAB);
  const bf16_t* hb = (const bf16_t*)(p.ws + OFF_HB); const bf16_t* sin_ = (const bf16_t*)(p.ws + OFF_SIN);
  bf16_t* hid = (bf16_t*)(p.ws + OFF_HID);
  for (int w = BID(); w < 2048; w += GDIM()) {
    const int g = w >> 5, mtile = (w >> 3) & 3, b = w & 7;
    const int nT = mtile * 2 + 2;
    auto al = [=](int row, int ks, int kc) -> uint4 {
      if (ks < nT) {
        const int k = ks * 64 + kc, sidx = k >> 4, hi0 = k & 15, t = row >> 4, ho = row & 15;
        if (t >= sidx) return *(const uint4*)((const char*)Ktab + (unsigned)(((((g * 32 + (t - sidx)) * 16 + ho) * 16) + hi0) * 2));
        return make_uint4(0, 0, 0, 0);
      }
      return *(const uint4*)((const char*)Gtab + (unsigned)((((g * 512 + row) * 128) + (ks - nT) * 64 + kc) * 2));
    };
    auto bl = [=](int n, int ks, int kc) -> uint4 {
      if (ks < nT) {
        const int k = ks * 64 + kc, sidx = k >> 4, hi0 = k & 15;
        return *(const uint4*)((const char*)hb + (unsigned)(((b * 4096 + n * 32 + sidx) * 1024 + g * 16 + hi0) * 2));
      }
      return *(const uint4*)((const char*)sin_ + (unsigned)((((g * 1024 + b * 128 + n) * 128) + (ks - nT) * 64 + kc) * 2));
    };
    gemm_tile(0, mtile * 128, nT + 2, bl, al, [&](f32x4 (&acc)[4][4], int rb, int cb) {
      const int lane = TID() & 63, l15 = lane & 15, quad = lane >> 4;
      const float4 dsk = *(const float4*)(p.s5_d + i * 1024 + g * 16 + quad * 4);
#pragma unroll
      for (int mt = 0; mt < 4; ++mt)
#pragma unroll
        for (int nt = 0; nt < 4; ++nt) {
          const int t = (cb + nt * 16) >> 4, n = rb + mt * 16 + l15;
          const size_t tok = (size_t)b * 4096 + n * 32 + t;
          const float4 u = *(const float4*)(p.out + tok * 1024 + g * 16 + quad * 4);
          u32x2 v;
          v[0] = pack2(gelu_tanh(acc[mt][nt][0] + dsk.x * u.x), gelu_tanh(acc[mt][nt][1] + dsk.y * u.y));
          v[1] = pack2(gelu_tanh(acc[mt][nt][2] + dsk.z * u.z), gelu_tanh(acc[mt][nt][3] + dsk.w * u.w));
          *(u32x2*)(hid + tok * 1024 + g * 16 + quad * 4) = v;
        }
    }, smem);
  }
}

DI void phase_glu(const Params& p, int i, bf16_t* smem) {
  const bf16_t* W = (const bf16_t*)(p.ws + OFF_W) + W_ODD0 + (size_t)i * SZ_GLU;
  PlainLoad al{(const bf16_t*)(p.ws + OFF_HID), 1024}, bl{W, 1024};
  {
    gemm_stream(256, 16, 16, al, bl, [&](f32x4 (&acc)[4][4], int rb, int cb) {
      const int lane = TID() & 63, l15 = lane & 15, quad = lane >> 4;
#pragma unroll
      for (int mt = 0; mt < 4; ++mt)
#pragma unroll
        for (int np = 0; np < 2; ++np) {
          float4* ptr = (float4*)(p.out + (size_t)(rb + mt * 16 + l15) * 1024 + (cb >> 1) + np * 16 + quad * 4);
          float4 h = *ptr;
          h.x = ALPHA * h.x + acc[mt][2 * np][0] * sigmoidf_(acc[mt][2 * np + 1][0]);
          h.y = ALPHA * h.y + acc[mt][2 * np][1] * sigmoidf_(acc[mt][2 * np + 1][1]);
          h.z = ALPHA * h.z + acc[mt][2 * np][2] * sigmoidf_(acc[mt][2 * np + 1][2]);
          h.w = ALPHA * h.w + acc[mt][2 * np][3] * sigmoidf_(acc[mt][2 * np + 1][3]);
          *ptr = h;
        }
    }, smem);
  }
}

DI void phase_xproj(const Params& p, int l, bf16_t* smem) {
  const bf16_t* wc = (const bf16_t*)(p.ws + OFF_W) + (size_t)l * SZ_COMMON;
  {
    PlainLoad al{(const bf16_t*)(p.ws + OFF_HB), 1024}, bl{wc, 1024};
    bf16_t* q = (bf16_t*)(p.ws + OFF_XQ);
    gemm_stream(256, 8, 16, al, bl, [&](f32x4 (&acc)[4][4], int rb, int cb) { epi_bf16(q, 1024, acc, rb, cb); }, smem);
  }
  {
    const float* memf = p.mem;
    auto al = [=](int row, int ks, int kc) -> uint4 {
      const float4* src = (const float4*)((const char*)memf + (unsigned)((row * 1024 + ks * 64 + kc) * 4));
      float4 a = src[0], b2 = src[1];
      return make_uint4(pack2(a.x, a.y), pack2(a.z, a.w), pack2(b2.x, b2.y), pack2(b2.z, b2.w));
    };
    bf16_t* kx = (bf16_t*)(p.ws + OFF_KX); bf16_t* vx = (bf16_t*)(p.ws + OFF_VX);
    for_tiles(16, 16, [&](int mi, int ni) {
      const bool isv = ni >= 8;
      PlainLoad bl{isv ? (wc + 2 * SZ_SQ) : (wc + SZ_SQ), 1024};
      gemm_tile(mi * 128, (ni & 7) * 128, 16, al, bl, [&](f32x4 (&acc)[4][4], int rb, int cb) {
        if (!isv) { epi_bf16(kx, 1024, acc, rb, cb); return; }
        const int lane = TID() & 63, l15 = lane & 15, quad = lane >> 4;
#pragma unroll
        for (int mt = 0; mt < 4; ++mt)
#pragma unroll
          for (int nt = 0; nt < 4; ++nt) {
            const int row = rb + mt * 16 + l15, col = cb + nt * 16 + quad * 4;
            const int b = row >> 8, key = row & 255, h = col >> 8, d = col & 255;
            bf16_t* dst = vx + ((size_t)((b * 4 + h) * 256 + d)) * 256 + kperm(key);
#pragma unroll
            for (int r = 0; r < 4; ++r) dst[r * 256] = f2bf(acc[mt][nt][r]);
          }
      }, smem);
    });
  }
}


DI void phase_xattn(const Params& p, bf16_t* smem) {
  const int tid = TID(), wave = tid >> 6, lane = tid & 63, l15 = lane & 15, quad = lane >> 4;
  const bf16_t* q = (const bf16_t*)(p.ws + OFF_XQ); const bf16_t* kx = (const bf16_t*)(p.ws + OFF_KX); const bf16_t* vxT = (const bf16_t*)(p.ws + OFF_VX);
  bf16_t* xo = (bf16_t*)(p.ws + OFF_XO);
  uint4 rg0, rg1, rg2, rg3, rg4, rg5, rg6, rg7;
#define XA_KLOAD(c_) do { const bf16_t* s_ = kx + (size_t)(b * 256 + (c_) * 64 + (tid >> 5)) * 1024 + h * 256 + (tid & 31) * 8; \
    rg0 = *(const uint4*)(s_); rg1 = *(const uint4*)(s_ + 8 * 1024); rg2 = *(const uint4*)(s_ + 16 * 1024); rg3 = *(const uint4*)(s_ + 24 * 1024); \
    rg4 = *(const uint4*)(s_ + 32 * 1024); rg5 = *(const uint4*)(s_ + 40 * 1024); rg6 = *(const uint4*)(s_ + 48 * 1024); rg7 = *(const uint4*)(s_ + 56 * 1024); } while (0)
#define XA_KSTORE(buf_) do { bf16_t* d_ = (buf_) + (tid >> 5) * 264 + (tid & 31) * 8; \
    *(uint4*)(d_) = rg0; *(uint4*)(d_ + 8 * 264) = rg1; *(uint4*)(d_ + 16 * 264) = rg2; *(uint4*)(d_ + 24 * 264) = rg3; \
    *(uint4*)(d_ + 32 * 264) = rg4; *(uint4*)(d_ + 40 * 264) = rg5; *(uint4*)(d_ + 48 * 264) = rg6; *(uint4*)(d_ + 56 * 264) = rg7; } while (0)
#define XA_VLOAD(c_) do { const bf16_t* s_ = vxT + ((size_t)((b * 4 + h) * 256 + (tid >> 3))) * 256 + (c_) * 64 + (tid & 7) * 8; \
    rg0 = *(const uint4*)(s_); rg1 = *(const uint4*)(s_ + 32 * 256); rg2 = *(const uint4*)(s_ + 64 * 256); rg3 = *(const uint4*)(s_ + 96 * 256); \
    rg4 = *(const uint4*)(s_ + 128 * 256); rg5 = *(const uint4*)(s_ + 160 * 256); rg6 = *(const uint4*)(s_ + 192 * 256); rg7 = *(const uint4*)(s_ + 224 * 256); } while (0)
#define XA_VSTORE(buf_) do { bf16_t* d_ = (buf_) + (tid >> 3) * 72 + (tid & 7) * 8; \
    *(uint4*)(d_) = rg0; *(uint4*)(d_ + 32 * 72) = rg1; *(uint4*)(d_ + 64 * 72) = rg2; *(uint4*)(d_ + 96 * 72) = rg3; \
    *(uint4*)(d_ + 128 * 72) = rg4; *(uint4*)(d_ + 160 * 72) = rg5; *(uint4*)(d_ + 192 * 72) = rg6; *(uint4*)(d_ + 224 * 72) = rg7; } while (0)
  for (int item = BID(); item < 2048; item += GDIM()) {
    const int b = item >> 8, h = (item >> 6) & 3, qb = item & 63;
    const size_t tq = (size_t)b * 4096 + qb * 64 + wave * 16 + l15;
    XA_KLOAD(0);
    bf16x8 qf[8];
#pragma unroll
    for (int ks = 0; ks < 8; ++ks) qf[ks] = *(const bf16x8*)(q + tq * 1024 + h * 256 + ks * 32 + quad * 8);
    XA_KSTORE(smem);
    __syncthreads();
    f32x4 s[16];
#pragma unroll
    for (int c = 0; c < 4; ++c) {
      const bf16_t* cur = smem + (c & 1) * 18432; bf16_t* nxt = smem + ((c + 1) & 1) * 18432;
      if (c < 3) XA_KLOAD(c + 1); else XA_VLOAD(0);
#pragma unroll
      for (int m4 = 0; m4 < 4; ++m4) {
        f32x4 a = {0.f, 0.f, 0.f, 0.f};
#pragma unroll
        for (int ks = 0; ks < 8; ++ks) a = MFMA16(*(const bf16x8*)(cur + (m4 * 16 + l15) * 264 + ks * 32 + quad * 8), qf[ks], a);
        s[c * 4 + m4] = a;
      }
      if (c < 3) XA_KSTORE(nxt); else XA_VSTORE(nxt);
      __syncthreads();
    }
    float m = -1e30f;
#pragma unroll
    for (int mt = 0; mt < 16; ++mt)
#pragma unroll
      for (int r = 0; r < 4; ++r) m = fmaxf(m, s[mt][r]);
    m = fmaxf(m, __shfl_xor(m, 16)); m = fmaxf(m, __shfl_xor(m, 32));
    const float c1 = 0.0625f * 1.4426950408889634f;
    float l = 0.f;
#pragma unroll
    for (int mt = 0; mt < 16; ++mt)
#pragma unroll
      for (int r = 0; r < 4; ++r) { float pv = exp2f((s[mt][r] - m) * c1); s[mt][r] = pv; l += pv; }
    l += __shfl_xor(l, 16); l += __shfl_xor(l, 32);
    f32x4 o[16];
#pragma unroll
    for (int dt = 0; dt < 16; ++dt) o[dt] = f32x4{0.f, 0.f, 0.f, 0.f};
#pragma unroll
    for (int c = 0; c < 4; ++c) {
      const bf16_t* cur = smem + (c & 1) * 18432; bf16_t* nxt = smem + ((c + 1) & 1) * 18432;
      if (c < 3) XA_VLOAD(c + 1);
#pragma unroll
      for (int s2 = 0; s2 < 2; ++s2) {
        const bf16x8 pf = pack8(s[4 * c + 2 * s2], s[4 * c + 2 * s2 + 1]);
#pragma unroll
        for (int dt = 0; dt < 16; ++dt) o[dt] = MFMA16(*(const bf16x8*)(cur + (dt * 16 + l15) * 72 + s2 * 32 + quad * 8), pf, o[dt]);
      }
      if (c < 3) XA_VSTORE(nxt);
      __syncthreads();
    }
    const float il = 1.f / l;
#pragma unroll
    for (int dt = 0; dt < 16; ++dt) {
      u32x2 v; v[0] = pack2(o[dt][0] * il, o[dt][1] * il); v[1] = pack2(o[dt][2] * il, o[dt][3] * il);
      *(u32x2*)(xo + tq * 1024 + h * 256 + dt * 16 + quad * 4) = v;
    }
  }
}

template <int R, int NT>
DI void dil_branch(const bf16_t* swk, const bf16_t* swv, size_t rowbase, int h, int tok0, const bf16x8 (&qf)[2], float& m, float& l, f32x4 (&o)[4],
                   int l15, int quad) {
  constexpr int U = 16 / R, W = 128 * R;
  f32x4 s[NT];
#pragma unroll
  for (int kt = 0; kt < NT; ++kt) {
    int kap = tok0 - W + R * (kt * 16 + l15);
    kap = min(max(kap, 0), 4095);
    const bf16_t* kp = swk + (rowbase + kap) * 512 + h * 64 + quad * 8;
    f32x4 a = {0.f, 0.f, 0.f, 0.f};
    a = MFMA16(*(const bf16x8*)kp, qf[0], a);
    a = MFMA16(*(const bf16x8*)(kp + 32), qf[1], a);
    s[kt] = a;
    if ((kt & 3) == 3) __builtin_amdgcn_sched_barrier(0);
  }
  float mx = m;
  const float c1 = 0.125f * 1.4426950408889634f;
#pragma unroll
  for (int kt = 0; kt < NT; ++kt)
#pragma unroll
    for (int r2 = 0; r2 < 4; ++r2) {
      const int c = kt * 16 + quad * 4 + r2;
      const int dist = U * l15 + 128 - c;
      const int kap = tok0 - W + R * c;
      const bool ok = (dist >= 0) && (dist <= 128) && (kap >= 0);
      const float v = ok ? s[kt][r2] * c1 : -1e30f;
      s[kt][r2] = v; mx = fmaxf(mx, v);
    }
  mx = fmaxf(mx, __shfl_xor(mx, 16)); mx = fmaxf(mx, __shfl_xor(mx, 32));
  const float corr = exp2f(m - mx);
  m = mx; l *= corr;
#pragma unroll
  for (int dt = 0; dt < 4; ++dt) { o[dt][0] *= corr; o[dt][1] *= corr; o[dt][2] *= corr; o[dt][3] *= corr; }
#pragma unroll
  for (int kt = 0; kt < NT; ++kt)
#pragma unroll
    for (int r2 = 0; r2 < 4; ++r2) { float pv = exp2f(s[kt][r2] - mx); s[kt][r2] = pv; l += pv; }
  constexpr int NS = (NT + 1) / 2;
#pragma unroll
  for (int s2 = 0; s2 < NS; ++s2) {
    const f32x4 z4 = {0.f, 0.f, 0.f, 0.f};
    const bf16x8 pf = pack8(s[2 * s2], (2 * s2 + 1 < NT) ? s[(2 * s2 + 1 < NT) ? 2 * s2 + 1 : 0] : z4);
    u32x2 vv[8];
#pragma unroll
    for (int j = 0; j < 8; ++j) {
      const int c = (2 * s2 + (j >> 2)) * 16 + quad * 4 + (j & 3);
      int kap = tok0 - W + R * c;
      kap = min(max(kap, 0), 4095);
      vv[j] = *(const u32x2*)(swv + (rowbase + kap) * 512 + h * 64 + 4 * l15);
    }
#pragma unroll
    for (int t4 = 0; t4 < 4; ++t4) {
      u32x4 t;
#pragma unroll
      for (int m = 0; m < 4; ++m) {
        const unsigned a = vv[2 * m][t4 >> 1], b2 = vv[2 * m + 1][t4 >> 1];
        t[m] = (t4 & 1) ? ((a >> 16) | (b2 & 0xffff0000u)) : ((a & 0xffffu) | (b2 << 16));
      }
      o[t4] = MFMA16(__builtin_bit_cast(bf16x8, t), pf, o[t4]);
    }
    __builtin_amdgcn_sched_barrier(0);
  }
}

DI void phase_dil_attn(const Params& p, int first, int nblk) {
  const int wave = TID() >> 6, lane = TID() & 63, l15 = lane & 15, quad = lane >> 4;
  bf16_t* swq = (bf16_t*)(p.ws + OFF_SWQ); const bf16_t* swk = (const bf16_t*)(p.ws + OFF_SWK); const bf16_t* swv = (const bf16_t*)(p.ws + OFF_SWV);
  for (int item = first; item < 4096; item += nblk) {
    const int b = item >> 9, h = (item >> 6) & 7, rho = (item >> 2) & 15, gq = item & 3;
    const int tok0 = (gq * 4 + wave) * 256 + rho;
    const size_t rowbase = (size_t)b * 4096;
    const size_t tq = rowbase + tok0 + 16 * l15;
    bf16x8 qf[2];
    qf[0] = *(const bf16x8*)(swq + tq * 512 + h * 64 + quad * 8);
    qf[1] = *(const bf16x8*)(swq + tq * 512 + h * 64 + 32 + quad * 8);
    float m = -1e30f, l = 0.f;
    f32x4 o[4];
#pragma unroll
    for (int dt = 0; dt < 4; ++dt) o[dt] = f32x4{0.f, 0.f, 0.f, 0.f};
    dil_branch<16, 9>(swk, swv, rowbase, h, tok0, qf, m, l, o, l15, quad);
    dil_branch<4, 12>(swk, swv, rowbase, h, tok0, qf, m, l, o, l15, quad);
    dil_branch<1, 24>(swk, swv, rowbase, h, tok0, qf, m, l, o, l15, quad);
    l += __shfl_xor(l, 16); l += __shfl_xor(l, 32);
    const float il = 1.f / l;
    u32x4 w0, w1;
    w0[0] = pack2(o[0][0] * il, o[1][0] * il); w0[1] = pack2(o[2][0] * il, o[3][0] * il);
    w0[2] = pack2(o[0][1] * il, o[1][1] * il); w0[3] = pack2(o[2][1] * il, o[3][1] * il);
    w1[0] = pack2(o[0][2] * il, o[1][2] * il); w1[1] = pack2(o[2][2] * il, o[3][2] * il);
    w1[2] = pack2(o[0][3] * il, o[1][3] * il); w1[3] = pack2(o[2][3] * il, o[3][3] * il);
    *(u32x4*)(swq + tq * 512 + h * 64 + quad * 16) = w0;
    *(u32x4*)(swq + tq * 512 + h * 64 + quad * 16 + 8) = w1;
  }
}

DI void phase_xo(const Params& p, int l, bf16_t* smem) {
  const bf16_t* wc = (const bf16_t*)(p.ws + OFF_W) + (size_t)l * SZ_COMMON + 3 * SZ_SQ;
  PlainLoad al{(const bf16_t*)(p.ws + OFF_XO), 1024}, bl{wc, 1024};
  {
    gemm_stream(256, 8, 16, al, bl, [&](f32x4 (&acc)[4][4], int rb, int cb) { epi_resid(p, acc, rb, cb); }, smem);
  }
}

DI void phase_ffn_gu(const Params& p, int l, bf16_t* smem) {
  const bf16_t* W = (const bf16_t*)(p.ws + OFF_W) + (size_t)l * SZ_COMMON + 4 * SZ_SQ;
  PlainLoad al{(const bf16_t*)(p.ws + OFF_HB), 1024}, bl{W, 1024};
  bf16_t* act = (bf16_t*)(p.ws + OFF_ACT);
  {
    gemm_stream(256, 44, 16, al, bl, [&](f32x4 (&acc)[4][4], int rb, int cb) {
      const int lane = TID() & 63, l15 = lane & 15, quad = lane >> 4;
#pragma unroll
      for (int mt = 0; mt < 4; ++mt)
#pragma unroll
        for (int np = 0; np < 2; ++np) {
          u32x2 v;
          v[0] = pack2(siluf_(acc[mt][2 * np][0]) * acc[mt][2 * np + 1][0], siluf_(acc[mt][2 * np][1]) * acc[mt][2 * np + 1][1]);
          v[1] = pack2(siluf_(acc[mt][2 * np][2]) * acc[mt][2 * np + 1][2], siluf_(acc[mt][2 * np][3]) * acc[mt][2 * np + 1][3]);
          *(u32x2*)(act + (size_t)(rb + mt * 16 + l15) * 2816 + (cb >> 1) + np * 16 + quad * 4) = v;
        }
    }, smem);
  }
}
DI void phase_ffn_down(const Params& p, int l, bf16_t* smem) {
  const bf16_t* W = (const bf16_t*)(p.ws + OFF_W) + (size_t)l * SZ_COMMON + 4 * SZ_SQ + SZ_GU;
  PlainLoad al{(const bf16_t*)(p.ws + OFF_ACT), 2816}, bl{W, 2816};
  {
    gemm_stream(256, 8, 44, al, bl, [&](f32x4 (&acc)[4][4], int rb, int cb) { epi_resid(p, acc, rb, cb); }, smem);
  }
}


#define XB_TMO      128
#define XB_XCNT(j)  (256  + 64 * (j))
#define XB_XSUB(j)  (1280 + 64 * (j))
#define XB_XGEN(j)  (2304 + 64 * (j))
#define XB_TOP      3328
#define XB_TOPGEN   3392
#define XCD_BAR_WORDS 3456
#define XB_SPIN_CAP (1u << 22)
#define LAS __attribute__((address_space(3)))
DI unsigned xb_ld(unsigned* p) { return __hip_atomic_load(p, __ATOMIC_RELAXED, __HIP_MEMORY_SCOPE_AGENT); }
DI unsigned xb_add(unsigned* p, unsigned v) { return __hip_atomic_fetch_add(p, v, __ATOMIC_RELAXED, __HIP_MEMORY_SCOPE_AGENT); }
DI unsigned xb_xcc_id() { return (unsigned)__builtin_amdgcn_s_getreg((3 << 11) | 20) & 0xFu; }
#define XB_SPIN(cond, bar) do { unsigned _sp = 0; while (cond) { __builtin_amdgcn_s_sleep(1); \
    if ((++_sp & 255u) == 0u) { if (xb_ld(&(bar)[XB_TMO])) break; if (_sp > XB_SPIN_CAP) { atomicAdd(&(bar)[XB_TMO], 1u); break; } } } } while (0)
struct XcdBarrier { unsigned* bar; unsigned x; volatile LAS unsigned* st; };
DI XcdBarrier xcd_barrier_post(unsigned* bar, volatile LAS unsigned* st) {
  XcdBarrier b; b.bar = bar; b.x = xb_xcc_id(); b.st = st;
  if (threadIdx.x == 0) (void)xb_add(&bar[XB_XCNT(b.x)], 1u);
  return b;
}
DI void xcd_barrier_complete(unsigned* bar, unsigned x, unsigned& nloc, unsigned& nx) {
  const unsigned G = gridDim.x * gridDim.y * gridDim.z;
  unsigned sum, cnt, mine, sp = 0u;
  for (;;) {
    sum = 0u; cnt = 0u; mine = 0u;
#pragma unroll
    for (unsigned j = 0; j < 16; ++j) { const unsigned c = xb_ld(&bar[XB_XCNT(j)]); sum += c; cnt += (c > 0u) ? 1u : 0u; mine = (j == x) ? c : mine; }
    if (sum == G) break;
    __builtin_amdgcn_s_sleep(1);
    if ((++sp & 255u) == 0u) { if (xb_ld(&bar[XB_TMO])) break; if (sp > XB_SPIN_CAP) { atomicAdd(&bar[XB_TMO], 1u); break; } }
  }
  nloc = mine > 0u ? mine : 1u; nx = cnt > 0u ? cnt : 1u;
}
DI void xcd_barrier(const XcdBarrier& b) {
  asm volatile("s_waitcnt vmcnt(0)" ::: "memory");
  __syncthreads();
  if (threadIdx.x == 0) {
    unsigned* bar = b.bar;
    __builtin_amdgcn_s_waitcnt(0);
    unsigned nloc = b.st[0], nx = b.st[1];
    if (nloc == 0u) { xcd_barrier_complete(bar, b.x, nloc, nx); b.st[0] = nloc; b.st[1] = nx; }
    const unsigned old = xb_add(&bar[XB_XSUB(b.x)], 1u);
    const unsigned gen = old / nloc;
    if (old + 1u == (gen + 1u) * nloc) {
      __builtin_amdgcn_fence(__ATOMIC_RELEASE, "agent");
      asm volatile("s_waitcnt vmcnt(0)" ::: "memory");
      const unsigned og = xb_add(&bar[XB_TOP], 1u);
      const unsigned tg = og / nx;
      if (og + 1u == (tg + 1u) * nx) xb_add(&bar[XB_TOPGEN], 1u);
      else XB_SPIN(xb_ld(&bar[XB_TOPGEN]) == tg, bar);
      __builtin_amdgcn_fence(__ATOMIC_ACQUIRE, "agent");
      xb_add(&bar[XB_XGEN(b.x)], 1u);
      asm volatile("s_waitcnt vmcnt(0)" ::: "memory");
    } else {
      XB_SPIN(xb_ld(&bar[XB_XGEN(b.x)]) == gen, bar);
      __builtin_amdgcn_fence(__ATOMIC_ACQUIRE, "agent");
      asm volatile("s_waitcnt vmcnt(0)" ::: "memory");
    }
  }
  __syncthreads();
}

__global__ void __launch_bounds__(256, 2) fwd_megakernel(Params p) {
  cg::grid_group grid = cg::this_grid();
  __shared__ __attribute__((aligned(16))) char smem_raw[2 * 2 * 128 * LDT * 2];
  bf16_t* sm16 = (bf16_t*)smem_raw; float* sm32 = (float*)smem_raw;

  __shared__ uint4 xb_words;
  if (threadIdx.x == 0) xb_words = make_uint4(0u, 0u, 0u, 0u);
  __syncthreads();
  XcdBarrier xb = xcd_barrier_post((unsigned*)(p.ws + OFF_BAR), (volatile LAS unsigned*)&xb_words);
  phase_prologue(p, sm32);
  grid.sync();
  for (int l = 0; l < 4; ++l) {
    const int i = l >> 1;
    if ((l & 1) == 0) {
      phase_proj(p, i, sm16); xcd_barrier(xb);
      phase_dn_prep(p, i, smem_raw); xcd_barrier(xb);
      phase_mix(p, i, sm16); xcd_barrier(xb);
      phase_dn_post(p, i); xcd_barrier(xb);
      phase_wout(p, i, sm16); xcd_barrier(xb);
    } else {
#if USE_S5_GEMM
      phase_s5_tables(p, i, sm32); xcd_barrier(xb);
      phase_s5_end(p, sm16); xcd_barrier(xb);
      phase_s5_y(p, i, sm16); xcd_barrier(xb);
#else
      phase_s5_naive(p, i); xcd_barrier(xb);
#endif
      phase_glu(p, i, sm16); xcd_barrier(xb);
    }
    phase_ln(p, p.ln_mix_g + l * 1024, p.ln_mix_b + l * 1024); xcd_barrier(xb);
    phase_xproj(p, l, sm16); xcd_barrier(xb);
    phase_xattn(p, sm16); xcd_barrier(xb);
    phase_xo(p, l, sm16); xcd_barrier(xb);
    phase_ln(p, p.ln_x_g + l * 1024, p.ln_x_b + l * 1024); xcd_barrier(xb);
    phase_ffn_gu(p, l, sm16); xcd_barrier(xb);
    phase_ffn_down(p, l, sm16); xcd_barrier(xb);
    phase_ln(p, p.ln_ffn_g + l * 1024, p.ln_ffn_b + l * 1024); xcd_barrier(xb);
  }
}

extern "C" void kernel_launch(void* const* d_in, const int* in_sizes, int n_in, void* d_out, int out_size, void* d_ws, size_t ws_size,
                              hipStream_t stream) {
  static int grid_blocks = 0;
  if (!grid_blocks) {
    int dev = 0, cus = 0, per_cu = 0;
    hipGetDevice(&dev);
    hipDeviceGetAttribute(&cus, hipDeviceAttributeMultiprocessorCount, dev);
    hipOccupancyMaxActiveBlocksPerMultiprocessor(&per_cu, fwd_megakernel, 256, 0);
    if (per_cu > 2) per_cu = 2;
    if (per_cu < 1) per_cu = 1;
    grid_blocks = cus * per_cu;
    grid_blocks -= grid_blocks % 8;
  }
  Params p{};
  const float** pf = (const float**)&p;
  for (int i = 0; i < 32; ++i) pf[i] = (const float*)d_in[i];
  p.pos = (const int*)d_in[2];
  p.out = (float*)d_out; p.ws = (char*)d_ws;
  hipMemsetAsync((char*)d_ws + OFF_BAR, 0, XCD_BAR_WORDS * sizeof(unsigned), stream);
  void* args[] = {&p};
  hipError_t e = hipLaunchCooperativeKernel((void*)fwd_megakernel, dim3(grid_blocks), dim3(256), args, 0, stream);
  if (e != hipSuccess) fprintf(stderr, "cooperative launch failed: %s (grid %d)\n", hipGetErrorString(e), grid_blocks);
}
```

```cpp
#include <hip/hip_runtime.h>
#include <hip/hip_cooperative_groups.h>
#include <cstdio>
namespace cg = cooperative_groups;
#ifndef USE_XATTN_MFMA
#define USE_XATTN_MFMA 1
#endif
#ifndef USE_S5_GEMM
#define USE_S5_GEMM 1
#endif
#ifndef USE_DIL_MFMA
#define USE_DIL_MFMA 1
#endif

typedef unsigned short bf16_t;
using bf16x8 = __attribute__((ext_vector_type(8))) short;
using f32x4 = __attribute__((ext_vector_type(4))) float;
#define DI __device__ __forceinline__

constexpr int T_ = 32768, S_ = 4096;
constexpr size_t MiB = (size_t)1 << 20;
constexpr size_t SZ_SQ = (size_t)1024 * 1024, SZ_WIN = (size_t)3712 * 1024, SZ_GLU = (size_t)2048 * 1024,
                 SZ_GU = (size_t)5632 * 1024, SZ_WD = (size_t)1024 * 2816;
constexpr size_t SZ_COMMON = 4 * SZ_SQ + SZ_GU + SZ_WD;
constexpr size_t W_EVEN0 = 4 * SZ_COMMON;
constexpr size_t W_ODD0 = W_EVEN0 + 2 * (SZ_WIN + SZ_SQ);
constexpr float ALPHA = 1.681792830507429f;

constexpr size_t OFF_W = 0;
constexpr size_t OFF_ROPE = 125 * MiB;
constexpr size_t OFF_HB = 133 * MiB;
constexpr size_t OFF_KX = 197 * MiB;
constexpr size_t OFF_VX = 201 * MiB;
constexpr size_t OFF_BIG = 205 * MiB;
constexpr size_t OFF_BAR = 511 * MiB;
constexpr size_t OFF_DNQKV = OFF_BIG;
constexpr size_t OFF_Z = OFF_BIG + 96 * MiB;
constexpr size_t OFF_SWQ = OFF_BIG + 128 * MiB;
constexpr size_t OFF_SWK = OFF_BIG + 160 * MiB;
constexpr size_t OFF_SWV = OFF_BIG + 192 * MiB;
constexpr size_t OFF_LOGIT = OFF_BIG + 224 * MiB;
constexpr size_t OFF_QD = OFF_BIG + 225 * MiB;
constexpr size_t OFF_KD = OFF_BIG + 257 * MiB;
constexpr size_t OFF_INTRA = OFF_BIG + 289 * MiB;
constexpr size_t OFF_WB = OFF_HB;
constexpr size_t OFF_UB = OFF_HB + 32 * MiB;
constexpr size_t OFF_EG = OFF_KX;
constexpr size_t OFF_XQ = OFF_BIG;
constexpr size_t OFF_XO = OFF_BIG + 64 * MiB;
constexpr size_t OFF_ACT = OFF_BIG;
constexpr size_t OFF_HID = OFF_BIG;
constexpr size_t OFF_SIN = OFF_BIG + 64 * MiB;
constexpr size_t OFF_KTAB = OFF_BIG + 80 * MiB;
constexpr size_t OFF_ETAB = OFF_BIG + 82 * MiB;
constexpr size_t OFF_GTAB = OFF_BIG + 90 * MiB;
constexpr size_t OFF_AL = OFF_BIG + 98 * MiB;

struct Params {
  const float* x; const float* mem; const int* pos;
  const float* hyb_w_in; const float* dn_conv_w; const float* dn_a_log; const float* dn_dt_bias; const float* dn_norm_g; const float* hyb_w_out;
  const float* s5_a_re; const float* s5_a_im; const float* s5_log_dt; const float* s5_b_re; const float* s5_b_im; const float* s5_c_re; const float* s5_c_im;
  const float* s5_d; const float* s5_glu_wo; const float* s5_glu_wg;
  const float* ln_mix_g; const float* ln_mix_b;
  const float* xq_w; const float* xk_w; const float* xv_w; const float* xo_w; const float* ln_x_g; const float* ln_x_b;
  const float* ffn_wg; const float* ffn_wu; const float* ffn_wd; const float* ln_ffn_g; const float* ln_ffn_b;
  float* out; char* ws;
};

DI int TID() { int t = threadIdx.x; asm volatile("" : "+v"(t)); return t; }
DI int BID() { int t = blockIdx.x; asm volatile("" : "+s"(t)); return t; }
DI int GDIM() { int t = gridDim.x; asm volatile("" : "+s"(t)); return t; }
typedef float f32x2_t __attribute__((ext_vector_type(2)));
typedef __bf16 bf16x2_t __attribute__((ext_vector_type(2)));
DI bf16_t f2bf(float x) { return __builtin_bit_cast(bf16_t, (__bf16)x); }
DI float bf2f(bf16_t v) { return __uint_as_float(((unsigned)v) << 16); }
DI unsigned pack2(float a, float b) { f32x2_t v = {a, b}; return __builtin_bit_cast(unsigned, __builtin_convertvector(v, bf16x2_t)); }
using u32x4 = __attribute__((ext_vector_type(4))) unsigned;
using u32x2 = __attribute__((ext_vector_type(2))) unsigned;
DI bf16x8 pack8(f32x4 a, f32x4 b) {
  u32x4 t; t[0] = pack2(a[0], a[1]); t[1] = pack2(a[2], a[3]); t[2] = pack2(b[0], b[1]); t[3] = pack2(b[2], b[3]);
  return __builtin_bit_cast(bf16x8, t);
}
#define MFMA16(a, b, c) __builtin_amdgcn_mfma_f32_16x16x32_bf16((a), (b), (c), 0, 0, 0)
DI int kperm(int x) { return (x & ~31) | (((x >> 2) & 3) * 8 + ((x >> 4) & 1) * 4 + (x & 3)); }
DI float wave_sum(float v) { for (int o = 32; o > 0; o >>= 1) v += __shfl_xor(v, o); return v; }
DI float wave_max(float v) { for (int o = 32; o > 0; o >>= 1) v = fmaxf(v, __shfl_xor(v, o)); return v; }
DI float sigmoidf_(float x) { return __builtin_amdgcn_rcpf(1.f + __expf(-x)); }
DI float siluf_(float x) { return x * sigmoidf_(x); }
DI float softplusf_(float x) { return fmaxf(x, 0.f) + log1pf(__expf(-fabsf(x))); }
DI float gelu_tanh(float x) { float u = 0.7978845608028654f * (x + 0.044715f * x * x * x); return 0.5f * x * (1.f + tanhf(u)); }

template <class CM>
DI void transpose_job(bf16_t* dst, int Ndst, int K, int srcStride, CM colptr, float* tile) {
  const int ntk = K / 64, ntiles = (Ndst / 64) * ntk;
  const int tid = TID();
  for (int tl = BID(); tl < ntiles; tl += GDIM()) {
    const int r0 = (tl / ntk) * 64, k0 = (tl % ntk) * 64;
    const int q4 = tid & 15, kl0 = tid >> 4;
    const float* cp = colptr(r0 + 4 * q4);
    float4 v[4];
#pragma unroll
    for (int i = 0; i < 4; ++i) v[i] = cp ? *(const float4*)(cp + (size_t)(k0 + kl0 + 16 * i) * srcStride) : make_float4(0.f, 0.f, 0.f, 0.f);
#pragma unroll
    for (int i = 0; i < 4; ++i) {
      float* t = tile + (kl0 + 16 * i) * 65 + 4 * q4;
      t[0] = v[i].x; t[1] = v[i].y; t[2] = v[i].z; t[3] = v[i].w;
    }
    __syncthreads();
#pragma unroll
    for (int i = 0; i < 2; ++i) {
      const int c = tid + 256 * i, rr = c >> 3, kc = (c & 7) * 8;
      const float* t = tile + kc * 65 + rr;
      uint4 o;
      o.x = pack2(t[0], t[65]); o.y = pack2(t[2 * 65], t[3 * 65]); o.z = pack2(t[4 * 65], t[5 * 65]); o.w = pack2(t[6 * 65], t[7 * 65]);
      *(uint4*)(dst + (size_t)(r0 + rr) * K + k0 + kc) = o;
    }
    __syncthreads();
  }
}

DI void phase_prologue(const Params& p, float* smem) {
  bf16_t* W = (bf16_t*)(p.ws + OFF_W);
  for (int l = 0; l < 4; ++l) {
    bf16_t* wc = W + (size_t)l * SZ_COMMON;
    const float* s;
    s = p.xq_w + (size_t)l * SZ_SQ; transpose_job(wc, 1024, 1024, 1024, [=](int r) { return s + r; }, smem);
    s = p.xk_w + (size_t)l * SZ_SQ; transpose_job(wc + SZ_SQ, 1024, 1024, 1024, [=](int r) { return s + r; }, smem);
    s = p.xv_w + (size_t)l * SZ_SQ; transpose_job(wc + 2 * SZ_SQ, 1024, 1024, 1024, [=](int r) { return s + r; }, smem);
    s = p.xo_w + (size_t)l * SZ_SQ; transpose_job(wc + 3 * SZ_SQ, 1024, 1024, 1024, [=](int r) { return s + r; }, smem);
    {
      const float* g = p.ffn_wg + (size_t)l * 1024 * 2816; const float* u = p.ffn_wu + (size_t)l * 1024 * 2816;
      transpose_job(wc + 4 * SZ_SQ, 5632, 1024, 2816, [=](int r) { int c = (r >> 5) * 16 + (r & 15); return ((r >> 4) & 1) ? (u + c) : (g + c); }, smem);
    }
    s = p.ffn_wd + (size_t)l * 2816 * 1024; transpose_job(wc + 4 * SZ_SQ + SZ_GU, 1024, 2816, 1024, [=](int r) { return s + r; }, smem);
  }
  for (int i = 0; i < 2; ++i) {
    bf16_t* we = W + W_EVEN0 + (size_t)i * (SZ_WIN + SZ_SQ);
    const float* s = p.hyb_w_in + (size_t)i * 1024 * 3592;
    transpose_job(we, 3712, 1024, 3592, [=](int r) -> const float* {
      if (r < 2048) return s + r;
      if (r < 3584) return s + r + 8;
      if (r < 3592) return s + 2048 + (r - 3584);
      return nullptr; }, smem);
    const float* s2 = p.hyb_w_out + (size_t)i * SZ_SQ;
    transpose_job(we + SZ_WIN, 1024, 1024, 1024, [=](int r) { return s2 + r; }, smem);
    bf16_t* wo = W + W_ODD0 + (size_t)i * SZ_GLU;
    const float* a = p.s5_glu_wo + (size_t)i * SZ_SQ; const float* b = p.s5_glu_wg + (size_t)i * SZ_SQ;
    transpose_job(wo, 2048, 1024, 1024, [=](int r) { int c = (r >> 5) * 16 + (r & 15); return ((r >> 4) & 1) ? (b + c) : (a + c); }, smem);
  }
  const size_t gtid = (size_t)BID() * 256 + TID(), gsz = (size_t)GDIM() * 256;
  bf16_t* hb = (bf16_t*)(p.ws + OFF_HB);
  for (size_t i = gtid; i < (size_t)T_ * 256; i += gsz) {
    float4 v = ((const float4*)p.x)[i];
    ((float4*)p.out)[i] = v;
    uint2 o; o.x = pack2(v.x, v.y); o.y = pack2(v.z, v.w);
    ((uint2*)hb)[i] = o;
  }
  float* rc = (float*)(p.ws + OFF_ROPE); float* rs = rc + (size_t)T_ * 32;
  for (size_t i = gtid; i < (size_t)T_ * 32; i += gsz) {
    int t = (int)(i >> 5), j = (int)(i & 31);
    float invf = (float)exp(-(double)(2 * j) / 64.0 * 9.210340371976184);
    float ang = (float)p.pos[t] * invf;
    double a = (double)ang;
    double k = rint(a * 0.15915494309189535);
    float r = (float)(a - k * 6.283185307179586);
    rc[i] = cosf(r); rs[i] = sinf(r);
  }
}

constexpr int LDT = 72;
template <class AL, class BL, class EP>
DI void gemm_tile(int m0, int n0, int nks, AL aload, BL bload, EP epi, bf16_t* smem) {
  bf16_t* As = smem; bf16_t* Bs = smem + 2 * 128 * LDT;
  const int tid = TID(), lane = tid & 63, wave = tid >> 6;
  const int wm = wave >> 1, wn = wave & 1, l15 = lane & 15, quad = lane >> 4;
  const int lrow = tid >> 3, lkc = (tid & 7) * 8;
  f32x4 acc[4][4];
#pragma unroll
  for (int i = 0; i < 4; ++i)
#pragma unroll
    for (int j = 0; j < 4; ++j) acc[i][j] = f32x4{0.f, 0.f, 0.f, 0.f};
  uint4 ra0[4], rb0[4], ra1[4], rb1[4];
#pragma unroll
  for (int i = 0; i < 4; ++i) { ra0[i] = aload(m0 + lrow + 32 * i, 0, lkc); rb0[i] = bload(n0 + lrow + 32 * i, 0, lkc); }
#pragma unroll
  for (int i = 0; i < 4; ++i) { ra1[i] = aload(m0 + lrow + 32 * i, 1, lkc); rb1[i] = bload(n0 + lrow + 32 * i, 1, lkc); }
#pragma unroll
  for (int i = 0; i < 4; ++i) {
    *(uint4*)(As + (lrow + 32 * i) * LDT + lkc) = ra0[i];
    *(uint4*)(Bs + (lrow + 32 * i) * LDT + lkc) = rb0[i];
  }
  __syncthreads();
  auto compute = [&](int cur) {
    const bf16_t* Ab = As + cur * 128 * LDT; const bf16_t* Bb = Bs + cur * 128 * LDT;
#pragma unroll
    for (int kk = 0; kk < 2; ++kk) {
      bf16x8 a[4], b[4];
#pragma unroll
      for (int mt = 0; mt < 4; ++mt) a[mt] = *(const bf16x8*)(Ab + (wm * 64 + mt * 16 + l15) * LDT + kk * 32 + quad * 8);
#pragma unroll
      for (int nt = 0; nt < 4; ++nt) b[nt] = *(const bf16x8*)(Bb + (wn * 64 + nt * 16 + l15) * LDT + kk * 32 + quad * 8);
#pragma unroll
      for (int mt = 0; mt < 4; ++mt)
#pragma unroll
        for (int nt = 0; nt < 4; ++nt) acc[mt][nt] = __builtin_amdgcn_mfma_f32_16x16x32_bf16(b[nt], a[mt], acc[mt][nt], 0, 0, 0);
    }
  };
  for (int ks = 0; ks < nks; ks += 2) {
    {
      const int kq = (ks + 2 < nks) ? ks + 2 : 0;
#pragma unroll
      for (int i = 0; i < 4; ++i) { ra0[i] = aload(m0 + lrow + 32 * i, kq, lkc); rb0[i] = bload(n0 + lrow + 32 * i, kq, lkc); }
    }
    compute(0);
#pragma unroll
    for (int i = 0; i < 4; ++i) {
      *(uint4*)(As + 128 * LDT + (lrow + 32 * i) * LDT + lkc) = ra1[i];
      *(uint4*)(Bs + 128 * LDT + (lrow + 32 * i) * LDT + lkc) = rb1[i];
    }
    __syncthreads();
    {
      const int kq = (ks + 3 < nks) ? ks + 3 : 1;
#pragma unroll
      for (int i = 0; i < 4; ++i) { ra1[i] = aload(m0 + lrow + 32 * i, kq, lkc); rb1[i] = bload(n0 + lrow + 32 * i, kq, lkc); }
    }
    compute(1);
#pragma unroll
    for (int i = 0; i < 4; ++i) {
      *(uint4*)(As + (lrow + 32 * i) * LDT + lkc) = ra0[i];
      *(uint4*)(Bs + (lrow + 32 * i) * LDT + lkc) = rb0[i];
    }
    __syncthreads();
  }
  epi(acc, m0 + wm * 64, n0 + wn * 64);
}

DI void tile_of(int w, int mtiles, int ntiles, int xcd, int& m0, int& n0) {
  const int mper = mtiles >> 3, full = mper * 8;
  int gidx = w / full;
  const int ngroups = (ntiles + 7) >> 3;
  if (gidx > ngroups - 1) gidx = ngroups - 1;
  const int rest = w - gidx * full;
  const int wg = min(8, ntiles - 8 * gidx);
  const int ml = rest / wg, ni = 8 * gidx + (rest - ml * wg);
  m0 = (ml * 8 + xcd) * 128; n0 = ni * 128;
}
template <class AL, class BL, class EP>
DI void gemm_stream(int mtiles, int ntiles, int nks, AL aload, BL bload, EP epi, bf16_t* smem) {
  const int xcd = BID() & 7, slot = BID() >> 3, nslot = GDIM() >> 3;
  const int per = (mtiles >> 3) * ntiles;
  if (slot >= per) return;
  bf16_t* As = smem; bf16_t* Bs = smem + 2 * 128 * LDT;
  const int tid = TID(), lane = tid & 63, wave = tid >> 6;
  const int wm = wave >> 1, wc = wave & 1, l15 = lane & 15, quad = lane >> 4;
  const int lrow = tid >> 3, lkc = (tid & 7) * 8;
  f32x4 acc[4][4];
  uint4 ra0[4], rb0[4], ra1[4], rb1[4];
  int w = slot;
  int m0, n0;
  tile_of(w, mtiles, ntiles, xcd, m0, n0);
#pragma unroll
  for (int i = 0; i < 4; ++i) { ra0[i] = aload(m0 + lrow + 32 * i, 0, lkc); rb0[i] = bload(n0 + lrow + 32 * i, 0, lkc); }
#pragma unroll
  for (int i = 0; i < 4; ++i) { ra1[i] = aload(m0 + lrow + 32 * i, 1, lkc); rb1[i] = bload(n0 + lrow + 32 * i, 1, lkc); }
#pragma unroll
  for (int i = 0; i < 4; ++i) {
    *(uint4*)(As + (lrow + 32 * i) * LDT + lkc) = ra0[i];
    *(uint4*)(Bs + (lrow + 32 * i) * LDT + lkc) = rb0[i];
  }
  __syncthreads();
  auto compute = [&](int cur) {
    const bf16_t* Ab = As + cur * 128 * LDT; const bf16_t* Bb = Bs + cur * 128 * LDT;
#pragma unroll
    for (int kk = 0; kk < 2; ++kk) {
      bf16x8 a[4], b[4];
#pragma unroll
      for (int mt = 0; mt < 4; ++mt) a[mt] = *(const bf16x8*)(Ab + (wm * 64 + mt * 16 + l15) * LDT + kk * 32 + quad * 8);
#pragma unroll
      for (int nt = 0; nt < 4; ++nt) b[nt] = *(const bf16x8*)(Bb + (wc * 64 + nt * 16 + l15) * LDT + kk * 32 + quad * 8);
      __builtin_amdgcn_s_setprio(2);
#pragma unroll
      for (int mt = 0; mt < 4; ++mt)
#pragma unroll
        for (int nt = 0; nt < 4; ++nt) acc[mt][nt] = __builtin_amdgcn_mfma_f32_16x16x32_bf16(b[nt], a[mt], acc[mt][nt], 0, 0, 0);
      __builtin_amdgcn_s_setprio(0);
    }
  };
  for (;;) {
    const int wnext = w + nslot;
    const bool has_next = wnext < per;
    int m1 = m0, n1 = n0;
    if (has_next) tile_of(wnext, mtiles, ntiles, xcd, m1, n1);
#pragma unroll
    for (int i = 0; i < 4; ++i)
#pragma unroll
      for (int j = 0; j < 4; ++j) acc[i][j] = f32x4{0.f, 0.f, 0.f, 0.f};
    for (int ks = 0; ks < nks; ks += 2) {
      const bool in2 = ks + 2 < nks;
      {
        const int mm = in2 ? m0 : m1, nn = in2 ? n0 : n1, kq = in2 ? ks + 2 : 0;
#pragma unroll
        for (int i = 0; i < 4; ++i) { ra0[i] = aload(mm + lrow + 32 * i, kq, lkc); rb0[i] = bload(nn + lrow + 32 * i, kq, lkc); }
      }
      compute(0);
#pragma unroll
      for (int i = 0; i < 4; ++i) {
        *(uint4*)(As + 128 * LDT + (lrow + 32 * i) * LDT + lkc) = ra1[i];
        *(uint4*)(Bs + 128 * LDT + (lrow + 32 * i) * LDT + lkc) = rb1[i];
      }
      __syncthreads();
      {
        const int mm = in2 ? m0 : m1, nn = in2 ? n0 : n1, kq = in2 ? ks + 3 : 1;
#pragma unroll
        for (int i = 0; i < 4; ++i) { ra1[i] = aload(mm + lrow + 32 * i, kq, lkc); rb1[i] = bload(nn + lrow + 32 * i, kq, lkc); }
      }
      compute(1);
#pragma unroll
      for (int i = 0; i < 4; ++i) {
        *(uint4*)(As + (lrow + 32 * i) * LDT + lkc) = ra0[i];
        *(uint4*)(Bs + (lrow + 32 * i) * LDT + lkc) = rb0[i];
      }
      __syncthreads();
    }
    epi(acc, m0 + wm * 64, n0 + wc * 64);
    if (!has_next) break;
    w = wnext; m0 = m1; n0 = n1;
  }
}

template <class F>
DI void for_tiles(int mtiles, int ntiles, F f) {
  const int xcd = BID() & 7, slot = BID() >> 3, nslot = GDIM() >> 3;
  const int per = (mtiles >> 3) * ntiles;
  for (int w = slot; w < per; w += nslot) {
    int mi = w / ntiles, ni = w - mi * ntiles;
    f((mi * 8 + xcd), ni);
  }
}

#define EPI_LOOP for (int mt = 0; mt < 4; ++mt) for (int nt = 0; nt < 4; ++nt) for (int r = 0; r < 4; ++r)

DI void epi_resid(const Params& p, f32x4 (&acc)[4][4], int rb, int cb) {
  const int lane = TID() & 63, l15 = lane & 15, quad = lane >> 4;
#pragma unroll
  for (int mt = 0; mt < 4; ++mt)
#pragma unroll
    for (int nt = 0; nt < 4; ++nt) {
      float4* ptr = (float4*)(p.out + (size_t)(rb + mt * 16 + l15) * 1024 + cb + nt * 16 + quad * 4);
      float4 h = *ptr;
      h.x = ALPHA * h.x + acc[mt][nt][0]; h.y = ALPHA * h.y + acc[mt][nt][1]; h.z = ALPHA * h.z + acc[mt][nt][2]; h.w = ALPHA * h.w + acc[mt][nt][3];
      *ptr = h;
    }
}
DI void epi_bf16(bf16_t* dst, int ld, f32x4 (&acc)[4][4], int rb, int cb) {
  const int lane = TID() & 63, l15 = lane & 15, quad = lane >> 4;
#pragma unroll
  for (int mt = 0; mt < 4; ++mt)
#pragma unroll
    for (int nt = 0; nt < 4; ++nt) {
      u32x2 v; v[0] = pack2(acc[mt][nt][0], acc[mt][nt][1]); v[1] = pack2(acc[mt][nt][2], acc[mt][nt][3]);
      *(u32x2*)(dst + (size_t)(rb + mt * 16 + l15) * ld + cb + nt * 16 + quad * 4) = v;
    }
}

struct PlainLoad {
  const bf16_t* base; int ld;
  DI uint4 operator()(int row, int ks, int kc) const { return *(const uint4*)((const char*)base + (unsigned)((row * ld + ks * 64 + kc) * 2)); }
};

DI void phase_proj(const Params& p, int i, bf16_t* smem) {
  const bf16_t* W = (const bf16_t*)(p.ws + OFF_W) + W_EVEN0 + (size_t)i * (SZ_WIN + SZ_SQ);
  PlainLoad al{(const bf16_t*)(p.ws + OFF_HB), 1024}, bl{W, 1024};
  bf16_t* dnqkv = (bf16_t*)(p.ws + OFF_DNQKV); bf16_t* z = (bf16_t*)(p.ws + OFF_Z);
  bf16_t* swq = (bf16_t*)(p.ws + OFF_SWQ); bf16_t* swk = (bf16_t*)(p.ws + OFF_SWK); bf16_t* swv = (bf16_t*)(p.ws + OFF_SWV);
  float* logit = (float*)(p.ws + OFF_LOGIT);
  const float* rc = (const float*)(p.ws + OFF_ROPE); const float* rs = rc + (size_t)T_ * 32;
  {
    gemm_stream(256, 29, 16, al, bl, [&](f32x4 (&acc)[4][4], int rb, int cb) {
      const int lane = TID() & 63, l15 = lane & 15, quad = lane >> 4;
      if (cb < 1536) epi_bf16(dnqkv, 1536, acc, rb, cb);
      else if (cb < 2048) epi_bf16(z, 512, acc, rb, cb - 1536);
      else if (cb < 3072) {
        bf16_t* dst = (cb < 2560) ? swq : swk; const int c0 = (cb < 2560) ? cb - 2048 : cb - 2560;
#pragma unroll
        for (int mt = 0; mt < 4; ++mt) {
          const int row = rb + mt * 16 + l15;
#pragma unroll
          for (int nt = 0; nt < 2; ++nt) {
            const int d = nt * 16 + quad * 4;
            const float4 c = *(const float4*)(rc + (size_t)row * 32 + d), sn = *(const float4*)(rs + (size_t)row * 32 + d);
            const f32x4 x1 = acc[mt][nt], x2 = acc[mt][nt + 2];
            u32x2 o1, o2;
            o1[0] = pack2(x1[0] * c.x - x2[0] * sn.x, x1[1] * c.y - x2[1] * sn.y); o1[1] = pack2(x1[2] * c.z - x2[2] * sn.z, x1[3] * c.w - x2[3] * sn.w);
            o2[0] = pack2(x2[0] * c.x + x1[0] * sn.x, x2[1] * c.y + x1[1] * sn.y); o2[1] = pack2(x2[2] * c.z + x1[2] * sn.z, x2[3] * c.w + x1[3] * sn.w);
            *(u32x2*)(dst + (size_t)row * 512 + c0 + d) = o1;
            *(u32x2*)(dst + (size_t)row * 512 + c0 + d + 32) = o2;
          }
        }
      } else if (cb < 3584) epi_bf16(swv, 512, acc, rb, cb - 3072);
      else if (cb == 3584) {
        if (quad < 2) {
#pragma unroll
          for (int mt = 0; mt < 4; ++mt)
            *(float4*)(logit + (size_t)(rb + mt * 16 + l15) * 8 + quad * 4) = make_float4(acc[mt][0][0], acc[mt][0][1], acc[mt][0][2], acc[mt][0][3]);
        }
      }
    }, smem);
  }
}

DI void phase_dil_attn(const Params& p, int first, int nblk);

DI void phase_dn_prep(const Params& p, int i, char* smem) {
  bf16_t* qs = (bf16_t*)smem; bf16_t* ks = qs + 64 * 136; bf16_t* vs = ks + 64 * 136;
  float* Lm = (float*)(smem + 3 * 17408); float* beta = Lm + 64 * 68; float* gcum = beta + 64; float* egc = gcum + 64;
  const bf16_t* dnqkv = (const bf16_t*)(p.ws + OFF_DNQKV);
  const float* logit = (const float*)(p.ws + OFF_LOGIT);
  bf16_t* qd_g = (bf16_t*)(p.ws + OFF_QD); bf16_t* kd_g = (bf16_t*)(p.ws + OFF_KD); bf16_t* in_g = (bf16_t*)(p.ws + OFF_INTRA);
  bf16_t* w_g = (bf16_t*)(p.ws + OFF_WB); bf16_t* u_g = (bf16_t*)(p.ws + OFF_UB); float* eg_g = (float*)(p.ws + OFF_EG);
  const float* cw = p.dn_conv_w + (size_t)i * 4 * 1536;
  const int tid = TID(), wave = tid >> 6, lane = tid & 63, l15 = lane & 15, quad = lane >> 4;
  const float QS = 0.08838834764831845f;
  for (int item = BID(); item < 2048; item += GDIM()) {
    const int b = item >> 8, h = (item >> 6) & 3, n = item & 63;
    const int t0 = b * 4096 + n * 64, s0 = n * 64;
    const float A = __expf(p.dn_a_log[i * 4 + h]), dtb = p.dn_dt_bias[i * 4 + h];
    {
      float cw0[3][4], cw1[3][4], x0[3][4], x1[3][4];
#pragma unroll
      for (int which = 0; which < 3; ++which)
#pragma unroll
        for (int j = 0; j < 4; ++j) {
          const int col = which * 512 + h * 128 + lane * 2;
          cw0[which][j] = cw[j * 1536 + col]; cw1[which][j] = cw[j * 1536 + col + 1];
        }
      const int ilb = wave * 16;
#pragma unroll
      for (int which = 0; which < 3; ++which)
#pragma unroll
        for (int j = 0; j < 3; ++j) {
          const int sq = s0 + ilb - 3 + j;
          unsigned v = 0u;
          if (sq >= 0) v = *(const unsigned*)(dnqkv + (size_t)(t0 + ilb - 3 + j) * 1536 + which * 512 + h * 128 + lane * 2);
          x0[which][j + 1] = bf2f((bf16_t)(v & 0xffff)); x1[which][j + 1] = bf2f((bf16_t)(v >> 16));
        }
#pragma unroll 4
      for (int tt = 0; tt < 16; ++tt) {
        const int il = ilb + tt;
#pragma unroll
        for (int which = 0; which < 3; ++which) {
          x0[which][0] = x0[which][1]; x0[which][1] = x0[which][2]; x0[which][2] = x0[which][3];
          x1[which][0] = x1[which][1]; x1[which][1] = x1[which][2]; x1[which][2] = x1[which][3];
          const unsigned v = *(const unsigned*)(dnqkv + (size_t)(t0 + il) * 1536 + which * 512 + h * 128 + lane * 2);
          x0[which][3] = bf2f((bf16_t)(v & 0xffff)); x1[which][3] = bf2f((bf16_t)(v >> 16));
          float y0 = cw0[which][0] * x0[which][0] + cw0[which][1] * x0[which][1] + cw0[which][2] * x0[which][2] + cw0[which][3] * x0[which][3];
          float y1 = cw1[which][0] * x1[which][0] + cw1[which][1] * x1[which][1] + cw1[which][2] * x1[which][2] + cw1[which][3] * x1[which][3];
          y0 = siluf_(y0); y1 = siluf_(y1);
          if (which < 2) {
            float ss = wave_sum(y0 * y0 + y1 * y1);
            float sc = rsqrtf(ss + 1e-6f);
            y0 *= sc; y1 *= sc;
          }
          bf16_t* dst = (which == 0) ? qs : (which == 1 ? ks : vs);
          *(unsigned*)(dst + il * 136 + lane * 2) = pack2(y0, y1);
        }
      }
    }
    if (wave == 0) {
      const size_t row = (size_t)(t0 + lane);
      const float bl = logit[row * 8 + h], al = logit[row * 8 + 4 + h];
      float g = -A * softplusf_(al + dtb);
#pragma unroll
      for (int o = 1; o < 64; o <<= 1) { float v = __shfl_up(g, o); if (lane >= o) g += v; }
      beta[lane] = sigmoidf_(bl); gcum[lane] = g; egc[lane] = __expf(g);
    }
    __syncthreads();
    {
      f32x4 kk[4], qk[4];
#pragma unroll
      for (int nt = 0; nt < 4; ++nt) { kk[nt] = f32x4{0.f, 0.f, 0.f, 0.f}; qk[nt] = f32x4{0.f, 0.f, 0.f, 0.f}; }
#pragma unroll
      for (int k4 = 0; k4 < 4; ++k4) {
        const bf16x8 ak = *(const bf16x8*)(ks + (wave * 16 + l15) * 136 + k4 * 32 + quad * 8);
        const bf16x8 aq = *(const bf16x8*)(qs + (wave * 16 + l15) * 136 + k4 * 32 + quad * 8);
#pragma unroll
        for (int nt = 0; nt < 4; ++nt) {
          const bf16x8 bk = *(const bf16x8*)(ks + (nt * 16 + l15) * 136 + k4 * 32 + quad * 8);
          kk[nt] = MFMA16(ak, bk, kk[nt]); qk[nt] = MFMA16(aq, bk, qk[nt]);
        }
      }
#pragma unroll
      for (int nt = 0; nt < 4; ++nt)
#pragma unroll
        for (int r = 0; r < 4; ++r) {
          const int ii = wave * 16 + quad * 4 + r, jj = nt * 16 + l15;
          const float dec = (jj <= ii) ? __expf(gcum[ii] - gcum[jj]) : 0.f;
          Lm[ii * 68 + jj] = (jj < ii) ? beta[ii] * kk[nt][r] * dec : 0.f;
          in_g[(size_t)item * 4096 + ii * 64 + kperm(jj)] = f2bf(qk[nt][r] * QS * dec);
        }
    }
    __syncthreads();
    {
      float x[64];
#pragma unroll
      for (int ii = 0; ii < 64; ++ii) x[ii] = 0.f;
      const int c = tid & 127;
      const bool isw = tid >= 128;
      bf16_t* dstb = (isw ? w_g : u_g) + (size_t)item * 8192 + (isw ? kperm(c) : c);
      const bf16_t* srcb = (isw ? ks : vs) + c;
#pragma unroll
      for (int ii = 0; ii < 64; ++ii) {
        float acc = bf2f(srcb[ii * 136]) * beta[ii] * (isw ? egc[ii] : 1.f);
#pragma unroll
        for (int j4 = 0; j4 < (ii + 3) / 4; ++j4) {
          const float4 l4 = *(const float4*)(Lm + ii * 68 + j4 * 4);
          acc -= l4.x * x[j4 * 4]; acc -= l4.y * x[j4 * 4 + 1]; acc -= l4.z * x[j4 * 4 + 2]; acc -= l4.w * x[j4 * 4 + 3];
        }
        x[ii] = acc;
        dstb[ii * 128] = f2bf(acc);
        if ((ii & 3) == 3) __builtin_amdgcn_sched_barrier(0);
      }
    }
    {
      const float gl = gcum[63];
#pragma unroll 4
      for (int k = 0; k < 32; ++k) {
        const int e = tid + 256 * k;
        const int ii = e >> 7, d = e & 127;
        qd_g[(size_t)item * 8192 + ii * 128 + kperm(d)] = f2bf(bf2f(qs[ii * 136 + d]) * QS * egc[ii]);
        const int d2 = e >> 6, i2 = e & 63;
        kd_g[(size_t)item * 8192 + d2 * 64 + kperm(i2)] = f2bf(bf2f(ks[i2 * 136 + d2]) * __expf(gl - gcum[i2]));
      }
      if (tid == 0) eg_g[item] = __expf(gl);
    }
    __syncthreads();
  }
}

DI bf16x8 ld2(const bf16_t* ptr) {
  u32x2 lo = *(const u32x2*)ptr, hi = *(const u32x2*)(ptr + 16);
  u32x4 t; t[0] = lo[0]; t[1] = lo[1]; t[2] = hi[0]; t[3] = hi[1];
  return __builtin_bit_cast(bf16x8, t);
}

DI void dn_chain_item(const Params& p, int item, bf16_t* smem) {
  const int tid = TID(), wave = tid >> 6, lane = tid & 63, l15 = lane & 15, quad = lane >> 4;
  const int bh = item >> 1, half = item & 1;
  const int e0 = half * 64 + wave * 16 + l15;
  const bf16_t* qd_g = (const bf16_t*)(p.ws + OFF_QD); const bf16_t* kd_g = (const bf16_t*)(p.ws + OFF_KD); const bf16_t* in_g = (const bf16_t*)(p.ws + OFF_INTRA);
  const bf16_t* w_g = (const bf16_t*)(p.ws + OFF_WB); bf16_t* u_g = (bf16_t*)(p.ws + OFF_UB); const float* eg_g = (const float*)(p.ws + OFF_EG);
  bf16_t* wl = smem; bf16_t* ql = wl + 64 * 136; bf16_t* kl = ql + 64 * 136; bf16_t* il = kl + 128 * 72; bf16_t* ul = il + 64 * 72;
  uint4 rw0, rw1, rw2, rw3, rq0, rq1, rq2, rq3, rk0, rk1, rk2, rk3, ri0, ri1, ru0, ru1;
#define CH_GLOAD(n_) do { const size_t ci_ = (size_t)bh * 64 + (n_); \
    const bf16_t* w_ = w_g + ci_ * 8192 + tid * 8; const bf16_t* q_ = qd_g + ci_ * 8192 + tid * 8; const bf16_t* k_ = kd_g + ci_ * 8192 + tid * 8; \
    rw0 = *(const uint4*)(w_); rw1 = *(const uint4*)(w_ + 2048); rw2 = *(const uint4*)(w_ + 4096); rw3 = *(const uint4*)(w_ + 6144); \
    rq0 = *(const uint4*)(q_); rq1 = *(const uint4*)(q_ + 2048); rq2 = *(const uint4*)(q_ + 4096); rq3 = *(const uint4*)(q_ + 6144); \
    rk0 = *(const uint4*)(k_); rk1 = *(const uint4*)(k_ + 2048); rk2 = *(const uint4*)(k_ + 4096); rk3 = *(const uint4*)(k_ + 6144); \
    ri0 = *(const uint4*)(in_g + ci_ * 4096 + tid * 8); ri1 = *(const uint4*)(in_g + ci_ * 4096 + 2048 + tid * 8); \
    ru0 = *(const uint4*)(u_g + ci_ * 8192 + (tid >> 3) * 128 + half * 64 + (tid & 7) * 8); \
    ru1 = *(const uint4*)(u_g + ci_ * 8192 + (32 + (tid >> 3)) * 128 + half * 64 + (tid & 7) * 8); } while (0)
#define CH_LSTORE() do { \
    bf16_t* w_ = wl + (tid >> 4) * 136 + (tid & 15) * 8; bf16_t* q_ = ql + (tid >> 4) * 136 + (tid & 15) * 8; bf16_t* k_ = kl + (tid >> 3) * 72 + (tid & 7) * 8; \
    *(uint4*)(w_) = rw0; *(uint4*)(w_ + 16 * 136) = rw1; *(uint4*)(w_ + 32 * 136) = rw2; *(uint4*)(w_ + 48 * 136) = rw3; \
    *(uint4*)(q_) = rq0; *(uint4*)(q_ + 16 * 136) = rq1; *(uint4*)(q_ + 32 * 136) = rq2; *(uint4*)(q_ + 48 * 136) = rq3; \
    *(uint4*)(k_) = rk0; *(uint4*)(k_ + 32 * 72) = rk1; *(uint4*)(k_ + 64 * 72) = rk2; *(uint4*)(k_ + 96 * 72) = rk3; \
    *(uint4*)(il + (tid >> 3) * 72 + (tid & 7) * 8) = ri0; *(uint4*)(il + (32 + (tid >> 3)) * 72 + (tid & 7) * 8) = ri1; \
    *(uint4*)(ul + (tid >> 3) * 72 + (tid & 7) * 8) = ru0; *(uint4*)(ul + (32 + (tid >> 3)) * 72 + (tid & 7) * 8) = ru1; } while (0)
  f32x4 S[8];
#pragma unroll
  for (int mt = 0; mt < 8; ++mt) S[mt] = f32x4{0.f, 0.f, 0.f, 0.f};
  CH_GLOAD(0);
  CH_LSTORE();
  __syncthreads();
#pragma unroll 1
  for (int n = 0; n < 64; ++n) {
    const size_t ci = (size_t)bh * 64 + n;
    if (n + 1 < 64) CH_GLOAD(n + 1);
    bf16_t* ub = u_g + ci * 8192;
    const float eg = eg_g[ci];
    bf16x8 sb[4];
#pragma unroll
    for (int s = 0; s < 4; ++s) sb[s] = pack8(S[2 * s], S[2 * s + 1]);
    f32x4 vn[4];
#pragma unroll
    for (int it = 0; it < 4; ++it) {
      f32x4 a = {0.f, 0.f, 0.f, 0.f};
#pragma unroll
      for (int s = 0; s < 4; ++s) a = MFMA16(*(const bf16x8*)(wl + (it * 16 + l15) * 136 + s * 32 + quad * 8), sb[s], a);
#pragma unroll
      for (int r = 0; r < 4; ++r) vn[it][r] = bf2f(ul[(it * 16 + quad * 4 + r) * 72 + wave * 16 + l15]) - a[r];
    }
    bf16x8 vb[2];
    vb[0] = pack8(vn[0], vn[1]); vb[1] = pack8(vn[2], vn[3]);
#pragma unroll
    for (int it = 0; it < 4; ++it) {
      f32x4 a = {0.f, 0.f, 0.f, 0.f};
#pragma unroll
      for (int s = 0; s < 4; ++s) a = MFMA16(*(const bf16x8*)(ql + (it * 16 + l15) * 136 + s * 32 + quad * 8), sb[s], a);
#pragma unroll
      for (int s = 0; s < 2; ++s) a = MFMA16(*(const bf16x8*)(il + (it * 16 + l15) * 72 + s * 32 + quad * 8), vb[s], a);
#pragma unroll
      for (int r = 0; r < 4; ++r) ub[(it * 16 + quad * 4 + r) * 128 + e0] = f2bf(a[r]);
    }
#pragma unroll
    for (int mt = 0; mt < 8; ++mt) {
      f32x4 a = S[mt];
      a[0] *= eg; a[1] *= eg; a[2] *= eg; a[3] *= eg;
#pragma unroll
      for (int s = 0; s < 2; ++s) a = MFMA16(*(const bf16x8*)(kl + (mt * 16 + l15) * 72 + s * 32 + quad * 8), vb[s], a);
      S[mt] = a;
    }
    __syncthreads();
    if (n + 1 < 64) CH_LSTORE();
    __syncthreads();
  }
}

DI void phase_mix(const Params& p, int i, bf16_t* smem) {
  if (BID() < 64) { dn_chain_item(p, BID(), smem); return; }
  phase_dil_attn(p, BID() - 64, GDIM() - 64);
}

DI void phase_dn_post(const Params& p, int i) {
  const bf16_t* ob = (const bf16_t*)(p.ws + OFF_UB);
  bf16_t* z = (bf16_t*)(p.ws + OFF_Z);
  const float* ng = p.dn_norm_g + i * 128;
  const int wave = TID() >> 6, lane = TID() & 63;
  const float g0 = ng[lane * 2], g1 = ng[lane * 2 + 1];
  const int N = T_ * 4;
  for (int base = (BID() * 4 + wave) * 4; base < N; base += GDIM() * 16) {
    unsigned ov[4], zv[4];
#pragma unroll
    for (int j = 0; j < 4; ++j) {
      const int item = base + j;
      const int t = item >> 2, h = item & 3, b = t >> 12, sidx = t & 4095;
      const size_t og = ((size_t)((b * 4 + h) * 64 + (sidx >> 6))) * 8192 + (sidx & 63) * 128 + lane * 2;
      ov[j] = *(const unsigned*)(ob + og);
      zv[j] = *(const unsigned*)(z + (size_t)item * 128 + lane * 2);
    }
#pragma unroll
    for (int j = 0; j < 4; ++j) {
      const float o0 = bf2f((bf16_t)(ov[j] & 0xffff)), o1 = bf2f((bf16_t)(ov[j] >> 16));
      const float z0 = bf2f((bf16_t)(zv[j] & 0xffff)), z1 = bf2f((bf16_t)(zv[j] >> 16));
      const float ms = wave_sum(o0 * o0 + o1 * o1) * (1.f / 128.f);
      const float rr = rsqrtf(ms + 1e-6f);
      *(unsigned*)(z + (size_t)(base + j) * 128 + lane * 2) = pack2(o0 * rr * g0 * siluf_(z0), o1 * rr * g1 * siluf_(z1));
    }
  }
}

struct MixLoad {
  const bf16_t* a; const bf16_t* b;
  DI uint4 operator()(int row, int ks, int kc) const {
    const unsigned off = (unsigned)((row * 512 + (ks & 7) * 64 + kc) * 2);
    return *(const uint4*)((const char*)((ks < 8) ? a : b) + off);
  }
};

DI void phase_wout(const Params& p, int i, bf16_t* smem) {
  const bf16_t* W = (const bf16_t*)(p.ws + OFF_W) + W_EVEN0 + (size_t)i * (SZ_WIN + SZ_SQ) + SZ_WIN;
  MixLoad al{(const bf16_t*)(p.ws + OFF_Z), (const bf16_t*)(p.ws + OFF_SWQ)};
  PlainLoad bl{W, 1024};
  {
    gemm_stream(256, 8, 16, al, bl, [&](f32x4 (&acc)[4][4], int rb, int cb) { epi_resid(p, acc, rb, cb); }, smem);
  }
}

template <int R>
DI void ln_rows(const Params& p, int row0, const float* g, const float* b, int lane) {
  bf16_t* hb = (bf16_t*)(p.ws + OFF_HB);
  float4 v[R][4];
#pragma unroll
  for (int j = 0; j < R; ++j)
#pragma unroll
    for (int i = 0; i < 4; ++i) v[j][i] = ((const float4*)(p.out + (size_t)(row0 + j) * 1024))[lane + 64 * i];
  float4 gg[4], bb[4];
#pragma unroll
  for (int i = 0; i < 4; ++i) { gg[i] = ((const float4*)g)[lane + 64 * i]; bb[i] = ((const float4*)b)[lane + 64 * i]; }
#pragma unroll
  for (int j = 0; j < R; ++j) {
    float s = 0.f;
#pragma unroll
    for (int i = 0; i < 4; ++i) s += v[j][i].x + v[j][i].y + v[j][i].z + v[j][i].w;
    const float mu = wave_sum(s) * (1.f / 1024.f);
    float q = 0.f;
#pragma unroll
    for (int i = 0; i < 4; ++i) { float a = v[j][i].x - mu, b2 = v[j][i].y - mu, c = v[j][i].z - mu, d = v[j][i].w - mu; q += a * a + b2 * b2 + c * c + d * d; }
    const float rstd = rsqrtf(wave_sum(q) * (1.f / 1024.f) + 1e-5f);
    float4* y = (float4*)(p.out + (size_t)(row0 + j) * 1024);
#pragma unroll
    for (int i = 0; i < 4; ++i) {
      float4 o;
      o.x = (v[j][i].x - mu) * rstd * gg[i].x + bb[i].x; o.y = (v[j][i].y - mu) * rstd * gg[i].y + bb[i].y;
      o.z = (v[j][i].z - mu) * rstd * gg[i].z + bb[i].z; o.w = (v[j][i].w - mu) * rstd * gg[i].w + bb[i].w;
      y[lane + 64 * i] = o;
      uint2 ob; ob.x = pack2(o.x, o.y); ob.y = pack2(o.z, o.w);
      ((uint2*)(hb + (size_t)(row0 + j) * 1024))[lane + 64 * i] = ob;
    }
  }
}
DI void phase_ln(const Params& p, const float* g, const float* b) {
  const int wave = TID() >> 6, lane = TID() & 63;
  for (int row = (BID() * 4 + wave) * 4; row < T_; row += GDIM() * 16) ln_rows<4>(p, row, g, b, lane);
}

DI void phase_s5_naive(const Params& p, int i) {
  const int wave = TID() >> 6, lane = TID() & 63;
  bf16_t* hid = (bf16_t*)(p.ws + OFF_HID);
  for (int base = BID() * 4; base < 512; base += GDIM() * 4) {
    const int item = base + wave, b = item >> 6, g = item & 63;
    const int gp = (i * 64 + g) * 64 + lane;
    const double dt = exp((double)p.s5_log_dt[i * 64 + g]);
    const double are = p.s5_a_re[gp], aim = p.s5_a_im[gp];
    const double lr = are * dt, li = aim * dt;
    const double kk = rint(li * 0.15915494309189535);
    const double red = li - kk * 6.283185307179586;
    const double e = exp(lr);
    const double abr = e * cos(red), abi = e * sin(red);
    const double den = are * are + aim * aim;
    const double nr = abr - 1.0, ni = abi;
    const double cfr = (nr * are + ni * aim) / den, cfi = (ni * are - nr * aim) / den;
    float bbr[16], bbi[16], cr[16], ci[16];
#pragma unroll
    for (int h = 0; h < 16; ++h) {
      const double br = p.s5_b_re[(size_t)gp * 16 + h], bi = p.s5_b_im[(size_t)gp * 16 + h];
      bbr[h] = (float)(cfr * br - cfi * bi); bbi[h] = (float)(cfr * bi + cfi * br);
      cr[h] = p.s5_c_re[((size_t)(i * 64 + g) * 16 + h) * 64 + lane];
      ci[h] = p.s5_c_im[((size_t)(i * 64 + g) * 16 + h) * 64 + lane];
    }
    const float ar = (float)abr, ai = (float)abi;
    const float dsk = p.s5_d[i * 1024 + g * 16 + (lane & 15)];
    float sr = 0.f, si = 0.f;
#pragma unroll 1
    for (int t = 0; t < S_; ++t) {
      const size_t row = (size_t)(b * S_ + t);
      const float4* up = (const float4*)(p.out + row * 1024 + g * 16);
      float u[16];
#pragma unroll
      for (int j = 0; j < 4; ++j) { float4 v = up[j]; u[4 * j] = v.x; u[4 * j + 1] = v.y; u[4 * j + 2] = v.z; u[4 * j + 3] = v.w; }
      float bur = 0.f, bui = 0.f;
#pragma unroll
      for (int h = 0; h < 16; ++h) { bur += bbr[h] * u[h]; bui += bbi[h] * u[h]; }
      const float nsr = ar * sr - ai * si + bur, nsi = ar * si + ai * sr + bui;
      sr = nsr; si = nsi;
      float yk = 0.f, uk = 0.f;
#pragma unroll
      for (int h = 0; h < 16; ++h) {
        float v = wave_sum(cr[h] * sr - ci[h] * si);
        if (lane == h) { yk = v; uk = u[h]; }
      }
      if (lane < 16) hid[row * 1024 + g * 16 + lane] = f2bf(gelu_tanh(yk + dsk * uk));
    }
  }
}

DI void phase_s5_tables(const Params& p, int i, float* smem) {
  float2* pw = (float2*)smem;
  float2* bb = pw + 64 * 33;
  float2* cc = bb + 64 * 16;
  bf16_t* Ktab = (bf16_t*)(p.ws + OFF_KTAB); bf16_t* Etab = (bf16_t*)(p.ws + OFF_ETAB); bf16_t* Gtab = (bf16_t*)(p.ws + OFF_GTAB);
  float2* AL = (float2*)(p.ws + OFF_AL);
  const int tid = TID();
  for (int item = BID(); item < 512; item += GDIM()) {
    const int g = item >> 3, part = item & 7;
    const double dt = exp((double)p.s5_log_dt[i * 64 + g]);
    for (int e = tid; e < 64 * 33; e += 256) {
      const int pp = e / 33, n = e - pp * 33;
      const double are = p.s5_a_re[(i * 64 + g) * 64 + pp], aim = p.s5_a_im[(i * 64 + g) * 64 + pp];
      const double lr = are * dt * n, li = aim * dt * n;
      const double k = rint(li * 0.15915494309189535);
      const double red = li - k * 6.283185307179586;
      const double ex = exp(lr);
      pw[e] = make_float2((float)(ex * cos(red)), (float)(ex * sin(red)));
    }
    for (int e = tid; e < 1024; e += 256) {
      const int pp = e >> 4;
      const int gp = (i * 64 + g) * 64 + pp;
      const double are = p.s5_a_re[gp], aim = p.s5_a_im[gp];
      const double lr = are * dt, li = aim * dt;
      const double k = rint(li * 0.15915494309189535);
      const double red = li - k * 6.283185307179586;
      const double ex = exp(lr);
      const double nr = ex * cos(red) - 1.0, ni = ex * sin(red);
      const double den = are * are + aim * aim;
      const double cfr = (nr * are + ni * aim) / den, cfi = (ni * are - nr * aim) / den;
      const double br = p.s5_b_re[(size_t)gp * 16 + (e & 15)], bi = p.s5_b_im[(size_t)gp * 16 + (e & 15)];
      bb[e] = make_float2((float)(cfr * br - cfi * bi), (float)(cfr * bi + cfi * br));
      const size_t ci = ((size_t)(i * 64 + g) * 16 + (e >> 6)) * 64 + (e & 63);
      cc[e] = make_float2(p.s5_c_re[ci], p.s5_c_im[ci]);
    }
    __syncthreads();
    for (int e = part * 1024 + tid; e < (part + 1) * 1024; e += 256) {
      const int tau = e >> 8, ho = (e >> 4) & 15, hi = e & 15;
      float acc = 0.f;
      for (int pp = 0; pp < 64; ++pp) {
        const float2 c = cc[ho * 64 + pp], w = pw[pp * 33 + tau], b = bb[pp * 16 + hi];
        const float cwr = c.x * w.x - c.y * w.y, cwi = c.x * w.y + c.y * w.x;
        acc += cwr * b.x - cwi * b.y;
      }
      Ktab[(size_t)g * 8192 + e] = f2bf(acc);
    }
    for (int e = part * 8192 + tid; e < (part + 1) * 8192; e += 256) {
      const int pc = e >> 9, sidx = (e >> 4) & 31, hi = e & 15, pp = pc & 63;
      const float2 w = pw[pp * 33 + 31 - sidx], b = bb[pp * 16 + hi];
      const float v = (pc < 64) ? (w.x * b.x - w.y * b.y) : (w.x * b.y + w.y * b.x);
      Etab[(size_t)g * 65536 + e] = f2bf(v);
    }
    for (int e = part * 8192 + tid; e < (part + 1) * 8192; e += 256) {
      const int row = e >> 7, pc = e & 127, pp = pc & 63, t = row >> 4, ho = row & 15;
      const float2 c = cc[ho * 64 + pp], w = pw[pp * 33 + t + 1];
      const float v = (pc < 64) ? (c.x * w.x - c.y * w.y) : -(c.x * w.y + c.y * w.x);
      Gtab[(size_t)g * 65536 + e] = f2bf(v);
    }
    if (tid < 64 && part == 0) AL[g * 64 + tid] = pw[tid * 33 + 32];
    __syncthreads();
  }
}

DI void phase_s5_end(const Params& p, bf16_t* smem) {
  const bf16_t* Etab = (const bf16_t*)(p.ws + OFF_ETAB); const bf16_t* hb = (const bf16_t*)(p.ws + OFF_HB);
  const float2* AL = (const float2*)(p.ws + OFF_AL);
  bf16_t* sin_ = (bf16_t*)(p.ws + OFF_SIN);
  float* endbuf = (float*)smem;
  for (int item = BID(); item < 512; item += GDIM()) {
    const int g = item >> 3, b = item & 7;
    auto al = [=](int row, int ks, int kc) { return *(const uint4*)((const char*)Etab + (unsigned)((((g * 128 + row) * 512) + ks * 64 + kc) * 2)); };
    auto bl = [=](int n, int ks, int kc) {
      const int k = ks * 64 + kc, sidx = k >> 4, hi0 = k & 15;
      return *(const uint4*)((const char*)hb + (unsigned)(((b * 4096 + n * 32 + sidx) * 1024 + g * 16 + hi0) * 2));
    };
    gemm_tile(0, 0, 8, al, bl, [&](f32x4 (&acc)[4][4], int rb, int cb) {
      const int lane = TID() & 63, l15 = lane & 15, quad = lane >> 4;
#pragma unroll
      for (int mt = 0; mt < 4; ++mt)
#pragma unroll
        for (int nt = 0; nt < 4; ++nt)
#pragma unroll
          for (int r = 0; r < 4; ++r) endbuf[(rb + mt * 16 + l15) * 129 + cb + nt * 16 + quad * 4 + r] = acc[mt][nt][r];
    }, smem);
    __syncthreads();
    if (TID() < 64) {
      const int pp = TID();
      const float2 a = AL[g * 64 + pp];
      float sr = 0.f, si = 0.f;
      for (int n = 0; n < 128; ++n) {
        bf16_t* dst = sin_ + ((size_t)g * 1024 + b * 128 + n) * 128;
        dst[pp] = f2bf(sr); dst[64 + pp] = f2bf(si);
        const float er = endbuf[pp * 129 + n], ei = endbuf[(64 + pp) * 129 + n];
        const float nr = a.x * sr - a.y * si + er, ni = a.x * si + a.y * sr + ei;
        sr = nr; si = ni;
      }
    }
    __syncthreads();
  }
}

DI void phase_s5_y(const Params& p, int i, bf16_t* smem) {
  const bf16_t* Ktab = (const bf16_t*)(p.ws + OFF_KTAB); const bf16_t* Gtab = (const bf16_t*)(p.ws + OFF_GTAB);
  const bf16_t* hb = (const bf16_t*)(p.ws + OFF_HB); const bf16_t* sin_ = (const bf16_t*)(p.ws + OFF_SIN);
  bf16_t* hid = (bf16_t*)(p.ws + OFF_HID);
  for (int w = BID(); w < 2048; w += GDIM()) {
    const int g = w >> 5, mtile = (w >> 3) & 3, b = w & 7;
    const int nT = mtile * 2 + 2;
    auto al = [=](int row, int ks, int kc) -> uint4 {
      if (ks < nT) {
        const int k = ks * 64 + kc, sidx = k >> 4, hi0 = k & 15, t = row >> 4, ho = row & 15;
        if (t >= sidx) return *(const uint4*)((const char*)Ktab + (unsigned)(((((g * 32 + (t - sidx)) * 16 + ho) * 16) + hi0) * 2));
        return make_uint4(0, 0, 0, 0);
      }
      return *(const uint4*)((const char*)Gtab + (unsigned)((((g * 512 + row) * 128) + (ks - nT) * 64 + kc) * 2));
    };
    auto bl = [=](int n, int ks, int kc) -> uint4 {
      if (ks < nT) {
        const int k = ks * 64 + kc, sidx = k >> 4, hi0 = k & 15;
        return *(const uint4*)((const char*)hb + (unsigned)(((b * 4096 + n * 32 + sidx) * 1024 + g * 16 + hi0) * 2));
      }
      return *(const uint4*)((const char*)sin_ + (unsigned)((((g * 1024 + b * 128 + n) * 128) + (ks - nT) * 64 + kc) * 2));
    };
    gemm_tile(0, mtile * 128, nT + 2, bl, al, [&](f32x4 (&acc)[4][4], int rb, int cb) {
      const int lane = TID() & 63, l15 = lane & 15, quad = lane >> 4;
      const float4 dsk = *(const float4*)(p.s5_d + i * 1024 + g * 16 + quad * 4);
#pragma unroll
      for (int mt = 0; mt < 4; ++mt)
#pragma unroll
        for (int nt = 0; nt < 4; ++nt) {
          const int t = (cb + nt * 16) >> 4, n = rb + mt * 16 + l15;
          const size_t tok = (size_t)b * 4096 + n * 32 + t;
          const float4 u = *(const float4*)(p.out + tok * 1024 + g * 16 + quad * 4);
          u32x2 v;
          v[0] = pack2(gelu_tanh(acc[mt][nt][0] + dsk.x * u.x), gelu_tanh(acc[mt][nt][1] + dsk.y * u.y));
          v[1] = pack2(gelu_tanh(acc[mt][nt][2] + dsk.z * u.z), gelu_tanh(acc[mt][nt][3] + dsk.w * u.w));
          *(u32x2*)(hid + tok * 1024 + g * 16 + quad * 4) = v;
        }
    }, smem);
  }
}

DI void phase_glu(const Params& p, int i, bf16_t* smem) {
  const bf16_t* W = (const bf16_t*)(p.ws + OFF_W) + W_ODD0 + (size_t)i * SZ_GLU;
  PlainLoad al{(const bf16_t*)(p.ws + OFF_HID), 1024}, bl{W, 1024};
  {
    gemm_stream(256, 16, 16, al, bl, [&](f32x4 (&acc)[4][4], int rb, int cb) {
      const int lane = TID() & 63, l15 = lane & 15, quad = lane >> 4;
#pragma unroll
      for (int mt = 0; mt < 4; ++mt)
#pragma unroll
        for (int np = 0; np < 2; ++np) {
          float4* ptr = (float4*)(p.out + (size_t)(rb + mt * 16 + l15) * 1024 + (cb >> 1) + np * 16 + quad * 4);
          float4 h = *ptr;
          h.x = ALPHA * h.x + acc[mt][2 * np][0] * sigmoidf_(acc[mt][2 * np + 1][0]);
          h.y = ALPHA * h.y + acc[mt][2 * np][1] * sigmoidf_(acc[mt][2 * np + 1][1]);
          h.z = ALPHA * h.z + acc[mt][2 * np][2] * sigmoidf_(acc[mt][2 * np + 1][2]);
          h.w = ALPHA * h.w + acc[mt][2 * np][3] * sigmoidf_(acc[mt][2 * np + 1][3]);
          *ptr = h;
        }
    }, smem);
  }
}

DI void phase_xproj(const Params& p, int l, bf16_t* smem) {
  const bf16_t* wc = (const bf16_t*)(p.ws + OFF_W) + (size_t)l * SZ_COMMON;
  {
    PlainLoad al{(const bf16_t*)(p.ws + OFF_HB), 1024}, bl{wc, 1024};
    bf16_t* q = (bf16_t*)(p.ws + OFF_XQ);
    gemm_stream(256, 8, 16, al, bl, [&](f32x4 (&acc)[4][4], int rb, int cb) { epi_bf16(q, 1024, acc, rb, cb); }, smem);
  }
  {
    const float* memf = p.mem;
    auto al = [=](int row, int ks, int kc) -> uint4 {
      const float4* src = (const float4*)((const char*)memf + (unsigned)((row * 1024 + ks * 64 + kc) * 4));
      float4 a = src[0], b2 = src[1];
      return make_uint4(pack2(a.x, a.y), pack2(a.z, a.w), pack2(b2.x, b2.y), pack2(b2.z, b2.w));
    };
    bf16_t* kx = (bf16_t*)(p.ws + OFF_KX); bf16_t* vx = (bf16_t*)(p.ws + OFF_VX);
    for_tiles(16, 16, [&](int mi, int ni) {
      const bool isv = ni >= 8;
      PlainLoad bl{isv ? (wc + 2 * SZ_SQ) : (wc + SZ_SQ), 1024};
      gemm_tile(mi * 128, (ni & 7) * 128, 16, al, bl, [&](f32x4 (&acc)[4][4], int rb, int cb) {
        if (!isv) { epi_bf16(kx, 1024, acc, rb, cb); return; }
        const int lane = TID() & 63, l15 = lane & 15, quad = lane >> 4;
#pragma unroll
        for (int mt = 0; mt < 4; ++mt)
#pragma unroll
          for (int nt = 0; nt < 4; ++nt) {
            const int row = rb + mt * 16 + l15, col = cb + nt * 16 + quad * 4;
            const int b = row >> 8, key = row & 255, h = col >> 8, d = col & 255;
            bf16_t* dst = vx + ((size_t)((b * 4 + h) * 256 + d)) * 256 + kperm(key);
#pragma unroll
            for (int r = 0; r < 4; ++r) dst[r * 256] = f2bf(acc[mt][nt][r]);
          }
      }, smem);
    });
  }
}


DI void phase_xattn(const Params& p, bf16_t* smem) {
  const int tid = TID(), wave = tid >> 6, lane = tid & 63, l15 = lane & 15, quad = lane >> 4;
  const bf16_t* q = (const bf16_t*)(p.ws + OFF_XQ); const bf16_t* kx = (const bf16_t*)(p.ws + OFF_KX); const bf16_t* vxT = (const bf16_t*)(p.ws + OFF_VX);
  bf16_t* xo = (bf16_t*)(p.ws + OFF_XO);
  uint4 rg0, rg1, rg2, rg3, rg4, rg5, rg6, rg7;
#define XA_KLOAD(c_) do { const bf16_t* s_ = kx + (size_t)(b * 256 + (c_) * 64 + (tid >> 5)) * 1024 + h * 256 + (tid & 31) * 8; \
    rg0 = *(const uint4*)(s_); rg1 = *(const uint4*)(s_ + 8 * 1024); rg2 = *(const uint4*)(s_ + 16 * 1024); rg3 = *(const uint4*)(s_ + 24 * 1024); \
    rg4 = *(const uint4*)(s_ + 32 * 1024); rg5 = *(const uint4*)(s_ + 40 * 1024); rg6 = *(const uint4*)(s_ + 48 * 1024); rg7 = *(const uint4*)(s_ + 56 * 1024); } while (0)
#define XA_KSTORE(buf_) do { bf16_t* d_ = (buf_) + (tid >> 5) * 264 + (tid & 31) * 8; \
    *(uint4*)(d_) = rg0; *(uint4*)(d_ + 8 * 264) = rg1; *(uint4*)(d_ + 16 * 264) = rg2; *(uint4*)(d_ + 24 * 264) = rg3; \
    *(uint4*)(d_ + 32 * 264) = rg4; *(uint4*)(d_ + 40 * 264) = rg5; *(uint4*)(d_ + 48 * 264) = rg6; *(uint4*)(d_ + 56 * 264) = rg7; } while (0)
#define XA_VLOAD(c_) do { const bf16_t* s_ = vxT + ((size_t)((b * 4 + h) * 256 + (tid >> 3))) * 256 + (c_) * 64 + (tid & 7) * 8; \
    rg0 = *(const uint4*)(s_); rg1 = *(const uint4*)(s_ + 32 * 256); rg2 = *(const uint4*)(s_ + 64 * 256); rg3 = *(const uint4*)(s_ + 96 * 256); \
    rg4 = *(const uint4*)(s_ + 128 * 256); rg5 = *(const uint4*)(s_ + 160 * 256); rg6 = *(const uint4*)(s_ + 192 * 256); rg7 = *(const uint4*)(s_ + 224 * 256); } while (0)
#define XA_VSTORE(buf_) do { bf16_t* d_ = (buf_) + (tid >> 3) * 72 + (tid & 7) * 8; \
    *(uint4*)(d_) = rg0; *(uint4*)(d_ + 32 * 72) = rg1; *(uint4*)(d_ + 64 * 72) = rg2; *(uint4*)(d_ + 96 * 72) = rg3; \
    *(uint4*)(d_ + 128 * 72) = rg4; *(uint4*)(d_ + 160 * 72) = rg5; *(uint4*)(d_ + 192 * 72) = rg6; *(uint4*)(d_ + 224 * 72) = rg7; } while (0)
  for (int item = BID(); item < 2048; item += GDIM()) {
    const int b = item >> 8, h = (item >> 6) & 3, qb = item & 63;
    const size_t tq = (size_t)b * 4096 + qb * 64 + wave * 16 + l15;
    XA_KLOAD(0);
    bf16x8 qf[8];
#pragma unroll
    for (int ks = 0; ks < 8; ++ks) qf[ks] = *(const bf16x8*)(q + tq * 1024 + h * 256 + ks * 32 + quad * 8);
    XA_KSTORE(smem);
    __syncthreads();
    f32x4 s[16];
#pragma unroll
    for (int c = 0; c < 4; ++c) {
      const bf16_t* cur = smem + (c & 1) * 18432; bf16_t* nxt = smem + ((c + 1) & 1) * 18432;
      if (c < 3) XA_KLOAD(c + 1); else XA_VLOAD(0);
#pragma unroll
      for (int m4 = 0; m4 < 4; ++m4) {
        f32x4 a = {0.f, 0.f, 0.f, 0.f};
#pragma unroll
        for (int ks = 0; ks < 8; ++ks) a = MFMA16(*(const bf16x8*)(cur + (m4 * 16 + l15) * 264 + ks * 32 + quad * 8), qf[ks], a);
        s[c * 4 + m4] = a;
      }
      if (c < 3) XA_KSTORE(nxt); else XA_VSTORE(nxt);
      __syncthreads();
    }
    float m = -1e30f;
#pragma unroll
    for (int mt = 0; mt < 16; ++mt)
#pragma unroll
      for (int r = 0; r < 4; ++r) m = fmaxf(m, s[mt][r]);
    m = fmaxf(m, __shfl_xor(m, 16)); m = fmaxf(m, __shfl_xor(m, 32));
    const float c1 = 0.0625f * 1.4426950408889634f;
    float l = 0.f;
#pragma unroll
    for (int mt = 0; mt < 16; ++mt)
#pragma unroll
      for (int r = 0; r < 4; ++r) { float pv = exp2f((s[mt][r] - m) * c1); s[mt][r] = pv; l += pv; }
    l += __shfl_xor(l, 16); l += __shfl_xor(l, 32);
    f32x4 o[16];
#pragma unroll
    for (int dt = 0; dt < 16; ++dt) o[dt] = f32x4{0.f, 0.f, 0.f, 0.f};
#pragma unroll
    for (int c = 0; c < 4; ++c) {
      const bf16_t* cur = smem + (c & 1) * 18432; bf16_t* nxt = smem + ((c + 1) & 1) * 18432;
      if (c < 3) XA_VLOAD(c + 1);
#pragma unroll
      for (int s2 = 0; s2 < 2; ++s2) {
        const bf16x8 pf = pack8(s[4 * c + 2 * s2], s[4 * c + 2 * s2 + 1]);
#pragma unroll
        for (int dt = 0; dt < 16; ++dt) o[dt] = MFMA16(*(const bf16x8*)(cur + (dt * 16 + l15) * 72 + s2 * 32 + quad * 8), pf, o[dt]);
      }
      if (c < 3) XA_VSTORE(nxt);
      __syncthreads();
    }
    const float il = 1.f / l;
#pragma unroll
    for (int dt = 0; dt < 16; ++dt) {
      u32x2 v; v[0] = pack2(o[dt][0] * il, o[dt][1] * il); v[1] = pack2(o[dt][2] * il, o[dt][3] * il);
      *(u32x2*)(xo + tq * 1024 + h * 256 + dt * 16 + quad * 4) = v;
    }
  }
}

template <int R, int NT>
DI void dil_branch(const bf16_t* swk, const bf16_t* swv, size_t rowbase, int h, int tok0, const bf16x8 (&qf)[2], float& m, float& l, f32x4 (&o)[4],
                   int l15, int quad) {
  constexpr int U = 16 / R, W = 128 * R;
  f32x4 s[NT];
#pragma unroll
  for (int kt = 0; kt < NT; ++kt) {
    int kap = tok0 - W + R * (kt * 16 + l15);
    kap = min(max(kap, 0), 4095);
    const bf16_t* kp = swk + (rowbase + kap) * 512 + h * 64 + quad * 8;
    f32x4 a = {0.f, 0.f, 0.f, 0.f};
    a = MFMA16(*(const bf16x8*)kp, qf[0], a);
    a = MFMA16(*(const bf16x8*)(kp + 32), qf[1], a);
    s[kt] = a;
    if ((kt & 3) == 3) __builtin_amdgcn_sched_barrier(0);
  }
  float mx = m;
  const float c1 = 0.125f * 1.4426950408889634f;
#pragma unroll
  for (int kt = 0; kt < NT; ++kt)
#pragma unroll
    for (int r2 = 0; r2 < 4; ++r2) {
      const int c = kt * 16 + quad * 4 + r2;
      const int dist = U * l15 + 128 - c;
      const int kap = tok0 - W + R * c;
      const bool ok = (dist >= 0) && (dist <= 128) && (kap >= 0);
      const float v = ok ? s[kt][r2] * c1 : -1e30f;
      s[kt][r2] = v; mx = fmaxf(mx, v);
    }
  mx = fmaxf(mx, __shfl_xor(mx, 16)); mx = fmaxf(mx, __shfl_xor(mx, 32));
  const float corr = exp2f(m - mx);
  m = mx; l *= corr;
#pragma unroll
  for (int dt = 0; dt < 4; ++dt) { o[dt][0] *= corr; o[dt][1] *= corr; o[dt][2] *= corr; o[dt][3] *= corr; }
#pragma unroll
  for (int kt = 0; kt < NT; ++kt)
#pragma unroll
    for (int r2 = 0; r2 < 4; ++r2) { float pv = exp2f(s[kt][r2] - mx); s[kt][r2] = pv; l += pv; }
  constexpr int NS = (NT + 1) / 2;
#pragma unroll
  for (int s2 = 0; s2 < NS; ++s2) {
    const f32x4 z4 = {0.f, 0.f, 0.f, 0.f};
    const bf16x8 pf = pack8(s[2 * s2], (2 * s2 + 1 < NT) ? s[(2 * s2 + 1 < NT) ? 2 * s2 + 1 : 0] : z4);
    u32x2 vv[8];
#pragma unroll
    for (int j = 0; j < 8; ++j) {
      const int c = (2 * s2 + (j >> 2)) * 16 + quad * 4 + (j & 3);
      int kap = tok0 - W + R * c;
      kap = min(max(kap, 0), 4095);
      vv[j] = *(const u32x2*)(swv + (rowbase + kap) * 512 + h * 64 + 4 * l15);
    }
#pragma unroll
    for (int t4 = 0; t4 < 4; ++t4) {
      u32x4 t;
#pragma unroll
      for (int m = 0; m < 4; ++m) {
        const unsigned a = vv[2 * m][t4 >> 1], b2 = vv[2 * m + 1][t4 >> 1];
        t[m] = (t4 & 1) ? ((a >> 16) | (b2 & 0xffff0000u)) : ((a & 0xffffu) | (b2 << 16));
      }
      o[t4] = MFMA16(__builtin_bit_cast(bf16x8, t), pf, o[t4]);
    }
    __builtin_amdgcn_sched_barrier(0);
  }
}

DI void phase_dil_attn(const Params& p, int first, int nblk) {
  const int wave = TID() >> 6, lane = TID() & 63, l15 = lane & 15, quad = lane >> 4;
  bf16_t* swq = (bf16_t*)(p.ws + OFF_SWQ); const bf16_t* swk = (const bf16_t*)(p.ws + OFF_SWK); const bf16_t* swv = (const bf16_t*)(p.ws + OFF_SWV);
  for (int item = first; item < 4096; item += nblk) {
    const int b = item >> 9, h = (item >> 6) & 7, rho = (item >> 2) & 15, gq = item & 3;
    const int tok0 = (gq * 4 + wave) * 256 + rho;
    const size_t rowbase = (size_t)b * 4096;
    const size_t tq = rowbase + tok0 + 16 * l15;
    bf16x8 qf[2];
    qf[0] = *(const bf16x8*)(swq + tq * 512 + h * 64 + quad * 8);
    qf[1] = *(const bf16x8*)(swq + tq * 512 + h * 64 + 32 + quad * 8);
    float m = -1e30f, l = 0.f;
    f32x4 o[4];
#pragma unroll
    for (int dt = 0; dt < 4; ++dt) o[dt] = f32x4{0.f, 0.f, 0.f, 0.f};
    dil_branch<16, 9>(swk, swv, rowbase, h, tok0, qf, m, l, o, l15, quad);
    dil_branch<4, 12>(swk, swv, rowbase, h, tok0, qf, m, l, o, l15, quad);
    dil_branch<1, 24>(swk, swv, rowbase, h, tok0, qf, m, l, o, l15, quad);
    l += __shfl_xor(l, 16); l += __shfl_xor(l, 32);
    const float il = 1.f / l;
    u32x4 w0, w1;
    w0[0] = pack2(o[0][0] * il, o[1][0] * il); w0[1] = pack2(o[2][0] * il, o[3][0] * il);
    w0[2] = pack2(o[0][1] * il, o[1][1] * il); w0[3] = pack2(o[2][1] * il, o[3][1] * il);
    w1[0] = pack2(o[0][2] * il, o[1][2] * il); w1[1] = pack2(o[2][2] * il, o[3][2] * il);
    w1[2] = pack2(o[0][3] * il, o[1][3] * il); w1[3] = pack2(o[2][3] * il, o[3][3] * il);
    *(u32x4*)(swq + tq * 512 + h * 64 + quad * 16) = w0;
    *(u32x4*)(swq + tq * 512 + h * 64 + quad * 16 + 8) = w1;
  }
}

DI void phase_xo(const Params& p, int l, bf16_t* smem) {
  const bf16_t* wc = (const bf16_t*)(p.ws + OFF_W) + (size_t)l * SZ_COMMON + 3 * SZ_SQ;
  PlainLoad al{(const bf16_t*)(p.ws + OFF_XO), 1024}, bl{wc, 1024};
  {
    gemm_stream(256, 8, 16, al, bl, [&](f32x4 (&acc)[4][4], int rb, int cb) { epi_resid(p, acc, rb, cb); }, smem);
  }
}

DI void phase_ffn_gu(const Params& p, int l, bf16_t* smem) {
  const bf16_t* W = (const bf16_t*)(p.ws + OFF_W) + (size_t)l * SZ_COMMON + 4 * SZ_SQ;
  PlainLoad al{(const bf16_t*)(p.ws + OFF_HB), 1024}, bl{W, 1024};
  bf16_t* act = (bf16_t*)(p.ws + OFF_ACT);
  {
    gemm_stream(256, 44, 16, al, bl, [&](f32x4 (&acc)[4][4], int rb, int cb) {
      const int lane = TID() & 63, l15 = lane & 15, quad = lane >> 4;
#pragma unroll
      for (int mt = 0; mt < 4; ++mt)
#pragma unroll
        for (int np = 0; np < 2; ++np) {
          u32x2 v;
          v[0] = pack2(siluf_(acc[mt][2 * np][0]) * acc[mt][2 * np + 1][0], siluf_(acc[mt][2 * np][1]) * acc[mt][2 * np + 1][1]);
          v[1] = pack2(siluf_(acc[mt][2 * np][2]) * acc[mt][2 * np + 1][2], siluf_(acc[mt][2 * np][3]) * acc[mt][2 * np + 1][3]);
          *(u32x2*)(act + (size_t)(rb + mt * 16 + l15) * 2816 + (cb >> 1) + np * 16 + quad * 4) = v;
        }
    }, smem);
  }
}
DI void phase_ffn_down(const Params& p, int l, bf16_t* smem) {
  const bf16_t* W = (const bf16_t*)(p.ws + OFF_W) + (size_t)l * SZ_COMMON + 4 * SZ_SQ + SZ_GU;
  PlainLoad al{(const bf16_t*)(p.ws + OFF_ACT), 2816}, bl{W, 2816};
  {
    gemm_stream(256, 8, 44, al, bl, [&](f32x4 (&acc)[4][4], int rb, int cb) { epi_resid(p, acc, rb, cb); }, smem);
  }
}


#define XB_TMO      128
#define XB_XCNT(j)  (256  + 64 * (j))
#define XB_XSUB(j)  (1280 + 64 * (j))
#define XB_XGEN(j)  (2304 + 64 * (j))
#define XB_TOP      3328
#define XB_TOPGEN   3392
#define XCD_BAR_WORDS 3456
#define XB_SPIN_CAP (1u << 22)
#define LAS __attribute__((address_space(3)))
DI unsigned xb_ld(unsigned* p) { return __hip_atomic_load(p, __ATOMIC_RELAXED, __HIP_MEMORY_SCOPE_AGENT); }
DI unsigned xb_add(unsigned* p, unsigned v) { return __hip_atomic_fetch_add(p, v, __ATOMIC_RELAXED, __HIP_MEMORY_SCOPE_AGENT); }
DI unsigned xb_xcc_id() { return (unsigned)__builtin_amdgcn_s_getreg((3 << 11) | 20) & 0xFu; }
#define XB_SPIN(cond, bar) do { unsigned _sp = 0; while (cond) { __builtin_amdgcn_s_sleep(1); \
    if ((++_sp & 255u) == 0u) { if (xb_ld(&(bar)[XB_TMO])) break; if (_sp > XB_SPIN_CAP) { atomicAdd(&(bar)[XB_TMO], 1u); break; } } } } while (0)
struct XcdBarrier { unsigned* bar; unsigned x; volatile LAS unsigned* st; };
DI XcdBarrier xcd_barrier_post(unsigned* bar, volatile LAS unsigned* st) {
  XcdBarrier b; b.bar = bar; b.x = xb_xcc_id(); b.st = st;
  if (threadIdx.x == 0) (void)xb_add(&bar[XB_XCNT(b.x)], 1u);
  return b;
}
DI void xcd_barrier_complete(unsigned* bar, unsigned x, unsigned& nloc, unsigned& nx) {
  const unsigned G = gridDim.x * gridDim.y * gridDim.z;
  unsigned sum, cnt, mine, sp = 0u;
  for (;;) {
    sum = 0u; cnt = 0u; mine = 0u;
#pragma unroll
    for (unsigned j = 0; j < 16; ++j) { const unsigned c = xb_ld(&bar[XB_XCNT(j)]); sum += c; cnt += (c > 0u) ? 1u : 0u; mine = (j == x) ? c : mine; }
    if (sum == G) break;
    __builtin_amdgcn_s_sleep(1);
    if ((++sp & 255u) == 0u) { if (xb_ld(&bar[XB_TMO])) break; if (sp > XB_SPIN_CAP) { atomicAdd(&bar[XB_TMO], 1u); break; } }
  }
  nloc = mine > 0u ? mine : 1u; nx = cnt > 0u ? cnt : 1u;
}
DI void xcd_barrier(const XcdBarrier& b) {
  asm volatile("s_waitcnt vmcnt(0)" ::: "memory");
  __syncthreads();
  if (threadIdx.x == 0) {
    unsigned* bar = b.bar;
    __builtin_amdgcn_s_waitcnt(0);
    unsigned nloc = b.st[0], nx = b.st[1];
    if (nloc == 0u) { xcd_barrier_complete(bar, b.x, nloc, nx); b.st[0] = nloc; b.st[1] = nx; }
    const unsigned old = xb_add(&bar[XB_XSUB(b.x)], 1u);
    const unsigned gen = old / nloc;
    if (old + 1u == (gen + 1u) * nloc) {
      __builtin_amdgcn_fence(__ATOMIC_RELEASE, "agent");
      asm volatile("s_waitcnt vmcnt(0)" ::: "memory");
      const unsigned og = xb_add(&bar[XB_TOP], 1u);
      const unsigned tg = og / nx;
      if (og + 1u == (tg + 1u) * nx) xb_add(&bar[XB_TOPGEN], 1u);
      else XB_SPIN(xb_ld(&bar[XB_TOPGEN]) == tg, bar);
      __builtin_amdgcn_fence(__ATOMIC_ACQUIRE, "agent");
      xb_add(&bar[XB_XGEN(b.x)], 1u);
      asm volatile("s_waitcnt vmcnt(0)" ::: "memory");
    } else {
      XB_SPIN(xb_ld(&bar[XB_XGEN(b.x)]) == gen, bar);
      __builtin_amdgcn_fence(__ATOMIC_ACQUIRE, "agent");
      asm volatile("s_waitcnt vmcnt(0)" ::: "memory");
    }
  }
  __syncthreads();
}

__global__ void __launch_bounds__(256, 2) fwd_megakernel(Params p) {
  cg::grid_group grid = cg::this_grid();
  __shared__ __attribute__((aligned(16))) char smem_raw[2 * 2 * 128 * LDT * 2];
  bf16_t* sm16 = (bf16_t*)smem_raw; float* sm32 = (float*)smem_raw;

  __shared__ uint4 xb_words;
  if (threadIdx.x == 0) xb_words = make_uint4(0u, 0u, 0u, 0u);
  __syncthreads();
  XcdBarrier xb = xcd_barrier_post((unsigned*)(p.ws + OFF_BAR), (volatile LAS unsigned*)&xb_words);
  phase_prologue(p, sm32);
  grid.sync();
  for (int l = 0; l < 4; ++l) {
    const int i = l >> 1;
    if ((l & 1) == 0) {
      phase_proj(p, i, sm16); xcd_barrier(xb);
      phase_dn_prep(p, i, smem_raw); xcd_barrier(xb);
      phase_mix(p, i, sm16); xcd_barrier(xb);
      phase_dn_post(p, i); xcd_barrier(xb);
      phase_wout(p, i, sm16); xcd_barrier(xb);
    } else {
#if USE_S5_GEMM
      phase_s5_tables(p, i, sm32); xcd_barrier(xb);
      phase_s5_end(p, sm16); xcd_barrier(xb);
      phase_s5_y(p, i, sm16); xcd_barrier(xb);
#else
      phase_s5_naive(p, i); xcd_barrier(xb);
#endif
      phase_glu(p, i, sm16); xcd_barrier(xb);
    }
    phase_ln(p, p.ln_mix_g + l * 1024, p.ln_mix_b + l * 1024); xcd_barrier(xb);
    phase_xproj(p, l, sm16); xcd_barrier(xb);
    phase_xattn(p, sm16); xcd_barrier(xb);
    phase_xo(p, l, sm16); xcd_barrier(xb);
    phase_ln(p, p.ln_x_g + l * 1024, p.ln_x_b + l * 1024); xcd_barrier(xb);
    phase_ffn_gu(p, l, sm16); xcd_barrier(xb);
    phase_ffn_down(p, l, sm16); xcd_barrier(xb);
    phase_ln(p, p.ln_ffn_g + l * 1024, p.ln_ffn_b + l * 1024); xcd_barrier(xb);
  }
}

extern "C" void kernel_launch(void* const* d_in, const int* in_sizes, int n_in, void* d_out, int out_size, void* d_ws, size_t ws_size,
                              hipStream_t stream) {
  static int grid_blocks = 0;
  if (!grid_blocks) {
    int dev = 0, cus = 0, per_cu = 0;
    hipGetDevice(&dev);
    hipDeviceGetAttribute(&cus, hipDeviceAttributeMultiprocessorCount, dev);
    hipOccupancyMaxActiveBlocksPerMultiprocessor(&per_cu, fwd_megakernel, 256, 0);
    if (per_cu > 2) per_cu = 2;
    if (per_cu < 1) per_cu = 1;
    grid_blocks = cus * per_cu;
    grid_blocks -= grid_blocks % 8;
  }
  Params p{};
  const float** pf = (const float**)&p;
  for (int i = 0; i < 32; ++i) pf[i] = (const float*)d_in[i];
  p.pos = (const int*)d_in[2];
  p.out = (float*)d_out; p.ws = (char*)d_ws;
  hipMemsetAsync((char*)d_ws + OFF_BAR, 0, XCD_BAR_WORDS * sizeof(unsigned), stream);
  void* args[] = {&p};
  hipError_t e = hipLaunchCooperativeKernel((void*)fwd_megakernel, dim3(grid_blocks), dim3(256), args, 0, stream);
  if (e != hipSuccess) fprintf(stderr, "cooperative launch failed: %s (grid %d)\n", hipGetErrorString(e), grid_blocks);
}
```

```cpp
#include <hip/hip_runtime.h>
#include <hip/hip_cooperative_groups.h>
#include <cstdio>
namespace cg = cooperative_groups;
#ifndef USE_XATTN_MFMA
#define USE_XATTN_MFMA 1
#endif
#ifndef USE_S5_GEMM
#define USE_S5_GEMM 1
#endif
#ifndef USE_DIL_MFMA
#define USE_DIL_MFMA 1
#endif

typedef unsigned short bf16_t;
using bf16x8 = __attribute__((ext_vector_type(8))) short;
using f32x4 = __attribute__((ext_vector_type(4))) float;
#define DI __device__ __forceinline__

constexpr int T_ = 32768, S_ = 4096;
constexpr size_t MiB = (size_t)1 << 20;
constexpr size_t SZ_SQ = (size_t)1024 * 1024, SZ_WIN = (size_t)3712 * 1024, SZ_GLU = (size_t)2048 * 1024,
                 SZ_GU = (size_t)5632 * 1024, SZ_WD = (size_t)1024 * 2816;
constexpr size_t SZ_COMMON = 4 * SZ_SQ + SZ_GU + SZ_WD;
constexpr size_t W_EVEN0 = 4 * SZ_COMMON;
constexpr size_t W_ODD0 = W_EVEN0 + 2 * (SZ_WIN + SZ_SQ);
constexpr float ALPHA = 1.681792830507429f;

constexpr size_t OFF_W = 0;
constexpr size_t OFF_ROPE = 125 * MiB;
constexpr size_t OFF_HB = 133 * MiB;
constexpr size_t OFF_KX = 197 * MiB;
constexpr size_t OFF_VX = 201 * MiB;
constexpr size_t OFF_BIG = 205 * MiB;
constexpr size_t OFF_BAR = 511 * MiB;
constexpr size_t OFF_DNQKV = OFF_BIG;
constexpr size_t OFF_Z = OFF_BIG + 96 * MiB;
constexpr size_t OFF_SWQ = OFF_BIG + 128 * MiB;
constexpr size_t OFF_SWK = OFF_BIG + 160 * MiB;
constexpr size_t OFF_SWV = OFF_BIG + 192 * MiB;
constexpr size_t OFF_LOGIT = OFF_BIG + 224 * MiB;
constexpr size_t OFF_QD = OFF_BIG + 225 * MiB;
constexpr size_t OFF_KD = OFF_BIG + 257 * MiB;
constexpr size_t OFF_INTRA = OFF_BIG + 289 * MiB;
constexpr size_t OFF_WB = OFF_HB;
constexpr size_t OFF_UB = OFF_HB + 32 * MiB;
constexpr size_t OFF_EG = OFF_KX;
constexpr size_t OFF_XQ = OFF_BIG;
constexpr size_t OFF_XO = OFF_BIG + 64 * MiB;
constexpr size_t OFF_ACT = OFF_BIG;
constexpr size_t OFF_HID = OFF_BIG;
constexpr size_t OFF_SIN = OFF_BIG + 64 * MiB;
constexpr size_t OFF_KTAB = OFF_BIG + 80 * MiB;
constexpr size_t OFF_ETAB = OFF_BIG + 82 * MiB;
constexpr size_t OFF_GTAB = OFF_BIG + 90 * MiB;
constexpr size_t OFF_AL = OFF_BIG + 98 * MiB;

struct Params {
  const float* x; const float* mem; const int* pos;
  const float* hyb_w_in; const float* dn_conv_w; const float* dn_a_log; const float* dn_dt_bias; const float* dn_norm_g; const float* hyb_w_out;
  const float* s5_a_re; const float* s5_a_im; const float* s5_log_dt; const float* s5_b_re; const float* s5_b_im; const float* s5_c_re; const float* s5_c_im;
  const float* s5_d; const float* s5_glu_wo; const float* s5_glu_wg;
  const float* ln_mix_g; const float* ln_mix_b;
  const float* xq_w; const float* xk_w; const float* xv_w; const float* xo_w; const float* ln_x_g; const float* ln_x_b;
  const float* ffn_wg; const float* ffn_wu; const float* ffn_wd; const float* ln_ffn_g; const float* ln_ffn_b;
  float* out; char* ws;
};
DI char* WS(const Params& p) { char* w = p.ws; asm volatile("" : "+s"(w)); return w; }

DI int TID() { int t = threadIdx.x; asm volatile("" : "+v"(t)); return t; }
DI int BID() { int t = blockIdx.x; asm volatile("" : "+s"(t)); return t; }
DI int GDIM() { int t = gridDim.x; asm volatile("" : "+s"(t)); return t; }
typedef float f32x2_t __attribute__((ext_vector_type(2)));
typedef __bf16 bf16x2_t __attribute__((ext_vector_type(2)));
DI bf16_t f2bf(float x) { return __builtin_bit_cast(bf16_t, (__bf16)x); }
DI float bf2f(bf16_t v) { return __uint_as_float(((unsigned)v) << 16); }
DI unsigned pack2(float a, float b) { f32x2_t v = {a, b}; return __builtin_bit_cast(unsigned, __builtin_convertvector(v, bf16x2_t)); }
using u32x4 = __attribute__((ext_vector_type(4))) unsigned;
using u32x2 = __attribute__((ext_vector_type(2))) unsigned;
DI bf16x8 pack8(f32x4 a, f32x4 b) {
  u32x4 t; t[0] = pack2(a[0], a[1]); t[1] = pack2(a[2], a[3]); t[2] = pack2(b[0], b[1]); t[3] = pack2(b[2], b[3]);
  return __builtin_bit_cast(bf16x8, t);
}
#define MFMA16(a, b, c) __builtin_amdgcn_mfma_f32_16x16x32_bf16((a), (b), (c), 0, 0, 0)
DI int kperm(int x) { return (x & ~31) | (((x >> 2) & 3) * 8 + ((x >> 4) & 1) * 4 + (x & 3)); }
DI float wave_sum(float v) { for (int o = 32; o > 0; o >>= 1) v += __shfl_xor(v, o); return v; }
DI float wave_max(float v) { for (int o = 32; o > 0; o >>= 1) v = fmaxf(v, __shfl_xor(v, o)); return v; }
DI float sigmoidf_(float x) { return __builtin_amdgcn_rcpf(1.f + __expf(-x)); }
DI float siluf_(float x) { return x * sigmoidf_(x); }
DI float softplusf_(float x) { return fmaxf(x, 0.f) + log1pf(__expf(-fabsf(x))); }
DI float gelu_tanh(float x) { float u = 0.7978845608028654f * (x + 0.044715f * x * x * x); return 0.5f * x * (1.f + tanhf(u)); }

template <class CM>
DI void transpose_job(bf16_t* dst, int Ndst, int K, int srcStride, CM colptr, float* tile) {
  const int ntk = K / 64, ntiles = (Ndst / 64) * ntk;
  const int tid = TID();
  for (int tl = BID(); tl < ntiles; tl += GDIM()) {
    const int r0 = (tl / ntk) * 64, k0 = (tl % ntk) * 64;
    const int q4 = tid & 15, kl0 = tid >> 4;
    const float* cp = colptr(r0 + 4 * q4);
    float4 v[4];
#pragma unroll
    for (int i = 0; i < 4; ++i) v[i] = cp ? *(const float4*)(cp + (size_t)(k0 + kl0 + 16 * i) * srcStride) : make_float4(0.f, 0.f, 0.f, 0.f);
#pragma unroll
    for (int i = 0; i < 4; ++i) {
      float* t = tile + (kl0 + 16 * i) * 65 + 4 * q4;
      t[0] = v[i].x; t[1] = v[i].y; t[2] = v[i].z; t[3] = v[i].w;
    }
    __syncthreads();
#pragma unroll
    for (int i = 0; i < 2; ++i) {
      const int c = tid + 256 * i, rr = c >> 3, kc = (c & 7) * 8;
      const float* t = tile + kc * 65 + rr;
      uint4 o;
      o.x = pack2(t[0], t[65]); o.y = pack2(t[2 * 65], t[3 * 65]); o.z = pack2(t[4 * 65], t[5 * 65]); o.w = pack2(t[6 * 65], t[7 * 65]);
      *(uint4*)(dst + (size_t)(r0 + rr) * K + k0 + kc) = o;
    }
    __syncthreads();
  }
}

DI void phase_prologue(const Params& p, float* smem) {
  bf16_t* W = (bf16_t*)(p.ws + OFF_W);
  for (int l = 0; l < 4; ++l) {
    bf16_t* wc = W + (size_t)l * SZ_COMMON;
    const float* s;
    s = p.xq_w + (size_t)l * SZ_SQ; transpose_job(wc, 1024, 1024, 1024, [=](int r) { return s + r; }, smem);
    s = p.xk_w + (size_t)l * SZ_SQ; transpose_job(wc + SZ_SQ, 1024, 1024, 1024, [=](int r) { return s + r; }, smem);
    s = p.xv_w + (size_t)l * SZ_SQ; transpose_job(wc + 2 * SZ_SQ, 1024, 1024, 1024, [=](int r) { return s + r; }, smem);
    s = p.xo_w + (size_t)l * SZ_SQ; transpose_job(wc + 3 * SZ_SQ, 1024, 1024, 1024, [=](int r) { return s + r; }, smem);
    {
      const float* g = p.ffn_wg + (size_t)l * 1024 * 2816; const float* u = p.ffn_wu + (size_t)l * 1024 * 2816;
      transpose_job(wc + 4 * SZ_SQ, 5632, 1024, 2816, [=](int r) { int c = (r >> 5) * 16 + (r & 15); return ((r >> 4) & 1) ? (u + c) : (g + c); }, smem);
    }
    s = p.ffn_wd + (size_t)l * 2816 * 1024; transpose_job(wc + 4 * SZ_SQ + SZ_GU, 1024, 2816, 1024, [=](int r) { return s + r; }, smem);
  }
  for (int i = 0; i < 2; ++i) {
    bf16_t* we = W + W_EVEN0 + (size_t)i * (SZ_WIN + SZ_SQ);
    const float* s = p.hyb_w_in + (size_t)i * 1024 * 3592;
    transpose_job(we, 3712, 1024, 3592, [=](int r) -> const float* {
      if (r < 2048) return s + r;
      if (r < 3584) return s + r + 8;
      if (r < 3592) return s + 2048 + (r - 3584);
      return nullptr; }, smem);
    const float* s2 = p.hyb_w_out + (size_t)i * SZ_SQ;
    transpose_job(we + SZ_WIN, 1024, 1024, 1024, [=](int r) { return s2 + r; }, smem);
    bf16_t* wo = W + W_ODD0 + (size_t)i * SZ_GLU;
    const float* a = p.s5_glu_wo + (size_t)i * SZ_SQ; const float* b = p.s5_glu_wg + (size_t)i * SZ_SQ;
    transpose_job(wo, 2048, 1024, 1024, [=](int r) { int c = (r >> 5) * 16 + (r & 15); return ((r >> 4) & 1) ? (b + c) : (a + c); }, smem);
  }
  const size_t gtid = (size_t)BID() * 256 + TID(), gsz = (size_t)GDIM() * 256;
  bf16_t* hb = (bf16_t*)(p.ws + OFF_HB);
  for (size_t i = gtid; i < (size_t)T_ * 256; i += gsz) {
    float4 v = ((const float4*)p.x)[i];
    ((float4*)p.out)[i] = v;
    uint2 o; o.x = pack2(v.x, v.y); o.y = pack2(v.z, v.w);
    ((uint2*)hb)[i] = o;
  }
  float* rc = (float*)(p.ws + OFF_ROPE); float* rs = rc + (size_t)T_ * 32;
  for (size_t i = gtid; i < (size_t)T_ * 32; i += gsz) {
    int t = (int)(i >> 5), j = (int)(i & 31);
    float invf = (float)exp(-(double)(2 * j) / 64.0 * 9.210340371976184);
    float ang = (float)p.pos[t] * invf;
    double a = (double)ang;
    double k = rint(a * 0.15915494309189535);
    float r = (float)(a - k * 6.283185307179586);
    rc[i] = cosf(r); rs[i] = sinf(r);
  }
}

constexpr int LDT = 72;
template <class AL, class BL, class EP>
DI void gemm_tile(int m0, int n0, int nks, AL aload, BL bload, EP epi, bf16_t* smem) {
  bf16_t* As = smem; bf16_t* Bs = smem + 2 * 128 * LDT;
  const int tid = TID(), lane = tid & 63, wave = tid >> 6;
  const int wm = wave >> 1, wn = wave & 1, l15 = lane & 15, quad = lane >> 4;
  const int lrow = tid >> 3, lkc = (tid & 7) * 8;
  f32x4 acc[4][4];
#pragma unroll
  for (int i = 0; i < 4; ++i)
#pragma unroll
    for (int j = 0; j < 4; ++j) acc[i][j] = f32x4{0.f, 0.f, 0.f, 0.f};
  uint4 ra0[4], rb0[4], ra1[4], rb1[4];
#pragma unroll
  for (int i = 0; i < 4; ++i) { ra0[i] = aload(m0 + lrow + 32 * i, 0, lkc); rb0[i] = bload(n0 + lrow + 32 * i, 0, lkc); }
#pragma unroll
  for (int i = 0; i < 4; ++i) { ra1[i] = aload(m0 + lrow + 32 * i, 1, lkc); rb1[i] = bload(n0 + lrow + 32 * i, 1, lkc); }
#pragma unroll
  for (int i = 0; i < 4; ++i) {
    *(uint4*)(As + (lrow + 32 * i) * LDT + lkc) = ra0[i];
    *(uint4*)(Bs + (lrow + 32 * i) * LDT + lkc) = rb0[i];
  }
  __syncthreads();
  auto compute = [&](int cur) {
    const bf16_t* Ab = As + cur * 128 * LDT; const bf16_t* Bb = Bs + cur * 128 * LDT;
#pragma unroll
    for (int kk = 0; kk < 2; ++kk) {
      bf16x8 a[4], b[4];
#pragma unroll
      for (int mt = 0; mt < 4; ++mt) a[mt] = *(const bf16x8*)(Ab + (wm * 64 + mt * 16 + l15) * LDT + kk * 32 + quad * 8);
#pragma unroll
      for (int nt = 0; nt < 4; ++nt) b[nt] = *(const bf16x8*)(Bb + (wn * 64 + nt * 16 + l15) * LDT + kk * 32 + quad * 8);
#pragma unroll
      for (int mt = 0; mt < 4; ++mt)
#pragma unroll
        for (int nt = 0; nt < 4; ++nt) acc[mt][nt] = __builtin_amdgcn_mfma_f32_16x16x32_bf16(b[nt], a[mt], acc[mt][nt], 0, 0, 0);
    }
  };
  for (int ks = 0; ks < nks; ks += 2) {
    {
      const int kq = (ks + 2 < nks) ? ks + 2 : 0;
#pragma unroll
      for (int i = 0; i < 4; ++i) { ra0[i] = aload(m0 + lrow + 32 * i, kq, lkc); rb0[i] = bload(n0 + lrow + 32 * i, kq, lkc); }
    }
    compute(0);
#pragma unroll
    for (int i = 0; i < 4; ++i) {
      *(uint4*)(As + 128 * LDT + (lrow + 32 * i) * LDT + lkc) = ra1[i];
      *(uint4*)(Bs + 128 * LDT + (lrow + 32 * i) * LDT + lkc) = rb1[i];
    }
    __syncthreads();
    {
      const int kq = (ks + 3 < nks) ? ks + 3 : 1;
#pragma unroll
      for (int i = 0; i < 4; ++i) { ra1[i] = aload(m0 + lrow + 32 * i, kq, lkc); rb1[i] = bload(n0 + lrow + 32 * i, kq, lkc); }
    }
    compute(1);
#pragma unroll
    for (int i = 0; i < 4; ++i) {
      *(uint4*)(As + (lrow + 32 * i) * LDT + lkc) = ra0[i];
      *(uint4*)(Bs + (lrow + 32 * i) * LDT + lkc) = rb0[i];
    }
    __syncthreads();
  }
  epi(acc, m0 + wm * 64, n0 + wn * 64);
}

DI void tile_of(int w, int mtiles, int ntiles, int xcd, int& m0, int& n0) {
  const int mper = mtiles >> 3, full = mper * 8;
  int gidx = w / full;
  const int ngroups = (ntiles + 7) >> 3;
  if (gidx > ngroups - 1) gidx = ngroups - 1;
  const int rest = w - gidx * full;
  const int wg = min(8, ntiles - 8 * gidx);
  const int ml = rest / wg, ni = 8 * gidx + (rest - ml * wg);
  m0 = (ml * 8 + xcd) * 128; n0 = ni * 128;
}
template <class AL, class BL, class EP>
DI void gemm_stream(int mtiles, int ntiles, int nks, AL aload, BL bload, EP epi, bf16_t* smem) {
  const int xcd = BID() & 7, slot = BID() >> 3, nslot = GDIM() >> 3;
  const int per = (mtiles >> 3) * ntiles;
  if (slot >= per) return;
  bf16_t* As = smem; bf16_t* Bs = smem + 2 * 128 * LDT;
  const int tid = TID(), lane = tid & 63, wave = tid >> 6;
  const int wm = wave >> 1, wc = wave & 1, l15 = lane & 15, quad = lane >> 4;
  const int lrow = tid >> 3, lkc = (tid & 7) * 8;
  f32x4 acc[4][4];
  uint4 ra0[4], rb0[4], ra1[4], rb1[4];
  int w = slot;
  int m0, n0;
  tile_of(w, mtiles, ntiles, xcd, m0, n0);
#pragma unroll
  for (int i = 0; i < 4; ++i) { ra0[i] = aload(m0 + lrow + 32 * i, 0, lkc); rb0[i] = bload(n0 + lrow + 32 * i, 0, lkc); }
#pragma unroll
  for (int i = 0; i < 4; ++i) { ra1[i] = aload(m0 + lrow + 32 * i, 1, lkc); rb1[i] = bload(n0 + lrow + 32 * i, 1, lkc); }
#pragma unroll
  for (int i = 0; i < 4; ++i) {
    *(uint4*)(As + (lrow + 32 * i) * LDT + lkc) = ra0[i];
    *(uint4*)(Bs + (lrow + 32 * i) * LDT + lkc) = rb0[i];
  }
  __syncthreads();
  auto compute = [&](int cur) {
    const bf16_t* Ab = As + cur * 128 * LDT; const bf16_t* Bb = Bs + cur * 128 * LDT;
#pragma unroll
    for (int kk = 0; kk < 2; ++kk) {
      bf16x8 a[4], b[4];
#pragma unroll
      for (int mt = 0; mt < 4; ++mt) a[mt] = *(const bf16x8*)(Ab + (wm * 64 + mt * 16 + l15) * LDT + kk * 32 + quad * 8);
#pragma unroll
      for (int nt = 0; nt < 4; ++nt) b[nt] = *(const bf16x8*)(Bb + (wc * 64 + nt * 16 + l15) * LDT + kk * 32 + quad * 8);
      __builtin_amdgcn_s_setprio(2);
#pragma unroll
      for (int mt = 0; mt < 4; ++mt)
#pragma unroll
        for (int nt = 0; nt < 4; ++nt) acc[mt][nt] = __builtin_amdgcn_mfma_f32_16x16x32_bf16(b[nt], a[mt], acc[mt][nt], 0, 0, 0);
      __builtin_amdgcn_s_setprio(0);
    }
  };
  for (;;) {
    const int wnext = w + nslot;
    const bool has_next = wnext < per;
    int m1 = m0, n1 = n0;
    if (has_next) tile_of(wnext, mtiles, ntiles, xcd, m1, n1);
#pragma unroll
    for (int i = 0; i < 4; ++i)
#pragma unroll
      for (int j = 0; j < 4; ++j) acc[i][j] = f32x4{0.f, 0.f, 0.f, 0.f};
    for (int ks = 0; ks < nks; ks += 2) {
      const bool in2 = ks + 2 < nks;
      {
        const int mm = in2 ? m0 : m1, nn = in2 ? n0 : n1, kq = in2 ? ks + 2 : 0;
#pragma unroll
        for (int i = 0; i < 4; ++i) { ra0[i] = aload(mm + lrow + 32 * i, kq, lkc); rb0[i] = bload(nn + lrow + 32 * i, kq, lkc); }
      }
      compute(0);
#pragma unroll
      for (int i = 0; i < 4; ++i) {
        *(uint4*)(As + 128 * LDT + (lrow + 32 * i) * LDT + lkc) = ra1[i];
        *(uint4*)(Bs + 128 * LDT + (lrow + 32 * i) * LDT + lkc) = rb1[i];
      }
      __syncthreads();
      {
        const int mm = in2 ? m0 : m1, nn = in2 ? n0 : n1, kq = in2 ? ks + 3 : 1;
#pragma unroll
        for (int i = 0; i < 4; ++i) { ra1[i] = aload(mm + lrow + 32 * i, kq, lkc); rb1[i] = bload(nn + lrow + 32 * i, kq, lkc); }
      }
      compute(1);
#pragma unroll
      for (int i = 0; i < 4; ++i) {
        *(uint4*)(As + (lrow + 32 * i) * LDT + lkc) = ra0[i];
        *(uint4*)(Bs + (lrow + 32 * i) * LDT + lkc) = rb0[i];
      }
      __syncthreads();
    }
    epi(acc, m0 + wm * 64, n0 + wc * 64);
    if (!has_next) break;
    w = wnext; m0 = m1; n0 = n1;
  }
}

template <class F>
DI void for_tiles(int mtiles, int ntiles, F f) {
  const int xcd = BID() & 7, slot = BID() >> 3, nslot = GDIM() >> 3;
  const int per = (mtiles >> 3) * ntiles;
  for (int w = slot; w < per; w += nslot) {
    int mi = w / ntiles, ni = w - mi * ntiles;
    f((mi * 8 + xcd), ni);
  }
}

#define EPI_LOOP for (int mt = 0; mt < 4; ++mt) for (int nt = 0; nt < 4; ++nt) for (int r = 0; r < 4; ++r)

struct LnRef { const float* g; const float* b; int slot; };
constexpr size_t OFF_LNST = 510 * MiB;
DI float4 ln_h4(const Params& p, const LnRef& r, int row, int col, float4 y) {
  if (r.slot < 0) return y;
  const float2 st = ((const float2*)(p.ws + OFF_LNST))[(size_t)r.slot * T_ + row];
  const float4 g = *(const float4*)(r.g + col), b = *(const float4*)(r.b + col);
  float4 h;
  h.x = (y.x - st.x) * st.y * g.x + b.x; h.y = (y.y - st.x) * st.y * g.y + b.y;
  h.z = (y.z - st.x) * st.y * g.z + b.z; h.w = (y.w - st.x) * st.y * g.w + b.w;
  return h;
}
DI void epi_resid(const Params& p, const LnRef& lr, f32x4 (&acc)[4][4], int rb, int cb) {
  const int lane = TID() & 63, l15 = lane & 15, quad = lane >> 4;
#pragma unroll
  for (int mt = 0; mt < 4; ++mt)
#pragma unroll
    for (int nt = 0; nt < 4; ++nt) {
      const int row = rb + mt * 16 + l15, col = cb + nt * 16 + quad * 4;
      float4* ptr = (float4*)(p.out + (size_t)row * 1024 + col);
      float4 h = ln_h4(p, lr, row, col, *ptr);
      h.x = ALPHA * h.x + acc[mt][nt][0]; h.y = ALPHA * h.y + acc[mt][nt][1]; h.z = ALPHA * h.z + acc[mt][nt][2]; h.w = ALPHA * h.w + acc[mt][nt][3];
      *ptr = h;
    }
}
DI void epi_bf16(bf16_t* dst, int ld, f32x4 (&acc)[4][4], int rb, int cb) {
  const int lane = TID() & 63, l15 = lane & 15, quad = lane >> 4;
#pragma unroll
  for (int mt = 0; mt < 4; ++mt)
#pragma unroll
    for (int nt = 0; nt < 4; ++nt) {
      u32x2 v; v[0] = pack2(acc[mt][nt][0], acc[mt][nt][1]); v[1] = pack2(acc[mt][nt][2], acc[mt][nt][3]);
      *(u32x2*)(dst + (size_t)(rb + mt * 16 + l15) * ld + cb + nt * 16 + quad * 4) = v;
    }
}

struct PlainLoad {
  const bf16_t* base; int ld;
  DI uint4 operator()(int row, int ks, int kc) const { return *(const uint4*)((const char*)base + (unsigned)((row * ld + ks * 64 + kc) * 2)); }
};

DI void phase_proj(const Params& p, int i, bf16_t* smem) {
  const bf16_t* W = (const bf16_t*)(p.ws + OFF_W) + W_EVEN0 + (size_t)i * (SZ_WIN + SZ_SQ);
  PlainLoad al{(const bf16_t*)(p.ws + OFF_HB), 1024}, bl{W, 1024};
  bf16_t* dnqkv = (bf16_t*)(p.ws + OFF_DNQKV); bf16_t* z = (bf16_t*)(p.ws + OFF_Z);
  bf16_t* swq = (bf16_t*)(p.ws + OFF_SWQ); bf16_t* swk = (bf16_t*)(p.ws + OFF_SWK); bf16_t* swv = (bf16_t*)(p.ws + OFF_SWV);
  float* logit = (float*)(p.ws + OFF_LOGIT);
  const float* rc = (const float*)(p.ws + OFF_ROPE); const float* rs = rc + (size_t)T_ * 32;
  {
    gemm_stream(256, 29, 16, al, bl, [&](f32x4 (&acc)[4][4], int rb, int cb) {
      const int lane = TID() & 63, l15 = lane & 15, quad = lane >> 4;
      if (cb < 1536) epi_bf16(dnqkv, 1536, acc, rb, cb);
      else if (cb < 2048) epi_bf16(z, 512, acc, rb, cb - 1536);
      else if (cb < 3072) {
        bf16_t* dst = (cb < 2560) ? swq : swk; const int c0 = (cb < 2560) ? cb - 2048 : cb - 2560;
#pragma unroll
        for (int mt = 0; mt < 4; ++mt) {
          const int row = rb + mt * 16 + l15;
#pragma unroll
          for (int nt = 0; nt < 2; ++nt) {
            const int d = nt * 16 + quad * 4;
            const float4 c = *(const float4*)(rc + (size_t)row * 32 + d), sn = *(const float4*)(rs + (size_t)row * 32 + d);
            const f32x4 x1 = acc[mt][nt], x2 = acc[mt][nt + 2];
            u32x2 o1, o2;
            o1[0] = pack2(x1[0] * c.x - x2[0] * sn.x, x1[1] * c.y - x2[1] * sn.y); o1[1] = pack2(x1[2] * c.z - x2[2] * sn.z, x1[3] * c.w - x2[3] * sn.w);
            o2[0] = pack2(x2[0] * c.x + x1[0] * sn.x, x2[1] * c.y + x1[1] * sn.y); o2[1] = pack2(x2[2] * c.z + x1[2] * sn.z, x2[3] * c.w + x1[3] * sn.w);
            *(u32x2*)(dst + (size_t)row * 512 + c0 + d) = o1;
            *(u32x2*)(dst + (size_t)row * 512 + c0 + d + 32) = o2;
          }
        }
      } else if (cb < 3584) epi_bf16(swv, 512, acc, rb, cb - 3072);
      else if (cb == 3584) {
        if (quad < 2) {
#pragma unroll
          for (int mt = 0; mt < 4; ++mt)
            *(float4*)(logit + (size_t)(rb + mt * 16 + l15) * 8 + quad * 4) = make_float4(acc[mt][0][0], acc[mt][0][1], acc[mt][0][2], acc[mt][0][3]);
        }
      }
    }, smem);
  }
}

DI void phase_dil_attn(const Params& p, int first, int nblk);

DI void phase_dn_prep(const Params& p, int i, char* smem) {
  bf16_t* qs = (bf16_t*)smem; bf16_t* ks = qs + 64 * 136; bf16_t* vs = ks + 64 * 136;
  float* Lm = (float*)(smem + 3 * 17408); float* beta = Lm + 64 * 68; float* gcum = beta + 64; float* egc = gcum + 64;
  const bf16_t* dnqkv = (const bf16_t*)(WS(p) + OFF_DNQKV);
  const float* logit = (const float*)(WS(p) + OFF_LOGIT);
  bf16_t* qd_g = (bf16_t*)(WS(p) + OFF_QD); bf16_t* kd_g = (bf16_t*)(WS(p) + OFF_KD); bf16_t* in_g = (bf16_t*)(WS(p) + OFF_INTRA);
  bf16_t* w_g = (bf16_t*)(WS(p) + OFF_WB); bf16_t* u_g = (bf16_t*)(WS(p) + OFF_UB); float* eg_g = (float*)(WS(p) + OFF_EG);
  const float* cw = p.dn_conv_w + (size_t)i * 4 * 1536;
  const int tid = TID(), wave = tid >> 6, lane = tid & 63, l15 = lane & 15, quad = lane >> 4;
  const float QS = 0.08838834764831845f;
  for (int item = BID(); item < 2048; item += GDIM()) {
    const int b = item >> 8, h = (item >> 6) & 3, n = item & 63;
    const int t0 = b * 4096 + n * 64, s0 = n * 64;
    const float A = __expf(p.dn_a_log[i * 4 + h]), dtb = p.dn_dt_bias[i * 4 + h];
    {
      float cw0[3][4], cw1[3][4], x0[3][4], x1[3][4];
#pragma unroll
      for (int which = 0; which < 3; ++which)
#pragma unroll
        for (int j = 0; j < 4; ++j) {
          const int col = which * 512 + h * 128 + lane * 2;
          cw0[which][j] = cw[j * 1536 + col]; cw1[which][j] = cw[j * 1536 + col + 1];
        }
      const int ilb = wave * 16;
#pragma unroll
      for (int which = 0; which < 3; ++which)
#pragma unroll
        for (int j = 0; j < 3; ++j) {
          const int sq = s0 + ilb - 3 + j;
          unsigned v = 0u;
          if (sq >= 0) v = *(const unsigned*)(dnqkv + (size_t)(t0 + ilb - 3 + j) * 1536 + which * 512 + h * 128 + lane * 2);
          x0[which][j + 1] = bf2f((bf16_t)(v & 0xffff)); x1[which][j + 1] = bf2f((bf16_t)(v >> 16));
        }
#pragma unroll 4
      for (int tt = 0; tt < 16; ++tt) {
        const int il = ilb + tt;
#pragma unroll
        for (int which = 0; which < 3; ++which) {
          x0[which][0] = x0[which][1]; x0[which][1] = x0[which][2]; x0[which][2] = x0[which][3];
          x1[which][0] = x1[which][1]; x1[which][1] = x1[which][2]; x1[which][2] = x1[which][3];
          const unsigned v = *(const unsigned*)(dnqkv + (size_t)(t0 + il) * 1536 + which * 512 + h * 128 + lane * 2);
          x0[which][3] = bf2f((bf16_t)(v & 0xffff)); x1[which][3] = bf2f((bf16_t)(v >> 16));
          float y0 = cw0[which][0] * x0[which][0] + cw0[which][1] * x0[which][1] + cw0[which][2] * x0[which][2] + cw0[which][3] * x0[which][3];
          float y1 = cw1[which][0] * x1[which][0] + cw1[which][1] * x1[which][1] + cw1[which][2] * x1[which][2] + cw1[which][3] * x1[which][3];
          y0 = siluf_(y0); y1 = siluf_(y1);
          if (which < 2) {
            float ss = wave_sum(y0 * y0 + y1 * y1);
            float sc = rsqrtf(ss + 1e-6f);
            y0 *= sc; y1 *= sc;
          }
          bf16_t* dst = (which == 0) ? qs : (which == 1 ? ks : vs);
          *(unsigned*)(dst + il * 136 + lane * 2) = pack2(y0, y1);
        }
      }
    }
    if (wave == 0) {
      const size_t row = (size_t)(t0 + lane);
      const float bl = logit[row * 8 + h], al = logit[row * 8 + 4 + h];
      float g = -A * softplusf_(al + dtb);
#pragma unroll
      for (int o = 1; o < 64; o <<= 1) { float v = __shfl_up(g, o); if (lane >= o) g += v; }
      beta[lane] = sigmoidf_(bl); gcum[lane] = g; egc[lane] = __expf(g);
    }
    __syncthreads();
    {
      f32x4 kk[4], qk[4];
#pragma unroll
      for (int nt = 0; nt < 4; ++nt) { kk[nt] = f32x4{0.f, 0.f, 0.f, 0.f}; qk[nt] = f32x4{0.f, 0.f, 0.f, 0.f}; }
#pragma unroll
      for (int k4 = 0; k4 < 4; ++k4) {
        const bf16x8 ak = *(const bf16x8*)(ks + (wave * 16 + l15) * 136 + k4 * 32 + quad * 8);
        const bf16x8 aq = *(const bf16x8*)(qs + (wave * 16 + l15) * 136 + k4 * 32 + quad * 8);
#pragma unroll
        for (int nt = 0; nt < 4; ++nt) {
          const bf16x8 bk = *(const bf16x8*)(ks + (nt * 16 + l15) * 136 + k4 * 32 + quad * 8);
          kk[nt] = MFMA16(ak, bk, kk[nt]); qk[nt] = MFMA16(aq, bk, qk[nt]);
        }
      }
#pragma unroll
      for (int nt = 0; nt < 4; ++nt)
#pragma unroll
        for (int r = 0; r < 4; ++r) {
          const int ii = wave * 16 + quad * 4 + r, jj = nt * 16 + l15;
          const float dec = (jj <= ii) ? __expf(gcum[ii] - gcum[jj]) : 0.f;
          Lm[ii * 68 + jj] = (jj < ii) ? beta[ii] * kk[nt][r] * dec : 0.f;
          in_g[(size_t)item * 4096 + ii * 64 + kperm(jj)] = f2bf(qk[nt][r] * QS * dec);
        }
    }
    __syncthreads();
    {
      float x[64];
#pragma unroll
      for (int ii = 0; ii < 64; ++ii) x[ii] = 0.f;
      const int c = tid & 127;
      const bool isw = tid >= 128;
      bf16_t* dstb = (isw ? w_g : u_g) + (size_t)item * 8192 + (isw ? kperm(c) : c);
      const bf16_t* srcb = (isw ? ks : vs) + c;
#pragma unroll
      for (int ii = 0; ii < 64; ++ii) {
        float acc = bf2f(srcb[ii * 136]) * beta[ii] * (isw ? egc[ii] : 1.f);
#pragma unroll
        for (int j4 = 0; j4 < (ii + 3) / 4; ++j4) {
          const float4 l4 = *(const float4*)(Lm + ii * 68 + j4 * 4);
          acc -= l4.x * x[j4 * 4]; acc -= l4.y * x[j4 * 4 + 1]; acc -= l4.z * x[j4 * 4 + 2]; acc -= l4.w * x[j4 * 4 + 3];
        }
        x[ii] = acc;
        dstb[ii * 128] = f2bf(acc);
        if ((ii & 3) == 3) __builtin_amdgcn_sched_barrier(0);
      }
    }
    {
      const float gl = gcum[63];
#pragma unroll 4
      for (int k = 0; k < 32; ++k) {
        const int e = tid + 256 * k;
        const int ii = e >> 7, d = e & 127;
        qd_g[(size_t)item * 8192 + ii * 128 + kperm(d)] = f2bf(bf2f(qs[ii * 136 + d]) * QS * egc[ii]);
        const int d2 = e >> 6, i2 = e & 63;
        kd_g[(size_t)item * 8192 + d2 * 64 + kperm(i2)] = f2bf(bf2f(ks[i2 * 136 + d2]) * __expf(gl - gcum[i2]));
      }
      if (tid == 0) eg_g[item] = __expf(gl);
    }
    __syncthreads();
  }
}

DI bf16x8 ld2(const bf16_t* ptr) {
  u32x2 lo = *(const u32x2*)ptr, hi = *(const u32x2*)(ptr + 16);
  u32x4 t; t[0] = lo[0]; t[1] = lo[1]; t[2] = hi[0]; t[3] = hi[1];
  return __builtin_bit_cast(bf16x8, t);
}

DI void dn_chain_item(const Params& p, int item, bf16_t* smem) {
  const int tid = TID(), wave = tid >> 6, lane = tid & 63, l15 = lane & 15, quad = lane >> 4;
  const int bh = item >> 1, half = item & 1;
  const int e0 = half * 64 + wave * 16 + l15;
  const bf16_t* qd_g = (const bf16_t*)(WS(p) + OFF_QD); const bf16_t* kd_g = (const bf16_t*)(WS(p) + OFF_KD); const bf16_t* in_g = (const bf16_t*)(WS(p) + OFF_INTRA);
  const bf16_t* w_g = (const bf16_t*)(WS(p) + OFF_WB); bf16_t* u_g = (bf16_t*)(WS(p) + OFF_UB); const float* eg_g = (const float*)(WS(p) + OFF_EG);
  bf16_t* wl = smem; bf16_t* ql = wl + 64 * 136; bf16_t* kl = ql + 64 * 136; bf16_t* il = kl + 128 * 72; bf16_t* ul = il + 64 * 72;
  uint4 rw0, rw1, rw2, rw3, rq0, rq1, rq2, rq3, rk0, rk1, rk2, rk3, ri0, ri1, ru0, ru1;
#define CH_GLOAD(n_) do { const size_t ci_ = (size_t)bh * 64 + (n_); \
    const bf16_t* w_ = w_g + ci_ * 8192 + tid * 8; const bf16_t* q_ = qd_g + ci_ * 8192 + tid * 8; const bf16_t* k_ = kd_g + ci_ * 8192 + tid * 8; \
    rw0 = *(const uint4*)(w_); rw1 = *(const uint4*)(w_ + 2048); rw2 = *(const uint4*)(w_ + 4096); rw3 = *(const uint4*)(w_ + 6144); \
    rq0 = *(const uint4*)(q_); rq1 = *(const uint4*)(q_ + 2048); rq2 = *(const uint4*)(q_ + 4096); rq3 = *(const uint4*)(q_ + 6144); \
    rk0 = *(const uint4*)(k_); rk1 = *(const uint4*)(k_ + 2048); rk2 = *(const uint4*)(k_ + 4096); rk3 = *(const uint4*)(k_ + 6144); \
    ri0 = *(const uint4*)(in_g + ci_ * 4096 + tid * 8); ri1 = *(const uint4*)(in_g + ci_ * 4096 + 2048 + tid * 8); \
    ru0 = *(const uint4*)(u_g + ci_ * 8192 + (tid >> 3) * 128 + half * 64 + (tid & 7) * 8); \
    ru1 = *(const uint4*)(u_g + ci_ * 8192 + (32 + (tid >> 3)) * 128 + half * 64 + (tid & 7) * 8); } while (0)
#define CH_LSTORE() do { \
    bf16_t* w_ = wl + (tid >> 4) * 136 + (tid & 15) * 8; bf16_t* q_ = ql + (tid >> 4) * 136 + (tid & 15) * 8; bf16_t* k_ = kl + (tid >> 3) * 72 + (tid & 7) * 8; \
    *(uint4*)(w_) = rw0; *(uint4*)(w_ + 16 * 136) = rw1; *(uint4*)(w_ + 32 * 136) = rw2; *(uint4*)(w_ + 48 * 136) = rw3; \
    *(uint4*)(q_) = rq0; *(uint4*)(q_ + 16 * 136) = rq1; *(uint4*)(q_ + 32 * 136) = rq2; *(uint4*)(q_ + 48 * 136) = rq3; \
    *(uint4*)(k_) = rk0; *(uint4*)(k_ + 32 * 72) = rk1; *(uint4*)(k_ + 64 * 72) = rk2; *(uint4*)(k_ + 96 * 72) = rk3; \
    *(uint4*)(il + (tid >> 3) * 72 + (tid & 7) * 8) = ri0; *(uint4*)(il + (32 + (tid >> 3)) * 72 + (tid & 7) * 8) = ri1; \
    *(uint4*)(ul + (tid >> 3) * 72 + (tid & 7) * 8) = ru0; *(uint4*)(ul + (32 + (tid >> 3)) * 72 + (tid & 7) * 8) = ru1; } while (0)
  f32x4 S[8];
#pragma unroll
  for (int mt = 0; mt < 8; ++mt) S[mt] = f32x4{0.f, 0.f, 0.f, 0.f};
  CH_GLOAD(0);
  CH_LSTORE();
  __syncthreads();
#pragma unroll 1
  for (int n = 0; n < 64; ++n) {
    const size_t ci = (size_t)bh * 64 + n;
    if (n + 1 < 64) CH_GLOAD(n + 1);
    bf16_t* ub = u_g + ci * 8192;
    const float eg = eg_g[ci];
    bf16x8 sb[4];
#pragma unroll
    for (int s = 0; s < 4; ++s) sb[s] = pack8(S[2 * s], S[2 * s + 1]);
    f32x4 vn[4];
#pragma unroll
    for (int it = 0; it < 4; ++it) {
      f32x4 a = {0.f, 0.f, 0.f, 0.f};
#pragma unroll
      for (int s = 0; s < 4; ++s) a = MFMA16(*(const bf16x8*)(wl + (it * 16 + l15) * 136 + s * 32 + quad * 8), sb[s], a);
#pragma unroll
      for (int r = 0; r < 4; ++r) vn[it][r] = bf2f(ul[(it * 16 + quad * 4 + r) * 72 + wave * 16 + l15]) - a[r];
    }
    bf16x8 vb[2];
    vb[0] = pack8(vn[0], vn[1]); vb[1] = pack8(vn[2], vn[3]);
#pragma unroll
    for (int it = 0; it < 4; ++it) {
      f32x4 a = {0.f, 0.f, 0.f, 0.f};
#pragma unroll
      for (int s = 0; s < 4; ++s) a = MFMA16(*(const bf16x8*)(ql + (it * 16 + l15) * 136 + s * 32 + quad * 8), sb[s], a);
#pragma unroll
      for (int s = 0; s < 2; ++s) a = MFMA16(*(const bf16x8*)(il + (it * 16 + l15) * 72 + s * 32 + quad * 8), vb[s], a);
#pragma unroll
      for (int r = 0; r < 4; ++r) ub[(it * 16 + quad * 4 + r) * 128 + e0] = f2bf(a[r]);
    }
#pragma unroll
    for (int mt = 0; mt < 8; ++mt) {
      f32x4 a = S[mt];
      a[0] *= eg; a[1] *= eg; a[2] *= eg; a[3] *= eg;
#pragma unroll
      for (int s = 0; s < 2; ++s) a = MFMA16(*(const bf16x8*)(kl + (mt * 16 + l15) * 72 + s * 32 + quad * 8), vb[s], a);
      S[mt] = a;
    }
    __syncthreads();
    if (n + 1 < 64) CH_LSTORE();
    __syncthreads();
  }
}

DI void phase_mix(const Params& p, int i, bf16_t* smem) {
  if (BID() < 64) { dn_chain_item(p, BID(), smem); return; }
  phase_dil_attn(p, BID() - 64, GDIM() - 64);
}

DI void phase_dn_post(const Params& p, int i) {
  const bf16_t* ob = (const bf16_t*)(p.ws + OFF_UB);
  bf16_t* z = (bf16_t*)(p.ws + OFF_Z);
  const float* ng = p.dn_norm_g + i * 128;
  const int wave = TID() >> 6, lane = TID() & 63;
  const float g0 = ng[lane * 2], g1 = ng[lane * 2 + 1];
  const int N = T_ * 4;
  for (int base = (BID() * 4 + wave) * 4; base < N; base += GDIM() * 16) {
    unsigned ov[4], zv[4];
#pragma unroll
    for (int j = 0; j < 4; ++j) {
      const int item = base + j;
      const int t = item >> 2, h = item & 3, b = t >> 12, sidx = t & 4095;
      const size_t og = ((size_t)((b * 4 + h) * 64 + (sidx >> 6))) * 8192 + (sidx & 63) * 128 + lane * 2;
      ov[j] = *(const unsigned*)(ob + og);
      zv[j] = *(const unsigned*)(z + (size_t)item * 128 + lane * 2);
    }
#pragma unroll
    for (int j = 0; j < 4; ++j) {
      const float o0 = bf2f((bf16_t)(ov[j] & 0xffff)), o1 = bf2f((bf16_t)(ov[j] >> 16));
      const float z0 = bf2f((bf16_t)(zv[j] & 0xffff)), z1 = bf2f((bf16_t)(zv[j] >> 16));
      const float ms = wave_sum(o0 * o0 + o1 * o1) * (1.f / 128.f);
      const float rr = rsqrtf(ms + 1e-6f);
      *(unsigned*)(z + (size_t)(base + j) * 128 + lane * 2) = pack2(o0 * rr * g0 * siluf_(z0), o1 * rr * g1 * siluf_(z1));
    }
  }
}

struct MixLoad {
  const bf16_t* a; const bf16_t* b;
  DI uint4 operator()(int row, int ks, int kc) const {
    const unsigned off = (unsigned)((row * 512 + (ks & 7) * 64 + kc) * 2);
    return *(const uint4*)((const char*)((ks < 8) ? a : b) + off);
  }
};

DI void phase_wout(const Params& p, int i, bf16_t* smem, LnRef lr) {
  const bf16_t* W = (const bf16_t*)(p.ws + OFF_W) + W_EVEN0 + (size_t)i * (SZ_WIN + SZ_SQ) + SZ_WIN;
  MixLoad al{(const bf16_t*)(p.ws + OFF_Z), (const bf16_t*)(p.ws + OFF_SWQ)};
  PlainLoad bl{W, 1024};
  {
    gemm_stream(256, 8, 16, al, bl, [&](f32x4 (&acc)[4][4], int rb, int cb) { epi_resid(p, lr, acc, rb, cb); }, smem);
  }
}

template <int R>
DI void ln_rows(const Params& p, int row0, const float* g, const float* b, int lane, int slot, bool final_out) {
  bf16_t* hb = (bf16_t*)(p.ws + OFF_HB);
  float2* lnst = (float2*)(p.ws + OFF_LNST) + (size_t)slot * T_;
  float4 v[R][4];
#pragma unroll
  for (int j = 0; j < R; ++j)
#pragma unroll
    for (int i = 0; i < 4; ++i) v[j][i] = ((const float4*)(p.out + (size_t)(row0 + j) * 1024))[lane + 64 * i];
  float4 gg[4], bb[4];
#pragma unroll
  for (int i = 0; i < 4; ++i) { gg[i] = ((const float4*)g)[lane + 64 * i]; bb[i] = ((const float4*)b)[lane + 64 * i]; }
#pragma unroll
  for (int j = 0; j < R; ++j) {
    float s = 0.f;
#pragma unroll
    for (int i = 0; i < 4; ++i) s += v[j][i].x + v[j][i].y + v[j][i].z + v[j][i].w;
    const float mu = wave_sum(s) * (1.f / 1024.f);
    float q = 0.f;
#pragma unroll
    for (int i = 0; i < 4; ++i) { float a = v[j][i].x - mu, b2 = v[j][i].y - mu, c = v[j][i].z - mu, d = v[j][i].w - mu; q += a * a + b2 * b2 + c * c + d * d; }
    const float rstd = rsqrtf(wave_sum(q) * (1.f / 1024.f) + 1e-5f);
    if (lane == 0) lnst[row0 + j] = make_float2(mu, rstd);
    float4* y = (float4*)(p.out + (size_t)(row0 + j) * 1024);
#pragma unroll
    for (int i = 0; i < 4; ++i) {
      float4 o;
      o.x = (v[j][i].x - mu) * rstd * gg[i].x + bb[i].x; o.y = (v[j][i].y - mu) * rstd * gg[i].y + bb[i].y;
      o.z = (v[j][i].z - mu) * rstd * gg[i].z + bb[i].z; o.w = (v[j][i].w - mu) * rstd * gg[i].w + bb[i].w;
      if (final_out) y[lane + 64 * i] = o;
      uint2 ob; ob.x = pack2(o.x, o.y); ob.y = pack2(o.z, o.w);
      ((uint2*)(hb + (size_t)(row0 + j) * 1024))[lane + 64 * i] = ob;
    }
  }
}
DI void phase_ln(const Params& p, const float* g, const float* b, int slot, bool final_out) {
  const int wave = TID() >> 6, lane = TID() & 63;
  for (int row = (BID() * 4 + wave) * 4; row < T_; row += GDIM() * 16) ln_rows<4>(p, row, g, b, lane, slot, final_out);
}

DI void phase_s5_naive(const Params& p, int i) {
  const int wave = TID() >> 6, lane = TID() & 63;
  bf16_t* hid = (bf16_t*)(p.ws + OFF_HID);
  for (int base = BID() * 4; base < 512; base += GDIM() * 4) {
    const int item = base + wave, b = item >> 6, g = item & 63;
    const int gp = (i * 64 + g) * 64 + lane;
    const double dt = exp((double)p.s5_log_dt[i * 64 + g]);
    const double are = p.s5_a_re[gp], aim = p.s5_a_im[gp];
    const double lr = are * dt, li = aim * dt;
    const double kk = rint(li * 0.15915494309189535);
    const double red = li - kk * 6.283185307179586;
    const double e = exp(lr);
    const double abr = e * cos(red), abi = e * sin(red);
    const double den = are * are + aim * aim;
    const double nr = abr - 1.0, ni = abi;
    const double cfr = (nr * are + ni * aim) / den, cfi = (ni * are - nr * aim) / den;
    float bbr[16], bbi[16], cr[16], ci[16];
#pragma unroll
    for (int h = 0; h < 16; ++h) {
      const double br = p.s5_b_re[(size_t)gp * 16 + h], bi = p.s5_b_im[(size_t)gp * 16 + h];
      bbr[h] = (float)(cfr * br - cfi * bi); bbi[h] = (float)(cfr * bi + cfi * br);
      cr[h] = p.s5_c_re[((size_t)(i * 64 + g) * 16 + h) * 64 + lane];
      ci[h] = p.s5_c_im[((size_t)(i * 64 + g) * 16 + h) * 64 + lane];
    }
    const float ar = (float)abr, ai = (float)abi;
    const float dsk = p.s5_d[i * 1024 + g * 16 + (lane & 15)];
    float sr = 0.f, si = 0.f;
#pragma unroll 1
    for (int t = 0; t < S_; ++t) {
      const size_t row = (size_t)(b * S_ + t);
      const float4* up = (const float4*)(p.out + row * 1024 + g * 16);
      float u[16];
#pragma unroll
      for (int j = 0; j < 4; ++j) { float4 v = up[j]; u[4 * j] = v.x; u[4 * j + 1] = v.y; u[4 * j + 2] = v.z; u[4 * j + 3] = v.w; }
      float bur = 0.f, bui = 0.f;
#pragma unroll
      for (int h = 0; h < 16; ++h) { bur += bbr[h] * u[h]; bui += bbi[h] * u[h]; }
      const float nsr = ar * sr - ai * si + bur, nsi = ar * si + ai * sr + bui;
      sr = nsr; si = nsi;
      float yk = 0.f, uk = 0.f;
#pragma unroll
      for (int h = 0; h < 16; ++h) {
        float v = wave_sum(cr[h] * sr - ci[h] * si);
        if (lane == h) { yk = v; uk = u[h]; }
      }
      if (lane < 16) hid[row * 1024 + g * 16 + lane] = f2bf(gelu_tanh(yk + dsk * uk));
    }
  }
}

DI void phase_s5_tables(const Params& p, int i, float* smem) {
  float2* pw = (float2*)smem;
  float2* bb = pw + 64 * 33;
  float2* cc = bb + 64 * 16;
  bf16_t* Ktab = (bf16_t*)(p.ws + OFF_KTAB); bf16_t* Etab = (bf16_t*)(p.ws + OFF_ETAB); bf16_t* Gtab = (bf16_t*)(p.ws + OFF_GTAB);
  float2* AL = (float2*)(p.ws + OFF_AL);
  const int tid = TID();
  for (int item = BID(); item < 512; item += GDIM()) {
    const int g = item >> 3, part = item & 7;
    const double dt = exp((double)p.s5_log_dt[i * 64 + g]);
    for (int e = tid; e < 64 * 33; e += 256) {
      const int pp = e / 33, n = e - pp * 33;
      const double are = p.s5_a_re[(i * 64 + g) * 64 + pp], aim = p.s5_a_im[(i * 64 + g) * 64 + pp];
      const double lr = are * dt * n, li = aim * dt * n;
      const double k = rint(li * 0.15915494309189535);
      const double red = li - k * 6.283185307179586;
      const double ex = exp(lr);
      pw[e] = make_float2((float)(ex * cos(red)), (float)(ex * sin(red)));
    }
    for (int e = tid; e < 1024; e += 256) {
      const int pp = e >> 4;
      const int gp = (i * 64 + g) * 64 + pp;
      const double are = p.s5_a_re[gp], aim = p.s5_a_im[gp];
      const double lr = are * dt, li = aim * dt;
      const double k = rint(li * 0.15915494309189535);
      const double red = li - k * 6.283185307179586;
      const double ex = exp(lr);
      const double nr = ex * cos(red) - 1.0, ni = ex * sin(red);
      const double den = are * are + aim * aim;
      const double cfr = (nr * are + ni * aim) / den, cfi = (ni * are - nr * aim) / den;
      const double br = p.s5_b_re[(size_t)gp * 16 + (e & 15)], bi = p.s5_b_im[(size_t)gp * 16 + (e & 15)];
      bb[e] = make_float2((float)(cfr * br - cfi * bi), (float)(cfr * bi + cfi * br));
      const size_t ci = ((size_t)(i * 64 + g) * 16 + (e >> 6)) * 64 + (e & 63);
      cc[e] = make_float2(p.s5_c_re[ci], p.s5_c_im[ci]);
    }
    __syncthreads();
    for (int e = part * 1024 + tid; e < (part + 1) * 1024; e += 256) {
      const int tau = e >> 8, ho = (e >> 4) & 15, hi = e & 15;
      float acc = 0.f;
      for (int pp = 0; pp < 64; ++pp) {
        const float2 c = cc[ho * 64 + pp], w = pw[pp * 33 + tau], b = bb[pp * 16 + hi];
        const float cwr = c.x * w.x - c.y * w.y, cwi = c.x * w.y + c.y * w.x;
        acc += cwr * b.x - cwi * b.y;
      }
      Ktab[(size_t)g * 8192 + e] = f2bf(acc);
    }
    for (int e = part * 8192 + tid; e < (part + 1) * 8192; e += 256) {
      const int pc = e >> 9, sidx = (e >> 4) & 31, hi = e & 15, pp = pc & 63;
      const float2 w = pw[pp * 33 + 31 - sidx], b = bb[pp * 16 + hi];
      const float v = (pc < 64) ? (w.x * b.x - w.y * b.y) : (w.x * b.y + w.y * b.x);
      Etab[(size_t)g * 65536 + e] = f2bf(v);
    }
    for (int e = part * 8192 + tid; e < (part + 1) * 8192; e += 256) {
      const int row = e >> 7, pc = e & 127, pp = pc & 63, t = row >> 4, ho = row & 15;
      const float2 c = cc[ho * 64 + pp], w = pw[pp * 33 + t + 1];
      const float v = (pc < 64) ? (c.x * w.x - c.y * w.y) : -(c.x * w.y + c.y * w.x);
      Gtab[(size_t)g * 65536 + e] = f2bf(v);
    }
    if (tid < 64 && part == 0) AL[g * 64 + tid] = pw[tid * 33 + 32];
    __syncthreads();
  }
}

DI void phase_s5_end(const Params& p, bf16_t* smem) {
  const bf16_t* Etab = (const bf16_t*)(p.ws + OFF_ETAB); const bf16_t* hb = (const bf16_t*)(p.ws + OFF_HB);
  const float2* AL = (const float2*)(p.ws + OFF_AL);
  bf16_t* sin_ = (bf16_t*)(p.ws + OFF_SIN);
  float* endbuf = (float*)smem;
  for (int item = BID(); item < 512; item += GDIM()) {
    const int g = item >> 3, b = item & 7;
    auto al = [=](int row, int ks, int kc) { return *(const uint4*)((const char*)Etab + (unsigned)((((g * 128 + row) * 512) + ks * 64 + kc) * 2)); };
    auto bl = [=](int n, int ks, int kc) {
      const int k = ks * 64 + kc, sidx = k >> 4, hi0 = k & 15;
      return *(const uint4*)((const char*)hb + (unsigned)(((b * 4096 + n * 32 + sidx) * 1024 + g * 16 + hi0) * 2));
    };
    gemm_tile(0, 0, 8, al, bl, [&](f32x4 (&acc)[4][4], int rb, int cb) {
      const int lane = TID() & 63, l15 = lane & 15, quad = lane >> 4;
#pragma unroll
      for (int mt = 0; mt < 4; ++mt)
#pragma unroll
        for (int nt = 0; nt < 4; ++nt)
#pragma unroll
          for (int r = 0; r < 4; ++r) endbuf[(rb + mt * 16 + l15) * 129 + cb + nt * 16 + quad * 4 + r] = acc[mt][nt][r];
    }, smem);
    __syncthreads();
    if (TID() < 64) {
      const int pp = TID();
      const float2 a = AL[g * 64 + pp];
      float sr = 0.f, si = 0.f;
      for (int n = 0; n < 128; ++n) {
        bf16_t* dst = sin_ + ((size_t)g * 1024 + b * 128 + n) * 128;
        dst[pp] = f2bf(sr); dst[64 + pp] = f2bf(si);
        const float er = endbuf[pp * 129 + n], ei = endbuf[(64 + pp) * 129 + n];
        const float nr = a.x * sr - a.y * si + er, ni = a.x * si + a.y * sr + ei;
        sr = nr; si = ni;
      }
    }
    __syncthreads();
  }
}

DI void phase_s5_y(const Params& p, int i, bf16_t* smem, LnRef lr) {
  const bf16_t* Ktab = (const bf16_t*)(p.ws + OFF_KTAB); const bf16_t* Gtab = (const bf16_t*)(p.ws + OFF_GTAB);
  const bf16_t* hb = (const bf16_t*)(p.ws + OFF_HB); const bf16_t* sin_ = (const bf16_t*)(p.ws + OFF_SIN);
  bf16_t* hid = (bf16_t*)(p.ws + OFF_HID);
  for (int w = BID(); w < 2048; w += GDIM()) {
    const int g = w >> 5, mtile = (w >> 3) & 3, b = w & 7;
    const int nT = mtile * 2 + 2;
    auto al = [=](int row, int ks, int kc) -> uint4 {
      if (ks < nT) {
        const int k = ks * 64 + kc, sidx = k >> 4, hi0 = k & 15, t = row >> 4, ho = row & 15;
        if (t >= sidx) return *(const uint4*)((const char*)Ktab + (unsigned)(((((g * 32 + (t - sidx)) * 16 + ho) * 16) + hi0) * 2));
        return make_uint4(0, 0, 0, 0);
      }
      return *(const uint4*)((const char*)Gtab + (unsigned)((((g * 512 + row) * 128) + (ks - nT) * 64 + kc) * 2));
    };
    auto bl = [=](int n, int ks, int kc) -> uint4 {
      if (ks < nT) {
        const int k = ks * 64 + kc, sidx = k >> 4, hi0 = k & 15;
        return *(const uint4*)((const char*)hb + (unsigned)(((b * 4096 + n * 32 + sidx) * 1024 + g * 16 + hi0) * 2));
      }
      return *(const uint4*)((const char*)sin_ + (unsigned)((((g * 1024 + b * 128 + n) * 128) + (ks - nT) * 64 + kc) * 2));
    };
    gemm_tile(0, mtile * 128, nT + 2, bl, al, [&](f32x4 (&acc)[4][4], int rb, int cb) {
      const int lane = TID() & 63, l15 = lane & 15, quad = lane >> 4;
      const float4 dsk = *(const float4*)(p.s5_d + i * 1024 + g * 16 + quad * 4);
#pragma unroll
      for (int mt = 0; mt < 4; ++mt)
#pragma unroll
        for (int nt = 0; nt < 4; ++nt) {
          const int t = (cb + nt * 16) >> 4, n = rb + mt * 16 + l15;
          const size_t tok = (size_t)b * 4096 + n * 32 + t;
          const float4 u = ln_h4(p, lr, (int)tok, g * 16 + quad * 4, *(const float4*)(p.out + tok * 1024 + g * 16 + quad * 4));
          u32x2 v;
          v[0] = pack2(gelu_tanh(acc[mt][nt][0] + dsk.x * u.x), gelu_tanh(acc[mt][nt][1] + dsk.y * u.y));
          v[1] = pack2(gelu_tanh(acc[mt][nt][2] + dsk.z * u.z), gelu_tanh(acc[mt][nt][3] + dsk.w * u.w));
          *(u32x2*)(hid + tok * 1024 + g * 16 + quad * 4) = v;
        }
    }, smem);
  }
}

DI void phase_glu(const Params& p, int i, bf16_t* smem, LnRef lr) {
  const bf16_t* W = (const bf16_t*)(p.ws + OFF_W) + W_ODD0 + (size_t)i * SZ_GLU;
  PlainLoad al{(const bf16_t*)(p.ws + OFF_HID), 1024}, bl{W, 1024};
  {
    gemm_stream(256, 16, 16, al, bl, [&](f32x4 (&acc)[4][4], int rb, int cb) {
      const int lane = TID() & 63, l15 = lane & 15, quad = lane >> 4;
#pragma unroll
      for (int mt = 0; mt < 4; ++mt)
#pragma unroll
        for (int np = 0; np < 2; ++np) {
          const int row = rb + mt * 16 + l15, col = (cb >> 1) + np * 16 + quad * 4;
          float4* ptr = (float4*)(p.out + (size_t)row * 1024 + col);
          float4 h = ln_h4(p, lr, row, col, *ptr);
          h.x = ALPHA * h.x + acc[mt][2 * np][0] * sigmoidf_(acc[mt][2 * np + 1][0]);
          h.y = ALPHA * h.y + acc[mt][2 * np][1] * sigmoidf_(acc[mt][2 * np + 1][1]);
          h.z = ALPHA * h.z + acc[mt][2 * np][2] * sigmoidf_(acc[mt][2 * np + 1][2]);
          h.w = ALPHA * h.w + acc[mt][2 * np][3] * sigmoidf_(acc[mt][2 * np + 1][3]);
          *ptr = h;
        }
    }, smem);
  }
}

DI void phase_xproj(const Params& p, int l, bf16_t* smem) {
  const bf16_t* wc = (const bf16_t*)(p.ws + OFF_W) + (size_t)l * SZ_COMMON;
  {
    PlainLoad al{(const bf16_t*)(p.ws + OFF_HB), 1024}, bl{wc, 1024};
    bf16_t* q = (bf16_t*)(p.ws + OFF_XQ);
    gemm_stream(256, 8, 16, al, bl, [&](f32x4 (&acc)[4][4], int rb, int cb) { epi_bf16(q, 1024, acc, rb, cb); }, smem);
  }
  {
    const float* memf = p.mem;
    auto al = [=](int row, int ks, int kc) -> uint4 {
      const float4* src = (const float4*)((const char*)memf + (unsigned)((row * 1024 + ks * 64 + kc) * 4));
      float4 a = src[0], b2 = src[1];
      return make_uint4(pack2(a.x, a.y), pack2(a.z, a.w), pack2(b2.x, b2.y), pack2(b2.z, b2.w));
    };
    bf16_t* kx = (bf16_t*)(p.ws + OFF_KX); bf16_t* vx = (bf16_t*)(p.ws + OFF_VX);
    for_tiles(16, 16, [&](int mi, int ni) {
      const bool isv = ni >= 8;
      PlainLoad bl{isv ? (wc + 2 * SZ_SQ) : (wc + SZ_SQ), 1024};
      gemm_tile(mi * 128, (ni & 7) * 128, 16, al, bl, [&](f32x4 (&acc)[4][4], int rb, int cb) {
        if (!isv) { epi_bf16(kx, 1024, acc, rb, cb); return; }
        const int lane = TID() & 63, l15 = lane & 15, quad = lane >> 4;
#pragma unroll
        for (int mt = 0; mt < 4; ++mt)
#pragma unroll
          for (int nt = 0; nt < 4; ++nt) {
            const int row = rb + mt * 16 + l15, col = cb + nt * 16 + quad * 4;
            const int b = row >> 8, key = row & 255, h = col >> 8, d = col & 255;
            bf16_t* dst = vx + ((size_t)((b * 4 + h) * 256 + d)) * 256 + kperm(key);
#pragma unroll
            for (int r = 0; r < 4; ++r) dst[r * 256] = f2bf(acc[mt][nt][r]);
          }
      }, smem);
    });
  }
}


DI void phase_xattn(const Params& p, bf16_t* smem) {
  const int tid = TID(), wave = tid >> 6, lane = tid & 63, l15 = lane & 15, quad = lane >> 4;
  const bf16_t* q = (const bf16_t*)(p.ws + OFF_XQ); const bf16_t* kx = (const bf16_t*)(p.ws + OFF_KX); const bf16_t* vxT = (const bf16_t*)(p.ws + OFF_VX);
  bf16_t* xo = (bf16_t*)(p.ws + OFF_XO);
  uint4 rg0, rg1, rg2, rg3, rg4, rg5, rg6, rg7;
#define XA_KLOAD(c_) do { const bf16_t* s_ = kx + (size_t)(b * 256 + (c_) * 64 + (tid >> 5)) * 1024 + h * 256 + (tid & 31) * 8; \
    rg0 = *(const uint4*)(s_); rg1 = *(const uint4*)(s_ + 8 * 1024); rg2 = *(const uint4*)(s_ + 16 * 1024); rg3 = *(const uint4*)(s_ + 24 * 1024); \
    rg4 = *(const uint4*)(s_ + 32 * 1024); rg5 = *(const uint4*)(s_ + 40 * 1024); rg6 = *(const uint4*)(s_ + 48 * 1024); rg7 = *(const uint4*)(s_ + 56 * 1024); } while (0)
#define XA_KSTORE(buf_) do { bf16_t* d_ = (buf_) + (tid >> 5) * 264 + (tid & 31) * 8; \
    *(uint4*)(d_) = rg0; *(uint4*)(d_ + 8 * 264) = rg1; *(uint4*)(d_ + 16 * 264) = rg2; *(uint4*)(d_ + 24 * 264) = rg3; \
    *(uint4*)(d_ + 32 * 264) = rg4; *(uint4*)(d_ + 40 * 264) = rg5; *(uint4*)(d_ + 48 * 264) = rg6; *(uint4*)(d_ + 56 * 264) = rg7; } while (0)
#define XA_VLOAD(c_) do { const bf16_t* s_ = vxT + ((size_t)((b * 4 + h) * 256 + (tid >> 3))) * 256 + (c_) * 64 + (tid & 7) * 8; \
    rg0 = *(const uint4*)(s_); rg1 = *(const uint4*)(s_ + 32 * 256); rg2 = *(const uint4*)(s_ + 64 * 256); rg3 = *(const uint4*)(s_ + 96 * 256); \
    rg4 = *(const uint4*)(s_ + 128 * 256); rg5 = *(const uint4*)(s_ + 160 * 256); rg6 = *(const uint4*)(s_ + 192 * 256); rg7 = *(const uint4*)(s_ + 224 * 256); } while (0)
#define XA_VSTORE(buf_) do { bf16_t* d_ = (buf_) + (tid >> 3) * 72 + (tid & 7) * 8; \
    *(uint4*)(d_) = rg0; *(uint4*)(d_ + 32 * 72) = rg1; *(uint4*)(d_ + 64 * 72) = rg2; *(uint4*)(d_ + 96 * 72) = rg3; \
    *(uint4*)(d_ + 128 * 72) = rg4; *(uint4*)(d_ + 160 * 72) = rg5; *(uint4*)(d_ + 192 * 72) = rg6; *(uint4*)(d_ + 224 * 72) = rg7; } while (0)
  for (int item = BID(); item < 2048; item += GDIM()) {
    const int b = item >> 8, h = (item >> 6) & 3, qb = item & 63;
    const size_t tq = (size_t)b * 4096 + qb * 64 + wave * 16 + l15;
    XA_KLOAD(0);
    bf16x8 qf[8];
#pragma unroll
    for (int ks = 0; ks < 8; ++ks) qf[ks] = *(const bf16x8*)(q + tq * 1024 + h * 256 + ks * 32 + quad * 8);
    XA_KSTORE(smem);
    __syncthreads();
    f32x4 s[16];
#pragma unroll
    for (int c = 0; c < 4; ++c) {
      const bf16_t* cur = smem + (c & 1) * 18432; bf16_t* nxt = smem + ((c + 1) & 1) * 18432;
      if (c < 3) XA_KLOAD(c + 1); else XA_VLOAD(0);
#pragma unroll
      for (int m4 = 0; m4 < 4; ++m4) {
        f32x4 a = {0.f, 0.f, 0.f, 0.f};
#pragma unroll
        for (int ks = 0; ks < 8; ++ks) a = MFMA16(*(const bf16x8*)(cur + (m4 * 16 + l15) * 264 + ks * 32 + quad * 8), qf[ks], a);
        s[c * 4 + m4] = a;
      }
      if (c < 3) XA_KSTORE(nxt); else XA_VSTORE(nxt);
      __syncthreads();
    }
    float m = -1e30f;
#pragma unroll
    for (int mt = 0; mt < 16; ++mt)
#pragma unroll
      for (int r = 0; r < 4; ++r) m = fmaxf(m, s[mt][r]);
    m = fmaxf(m, __shfl_xor(m, 16)); m = fmaxf(m, __shfl_xor(m, 32));
    const float c1 = 0.0625f * 1.4426950408889634f;
    float l = 0.f;
#pragma unroll
    for (int mt = 0; mt < 16; ++mt)
#pragma unroll
      for (int r = 0; r < 4; ++r) { float pv = exp2f((s[mt][r] - m) * c1); s[mt][r] = pv; l += pv; }
    l += __shfl_xor(l, 16); l += __shfl_xor(l, 32);
    f32x4 o[16];
#pragma unroll
    for (int dt = 0; dt < 16; ++dt) o[dt] = f32x4{0.f, 0.f, 0.f, 0.f};
#pragma unroll
    for (int c = 0; c < 4; ++c) {
      const bf16_t* cur = smem + (c & 1) * 18432; bf16_t* nxt = smem + ((c + 1) & 1) * 18432;
      if (c < 3) XA_VLOAD(c + 1);
#pragma unroll
      for (int s2 = 0; s2 < 2; ++s2) {
        const bf16x8 pf = pack8(s[4 * c + 2 * s2], s[4 * c + 2 * s2 + 1]);
#pragma unroll
        for (int dt = 0; dt < 16; ++dt) o[dt] = MFMA16(*(const bf16x8*)(cur + (dt * 16 + l15) * 72 + s2 * 32 + quad * 8), pf, o[dt]);
      }
      if (c < 3) XA_VSTORE(nxt);
      __syncthreads();
    }
    const float il = 1.f / l;
#pragma unroll
    for (int dt = 0; dt < 16; ++dt) {
      u32x2 v; v[0] = pack2(o[dt][0] * il, o[dt][1] * il); v[1] = pack2(o[dt][2] * il, o[dt][3] * il);
      *(u32x2*)(xo + tq * 1024 + h * 256 + dt * 16 + quad * 4) = v;
    }
  }
}

template <int R, int NT>
DI void dil_branch(const bf16_t* swk, const bf16_t* swv, size_t rowbase, int h, int tok0, const bf16x8 (&qf)[2], float& m, float& l, f32x4 (&o)[4],
                   int l15, int quad) {
  constexpr int U = 16 / R, W = 128 * R;
  f32x4 s[NT];
#pragma unroll
  for (int kt = 0; kt < NT; ++kt) {
    int kap = tok0 - W + R * (kt * 16 + l15);
    kap = min(max(kap, 0), 4095);
    const bf16_t* kp = swk + (rowbase + kap) * 512 + h * 64 + quad * 8;
    f32x4 a = {0.f, 0.f, 0.f, 0.f};
    a = MFMA16(*(const bf16x8*)kp, qf[0], a);
    a = MFMA16(*(const bf16x8*)(kp + 32), qf[1], a);
    s[kt] = a;
    if ((kt & 3) == 3) __builtin_amdgcn_sched_barrier(0);
  }
  float mx = m;
  const float c1 = 0.125f * 1.4426950408889634f;
#pragma unroll
  for (int kt = 0; kt < NT; ++kt)
#pragma unroll
    for (int r2 = 0; r2 < 4; ++r2) {
      const int c = kt * 16 + quad * 4 + r2;
      const int dist = U * l15 + 128 - c;
      const int kap = tok0 - W + R * c;
      const bool ok = (dist >= 0) && (dist <= 128) && (kap >= 0);
      const float v = ok ? s[kt][r2] * c1 : -1e30f;
      s[kt][r2] = v; mx = fmaxf(mx, v);
    }
  mx = fmaxf(mx, __shfl_xor(mx, 16)); mx = fmaxf(mx, __shfl_xor(mx, 32));
  const float corr = exp2f(m - mx);
  m = mx; l *= corr;
#pragma unroll
  for (int dt = 0; dt < 4; ++dt) { o[dt][0] *= corr; o[dt][1] *= corr; o[dt][2] *= corr; o[dt][3] *= corr; }
#pragma unroll
  for (int kt = 0; kt < NT; ++kt)
#pragma unroll
    for (int r2 = 0; r2 < 4; ++r2) { float pv = exp2f(s[kt][r2] - mx); s[kt][r2] = pv; l += pv; }
  constexpr int NS = (NT + 1) / 2;
#pragma unroll
  for (int s2 = 0; s2 < NS; ++s2) {
    const f32x4 z4 = {0.f, 0.f, 0.f, 0.f};
    const bf16x8 pf = pack8(s[2 * s2], (2 * s2 + 1 < NT) ? s[(2 * s2 + 1 < NT) ? 2 * s2 + 1 : 0] : z4);
    u32x2 vv[8];
#pragma unroll
    for (int j = 0; j < 8; ++j) {
      const int c = (2 * s2 + (j >> 2)) * 16 + quad * 4 + (j & 3);
      int kap = tok0 - W + R * c;
      kap = min(max(kap, 0), 4095);
      vv[j] = *(const u32x2*)(swv + (rowbase + kap) * 512 + h * 64 + 4 * l15);
    }
#pragma unroll
    for (int t4 = 0; t4 < 4; ++t4) {
      u32x4 t;
#pragma unroll
      for (int m = 0; m < 4; ++m) {
        const unsigned a = vv[2 * m][t4 >> 1], b2 = vv[2 * m + 1][t4 >> 1];
        t[m] = (t4 & 1) ? ((a >> 16) | (b2 & 0xffff0000u)) : ((a & 0xffffu) | (b2 << 16));
      }
      o[t4] = MFMA16(__builtin_bit_cast(bf16x8, t), pf, o[t4]);
    }
    __builtin_amdgcn_sched_barrier(0);
  }
}

DI void phase_dil_attn(const Params& p, int first, int nblk) {
  const int wave = TID() >> 6, lane = TID() & 63, l15 = lane & 15, quad = lane >> 4;
  bf16_t* swq = (bf16_t*)(WS(p) + OFF_SWQ); const bf16_t* swk = (const bf16_t*)(WS(p) + OFF_SWK); const bf16_t* swv = (const bf16_t*)(WS(p) + OFF_SWV);
  for (int item = first; item < 4096; item += nblk) {
    const int b = item >> 9, h = (item >> 6) & 7, rho = (item >> 2) & 15, gq = item & 3;
    const int tok0 = (gq * 4 + wave) * 256 + rho;
    const size_t rowbase = (size_t)b * 4096;
    const size_t tq = rowbase + tok0 + 16 * l15;
    bf16x8 qf[2];
    qf[0] = *(const bf16x8*)(swq + tq * 512 + h * 64 + quad * 8);
    qf[1] = *(const bf16x8*)(swq + tq * 512 + h * 64 + 32 + quad * 8);
    float m = -1e30f, l = 0.f;
    f32x4 o[4];
#pragma unroll
    for (int dt = 0; dt < 4; ++dt) o[dt] = f32x4{0.f, 0.f, 0.f, 0.f};
    dil_branch<16, 9>(swk, swv, rowbase, h, tok0, qf, m, l, o, l15, quad);
    dil_branch<4, 12>(swk, swv, rowbase, h, tok0, qf, m, l, o, l15, quad);
    dil_branch<1, 24>(swk, swv, rowbase, h, tok0, qf, m, l, o, l15, quad);
    l += __shfl_xor(l, 16); l += __shfl_xor(l, 32);
    const float il = 1.f / l;
    u32x4 w0, w1;
    w0[0] = pack2(o[0][0] * il, o[1][0] * il); w0[1] = pack2(o[2][0] * il, o[3][0] * il);
    w0[2] = pack2(o[0][1] * il, o[1][1] * il); w0[3] = pack2(o[2][1] * il, o[3][1] * il);
    w1[0] = pack2(o[0][2] * il, o[1][2] * il); w1[1] = pack2(o[2][2] * il, o[3][2] * il);
    w1[2] = pack2(o[0][3] * il, o[1][3] * il); w1[3] = pack2(o[2][3] * il, o[3][3] * il);
    *(u32x4*)(swq + tq * 512 + h * 64 + quad * 16) = w0;
    *(u32x4*)(swq + tq * 512 + h * 64 + quad * 16 + 8) = w1;
  }
}

DI void phase_xo(const Params& p, int l, bf16_t* smem, LnRef lr) {
  const bf16_t* wc = (const bf16_t*)(p.ws + OFF_W) + (size_t)l * SZ_COMMON + 3 * SZ_SQ;
  PlainLoad al{(const bf16_t*)(p.ws + OFF_XO), 1024}, bl{wc, 1024};
  {
    gemm_stream(256, 8, 16, al, bl, [&](f32x4 (&acc)[4][4], int rb, int cb) { epi_resid(p, lr, acc, rb, cb); }, smem);
  }
}

DI void phase_ffn_gu(const Params& p, int l, bf16_t* smem) {
  const bf16_t* W = (const bf16_t*)(p.ws + OFF_W) + (size_t)l * SZ_COMMON + 4 * SZ_SQ;
  PlainLoad al{(const bf16_t*)(p.ws + OFF_HB), 1024}, bl{W, 1024};
  bf16_t* act = (bf16_t*)(p.ws + OFF_ACT);
  {
    gemm_stream(256, 44, 16, al, bl, [&](f32x4 (&acc)[4][4], int rb, int cb) {
      const int lane = TID() & 63, l15 = lane & 15, quad = lane >> 4;
#pragma unroll
      for (int mt = 0; mt < 4; ++mt)
#pragma unroll
        for (int np = 0; np < 2; ++np) {
          u32x2 v;
          v[0] = pack2(siluf_(acc[mt][2 * np][0]) * acc[mt][2 * np + 1][0], siluf_(acc[mt][2 * np][1]) * acc[mt][2 * np + 1][1]);
          v[1] = pack2(siluf_(acc[mt][2 * np][2]) * acc[mt][2 * np + 1][2], siluf_(acc[mt][2 * np][3]) * acc[mt][2 * np + 1][3]);
          *(u32x2*)(act + (size_t)(rb + mt * 16 + l15) * 2816 + (cb >> 1) + np * 16 + quad * 4) = v;
        }
    }, smem);
  }
}
DI void phase_ffn_down(const Params& p, int l, bf16_t* smem, LnRef lr) {
  const bf16_t* W = (const bf16_t*)(p.ws + OFF_W) + (size_t)l * SZ_COMMON + 4 * SZ_SQ + SZ_GU;
  PlainLoad al{(const bf16_t*)(p.ws + OFF_ACT), 2816}, bl{W, 2816};
  {
    gemm_stream(256, 8, 44, al, bl, [&](f32x4 (&acc)[4][4], int rb, int cb) { epi_resid(p, lr, acc, rb, cb); }, smem);
  }
}


#define XB_TMO      128
#define XB_XCNT(j)  (256  + 64 * (j))
#define XB_XSUB(j)  (1280 + 64 * (j))
#define XB_XGEN(j)  (2304 + 64 * (j))
#define XB_TOP      3328
#define XB_TOPGEN   3392
#define XCD_BAR_WORDS 3456
#define XB_SPIN_CAP (1u << 22)
#define LAS __attribute__((address_space(3)))
DI unsigned xb_ld(unsigned* p) { return __hip_atomic_load(p, __ATOMIC_RELAXED, __HIP_MEMORY_SCOPE_AGENT); }
DI unsigned xb_add(unsigned* p, unsigned v) { return __hip_atomic_fetch_add(p, v, __ATOMIC_RELAXED, __HIP_MEMORY_SCOPE_AGENT); }
DI unsigned xb_xcc_id() { return (unsigned)__builtin_amdgcn_s_getreg((3 << 11) | 20) & 0xFu; }
#define XB_SPIN(cond, bar) do { unsigned _sp = 0; while (cond) { __builtin_amdgcn_s_sleep(1); \
    if ((++_sp & 255u) == 0u) { if (xb_ld(&(bar)[XB_TMO])) break; if (_sp > XB_SPIN_CAP) { atomicAdd(&(bar)[XB_TMO], 1u); break; } } } } while (0)
struct XcdBarrier { unsigned* bar; unsigned x; volatile LAS unsigned* st; };
DI XcdBarrier xcd_barrier_post(unsigned* bar, volatile LAS unsigned* st) {
  XcdBarrier b; b.bar = bar; b.x = xb_xcc_id(); b.st = st;
  if (threadIdx.x == 0) (void)xb_add(&bar[XB_XCNT(b.x)], 1u);
  return b;
}
DI void xcd_barrier_complete(unsigned* bar, unsigned x, unsigned& nloc, unsigned& nx) {
  const unsigned G = gridDim.x * gridDim.y * gridDim.z;
  unsigned sum, cnt, mine, sp = 0u;
  for (;;) {
    sum = 0u; cnt = 0u; mine = 0u;
#pragma unroll
    for (unsigned j = 0; j < 16; ++j) { const unsigned c = xb_ld(&bar[XB_XCNT(j)]); sum += c; cnt += (c > 0u) ? 1u : 0u; mine = (j == x) ? c : mine; }
    if (sum == G) break;
    __builtin_amdgcn_s_sleep(1);
    if ((++sp & 255u) == 0u) { if (xb_ld(&bar[XB_TMO])) break; if (sp > XB_SPIN_CAP) { atomicAdd(&bar[XB_TMO], 1u); break; } }
  }
  nloc = mine > 0u ? mine : 1u; nx = cnt > 0u ? cnt : 1u;
}
DI void xcd_barrier(const XcdBarrier& b) {
  asm volatile("s_waitcnt vmcnt(0)" ::: "memory");
  __syncthreads();
  if (threadIdx.x == 0) {
    unsigned* bar = b.bar;
    __builtin_amdgcn_s_waitcnt(0);
    unsigned nloc = b.st[0], nx = b.st[1];
    if (nloc == 0u) { xcd_barrier_complete(bar, b.x, nloc, nx); b.st[0] = nloc; b.st[1] = nx; }
    const unsigned old = xb_add(&bar[XB_XSUB(b.x)], 1u);
    const unsigned gen = old / nloc;
    if (old + 1u == (gen + 1u) * nloc) {
      __builtin_amdgcn_fence(__ATOMIC_RELEASE, "agent");
      asm volatile("s_waitcnt vmcnt(0)" ::: "memory");
      const unsigned og = xb_add(&bar[XB_TOP], 1u);
      const unsigned tg = og / nx;
      if (og + 1u == (tg + 1u) * nx) xb_add(&bar[XB_TOPGEN], 1u);
      else XB_SPIN(xb_ld(&bar[XB_TOPGEN]) == tg, bar);
      __builtin_amdgcn_fence(__ATOMIC_ACQUIRE, "agent");
      xb_add(&bar[XB_XGEN(b.x)], 1u);
      asm volatile("s_waitcnt vmcnt(0)" ::: "memory");
    } else {
      XB_SPIN(xb_ld(&bar[XB_XGEN(b.x)]) == gen, bar);
      __builtin_amdgcn_fence(__ATOMIC_ACQUIRE, "agent");
      asm volatile("s_waitcnt vmcnt(0)" ::: "memory");
    }
  }
  __syncthreads();
}

__global__ void __launch_bounds__(256, 2) fwd_megakernel(Params p) {
  cg::grid_group grid = cg::this_grid();
  __shared__ __attribute__((aligned(16))) char smem_raw[2 * 2 * 128 * LDT * 2];
  bf16_t* sm16 = (bf16_t*)smem_raw; float* sm32 = (float*)smem_raw;

  __shared__ uint4 xb_words;
  if (threadIdx.x == 0) xb_words = make_uint4(0u, 0u, 0u, 0u);
  __syncthreads();
  XcdBarrier xb = xcd_barrier_post((unsigned*)(p.ws + OFF_BAR), (volatile LAS unsigned*)&xb_words);
  phase_prologue(p, sm32);
  grid.sync();
  for (int l = 0; l < 4; ++l) {
    const int i = l >> 1;
    if ((l & 1) == 0) {
      phase_proj(p, i, sm16); xcd_barrier(xb);
      phase_dn_prep(p, i, smem_raw); xcd_barrier(xb);
      phase_mix(p, i, sm16); xcd_barrier(xb);
      phase_dn_post(p, i); xcd_barrier(xb);
      phase_wout(p, i, sm16, LnRef{p.ln_ffn_g + (l > 0 ? l - 1 : 0) * 1024, p.ln_ffn_b + (l > 0 ? l - 1 : 0) * 1024, l == 0 ? -1 : ((l * 3 - 1) & 3)}); xcd_barrier(xb);
    } else {
#if USE_S5_GEMM
      phase_s5_tables(p, i, sm32); xcd_barrier(xb);
      phase_s5_end(p, sm16); xcd_barrier(xb);
      phase_s5_y(p, i, sm16, LnRef{p.ln_ffn_g + (l - 1) * 1024, p.ln_ffn_b + (l - 1) * 1024, (l * 3 - 1) & 3}); xcd_barrier(xb);
#else
      phase_s5_naive(p, i); xcd_barrier(xb);
#endif
      phase_glu(p, i, sm16, LnRef{p.ln_ffn_g + (l - 1) * 1024, p.ln_ffn_b + (l - 1) * 1024, (l * 3 - 1) & 3}); xcd_barrier(xb);
    }
    phase_ln(p, p.ln_mix_g + l * 1024, p.ln_mix_b + l * 1024, (l * 3) & 3, false); xcd_barrier(xb);
    phase_xproj(p, l, sm16); xcd_barrier(xb);
    phase_xattn(p, sm16); xcd_barrier(xb);
    phase_xo(p, l, sm16, LnRef{p.ln_mix_g + l * 1024, p.ln_mix_b + l * 1024, (l * 3) & 3}); xcd_barrier(xb);
    phase_ln(p, p.ln_x_g + l * 1024, p.ln_x_b + l * 1024, (l * 3 + 1) & 3, false); xcd_barrier(xb);
    phase_ffn_gu(p, l, sm16); xcd_barrier(xb);
    phase_ffn_down(p, l, sm16, LnRef{p.ln_x_g + l * 1024, p.ln_x_b + l * 1024, (l * 3 + 1) & 3}); xcd_barrier(xb);
    phase_ln(p, p.ln_ffn_g + l * 1024, p.ln_ffn_b + l * 1024, (l * 3 + 2) & 3, l == 3); xcd_barrier(xb);
  }
}

extern "C" void kernel_launch(void* const* d_in, const int* in_sizes, int n_in, void* d_out, int out_size, void* d_ws, size_t ws_size,
                              hipStream_t stream) {
  static int grid_blocks = 0;
  if (!grid_blocks) {
    int dev = 0, cus = 0, per_cu = 0;
    hipGetDevice(&dev);
    hipDeviceGetAttribute(&cus, hipDeviceAttributeMultiprocessorCount, dev);
    hipOccupancyMaxActiveBlocksPerMultiprocessor(&per_cu, fwd_megakernel, 256, 0);
    if (per_cu > 2) per_cu = 2;
    if (per_cu < 1) per_cu = 1;
    grid_blocks = cus * per_cu;
    grid_blocks -= grid_blocks % 8;
  }
  Params p{};
  const float** pf = (const float**)&p;
  for (int i = 0; i < 32; ++i) pf[i] = (const float*)d_in[i];
  p.pos = (const int*)d_in[2];
  p.out = (float*)d_out; p.ws = (char*)d_ws;
  hipMemsetAsync((char*)d_ws + OFF_BAR, 0, XCD_BAR_WORDS * sizeof(unsigned), stream);
  void* args[] = {&p};
  hipError_t e = hipLaunchCooperativeKernel((void*)fwd_megakernel, dim3(grid_blocks), dim3(256), args, 0, stream);
  if (e != hipSuccess) fprintf(stderr, "cooperative launch failed: %s (grid %d)\n", hipGetErrorString(e), grid_blocks);
}
```

```cpp
#include <hip/hip_runtime.h>
#include <hip/hip_cooperative_groups.h>
#include <cstdio>
namespace cg = cooperative_groups;
#ifndef USE_XATTN_MFMA
#define USE_XATTN_MFMA 1
#endif
#ifndef USE_S5_GEMM
#define USE_S5_GEMM 1
#endif
#ifndef USE_DIL_MFMA
#define USE_DIL_MFMA 1
#endif

typedef unsigned short bf16_t;
using bf16x8 = __attribute__((ext_vector_type(8))) short;
using f32x4 = __attribute__((ext_vector_type(4))) float;
#define DI __device__ __forceinline__

constexpr int T_ = 32768, S_ = 4096;
constexpr size_t MiB = (size_t)1 << 20;
constexpr size_t SZ_SQ = (size_t)1024 * 1024, SZ_WIN = (size_t)3712 * 1024, SZ_GLU = (size_t)2048 * 1024,
                 SZ_GU = (size_t)5632 * 1024, SZ_WD = (size_t)1024 * 2816;
constexpr size_t SZ_COMMON = 4 * SZ_SQ + SZ_GU + SZ_WD;
constexpr size_t W_EVEN0 = 4 * SZ_COMMON;
constexpr size_t W_ODD0 = W_EVEN0 + 2 * (SZ_WIN + SZ_SQ);
constexpr float ALPHA = 1.681792830507429f;

constexpr size_t OFF_W = 0;
constexpr size_t OFF_ROPE = 125 * MiB;
constexpr size_t OFF_HB = 133 * MiB;
constexpr size_t OFF_KX = 197 * MiB;
constexpr size_t OFF_VX = 201 * MiB;
constexpr size_t OFF_BIG = 205 * MiB;
constexpr size_t OFF_BAR = 511 * MiB;
constexpr size_t OFF_DNQKV = OFF_BIG;
constexpr size_t OFF_Z = OFF_BIG + 96 * MiB;
constexpr size_t OFF_SWQ = OFF_BIG + 128 * MiB;
constexpr size_t OFF_SWK = OFF_BIG + 160 * MiB;
constexpr size_t OFF_SWV = OFF_BIG + 192 * MiB;
constexpr size_t OFF_LOGIT = OFF_BIG + 224 * MiB;
constexpr size_t OFF_QD = OFF_BIG + 225 * MiB;
constexpr size_t OFF_KD = OFF_BIG + 257 * MiB;
constexpr size_t OFF_INTRA = OFF_BIG + 289 * MiB;
constexpr size_t OFF_WB = OFF_HB;
constexpr size_t OFF_UB = OFF_HB + 32 * MiB;
constexpr size_t OFF_EG = OFF_KX;
constexpr size_t OFF_XQ = OFF_BIG;
constexpr size_t OFF_XO = OFF_BIG + 64 * MiB;
constexpr size_t OFF_ACT = OFF_BIG;
constexpr size_t OFF_HID = OFF_BIG;
constexpr size_t OFF_SIN = OFF_BIG + 64 * MiB;
constexpr size_t OFF_KTAB = OFF_BIG + 80 * MiB;
constexpr size_t OFF_ETAB = OFF_BIG + 82 * MiB;
constexpr size_t OFF_GTAB = OFF_BIG + 90 * MiB;
constexpr size_t OFF_AL = OFF_BIG + 98 * MiB;

struct Params {
  const float* x; const float* mem; const int* pos;
  const float* hyb_w_in; const float* dn_conv_w; const float* dn_a_log; const float* dn_dt_bias; const float* dn_norm_g; const float* hyb_w_out;
  const float* s5_a_re; const float* s5_a_im; const float* s5_log_dt; const float* s5_b_re; const float* s5_b_im; const float* s5_c_re; const float* s5_c_im;
  const float* s5_d; const float* s5_glu_wo; const float* s5_glu_wg;
  const float* ln_mix_g; const float* ln_mix_b;
  const float* xq_w; const float* xk_w; const float* xv_w; const float* xo_w; const float* ln_x_g; const float* ln_x_b;
  const float* ffn_wg; const float* ffn_wu; const float* ffn_wd; const float* ln_ffn_g; const float* ln_ffn_b;
  float* out; char* ws;
};
DI char* WS(const Params& p) { char* w = p.ws; asm volatile("" : "+s"(w)); return w; }

DI int TID() { int t = threadIdx.x; asm volatile("" : "+v"(t)); return t; }
DI int BID() { int t = blockIdx.x; asm volatile("" : "+s"(t)); return t; }
DI int GDIM() { int t = gridDim.x; asm volatile("" : "+s"(t)); return t; }
typedef float f32x2_t __attribute__((ext_vector_type(2)));
typedef __bf16 bf16x2_t __attribute__((ext_vector_type(2)));
DI bf16_t f2bf(float x) { return __builtin_bit_cast(bf16_t, (__bf16)x); }
DI float bf2f(bf16_t v) { return __uint_as_float(((unsigned)v) << 16); }
DI unsigned pack2(float a, float b) { f32x2_t v = {a, b}; return __builtin_bit_cast(unsigned, __builtin_convertvector(v, bf16x2_t)); }
using u32x4 = __attribute__((ext_vector_type(4))) unsigned;
using u32x2 = __attribute__((ext_vector_type(2))) unsigned;
DI bf16x8 pack8(f32x4 a, f32x4 b) {
  u32x4 t; t[0] = pack2(a[0], a[1]); t[1] = pack2(a[2], a[3]); t[2] = pack2(b[0], b[1]); t[3] = pack2(b[2], b[3]);
  return __builtin_bit_cast(bf16x8, t);
}
#define MFMA16(a, b, c) __builtin_amdgcn_mfma_f32_16x16x32_bf16((a), (b), (c), 0, 0, 0)
DI int kperm(int x) { return (x & ~31) | (((x >> 2) & 3) * 8 + ((x >> 4) & 1) * 4 + (x & 3)); }
DI float wave_sum(float v) { for (int o = 32; o > 0; o >>= 1) v += __shfl_xor(v, o); return v; }
DI float wave_max(float v) { for (int o = 32; o > 0; o >>= 1) v = fmaxf(v, __shfl_xor(v, o)); return v; }
DI float sigmoidf_(float x) { return __builtin_amdgcn_rcpf(1.f + __expf(-x)); }
DI float siluf_(float x) { return x * sigmoidf_(x); }
DI float softplusf_(float x) { return fmaxf(x, 0.f) + log1pf(__expf(-fabsf(x))); }
DI float gelu_tanh(float x) { float u = 0.7978845608028654f * (x + 0.044715f * x * x * x); return 0.5f * x * (1.f + tanhf(u)); }

template <class CM>
DI void transpose_job(bf16_t* dst, int Ndst, int K, int srcStride, CM colptr, float* tile) {
  const int ntk = K / 64, ntiles = (Ndst / 64) * ntk;
  const int tid = TID();
  for (int tl = BID(); tl < ntiles; tl += GDIM()) {
    const int r0 = (tl / ntk) * 64, k0 = (tl % ntk) * 64;
    const int q4 = tid & 15, kl0 = tid >> 4;
    const float* cp = colptr(r0 + 4 * q4);
    float4 v[4];
#pragma unroll
    for (int i = 0; i < 4; ++i) v[i] = cp ? *(const float4*)(cp + (size_t)(k0 + kl0 + 16 * i) * srcStride) : make_float4(0.f, 0.f, 0.f, 0.f);
#pragma unroll
    for (int i = 0; i < 4; ++i) {
      float* t = tile + (kl0 + 16 * i) * 65 + 4 * q4;
      t[0] = v[i].x; t[1] = v[i].y; t[2] = v[i].z; t[3] = v[i].w;
    }
    __syncthreads();
#pragma unroll
    for (int i = 0; i < 2; ++i) {
      const int c = tid + 256 * i, rr = c >> 3, kc = (c & 7) * 8;
      const float* t = tile + kc * 65 + rr;
      uint4 o;
      o.x = pack2(t[0], t[65]); o.y = pack2(t[2 * 65], t[3 * 65]); o.z = pack2(t[4 * 65], t[5 * 65]); o.w = pack2(t[6 * 65], t[7 * 65]);
      *(uint4*)(dst + (size_t)(r0 + rr) * K + k0 + kc) = o;
    }
    __syncthreads();
  }
}

DI void phase_prologue(const Params& p, float* smem) {
  bf16_t* W = (bf16_t*)(p.ws + OFF_W);
  for (int l = 0; l < 4; ++l) {
    bf16_t* wc = W + (size_t)l * SZ_COMMON;
    const float* s;
    s = p.xq_w + (size_t)l * SZ_SQ; transpose_job(wc, 1024, 1024, 1024, [=](int r) { return s + r; }, smem);
    s = p.xk_w + (size_t)l * SZ_SQ; transpose_job(wc + SZ_SQ, 1024, 1024, 1024, [=](int r) { return s + r; }, smem);
    s = p.xv_w + (size_t)l * SZ_SQ; transpose_job(wc + 2 * SZ_SQ, 1024, 1024, 1024, [=](int r) { return s + r; }, smem);
    s = p.xo_w + (size_t)l * SZ_SQ; transpose_job(wc + 3 * SZ_SQ, 1024, 1024, 1024, [=](int r) { return s + r; }, smem);
    {
      const float* g = p.ffn_wg + (size_t)l * 1024 * 2816; const float* u = p.ffn_wu + (size_t)l * 1024 * 2816;
      transpose_job(wc + 4 * SZ_SQ, 5632, 1024, 2816, [=](int r) { int c = (r >> 5) * 16 + (r & 15); return ((r >> 4) & 1) ? (u + c) : (g + c); }, smem);
    }
    s = p.ffn_wd + (size_t)l * 2816 * 1024; transpose_job(wc + 4 * SZ_SQ + SZ_GU, 1024, 2816, 1024, [=](int r) { return s + r; }, smem);
  }
  for (int i = 0; i < 2; ++i) {
    bf16_t* we = W + W_EVEN0 + (size_t)i * (SZ_WIN + SZ_SQ);
    const float* s = p.hyb_w_in + (size_t)i * 1024 * 3592;
    transpose_job(we, 3712, 1024, 3592, [=](int r) -> const float* {
      if (r < 2048) return s + r;
      if (r < 3584) return s + r + 8;
      if (r < 3592) return s + 2048 + (r - 3584);
      return nullptr; }, smem);
    const float* s2 = p.hyb_w_out + (size_t)i * SZ_SQ;
    transpose_job(we + SZ_WIN, 1024, 1024, 1024, [=](int r) { return s2 + r; }, smem);
    bf16_t* wo = W + W_ODD0 + (size_t)i * SZ_GLU;
    const float* a = p.s5_glu_wo + (size_t)i * SZ_SQ; const float* b = p.s5_glu_wg + (size_t)i * SZ_SQ;
    transpose_job(wo, 2048, 1024, 1024, [=](int r) { int c = (r >> 5) * 16 + (r & 15); return ((r >> 4) & 1) ? (b + c) : (a + c); }, smem);
  }
  const size_t gtid = (size_t)BID() * 256 + TID(), gsz = (size_t)GDIM() * 256;
  bf16_t* hb = (bf16_t*)(p.ws + OFF_HB);
  for (size_t i = gtid; i < (size_t)T_ * 256; i += gsz) {
    float4 v = ((const float4*)p.x)[i];
    uint2 o; o.x = pack2(v.x, v.y); o.y = pack2(v.z, v.w);
    ((uint2*)hb)[i] = o;
  }
  float* rc = (float*)(p.ws + OFF_ROPE); float* rs = rc + (size_t)T_ * 32;
  for (size_t i = gtid; i < (size_t)T_ * 32; i += gsz) {
    int t = (int)(i >> 5), j = (int)(i & 31);
    float invf = (float)exp(-(double)(2 * j) / 64.0 * 9.210340371976184);
    float ang = (float)p.pos[t] * invf;
    double a = (double)ang;
    double k = rint(a * 0.15915494309189535);
    float r = (float)(a - k * 6.283185307179586);
    rc[i] = cosf(r); rs[i] = sinf(r);
  }
}

constexpr int LDT = 72;
template <class AL, class BL, class EP>
DI void gemm_tile(int m0, int n0, int nks, AL aload, BL bload, EP epi, bf16_t* smem) {
  bf16_t* As = smem; bf16_t* Bs = smem + 2 * 128 * LDT;
  const int tid = TID(), lane = tid & 63, wave = tid >> 6;
  const int wm = wave >> 1, wn = wave & 1, l15 = lane & 15, quad = lane >> 4;
  const int lrow = tid >> 3, lkc = (tid & 7) * 8;
  f32x4 acc[4][4];
#pragma unroll
  for (int i = 0; i < 4; ++i)
#pragma unroll
    for (int j = 0; j < 4; ++j) acc[i][j] = f32x4{0.f, 0.f, 0.f, 0.f};
  uint4 ra0[4], rb0[4], ra1[4], rb1[4];
#pragma unroll
  for (int i = 0; i < 4; ++i) { ra0[i] = aload(m0 + lrow + 32 * i, 0, lkc); rb0[i] = bload(n0 + lrow + 32 * i, 0, lkc); }
#pragma unroll
  for (int i = 0; i < 4; ++i) { ra1[i] = aload(m0 + lrow + 32 * i, 1, lkc); rb1[i] = bload(n0 + lrow + 32 * i, 1, lkc); }
#pragma unroll
  for (int i = 0; i < 4; ++i) {
    *(uint4*)(As + (lrow + 32 * i) * LDT + lkc) = ra0[i];
    *(uint4*)(Bs + (lrow + 32 * i) * LDT + lkc) = rb0[i];
  }
  __syncthreads();
  auto compute = [&](int cur) {
    const bf16_t* Ab = As + cur * 128 * LDT; const bf16_t* Bb = Bs + cur * 128 * LDT;
#pragma unroll
    for (int kk = 0; kk < 2; ++kk) {
      bf16x8 a[4], b[4];
#pragma unroll
      for (int mt = 0; mt < 4; ++mt) a[mt] = *(const bf16x8*)(Ab + (wm * 64 + mt * 16 + l15) * LDT + kk * 32 + quad * 8);
#pragma unroll
      for (int nt = 0; nt < 4; ++nt) b[nt] = *(const bf16x8*)(Bb + (wn * 64 + nt * 16 + l15) * LDT + kk * 32 + quad * 8);
#pragma unroll
      for (int mt = 0; mt < 4; ++mt)
#pragma unroll
        for (int nt = 0; nt < 4; ++nt) acc[mt][nt] = __builtin_amdgcn_mfma_f32_16x16x32_bf16(b[nt], a[mt], acc[mt][nt], 0, 0, 0);
    }
  };
  for (int ks = 0; ks < nks; ks += 2) {
    {
      const int kq = (ks + 2 < nks) ? ks + 2 : 0;
#pragma unroll
      for (int i = 0; i < 4; ++i) { ra0[i] = aload(m0 + lrow + 32 * i, kq, lkc); rb0[i] = bload(n0 + lrow + 32 * i, kq, lkc); }
    }
    compute(0);
#pragma unroll
    for (int i = 0; i < 4; ++i) {
      *(uint4*)(As + 128 * LDT + (lrow + 32 * i) * LDT + lkc) = ra1[i];
      *(uint4*)(Bs + 128 * LDT + (lrow + 32 * i) * LDT + lkc) = rb1[i];
    }
    __syncthreads();
    {
      const int kq = (ks + 3 < nks) ? ks + 3 : 1;
#pragma unroll
      for (int i = 0; i < 4; ++i) { ra1[i] = aload(m0 + lrow + 32 * i, kq, lkc); rb1[i] = bload(n0 + lrow + 32 * i, kq, lkc); }
    }
    compute(1);
#pragma unroll
    for (int i = 0; i < 4; ++i) {
      *(uint4*)(As + (lrow + 32 * i) * LDT + lkc) = ra0[i];
      *(uint4*)(Bs + (lrow + 32 * i) * LDT + lkc) = rb0[i];
    }
    __syncthreads();
  }
  epi(acc, m0 + wm * 64, n0 + wn * 64);
}

DI void tile_of(int w, int mtiles, int ntiles, int xcd, int& m0, int& n0) {
  const int mper = mtiles >> 3, full = mper * 8;
  int gidx = w / full;
  const int ngroups = (ntiles + 7) >> 3;
  if (gidx > ngroups - 1) gidx = ngroups - 1;
  const int rest = w - gidx * full;
  const int wg = min(8, ntiles - 8 * gidx);
  const int ml = rest / wg, ni = 8 * gidx + (rest - ml * wg);
  m0 = (ml * 8 + xcd) * 128; n0 = ni * 128;
}
template <class AL, class BL, class EP>
DI void gemm_stream(int mtiles, int ntiles, int nks, AL aload, BL bload, EP epi, bf16_t* smem) {
  const int xcd = BID() & 7, slot = BID() >> 3, nslot = GDIM() >> 3;
  const int per = (mtiles >> 3) * ntiles;
  if (slot >= per) return;
  bf16_t* As = smem; bf16_t* Bs = smem + 2 * 128 * LDT;
  const int tid = TID(), lane = tid & 63, wave = tid >> 6;
  const int wm = wave >> 1, wc = wave & 1, l15 = lane & 15, quad = lane >> 4;
  const int lrow = tid >> 3, lkc = (tid & 7) * 8;
  f32x4 acc[4][4];
  uint4 ra0[4], rb0[4], ra1[4], rb1[4];
  int w = slot;
  int m0, n0;
  tile_of(w, mtiles, ntiles, xcd, m0, n0);
#pragma unroll
  for (int i = 0; i < 4; ++i) { ra0[i] = aload(m0 + lrow + 32 * i, 0, lkc); rb0[i] = bload(n0 + lrow + 32 * i, 0, lkc); }
#pragma unroll
  for (int i = 0; i < 4; ++i) { ra1[i] = aload(m0 + lrow + 32 * i, 1, lkc); rb1[i] = bload(n0 + lrow + 32 * i, 1, lkc); }
#pragma unroll
  for (int i = 0; i < 4; ++i) {
    *(uint4*)(As + (lrow + 32 * i) * LDT + lkc) = ra0[i];
    *(uint4*)(Bs + (lrow + 32 * i) * LDT + lkc) = rb0[i];
  }
  __syncthreads();
  auto compute = [&](int cur) {
    const bf16_t* Ab = As + cur * 128 * LDT; const bf16_t* Bb = Bs + cur * 128 * LDT;
#pragma unroll
    for (int kk = 0; kk < 2; ++kk) {
      bf16x8 a[4], b[4];
#pragma unroll
      for (int mt = 0; mt < 4; ++mt) a[mt] = *(const bf16x8*)(Ab + (wm * 64 + mt * 16 + l15) * LDT + kk * 32 + quad * 8);
#pragma unroll
      for (int nt = 0; nt < 4; ++nt) b[nt] = *(const bf16x8*)(Bb + (wc * 64 + nt * 16 + l15) * LDT + kk * 32 + quad * 8);
      __builtin_amdgcn_s_setprio(2);
#pragma unroll
      for (int mt = 0; mt < 4; ++mt)
#pragma unroll
        for (int nt = 0; nt < 4; ++nt) acc[mt][nt] = __builtin_amdgcn_mfma_f32_16x16x32_bf16(b[nt], a[mt], acc[mt][nt], 0, 0, 0);
      __builtin_amdgcn_s_setprio(0);
    }
  };
  for (;;) {
    const int wnext = w + nslot;
    const bool has_next = wnext < per;
    int m1 = m0, n1 = n0;
    if (has_next) tile_of(wnext, mtiles, ntiles, xcd, m1, n1);
#pragma unroll
    for (int i = 0; i < 4; ++i)
#pragma unroll
      for (int j = 0; j < 4; ++j) acc[i][j] = f32x4{0.f, 0.f, 0.f, 0.f};
    for (int ks = 0; ks < nks; ks += 2) {
      const bool in2 = ks + 2 < nks;
      {
        const int mm = in2 ? m0 : m1, nn = in2 ? n0 : n1, kq = in2 ? ks + 2 : 0;
#pragma unroll
        for (int i = 0; i < 4; ++i) { ra0[i] = aload(mm + lrow + 32 * i, kq, lkc); rb0[i] = bload(nn + lrow + 32 * i, kq, lkc); }
      }
      compute(0);
#pragma unroll
      for (int i = 0; i < 4; ++i) {
        *(uint4*)(As + 128 * LDT + (lrow + 32 * i) * LDT + lkc) = ra1[i];
        *(uint4*)(Bs + 128 * LDT + (lrow + 32 * i) * LDT + lkc) = rb1[i];
      }
      __syncthreads();
      {
        const int mm = in2 ? m0 : m1, nn = in2 ? n0 : n1, kq = in2 ? ks + 3 : 1;
#pragma unroll
        for (int i = 0; i < 4; ++i) { ra1[i] = aload(mm + lrow + 32 * i, kq, lkc); rb1[i] = bload(nn + lrow + 32 * i, kq, lkc); }
      }
      compute(1);
#pragma unroll
      for (int i = 0; i < 4; ++i) {
        *(uint4*)(As + (lrow + 32 * i) * LDT + lkc) = ra0[i];
        *(uint4*)(Bs + (lrow + 32 * i) * LDT + lkc) = rb0[i];
      }
      __syncthreads();
    }
    epi(acc, m0 + wm * 64, n0 + wc * 64);
    if (!has_next) break;
    w = wnext; m0 = m1; n0 = n1;
  }
}

template <class F>
DI void for_tiles(int mtiles, int ntiles, F f) {
  const int xcd = BID() & 7, slot = BID() >> 3, nslot = GDIM() >> 3;
  const int per = (mtiles >> 3) * ntiles;
  for (int w = slot; w < per; w += nslot) {
    int mi = w / ntiles, ni = w - mi * ntiles;
    f((mi * 8 + xcd), ni);
  }
}

#define EPI_LOOP for (int mt = 0; mt < 4; ++mt) for (int nt = 0; nt < 4; ++nt) for (int r = 0; r < 4; ++r)

struct LnRef { const float* g; const float* b; int slot; };
constexpr size_t OFF_LNST = 510 * MiB;
DI float4 ln_h4(const Params& p, const LnRef& r, int row, int col, float4 y) {
  if (r.slot < 0) return y;
  const float2 st = ((const float2*)(p.ws + OFF_LNST))[(size_t)r.slot * T_ + row];
  const float4 g = *(const float4*)(r.g + col), b = *(const float4*)(r.b + col);
  float4 h;
  h.x = (y.x - st.x) * st.y * g.x + b.x; h.y = (y.y - st.x) * st.y * g.y + b.y;
  h.z = (y.z - st.x) * st.y * g.z + b.z; h.w = (y.w - st.x) * st.y * g.w + b.w;
  return h;
}
DI void epi_resid(const Params& p, const LnRef& lr, f32x4 (&acc)[4][4], int rb, int cb) {
  const int lane = TID() & 63, l15 = lane & 15, quad = lane >> 4;
#pragma unroll
  for (int mt = 0; mt < 4; ++mt)
#pragma unroll
    for (int nt = 0; nt < 4; ++nt) {
      const int row = rb + mt * 16 + l15, col = cb + nt * 16 + quad * 4;
      float4* ptr = (float4*)(p.out + (size_t)row * 1024 + col);
      float4 h = (lr.slot < 0) ? *(const float4*)(p.x + (size_t)row * 1024 + col) : ln_h4(p, lr, row, col, *ptr);
      h.x = ALPHA * h.x + acc[mt][nt][0]; h.y = ALPHA * h.y + acc[mt][nt][1]; h.z = ALPHA * h.z + acc[mt][nt][2]; h.w = ALPHA * h.w + acc[mt][nt][3];
      *ptr = h;
    }
}
DI void epi_bf16(bf16_t* dst, int ld, f32x4 (&acc)[4][4], int rb, int cb) {
  const int lane = TID() & 63, l15 = lane & 15, quad = lane >> 4;
#pragma unroll
  for (int mt = 0; mt < 4; ++mt)
#pragma unroll
    for (int nt = 0; nt < 4; ++nt) {
      u32x2 v; v[0] = pack2(acc[mt][nt][0], acc[mt][nt][1]); v[1] = pack2(acc[mt][nt][2], acc[mt][nt][3]);
      *(u32x2*)(dst + (size_t)(rb + mt * 16 + l15) * ld + cb + nt * 16 + quad * 4) = v;
    }
}

struct PlainLoad {
  const bf16_t* base; int ld;
  DI uint4 operator()(int row, int ks, int kc) const { return *(const uint4*)((const char*)base + (unsigned)((row * ld + ks * 64 + kc) * 2)); }
};

DI void phase_proj(const Params& p, int i, bf16_t* smem) {
  const bf16_t* W = (const bf16_t*)(p.ws + OFF_W) + W_EVEN0 + (size_t)i * (SZ_WIN + SZ_SQ);
  PlainLoad al{(const bf16_t*)(p.ws + OFF_HB), 1024}, bl{W, 1024};
  bf16_t* dnqkv = (bf16_t*)(p.ws + OFF_DNQKV); bf16_t* z = (bf16_t*)(p.ws + OFF_Z);
  bf16_t* swq = (bf16_t*)(p.ws + OFF_SWQ); bf16_t* swk = (bf16_t*)(p.ws + OFF_SWK); bf16_t* swv = (bf16_t*)(p.ws + OFF_SWV);
  float* logit = (float*)(p.ws + OFF_LOGIT);
  const float* rc = (const float*)(p.ws + OFF_ROPE); const float* rs = rc + (size_t)T_ * 32;
  {
    gemm_stream(256, 29, 16, al, bl, [&](f32x4 (&acc)[4][4], int rb, int cb) {
      const int lane = TID() & 63, l15 = lane & 15, quad = lane >> 4;
      if (cb < 1536) epi_bf16(dnqkv, 1536, acc, rb, cb);
      else if (cb < 2048) epi_bf16(z, 512, acc, rb, cb - 1536);
      else if (cb < 3072) {
        bf16_t* dst = (cb < 2560) ? swq : swk; const int c0 = (cb < 2560) ? cb - 2048 : cb - 2560;
#pragma unroll
        for (int mt = 0; mt < 4; ++mt) {
          const int row = rb + mt * 16 + l15;
#pragma unroll
          for (int nt = 0; nt < 2; ++nt) {
            const int d = nt * 16 + quad * 4;
            const float4 c = *(const float4*)(rc + (size_t)row * 32 + d), sn = *(const float4*)(rs + (size_t)row * 32 + d);
            const f32x4 x1 = acc[mt][nt], x2 = acc[mt][nt + 2];
            u32x2 o1, o2;
            o1[0] = pack2(x1[0] * c.x - x2[0] * sn.x, x1[1] * c.y - x2[1] * sn.y); o1[1] = pack2(x1[2] * c.z - x2[2] * sn.z, x1[3] * c.w - x2[3] * sn.w);
            o2[0] = pack2(x2[0] * c.x + x1[0] * sn.x, x2[1] * c.y + x1[1] * sn.y); o2[1] = pack2(x2[2] * c.z + x1[2] * sn.z, x2[3] * c.w + x1[3] * sn.w);
            *(u32x2*)(dst + (size_t)row * 512 + c0 + d) = o1;
            *(u32x2*)(dst + (size_t)row * 512 + c0 + d + 32) = o2;
          }
        }
      } else if (cb < 3584) epi_bf16(swv, 512, acc, rb, cb - 3072);
      else if (cb == 3584) {
        if (quad < 2) {
#pragma unroll
          for (int mt = 0; mt < 4; ++mt)
            *(float4*)(logit + (size_t)(rb + mt * 16 + l15) * 8 + quad * 4) = make_float4(acc[mt][0][0], acc[mt][0][1], acc[mt][0][2], acc[mt][0][3]);
        }
      }
    }, smem);
  }
}

DI void phase_dil_attn(const Params& p, int first, int nblk);

DI void phase_dn_prep(const Params& p, int i, char* smem) {
  bf16_t* qs = (bf16_t*)smem; bf16_t* ks = qs + 64 * 136; bf16_t* vs = ks + 64 * 136;
  float* Lm = (float*)(smem + 3 * 17408); float* beta = Lm + 64 * 68; float* gcum = beta + 64; float* egc = gcum + 64;
  const bf16_t* dnqkv = (const bf16_t*)(WS(p) + OFF_DNQKV);
  const float* logit = (const float*)(WS(p) + OFF_LOGIT);
  bf16_t* qd_g = (bf16_t*)(WS(p) + OFF_QD); bf16_t* kd_g = (bf16_t*)(WS(p) + OFF_KD); bf16_t* in_g = (bf16_t*)(WS(p) + OFF_INTRA);
  bf16_t* w_g = (bf16_t*)(WS(p) + OFF_WB); bf16_t* u_g = (bf16_t*)(WS(p) + OFF_UB); float* eg_g = (float*)(WS(p) + OFF_EG);
  const float* cw = p.dn_conv_w + (size_t)i * 4 * 1536;
  const int tid = TID(), wave = tid >> 6, lane = tid & 63, l15 = lane & 15, quad = lane >> 4;
  const float QS = 0.08838834764831845f;
  for (int item = BID(); item < 2048; item += GDIM()) {
    const int b = item >> 8, h = (item >> 6) & 3, n = item & 63;
    const int t0 = b * 4096 + n * 64, s0 = n * 64;
    const float A = __expf(p.dn_a_log[i * 4 + h]), dtb = p.dn_dt_bias[i * 4 + h];
    {
      float cw0[3][4], cw1[3][4], x0[3][4], x1[3][4];
#pragma unroll
      for (int which = 0; which < 3; ++which)
#pragma unroll
        for (int j = 0; j < 4; ++j) {
          const int col = which * 512 + h * 128 + lane * 2;
          cw0[which][j] = cw[j * 1536 + col]; cw1[which][j] = cw[j * 1536 + col + 1];
        }
      const int ilb = wave * 16;
#pragma unroll
      for (int which = 0; which < 3; ++which)
#pragma unroll
        for (int j = 0; j < 3; ++j) {
          const int sq = s0 + ilb - 3 + j;
          unsigned v = 0u;
          if (sq >= 0) v = *(const unsigned*)(dnqkv + (size_t)(t0 + ilb - 3 + j) * 1536 + which * 512 + h * 128 + lane * 2);
          x0[which][j + 1] = bf2f((bf16_t)(v & 0xffff)); x1[which][j + 1] = bf2f((bf16_t)(v >> 16));
        }
#pragma unroll 4
      for (int tt = 0; tt < 16; ++tt) {
        const int il = ilb + tt;
#pragma unroll
        for (int which = 0; which < 3; ++which) {
          x0[which][0] = x0[which][1]; x0[which][1] = x0[which][2]; x0[which][2] = x0[which][3];
          x1[which][0] = x1[which][1]; x1[which][1] = x1[which][2]; x1[which][2] = x1[which][3];
          const unsigned v = *(const unsigned*)(dnqkv + (size_t)(t0 + il) * 1536 + which * 512 + h * 128 + lane * 2);
          x0[which][3] = bf2f((bf16_t)(v & 0xffff)); x1[which][3] = bf2f((bf16_t)(v >> 16));
          float y0 = cw0[which][0] * x0[which][0] + cw0[which][1] * x0[which][1] + cw0[which][2] * x0[which][2] + cw0[which][3] * x0[which][3];
          float y1 = cw1[which][0] * x1[which][0] + cw1[which][1] * x1[which][1] + cw1[which][2] * x1[which][2] + cw1[which][3] * x1[which][3];
          y0 = siluf_(y0); y1 = siluf_(y1);
          if (which < 2) {
            float ss = wave_sum(y0 * y0 + y1 * y1);
            float sc = rsqrtf(ss + 1e-6f);
            y0 *= sc; y1 *= sc;
          }
          bf16_t* dst = (which == 0) ? qs : (which == 1 ? ks : vs);
          *(unsigned*)(dst + il * 136 + lane * 2) = pack2(y0, y1);
        }
      }
    }
    if (wave == 0) {
      const size_t row = (size_t)(t0 + lane);
      const float bl = logit[row * 8 + h], al = logit[row * 8 + 4 + h];
      float g = -A * softplusf_(al + dtb);
#pragma unroll
      for (int o = 1; o < 64; o <<= 1) { float v = __shfl_up(g, o); if (lane >= o) g += v; }
      beta[lane] = sigmoidf_(bl); gcum[lane] = g; egc[lane] = __expf(g);
    }
    __syncthreads();
    {
      f32x4 kk[4], qk[4];
#pragma unroll
      for (int nt = 0; nt < 4; ++nt) { kk[nt] = f32x4{0.f, 0.f, 0.f, 0.f}; qk[nt] = f32x4{0.f, 0.f, 0.f, 0.f}; }
#pragma unroll
      for (int k4 = 0; k4 < 4; ++k4) {
        const bf16x8 ak = *(const bf16x8*)(ks + (wave * 16 + l15) * 136 + k4 * 32 + quad * 8);
        const bf16x8 aq = *(const bf16x8*)(qs + (wave * 16 + l15) * 136 + k4 * 32 + quad * 8);
#pragma unroll
        for (int nt = 0; nt < 4; ++nt) {
          const bf16x8 bk = *(const bf16x8*)(ks + (nt * 16 + l15) * 136 + k4 * 32 + quad * 8);
          kk[nt] = MFMA16(ak, bk, kk[nt]); qk[nt] = MFMA16(aq, bk, qk[nt]);
        }
      }
#pragma unroll
      for (int nt = 0; nt < 4; ++nt)
#pragma unroll
        for (int r = 0; r < 4; ++r) {
          const int ii = wave * 16 + quad * 4 + r, jj = nt * 16 + l15;
          const float dec = (jj <= ii) ? __expf(gcum[ii] - gcum[jj]) : 0.f;
          Lm[ii * 68 + jj] = (jj < ii) ? beta[ii] * kk[nt][r] * dec : 0.f;
          in_g[(size_t)item * 4096 + ii * 64 + kperm(jj)] = f2bf(qk[nt][r] * QS * dec);
        }
    }
    __syncthreads();
    {
      float x[64];
#pragma unroll
      for (int ii = 0; ii < 64; ++ii) x[ii] = 0.f;
      const int c = tid & 127;
      const bool isw = tid >= 128;
      bf16_t* dstb = (isw ? w_g : u_g) + (size_t)item * 8192 + (isw ? kperm(c) : c);
      const bf16_t* srcb = (isw ? ks : vs) + c;
#pragma unroll
      for (int ii = 0; ii < 64; ++ii) {
        float acc = bf2f(srcb[ii * 136]) * beta[ii] * (isw ? egc[ii] : 1.f);
#pragma unroll
        for (int j4 = 0; j4 < (ii + 3) / 4; ++j4) {
          const float4 l4 = *(const float4*)(Lm + ii * 68 + j4 * 4);
          acc -= l4.x * x[j4 * 4]; acc -= l4.y * x[j4 * 4 + 1]; acc -= l4.z * x[j4 * 4 + 2]; acc -= l4.w * x[j4 * 4 + 3];
        }
        x[ii] = acc;
        dstb[ii * 128] = f2bf(acc);
        if ((ii & 3) == 3) __builtin_amdgcn_sched_barrier(0);
      }
    }
    {
      const float gl = gcum[63];
#pragma unroll 4
      for (int k = 0; k < 32; ++k) {
        const int e = tid + 256 * k;
        const int ii = e >> 7, d = e & 127;
        qd_g[(size_t)item * 8192 + ii * 128 + kperm(d)] = f2bf(bf2f(qs[ii * 136 + d]) * QS * egc[ii]);
        const int d2 = e >> 6, i2 = e & 63;
        kd_g[(size_t)item * 8192 + d2 * 64 + kperm(i2)] = f2bf(bf2f(ks[i2 * 136 + d2]) * __expf(gl - gcum[i2]));
      }
      if (tid == 0) eg_g[item] = __expf(gl);
    }
    __syncthreads();
  }
}

DI bf16x8 ld2(const bf16_t* ptr) {
  u32x2 lo = *(const u32x2*)ptr, hi = *(const u32x2*)(ptr + 16);
  u32x4 t; t[0] = lo[0]; t[1] = lo[1]; t[2] = hi[0]; t[3] = hi[1];
  return __builtin_bit_cast(bf16x8, t);
}

DI void dn_chain_item(const Params& p, int item, bf16_t* smem) {
  const int tid = TID(), wave = tid >> 6, lane = tid & 63, l15 = lane & 15, quad = lane >> 4;
  const int bh = item >> 1, half = item & 1;
  const int e0 = half * 64 + wave * 16 + l15;
  const bf16_t* qd_g = (const bf16_t*)(WS(p) + OFF_QD); const bf16_t* kd_g = (const bf16_t*)(WS(p) + OFF_KD); const bf16_t* in_g = (const bf16_t*)(WS(p) + OFF_INTRA);
  const bf16_t* w_g = (const bf16_t*)(WS(p) + OFF_WB); bf16_t* u_g = (bf16_t*)(WS(p) + OFF_UB); const float* eg_g = (const float*)(WS(p) + OFF_EG);
  bf16_t* wl = smem; bf16_t* ql = wl + 64 * 136; bf16_t* kl = ql + 64 * 136; bf16_t* il = kl + 128 * 72; bf16_t* ul = il + 64 * 72;
  uint4 rw0, rw1, rw2, rw3, rq0, rq1, rq2, rq3, rk0, rk1, rk2, rk3, ri0, ri1, ru0, ru1;
#define CH_GLOAD(n_) do { const size_t ci_ = (size_t)bh * 64 + (n_); \
    const bf16_t* w_ = w_g + ci_ * 8192 + tid * 8; const bf16_t* q_ = qd_g + ci_ * 8192 + tid * 8; const bf16_t* k_ = kd_g + ci_ * 8192 + tid * 8; \
    rw0 = *(const uint4*)(w_); rw1 = *(const uint4*)(w_ + 2048); rw2 = *(const uint4*)(w_ + 4096); rw3 = *(const uint4*)(w_ + 6144); \
    rq0 = *(const uint4*)(q_); rq1 = *(const uint4*)(q_ + 2048); rq2 = *(const uint4*)(q_ + 4096); rq3 = *(const uint4*)(q_ + 6144); \
    rk0 = *(const uint4*)(k_); rk1 = *(const uint4*)(k_ + 2048); rk2 = *(const uint4*)(k_ + 4096); rk3 = *(const uint4*)(k_ + 6144); \
    ri0 = *(const uint4*)(in_g + ci_ * 4096 + tid * 8); ri1 = *(const uint4*)(in_g + ci_ * 4096 + 2048 + tid * 8); \
    ru0 = *(const uint4*)(u_g + ci_ * 8192 + (tid >> 3) * 128 + half * 64 + (tid & 7) * 8); \
    ru1 = *(const uint4*)(u_g + ci_ * 8192 + (32 + (tid >> 3)) * 128 + half * 64 + (tid & 7) * 8); } while (0)
#define CH_LSTORE() do { \
    bf16_t* w_ = wl + (tid >> 4) * 136 + (tid & 15) * 8; bf16_t* q_ = ql + (tid >> 4) * 136 + (tid & 15) * 8; bf16_t* k_ = kl + (tid >> 3) * 72 + (tid & 7) * 8; \
    *(uint4*)(w_) = rw0; *(uint4*)(w_ + 16 * 136) = rw1; *(uint4*)(w_ + 32 * 136) = rw2; *(uint4*)(w_ + 48 * 136) = rw3; \
    *(uint4*)(q_) = rq0; *(uint4*)(q_ + 16 * 136) = rq1; *(uint4*)(q_ + 32 * 136) = rq2; *(uint4*)(q_ + 48 * 136) = rq3; \
    *(uint4*)(k_) = rk0; *(uint4*)(k_ + 32 * 72) = rk1; *(uint4*)(k_ + 64 * 72) = rk2; *(uint4*)(k_ + 96 * 72) = rk3; \
    *(uint4*)(il + (tid >> 3) * 72 + (tid & 7) * 8) = ri0; *(uint4*)(il + (32 + (tid >> 3)) * 72 + (tid & 7) * 8) = ri1; \
    *(uint4*)(ul + (tid >> 3) * 72 + (tid & 7) * 8) = ru0; *(uint4*)(ul + (32 + (tid >> 3)) * 72 + (tid & 7) * 8) = ru1; } while (0)
  f32x4 S[8];
#pragma unroll
  for (int mt = 0; mt < 8; ++mt) S[mt] = f32x4{0.f, 0.f, 0.f, 0.f};
  CH_GLOAD(0);
  CH_LSTORE();
  __syncthreads();
#pragma unroll 1
  for (int n = 0; n < 64; ++n) {
    const size_t ci = (size_t)bh * 64 + n;
    if (n + 1 < 64) CH_GLOAD(n + 1);
    bf16_t* ub = u_g + ci * 8192;
    const float eg = eg_g[ci];
    bf16x8 sb[4];
#pragma unroll
    for (int s = 0; s < 4; ++s) sb[s] = pack8(S[2 * s], S[2 * s + 1]);
    f32x4 vn[4];
#pragma unroll
    for (int it = 0; it < 4; ++it) {
      f32x4 a = {0.f, 0.f, 0.f, 0.f};
#pragma unroll
      for (int s = 0; s < 4; ++s) a = MFMA16(*(const bf16x8*)(wl + (it * 16 + l15) * 136 + s * 32 + quad * 8), sb[s], a);
#pragma unroll
      for (int r = 0; r < 4; ++r) vn[it][r] = bf2f(ul[(it * 16 + quad * 4 + r) * 72 + wave * 16 + l15]) - a[r];
    }
    bf16x8 vb[2];
    vb[0] = pack8(vn[0], vn[1]); vb[1] = pack8(vn[2], vn[3]);
#pragma unroll
    for (int it = 0; it < 4; ++it) {
      f32x4 a = {0.f, 0.f, 0.f, 0.f};
#pragma unroll
      for (int s = 0; s < 4; ++s) a = MFMA16(*(const bf16x8*)(ql + (it * 16 + l15) * 136 + s * 32 + quad * 8), sb[s], a);
#pragma unroll
      for (int s = 0; s < 2; ++s) a = MFMA16(*(const bf16x8*)(il + (it * 16 + l15) * 72 + s * 32 + quad * 8), vb[s], a);
#pragma unroll
      for (int r = 0; r < 4; ++r) ub[(it * 16 + quad * 4 + r) * 128 + e0] = f2bf(a[r]);
    }
#pragma unroll
    for (int mt = 0; mt < 8; ++mt) {
      f32x4 a = S[mt];
      a[0] *= eg; a[1] *= eg; a[2] *= eg; a[3] *= eg;
#pragma unroll
      for (int s = 0; s < 2; ++s) a = MFMA16(*(const bf16x8*)(kl + (mt * 16 + l15) * 72 + s * 32 + quad * 8), vb[s], a);
      S[mt] = a;
    }
    __syncthreads();
    if (n + 1 < 64) CH_LSTORE();
    __syncthreads();
  }
}

DI void phase_mix(const Params& p, int i, bf16_t* smem) {
  if (BID() < 64) { dn_chain_item(p, BID(), smem); return; }
  phase_dil_attn(p, BID() - 64, GDIM() - 64);
}

DI void phase_dn_post(const Params& p, int i) {
  const bf16_t* ob = (const bf16_t*)(p.ws + OFF_UB);
  bf16_t* z = (bf16_t*)(p.ws + OFF_Z);
  const float* ng = p.dn_norm_g + i * 128;
  const int wave = TID() >> 6, lane = TID() & 63;
  const float g0 = ng[lane * 2], g1 = ng[lane * 2 + 1];
  const int N = T_ * 4;
  for (int base = (BID() * 4 + wave) * 4; base < N; base += GDIM() * 16) {
    unsigned ov[4], zv[4];
#pragma unroll
    for (int j = 0; j < 4; ++j) {
      const int item = base + j;
      const int t = item >> 2, h = item & 3, b = t >> 12, sidx = t & 4095;
      const size_t og = ((size_t)((b * 4 + h) * 64 + (sidx >> 6))) * 8192 + (sidx & 63) * 128 + lane * 2;
      ov[j] = *(const unsigned*)(ob + og);
      zv[j] = *(const unsigned*)(z + (size_t)item * 128 + lane * 2);
    }
#pragma unroll
    for (int j = 0; j < 4; ++j) {
      const float o0 = bf2f((bf16_t)(ov[j] & 0xffff)), o1 = bf2f((bf16_t)(ov[j] >> 16));
      const float z0 = bf2f((bf16_t)(zv[j] & 0xffff)), z1 = bf2f((bf16_t)(zv[j] >> 16));
      const float ms = wave_sum(o0 * o0 + o1 * o1) * (1.f / 128.f);
      const float rr = rsqrtf(ms + 1e-6f);
      *(unsigned*)(z + (size_t)(base + j) * 128 + lane * 2) = pack2(o0 * rr * g0 * siluf_(z0), o1 * rr * g1 * siluf_(z1));
    }
  }
}

struct MixLoad {
  const bf16_t* a; const bf16_t* b;
  DI uint4 operator()(int row, int ks, int kc) const {
    const unsigned off = (unsigned)((row * 512 + (ks & 7) * 64 + kc) * 2);
    return *(const uint4*)((const char*)((ks < 8) ? a : b) + off);
  }
};

DI void phase_wout(const Params& p, int i, bf16_t* smem, LnRef lr) {
  const bf16_t* W = (const bf16_t*)(p.ws + OFF_W) + W_EVEN0 + (size_t)i * (SZ_WIN + SZ_SQ) + SZ_WIN;
  MixLoad al{(const bf16_t*)(p.ws + OFF_Z), (const bf16_t*)(p.ws + OFF_SWQ)};
  PlainLoad bl{W, 1024};
  {
    gemm_stream(256, 8, 16, al, bl, [&](f32x4 (&acc)[4][4], int rb, int cb) { epi_resid(p, lr, acc, rb, cb); }, smem);
  }
}

template <int R>
DI void ln_rows(const Params& p, int row0, const float* g, const float* b, int lane, int slot, bool final_out) {
  bf16_t* hb = (bf16_t*)(p.ws + OFF_HB);
  float2* lnst = (float2*)(p.ws + OFF_LNST) + (size_t)slot * T_;
  float4 v[R][4];
#pragma unroll
  for (int j = 0; j < R; ++j)
#pragma unroll
    for (int i = 0; i < 4; ++i) v[j][i] = ((const float4*)(p.out + (size_t)(row0 + j) * 1024))[lane + 64 * i];
  float4 gg[4], bb[4];
#pragma unroll
  for (int i = 0; i < 4; ++i) { gg[i] = ((const float4*)g)[lane + 64 * i]; bb[i] = ((const float4*)b)[lane + 64 * i]; }
#pragma unroll
  for (int j = 0; j < R; ++j) {
    float s = 0.f;
#pragma unroll
    for (int i = 0; i < 4; ++i) s += v[j][i].x + v[j][i].y + v[j][i].z + v[j][i].w;
    const float mu = wave_sum(s) * (1.f / 1024.f);
    float q = 0.f;
#pragma unroll
    for (int i = 0; i < 4; ++i) { float a = v[j][i].x - mu, b2 = v[j][i].y - mu, c = v[j][i].z - mu, d = v[j][i].w - mu; q += a * a + b2 * b2 + c * c + d * d; }
    const float rstd = rsqrtf(wave_sum(q) * (1.f / 1024.f) + 1e-5f);
    if (lane == 0) lnst[row0 + j] = make_float2(mu, rstd);
    float4* y = (float4*)(p.out + (size_t)(row0 + j) * 1024);
#pragma unroll
    for (int i = 0; i < 4; ++i) {
      float4 o;
      o.x = (v[j][i].x - mu) * rstd * gg[i].x + bb[i].x; o.y = (v[j][i].y - mu) * rstd * gg[i].y + bb[i].y;
      o.z = (v[j][i].z - mu) * rstd * gg[i].z + bb[i].z; o.w = (v[j][i].w - mu) * rstd * gg[i].w + bb[i].w;
      if (final_out) y[lane + 64 * i] = o;
      uint2 ob; ob.x = pack2(o.x, o.y); ob.y = pack2(o.z, o.w);
      ((uint2*)(hb + (size_t)(row0 + j) * 1024))[lane + 64 * i] = ob;
    }
  }
}
DI void phase_ln(const Params& p, const float* g, const float* b, int slot, bool final_out) {
  const int wave = TID() >> 6, lane = TID() & 63;
  for (int row = (BID() * 4 + wave) * 4; row < T_; row += GDIM() * 16) ln_rows<4>(p, row, g, b, lane, slot, final_out);
}

DI void phase_s5_naive(const Params& p, int i) {
  const int wave = TID() >> 6, lane = TID() & 63;
  bf16_t* hid = (bf16_t*)(p.ws + OFF_HID);
  for (int base = BID() * 4; base < 512; base += GDIM() * 4) {
    const int item = base + wave, b = item >> 6, g = item & 63;
    const int gp = (i * 64 + g) * 64 + lane;
    const double dt = exp((double)p.s5_log_dt[i * 64 + g]);
    const double are = p.s5_a_re[gp], aim = p.s5_a_im[gp];
    const double lr = are * dt, li = aim * dt;
    const double kk = rint(li * 0.15915494309189535);
    const double red = li - kk * 6.283185307179586;
    const double e = exp(lr);
    const double abr = e * cos(red), abi = e * sin(red);
    const double den = are * are + aim * aim;
    const double nr = abr - 1.0, ni = abi;
    const double cfr = (nr * are + ni * aim) / den, cfi = (ni * are - nr * aim) / den;
    float bbr[16], bbi[16], cr[16], ci[16];
#pragma unroll
    for (int h = 0; h < 16; ++h) {
      const double br = p.s5_b_re[(size_t)gp * 16 + h], bi = p.s5_b_im[(size_t)gp * 16 + h];
      bbr[h] = (float)(cfr * br - cfi * bi); bbi[h] = (float)(cfr * bi + cfi * br);
      cr[h] = p.s5_c_re[((size_t)(i * 64 + g) * 16 + h) * 64 + lane];
      ci[h] = p.s5_c_im[((size_t)(i * 64 + g) * 16 + h) * 64 + lane];
    }
    const float ar = (float)abr, ai = (float)abi;
    const float dsk = p.s5_d[i * 1024 + g * 16 + (lane & 15)];
    float sr = 0.f, si = 0.f;
#pragma unroll 1
    for (int t = 0; t < S_; ++t) {
      const size_t row = (size_t)(b * S_ + t);
      const float4* up = (const float4*)(p.out + row * 1024 + g * 16);
      float u[16];
#pragma unroll
      for (int j = 0; j < 4; ++j) { float4 v = up[j]; u[4 * j] = v.x; u[4 * j + 1] = v.y; u[4 * j + 2] = v.z; u[4 * j + 3] = v.w; }
      float bur = 0.f, bui = 0.f;
#pragma unroll
      for (int h = 0; h < 16; ++h) { bur += bbr[h] * u[h]; bui += bbi[h] * u[h]; }
      const float nsr = ar * sr - ai * si + bur, nsi = ar * si + ai * sr + bui;
      sr = nsr; si = nsi;
      float yk = 0.f, uk = 0.f;
#pragma unroll
      for (int h = 0; h < 16; ++h) {
        float v = wave_sum(cr[h] * sr - ci[h] * si);
        if (lane == h) { yk = v; uk = u[h]; }
      }
      if (lane < 16) hid[row * 1024 + g * 16 + lane] = f2bf(gelu_tanh(yk + dsk * uk));
    }
  }
}

DI void phase_s5_tables(const Params& p, int i, float* smem) {
  float2* pw = (float2*)smem;
  float2* bb = pw + 64 * 33;
  float2* cc = bb + 64 * 16;
  bf16_t* Ktab = (bf16_t*)(p.ws + OFF_KTAB); bf16_t* Etab = (bf16_t*)(p.ws + OFF_ETAB); bf16_t* Gtab = (bf16_t*)(p.ws + OFF_GTAB);
  float2* AL = (float2*)(p.ws + OFF_AL);
  const int tid = TID();
  for (int item = BID(); item < 512; item += GDIM()) {
    const int g = item >> 3, part = item & 7;
    const double dt = exp((double)p.s5_log_dt[i * 64 + g]);
    for (int e = tid; e < 64 * 33; e += 256) {
      const int pp = e / 33, n = e - pp * 33;
      const double are = p.s5_a_re[(i * 64 + g) * 64 + pp], aim = p.s5_a_im[(i * 64 + g) * 64 + pp];
      const double lr = are * dt * n, li = aim * dt * n;
      const double k = rint(li * 0.15915494309189535);
      const double red = li - k * 6.283185307179586;
      const double ex = exp(lr);
      pw[e] = make_float2((float)(ex * cos(red)), (float)(ex * sin(red)));
    }
    for (int e = tid; e < 1024; e += 256) {
      const int pp = e >> 4;
      const int gp = (i * 64 + g) * 64 + pp;
      const double are = p.s5_a_re[gp], aim = p.s5_a_im[gp];
      const double lr = are * dt, li = aim * dt;
      const double k = rint(li * 0.15915494309189535);
      const double red = li - k * 6.283185307179586;
      const double ex = exp(lr);
      const double nr = ex * cos(red) - 1.0, ni = ex * sin(red);
      const double den = are * are + aim * aim;
      const double cfr = (nr * are + ni * aim) / den, cfi = (ni * are - nr * aim) / den;
      const double br = p.s5_b_re[(size_t)gp * 16 + (e & 15)], bi = p.s5_b_im[(size_t)gp * 16 + (e & 15)];
      bb[e] = make_float2((float)(cfr * br - cfi * bi), (float)(cfr * bi + cfi * br));
      const size_t ci = ((size_t)(i * 64 + g) * 16 + (e >> 6)) * 64 + (e & 63);
      cc[e] = make_float2(p.s5_c_re[ci], p.s5_c_im[ci]);
    }
    __syncthreads();
    for (int e = part * 1024 + tid; e < (part + 1) * 1024; e += 256) {
      const int tau = e >> 8, ho = (e >> 4) & 15, hi = e & 15;
      float acc = 0.f;
      for (int pp = 0; pp < 64; ++pp) {
        const float2 c = cc[ho * 64 + pp], w = pw[pp * 33 + tau], b = bb[pp * 16 + hi];
        const float cwr = c.x * w.x - c.y * w.y, cwi = c.x * w.y + c.y * w.x;
        acc += cwr * b.x - cwi * b.y;
      }
      Ktab[(size_t)g * 8192 + e] = f2bf(acc);
    }
    for (int e = part * 8192 + tid; e < (part + 1) * 8192; e += 256) {
      const int pc = e >> 9, sidx = (e >> 4) & 31, hi = e & 15, pp = pc & 63;
      const float2 w = pw[pp * 33 + 31 - sidx], b = bb[pp * 16 + hi];
      const float v = (pc < 64) ? (w.x * b.x - w.y * b.y) : (w.x * b.y + w.y * b.x);
      Etab[(size_t)g * 65536 + e] = f2bf(v);
    }
    for (int e = part * 8192 + tid; e < (part + 1) * 8192; e += 256) {
      const int row = e >> 7, pc = e & 127, pp = pc & 63, t = row >> 4, ho = row & 15;
      const float2 c = cc[ho * 64 + pp], w = pw[pp * 33 + t + 1];
      const float v = (pc < 64) ? (c.x * w.x - c.y * w.y) : -(c.x * w.y + c.y * w.x);
      Gtab[(size_t)g * 65536 + e] = f2bf(v);
    }
    if (tid < 64 && part == 0) AL[g * 64 + tid] = pw[tid * 33 + 32];
    __syncthreads();
  }
}

DI void phase_s5_end(const Params& p, bf16_t* smem) {
  const bf16_t* Etab = (const bf16_t*)(p.ws + OFF_ETAB); const bf16_t* hb = (const bf16_t*)(p.ws + OFF_HB);
  const float2* AL = (const float2*)(p.ws + OFF_AL);
  bf16_t* sin_ = (bf16_t*)(p.ws + OFF_SIN);
  float* endbuf = (float*)smem;
  for (int item = BID(); item < 512; item += GDIM()) {
    const int g = item >> 3, b = item & 7;
    auto al = [=](int row, int ks, int kc) { return *(const uint4*)((const char*)Etab + (unsigned)((((g * 128 + row) * 512) + ks * 64 + kc) * 2)); };
    auto bl = [=](int n, int ks, int kc) {
      const int k = ks * 64 + kc, sidx = k >> 4, hi0 = k & 15;
      return *(const uint4*)((const char*)hb + (unsigned)(((b * 4096 + n * 32 + sidx) * 1024 + g * 16 + hi0) * 2));
    };
    gemm_tile(0, 0, 8, al, bl, [&](f32x4 (&acc)[4][4], int rb, int cb) {
      const int lane = TID() & 63, l15 = lane & 15, quad = lane >> 4;
#pragma unroll
      for (int mt = 0; mt < 4; ++mt)
#pragma unroll
        for (int nt = 0; nt < 4; ++nt)
#pragma unroll
          for (int r = 0; r < 4; ++r) endbuf[(rb + mt * 16 + l15) * 129 + cb + nt * 16 + quad * 4 + r] = acc[mt][nt][r];
    }, smem);
    __syncthreads();
    if (TID() < 64) {
      const int pp = TID();
      const float2 a = AL[g * 64 + pp];
      float sr = 0.f, si = 0.f;
      for (int n = 0; n < 128; ++n) {
        bf16_t* dst = sin_ + ((size_t)g * 1024 + b * 128 + n) * 128;
        dst[pp] = f2bf(sr); dst[64 + pp] = f2bf(si);
        const float er = endbuf[pp * 129 + n], ei = endbuf[(64 + pp) * 129 + n];
        const float nr = a.x * sr - a.y * si + er, ni = a.x * si + a.y * sr + ei;
        sr = nr; si = ni;
      }
    }
    __syncthreads();
  }
}

DI void phase_s5_y(const Params& p, int i, bf16_t* smem, LnRef lr) {
  const bf16_t* Ktab = (const bf16_t*)(p.ws + OFF_KTAB); const bf16_t* Gtab = (const bf16_t*)(p.ws + OFF_GTAB);
  const bf16_t* hb = (const bf16_t*)(p.ws + OFF_HB); const bf16_t* sin_ = (const bf16_t*)(p.ws + OFF_SIN);
  bf16_t* hid = (bf16_t*)(p.ws + OFF_HID);
  for (int w = BID(); w < 2048; w += GDIM()) {
    const int g = w >> 5, mtile = (w >> 3) & 3, b = w & 7;
    const int nT = mtile * 2 + 2;
    auto al = [=](int row, int ks, int kc) -> uint4 {
      if (ks < nT) {
        const int k = ks * 64 + kc, sidx = k >> 4, hi0 = k & 15, t = row >> 4, ho = row & 15;
        if (t >= sidx) return *(const uint4*)((const char*)Ktab + (unsigned)(((((g * 32 + (t - sidx)) * 16 + ho) * 16) + hi0) * 2));
        return make_uint4(0, 0, 0, 0);
      }
      return *(const uint4*)((const char*)Gtab + (unsigned)((((g * 512 + row) * 128) + (ks - nT) * 64 + kc) * 2));
    };
    auto bl = [=](int n, int ks, int kc) -> uint4 {
      if (ks < nT) {
        const int k = ks * 64 + kc, sidx = k >> 4, hi0 = k & 15;
        return *(const uint4*)((const char*)hb + (unsigned)(((b * 4096 + n * 32 + sidx) * 1024 + g * 16 + hi0) * 2));
      }
      return *(const uint4*)((const char*)sin_ + (unsigned)((((g * 1024 + b * 128 + n) * 128) + (ks - nT) * 64 + kc) * 2));
    };
    gemm_tile(0, mtile * 128, nT + 2, bl, al, [&](f32x4 (&acc)[4][4], int rb, int cb) {
      const int lane = TID() & 63, l15 = lane & 15, quad = lane >> 4;
      const float4 dsk = *(const float4*)(p.s5_d + i * 1024 + g * 16 + quad * 4);
#pragma unroll
      for (int mt = 0; mt < 4; ++mt)
#pragma unroll
        for (int nt = 0; nt < 4; ++nt) {
          const int t = (cb + nt * 16) >> 4, n = rb + mt * 16 + l15;
          const size_t tok = (size_t)b * 4096 + n * 32 + t;
          const float4 u = ln_h4(p, lr, (int)tok, g * 16 + quad * 4, *(const float4*)(p.out + tok * 1024 + g * 16 + quad * 4));
          u32x2 v;
          v[0] = pack2(gelu_tanh(acc[mt][nt][0] + dsk.x * u.x), gelu_tanh(acc[mt][nt][1] + dsk.y * u.y));
          v[1] = pack2(gelu_tanh(acc[mt][nt][2] + dsk.z * u.z), gelu_tanh(acc[mt][nt][3] + dsk.w * u.w));
          *(u32x2*)(hid + tok * 1024 + g * 16 + quad * 4) = v;
        }
    }, smem);
  }
}

DI void phase_glu(const Params& p, int i, bf16_t* smem, LnRef lr) {
  const bf16_t* W = (const bf16_t*)(p.ws + OFF_W) + W_ODD0 + (size_t)i * SZ_GLU;
  PlainLoad al{(const bf16_t*)(p.ws + OFF_HID), 1024}, bl{W, 1024};
  {
    gemm_stream(256, 16, 16, al, bl, [&](f32x4 (&acc)[4][4], int rb, int cb) {
      const int lane = TID() & 63, l15 = lane & 15, quad = lane >> 4;
#pragma unroll
      for (int mt = 0; mt < 4; ++mt)
#pragma unroll
        for (int np = 0; np < 2; ++np) {
          const int row = rb + mt * 16 + l15, col = (cb >> 1) + np * 16 + quad * 4;
          float4* ptr = (float4*)(p.out + (size_t)row * 1024 + col);
          float4 h = ln_h4(p, lr, row, col, *ptr);
          h.x = ALPHA * h.x + acc[mt][2 * np][0] * sigmoidf_(acc[mt][2 * np + 1][0]);
          h.y = ALPHA * h.y + acc[mt][2 * np][1] * sigmoidf_(acc[mt][2 * np + 1][1]);
          h.z = ALPHA * h.z + acc[mt][2 * np][2] * sigmoidf_(acc[mt][2 * np + 1][2]);
          h.w = ALPHA * h.w + acc[mt][2 * np][3] * sigmoidf_(acc[mt][2 * np + 1][3]);
          *ptr = h;
        }
    }, smem);
  }
}

DI void phase_xproj(const Params& p, int l, bf16_t* smem) {
  const bf16_t* wc = (const bf16_t*)(p.ws + OFF_W) + (size_t)l * SZ_COMMON;
  {
    PlainLoad al{(const bf16_t*)(p.ws + OFF_HB), 1024}, bl{wc, 1024};
    bf16_t* q = (bf16_t*)(p.ws + OFF_XQ);
    gemm_stream(256, 8, 16, al, bl, [&](f32x4 (&acc)[4][4], int rb, int cb) { epi_bf16(q, 1024, acc, rb, cb); }, smem);
  }
  {
    const float* memf = p.mem;
    auto al = [=](int row, int ks, int kc) -> uint4 {
      const float4* src = (const float4*)((const char*)memf + (unsigned)((row * 1024 + ks * 64 + kc) * 4));
      float4 a = src[0], b2 = src[1];
      return make_uint4(pack2(a.x, a.y), pack2(a.z, a.w), pack2(b2.x, b2.y), pack2(b2.z, b2.w));
    };
    bf16_t* kx = (bf16_t*)(p.ws + OFF_KX); bf16_t* vx = (bf16_t*)(p.ws + OFF_VX);
    for_tiles(16, 16, [&](int mi, int ni) {
      const bool isv = ni >= 8;
      PlainLoad bl{isv ? (wc + 2 * SZ_SQ) : (wc + SZ_SQ), 1024};
      gemm_tile(mi * 128, (ni & 7) * 128, 16, al, bl, [&](f32x4 (&acc)[4][4], int rb, int cb) {
        if (!isv) { epi_bf16(kx, 1024, acc, rb, cb); return; }
        const int lane = TID() & 63, l15 = lane & 15, quad = lane >> 4;
#pragma unroll
        for (int mt = 0; mt < 4; ++mt)
#pragma unroll
          for (int nt = 0; nt < 4; ++nt) {
            const int row = rb + mt * 16 + l15, col = cb + nt * 16 + quad * 4;
            const int b = row >> 8, key = row & 255, h = col >> 8, d = col & 255;
            bf16_t* dst = vx + ((size_t)((b * 4 + h) * 256 + d)) * 256 + kperm(key);
#pragma unroll
            for (int r = 0; r < 4; ++r) dst[r * 256] = f2bf(acc[mt][nt][r]);
          }
      }, smem);
    });
  }
}


DI void phase_xattn(const Params& p, bf16_t* smem) {
  const int tid = TID(), wave = tid >> 6, lane = tid & 63, l15 = lane & 15, quad = lane >> 4;
  const bf16_t* q = (const bf16_t*)(p.ws + OFF_XQ); const bf16_t* kx = (const bf16_t*)(p.ws + OFF_KX); const bf16_t* vxT = (const bf16_t*)(p.ws + OFF_VX);
  bf16_t* xo = (bf16_t*)(p.ws + OFF_XO);
  uint4 rg0, rg1, rg2, rg3, rg4, rg5, rg6, rg7;
#define XA_KLOAD(c_) do { const bf16_t* s_ = kx + (size_t)(b * 256 + (c_) * 64 + (tid >> 5)) * 1024 + h * 256 + (tid & 31) * 8; \
    rg0 = *(const uint4*)(s_); rg1 = *(const uint4*)(s_ + 8 * 1024); rg2 = *(const uint4*)(s_ + 16 * 1024); rg3 = *(const uint4*)(s_ + 24 * 1024); \
    rg4 = *(const uint4*)(s_ + 32 * 1024); rg5 = *(const uint4*)(s_ + 40 * 1024); rg6 = *(const uint4*)(s_ + 48 * 1024); rg7 = *(const uint4*)(s_ + 56 * 1024); } while (0)
#define XA_KSTORE(buf_) do { bf16_t* d_ = (buf_) + (tid >> 5) * 264 + (tid & 31) * 8; \
    *(uint4*)(d_) = rg0; *(uint4*)(d_ + 8 * 264) = rg1; *(uint4*)(d_ + 16 * 264) = rg2; *(uint4*)(d_ + 24 * 264) = rg3; \
    *(uint4*)(d_ + 32 * 264) = rg4; *(uint4*)(d_ + 40 * 264) = rg5; *(uint4*)(d_ + 48 * 264) = rg6; *(uint4*)(d_ + 56 * 264) = rg7; } while (0)
#define XA_VLOAD(c_) do { const bf16_t* s_ = vxT + ((size_t)((b * 4 + h) * 256 + (tid >> 3))) * 256 + (c_) * 64 + (tid & 7) * 8; \
    rg0 = *(const uint4*)(s_); rg1 = *(const uint4*)(s_ + 32 * 256); rg2 = *(const uint4*)(s_ + 64 * 256); rg3 = *(const uint4*)(s_ + 96 * 256); \
    rg4 = *(const uint4*)(s_ + 128 * 256); rg5 = *(const uint4*)(s_ + 160 * 256); rg6 = *(const uint4*)(s_ + 192 * 256); rg7 = *(const uint4*)(s_ + 224 * 256); } while (0)
#define XA_VSTORE(buf_) do { bf16_t* d_ = (buf_) + (tid >> 3) * 72 + (tid & 7) * 8; \
    *(uint4*)(d_) = rg0; *(uint4*)(d_ + 32 * 72) = rg1; *(uint4*)(d_ + 64 * 72) = rg2; *(uint4*)(d_ + 96 * 72) = rg3; \
    *(uint4*)(d_ + 128 * 72) = rg4; *(uint4*)(d_ + 160 * 72) = rg5; *(uint4*)(d_ + 192 * 72) = rg6; *(uint4*)(d_ + 224 * 72) = rg7; } while (0)
  for (int item = BID(); item < 2048; item += GDIM()) {
    const int b = item >> 8, h = (item >> 6) & 3, qb = item & 63;
    const size_t tq = (size_t)b * 4096 + qb * 64 + wave * 16 + l15;
    XA_KLOAD(0);
    bf16x8 qf[8];
#pragma unroll
    for (int ks = 0; ks < 8; ++ks) qf[ks] = *(const bf16x8*)(q + tq * 1024 + h * 256 + ks * 32 + quad * 8);
    XA_KSTORE(smem);
    __syncthreads();
    f32x4 s[16];
#pragma unroll
    for (int c = 0; c < 4; ++c) {
      const bf16_t* cur = smem + (c & 1) * 18432; bf16_t* nxt = smem + ((c + 1) & 1) * 18432;
      if (c < 3) XA_KLOAD(c + 1); else XA_VLOAD(0);
#pragma unroll
      for (int m4 = 0; m4 < 4; ++m4) {
        f32x4 a = {0.f, 0.f, 0.f, 0.f};
#pragma unroll
        for (int ks = 0; ks < 8; ++ks) a = MFMA16(*(const bf16x8*)(cur + (m4 * 16 + l15) * 264 + ks * 32 + quad * 8), qf[ks], a);
        s[c * 4 + m4] = a;
      }
      if (c < 3) XA_KSTORE(nxt); else XA_VSTORE(nxt);
      __syncthreads();
    }
    float m = -1e30f;
#pragma unroll
    for (int mt = 0; mt < 16; ++mt)
#pragma unroll
      for (int r = 0; r < 4; ++r) m = fmaxf(m, s[mt][r]);
    m = fmaxf(m, __shfl_xor(m, 16)); m = fmaxf(m, __shfl_xor(m, 32));
    const float c1 = 0.0625f * 1.4426950408889634f;
    float l = 0.f;
#pragma unroll
    for (int mt = 0; mt < 16; ++mt)
#pragma unroll
      for (int r = 0; r < 4; ++r) { float pv = exp2f((s[mt][r] - m) * c1); s[mt][r] = pv; l += pv; }
    l += __shfl_xor(l, 16); l += __shfl_xor(l, 32);
    f32x4 o[16];
#pragma unroll
    for (int dt = 0; dt < 16; ++dt) o[dt] = f32x4{0.f, 0.f, 0.f, 0.f};
#pragma unroll
    for (int c = 0; c < 4; ++c) {
      const bf16_t* cur = smem + (c & 1) * 18432; bf16_t* nxt = smem + ((c + 1) & 1) * 18432;
      if (c < 3) XA_VLOAD(c + 1);
#pragma unroll
      for (int s2 = 0; s2 < 2; ++s2) {
        const bf16x8 pf = pack8(s[4 * c + 2 * s2], s[4 * c + 2 * s2 + 1]);
#pragma unroll
        for (int dt = 0; dt < 16; ++dt) o[dt] = MFMA16(*(const bf16x8*)(cur + (dt * 16 + l15) * 72 + s2 * 32 + quad * 8), pf, o[dt]);
      }
      if (c < 3) XA_VSTORE(nxt);
      __syncthreads();
    }
    const float il = 1.f / l;
#pragma unroll
    for (int dt = 0; dt < 16; ++dt) {
      u32x2 v; v[0] = pack2(o[dt][0] * il, o[dt][1] * il); v[1] = pack2(o[dt][2] * il, o[dt][3] * il);
      *(u32x2*)(xo + tq * 1024 + h * 256 + dt * 16 + quad * 4) = v;
    }
  }
}

template <int R, int NT>
DI void dil_branch(const bf16_t* swk, const bf16_t* swv, size_t rowbase, int h, int tok0, const bf16x8 (&qf)[2], float& m, float& l, f32x4 (&o)[4],
                   int l15, int quad) {
  constexpr int U = 16 / R, W = 128 * R;
  f32x4 s[NT];
#pragma unroll
  for (int kt = 0; kt < NT; ++kt) {
    int kap = tok0 - W + R * (kt * 16 + l15);
    kap = min(max(kap, 0), 4095);
    const bf16_t* kp = swk + (rowbase + kap) * 512 + h * 64 + quad * 8;
    f32x4 a = {0.f, 0.f, 0.f, 0.f};
    a = MFMA16(*(const bf16x8*)kp, qf[0], a);
    a = MFMA16(*(const bf16x8*)(kp + 32), qf[1], a);
    s[kt] = a;
    if ((kt & 3) == 3) __builtin_amdgcn_sched_barrier(0);
  }
  float mx = m;
  const float c1 = 0.125f * 1.4426950408889634f;
#pragma unroll
  for (int kt = 0; kt < NT; ++kt)
#pragma unroll
    for (int r2 = 0; r2 < 4; ++r2) {
      const int c = kt * 16 + quad * 4 + r2;
      const int dist = U * l15 + 128 - c;
      const int kap = tok0 - W + R * c;
      const bool ok = (dist >= 0) && (dist <= 128) && (kap >= 0);
      const float v = ok ? s[kt][r2] * c1 : -1e30f;
      s[kt][r2] = v; mx = fmaxf(mx, v);
    }
  mx = fmaxf(mx, __shfl_xor(mx, 16)); mx = fmaxf(mx, __shfl_xor(mx, 32));
  const float corr = exp2f(m - mx);
  m = mx; l *= corr;
#pragma unroll
  for (int dt = 0; dt < 4; ++dt) { o[dt][0] *= corr; o[dt][1] *= corr; o[dt][2] *= corr; o[dt][3] *= corr; }
#pragma unroll
  for (int kt = 0; kt < NT; ++kt)
#pragma unroll
    for (int r2 = 0; r2 < 4; ++r2) { float pv = exp2f(s[kt][r2] - mx); s[kt][r2] = pv; l += pv; }
  constexpr int NS = (NT + 1) / 2;
#pragma unroll
  for (int s2 = 0; s2 < NS; ++s2) {
    const f32x4 z4 = {0.f, 0.f, 0.f, 0.f};
    const bf16x8 pf = pack8(s[2 * s2], (2 * s2 + 1 < NT) ? s[(2 * s2 + 1 < NT) ? 2 * s2 + 1 : 0] : z4);
    u32x2 vv[8];
#pragma unroll
    for (int j = 0; j < 8; ++j) {
      const int c = (2 * s2 + (j >> 2)) * 16 + quad * 4 + (j & 3);
      int kap = tok0 - W + R * c;
      kap = min(max(kap, 0), 4095);
      vv[j] = *(const u32x2*)(swv + (rowbase + kap) * 512 + h * 64 + 4 * l15);
    }
#pragma unroll
    for (int t4 = 0; t4 < 4; ++t4) {
      u32x4 t;
#pragma unroll
      for (int m = 0; m < 4; ++m) {
        const unsigned a = vv[2 * m][t4 >> 1], b2 = vv[2 * m + 1][t4 >> 1];
        t[m] = (t4 & 1) ? ((a >> 16) | (b2 & 0xffff0000u)) : ((a & 0xffffu) | (b2 << 16));
      }
      o[t4] = MFMA16(__builtin_bit_cast(bf16x8, t), pf, o[t4]);
    }
    __builtin_amdgcn_sched_barrier(0);
  }
}

DI void phase_dil_attn(const Params& p, int first, int nblk) {
  const int wave = TID() >> 6, lane = TID() & 63, l15 = lane & 15, quad = lane >> 4;
  bf16_t* swq = (bf16_t*)(WS(p) + OFF_SWQ); const bf16_t* swk = (const bf16_t*)(WS(p) + OFF_SWK); const bf16_t* swv = (const bf16_t*)(WS(p) + OFF_SWV);
  for (int item = first; item < 4096; item += nblk) {
    const int b = item >> 9, h = (item >> 6) & 7, rho = (item >> 2) & 15, gq = item & 3;
    const int tok0 = (gq * 4 + wave) * 256 + rho;
    const size_t rowbase = (size_t)b * 4096;
    const size_t tq = rowbase + tok0 + 16 * l15;
    bf16x8 qf[2];
    qf[0] = *(const bf16x8*)(swq + tq * 512 + h * 64 + quad * 8);
    qf[1] = *(const bf16x8*)(swq + tq * 512 + h * 64 + 32 + quad * 8);
    float m = -1e30f, l = 0.f;
    f32x4 o[4];
#pragma unroll
    for (int dt = 0; dt < 4; ++dt) o[dt] = f32x4{0.f, 0.f, 0.f, 0.f};
    dil_branch<16, 9>(swk, swv, rowbase, h, tok0, qf, m, l, o, l15, quad);
    dil_branch<4, 12>(swk, swv, rowbase, h, tok0, qf, m, l, o, l15, quad);
    dil_branch<1, 24>(swk, swv, rowbase, h, tok0, qf, m, l, o, l15, quad);
    l += __shfl_xor(l, 16); l += __shfl_xor(l, 32);
    const float il = 1.f / l;
    u32x4 w0, w1;
    w0[0] = pack2(o[0][0] * il, o[1][0] * il); w0[1] = pack2(o[2][0] * il, o[3][0] * il);
    w0[2] = pack2(o[0][1] * il, o[1][1] * il); w0[3] = pack2(o[2][1] * il, o[3][1] * il);
    w1[0] = pack2(o[0][2] * il, o[1][2] * il); w1[1] = pack2(o[2][2] * il, o[3][2] * il);
    w1[2] = pack2(o[0][3] * il, o[1][3] * il); w1[3] = pack2(o[2][3] * il, o[3][3] * il);
    *(u32x4*)(swq + tq * 512 + h * 64 + quad * 16) = w0;
    *(u32x4*)(swq + tq * 512 + h * 64 + quad * 16 + 8) = w1;
  }
}

DI void phase_xo(const Params& p, int l, bf16_t* smem, LnRef lr) {
  const bf16_t* wc = (const bf16_t*)(p.ws + OFF_W) + (size_t)l * SZ_COMMON + 3 * SZ_SQ;
  PlainLoad al{(const bf16_t*)(p.ws + OFF_XO), 1024}, bl{wc, 1024};
  {
    gemm_stream(256, 8, 16, al, bl, [&](f32x4 (&acc)[4][4], int rb, int cb) { epi_resid(p, lr, acc, rb, cb); }, smem);
  }
}

DI void phase_ffn_gu(const Params& p, int l, bf16_t* smem) {
  const bf16_t* W = (const bf16_t*)(p.ws + OFF_W) + (size_t)l * SZ_COMMON + 4 * SZ_SQ;
  PlainLoad al{(const bf16_t*)(p.ws + OFF_HB), 1024}, bl{W, 1024};
  bf16_t* act = (bf16_t*)(p.ws + OFF_ACT);
  {
    gemm_stream(256, 44, 16, al, bl, [&](f32x4 (&acc)[4][4], int rb, int cb) {
      const int lane = TID() & 63, l15 = lane & 15, quad = lane >> 4;
#pragma unroll
      for (int mt = 0; mt < 4; ++mt)
#pragma unroll
        for (int np = 0; np < 2; ++np) {
          u32x2 v;
          v[0] = pack2(siluf_(acc[mt][2 * np][0]) * acc[mt][2 * np + 1][0], siluf_(acc[mt][2 * np][1]) * acc[mt][2 * np + 1][1]);
          v[1] = pack2(siluf_(acc[mt][2 * np][2]) * acc[mt][2 * np + 1][2], siluf_(acc[mt][2 * np][3]) * acc[mt][2 * np + 1][3]);
          *(u32x2*)(act + (size_t)(rb + mt * 16 + l15) * 2816 + (cb >> 1) + np * 16 + quad * 4) = v;
        }
    }, smem);
  }
}
DI void phase_ffn_down(const Params& p, int l, bf16_t* smem, LnRef lr) {
  const bf16_t* W = (const bf16_t*)(p.ws + OFF_W) + (size_t)l * SZ_COMMON + 4 * SZ_SQ + SZ_GU;
  PlainLoad al{(const bf16_t*)(p.ws + OFF_ACT), 2816}, bl{W, 2816};
  {
    gemm_stream(256, 8, 44, al, bl, [&](f32x4 (&acc)[4][4], int rb, int cb) { epi_resid(p, lr, acc, rb, cb); }, smem);
  }
}


#define XB_TMO      128
#define XB_XCNT(j)  (256  + 64 * (j))
#define XB_XSUB(j)  (1280 + 64 * (j))
#define XB_XGEN(j)  (2304 + 64 * (j))
#define XB_TOP      3328
#define XB_TOPGEN   3392
#define XCD_BAR_WORDS 3456
#define XB_SPIN_CAP (1u << 22)
#define LAS __attribute__((address_space(3)))
DI unsigned xb_ld(unsigned* p) { return __hip_atomic_load(p, __ATOMIC_RELAXED, __HIP_MEMORY_SCOPE_AGENT); }
DI unsigned xb_add(unsigned* p, unsigned v) { return __hip_atomic_fetch_add(p, v, __ATOMIC_RELAXED, __HIP_MEMORY_SCOPE_AGENT); }
DI unsigned xb_xcc_id() { return (unsigned)__builtin_amdgcn_s_getreg((3 << 11) | 20) & 0xFu; }
#define XB_SPIN(cond, bar) do { unsigned _sp = 0; while (cond) { __builtin_amdgcn_s_sleep(1); \
    if ((++_sp & 255u) == 0u) { if (xb_ld(&(bar)[XB_TMO])) break; if (_sp > XB_SPIN_CAP) { atomicAdd(&(bar)[XB_TMO], 1u); break; } } } } while (0)
struct XcdBarrier { unsigned* bar; unsigned x; volatile LAS unsigned* st; };
DI XcdBarrier xcd_barrier_post(unsigned* bar, volatile LAS unsigned* st) {
  XcdBarrier b; b.bar = bar; b.x = xb_xcc_id(); b.st = st;
  if (threadIdx.x == 0) (void)xb_add(&bar[XB_XCNT(b.x)], 1u);
  return b;
}
DI void xcd_barrier_complete(unsigned* bar, unsigned x, unsigned& nloc, unsigned& nx) {
  const unsigned G = gridDim.x * gridDim.y * gridDim.z;
  unsigned sum, cnt, mine, sp = 0u;
  for (;;) {
    sum = 0u; cnt = 0u; mine = 0u;
#pragma unroll
    for (unsigned j = 0; j < 16; ++j) { const unsigned c = xb_ld(&bar[XB_XCNT(j)]); sum += c; cnt += (c > 0u) ? 1u : 0u; mine = (j == x) ? c : mine; }
    if (sum == G) break;
    __builtin_amdgcn_s_sleep(1);
    if ((++sp & 255u) == 0u) { if (xb_ld(&bar[XB_TMO])) break; if (sp > XB_SPIN_CAP) { atomicAdd(&bar[XB_TMO], 1u); break; } }
  }
  nloc = mine > 0u ? mine : 1u; nx = cnt > 0u ? cnt : 1u;
}
DI void xcd_barrier(const XcdBarrier& b) {
  asm volatile("s_waitcnt vmcnt(0)" ::: "memory");
  __syncthreads();
  if (threadIdx.x == 0) {
    unsigned* bar = b.bar;
    __builtin_amdgcn_s_waitcnt(0);
    unsigned nloc = b.st[0], nx = b.st[1];
    if (nloc == 0u) { xcd_barrier_complete(bar, b.x, nloc, nx); b.st[0] = nloc; b.st[1] = nx; }
    const unsigned old = xb_add(&bar[XB_XSUB(b.x)], 1u);
    const unsigned gen = old / nloc;
    if (old + 1u == (gen + 1u) * nloc) {
      __builtin_amdgcn_fence(__ATOMIC_RELEASE, "agent");
      asm volatile("s_waitcnt vmcnt(0)" ::: "memory");
      const unsigned og = xb_add(&bar[XB_TOP], 1u);
      const unsigned tg = og / nx;
      if (og + 1u == (tg + 1u) * nx) xb_add(&bar[XB_TOPGEN], 1u);
      else XB_SPIN(xb_ld(&bar[XB_TOPGEN]) == tg, bar);
      __builtin_amdgcn_fence(__ATOMIC_ACQUIRE, "agent");
      xb_add(&bar[XB_XGEN(b.x)], 1u);
      asm volatile("s_waitcnt vmcnt(0)" ::: "memory");
    } else {
      XB_SPIN(xb_ld(&bar[XB_XGEN(b.x)]) == gen, bar);
      __builtin_amdgcn_fence(__ATOMIC_ACQUIRE, "agent");
      asm volatile("s_waitcnt vmcnt(0)" ::: "memory");
    }
  }
  __syncthreads();
}

__global__ void __launch_bounds__(256, 2) fwd_megakernel(Params p) {
  cg::grid_group grid = cg::this_grid();
  __shared__ __attribute__((aligned(16))) char smem_raw[2 * 2 * 128 * LDT * 2];
  bf16_t* sm16 = (bf16_t*)smem_raw; float* sm32 = (float*)smem_raw;

  __shared__ uint4 xb_words;
  if (threadIdx.x == 0) xb_words = make_uint4(0u, 0u, 0u, 0u);
  __syncthreads();
  XcdBarrier xb = xcd_barrier_post((unsigned*)(p.ws + OFF_BAR), (volatile LAS unsigned*)&xb_words);
  phase_prologue(p, sm32);
  grid.sync();
  for (int l = 0; l < 4; ++l) {
    const int i = l >> 1;
    if ((l & 1) == 0) {
      phase_proj(p, i, sm16); xcd_barrier(xb);
      phase_dn_prep(p, i, smem_raw); xcd_barrier(xb);
      phase_mix(p, i, sm16); xcd_barrier(xb);
      phase_dn_post(p, i); xcd_barrier(xb);
      phase_wout(p, i, sm16, LnRef{p.ln_ffn_g + (l > 0 ? l - 1 : 0) * 1024, p.ln_ffn_b + (l > 0 ? l - 1 : 0) * 1024, l == 0 ? -1 : ((l * 3 - 1) & 3)}); xcd_barrier(xb);
    } else {
#if USE_S5_GEMM
      phase_s5_tables(p, i, sm32); xcd_barrier(xb);
      phase_s5_end(p, sm16); xcd_barrier(xb);
      phase_s5_y(p, i, sm16, LnRef{p.ln_ffn_g + (l - 1) * 1024, p.ln_ffn_b + (l - 1) * 1024, (l * 3 - 1) & 3}); xcd_barrier(xb);
#else
      phase_s5_naive(p, i); xcd_barrier(xb);
#endif
      phase_glu(p, i, sm16, LnRef{p.ln_ffn_g + (l - 1) * 1024, p.ln_ffn_b + (l - 1) * 1024, (l * 3 - 1) & 3}); xcd_barrier(xb);
    }
    phase_ln(p, p.ln_mix_g + l * 1024, p.ln_mix_b + l * 1024, (l * 3) & 3, false); xcd_barrier(xb);
    phase_xproj(p, l, sm16); xcd_barrier(xb);
    phase_xattn(p, sm16); xcd_barrier(xb);
    phase_xo(p, l, sm16, LnRef{p.ln_mix_g + l * 1024, p.ln_mix_b + l * 1024, (l * 3) & 3}); xcd_barrier(xb);
    phase_ln(p, p.ln_x_g + l * 1024, p.ln_x_b + l * 1024, (l * 3 + 1) & 3, false); xcd_barrier(xb);
    phase_ffn_gu(p, l, sm16); xcd_barrier(xb);
    phase_ffn_down(p, l, sm16, LnRef{p.ln_x_g + l * 1024, p.ln_x_b + l * 1024, (l * 3 + 1) & 3}); xcd_barrier(xb);
    phase_ln(p, p.ln_ffn_g + l * 1024, p.ln_ffn_b + l * 1024, (l * 3 + 2) & 3, l == 3); xcd_barrier(xb);
  }
}

extern "C" void kernel_launch(void* const* d_in, const int* in_sizes, int n_in, void* d_out, int out_size, void* d_ws, size_t ws_size,
                              hipStream_t stream) {
  static int grid_blocks = 0;
  if (!grid_blocks) {
    int dev = 0, cus = 0, per_cu = 0;
    hipGetDevice(&dev);
    hipDeviceGetAttribute(&cus, hipDeviceAttributeMultiprocessorCount, dev);
    hipOccupancyMaxActiveBlocksPerMultiprocessor(&per_cu, fwd_megakernel, 256, 0);
    if (per_cu > 2) per_cu = 2;
    if (per_cu < 1) per_cu = 1;
    grid_blocks = cus * per_cu;
    grid_blocks -= grid_blocks % 8;
  }
  Params p{};
  const float** pf = (const float**)&p;
  for (int i = 0; i < 32; ++i) pf[i] = (const float*)d_in[i];
  p.pos = (const int*)d_in[2];
  p.out = (float*)d_out; p.ws = (char*)d_ws;
  hipMemsetAsync((char*)d_ws + OFF_BAR, 0, XCD_BAR_WORDS * sizeof(unsigned), stream);
  void* args[] = {&p};
  hipError_t e = hipLaunchCooperativeKernel((void*)fwd_megakernel, dim3(grid_blocks), dim3(256), args, 0, stream);
  if (e != hipSuccess) fprintf(stderr, "cooperative launch failed: %s (grid %d)\n", hipGetErrorString(e), grid_blocks);
}
```
